# Optimizing an MI355X kernel written in HIP

```python
import jax
import jax.numpy as jnp
from jax import lax
import numpy as np

D_MODEL = 1024
BATCH = 4
SEQ = 8192
DEPTH = 2

GRID_W = 64
CTX_LEN = 256
HEAD_DIM = 64
A_Q_HEADS = 6
A_KV_HEADS = 2
A_GROUP = A_Q_HEADS // A_KV_HEADS
A_WINDOW = 128
A_BLOCK = 128
B_WIDTH = 256
B_CONV = 3
C_HEADS = 6
NA_ROWS = 8
NA_COLS = 16
A_WIDTH = A_Q_HEADS * HEAD_DIM
A_KV_WIDTH = A_KV_HEADS * HEAD_DIM
C_WIDTH = C_HEADS * HEAD_DIM
MIX_WIDTH = A_WIDTH + B_WIDTH + C_WIDTH
IN_SPLITS = (A_WIDTH, A_KV_WIDTH, A_KV_WIDTH, B_WIDTH, B_WIDTH, B_WIDTH, C_WIDTH, C_WIDTH, C_WIDTH)
IN_WIDTH = sum(IN_SPLITS)
N_EXPERTS = 16
EXPERT_FF = 512
CAPACITY_FACTOR = 2
ROPE_THETA = 10000.0
ROPE_AXIS_DIM = HEAD_DIM // 2
LN_EPS = 1e-6
N_MOD = 6
DEEPNORM_ALPHA = (2 * DEPTH) ** 0.25
DEEPNORM_BETA = (8 * DEPTH) ** -0.25
NEG_INF = -1e30

kernel_name = "hybrid_parallel_group_dit_block"


def _split_last(a, sizes):
    out, start = [], 0
    for n in sizes:
        out.append(a[..., start:start + n])
        start += n
    return out


def _heads(a, n_heads):
    return a.reshape(a.shape[0], a.shape[1], n_heads, HEAD_DIM)


def _ln_stats(x):
    xf = x.astype(jnp.float32)
    mu = jnp.mean(xf, axis=-1, keepdims=True)
    var = jnp.mean(jnp.square(xf - mu), axis=-1, keepdims=True)
    return (xf - mu) * lax.rsqrt(var + LN_EPS)


def ln_plain(x):
    return _ln_stats(x).astype(x.dtype)


def ln_affine(x, g, b):
    return (_ln_stats(x) * g.astype(jnp.float32) + b.astype(jnp.float32)).astype(x.dtype)


def modulate(h, shift, scale):
    return h * (1 + scale) + shift


def joint_softmax(parts):
    probs = jax.nn.softmax(jnp.concatenate([p.astype(jnp.float32) for p in parts], axis=-1), axis=-1)
    return _split_last(probs, [p.shape[-1] for p in parts])


def axial_rope(x, row_pos, col_pos):
    inv = ROPE_THETA ** (-jnp.arange(0, ROPE_AXIS_DIM, 2, dtype=jnp.float32) / ROPE_AXIS_DIM)

    def rot(xa, pos):
        ang = pos.astype(jnp.float32)[:, None] * inv[None, :]
        cos = jnp.cos(ang)[None, :, None, :].astype(x.dtype)
        sin = jnp.sin(ang)[None, :, None, :].astype(x.dtype)
        x1, x2 = jnp.split(xa, 2, axis=-1)
        return jnp.concatenate([x1 * cos - x2 * sin, x2 * cos + x1 * sin], axis=-1)

    return jnp.concatenate([rot(x[..., :ROPE_AXIS_DIM], row_pos), rot(x[..., ROPE_AXIS_DIM:], col_pos)], axis=-1)


def windowed_gqa_latent(q, k, v, k_ctx, v_ctx, sink):
    bsz, seq = q.shape[:2]
    nb = seq // A_BLOCK
    scale = HEAD_DIM ** -0.5
    qb = q.reshape(bsz, nb, A_BLOCK, A_KV_HEADS, A_GROUP, HEAD_DIM)
    pad = ((0, 0), (A_BLOCK, A_BLOCK), (0, 0), (0, 0))
    kp = jnp.pad(k, pad).reshape(bsz, nb + 2, A_BLOCK, A_KV_HEADS, HEAD_DIM)
    vp = jnp.pad(v, pad).reshape(bsz, nb + 2, A_BLOCK, A_KV_HEADS, HEAD_DIM)
    kw = jnp.concatenate([kp[:, :-2], kp[:, 1:-1], kp[:, 2:]], axis=2)
    vw = jnp.concatenate([vp[:, :-2], vp[:, 1:-1], vp[:, 2:]], axis=2)
    s_win = jnp.einsum('bnqkgd,bnjkd->bnkgqj', qb, kw).astype(jnp.float32) * scale
    blk = jnp.arange(nb)[:, None] * A_BLOCK
    qpos = blk + jnp.arange(A_BLOCK)[None, :]
    kpos = blk - A_BLOCK + jnp.arange(3 * A_BLOCK)[None, :]
    valid = ((jnp.abs(qpos[:, :, None] - kpos[:, None, :]) <= A_WINDOW)
             & (kpos[:, None, :] >= 0) & (kpos[:, None, :] < seq))
    s_win = jnp.where(valid[None, :, None, None], s_win, NEG_INF)
    s_ctx = jnp.einsum('bnqkgd,bjkd->bnkgqj', qb, k_ctx).astype(jnp.float32) * scale
    s_sink = jnp.broadcast_to(sink.reshape(A_KV_HEADS, A_GROUP)[None, None, :, :, None, None].astype(jnp.float32),
                              s_win.shape[:-1] + (1,))
    p_win, p_ctx, _ = joint_softmax([s_win, s_ctx, s_sink])
    o = (jnp.einsum('bnkgqj,bnjkd->bnqkgd', p_win.astype(v.dtype), vw)
         + jnp.einsum('bnkgqj,bjkd->bnqkgd', p_ctx.astype(v.dtype), v_ctx))
    return o.reshape(bsz, seq, A_WIDTH)


def context_gqa(q, k, v, sink):
    bsz, ln = q.shape[:2]
    qg = q.reshape(bsz, ln, A_KV_HEADS, A_GROUP, HEAD_DIM)
    s = jnp.einsum('blkgd,bjkd->bkglj', qg, k).astype(jnp.float32) * HEAD_DIM ** -0.5
    s_sink = jnp.broadcast_to(sink.reshape(A_KV_HEADS, A_GROUP)[None, :, :, None, None].astype(jnp.float32),
                              s.shape[:-1] + (1,))
    p, _ = joint_softmax([s, s_sink])
    o = jnp.einsum('bkglj,bjkd->blkgd', p.astype(v.dtype), v)
    return o.reshape(bsz, ln, A_WIDTH)


def gated_short_conv(xin, gate_b, gate_c, w):
    u = gate_c * xin
    tlen = u.shape[1]
    up = jnp.pad(u, ((0, 0), (1, 1), (0, 0)))
    y = up[:, :tlen] * w[0] + up[:, 1:tlen + 1] * w[1] + up[:, 2:] * w[2]
    return gate_b * y


def neighbourhood_attention_latent(q, k, v, k_ctx, v_ctx, rpb):
    bsz, seq = q.shape[:2]
    rows = seq // GRID_W
    kh = min(NA_ROWS, rows)
    scale = HEAD_DIM ** -0.5
    qg = q.reshape(bsz, rows, GRID_W, C_HEADS, HEAD_DIM)
    kg = k.reshape(bsz, rows, GRID_W, C_HEADS, HEAD_DIM)
    vg = v.reshape(bsz, rows, GRID_W, C_HEADS, HEAD_DIM)
    r = jnp.arange(rows)
    row_start = jnp.clip(r - kh // 2, 0, rows - kh)
    key_rows = row_start[:, None] + jnp.arange(kh)[None, :]
    kn = kg[:, key_rows]
    vn = vg[:, key_rows]
    s_nb = jnp.einsum('brqhd,brachd->brhqac', qg, kn).astype(jnp.float32) * scale
    cq = jnp.arange(GRID_W)
    col_start = jnp.clip(cq - NA_COLS // 2, 0, GRID_W - NA_COLS)
    col_ok = (cq[None, :] >= col_start[:, None]) & (cq[None, :] < col_start[:, None] + NA_COLS)
    roff = key_rows - r[:, None] + (NA_ROWS - 1)
    coff = jnp.clip(cq[None, :] - cq[:, None], -(NA_COLS - 1), NA_COLS - 1) + (NA_COLS - 1)
    bias = rpb[:, roff[:, None, :, None], coff[None, :, None, :]]
    s_nb = s_nb + jnp.transpose(bias, (1, 0, 2, 3, 4))[None].astype(jnp.float32)
    s_nb = jnp.where(col_ok[None, None, None, :, None, :], s_nb, NEG_INF)
    s_nb = s_nb.reshape(bsz, rows, C_HEADS, GRID_W, kh * GRID_W)
    s_ctx = jnp.einsum('brqhd,bjhd->brhqj', qg, k_ctx).astype(jnp.float32) * scale
    p_nb, p_ctx = joint_softmax([s_nb, s_ctx])
    p_nb = p_nb.reshape(bsz, rows, C_HEADS, GRID_W, kh, GRID_W).astype(v.dtype)
    o = (jnp.einsum('brhqac,brachd->brqhd', p_nb, vn)
         + jnp.einsum('brhqj,bjhd->brqhd', p_ctx.astype(v.dtype), v_ctx))
    return o.reshape(bsz, seq, C_WIDTH)


def context_mha(q, k, v):
    bsz, ln = q.shape[:2]
    s = jnp.einsum('blhd,bjhd->bhlj', q, k).astype(jnp.float32) * HEAD_DIM ** -0.5
    p = jax.nn.softmax(s, axis=-1).astype(v.dtype)
    return jnp.einsum('bhlj,bjhd->blhd', p, v).reshape(bsz, ln, C_WIDTH)


def expert_choice_ffn(h, w_router, w_gate, w_up, w_down):
    bsz, tlen, dm = h.shape
    cap = CAPACITY_FACTOR * tlen // N_EXPERTS
    aff = jax.nn.softmax(jnp.einsum('btd,de->bte', h, w_router).astype(jnp.float32), axis=-1)
    gate, idx = lax.top_k(jnp.transpose(aff, (0, 2, 1)), cap)
    xe = jax.vmap(lambda hb, ib: hb[ib])(h, idx)
    a = jnp.einsum('becd,edf->becf', xe, w_gate)
    u = jnp.einsum('becd,edf->becf', xe, w_up)
    y = jnp.einsum('becf,efd->becd', jax.nn.silu(a) * u, w_down) * gate[..., None].astype(h.dtype)
    return jax.vmap(lambda yb, ib: jnp.zeros((tlen, dm), yb.dtype).at[ib.reshape(-1)].add(yb.reshape(-1, dm)))(y, idx)


def setup_inputs(seed: int = 0) -> dict:
    key = jax.random.key(seed)
    ks = jax.random.split(key, 20)
    f32 = jnp.float32
    nrm = lambda k, shape, s: jax.random.normal(k, shape, f32) * s
    return {
        "x": nrm(ks[0], (BATCH, SEQ, D_MODEL), 1.0),
        "c": nrm(ks[1], (BATCH, D_MODEL), 1.0),
        "ctx": nrm(ks[2], (BATCH, CTX_LEN, D_MODEL), 1.0),
        "c_ctx": nrm(ks[3], (D_MODEL,), 1.0),
        "w_mod": nrm(ks[4], (DEPTH, D_MODEL, N_MOD * D_MODEL), D_MODEL ** -0.5),
        "b_mod": nrm(ks[5], (DEPTH, N_MOD * D_MODEL), 0.02),
        "w_in": nrm(ks[6], (DEPTH, D_MODEL, IN_WIDTH), D_MODEL ** -0.5),
        "conv_w": nrm(ks[7], (DEPTH, B_CONV, B_WIDTH), B_CONV ** -0.5),
        "attn_sink": nrm(ks[8], (DEPTH, A_Q_HEADS), 0.5),
        "na_rpb": nrm(ks[9], (DEPTH, C_HEADS, 2 * NA_ROWS - 1, 2 * NA_COLS - 1), 0.1),
        "w_out": nrm(ks[10], (DEPTH, MIX_WIDTH, D_MODEL), MIX_WIDTH ** -0.5 * DEEPNORM_BETA),
        "ln1_g": 1.0 + nrm(ks[11], (DEPTH, D_MODEL), 0.02),
        "ln1_b": nrm(ks[12], (DEPTH, D_MODEL), 0.02),
        "w_router": nrm(ks[13], (DEPTH, D_MODEL, N_EXPERTS), D_MODEL ** -0.5),
        "w_gate": nrm(ks[14], (DEPTH, N_EXPERTS, D_MODEL, EXPERT_FF), D_MODEL ** -0.5),
        "w_up": nrm(ks[15], (DEPTH, N_EXPERTS, D_MODEL, EXPERT_FF), D_MODEL ** -0.5),
        "w_down": nrm(ks[16], (DEPTH, N_EXPERTS, EXPERT_FF, D_MODEL), EXPERT_FF ** -0.5 * DEEPNORM_BETA),
        "ln2_g": 1.0 + nrm(ks[17], (DEPTH, D_MODEL), 0.02),
        "ln2_b": nrm(ks[18], (DEPTH, D_MODEL), 0.02),
    }


def reference(x, c, ctx, c_ctx, w_mod, b_mod, w_in, conv_w, attn_sink, na_rpb, w_out,
              ln1_g, ln1_b, w_router, w_gate, w_up, w_down, ln2_g, ln2_b):
    seq = x.shape[1]
    t = jnp.arange(seq)
    row_pos = t // GRID_W
    col_pos = t % GRID_W
    for l in range(DEPTH):
        last = l == DEPTH - 1
        mod = jax.nn.silu(c) @ w_mod[l] + b_mod[l]
        mod_c = jax.nn.silu(c_ctx) @ w_mod[l] + b_mod[l]
        sh1, sc1, g1, sh2, sc2, g2 = jnp.split(mod[:, None, :], N_MOD, axis=-1)
        csh1, csc1, cg1, csh2, csc2, cg2 = jnp.split(mod_c, N_MOD, axis=-1)

        h = modulate(ln_plain(x), sh1, sc1)
        hc = modulate(ln_plain(ctx), csh1, csc1)
        qa, ka, va, bx, bb, bc, qn, kn, vn = _split_last(h @ w_in[l], IN_SPLITS)
        qa_c, ka_c, va_c, bx_c, bb_c, bc_c, qn_c, kn_c, vn_c = _split_last(hc @ w_in[l], IN_SPLITS)
        ka_c = _heads(ka_c, A_KV_HEADS)
        va_c = _heads(va_c, A_KV_HEADS)
        kn_c = _heads(kn_c, C_HEADS)
        vn_c = _heads(vn_c, C_HEADS)

        o_a = windowed_gqa_latent(axial_rope(_heads(qa, A_Q_HEADS), row_pos, col_pos),
                                  axial_rope(_heads(ka, A_KV_HEADS), row_pos, col_pos),
                                  _heads(va, A_KV_HEADS), ka_c, va_c, attn_sink[l])
        o_b = gated_short_conv(bx, bb, bc, conv_w[l])
        o_c = neighbourhood_attention_latent(_heads(qn, C_HEADS), _heads(kn, C_HEADS), _heads(vn, C_HEADS),
                                             kn_c, vn_c, na_rpb[l])
        mix = jnp.concatenate([o_a, o_b, o_c], axis=-1) @ w_out[l]
        x_mid = ln_affine(DEEPNORM_ALPHA * x + g1 * mix, ln1_g[l], ln1_b[l])

        if not last:
            o_a_c = context_gqa(_heads(qa_c, A_Q_HEADS), ka_c, va_c, attn_sink[l])
            o_b_c = gated_short_conv(bx_c, bb_c, bc_c, conv_w[l])
            o_c_c = context_mha(_heads(qn_c, C_HEADS), kn_c, vn_c)
            mix_c = jnp.concatenate([o_a_c, o_b_c, o_c_c], axis=-1) @ w_out[l]
            ctx_mid = ln_affine(DEEPNORM_ALPHA * ctx + cg1 * mix_c, ln1_g[l], ln1_b[l])
            h2c = modulate(ln_plain(ctx_mid), csh2, csc2)
            ffn_c = expert_choice_ffn(h2c, w_router[l], w_gate[l], w_up[l], w_down[l])
            ctx = ln_affine(DEEPNORM_ALPHA * ctx_mid + cg2 * ffn_c, ln2_g[l], ln2_b[l])

        h2 = modulate(ln_plain(x_mid), sh2, sc2)
        ffn = expert_choice_ffn(h2, w_router[l], w_gate[l], w_up[l], w_down[l])
        x = ln_affine(DEEPNORM_ALPHA * x_mid + g2 * ffn, ln2_g[l], ln2_b[l])
    return x
```

```cpp
#include <hip/hip_runtime.h>
#include <hip/hip_cooperative_groups.h>
#include <cstdio>
#include <cstdint>
#include <cmath>

#define LAS __attribute__((address_space(3)))
typedef unsigned short bf16_t;
typedef short bf16x8 __attribute__((ext_vector_type(8)));
typedef float f32x4 __attribute__((ext_vector_type(4)));
typedef unsigned u32x4 __attribute__((ext_vector_type(4)));
typedef unsigned u32x2 __attribute__((ext_vector_type(2)));

constexpr int NB = 4, SEQ = 8192, DM = 1024, CTXL = 256, DEPTH = 2;
constexpr int NLAT = NB * SEQ, NCTX = NB * CTXL, NROWS = NLAT + NCTX;
constexpr int INW = 2560, NE = 16, FF = 512, CAP = 1024, CCAP = 32;
constexpr int NSLOT_LAT = NB * NE * CAP, NSLOT_CTX = NB * NE * CCAP, NSLOT = NSLOT_LAT + NSLOT_CTX;
constexpr int NMOD = 6 * DM;
constexpr float LN_EPS = 1e-6f;
constexpr float ALPHA = 1.41421356237309515f;
constexpr int C_QA = 0, C_KA = 384, C_VA = 512, C_BX = 640, C_BB = 896, C_BC = 1152, C_QN = 1408, C_KN = 1792, C_VN = 2176;

constexpr int NTHREADS = 512, NWAVES = 8;
constexpr int LDS_BYTES = 147456;

constexpr size_t MiB = 1u << 20;
constexpr size_t WS_CTL = 0, CTL_ZERO_BYTES = 1 * MiB;
constexpr size_t WS_ROPE = 1 * MiB;
constexpr size_t WS_MOD = 1 * MiB + 65536;
constexpr size_t WS_AFF = 2 * MiB;
constexpr size_t WS_INV = 5 * MiB;
constexpr size_t WS_TOK = 8 * MiB;
constexpr size_t WS_GATE = 8 * MiB + 512 * 1024;
constexpr size_t WS_CXR = 9 * MiB;
constexpr size_t WS_WIN = 16 * MiB;
constexpr size_t WS_WOUT = 26 * MiB;
constexpr size_t WS_WGU = 30 * MiB;
constexpr size_t WS_WD = 94 * MiB;
constexpr size_t WS_HB = 126 * MiB;
constexpr size_t WS_OB = 192 * MiB;
constexpr size_t WS_HH = 192 * MiB;
constexpr size_t WS_PB = 258 * MiB;
constexpr size_t WS_Y = 258 * MiB;
constexpr size_t WS_END = 423 * MiB;
static_assert(WS_HB + (size_t)NROWS * DM * 2 <= WS_OB && WS_OB + (size_t)NROWS * DM * 2 <= WS_PB && WS_PB + (size_t)NROWS * INW * 2 <= WS_END, "ws map");
static_assert((size_t)NSLOT * FF * 2 <= (size_t)NROWS * DM * 2 && (size_t)NSLOT * DM * 2 <= (size_t)NROWS * INW * 2, "overlays");
constexpr int CW_BAR = 4096;

struct Params {
    const float *x, *c, *ctx, *c_ctx, *w_mod, *b_mod, *w_in, *conv_w, *attn_sink, *na_rpb, *w_out, *ln1_g, *ln1_b, *w_router, *w_gate, *w_up, *w_down, *ln2_g, *ln2_b;
    float* out; unsigned char* ws;
    int ph_lo, ph_hi;
};

__device__ __forceinline__ unsigned f2bf(float f) { unsigned u = __builtin_bit_cast(unsigned, f); return (u + 0x7fffu + ((u >> 16) & 1u)) >> 16; }
__device__ __forceinline__ unsigned pk2(float lo, float hi) { return f2bf(lo) | (f2bf(hi) << 16); }
__device__ __forceinline__ float bf_lo(unsigned w) { return __builtin_bit_cast(float, w << 16); }
__device__ __forceinline__ float bf_hi(unsigned w) { return __builtin_bit_cast(float, w & 0xffff0000u); }
__device__ __forceinline__ float wave_sum(float v) {
#pragma unroll
    for (int o = 32; o >= 1; o >>= 1) v += __shfl_xor(v, o);
    return v;
}
#define LDS_WAIT() asm volatile("s_waitcnt lgkmcnt(0)" ::: "memory")

__device__ __forceinline__ float* mod_ptr(const Params& p, int l, int r) { return (float*)(p.ws + WS_MOD) + ((size_t)l * 5 + r) * NMOD; }

#define XB_TMO      128
#define XB_XCNT(j)  (256  + 64 * (j))
#define XB_XSUB(j)  (1280 + 64 * (j))
#define XB_XGEN(j)  (2304 + 64 * (j))
#define XB_TOP      3328
#define XB_TOPGEN   3392
#define XCD_BAR_WORDS 3456
#define XB_SPIN_CAP (1u << 20)
__device__ __forceinline__ unsigned xb_ld(unsigned* p)              { return __hip_atomic_load(p, __ATOMIC_RELAXED, __HIP_MEMORY_SCOPE_AGENT); }
__device__ __forceinline__ unsigned xb_add(unsigned* p, unsigned v) { return __hip_atomic_fetch_add(p, v, __ATOMIC_RELAXED, __HIP_MEMORY_SCOPE_AGENT); }
__device__ __forceinline__ unsigned xb_xcc_id() { return (unsigned)__builtin_amdgcn_s_getreg((3 << 11) | 20) & 0xFu; }
#define XB_SPIN(cond, bar) do { unsigned _sp = 0; while (cond) { __builtin_amdgcn_s_sleep(1); \
    if ((++_sp & 255u) == 0u) { if (xb_ld(&(bar)[XB_TMO])) break; if (_sp > XB_SPIN_CAP) { atomicAdd(&(bar)[XB_TMO], 1u); break; } } } } while (0)
struct XcdBarrier { unsigned* bar; unsigned x; volatile LAS unsigned* st; };
__device__ __forceinline__ XcdBarrier xcd_barrier_post(unsigned* bar, volatile LAS unsigned* st) {
    XcdBarrier b; b.bar = bar; b.x = xb_xcc_id(); b.st = st;
    if (threadIdx.x == 0) (void)xb_add(&bar[XB_XCNT(b.x)], 1u);
    return b;
}
__device__ __forceinline__ void xcd_barrier_complete(unsigned* bar, unsigned x, unsigned& nloc, unsigned& nx) {
    const unsigned G = gridDim.x * gridDim.y * gridDim.z;
    unsigned sum, cnt, mine, sp = 0u;
    for (;;) {
        sum = 0u; cnt = 0u; mine = 0u;
#pragma unroll
        for (unsigned j = 0; j < 16; ++j) { const unsigned c = xb_ld(&bar[XB_XCNT(j)]); sum += c; cnt += (c > 0u) ? 1u : 0u; mine = (j == x) ? c : mine; }
        if (sum == G) break;
        __builtin_amdgcn_s_sleep(1);
        if ((++sp & 255u) == 0u) { if (xb_ld(&bar[XB_TMO])) break; if (sp > XB_SPIN_CAP) { atomicAdd(&bar[XB_TMO], 1u); break; } }
    }
    nloc = mine > 0u ? mine : 1u; nx = cnt > 0u ? cnt : 1u;
}
__device__ __forceinline__ void xcd_barrier(const XcdBarrier& b) {
    asm volatile("s_waitcnt vmcnt(0)" ::: "memory");
    __syncthreads();
    if (threadIdx.x == 0) {
        unsigned* bar = b.bar;
        __builtin_amdgcn_s_waitcnt(0);
        unsigned nloc = b.st[0], nx = b.st[1];
        if (nloc == 0u) { xcd_barrier_complete(bar, b.x, nloc, nx); b.st[0] = nloc; b.st[1] = nx; }
        const unsigned old = xb_add(&bar[XB_XSUB(b.x)], 1u);
        const unsigned gen = old / nloc;
        if (old + 1u == (gen + 1u) * nloc) {
            __builtin_amdgcn_fence(__ATOMIC_RELEASE, "agent");
            asm volatile("s_waitcnt vmcnt(0)" ::: "memory");
            const unsigned og = xb_add(&bar[XB_TOP], 1u);
            const unsigned tg = og / nx;
            if (og + 1u == (tg + 1u) * nx) xb_add(&bar[XB_TOPGEN], 1u);
            else XB_SPIN(xb_ld(&bar[XB_TOPGEN]) == tg, bar);
            __builtin_amdgcn_fence(__ATOMIC_ACQUIRE, "agent");
            xb_add(&bar[XB_XGEN(b.x)], 1u);
            asm volatile("s_waitcnt vmcnt(0)" ::: "memory");
        } else {
            XB_SPIN(xb_ld(&bar[XB_XGEN(b.x)]) == gen, bar);
            __builtin_amdgcn_fence(__ATOMIC_ACQUIRE, "agent");
            asm volatile("s_waitcnt vmcnt(0)" ::: "memory");
        }
    }
    __syncthreads();
}

__device__ __forceinline__ void transpose_item(const float* W, int K, int N, bf16_t* WT, int mode, LAS float* scr, int item, int lane) {
    const int nblk = N / 32, kb = item / nblk, nb = item % nblk, k0 = 64 * kb, n0 = 32 * nb;
#pragma unroll 8
    for (int i = 0; i < 32; ++i) { const int kk = 2 * i + (lane >> 5); scr[kk * 33 + (lane & 31)] = W[(size_t)(k0 + kk) * N + n0 + (lane & 31)]; }
    LDS_WAIT();
    const int c = lane & 7;
#pragma unroll
    for (int j = 0; j < 4; ++j) {
        const int n = (lane >> 3) + 8 * j; const LAS float* s = scr + (8 * c) * 33 + n;
        u32x4 o; o.x = pk2(s[0 * 33], s[1 * 33]); o.y = pk2(s[2 * 33], s[3 * 33]); o.z = pk2(s[4 * 33], s[5 * 33]); o.w = pk2(s[6 * 33], s[7 * 33]);
        const int f = n0 + n; const int orow = mode == 0 ? f : (32 * (f >> 4) + (f & 15) + (mode == 2 ? 16 : 0));
        *(u32x4*)(WT + (size_t)orow * K + k0 + 8 * c) = o;
    }
    LDS_WAIT();
}

__device__ __forceinline__ void phase_prologue(const Params& p, LAS unsigned char* lds, int bid, int nb) {
    const int tid = threadIdx.x, lane = tid & 63, w = tid >> 6;
    {
        LAS float* ssil = (LAS float*)lds;
        LAS float* red = ssil + 5 * 1024;
        for (int i = tid; i < 5 * 1024; i += NTHREADS) { const int r = i >> 10, k = i & 1023; const float v = r < 4 ? p.c[r * 1024 + k] : p.c_ctx[k]; ssil[i] = v / (1.f + expf(-v)); }
        __syncthreads();
        for (int item = bid; item < 2 * 96; item += nb) {
            const int l = item / 96, n0 = (item % 96) * 64;
            const float* W = p.w_mod + (size_t)l * DM * NMOD + n0 + lane;
            float a0 = 0.f, a1 = 0.f, a2 = 0.f, a3 = 0.f, a4 = 0.f;
#pragma unroll 8
            for (int k = w * 128; k < w * 128 + 128; ++k) {
                const float wv = W[(size_t)k * NMOD];
                a0 += ssil[k] * wv; a1 += ssil[1024 + k] * wv; a2 += ssil[2048 + k] * wv; a3 += ssil[3072 + k] * wv; a4 += ssil[4096 + k] * wv;
            }
            red[(w * 5 + 0) * 64 + lane] = a0; red[(w * 5 + 1) * 64 + lane] = a1; red[(w * 5 + 2) * 64 + lane] = a2; red[(w * 5 + 3) * 64 + lane] = a3; red[(w * 5 + 4) * 64 + lane] = a4;
            __syncthreads();
            if (tid < 320) { const int r = tid >> 6; float s = 0.f;
#pragma unroll
                for (int ww = 0; ww < 8; ++ww) s += red[(ww * 5 + r) * 64 + lane];
                mod_ptr(p, l, r)[n0 + lane] = s + p.b_mod[l * NMOD + n0 + lane]; }
            __syncthreads();
        }
    }
    if (bid == nb - 1) {
        float* rope = (float*)(p.ws + WS_ROPE);
        for (int e = tid; e < 128 * 16; e += NTHREADS) {
            const int pos = e >> 4, i = e & 15;
            const double a = exp(-((double)i / 16.0) * 9.210340371976184);
            const double a2 = a * a; double c = 1.0, s = a, tc = 1.0, ts = a;
            for (int n = 1; n <= 14; ++n) { tc *= -a2 / (double)((2 * n - 1) * (2 * n)); c += tc; ts *= -a2 / (double)((2 * n) * (2 * n + 1)); s += ts; }
            double rc = 1.0, rs = 0.0, bc = c, bs = s; int q = pos;
            while (q) { if (q & 1) { const double t = rc * bc - rs * bs; rs = rc * bs + rs * bc; rc = t; } const double t = bc * bc - bs * bs; bs = 2.0 * bc * bs; bc = t; q >>= 1; }
            rope[2 * e] = (float)rc; rope[2 * e + 1] = (float)rs;
        }
    }
    __syncthreads();
    {
        LAS float* scr = (LAS float*)lds + w * (64 * 33);
        const int gw = bid * NWAVES + w, NGW = nb * NWAVES;
        constexpr int I_IN = 16 * 80, I_OUT = 16 * 32, I_G = 16 * 16, I_D = 8 * 32;
        constexpr int PER_L = I_IN + I_OUT + 16 * (2 * I_G + I_D);
        for (int it = gw; it < 2 * PER_L; it += NGW) {
            const int l = it / PER_L; int r = it % PER_L;
            if (r < I_IN) { transpose_item(p.w_in + (size_t)l * DM * INW, DM, INW, (bf16_t*)(p.ws + WS_WIN) + (size_t)l * INW * DM, 0, scr, r, lane); continue; } r -= I_IN;
            if (r < I_OUT) { transpose_item(p.w_out + (size_t)l * DM * DM, DM, DM, (bf16_t*)(p.ws + WS_WOUT) + (size_t)l * DM * DM, 0, scr, r, lane); continue; } r -= I_OUT;
            if (r < 16 * I_G) { const int e = r / I_G; transpose_item(p.w_gate + ((size_t)l * NE + e) * DM * FF, DM, FF, (bf16_t*)(p.ws + WS_WGU) + ((size_t)l * NE + e) * 1024 * DM, 1, scr, r % I_G, lane); continue; } r -= 16 * I_G;
            if (r < 16 * I_G) { const int e = r / I_G; transpose_item(p.w_up + ((size_t)l * NE + e) * DM * FF, DM, FF, (bf16_t*)(p.ws + WS_WGU) + ((size_t)l * NE + e) * 1024 * DM, 2, scr, r % I_G, lane); continue; } r -= 16 * I_G;
            { const int e = r / I_D; transpose_item(p.w_down + ((size_t)l * NE + e) * FF * DM, FF, DM, (bf16_t*)(p.ws + WS_WD) + ((size_t)l * NE + e) * DM * FF, 0, scr, r % I_D, lane); }
        }
    }
}

__device__ __forceinline__ void row_load(const float* rowp, int lane, f32x4 (&v)[4]) {
#pragma unroll
    for (int j = 0; j < 4; ++j) v[j] = *(const f32x4*)(rowp + 256 * j + 4 * lane);
}
__device__ __forceinline__ void row_store(float* rowp, int lane, const f32x4 (&v)[4]) {
#pragma unroll
    for (int j = 0; j < 4; ++j) *(f32x4*)(rowp + 256 * j + 4 * lane) = v[j];
}
__device__ __forceinline__ void row_store_bf16(bf16_t* rowp, int lane, const f32x4 (&v)[4]) {
#pragma unroll
    for (int j = 0; j < 4; ++j) { u32x2 o; o.x = pk2(v[j][0], v[j][1]); o.y = pk2(v[j][2], v[j][3]); *(u32x2*)(rowp + 256 * j + 4 * lane) = o; }
}
__device__ __forceinline__ void row_normalize(f32x4 (&v)[4]) {
    float s = 0.f;
#pragma unroll
    for (int j = 0; j < 4; ++j) s += (v[j][0] + v[j][1]) + (v[j][2] + v[j][3]);
    const float mean = wave_sum(s) * (1.f / DM);
    float q = 0.f;
#pragma unroll
    for (int j = 0; j < 4; ++j) { v[j] = v[j] - mean; q += (v[j][0] * v[j][0] + v[j][1] * v[j][1]) + (v[j][2] * v[j][2] + v[j][3] * v[j][3]); }
    const float rstd = 1.f / sqrtf(wave_sum(q) * (1.f / DM) + LN_EPS);
#pragma unroll
    for (int j = 0; j < 4; ++j) v[j] = v[j] * rstd;
}
__device__ __forceinline__ void row_modulate(f32x4 (&v)[4], const float* sh, const float* sc, int lane) {
#pragma unroll
    for (int j = 0; j < 4; ++j) { const f32x4 a = *(const f32x4*)(sc + 256 * j + 4 * lane), b = *(const f32x4*)(sh + 256 * j + 4 * lane); v[j] = v[j] * (a + 1.f) + b; }
}
__device__ __forceinline__ void row_affine(f32x4 (&v)[4], const float* g, const float* bb, int lane) {
#pragma unroll
    for (int j = 0; j < 4; ++j) { const f32x4 a = *(const f32x4*)(g + 256 * j + 4 * lane), b = *(const f32x4*)(bb + 256 * j + 4 * lane); v[j] = v[j] * a + b; }
}
__device__ __forceinline__ int row_modrow(int row) { return row < NLAT ? (row >> 13) : 4; }

__device__ __forceinline__ void phase_ln1(const Params& p, int bid, int nb) {
    const int lane = threadIdx.x & 63, gw = bid * NWAVES + (threadIdx.x >> 6), NGW = nb * NWAVES;
    bf16_t* HB = (bf16_t*)(p.ws + WS_HB);
    for (int row = gw; row < NROWS; row += NGW) {
        const float* src = row < NLAT ? p.x + (size_t)row * DM : p.ctx + (size_t)(row - NLAT) * DM;
        f32x4 v[4]; row_load(src, lane, v); row_normalize(v);
        const float* m = mod_ptr(p, 0, row_modrow(row)); row_modulate(v, m, m + DM, lane);
        row_store_bf16(HB + (size_t)row * DM, lane, v);
    }
}

struct SgDesc { const bf16_t* A; int lda; const int* rowidx; const bf16_t* Bt; size_t grp_stride; int rows_per_grp, ngrp; int M, N, K; int row_base; };
template <class Epi>
__device__ __forceinline__ void sg_gemm(const SgDesc& g, const Epi& E, int bid, int nb) {
    const int lane = threadIdx.x & 63, w = threadIdx.x >> 6, fr = lane & 15, fq = lane >> 4, wm = w >> 1, wn = w & 1;
    const int tilesN = g.N / 128, tiles = (g.M / 128) * tilesN;
    for (int t = bid; t < tiles; t += nb) {
        const int tm = t / tilesN, tn = t % tilesN;
        const int row0 = tm * 128 + wm * 32, col0 = tn * 128 + wn * 64;
        const bf16_t* Bt = g.Bt + (size_t)(((tm * 128) / g.rows_per_grp) % g.ngrp) * g.grp_stride;
        const bf16_t* ap[2]; const bf16_t* bp[4];
#pragma unroll
        for (int i = 0; i < 2; ++i) { const int r = row0 + 16 * i + fr; const int ar = g.rowidx ? g.rowidx[r] : r; ap[i] = g.A + (size_t)ar * g.lda + 8 * fq; }
#pragma unroll
        for (int n = 0; n < 4; ++n) bp[n] = Bt + (size_t)(col0 + 16 * n + fr) * g.K + 8 * fq;
        f32x4 acc[2][4];
#pragma unroll
        for (int i = 0; i < 2; ++i)
#pragma unroll
            for (int n = 0; n < 4; ++n) acc[i][n] = (f32x4){0.f, 0.f, 0.f, 0.f};
#pragma unroll 2
        for (int k = 0; k < g.K; k += 32) {
            bf16x8 a[2], b[4];
#pragma unroll
            for (int i = 0; i < 2; ++i) a[i] = *(const bf16x8*)(ap[i] + k);
#pragma unroll
            for (int n = 0; n < 4; ++n) b[n] = *(const bf16x8*)(bp[n] + k);
#pragma unroll
            for (int i = 0; i < 2; ++i)
#pragma unroll
                for (int n = 0; n < 4; ++n) acc[i][n] = __builtin_amdgcn_mfma_f32_16x16x32_bf16(b[n], a[i], acc[i][n], 0, 0, 0);
        }
#pragma unroll
        for (int i = 0; i < 2; ++i)
#pragma unroll
            for (int g2 = 0; g2 < 2; ++g2) E(g.row_base + row0 + 16 * i + fr, col0 + 32 * g2, fq, acc[i][2 * g2], acc[i][2 * g2 + 1]);
    }
}

__device__ __forceinline__ void store_bf16x4(bf16_t* p, const f32x4 v) { u32x2 o; o.x = pk2(v[0], v[1]); o.y = pk2(v[2], v[3]); *(u32x2*)p = o; }

struct EpiQKV {
    bf16_t* PB; const float* rope;
    __device__ __forceinline__ void operator()(int row, int c32, int fq, f32x4 v0, f32x4 v1) const {
        if (c32 < 512 && row < NLAT) {
            const int t = row & (SEQ - 1); const int pos = (c32 & 32) ? (t & 63) : (t >> 6);
            const float* rp = rope + (pos * 16 + 4 * fq) * 2;
#pragma unroll
            for (int j = 0; j < 4; ++j) { const float cs = rp[2 * j], sn = rp[2 * j + 1], a = v0[j], b = v1[j]; v0[j] = a * cs - b * sn; v1[j] = b * cs + a * sn; }
        }
        bf16_t* o = PB + (size_t)row * INW + c32 + 4 * fq;
        store_bf16x4(o, v0); store_bf16x4(o + 16, v1);
    }
};
struct EpiOut {
    const float* xl; const float* xc; float* XR; float* CXR; const float* mod;
    __device__ __forceinline__ void operator()(int row, int c32, int fq, f32x4 v0, f32x4 v1) const {
        const int c = c32 + 4 * fq; const float* xin; float* xo; const float* g1;
        if (row < NLAT) { xin = xl + (size_t)row * DM; xo = XR + (size_t)row * DM; g1 = mod + (size_t)(row >> 13) * NMOD + 2 * DM; }
        else { const int r = row - NLAT; xin = xc + (size_t)r * DM; xo = CXR + (size_t)r * DM; g1 = mod + (size_t)4 * NMOD + 2 * DM; }
        const f32x4 x0 = *(const f32x4*)(xin + c), x1 = *(const f32x4*)(xin + c + 16), g0 = *(const f32x4*)(g1 + c), g1v = *(const f32x4*)(g1 + c + 16);
        *(f32x4*)(xo + c) = x0 * ALPHA + g0 * v0; *(f32x4*)(xo + c + 16) = x1 * ALPHA + g1v * v1;
    }
};
struct EpiGU {
    bf16_t* HH;
    __device__ __forceinline__ void operator()(int row, int c32, int fq, f32x4 v0, f32x4 v1) const {
        f32x4 h;
#pragma unroll
        for (int j = 0; j < 4; ++j) h[j] = v0[j] / (1.f + __expf(-v0[j])) * v1[j];
        store_bf16x4(HH + (size_t)row * FF + (c32 >> 1) + 4 * fq, h);
    }
};
struct EpiDown {
    bf16_t* Y; const float* gate;
    __device__ __forceinline__ void operator()(int row, int c32, int fq, f32x4 v0, f32x4 v1) const {
        const float g = gate[row]; bf16_t* o = Y + (size_t)row * DM + c32 + 4 * fq;
        store_bf16x4(o, v0 * g); store_bf16x4(o + 16, v1 * g);
    }
};

struct AttnState { float m, l; float o[32]; };
__device__ __forceinline__ void attn_init(AttnState& st) { st.m = -INFINITY; st.l = 0.f;
#pragma unroll
    for (int d = 0; d < 32; ++d) st.o[d] = 0.f; }
__device__ __forceinline__ void load_row32(const bf16_t* p, float (&r)[32], float scale) {
#pragma unroll
    for (int i = 0; i < 4; ++i) { const u32x4 w = *(const u32x4*)(p + 8 * i);
        r[8 * i + 0] = bf_lo(w.x) * scale; r[8 * i + 1] = bf_hi(w.x) * scale; r[8 * i + 2] = bf_lo(w.y) * scale; r[8 * i + 3] = bf_hi(w.y) * scale;
        r[8 * i + 4] = bf_lo(w.z) * scale; r[8 * i + 5] = bf_hi(w.z) * scale; r[8 * i + 6] = bf_lo(w.w) * scale; r[8 * i + 7] = bf_hi(w.w) * scale; }
}
__device__ __forceinline__ float dot_row32(const bf16_t* p, const float (&q)[32]) {
    float d0 = 0.f, d1 = 0.f;
#pragma unroll
    for (int i = 0; i < 4; ++i) { const u32x4 w = *(const u32x4*)(p + 8 * i);
        d0 += q[8 * i + 0] * bf_lo(w.x); d1 += q[8 * i + 1] * bf_hi(w.x); d0 += q[8 * i + 2] * bf_lo(w.y); d1 += q[8 * i + 3] * bf_hi(w.y);
        d0 += q[8 * i + 4] * bf_lo(w.z); d1 += q[8 * i + 5] * bf_hi(w.z); d0 += q[8 * i + 6] * bf_lo(w.w); d1 += q[8 * i + 7] * bf_hi(w.w); }
    const float d = d0 + d1;
    return d + __shfl_xor(d, 32);
}
__device__ __forceinline__ void axpy_row32(const bf16_t* p, float a, float (&o)[32]) {
#pragma unroll
    for (int i = 0; i < 4; ++i) { const u32x4 w = *(const u32x4*)(p + 8 * i);
        o[8 * i + 0] += a * bf_lo(w.x); o[8 * i + 1] += a * bf_hi(w.x); o[8 * i + 2] += a * bf_lo(w.y); o[8 * i + 3] += a * bf_hi(w.y);
        o[8 * i + 4] += a * bf_lo(w.z); o[8 * i + 5] += a * bf_hi(w.z); o[8 * i + 6] += a * bf_lo(w.w); o[8 * i + 7] += a * bf_hi(w.w); }
}
template <class ScoreFn>
__device__ __forceinline__ void attn_segment(const float (&q)[32], AttnState& st, const bf16_t* Kb, const bf16_t* Vb, int j0, int j1, ScoreFn sf) {
#pragma unroll 1
    for (int j = j0; j < j1; ++j) {
        const float s0 = sf(j, dot_row32(Kb + (size_t)j * INW, q));
        if (s0 > st.m) { const float corr = __expf(st.m - s0); st.l *= corr;
#pragma unroll
            for (int d = 0; d < 32; ++d) st.o[d] *= corr;
            st.m = s0; }
        const float p0 = (s0 == -INFINITY) ? 0.f : __expf(s0 - st.m);
        st.l += p0;
        axpy_row32(Vb + (size_t)j * INW, p0, st.o);
    }
}
__device__ __forceinline__ void attn_sink(AttnState& st, float sk) {
    if (sk > st.m) { const float corr = __expf(st.m - sk); st.l *= corr;
#pragma unroll
        for (int d = 0; d < 32; ++d) st.o[d] *= corr;
        st.m = sk; }
    st.l += __expf(sk - st.m);
}
__device__ __forceinline__ void attn_store(const AttnState& st, bf16_t* o) {
    const float inv = 1.f / st.l;
#pragma unroll
    for (int i = 0; i < 4; ++i) { u32x4 w; w.x = pk2(st.o[8 * i] * inv, st.o[8 * i + 1] * inv); w.y = pk2(st.o[8 * i + 2] * inv, st.o[8 * i + 3] * inv);
        w.z = pk2(st.o[8 * i + 4] * inv, st.o[8 * i + 5] * inv); w.w = pk2(st.o[8 * i + 6] * inv, st.o[8 * i + 7] * inv); *(u32x4*)(o + 8 * i) = w; }
}

__device__ __forceinline__ void phase_mixers(const Params& p, int l, bool with_ctx, int bid, int nb) {
    const int lane = threadIdx.x & 63, gw = bid * NWAVES + (threadIdx.x >> 6), NGW = nb * NWAVES;
    const int ql = lane & 31, hf = lane >> 5;
    const bf16_t* PB = (const bf16_t*)(p.ws + WS_PB); bf16_t* OB = (bf16_t*)(p.ws + WS_OB);
    const float* sink = p.attn_sink + l * 6; const float* rpb = p.na_rpb + (size_t)l * 6 * 15 * 31;
#pragma unroll 1
    for (int it = gw; it < NB * 6 * 256; it += NGW) {
        const int chunk = it & 255, h = (it >> 8) % 6, b = it / (6 * 256), kvh = h / 3;
        const int t = chunk * 32 + ql; const size_t rowb = (size_t)b * SEQ;
        float q[32]; load_row32(PB + (rowb + t) * INW + C_QA + h * 64 + 32 * hf, q, 0.125f);
        AttnState st; attn_init(st);
        const int jlo = max(0, chunk * 32 - 128), jhi = min(SEQ, chunk * 32 + 32 + 128);
        attn_segment(q, st, PB + rowb * INW + C_KA + kvh * 64 + 32 * hf, PB + rowb * INW + C_VA + kvh * 64 + 32 * hf, jlo, jhi,
                     [&](int j, float d) { const int dt = t - j; return (dt <= 128 && dt >= -128) ? d : -INFINITY; });
        const size_t crow = (size_t)NLAT + (size_t)b * CTXL;
        attn_segment(q, st, PB + crow * INW + C_KA + kvh * 64 + 32 * hf, PB + crow * INW + C_VA + kvh * 64 + 32 * hf, 0, CTXL, [&](int, float d) { return d; });
        attn_sink(st, sink[h]);
        attn_store(st, OB + (rowb + t) * DM + h * 64 + 32 * hf);
    }
#pragma unroll 1
    for (int it = gw; it < NB * 6 * 256; it += NGW) {
        const int r = (it & 255) >> 1, ch = it & 1, h = (it >> 8) % 6, b = it / (6 * 256);
        const int cq = ch * 32 + ql; const size_t rowb = (size_t)b * SEQ; const int t = r * 64 + cq;
        float q[32]; load_row32(PB + (rowb + t) * INW + C_QN + h * 64 + 32 * hf, q, 0.125f);
        AttnState st; attn_init(st);
        const int rs = min(max(r - 4, 0), 128 - 8), cs = min(max(cq - 8, 0), 64 - 16);
        const float* bias = rpb + (size_t)h * 15 * 31;
        attn_segment(q, st, PB + (rowb + (size_t)rs * 64) * INW + C_KN + h * 64 + 32 * hf, PB + (rowb + (size_t)rs * 64) * INW + C_VN + h * 64 + 32 * hf, 0, 512,
                     [&](int j, float d) { const int ka = rs + (j >> 6), ck = j & 63; const bool ok = (ck >= cs) && (ck < cs + 16);
                                           const int ro = ka - r + 7, co = min(max(ck - cq, -15), 15) + 15; return ok ? d + bias[ro * 31 + co] : -INFINITY; });
        const size_t crow = (size_t)NLAT + (size_t)b * CTXL;
        attn_segment(q, st, PB + crow * INW + C_KN + h * 64 + 32 * hf, PB + crow * INW + C_VN + h * 64 + 32 * hf, 0, CTXL, [&](int, float d) { return d; });
        attn_store(st, OB + (rowb + t) * DM + 640 + h * 64 + 32 * hf);
    }
    {
        const float* cw = p.conv_w + (size_t)l * 3 * 256;
        const int nrows = with_ctx ? NROWS : NLAT;
        for (long e = (long)bid * NTHREADS + threadIdx.x; e < (long)nrows * 32; e += (long)nb * NTHREADS) {
            const int row = (int)(e >> 5), ch = (int)(e & 31) * 8;
            const int tpos = row < NLAT ? (row & (SEQ - 1)) : ((row - NLAT) & (CTXL - 1)); const int tlen = row < NLAT ? SEQ : CTXL;
            const bf16_t* pr = PB + (size_t)row * INW;
            float u[3][8];
#pragma unroll
            for (int dlt = -1; dlt <= 1; ++dlt) {
                const bool ok = (tpos + dlt >= 0) && (tpos + dlt < tlen);
                if (ok) { const u32x4 a = *(const u32x4*)(pr + (long)dlt * INW + C_BX + ch), c = *(const u32x4*)(pr + (long)dlt * INW + C_BC + ch);
                    u[dlt + 1][0] = bf_lo(a.x) * bf_lo(c.x); u[dlt + 1][1] = bf_hi(a.x) * bf_hi(c.x); u[dlt + 1][2] = bf_lo(a.y) * bf_lo(c.y); u[dlt + 1][3] = bf_hi(a.y) * bf_hi(c.y);
                    u[dlt + 1][4] = bf_lo(a.z) * bf_lo(c.z); u[dlt + 1][5] = bf_hi(a.z) * bf_hi(c.z); u[dlt + 1][6] = bf_lo(a.w) * bf_lo(c.w); u[dlt + 1][7] = bf_hi(a.w) * bf_hi(c.w); }
                else {
#pragma unroll
                    for (int i = 0; i < 8; ++i) u[dlt + 1][i] = 0.f; }
            }
            const u32x4 gb = *(const u32x4*)(pr + C_BB + ch);
            const float g[8] = {bf_lo(gb.x), bf_hi(gb.x), bf_lo(gb.y), bf_hi(gb.y), bf_lo(gb.z), bf_hi(gb.z), bf_lo(gb.w), bf_hi(gb.w)};
            float y[8];
#pragma unroll
            for (int i = 0; i < 8; ++i) y[i] = g[i] * (u[0][i] * cw[ch + i] + u[1][i] * cw[256 + ch + i] + u[2][i] * cw[512 + ch + i]);
            u32x4 o; o.x = pk2(y[0], y[1]); o.y = pk2(y[2], y[3]); o.z = pk2(y[4], y[5]); o.w = pk2(y[6], y[7]);
            *(u32x4*)(OB + (size_t)row * DM + 384 + ch) = o;
        }
    }
    if (with_ctx) {
#pragma unroll 1
        for (int it = gw; it < 2 * NB * 6 * 8; it += NGW) {
            const int kind = it / (NB * 6 * 8), r = it % (NB * 6 * 8), chunk = r & 7, h = (r >> 3) % 6, b = r / 48;
            const size_t crow = (size_t)NLAT + (size_t)b * CTXL; const int tq = chunk * 32 + ql;
            const int qc = (kind == 0 ? C_QA + h * 64 : C_QN + h * 64) + 32 * hf, kc = (kind == 0 ? C_KA + (h / 3) * 64 : C_KN + h * 64) + 32 * hf, vc = (kind == 0 ? C_VA + (h / 3) * 64 : C_VN + h * 64) + 32 * hf;
            float q[32]; load_row32(PB + (crow + tq) * INW + qc, q, 0.125f);
            AttnState st; attn_init(st);
            attn_segment(q, st, PB + crow * INW + kc, PB + crow * INW + vc, 0, CTXL, [&](int, float d) { return d; });
            if (kind == 0) attn_sink(st, sink[h]);
            attn_store(st, OB + (crow + tq) * DM + (kind == 0 ? 0 : 640) + h * 64 + 32 * hf);
        }
    }
}

__device__ __forceinline__ void phase_ln_router(const Params& p, int l, bool with_ctx, LAS unsigned char* lds, int bid, int nb) {
    const int tid = threadIdx.x, lane = tid & 63, gw = bid * NWAVES + (tid >> 6), NGW = nb * NWAVES;
    LAS float* wr = (LAS float*)lds;
    const float* wrg = p.w_router + (size_t)l * DM * NE;
    for (int i = tid; i < DM * NE; i += NTHREADS) { const int c = i >> 4, e = i & 15; wr[e * DM + c] = wrg[i]; }
    __syncthreads();
    float* XR = p.out; float* CXR = (float*)(p.ws + WS_CXR); bf16_t* HB = (bf16_t*)(p.ws + WS_HB); float* AFF = (float*)(p.ws + WS_AFF);
    const float* g = p.ln1_g + l * DM; const float* bb = p.ln1_b + l * DM;
    const int nrows = with_ctx ? NROWS : NLAT;
    for (int row = gw; row < nrows; row += NGW) {
        float* xr = row < NLAT ? XR + (size_t)row * DM : CXR + (size_t)(row - NLAT) * DM;
        f32x4 v[4]; row_load(xr, lane, v); row_normalize(v); row_affine(v, g, bb, lane); row_store(xr, lane, v);
        row_normalize(v);
        const float* m = mod_ptr(p, l, row_modrow(row)); row_modulate(v, m + 3 * DM, m + 4 * DM, lane);
        row_store_bf16(HB + (size_t)row * DM, lane, v);
        float lg[16];
#pragma unroll
        for (int e = 0; e < 16; ++e) { float s = 0.f;
#pragma unroll
            for (int j = 0; j < 4; ++j) { const f32x4 wv = *(const LAS f32x4*)(wr + e * DM + 256 * j + 4 * lane); s += (v[j][0] * wv[0] + v[j][1] * wv[1]) + (v[j][2] * wv[2] + v[j][3] * wv[3]); }
            lg[e] = wave_sum(s);
            if ((e & 3) == 3) asm volatile("" ::: "memory"); }
        float mx = lg[0];
#pragma unroll
        for (int e = 1; e < 16; ++e) mx = fmaxf(mx, lg[e]);
        float sum = 0.f;
#pragma unroll
        for (int e = 0; e < 16; ++e) { lg[e] = expf(lg[e] - mx); sum += lg[e]; }
        const float inv = 1.f / sum; float mine = 0.f;
#pragma unroll
        for (int e = 0; e < 16; ++e) mine = (lane == e) ? lg[e] * inv : mine;
        if (lane < 16) AFF[(size_t)row * 16 + lane] = mine;
    }
}

__device__ __forceinline__ void topk_item(const float* aff  , int n, int k, int row0  , int e, int slot0,
                                          int* TOK, float* GATE, int* INV, LAS unsigned char* lds) {
    const int tid = threadIdx.x, lane = tid & 63, w = tid >> 6;
    LAS unsigned* keys = (LAS unsigned*)lds;
    LAS unsigned* hist = keys + 8192;
    LAS unsigned* misc = hist + 256;
    for (int i = tid; i < n; i += NTHREADS) keys[i] = __builtin_bit_cast(unsigned, aff[(size_t)i * 16]);
    if (tid == 0) { misc[0] = 0u; misc[1] = (unsigned)k; }
    __syncthreads();
    unsigned maskv = 0u;
    for (int pass = 0; pass < 4; ++pass) {
        const int shift = 24 - 8 * pass;
        if (tid < 256) hist[tid] = 0u;
        __syncthreads();
        const unsigned prefix = misc[0];
        for (int i = tid; i < n; i += NTHREADS) { const unsigned kv = keys[i]; if ((kv & maskv) == prefix) atomicAdd((unsigned*)&hist[(kv >> shift) & 255u], 1u); }
        __syncthreads();
        if (tid == 0) { unsigned rem = misc[1], cum = 0u; int bin = 255;
            for (; bin > 0; --bin) { const unsigned hc = hist[bin]; if (cum + hc >= rem) break; cum += hc; }
            misc[0] = prefix | ((unsigned)bin << shift); misc[1] = rem - cum; }
        __syncthreads();
        maskv |= 255u << shift;
    }
    const unsigned T = misc[0], need_eq = misc[1];
    __syncthreads();
    const int per = n >= NTHREADS ? n / NTHREADS : 1; const int t0 = tid * per; const bool act = t0 < n;
    unsigned ce = 0u;
    if (act) for (int i = 0; i < per; ++i) ce += (keys[t0 + i] == T) ? 1u : 0u;
    unsigned inc = ce;
#pragma unroll
    for (int o = 1; o < 64; o <<= 1) { const unsigned y = __shfl_up(inc, o); if (lane >= o) inc += y; }
    if (lane == 63) misc[16 + w] = inc;
    __syncthreads();
    unsigned base = 0u;
    for (int ww = 0; ww < w; ++ww) base += misc[16 + ww];
    unsigned eqrank = base + inc - ce;
    __syncthreads();
    unsigned cs = 0u;
    if (act) { unsigned er = eqrank; for (int i = 0; i < per; ++i) { const unsigned kv = keys[t0 + i]; if (kv > T) cs++; else if (kv == T) { if (er < need_eq) cs++; er++; } } }
    inc = cs;
#pragma unroll
    for (int o = 1; o < 64; o <<= 1) { const unsigned y = __shfl_up(inc, o); if (lane >= o) inc += y; }
    if (lane == 63) misc[16 + w] = inc;
    __syncthreads();
    base = 0u;
    for (int ww = 0; ww < w; ++ww) base += misc[16 + ww];
    unsigned pos = base + inc - cs;
    if (act) { unsigned er = eqrank; for (int i = 0; i < per; ++i) { const unsigned kv = keys[t0 + i]; bool sel = false;
            if (kv > T) sel = true; else if (kv == T) { sel = er < need_eq; er++; }
            const int row = row0 + t0 + i;
            if (sel) { const int slot = slot0 + (int)pos; TOK[slot] = row; GATE[slot] = __builtin_bit_cast(float, kv); INV[(size_t)row * 16 + e] = slot; pos++; }
            else INV[(size_t)row * 16 + e] = -1; } }
    __syncthreads();
}
__device__ __forceinline__ void phase_topk(const Params& p, bool with_ctx, LAS unsigned char* lds, int bid, int nb) {
    const float* AFF = (const float*)(p.ws + WS_AFF); int* TOK = (int*)(p.ws + WS_TOK); float* GATE = (float*)(p.ws + WS_GATE); int* INV = (int*)(p.ws + WS_INV);
    const int nitems = with_ctx ? 128 : 64;
    for (int it = bid; it < nitems; it += nb) {
        if (it < 64) { const int b = it >> 4, e = it & 15; topk_item(AFF + (size_t)b * SEQ * 16 + e, SEQ, CAP, b * SEQ, e, (b * NE + e) * CAP, TOK, GATE, INV, lds); }
        else { const int b = (it - 64) >> 4, e = it & 15; topk_item(AFF + ((size_t)NLAT + (size_t)b * CTXL) * 16 + e, CTXL, CCAP, NLAT + b * CTXL, e, NSLOT_LAT + (e * NB + b) * CCAP, TOK, GATE, INV, lds); }
    }
}

__device__ __forceinline__ void phase_combine(const Params& p, int l, bool with_ctx, int bid, int nb) {
    const int lane = threadIdx.x & 63, gw = bid * NWAVES + (threadIdx.x >> 6), NGW = nb * NWAVES;
    float* XR = p.out; float* CXR = (float*)(p.ws + WS_CXR); bf16_t* HB = (bf16_t*)(p.ws + WS_HB);
    const bf16_t* Y = (const bf16_t*)(p.ws + WS_Y); const int* INV = (const int*)(p.ws + WS_INV);
    const float* g = p.ln2_g + l * DM; const float* bb = p.ln2_b + l * DM;
    const int nrows = with_ctx ? NROWS : NLAT;
    for (int row = gw; row < nrows; row += NGW) {
        float* xr = row < NLAT ? XR + (size_t)row * DM : CXR + (size_t)(row - NLAT) * DM;
        f32x4 v[4]; row_load(xr, lane, v);
        f32x4 a[4];
#pragma unroll
        for (int j = 0; j < 4; ++j) a[j] = (f32x4){0.f, 0.f, 0.f, 0.f};
        const int myinv = INV[(size_t)row * 16 + (lane & 15)];
        for (int e = 0; e < 16; ++e) {
            const int slot = __shfl(myinv, e);
            if (slot >= 0) { const bf16_t* yr = Y + (size_t)slot * DM;
#pragma unroll
                for (int j = 0; j < 4; ++j) { const u32x2 wv = *(const u32x2*)(yr + 256 * j + 4 * lane); a[j][0] += bf_lo(wv.x); a[j][1] += bf_hi(wv.x); a[j][2] += bf_lo(wv.y); a[j][3] += bf_hi(wv.y); } }
        }
        const float* m = mod_ptr(p, l, row_modrow(row)) + 5 * DM;
#pragma unroll
        for (int j = 0; j < 4; ++j) { const f32x4 g2 = *(const f32x4*)(m + 256 * j + 4 * lane); v[j] = v[j] * ALPHA + g2 * a[j]; }
        row_normalize(v); row_affine(v, g, bb, lane); row_store(xr, lane, v);
        if (l + 1 < DEPTH) { row_normalize(v); const float* m2 = mod_ptr(p, l + 1, row_modrow(row)); row_modulate(v, m2, m2 + DM, lane); row_store_bf16(HB + (size_t)row * DM, lane, v); }
    }
}

constexpr int N_PHASES = 2 + 8 * DEPTH;
#ifndef PHMASK
#define PHMASK 0x3ff
#endif
#define PHON(i) ((PHMASK >> (i)) & 1)
__global__ void __launch_bounds__(NTHREADS, 2) fwd_kernel(Params p) {
    extern __shared__ __attribute__((aligned(16))) unsigned char lds_raw[];
    LAS unsigned char* lds = (LAS unsigned char*)lds_raw;
    const int bid = blockIdx.x, nb = gridDim.x;
    volatile LAS unsigned* MISC = (volatile LAS unsigned*)(lds + LDS_BYTES - 64);
    if (threadIdx.x < 16) MISC[threadIdx.x] = 0u;
    __syncthreads();
    XcdBarrier bar; bar.bar = (unsigned*)(p.ws + WS_CTL) + CW_BAR; bar.x = 0; bar.st = nullptr;
    const bool multi = p.ph_hi - p.ph_lo > 1;
    if (multi) bar = xcd_barrier_post((unsigned*)(p.ws + WS_CTL) + CW_BAR, MISC + 8);
    bf16_t* HB = (bf16_t*)(p.ws + WS_HB); bf16_t* PB = (bf16_t*)(p.ws + WS_PB); bf16_t* OB = (bf16_t*)(p.ws + WS_OB);
    bf16_t* HH = (bf16_t*)(p.ws + WS_HH); bf16_t* Y = (bf16_t*)(p.ws + WS_Y);
    const int* TOK = (const int*)(p.ws + WS_TOK); const float* GATE = (const float*)(p.ws + WS_GATE);
    const int lo = p.ph_lo, hi = p.ph_hi;
#define IN(k) (lo <= (k) && (k) < hi)
#define SEAM(k) do { if (IN(k) && IN((k) + 1)) xcd_barrier(bar); } while (0)
    if (IN(0)) { if (PHON(0)) phase_prologue(p, lds, bid, nb); } SEAM(0);
    if (IN(1)) { if (PHON(1)) phase_ln1(p, bid, nb); } SEAM(1);
#pragma unroll 1
    for (int l = 0; l < DEPTH; ++l) {
        const int pb = 2 + 8 * l; const bool wc = (l == 0);
        if (IN(pb + 0)) { if (PHON(2)) {
            SgDesc g{HB, DM, nullptr, (const bf16_t*)(p.ws + WS_WIN) + (size_t)l * INW * DM, 0, 1 << 30, 1, NROWS, INW, DM, 0};
            EpiQKV E{PB, (const float*)(p.ws + WS_ROPE)}; sg_gemm(g, E, bid, nb); } }
        SEAM(pb + 0);
        if (IN(pb + 1)) { if (PHON(3)) phase_mixers(p, l, wc, bid, nb); }
        SEAM(pb + 1);
        if (IN(pb + 2)) { if (PHON(4)) {
            SgDesc g{OB, DM, nullptr, (const bf16_t*)(p.ws + WS_WOUT) + (size_t)l * DM * DM, 0, 1 << 30, 1, wc ? NROWS : NLAT, DM, DM, 0};
            EpiOut E{l == 0 ? p.x : p.out, p.ctx, p.out, (float*)(p.ws + WS_CXR), mod_ptr(p, l, 0)}; sg_gemm(g, E, bid, nb); } }
        SEAM(pb + 2);
        if (IN(pb + 3)) { if (PHON(5)) phase_ln_router(p, l, wc, lds, bid, nb); }
        SEAM(pb + 3);
        if (IN(pb + 4)) { if (PHON(6)) phase_topk(p, wc, lds, bid, nb); }
        SEAM(pb + 4);
        if (IN(pb + 5)) { if (PHON(7)) {
            const bf16_t* W = (const bf16_t*)(p.ws + WS_WGU) + (size_t)l * NE * 1024 * DM; EpiGU E{HH};
            { SgDesc g{HB, DM, TOK, W, (size_t)1024 * DM, CAP, NE, NSLOT_LAT, 1024, DM, 0}; sg_gemm(g, E, bid, nb); }
            if (wc) { SgDesc g{HB, DM, TOK + NSLOT_LAT, W, (size_t)1024 * DM, NB * CCAP, NE, NSLOT_CTX, 1024, DM, NSLOT_LAT}; sg_gemm(g, E, bid, nb); } } }
        SEAM(pb + 5);
        if (IN(pb + 6)) { if (PHON(8)) {
            const bf16_t* W = (const bf16_t*)(p.ws + WS_WD) + (size_t)l * NE * DM * FF; EpiDown E{Y, GATE};
            { SgDesc g{HH, FF, nullptr, W, (size_t)DM * FF, CAP, NE, NSLOT_LAT, DM, FF, 0}; sg_gemm(g, E, bid, nb); }
            if (wc) { SgDesc g{HH + (size_t)NSLOT_LAT * FF, FF, nullptr, W, (size_t)DM * FF, NB * CCAP, NE, NSLOT_CTX, DM, FF, NSLOT_LAT}; sg_gemm(g, E, bid, nb); } } }
        SEAM(pb + 6);
        if (IN(pb + 7)) { if (PHON(9)) phase_combine(p, l, wc, bid, nb); }
        SEAM(pb + 7);
    }
#undef IN
#undef SEAM
}

#ifndef N_LAUNCH_SPLIT
#define N_LAUNCH_SPLIT 1
#endif
extern "C" void kernel_launch(void* const* d_in, const int* in_sizes, int n_in, void* d_out, int out_size, void* d_ws, size_t ws_size, hipStream_t stream) {
    static int grid = 0;
    if (grid == 0) {
        if (n_in != 19 || in_sizes[0] != NLAT * DM || out_size != NLAT * DM || ws_size < WS_END) { fprintf(stderr, "kernel_launch: unexpected shapes (n_in %d, in0 %d, out %d, ws %zu)\n", n_in, n_in > 0 ? in_sizes[0] : -1, out_size, ws_size); grid = -1; return; }
        int dev = 0, cus = 0, per_cu = 0;
        if (hipGetDevice(&dev) != hipSuccess || hipDeviceGetAttribute(&cus, hipDeviceAttributeMultiprocessorCount, dev) != hipSuccess) { grid = -1; return; }
        if (hipFuncSetAttribute((const void*)fwd_kernel, hipFuncAttributeMaxDynamicSharedMemorySize, LDS_BYTES) != hipSuccess) { fprintf(stderr, "kernel_launch: hipFuncSetAttribute failed\n"); grid = -1; return; }
        if (hipOccupancyMaxActiveBlocksPerMultiprocessor(&per_cu, (const void*)fwd_kernel, NTHREADS, LDS_BYTES) != hipSuccess || per_cu < 1) { fprintf(stderr, "kernel_launch: occupancy query says %d\n", per_cu); per_cu = 1; }
        (void)hipGetLastError();
        grid = cus;
    }
    if (grid < 0) return;
    (void)hipMemsetAsync((char*)d_ws + WS_CTL, 0, CTL_ZERO_BYTES, stream);
    Params p{};
    const float** pp = (const float**)&p;
    for (int i = 0; i < 19; ++i) pp[i] = (const float*)d_in[i];
    p.out = (float*)d_out; p.ws = (unsigned char*)d_ws;
#if N_LAUNCH_SPLIT
    for (int ph = 0; ph < N_PHASES; ++ph) { p.ph_lo = ph; p.ph_hi = ph + 1; hipLaunchKernelGGL(fwd_kernel, dim3(grid), dim3(NTHREADS), LDS_BYTES, stream, p); }
#else
    p.ph_lo = 0; p.ph_hi = N_PHASES;
    void* args[] = {&p};
    hipError_t e = hipLaunchCooperativeKernel((const void*)fwd_kernel, dim3(grid), dim3(NTHREADS), args, LDS_BYTES, stream);
    if (e != hipSuccess) fprintf(stderr, "kernel_launch: cooperative launch failed: %s\n", hipGetErrorString(e));
#endif
}
```

```cpp
#include <hip/hip_runtime.h>
#include <hip/hip_cooperative_groups.h>
#include <cstdio>
#include <cstdint>
#include <cmath>

#define LAS __attribute__((address_space(3)))
typedef unsigned short bf16_t;
typedef short bf16x8 __attribute__((ext_vector_type(8)));
typedef float f32x4 __attribute__((ext_vector_type(4)));
typedef unsigned u32x4 __attribute__((ext_vector_type(4)));
typedef unsigned u32x2 __attribute__((ext_vector_type(2)));

constexpr int NB = 4, SEQ = 8192, DM = 1024, CTXL = 256, DEPTH = 2;
constexpr int NLAT = NB * SEQ, NCTX = NB * CTXL, NROWS = NLAT + NCTX;
constexpr int INW = 2560, NE = 16, FF = 512, CAP = 1024, CCAP = 32;
constexpr int NSLOT_LAT = NB * NE * CAP, NSLOT_CTX = NB * NE * CCAP, NSLOT = NSLOT_LAT + NSLOT_CTX;
constexpr int NMOD = 6 * DM;
constexpr float LN_EPS = 1e-6f;
constexpr float ALPHA = 1.41421356237309515f;
constexpr int C_QA = 0, C_KA = 384, C_VA = 512, C_BX = 640, C_BB = 896, C_BC = 1152, C_QN = 1408, C_KN = 1792, C_VN = 2176;

constexpr int NTHREADS = 512, NWAVES = 8;
constexpr int LDS_BYTES = 147456;

constexpr size_t MiB = 1u << 20;
constexpr size_t WS_CTL = 0, CTL_ZERO_BYTES = 1 * MiB;
constexpr size_t WS_ROPE = 1 * MiB;
constexpr size_t WS_MOD = 1 * MiB + 65536;
constexpr size_t WS_AFF = 2 * MiB;
constexpr size_t WS_INV = 5 * MiB;
constexpr size_t WS_TOK = 8 * MiB;
constexpr size_t WS_GATE = 8 * MiB + 512 * 1024;
constexpr size_t WS_CXR = 9 * MiB;
constexpr size_t WS_WIN = 16 * MiB;
constexpr size_t WS_WOUT = 26 * MiB;
constexpr size_t WS_WGU = 30 * MiB;
constexpr size_t WS_WD = 94 * MiB;
constexpr size_t WS_HB = 126 * MiB;
constexpr size_t WS_OB = 192 * MiB;
constexpr size_t WS_HH = 192 * MiB;
constexpr size_t WS_PB = 258 * MiB;
constexpr size_t WS_Y = 258 * MiB;
constexpr size_t WS_END = 423 * MiB;
static_assert(WS_HB + (size_t)NROWS * DM * 2 <= WS_OB && WS_OB + (size_t)NROWS * DM * 2 <= WS_PB && WS_PB + (size_t)NROWS * INW * 2 <= WS_END, "ws map");
static_assert((size_t)NSLOT * FF * 2 <= (size_t)NROWS * DM * 2 && (size_t)NSLOT * DM * 2 <= (size_t)NROWS * INW * 2, "overlays");
constexpr int CW_BAR = 4096;

struct Params {
    const float *x, *c, *ctx, *c_ctx, *w_mod, *b_mod, *w_in, *conv_w, *attn_sink, *na_rpb, *w_out, *ln1_g, *ln1_b, *w_router, *w_gate, *w_up, *w_down, *ln2_g, *ln2_b;
    float* out; unsigned char* ws;
    int ph_lo, ph_hi;
};

__device__ __forceinline__ unsigned f2bf(float f) { unsigned u = __builtin_bit_cast(unsigned, f); return (u + 0x7fffu + ((u >> 16) & 1u)) >> 16; }
__device__ __forceinline__ unsigned pk2(float lo, float hi) { return f2bf(lo) | (f2bf(hi) << 16); }
__device__ __forceinline__ float bf_lo(unsigned w) { return __builtin_bit_cast(float, w << 16); }
__device__ __forceinline__ float bf_hi(unsigned w) { return __builtin_bit_cast(float, w & 0xffff0000u); }
__device__ __forceinline__ float wave_sum(float v) {
#pragma unroll
    for (int o = 32; o >= 1; o >>= 1) v += __shfl_xor(v, o);
    return v;
}
#define LDS_WAIT() asm volatile("s_waitcnt lgkmcnt(0)" ::: "memory")

__device__ __forceinline__ float* mod_ptr(const Params& p, int l, int r) { return (float*)(p.ws + WS_MOD) + ((size_t)l * 5 + r) * NMOD; }

#define XB_TMO      128
#define XB_XCNT(j)  (256  + 64 * (j))
#define XB_XSUB(j)  (1280 + 64 * (j))
#define XB_XGEN(j)  (2304 + 64 * (j))
#define XB_TOP      3328
#define XB_TOPGEN   3392
#define XCD_BAR_WORDS 3456
#define XB_SPIN_CAP (1u << 20)
__device__ __forceinline__ unsigned xb_ld(unsigned* p)              { return __hip_atomic_load(p, __ATOMIC_RELAXED, __HIP_MEMORY_SCOPE_AGENT); }
__device__ __forceinline__ unsigned xb_add(unsigned* p, unsigned v) { return __hip_atomic_fetch_add(p, v, __ATOMIC_RELAXED, __HIP_MEMORY_SCOPE_AGENT); }
__device__ __forceinline__ unsigned xb_xcc_id() { return (unsigned)__builtin_amdgcn_s_getreg((3 << 11) | 20) & 0xFu; }
#define XB_SPIN(cond, bar) do { unsigned _sp = 0; while (cond) { __builtin_amdgcn_s_sleep(1); \
    if ((++_sp & 255u) == 0u) { if (xb_ld(&(bar)[XB_TMO])) break; if (_sp > XB_SPIN_CAP) { atomicAdd(&(bar)[XB_TMO], 1u); break; } } } } while (0)
struct XcdBarrier { unsigned* bar; unsigned x; volatile LAS unsigned* st; };
__device__ __forceinline__ XcdBarrier xcd_barrier_post(unsigned* bar, volatile LAS unsigned* st) {
    XcdBarrier b; b.bar = bar; b.x = xb_xcc_id(); b.st = st;
    if (threadIdx.x == 0) (void)xb_add(&bar[XB_XCNT(b.x)], 1u);
    return b;
}
__device__ __forceinline__ void xcd_barrier_complete(unsigned* bar, unsigned x, unsigned& nloc, unsigned& nx) {
    const unsigned G = gridDim.x * gridDim.y * gridDim.z;
    unsigned sum, cnt, mine, sp = 0u;
    for (;;) {
        sum = 0u; cnt = 0u; mine = 0u;
#pragma unroll
        for (unsigned j = 0; j < 16; ++j) { const unsigned c = xb_ld(&bar[XB_XCNT(j)]); sum += c; cnt += (c > 0u) ? 1u : 0u; mine = (j == x) ? c : mine; }
        if (sum == G) break;
        __builtin_amdgcn_s_sleep(1);
        if ((++sp & 255u) == 0u) { if (xb_ld(&bar[XB_TMO])) break; if (sp > XB_SPIN_CAP) { atomicAdd(&bar[XB_TMO], 1u); break; } }
    }
    nloc = mine > 0u ? mine : 1u; nx = cnt > 0u ? cnt : 1u;
}
__device__ __forceinline__ void xcd_barrier(const XcdBarrier& b) {
    asm volatile("s_waitcnt vmcnt(0)" ::: "memory");
    __syncthreads();
    if (threadIdx.x == 0) {
        unsigned* bar = b.bar;
        __builtin_amdgcn_s_waitcnt(0);
        unsigned nloc = b.st[0], nx = b.st[1];
        if (nloc == 0u) { xcd_barrier_complete(bar, b.x, nloc, nx); b.st[0] = nloc; b.st[1] = nx; }
        const unsigned old = xb_add(&bar[XB_XSUB(b.x)], 1u);
        const unsigned gen = old / nloc;
        if (old + 1u == (gen + 1u) * nloc) {
            __builtin_amdgcn_fence(__ATOMIC_RELEASE, "agent");
            asm volatile("s_waitcnt vmcnt(0)" ::: "memory");
            const unsigned og = xb_add(&bar[XB_TOP], 1u);
            const unsigned tg = og / nx;
            if (og + 1u == (tg + 1u) * nx) xb_add(&bar[XB_TOPGEN], 1u);
            else XB_SPIN(xb_ld(&bar[XB_TOPGEN]) == tg, bar);
            __builtin_amdgcn_fence(__ATOMIC_ACQUIRE, "agent");
            xb_add(&bar[XB_XGEN(b.x)], 1u);
            asm volatile("s_waitcnt vmcnt(0)" ::: "memory");
        } else {
            XB_SPIN(xb_ld(&bar[XB_XGEN(b.x)]) == gen, bar);
            __builtin_amdgcn_fence(__ATOMIC_ACQUIRE, "agent");
            asm volatile("s_waitcnt vmcnt(0)" ::: "memory");
        }
    }
    __syncthreads();
}

__device__ __forceinline__ void transpose_item(const float* W, int K, int N, bf16_t* WT, int mode, LAS float* scr, int item, int lane) {
    const int nblk = N / 32, kb = item / nblk, nb = item % nblk, k0 = 64 * kb, n0 = 32 * nb;
#pragma unroll 8
    for (int i = 0; i < 32; ++i) { const int kk = 2 * i + (lane >> 5); scr[kk * 33 + (lane & 31)] = W[(size_t)(k0 + kk) * N + n0 + (lane & 31)]; }
    LDS_WAIT();
    const int c = lane & 7;
#pragma unroll
    for (int j = 0; j < 4; ++j) {
        const int n = (lane >> 3) + 8 * j; const LAS float* s = scr + (8 * c) * 33 + n;
        u32x4 o; o.x = pk2(s[0 * 33], s[1 * 33]); o.y = pk2(s[2 * 33], s[3 * 33]); o.z = pk2(s[4 * 33], s[5 * 33]); o.w = pk2(s[6 * 33], s[7 * 33]);
        const int f = n0 + n; const int orow = mode == 0 ? f : (32 * (f >> 4) + (f & 15) + (mode == 2 ? 16 : 0));
        *(u32x4*)(WT + (size_t)orow * K + k0 + 8 * c) = o;
    }
    LDS_WAIT();
}

__device__ __forceinline__ void phase_prologue(const Params& p, LAS unsigned char* lds, int bid, int nb) {
    const int tid = threadIdx.x, lane = tid & 63, w = tid >> 6;
    {
        LAS float* ssil = (LAS float*)lds;
        LAS float* red = ssil + 5 * 1024;
        for (int i = tid; i < 5 * 1024; i += NTHREADS) { const int r = i >> 10, k = i & 1023; const float v = r < 4 ? p.c[r * 1024 + k] : p.c_ctx[k]; ssil[i] = v / (1.f + expf(-v)); }
        __syncthreads();
        for (int item = bid; item < 2 * 96; item += nb) {
            const int l = item / 96, n0 = (item % 96) * 64;
            const float* W = p.w_mod + (size_t)l * DM * NMOD + n0 + lane;
            float a0 = 0.f, a1 = 0.f, a2 = 0.f, a3 = 0.f, a4 = 0.f;
#pragma unroll 8
            for (int k = w * 128; k < w * 128 + 128; ++k) {
                const float wv = W[(size_t)k * NMOD];
                a0 += ssil[k] * wv; a1 += ssil[1024 + k] * wv; a2 += ssil[2048 + k] * wv; a3 += ssil[3072 + k] * wv; a4 += ssil[4096 + k] * wv;
            }
            red[(w * 5 + 0) * 64 + lane] = a0; red[(w * 5 + 1) * 64 + lane] = a1; red[(w * 5 + 2) * 64 + lane] = a2; red[(w * 5 + 3) * 64 + lane] = a3; red[(w * 5 + 4) * 64 + lane] = a4;
            __syncthreads();
            if (tid < 320) { const int r = tid >> 6; float s = 0.f;
#pragma unroll
                for (int ww = 0; ww < 8; ++ww) s += red[(ww * 5 + r) * 64 + lane];
                mod_ptr(p, l, r)[n0 + lane] = s + p.b_mod[l * NMOD + n0 + lane]; }
            __syncthreads();
        }
    }
    if (bid == nb - 1) {
        float* rope = (float*)(p.ws + WS_ROPE);
        for (int e = tid; e < 128 * 16; e += NTHREADS) {
            const int pos = e >> 4, i = e & 15;
            const double a = exp(-((double)i / 16.0) * 9.210340371976184);
            const double a2 = a * a; double c = 1.0, s = a, tc = 1.0, ts = a;
            for (int n = 1; n <= 14; ++n) { tc *= -a2 / (double)((2 * n - 1) * (2 * n)); c += tc; ts *= -a2 / (double)((2 * n) * (2 * n + 1)); s += ts; }
            double rc = 1.0, rs = 0.0, bc = c, bs = s; int q = pos;
            while (q) { if (q & 1) { const double t = rc * bc - rs * bs; rs = rc * bs + rs * bc; rc = t; } const double t = bc * bc - bs * bs; bs = 2.0 * bc * bs; bc = t; q >>= 1; }
            rope[2 * e] = (float)rc; rope[2 * e + 1] = (float)rs;
        }
    }
    __syncthreads();
    {
        LAS float* scr = (LAS float*)lds + w * (64 * 33);
        const int gw = bid * NWAVES + w, NGW = nb * NWAVES;
        constexpr int I_IN = 16 * 80, I_OUT = 16 * 32, I_G = 16 * 16, I_D = 8 * 32;
        constexpr int PER_L = I_IN + I_OUT + 16 * (2 * I_G + I_D);
        for (int it = gw; it < 2 * PER_L; it += NGW) {
            const int l = it / PER_L; int r = it % PER_L;
            if (r < I_IN) { transpose_item(p.w_in + (size_t)l * DM * INW, DM, INW, (bf16_t*)(p.ws + WS_WIN) + (size_t)l * INW * DM, 0, scr, r, lane); continue; } r -= I_IN;
            if (r < I_OUT) { transpose_item(p.w_out + (size_t)l * DM * DM, DM, DM, (bf16_t*)(p.ws + WS_WOUT) + (size_t)l * DM * DM, 0, scr, r, lane); continue; } r -= I_OUT;
            if (r < 16 * I_G) { const int e = r / I_G; transpose_item(p.w_gate + ((size_t)l * NE + e) * DM * FF, DM, FF, (bf16_t*)(p.ws + WS_WGU) + ((size_t)l * NE + e) * 1024 * DM, 1, scr, r % I_G, lane); continue; } r -= 16 * I_G;
            if (r < 16 * I_G) { const int e = r / I_G; transpose_item(p.w_up + ((size_t)l * NE + e) * DM * FF, DM, FF, (bf16_t*)(p.ws + WS_WGU) + ((size_t)l * NE + e) * 1024 * DM, 2, scr, r % I_G, lane); continue; } r -= 16 * I_G;
            { const int e = r / I_D; transpose_item(p.w_down + ((size_t)l * NE + e) * FF * DM, FF, DM, (bf16_t*)(p.ws + WS_WD) + ((size_t)l * NE + e) * DM * FF, 0, scr, r % I_D, lane); }
        }
    }
}

__device__ __forceinline__ void row_load(const float* rowp, int lane, f32x4 (&v)[4]) {
#pragma unroll
    for (int j = 0; j < 4; ++j) v[j] = *(const f32x4*)(rowp + 256 * j + 4 * lane);
}
__device__ __forceinline__ void row_store(float* rowp, int lane, const f32x4 (&v)[4]) {
#pragma unroll
    for (int j = 0; j < 4; ++j) *(f32x4*)(rowp + 256 * j + 4 * lane) = v[j];
}
__device__ __forceinline__ void row_store_bf16(bf16_t* rowp, int lane, const f32x4 (&v)[4]) {
#pragma unroll
    for (int j = 0; j < 4; ++j) { u32x2 o; o.x = pk2(v[j][0], v[j][1]); o.y = pk2(v[j][2], v[j][3]); *(u32x2*)(rowp + 256 * j + 4 * lane) = o; }
}
__device__ __forceinline__ void row_normalize(f32x4 (&v)[4]) {
    float s = 0.f;
#pragma unroll
    for (int j = 0; j < 4; ++j) s += (v[j][0] + v[j][1]) + (v[j][2] + v[j][3]);
    const float mean = wave_sum(s) * (1.f / DM);
    float q = 0.f;
#pragma unroll
    for (int j = 0; j < 4; ++j) { v[j] = v[j] - mean; q += (v[j][0] * v[j][0] + v[j][1] * v[j][1]) + (v[j][2] * v[j][2] + v[j][3] * v[j][3]); }
    const float rstd = 1.f / sqrtf(wave_sum(q) * (1.f / DM) + LN_EPS);
#pragma unroll
    for (int j = 0; j < 4; ++j) v[j] = v[j] * rstd;
}
__device__ __forceinline__ void row_modulate(f32x4 (&v)[4], const float* sh, const float* sc, int lane) {
#pragma unroll
    for (int j = 0; j < 4; ++j) { const f32x4 a = *(const f32x4*)(sc + 256 * j + 4 * lane), b = *(const f32x4*)(sh + 256 * j + 4 * lane); v[j] = v[j] * (a + 1.f) + b; }
}
__device__ __forceinline__ void row_affine(f32x4 (&v)[4], const float* g, const float* bb, int lane) {
#pragma unroll
    for (int j = 0; j < 4; ++j) { const f32x4 a = *(const f32x4*)(g + 256 * j + 4 * lane), b = *(const f32x4*)(bb + 256 * j + 4 * lane); v[j] = v[j] * a + b; }
}
__device__ __forceinline__ int row_modrow(int row) { return row < NLAT ? (row >> 13) : 4; }

__device__ __forceinline__ void phase_ln1(const Params& p, int bid, int nb) {
    const int lane = threadIdx.x & 63, gw = bid * NWAVES + (threadIdx.x >> 6), NGW = nb * NWAVES;
    bf16_t* HB = (bf16_t*)(p.ws + WS_HB);
    for (int row = gw; row < NROWS; row += NGW) {
        const float* src = row < NLAT ? p.x + (size_t)row * DM : p.ctx + (size_t)(row - NLAT) * DM;
        f32x4 v[4]; row_load(src, lane, v); row_normalize(v);
        const float* m = mod_ptr(p, 0, row_modrow(row)); row_modulate(v, m, m + DM, lane);
        row_store_bf16(HB + (size_t)row * DM, lane, v);
    }
}

struct SgDesc { const bf16_t* A; int lda; const int* rowidx; const bf16_t* Bt; size_t grp_stride; int rows_per_grp, ngrp; int M, N, K; int row_base; };
template <class Epi>
__device__ __forceinline__ void sg_gemm(const SgDesc& g, const Epi& E, int bid, int nb) {
    const int lane = threadIdx.x & 63, w = threadIdx.x >> 6, fr = lane & 15, fq = lane >> 4, wm = w >> 1, wn = w & 1;
    const int tilesN = g.N / 128, tiles = (g.M / 128) * tilesN;
    for (int t = bid; t < tiles; t += nb) {
        const int tm = t / tilesN, tn = t % tilesN;
        const int row0 = tm * 128 + wm * 32, col0 = tn * 128 + wn * 64;
        const bf16_t* Bt = g.Bt + (size_t)(((tm * 128) / g.rows_per_grp) % g.ngrp) * g.grp_stride;
        const bf16_t* ap[2]; const bf16_t* bp[4];
#pragma unroll
        for (int i = 0; i < 2; ++i) { const int r = row0 + 16 * i + fr; const int ar = g.rowidx ? g.rowidx[r] : r; ap[i] = g.A + (size_t)ar * g.lda + 8 * fq; }
#pragma unroll
        for (int n = 0; n < 4; ++n) bp[n] = Bt + (size_t)(col0 + 16 * n + fr) * g.K + 8 * fq;
        f32x4 acc[2][4];
#pragma unroll
        for (int i = 0; i < 2; ++i)
#pragma unroll
            for (int n = 0; n < 4; ++n) acc[i][n] = (f32x4){0.f, 0.f, 0.f, 0.f};
#pragma unroll 2
        for (int k = 0; k < g.K; k += 32) {
            bf16x8 a[2], b[4];
#pragma unroll
            for (int i = 0; i < 2; ++i) a[i] = *(const bf16x8*)(ap[i] + k);
#pragma unroll
            for (int n = 0; n < 4; ++n) b[n] = *(const bf16x8*)(bp[n] + k);
#pragma unroll
            for (int i = 0; i < 2; ++i)
#pragma unroll
                for (int n = 0; n < 4; ++n) acc[i][n] = __builtin_amdgcn_mfma_f32_16x16x32_bf16(b[n], a[i], acc[i][n], 0, 0, 0);
        }
#pragma unroll
        for (int i = 0; i < 2; ++i)
#pragma unroll
            for (int g2 = 0; g2 < 2; ++g2) E(g.row_base + row0 + 16 * i + fr, col0 + 32 * g2, fq, acc[i][2 * g2], acc[i][2 * g2 + 1]);
    }
}

__device__ __forceinline__ void store_bf16x4(bf16_t* p, const f32x4 v) { u32x2 o; o.x = pk2(v[0], v[1]); o.y = pk2(v[2], v[3]); *(u32x2*)p = o; }

struct EpiQKV {
    bf16_t* PB; const float* rope;
    __device__ __forceinline__ void operator()(int row, int c32, int fq, f32x4 v0, f32x4 v1) const {
        if (c32 < 512 && row < NLAT) {
            const int t = row & (SEQ - 1); const int pos = (c32 & 32) ? (t & 63) : (t >> 6);
            const float* rp = rope + (pos * 16 + 4 * fq) * 2;
#pragma unroll
            for (int j = 0; j < 4; ++j) { const float cs = rp[2 * j], sn = rp[2 * j + 1], a = v0[j], b = v1[j]; v0[j] = a * cs - b * sn; v1[j] = b * cs + a * sn; }
        }
        bf16_t* o = PB + (size_t)row * INW + c32 + 4 * fq;
        store_bf16x4(o, v0); store_bf16x4(o + 16, v1);
    }
};
struct EpiOut {
    const float* xl; const float* xc; float* XR; float* CXR; const float* mod;
    __device__ __forceinline__ void operator()(int row, int c32, int fq, f32x4 v0, f32x4 v1) const {
        const int c = c32 + 4 * fq; const float* xin; float* xo; const float* g1;
        if (row < NLAT) { xin = xl + (size_t)row * DM; xo = XR + (size_t)row * DM; g1 = mod + (size_t)(row >> 13) * NMOD + 2 * DM; }
        else { const int r = row - NLAT; xin = xc + (size_t)r * DM; xo = CXR + (size_t)r * DM; g1 = mod + (size_t)4 * NMOD + 2 * DM; }
        const f32x4 x0 = *(const f32x4*)(xin + c), x1 = *(const f32x4*)(xin + c + 16), g0 = *(const f32x4*)(g1 + c), g1v = *(const f32x4*)(g1 + c + 16);
        *(f32x4*)(xo + c) = x0 * ALPHA + g0 * v0; *(f32x4*)(xo + c + 16) = x1 * ALPHA + g1v * v1;
    }
};
struct EpiGU {
    bf16_t* HH;
    __device__ __forceinline__ void operator()(int row, int c32, int fq, f32x4 v0, f32x4 v1) const {
        f32x4 h;
#pragma unroll
        for (int j = 0; j < 4; ++j) h[j] = v0[j] / (1.f + __expf(-v0[j])) * v1[j];
        store_bf16x4(HH + (size_t)row * FF + (c32 >> 1) + 4 * fq, h);
    }
};
struct EpiDown {
    bf16_t* Y; const float* gate;
    __device__ __forceinline__ void operator()(int row, int c32, int fq, f32x4 v0, f32x4 v1) const {
        const float g = gate[row]; bf16_t* o = Y + (size_t)row * DM + c32 + 4 * fq;
        store_bf16x4(o, v0 * g); store_bf16x4(o + 16, v1 * g);
    }
};

struct AttnState { float m, l; float o[32]; };
__device__ __forceinline__ void attn_init(AttnState& st) { st.m = -INFINITY; st.l = 0.f;
#pragma unroll
    for (int d = 0; d < 32; ++d) st.o[d] = 0.f; }
__device__ __forceinline__ void load_row32(const bf16_t* p, float (&r)[32], float scale) {
#pragma unroll
    for (int i = 0; i < 4; ++i) { const u32x4 w = *(const u32x4*)(p + 8 * i);
        r[8 * i + 0] = bf_lo(w.x) * scale; r[8 * i + 1] = bf_hi(w.x) * scale; r[8 * i + 2] = bf_lo(w.y) * scale; r[8 * i + 3] = bf_hi(w.y) * scale;
        r[8 * i + 4] = bf_lo(w.z) * scale; r[8 * i + 5] = bf_hi(w.z) * scale; r[8 * i + 6] = bf_lo(w.w) * scale; r[8 * i + 7] = bf_hi(w.w) * scale; }
}
__device__ __forceinline__ float dot_row32(const bf16_t* p, const float (&q)[32]) {
    float d0 = 0.f, d1 = 0.f;
#pragma unroll
    for (int i = 0; i < 4; ++i) { const u32x4 w = *(const u32x4*)(p + 8 * i);
        d0 += q[8 * i + 0] * bf_lo(w.x); d1 += q[8 * i + 1] * bf_hi(w.x); d0 += q[8 * i + 2] * bf_lo(w.y); d1 += q[8 * i + 3] * bf_hi(w.y);
        d0 += q[8 * i + 4] * bf_lo(w.z); d1 += q[8 * i + 5] * bf_hi(w.z); d0 += q[8 * i + 6] * bf_lo(w.w); d1 += q[8 * i + 7] * bf_hi(w.w); }
    const float d = d0 + d1;
    return d + __shfl_xor(d, 32);
}
__device__ __forceinline__ void axpy_row32(const bf16_t* p, float a, float (&o)[32]) {
#pragma unroll
    for (int i = 0; i < 4; ++i) { const u32x4 w = *(const u32x4*)(p + 8 * i);
        o[8 * i + 0] += a * bf_lo(w.x); o[8 * i + 1] += a * bf_hi(w.x); o[8 * i + 2] += a * bf_lo(w.y); o[8 * i + 3] += a * bf_hi(w.y);
        o[8 * i + 4] += a * bf_lo(w.z); o[8 * i + 5] += a * bf_hi(w.z); o[8 * i + 6] += a * bf_lo(w.w); o[8 * i + 7] += a * bf_hi(w.w); }
}
template <class ScoreFn>
__device__ __forceinline__ void attn_segment(const float (&q)[32], AttnState& st, const bf16_t* Kb, const bf16_t* Vb, int j0, int j1, ScoreFn sf) {
#pragma unroll 1
    for (int j = j0; j < j1; ++j) {
        const float s0 = sf(j, dot_row32(Kb + (size_t)j * INW, q));
        if (s0 > st.m) { const float corr = __expf(st.m - s0); st.l *= corr;
#pragma unroll
            for (int d = 0; d < 32; ++d) st.o[d] *= corr;
            st.m = s0; }
        const float p0 = (s0 == -INFINITY) ? 0.f : __expf(s0 - st.m);
        st.l += p0;
        axpy_row32(Vb + (size_t)j * INW, p0, st.o);
    }
}
__device__ __forceinline__ void attn_sink(AttnState& st, float sk) {
    if (sk > st.m) { const float corr = __expf(st.m - sk); st.l *= corr;
#pragma unroll
        for (int d = 0; d < 32; ++d) st.o[d] *= corr;
        st.m = sk; }
    st.l += __expf(sk - st.m);
}
__device__ __forceinline__ void attn_store(const AttnState& st, bf16_t* o) {
    const float inv = 1.f / st.l;
#pragma unroll
    for (int i = 0; i < 4; ++i) { u32x4 w; w.x = pk2(st.o[8 * i] * inv, st.o[8 * i + 1] * inv); w.y = pk2(st.o[8 * i + 2] * inv, st.o[8 * i + 3] * inv);
        w.z = pk2(st.o[8 * i + 4] * inv, st.o[8 * i + 5] * inv); w.w = pk2(st.o[8 * i + 6] * inv, st.o[8 * i + 7] * inv); *(u32x4*)(o + 8 * i) = w; }
}

__device__ __forceinline__ void phase_mixers(const Params& p, int l, bool with_ctx, int bid, int nb) {
    const int lane = threadIdx.x & 63, gw = bid * NWAVES + (threadIdx.x >> 6), NGW = nb * NWAVES;
    const int ql = lane & 31, hf = lane >> 5;
    const bf16_t* PB = (const bf16_t*)(p.ws + WS_PB); bf16_t* OB = (bf16_t*)(p.ws + WS_OB);
    const float* sink = p.attn_sink + l * 6; const float* rpb = p.na_rpb + (size_t)l * 6 * 15 * 31;
#pragma unroll 1
    for (int it = gw; it < NB * 6 * 256; it += NGW) {
        const int chunk = it & 255, h = (it >> 8) % 6, b = it / (6 * 256), kvh = h / 3;
        const int t = chunk * 32 + ql; const size_t rowb = (size_t)b * SEQ;
        float q[32]; load_row32(PB + (rowb + t) * INW + C_QA + h * 64 + 32 * hf, q, 0.125f);
        AttnState st; attn_init(st);
        const int jlo = max(0, chunk * 32 - 128), jhi = min(SEQ, chunk * 32 + 32 + 128);
        attn_segment(q, st, PB + rowb * INW + C_KA + kvh * 64 + 32 * hf, PB + rowb * INW + C_VA + kvh * 64 + 32 * hf, jlo, jhi,
                     [&](int j, float d) { const int dt = t - j; return (dt <= 128 && dt >= -128) ? d : -INFINITY; });
        const size_t crow = (size_t)NLAT + (size_t)b * CTXL;
        attn_segment(q, st, PB + crow * INW + C_KA + kvh * 64 + 32 * hf, PB + crow * INW + C_VA + kvh * 64 + 32 * hf, 0, CTXL, [&](int, float d) { return d; });
        attn_sink(st, sink[h]);
        attn_store(st, OB + (rowb + t) * DM + h * 64 + 32 * hf);
    }
#pragma unroll 1
    for (int it = gw; it < NB * 6 * 256; it += NGW) {
        const int r = (it & 255) >> 1, ch = it & 1, h = (it >> 8) % 6, b = it / (6 * 256);
        const int cq = ch * 32 + ql; const size_t rowb = (size_t)b * SEQ; const int t = r * 64 + cq;
        float q[32]; load_row32(PB + (rowb + t) * INW + C_QN + h * 64 + 32 * hf, q, 0.125f);
        AttnState st; attn_init(st);
        const int rs = min(max(r - 4, 0), 128 - 8), cs = min(max(cq - 8, 0), 64 - 16);
        const float* bias = rpb + (size_t)h * 15 * 31;
        attn_segment(q, st, PB + (rowb + (size_t)rs * 64) * INW + C_KN + h * 64 + 32 * hf, PB + (rowb + (size_t)rs * 64) * INW + C_VN + h * 64 + 32 * hf, 0, 512,
                     [&](int j, float d) { const int ka = rs + (j >> 6), ck = j & 63; const bool ok = (ck >= cs) && (ck < cs + 16);
                                           const int ro = ka - r + 7, co = min(max(ck - cq, -15), 15) + 15; return ok ? d + bias[ro * 31 + co] : -INFINITY; });
        const size_t crow = (size_t)NLAT + (size_t)b * CTXL;
        attn_segment(q, st, PB + crow * INW + C_KN + h * 64 + 32 * hf, PB + crow * INW + C_VN + h * 64 + 32 * hf, 0, CTXL, [&](int, float d) { return d; });
        attn_store(st, OB + (rowb + t) * DM + 640 + h * 64 + 32 * hf);
    }
    {
        const float* cw = p.conv_w + (size_t)l * 3 * 256;
        const int nrows = with_ctx ? NROWS : NLAT;
        for (long e = (long)bid * NTHREADS + threadIdx.x; e < (long)nrows * 32; e += (long)nb * NTHREADS) {
            const int row = (int)(e >> 5), ch = (int)(e & 31) * 8;
            const int tpos = row < NLAT ? (row & (SEQ - 1)) : ((row - NLAT) & (CTXL - 1)); const int tlen = row < NLAT ? SEQ : CTXL;
            const bf16_t* pr = PB + (size_t)row * INW;
            float u[3][8];
#pragma unroll
            for (int dlt = -1; dlt <= 1; ++dlt) {
                const bool ok = (tpos + dlt >= 0) && (tpos + dlt < tlen);
                if (ok) { const u32x4 a = *(const u32x4*)(pr + (long)dlt * INW + C_BX + ch), c = *(const u32x4*)(pr + (long)dlt * INW + C_BC + ch);
                    u[dlt + 1][0] = bf_lo(a.x) * bf_lo(c.x); u[dlt + 1][1] = bf_hi(a.x) * bf_hi(c.x); u[dlt + 1][2] = bf_lo(a.y) * bf_lo(c.y); u[dlt + 1][3] = bf_hi(a.y) * bf_hi(c.y);
                    u[dlt + 1][4] = bf_lo(a.z) * bf_lo(c.z); u[dlt + 1][5] = bf_hi(a.z) * bf_hi(c.z); u[dlt + 1][6] = bf_lo(a.w) * bf_lo(c.w); u[dlt + 1][7] = bf_hi(a.w) * bf_hi(c.w); }
                else {
#pragma unroll
                    for (int i = 0; i < 8; ++i) u[dlt + 1][i] = 0.f; }
            }
            const u32x4 gb = *(const u32x4*)(pr + C_BB + ch);
            const float g[8] = {bf_lo(gb.x), bf_hi(gb.x), bf_lo(gb.y), bf_hi(gb.y), bf_lo(gb.z), bf_hi(gb.z), bf_lo(gb.w), bf_hi(gb.w)};
            float y[8];
#pragma unroll
            for (int i = 0; i < 8; ++i) y[i] = g[i] * (u[0][i] * cw[ch + i] + u[1][i] * cw[256 + ch + i] + u[2][i] * cw[512 + ch + i]);
            u32x4 o; o.x = pk2(y[0], y[1]); o.y = pk2(y[2], y[3]); o.z = pk2(y[4], y[5]); o.w = pk2(y[6], y[7]);
            *(u32x4*)(OB + (size_t)row * DM + 384 + ch) = o;
        }
    }
    if (with_ctx) {
#pragma unroll 1
        for (int it = gw; it < 2 * NB * 6 * 8; it += NGW) {
            const int kind = it / (NB * 6 * 8), r = it % (NB * 6 * 8), chunk = r & 7, h = (r >> 3) % 6, b = r / 48;
            const size_t crow = (size_t)NLAT + (size_t)b * CTXL; const int tq = chunk * 32 + ql;
            const int qc = (kind == 0 ? C_QA + h * 64 : C_QN + h * 64) + 32 * hf, kc = (kind == 0 ? C_KA + (h / 3) * 64 : C_KN + h * 64) + 32 * hf, vc = (kind == 0 ? C_VA + (h / 3) * 64 : C_VN + h * 64) + 32 * hf;
            float q[32]; load_row32(PB + (crow + tq) * INW + qc, q, 0.125f);
            AttnState st; attn_init(st);
            attn_segment(q, st, PB + crow * INW + kc, PB + crow * INW + vc, 0, CTXL, [&](int, float d) { return d; });
            if (kind == 0) attn_sink(st, sink[h]);
            attn_store(st, OB + (crow + tq) * DM + (kind == 0 ? 0 : 640) + h * 64 + 32 * hf);
        }
    }
}

__device__ __forceinline__ void phase_ln_router(const Params& p, int l, bool with_ctx, LAS unsigned char* lds, int bid, int nb) {
    const int tid = threadIdx.x, lane = tid & 63, gw = bid * NWAVES + (tid >> 6), NGW = nb * NWAVES;
    LAS float* wr = (LAS float*)lds;
    const float* wrg = p.w_router + (size_t)l * DM * NE;
    for (int i = tid; i < DM * NE; i += NTHREADS) { const int c = i >> 4, e = i & 15; wr[e * DM + c] = wrg[i]; }
    __syncthreads();
    float* XR = p.out; float* CXR = (float*)(p.ws + WS_CXR); bf16_t* HB = (bf16_t*)(p.ws + WS_HB); float* AFF = (float*)(p.ws + WS_AFF);
    const float* g = p.ln1_g + l * DM; const float* bb = p.ln1_b + l * DM;
    const int nrows = with_ctx ? NROWS : NLAT;
    for (int row = gw; row < nrows; row += NGW) {
        float* xr = row < NLAT ? XR + (size_t)row * DM : CXR + (size_t)(row - NLAT) * DM;
        f32x4 v[4]; row_load(xr, lane, v); row_normalize(v); row_affine(v, g, bb, lane); row_store(xr, lane, v);
        row_normalize(v);
        const float* m = mod_ptr(p, l, row_modrow(row)); row_modulate(v, m + 3 * DM, m + 4 * DM, lane);
        row_store_bf16(HB + (size_t)row * DM, lane, v);
        float lg[16];
#pragma unroll
        for (int e = 0; e < 16; ++e) { float s = 0.f;
#pragma unroll
            for (int j = 0; j < 4; ++j) { const f32x4 wv = *(const LAS f32x4*)(wr + e * DM + 256 * j + 4 * lane); s += (v[j][0] * wv[0] + v[j][1] * wv[1]) + (v[j][2] * wv[2] + v[j][3] * wv[3]); }
            lg[e] = wave_sum(s);
            if ((e & 3) == 3) asm volatile("" ::: "memory"); }
        float mx = lg[0];
#pragma unroll
        for (int e = 1; e < 16; ++e) mx = fmaxf(mx, lg[e]);
        float sum = 0.f;
#pragma unroll
        for (int e = 0; e < 16; ++e) { lg[e] = expf(lg[e] - mx); sum += lg[e]; }
        const float inv = 1.f / sum; float mine = 0.f;
#pragma unroll
        for (int e = 0; e < 16; ++e) mine = (lane == e) ? lg[e] * inv : mine;
        if (lane < 16) AFF[(size_t)row * 16 + lane] = mine;
    }
}

__device__ __forceinline__ void topk_item(const float* aff  , int n, int k, int row0  , int e, int slot0,
                                          int* TOK, float* GATE, int* INV, LAS unsigned char* lds) {
    const int tid = threadIdx.x, lane = tid & 63, w = tid >> 6;
    LAS unsigned* keys = (LAS unsigned*)lds;
    LAS unsigned* hist = keys + 8192;
    LAS unsigned* misc = hist + 256;
    for (int i = tid; i < n; i += NTHREADS) keys[i] = __builtin_bit_cast(unsigned, aff[(size_t)i * 16]);
    if (tid == 0) { misc[0] = 0u; misc[1] = (unsigned)k; }
    __syncthreads();
    unsigned maskv = 0u;
    for (int pass = 0; pass < 4; ++pass) {
        const int shift = 24 - 8 * pass;
        if (tid < 256) hist[tid] = 0u;
        __syncthreads();
        const unsigned prefix = misc[0];
        for (int i = tid; i < n; i += NTHREADS) { const unsigned kv = keys[i]; if ((kv & maskv) == prefix) atomicAdd((unsigned*)&hist[(kv >> shift) & 255u], 1u); }
        __syncthreads();
        if (tid == 0) { unsigned rem = misc[1], cum = 0u; int bin = 255;
            for (; bin > 0; --bin) { const unsigned hc = hist[bin]; if (cum + hc >= rem) break; cum += hc; }
            misc[0] = prefix | ((unsigned)bin << shift); misc[1] = rem - cum; }
        __syncthreads();
        maskv |= 255u << shift;
    }
    const unsigned T = misc[0], need_eq = misc[1];
    __syncthreads();
    const int per = n >= NTHREADS ? n / NTHREADS : 1; const int t0 = tid * per; const bool act = t0 < n;
    unsigned ce = 0u;
    if (act) for (int i = 0; i < per; ++i) ce += (keys[t0 + i] == T) ? 1u : 0u;
    unsigned inc = ce;
#pragma unroll
    for (int o = 1; o < 64; o <<= 1) { const unsigned y = __shfl_up(inc, o); if (lane >= o) inc += y; }
    if (lane == 63) misc[16 + w] = inc;
    __syncthreads();
    unsigned base = 0u;
    for (int ww = 0; ww < w; ++ww) base += misc[16 + ww];
    unsigned eqrank = base + inc - ce;
    __syncthreads();
    unsigned cs = 0u;
    if (act) { unsigned er = eqrank; for (int i = 0; i < per; ++i) { const unsigned kv = keys[t0 + i]; if (kv > T) cs++; else if (kv == T) { if (er < need_eq) cs++; er++; } } }
    inc = cs;
#pragma unroll
    for (int o = 1; o < 64; o <<= 1) { const unsigned y = __shfl_up(inc, o); if (lane >= o) inc += y; }
    if (lane == 63) misc[16 + w] = inc;
    __syncthreads();
    base = 0u;
    for (int ww = 0; ww < w; ++ww) base += misc[16 + ww];
    unsigned pos = base + inc - cs;
    if (act) { unsigned er = eqrank; for (int i = 0; i < per; ++i) { const unsigned kv = keys[t0 + i]; bool sel = false;
            if (kv > T) sel = true; else if (kv == T) { sel = er < need_eq; er++; }
            const int row = row0 + t0 + i;
            if (sel) { const int slot = slot0 + (int)pos; TOK[slot] = row; GATE[slot] = __builtin_bit_cast(float, kv); INV[(size_t)row * 16 + e] = slot; pos++; }
            else INV[(size_t)row * 16 + e] = -1; } }
    __syncthreads();
}
__device__ __forceinline__ void phase_topk(const Params& p, bool with_ctx, LAS unsigned char* lds, int bid, int nb) {
    const float* AFF = (const float*)(p.ws + WS_AFF); int* TOK = (int*)(p.ws + WS_TOK); float* GATE = (float*)(p.ws + WS_GATE); int* INV = (int*)(p.ws + WS_INV);
    const int nitems = with_ctx ? 128 : 64;
    for (int it = bid; it < nitems; it += nb) {
        if (it < 64) { const int b = it >> 4, e = it & 15; topk_item(AFF + (size_t)b * SEQ * 16 + e, SEQ, CAP, b * SEQ, e, (b * NE + e) * CAP, TOK, GATE, INV, lds); }
        else { const int b = (it - 64) >> 4, e = it & 15; topk_item(AFF + ((size_t)NLAT + (size_t)b * CTXL) * 16 + e, CTXL, CCAP, NLAT + b * CTXL, e, NSLOT_LAT + (e * NB + b) * CCAP, TOK, GATE, INV, lds); }
    }
}

__device__ __forceinline__ void phase_combine(const Params& p, int l, bool with_ctx, int bid, int nb) {
    const int lane = threadIdx.x & 63, gw = bid * NWAVES + (threadIdx.x >> 6), NGW = nb * NWAVES;
    float* XR = p.out; float* CXR = (float*)(p.ws + WS_CXR); bf16_t* HB = (bf16_t*)(p.ws + WS_HB);
    const bf16_t* Y = (const bf16_t*)(p.ws + WS_Y); const int* INV = (const int*)(p.ws + WS_INV);
    const float* g = p.ln2_g + l * DM; const float* bb = p.ln2_b + l * DM;
    const int nrows = with_ctx ? NROWS : NLAT;
    for (int row = gw; row < nrows; row += NGW) {
        float* xr = row < NLAT ? XR + (size_t)row * DM : CXR + (size_t)(row - NLAT) * DM;
        f32x4 v[4]; row_load(xr, lane, v);
        f32x4 a[4];
#pragma unroll
        for (int j = 0; j < 4; ++j) a[j] = (f32x4){0.f, 0.f, 0.f, 0.f};
        const int myinv = INV[(size_t)row * 16 + (lane & 15)];
        for (int e = 0; e < 16; ++e) {
            const int slot = __shfl(myinv, e);
            if (slot >= 0) { const bf16_t* yr = Y + (size_t)slot * DM;
#pragma unroll
                for (int j = 0; j < 4; ++j) { const u32x2 wv = *(const u32x2*)(yr + 256 * j + 4 * lane); a[j][0] += bf_lo(wv.x); a[j][1] += bf_hi(wv.x); a[j][2] += bf_lo(wv.y); a[j][3] += bf_hi(wv.y); } }
        }
        const float* m = mod_ptr(p, l, row_modrow(row)) + 5 * DM;
#pragma unroll
        for (int j = 0; j < 4; ++j) { const f32x4 g2 = *(const f32x4*)(m + 256 * j + 4 * lane); v[j] = v[j] * ALPHA + g2 * a[j]; }
        row_normalize(v); row_affine(v, g, bb, lane); row_store(xr, lane, v);
        if (l + 1 < DEPTH) { row_normalize(v); const float* m2 = mod_ptr(p, l + 1, row_modrow(row)); row_modulate(v, m2, m2 + DM, lane); row_store_bf16(HB + (size_t)row * DM, lane, v); }
    }
}

constexpr int N_PHASES = 2 + 8 * DEPTH;
#ifndef PHMASK
#define PHMASK 0x3ff
#endif
#define PHON(i) ((PHMASK >> (i)) & 1)
__global__ void __launch_bounds__(NTHREADS, 2) fwd_kernel(Params p) {
    extern __shared__ __attribute__((aligned(16))) unsigned char lds_raw[];
    LAS unsigned char* lds = (LAS unsigned char*)lds_raw;
    const int bid = blockIdx.x, nb = gridDim.x;
    volatile LAS unsigned* MISC = (volatile LAS unsigned*)(lds + LDS_BYTES - 64);
    if (threadIdx.x < 16) MISC[threadIdx.x] = 0u;
    __syncthreads();
    XcdBarrier bar; bar.bar = (unsigned*)(p.ws + WS_CTL) + CW_BAR; bar.x = 0; bar.st = nullptr;
    const bool multi = p.ph_hi - p.ph_lo > 1;
    if (multi) bar = xcd_barrier_post((unsigned*)(p.ws + WS_CTL) + CW_BAR, MISC + 8);
    bf16_t* HB = (bf16_t*)(p.ws + WS_HB); bf16_t* PB = (bf16_t*)(p.ws + WS_PB); bf16_t* OB = (bf16_t*)(p.ws + WS_OB);
    bf16_t* HH = (bf16_t*)(p.ws + WS_HH); bf16_t* Y = (bf16_t*)(p.ws + WS_Y);
    const int* TOK = (const int*)(p.ws + WS_TOK); const float* GATE = (const float*)(p.ws + WS_GATE);
    const int lo = p.ph_lo, hi = p.ph_hi;
#define IN(k) (lo <= (k) && (k) < hi)
#define SEAM(k) do { if (IN(k) && IN((k) + 1)) xcd_barrier(bar); } while (0)
    if (IN(0)) { if (PHON(0)) phase_prologue(p, lds, bid, nb); } SEAM(0);
    if (IN(1)) { if (PHON(1)) phase_ln1(p, bid, nb); } SEAM(1);
#pragma unroll 1
    for (int l = 0; l < DEPTH; ++l) {
        const int pb = 2 + 8 * l; const bool wc = (l == 0);
        if (IN(pb + 0)) { if (PHON(2)) {
            SgDesc g{HB, DM, nullptr, (const bf16_t*)(p.ws + WS_WIN) + (size_t)l * INW * DM, 0, 1 << 30, 1, NROWS, INW, DM, 0};
            EpiQKV E{PB, (const float*)(p.ws + WS_ROPE)}; sg_gemm(g, E, bid, nb); } }
        SEAM(pb + 0);
        if (IN(pb + 1)) { if (PHON(3)) phase_mixers(p, l, wc, bid, nb); }
        SEAM(pb + 1);
        if (IN(pb + 2)) { if (PHON(4)) {
            SgDesc g{OB, DM, nullptr, (const bf16_t*)(p.ws + WS_WOUT) + (size_t)l * DM * DM, 0, 1 << 30, 1, wc ? NROWS : NLAT, DM, DM, 0};
            EpiOut E{l == 0 ? p.x : p.out, p.ctx, p.out, (float*)(p.ws + WS_CXR), mod_ptr(p, l, 0)}; sg_gemm(g, E, bid, nb); } }
        SEAM(pb + 2);
        if (IN(pb + 3)) { if (PHON(5)) phase_ln_router(p, l, wc, lds, bid, nb); }
        SEAM(pb + 3);
        if (IN(pb + 4)) { if (PHON(6)) phase_topk(p, wc, lds, bid, nb); }
        SEAM(pb + 4);
        if (IN(pb + 5)) { if (PHON(7)) {
            const bf16_t* W = (const bf16_t*)(p.ws + WS_WGU) + (size_t)l * NE * 1024 * DM; EpiGU E{HH};
            { SgDesc g{HB, DM, TOK, W, (size_t)1024 * DM, CAP, NE, NSLOT_LAT, 1024, DM, 0}; sg_gemm(g, E, bid, nb); }
            if (wc) { SgDesc g{HB, DM, TOK + NSLOT_LAT, W, (size_t)1024 * DM, NB * CCAP, NE, NSLOT_CTX, 1024, DM, NSLOT_LAT}; sg_gemm(g, E, bid, nb); } } }
        SEAM(pb + 5);
        if (IN(pb + 6)) { if (PHON(8)) {
            const bf16_t* W = (const bf16_t*)(p.ws + WS_WD) + (size_t)l * NE * DM * FF; EpiDown E{Y, GATE};
            { SgDesc g{HH, FF, nullptr, W, (size_t)DM * FF, CAP, NE, NSLOT_LAT, DM, FF, 0}; sg_gemm(g, E, bid, nb); }
            if (wc) { SgDesc g{HH + (size_t)NSLOT_LAT * FF, FF, nullptr, W, (size_t)DM * FF, NB * CCAP, NE, NSLOT_CTX, DM, FF, NSLOT_LAT}; sg_gemm(g, E, bid, nb); } } }
        SEAM(pb + 6);
        if (IN(pb + 7)) { if (PHON(9)) phase_combine(p, l, wc, bid, nb); }
        SEAM(pb + 7);
    }
#undef IN
#undef SEAM
}

#ifndef N_LAUNCH_SPLIT
#define N_LAUNCH_SPLIT 0
#endif
extern "C" void kernel_launch(void* const* d_in, const int* in_sizes, int n_in, void* d_out, int out_size, void* d_ws, size_t ws_size, hipStream_t stream) {
    static int grid = 0;
    if (grid == 0) {
        if (n_in != 19 || in_sizes[0] != NLAT * DM || out_size != NLAT * DM || ws_size < WS_END) { fprintf(stderr, "kernel_launch: unexpected shapes (n_in %d, in0 %d, out %d, ws %zu)\n", n_in, n_in > 0 ? in_sizes[0] : -1, out_size, ws_size); grid = -1; return; }
        int dev = 0, cus = 0, per_cu = 0;
        if (hipGetDevice(&dev) != hipSuccess || hipDeviceGetAttribute(&cus, hipDeviceAttributeMultiprocessorCount, dev) != hipSuccess) { grid = -1; return; }
        if (hipFuncSetAttribute((const void*)fwd_kernel, hipFuncAttributeMaxDynamicSharedMemorySize, LDS_BYTES) != hipSuccess) { fprintf(stderr, "kernel_launch: hipFuncSetAttribute failed\n"); grid = -1; return; }
        if (hipOccupancyMaxActiveBlocksPerMultiprocessor(&per_cu, (const void*)fwd_kernel, NTHREADS, LDS_BYTES) != hipSuccess || per_cu < 1) { fprintf(stderr, "kernel_launch: occupancy query says %d\n", per_cu); per_cu = 1; }
        (void)hipGetLastError();
        grid = cus;
    }
    if (grid < 0) return;
    (void)hipMemsetAsync((char*)d_ws + WS_CTL, 0, CTL_ZERO_BYTES, stream);
    Params p{};
    const float** pp = (const float**)&p;
    for (int i = 0; i < 19; ++i) pp[i] = (const float*)d_in[i];
    p.out = (float*)d_out; p.ws = (unsigned char*)d_ws;
#if N_LAUNCH_SPLIT
    for (int ph = 0; ph < N_PHASES; ++ph) { p.ph_lo = ph; p.ph_hi = ph + 1; hipLaunchKernelGGL(fwd_kernel, dim3(grid), dim3(NTHREADS), LDS_BYTES, stream, p); }
#else
    p.ph_lo = 0; p.ph_hi = N_PHASES;
    void* args[] = {&p};
    hipError_t e = hipLaunchCooperativeKernel((const void*)fwd_kernel, dim3(grid), dim3(NTHREADS), args, LDS_BYTES, stream);
    if (e != hipSuccess) fprintf(stderr, "kernel_launch: cooperative launch failed: %s\n", hipGetErrorString(e));
#endif
}
```

```cpp
#include <hip/hip_runtime.h>
#include <hip/hip_cooperative_groups.h>
#include <cstdio>
#include <cstdint>
#include <cmath>

#define LAS __attribute__((address_space(3)))
typedef unsigned short bf16_t;
typedef short bf16x8 __attribute__((ext_vector_type(8)));
typedef float f32x4 __attribute__((ext_vector_type(4)));
typedef unsigned u32x4 __attribute__((ext_vector_type(4)));
typedef unsigned u32x2 __attribute__((ext_vector_type(2)));

constexpr int NB = 4, SEQ = 8192, DM = 1024, CTXL = 256, DEPTH = 2;
constexpr int NLAT = NB * SEQ, NCTX = NB * CTXL, NROWS = NLAT + NCTX;
constexpr int INW = 2560, NE = 16, FF = 512, CAP = 1024, CCAP = 32;
constexpr int NSLOT_LAT = NB * NE * CAP, NSLOT_CTX = NB * NE * CCAP, NSLOT = NSLOT_LAT + NSLOT_CTX;
constexpr int NMOD = 6 * DM;
constexpr float LN_EPS = 1e-6f;
constexpr float ALPHA = 1.41421356237309515f;
constexpr int C_QA = 0, C_KA = 384, C_VA = 512, C_BX = 640, C_BB = 896, C_BC = 1152, C_QN = 1408, C_KN = 1792, C_VN = 2176;

constexpr int NTHREADS = 512, NWAVES = 8;
constexpr int LDS_BYTES = 147456;

constexpr size_t MiB = 1u << 20;
constexpr size_t WS_CTL = 0, CTL_ZERO_BYTES = 1 * MiB;
constexpr size_t WS_ROPE = 1 * MiB;
constexpr size_t WS_MOD = 1 * MiB + 65536;
constexpr size_t WS_AFF = 2 * MiB;
constexpr size_t WS_INV = 5 * MiB;
constexpr size_t WS_TOK = 8 * MiB;
constexpr size_t WS_GATE = 8 * MiB + 512 * 1024;
constexpr size_t WS_CXR = 9 * MiB;
constexpr size_t WS_WIN = 16 * MiB;
constexpr size_t WS_WOUT = 26 * MiB;
constexpr size_t WS_WGU = 30 * MiB;
constexpr size_t WS_WD = 94 * MiB;
constexpr size_t WS_HB = 126 * MiB;
constexpr size_t WS_OB = 192 * MiB;
constexpr size_t WS_HH = 192 * MiB;
constexpr size_t WS_PB = 258 * MiB;
constexpr size_t WS_Y = 258 * MiB;
constexpr size_t WS_END = 423 * MiB;
static_assert(WS_HB + (size_t)NROWS * DM * 2 <= WS_OB && WS_OB + (size_t)NROWS * DM * 2 <= WS_PB && WS_PB + (size_t)NROWS * INW * 2 <= WS_END, "ws map");
static_assert((size_t)NSLOT * FF * 2 <= (size_t)NROWS * DM * 2 && (size_t)NSLOT * DM * 2 <= (size_t)NROWS * INW * 2, "overlays");
constexpr int CW_BAR = 4096;

struct Params {
    const float *x, *c, *ctx, *c_ctx, *w_mod, *b_mod, *w_in, *conv_w, *attn_sink, *na_rpb, *w_out, *ln1_g, *ln1_b, *w_router, *w_gate, *w_up, *w_down, *ln2_g, *ln2_b;
    float* out; unsigned char* ws;
    int ph_lo, ph_hi;
};

__device__ __forceinline__ unsigned f2bf(float f) { unsigned u = __builtin_bit_cast(unsigned, f); return (u + 0x7fffu + ((u >> 16) & 1u)) >> 16; }
__device__ __forceinline__ unsigned pk2(float lo, float hi) { return f2bf(lo) | (f2bf(hi) << 16); }
__device__ __forceinline__ float bf_lo(unsigned w) { return __builtin_bit_cast(float, w << 16); }
__device__ __forceinline__ float bf_hi(unsigned w) { return __builtin_bit_cast(float, w & 0xffff0000u); }
__device__ __forceinline__ float wave_sum(float v) {
#pragma unroll
    for (int o = 32; o >= 1; o >>= 1) v += __shfl_xor(v, o);
    return v;
}
#define LDS_WAIT() asm volatile("s_waitcnt lgkmcnt(0)" ::: "memory")
__device__ __forceinline__ int opaque_tid() { int t = threadIdx.x; asm volatile("" : "+v"(t)); return t; }
__device__ __forceinline__ int opaque_s(int v) { asm volatile("" : "+s"(v)); return v; }

__device__ __forceinline__ float* mod_ptr(const Params& p, int l, int r) { return (float*)(p.ws + WS_MOD) + ((size_t)l * 5 + r) * NMOD; }

#define XB_TMO      128
#define XB_XCNT(j)  (256  + 64 * (j))
#define XB_XSUB(j)  (1280 + 64 * (j))
#define XB_XGEN(j)  (2304 + 64 * (j))
#define XB_TOP      3328
#define XB_TOPGEN   3392
#define XCD_BAR_WORDS 3456
#define XB_SPIN_CAP (1u << 20)
__device__ __forceinline__ unsigned xb_ld(unsigned* p)              { return __hip_atomic_load(p, __ATOMIC_RELAXED, __HIP_MEMORY_SCOPE_AGENT); }
__device__ __forceinline__ unsigned xb_add(unsigned* p, unsigned v) { return __hip_atomic_fetch_add(p, v, __ATOMIC_RELAXED, __HIP_MEMORY_SCOPE_AGENT); }
__device__ __forceinline__ unsigned xb_xcc_id() { return (unsigned)__builtin_amdgcn_s_getreg((3 << 11) | 20) & 0xFu; }
#define XB_SPIN(cond, bar) do { unsigned _sp = 0; while (cond) { __builtin_amdgcn_s_sleep(1); \
    if ((++_sp & 255u) == 0u) { if (xb_ld(&(bar)[XB_TMO])) break; if (_sp > XB_SPIN_CAP) { atomicAdd(&(bar)[XB_TMO], 1u); break; } } } } while (0)
struct XcdBarrier { unsigned* bar; unsigned x; volatile LAS unsigned* st; };
__device__ __forceinline__ XcdBarrier xcd_barrier_post(unsigned* bar, volatile LAS unsigned* st) {
    XcdBarrier b; b.bar = bar; b.x = xb_xcc_id(); b.st = st;
    if (threadIdx.x == 0) (void)xb_add(&bar[XB_XCNT(b.x)], 1u);
    return b;
}
__device__ __forceinline__ void xcd_barrier_complete(unsigned* bar, unsigned x, unsigned& nloc, unsigned& nx) {
    const unsigned G = gridDim.x * gridDim.y * gridDim.z;
    unsigned sum, cnt, mine, sp = 0u;
    for (;;) {
        sum = 0u; cnt = 0u; mine = 0u;
#pragma unroll 1
        for (unsigned j = 0; j < 16; ++j) { const unsigned c = xb_ld(&bar[XB_XCNT(j)]); sum += c; cnt += (c > 0u) ? 1u : 0u; mine = (j == x) ? c : mine; }
        if (sum == G) break;
        __builtin_amdgcn_s_sleep(1);
        if ((++sp & 255u) == 0u) { if (xb_ld(&bar[XB_TMO])) break; if (sp > XB_SPIN_CAP) { atomicAdd(&bar[XB_TMO], 1u); break; } }
    }
    nloc = mine > 0u ? mine : 1u; nx = cnt > 0u ? cnt : 1u;
}
__device__ __forceinline__ void xcd_barrier(const XcdBarrier& b) {
    asm volatile("s_waitcnt vmcnt(0)" ::: "memory");
    __syncthreads();
    if (threadIdx.x == 0) {
        unsigned* bar = b.bar; asm volatile("" : "+s"(bar));
        __builtin_amdgcn_s_waitcnt(0);
        unsigned nloc = b.st[0], nx = b.st[1];
        if (nloc == 0u) { xcd_barrier_complete(bar, b.x, nloc, nx); b.st[0] = nloc; b.st[1] = nx; }
        const unsigned old = xb_add(&bar[XB_XSUB(b.x)], 1u);
        const unsigned gen = old / nloc;
        if (old + 1u == (gen + 1u) * nloc) {
            __builtin_amdgcn_fence(__ATOMIC_RELEASE, "agent");
            asm volatile("s_waitcnt vmcnt(0)" ::: "memory");
            const unsigned og = xb_add(&bar[XB_TOP], 1u);
            const unsigned tg = og / nx;
            if (og + 1u == (tg + 1u) * nx) xb_add(&bar[XB_TOPGEN], 1u);
            else XB_SPIN(xb_ld(&bar[XB_TOPGEN]) == tg, bar);
            __builtin_amdgcn_fence(__ATOMIC_ACQUIRE, "agent");
            xb_add(&bar[XB_XGEN(b.x)], 1u);
            asm volatile("s_waitcnt vmcnt(0)" ::: "memory");
        } else {
            XB_SPIN(xb_ld(&bar[XB_XGEN(b.x)]) == gen, bar);
            __builtin_amdgcn_fence(__ATOMIC_ACQUIRE, "agent");
            asm volatile("s_waitcnt vmcnt(0)" ::: "memory");
        }
    }
    __syncthreads();
}

__device__ __forceinline__ void transpose_item(const float* W, int K, int N, bf16_t* WT, int mode, LAS float* scr, int item, int lane) {
    const int nblk = N / 32, kb = item / nblk, nb = item % nblk, k0 = 64 * kb, n0 = 32 * nb;
#pragma unroll 8
    for (int i = 0; i < 32; ++i) { const int kk = 2 * i + (lane >> 5); scr[kk * 33 + (lane & 31)] = W[(size_t)(k0 + kk) * N + n0 + (lane & 31)]; }
    LDS_WAIT();
    const int c = lane & 7;
#pragma unroll
    for (int j = 0; j < 4; ++j) {
        const int n = (lane >> 3) + 8 * j; const LAS float* s = scr + (8 * c) * 33 + n;
        u32x4 o; o.x = pk2(s[0 * 33], s[1 * 33]); o.y = pk2(s[2 * 33], s[3 * 33]); o.z = pk2(s[4 * 33], s[5 * 33]); o.w = pk2(s[6 * 33], s[7 * 33]);
        const int f = n0 + n; const int orow = mode == 0 ? f : (32 * (f >> 4) + (f & 15) + (mode == 2 ? 16 : 0));
        *(u32x4*)(WT + (size_t)orow * K + k0 + 8 * c) = o;
    }
    LDS_WAIT();
}

__device__ __forceinline__ void phase_prologue(const Params& p, LAS unsigned char* lds, int bid, int nb) {
    bid = opaque_s(bid); const int tid = opaque_tid(), lane = tid & 63, w = tid >> 6;
    {
        LAS float* ssil = (LAS float*)lds;
        LAS float* red = ssil + 5 * 1024;
        for (int i = tid; i < 5 * 1024; i += NTHREADS) { const int r = i >> 10, k = i & 1023; const float v = r < 4 ? p.c[r * 1024 + k] : p.c_ctx[k]; ssil[i] = v / (1.f + expf(-v)); }
        __syncthreads();
        for (int item = bid; item < 2 * 96; item += nb) {
            const int l = item / 96, n0 = (item % 96) * 64;
            const float* W = p.w_mod + (size_t)l * DM * NMOD + n0 + lane;
            float a0 = 0.f, a1 = 0.f, a2 = 0.f, a3 = 0.f, a4 = 0.f;
#pragma unroll 8
            for (int k = w * 128; k < w * 128 + 128; ++k) {
                const float wv = W[(size_t)k * NMOD];
                a0 += ssil[k] * wv; a1 += ssil[1024 + k] * wv; a2 += ssil[2048 + k] * wv; a3 += ssil[3072 + k] * wv; a4 += ssil[4096 + k] * wv;
            }
            red[(w * 5 + 0) * 64 + lane] = a0; red[(w * 5 + 1) * 64 + lane] = a1; red[(w * 5 + 2) * 64 + lane] = a2; red[(w * 5 + 3) * 64 + lane] = a3; red[(w * 5 + 4) * 64 + lane] = a4;
            __syncthreads();
            if (tid < 320) { const int r = tid >> 6; float s = 0.f;
#pragma unroll
                for (int ww = 0; ww < 8; ++ww) s += red[(ww * 5 + r) * 64 + lane];
                mod_ptr(p, l, r)[n0 + lane] = s + p.b_mod[l * NMOD + n0 + lane]; }
            __syncthreads();
        }
    }
    if (bid == nb - 1) {
        float* rope = (float*)(p.ws + WS_ROPE);
        for (int e = tid; e < 128 * 16; e += NTHREADS) {
            const int pos = e >> 4, i = e & 15;
            const double a = exp(-((double)i / 16.0) * 9.210340371976184);
            const double a2 = a * a; double c = 1.0, s = a, tc = 1.0, ts = a;
            for (int n = 1; n <= 14; ++n) { tc *= -a2 / (double)((2 * n - 1) * (2 * n)); c += tc; ts *= -a2 / (double)((2 * n) * (2 * n + 1)); s += ts; }
            double rc = 1.0, rs = 0.0, bc = c, bs = s; int q = pos;
            while (q) { if (q & 1) { const double t = rc * bc - rs * bs; rs = rc * bs + rs * bc; rc = t; } const double t = bc * bc - bs * bs; bs = 2.0 * bc * bs; bc = t; q >>= 1; }
            rope[2 * e] = (float)rc; rope[2 * e + 1] = (float)rs;
        }
    }
    __syncthreads();
    {
        LAS float* scr = (LAS float*)lds + w * (64 * 33);
        const int gw = bid * NWAVES + w, NGW = nb * NWAVES;
        constexpr int I_IN = 16 * 80, I_OUT = 16 * 32, I_G = 16 * 16, I_D = 8 * 32;
        constexpr int PER_L = I_IN + I_OUT + 16 * (2 * I_G + I_D);
        for (int it = gw; it < 2 * PER_L; it += NGW) {
            const int l = it / PER_L; int r = it % PER_L;
            if (r < I_IN) { transpose_item(p.w_in + (size_t)l * DM * INW, DM, INW, (bf16_t*)(p.ws + WS_WIN) + (size_t)l * INW * DM, 0, scr, r, lane); continue; } r -= I_IN;
            if (r < I_OUT) { transpose_item(p.w_out + (size_t)l * DM * DM, DM, DM, (bf16_t*)(p.ws + WS_WOUT) + (size_t)l * DM * DM, 0, scr, r, lane); continue; } r -= I_OUT;
            if (r < 16 * I_G) { const int e = r / I_G; transpose_item(p.w_gate + ((size_t)l * NE + e) * DM * FF, DM, FF, (bf16_t*)(p.ws + WS_WGU) + ((size_t)l * NE + e) * 1024 * DM, 1, scr, r % I_G, lane); continue; } r -= 16 * I_G;
            if (r < 16 * I_G) { const int e = r / I_G; transpose_item(p.w_up + ((size_t)l * NE + e) * DM * FF, DM, FF, (bf16_t*)(p.ws + WS_WGU) + ((size_t)l * NE + e) * 1024 * DM, 2, scr, r % I_G, lane); continue; } r -= 16 * I_G;
            { const int e = r / I_D; transpose_item(p.w_down + ((size_t)l * NE + e) * FF * DM, FF, DM, (bf16_t*)(p.ws + WS_WD) + ((size_t)l * NE + e) * DM * FF, 0, scr, r % I_D, lane); }
        }
    }
}

__device__ __forceinline__ void row_load(const float* rowp, int lane, f32x4 (&v)[4]) {
#pragma unroll
    for (int j = 0; j < 4; ++j) v[j] = *(const f32x4*)(rowp + 256 * j + 4 * lane);
}
__device__ __forceinline__ void row_store(float* rowp, int lane, const f32x4 (&v)[4]) {
#pragma unroll
    for (int j = 0; j < 4; ++j) *(f32x4*)(rowp + 256 * j + 4 * lane) = v[j];
}
__device__ __forceinline__ void row_store_bf16(bf16_t* rowp, int lane, const f32x4 (&v)[4]) {
#pragma unroll
    for (int j = 0; j < 4; ++j) { u32x2 o; o.x = pk2(v[j][0], v[j][1]); o.y = pk2(v[j][2], v[j][3]); *(u32x2*)(rowp + 256 * j + 4 * lane) = o; }
}
__device__ __forceinline__ void row_normalize(f32x4 (&v)[4]) {
    float s = 0.f;
#pragma unroll
    for (int j = 0; j < 4; ++j) s += (v[j][0] + v[j][1]) + (v[j][2] + v[j][3]);
    const float mean = wave_sum(s) * (1.f / DM);
    float q = 0.f;
#pragma unroll
    for (int j = 0; j < 4; ++j) { v[j] = v[j] - mean; q += (v[j][0] * v[j][0] + v[j][1] * v[j][1]) + (v[j][2] * v[j][2] + v[j][3] * v[j][3]); }
    const float rstd = 1.f / sqrtf(wave_sum(q) * (1.f / DM) + LN_EPS);
#pragma unroll
    for (int j = 0; j < 4; ++j) v[j] = v[j] * rstd;
}
__device__ __forceinline__ void row_modulate(f32x4 (&v)[4], const float* sh, const float* sc, int lane) {
#pragma unroll
    for (int j = 0; j < 4; ++j) { const f32x4 a = *(const f32x4*)(sc + 256 * j + 4 * lane), b = *(const f32x4*)(sh + 256 * j + 4 * lane); v[j] = v[j] * (a + 1.f) + b; }
}
__device__ __forceinline__ void row_affine(f32x4 (&v)[4], const float* g, const float* bb, int lane) {
#pragma unroll
    for (int j = 0; j < 4; ++j) { const f32x4 a = *(const f32x4*)(g + 256 * j + 4 * lane), b = *(const f32x4*)(bb + 256 * j + 4 * lane); v[j] = v[j] * a + b; }
}
__device__ __forceinline__ int row_modrow(int row) { return row < NLAT ? (row >> 13) : 4; }

__device__ __forceinline__ void phase_ln1(const Params& p, int bid, int nb) {
    bid = opaque_s(bid); const int tid = opaque_tid(), lane = tid & 63, gw = bid * NWAVES + (tid >> 6), NGW = nb * NWAVES;
    bf16_t* HB = (bf16_t*)(p.ws + WS_HB);
    for (int row = gw; row < NROWS; row += NGW) {
        const float* src = row < NLAT ? p.x + (size_t)row * DM : p.ctx + (size_t)(row - NLAT) * DM;
        f32x4 v[4]; row_load(src, lane, v); row_normalize(v);
        const float* m = mod_ptr(p, 0, row_modrow(row)); row_modulate(v, m, m + DM, lane);
        row_store_bf16(HB + (size_t)row * DM, lane, v);
    }
}

struct SgDesc { const bf16_t* A; int lda; const int* rowidx; const bf16_t* Bt; size_t grp_stride; int rows_per_grp, ngrp; int M, N, K; int row_base; };
template <class Epi>
__device__ __forceinline__ void sg_gemm(const SgDesc& g, const Epi& E, int bid, int nb) {
    bid = opaque_s(bid); const int tid = opaque_tid(); const int lane = tid & 63, w = tid >> 6, fr = lane & 15, fq = lane >> 4, wm = w >> 1, wn = w & 1;
    const int tilesN = g.N / 128, tiles = (g.M / 128) * tilesN;
    for (int t = bid; t < tiles; t += nb) {
        const int tm = t / tilesN, tn = t % tilesN;
        const int row0 = tm * 128 + wm * 32, col0 = tn * 128 + wn * 64;
        const bf16_t* Bt = g.Bt + (size_t)(((tm * 128) / g.rows_per_grp) % g.ngrp) * g.grp_stride;
        const bf16_t* ap[2]; const bf16_t* bp[4];
#pragma unroll
        for (int i = 0; i < 2; ++i) { const int r = row0 + 16 * i + fr; const int ar = g.rowidx ? g.rowidx[r] : r; ap[i] = g.A + (size_t)ar * g.lda + 8 * fq; }
#pragma unroll
        for (int n = 0; n < 4; ++n) bp[n] = Bt + (size_t)(col0 + 16 * n + fr) * g.K + 8 * fq;
        f32x4 acc[2][4];
#pragma unroll
        for (int i = 0; i < 2; ++i)
#pragma unroll
            for (int n = 0; n < 4; ++n) acc[i][n] = (f32x4){0.f, 0.f, 0.f, 0.f};
#pragma unroll 2
        for (int k = 0; k < g.K; k += 32) {
            bf16x8 a[2], b[4];
#pragma unroll
            for (int i = 0; i < 2; ++i) a[i] = *(const bf16x8*)(ap[i] + k);
#pragma unroll
            for (int n = 0; n < 4; ++n) b[n] = *(const bf16x8*)(bp[n] + k);
#pragma unroll
            for (int i = 0; i < 2; ++i)
#pragma unroll
                for (int n = 0; n < 4; ++n) acc[i][n] = __builtin_amdgcn_mfma_f32_16x16x32_bf16(b[n], a[i], acc[i][n], 0, 0, 0);
        }
#pragma unroll
        for (int i = 0; i < 2; ++i)
#pragma unroll
            for (int g2 = 0; g2 < 2; ++g2) E(g.row_base + row0 + 16 * i + fr, col0 + 32 * g2, fq, acc[i][2 * g2], acc[i][2 * g2 + 1]);
    }
}

__device__ __forceinline__ void store_bf16x4(bf16_t* p, const f32x4 v) { u32x2 o; o.x = pk2(v[0], v[1]); o.y = pk2(v[2], v[3]); *(u32x2*)p = o; }

struct EpiQKV {
    bf16_t* PB; const float* rope;
    __device__ __forceinline__ void operator()(int row, int c32, int fq, f32x4 v0, f32x4 v1) const {
        if (c32 < 512 && row < NLAT) {
            const int t = row & (SEQ - 1); const int pos = (c32 & 32) ? (t & 63) : (t >> 6);
            const float* rp = rope + (pos * 16 + 4 * fq) * 2;
#pragma unroll
            for (int j = 0; j < 4; ++j) { const float cs = rp[2 * j], sn = rp[2 * j + 1], a = v0[j], b = v1[j]; v0[j] = a * cs - b * sn; v1[j] = b * cs + a * sn; }
        }
        bf16_t* o = PB + (size_t)row * INW + c32 + 4 * fq;
        store_bf16x4(o, v0); store_bf16x4(o + 16, v1);
    }
};
struct EpiOut {
    const float* xl; const float* xc; float* XR; float* CXR; const float* mod;
    __device__ __forceinline__ void operator()(int row, int c32, int fq, f32x4 v0, f32x4 v1) const {
        const int c = c32 + 4 * fq; const float* xin; float* xo; const float* g1;
        if (row < NLAT) { xin = xl + (size_t)row * DM; xo = XR + (size_t)row * DM; g1 = mod + (size_t)(row >> 13) * NMOD + 2 * DM; }
        else { const int r = row - NLAT; xin = xc + (size_t)r * DM; xo = CXR + (size_t)r * DM; g1 = mod + (size_t)4 * NMOD + 2 * DM; }
        const f32x4 x0 = *(const f32x4*)(xin + c), x1 = *(const f32x4*)(xin + c + 16), g0 = *(const f32x4*)(g1 + c), g1v = *(const f32x4*)(g1 + c + 16);
        *(f32x4*)(xo + c) = x0 * ALPHA + g0 * v0; *(f32x4*)(xo + c + 16) = x1 * ALPHA + g1v * v1;
    }
};
struct EpiGU {
    bf16_t* HH;
    __device__ __forceinline__ void operator()(int row, int c32, int fq, f32x4 v0, f32x4 v1) const {
        f32x4 h;
#pragma unroll
        for (int j = 0; j < 4; ++j) h[j] = v0[j] / (1.f + __expf(-v0[j])) * v1[j];
        store_bf16x4(HH + (size_t)row * FF + (c32 >> 1) + 4 * fq, h);
    }
};
struct EpiDown {
    bf16_t* Y; const float* gate;
    __device__ __forceinline__ void operator()(int row, int c32, int fq, f32x4 v0, f32x4 v1) const {
        const float g = gate[row]; bf16_t* o = Y + (size_t)row * DM + c32 + 4 * fq;
        store_bf16x4(o, v0 * g); store_bf16x4(o + 16, v1 * g);
    }
};


namespace mg {
constexpr int BM = 256, BK = 64, HALF = 128, HTB = HALF * BK * 2, STAGE_BYTES = 8 * HTB, NXCD = 8, WGM = 8, MAXU = 8;
__device__ __forceinline__ int lds_byte(int r, int c) { const int st = (r >> 4) * 2 + (c >> 5), rr = r & 15, cc = c & 31, ob = rr * 64 + cc * 2; return st * 1024 + (ob ^ (((ob >> 9) & 1) << 5)); }
__device__ __forceinline__ void stage_rc(int b, int& R, int& C) { const int st = b / 1024, sb = b % 1024, swz = sb ^ (((sb >> 9) & 1) << 5); R = (st >> 1) * 16 + swz / 64; C = (st & 1) * 32 + (swz % 64) / 2; }
struct Unit { int pm, pn; };
struct Gemm { const bf16_t* A; const bf16_t* Bt; int M, N, K; const int* rowidx; size_t grp_stride; int grp_tiles, ngrp; };
struct StaticOrder {
    int nM, nN, nwg, G, c;
    __device__ void init(int M, int N, int G_, int c_) { nM = M / BM; nN = N / BM; nwg = nM * nN; G = G_; c = c_; }
    __device__ bool next(int i, Unit& u) const {
        const long L = (long)i * G + c; if (L >= nwg) return false;
        int wgid = (int)L; { const int q = nwg / NXCD, r = nwg % NXCD, xcd = wgid % NXCD, off = wgid / NXCD; wgid = (xcd < r ? xcd * (q + 1) : r * (q + 1) + (xcd - r) * q) + off; }
        const int nig = WGM * nN, gid = wgid / nig, fm = gid * WGM, gsz = (nM - fm) < WGM ? (nM - fm) : WGM;
        u.pm = fm + ((wgid % nig) % gsz); u.pn = (wgid % nig) / gsz; return true;
    }
};
template <class Epi>
__device__ __forceinline__ void gemm_phase(LAS unsigned char* lds, LAS int* idxl, const Gemm g, const StaticOrder& S, const Epi& E) {
    const int tid = opaque_tid(), wid = __builtin_amdgcn_readfirstlane(tid >> 6), lane = tid & 63, wr = wid >> 2, wc = wid & 3, fr = lane & 15, fq = lane >> 4;
    const int K = g.K, nt = K / BK;
    unsigned voffB[2];
#pragma unroll
    for (int i = 0; i < 2; ++i) { int R_, C_; stage_rc(tid * 16 + i * 8192, R_, C_); voffB[i] = (unsigned)(R_ * K + C_) * 2u; }
    const size_t kstep = (size_t)(BK * 2);
    const size_t hstep = (size_t)HALF * K * 2;
    const size_t tstep = 2 * hstep;
    const unsigned ldsw = (unsigned)wid * 1024u;
    const int aoff = lds_byte(wr * 64 + fr, fq * 8), boff = lds_byte(wc * 32 + fr, fq * 8);
    Unit cur, nxt; int ui = 0;
    if (!S.next(0, cur)) return;
    if (g.rowidx) {
        for (int i = 0; i < MAXU; ++i) { Unit u; if (!S.next(i, u)) break; if (tid < 256) idxl[i * 256 + tid] = g.rowidx[u.pm * BM + tid]; }
        asm volatile("s_waitcnt vmcnt(0) lgkmcnt(0)" ::: "memory"); __builtin_amdgcn_s_barrier(); asm volatile("" ::: "memory");
    }
#define MG_AOFFS(dst, u_, ui_) do { _Pragma("unroll") for (int i_ = 0; i_ < 2; ++i_) { int R_, C_; stage_rc(tid * 16 + i_ * 8192, R_, C_); _Pragma("unroll") for (int h_ = 0; h_ < 2; ++h_) { \
        const int rr_ = g.rowidx ? idxl[(ui_) * 256 + h_ * HALF + R_] : ((u_).pm * BM + h_ * HALF + R_); dst[h_][i_] = (unsigned)(rr_ * K + C_) * 2u; } } } while (0)
#define MG_BPTR(u_) ((const char*)g.Bt + ((size_t)(((u_).pm / g.grp_tiles) % g.ngrp) * g.grp_stride) * 2 + (size_t)(u_).pn * tstep)
#define PG8_SA(b, h) (((b) * 2 + (h)) * HTB)
#define PG8_SB(b, h) ((4 + (b) * 2 + (h)) * HTB)
#define PG8_STAGE(bufoff, gbase, voff) do { _Pragma("unroll") for (int _i = 0; _i < 2; ++_i) \
        __builtin_amdgcn_global_load_lds((const unsigned*)((const char*)(gbase) + (voff)[_i]), (LAS unsigned*)(lds + (bufoff) + ldsw + _i * 8192), 16, 0, 0); } while (0)
#define PG8_LDA(dst, b, h) do { _Pragma("unroll") for (int m = 0; m < 4; ++m) _Pragma("unroll") for (int k = 0; k < 2; ++k) dst[m][k] = *(const LAS bf16x8*)(lds + PG8_SA(b, h) + aoff + m * 2048 + k * 1024); } while (0)
#define PG8_LDB(dst, b, h) do { _Pragma("unroll") for (int n = 0; n < 2; ++n) _Pragma("unroll") for (int k = 0; k < 2; ++k) dst[n][k] = *(const LAS bf16x8*)(lds + PG8_SB(b, h) + boff + n * 2048 + k * 1024); } while (0)
#define PG8_MMA(ai, bj, At, Bt) do { __builtin_amdgcn_s_setprio(1); _Pragma("unroll") for (int m = 0; m < 4; ++m) _Pragma("unroll") for (int n = 0; n < 2; ++n) _Pragma("unroll") for (int k = 0; k < 2; ++k) \
        acc[ai][bj][m][n] = __builtin_amdgcn_mfma_f32_16x16x32_bf16(Bt[n][k], At[m][k], acc[ai][bj][m][n], 0, 0, 0); __builtin_amdgcn_s_setprio(0); } while (0)
#define PG8_WAIT_V(n) asm volatile("s_waitcnt vmcnt(" #n ")" ::: "memory")
#define PG8_WAIT_L(n) asm volatile("s_waitcnt lgkmcnt(" #n ")" ::: "memory")
#define PG8_BAR __builtin_amdgcn_s_barrier()
#define PG8_SCHED __builtin_amdgcn_sched_barrier(0)
    f32x4 acc[2][2][4][2];
#pragma unroll
    for (int a = 0; a < 2; ++a)
#pragma unroll
        for (int b = 0; b < 2; ++b)
#pragma unroll
            for (int m = 0; m < 4; ++m)
#pragma unroll
                for (int n = 0; n < 2; ++n) acc[a][b][m][n] = (f32x4){0.f, 0.f, 0.f, 0.f};
    bf16x8 At[4][2], B0[2][2], B1[2][2];
    unsigned cAo[2][2], o2[2][2];
    MG_AOFFS(cAo, cur, 0);
    const char* const Abase = (const char*)g.A;
    const char* cB = MG_BPTR(cur);
    PG8_STAGE(PG8_SB(0, 0), cB, voffB); PG8_STAGE(PG8_SB(0, 1), cB + hstep, voffB); PG8_STAGE(PG8_SA(0, 0), Abase, cAo[0]); PG8_STAGE(PG8_SA(0, 1), Abase, cAo[1]);
    if (wr == 1) PG8_BAR;
    PG8_WAIT_V(2); PG8_BAR;
    PG8_STAGE(PG8_SB(1, 0), cB + kstep, voffB); PG8_STAGE(PG8_SA(1, 0), Abase + kstep, cAo[0]); PG8_STAGE(PG8_SB(1, 1), cB + hstep + kstep, voffB);
    PG8_WAIT_V(6); PG8_BAR;
    for (;;) {
        const bool has_next = S.next(ui + 1, nxt);
        const char* nB = has_next ? MG_BPTR(nxt) : cB;
        for (int t = 0; t < nt; t += 2) {
            const bool last = (t == nt - 2);
            const char* a1 = Abase + (size_t)(t + 1) * kstep;
            const char* a2 = last ? Abase : Abase + (size_t)(t + 2) * kstep; const char* b2 = last ? nB : cB + (size_t)(t + 2) * kstep;
            const char* a3 = a2 + kstep; const char* b3 = b2 + kstep;
            if (last && has_next) { MG_AOFFS(o2, nxt, ui + 1); } else {
#pragma unroll
                for (int h = 0; h < 2; ++h)
#pragma unroll
                    for (int i = 0; i < 2; ++i) o2[h][i] = cAo[h][i]; }
            PG8_LDB(B0, 0, 0); PG8_LDB(B1, 0, 1); PG8_SCHED; PG8_LDA(At, 0, 0); PG8_STAGE(PG8_SA(1, 1), a1, cAo[1]);
            PG8_WAIT_V(8); PG8_WAIT_L(0); PG8_BAR; PG8_MMA(0, 0, At, B0); PG8_MMA(0, 1, At, B1); PG8_BAR; PG8_SCHED;
            PG8_LDA(At, 0, 1); PG8_STAGE(PG8_SB(0, 0), b2, voffB); PG8_STAGE(PG8_SB(0, 1), b2 + hstep, voffB); PG8_STAGE(PG8_SA(0, 0), a2, o2[0]);
            PG8_WAIT_V(8); PG8_WAIT_L(0); PG8_BAR; PG8_MMA(1, 0, At, B0); PG8_MMA(1, 1, At, B1); PG8_BAR; PG8_SCHED;
            PG8_LDB(B0, 1, 0); PG8_LDB(B1, 1, 1); PG8_SCHED; PG8_LDA(At, 1, 0); PG8_STAGE(PG8_SA(0, 1), a2, o2[1]);
            PG8_WAIT_V(8); PG8_WAIT_L(0); PG8_BAR; PG8_MMA(0, 0, At, B0); PG8_MMA(0, 1, At, B1); PG8_BAR; PG8_SCHED;
            PG8_LDA(At, 1, 1); PG8_STAGE(PG8_SB(1, 0), b3, voffB); PG8_STAGE(PG8_SB(1, 1), b3 + hstep, voffB); PG8_STAGE(PG8_SA(1, 0), a3, o2[0]);
            PG8_WAIT_V(8); PG8_WAIT_L(0); PG8_BAR; PG8_MMA(1, 0, At, B0); PG8_MMA(1, 1, At, B1); PG8_BAR; PG8_SCHED;
        }
        if (wr == 0) PG8_BAR;
        E(acc, cur, wr, wc, fr, fq);
        if (!has_next) break;
#pragma unroll
        for (int a = 0; a < 2; ++a)
#pragma unroll
            for (int b = 0; b < 2; ++b)
#pragma unroll
                for (int m = 0; m < 4; ++m)
#pragma unroll
                    for (int n = 0; n < 2; ++n) acc[a][b][m][n] = (f32x4){0.f, 0.f, 0.f, 0.f};
        cur = nxt; cB = nB; ++ui;
#pragma unroll
        for (int h = 0; h < 2; ++h)
#pragma unroll
            for (int i = 0; i < 2; ++i) cAo[h][i] = o2[h][i];
        if (wr == 1) PG8_BAR;
    }
    PG8_WAIT_V(0);
    PG8_BAR;
#undef MG_AOFFS
#undef MG_BPTR
#undef PG8_SA
#undef PG8_SB
#undef PG8_STAGE
#undef PG8_LDA
#undef PG8_LDB
#undef PG8_MMA
#undef PG8_WAIT_V
#undef PG8_WAIT_L
#undef PG8_BAR
#undef PG8_SCHED
}
template <class EE> struct EpiAdapt {
    EE e; int row_base;
    __device__ __forceinline__ void operator()(const f32x4 (&acc)[2][2][4][2], const Unit& u, int wr, int wc, int fr, int fq) const {
#pragma unroll
        for (int ai = 0; ai < 2; ++ai)
#pragma unroll
            for (int m = 0; m < 4; ++m) { const int row = row_base + u.pm * BM + ai * HALF + wr * 64 + m * 16 + fr;
#pragma unroll
                for (int bj = 0; bj < 2; ++bj) e(row, u.pn * BM + bj * HALF + wc * 32, fq, acc[ai][bj][m][0], acc[ai][bj][m][1]);
                asm volatile("" ::: "memory"); }
    }
};
}

struct AttnState { float m, l; float o[32]; };
__device__ __forceinline__ void attn_init(AttnState& st) { st.m = -INFINITY; st.l = 0.f;
#pragma unroll
    for (int d = 0; d < 32; ++d) st.o[d] = 0.f; }
__device__ __forceinline__ void load_row32(const bf16_t* p, float (&r)[32], float scale) {
#pragma unroll
    for (int i = 0; i < 4; ++i) { const u32x4 w = *(const u32x4*)(p + 8 * i);
        r[8 * i + 0] = bf_lo(w.x) * scale; r[8 * i + 1] = bf_hi(w.x) * scale; r[8 * i + 2] = bf_lo(w.y) * scale; r[8 * i + 3] = bf_hi(w.y) * scale;
        r[8 * i + 4] = bf_lo(w.z) * scale; r[8 * i + 5] = bf_hi(w.z) * scale; r[8 * i + 6] = bf_lo(w.w) * scale; r[8 * i + 7] = bf_hi(w.w) * scale; }
}
__device__ __forceinline__ float dot_row32(const bf16_t* p, const float (&q)[32]) {
    float d0 = 0.f, d1 = 0.f;
#pragma unroll
    for (int i = 0; i < 4; ++i) { const u32x4 w = *(const u32x4*)(p + 8 * i);
        d0 += q[8 * i + 0] * bf_lo(w.x); d1 += q[8 * i + 1] * bf_hi(w.x); d0 += q[8 * i + 2] * bf_lo(w.y); d1 += q[8 * i + 3] * bf_hi(w.y);
        d0 += q[8 * i + 4] * bf_lo(w.z); d1 += q[8 * i + 5] * bf_hi(w.z); d0 += q[8 * i + 6] * bf_lo(w.w); d1 += q[8 * i + 7] * bf_hi(w.w); }
    const float d = d0 + d1;
    return d + __shfl_xor(d, 32);
}
__device__ __forceinline__ void axpy_row32(const bf16_t* p, float a, float (&o)[32]) {
#pragma unroll
    for (int i = 0; i < 4; ++i) { const u32x4 w = *(const u32x4*)(p + 8 * i);
        o[8 * i + 0] += a * bf_lo(w.x); o[8 * i + 1] += a * bf_hi(w.x); o[8 * i + 2] += a * bf_lo(w.y); o[8 * i + 3] += a * bf_hi(w.y);
        o[8 * i + 4] += a * bf_lo(w.z); o[8 * i + 5] += a * bf_hi(w.z); o[8 * i + 6] += a * bf_lo(w.w); o[8 * i + 7] += a * bf_hi(w.w); }
}
template <class ScoreFn>
__device__ __forceinline__ void attn_segment(const float (&q)[32], AttnState& st, const bf16_t* Kb, const bf16_t* Vb, int j0, int j1, ScoreFn sf) {
#pragma unroll 1
    for (int j = j0; j < j1; ++j) {
        const float s0 = sf(j, dot_row32(Kb + (size_t)j * INW, q));
        if (s0 > st.m) { const float corr = __expf(st.m - s0); st.l *= corr;
#pragma unroll
            for (int d = 0; d < 32; ++d) st.o[d] *= corr;
            st.m = s0; }
        const float p0 = (s0 == -INFINITY) ? 0.f : __expf(s0 - st.m);
        st.l += p0;
        axpy_row32(Vb + (size_t)j * INW, p0, st.o);
    }
}
__device__ __forceinline__ void attn_sink(AttnState& st, float sk) {
    if (sk > st.m) { const float corr = __expf(st.m - sk); st.l *= corr;
#pragma unroll
        for (int d = 0; d < 32; ++d) st.o[d] *= corr;
        st.m = sk; }
    st.l += __expf(sk - st.m);
}
__device__ __forceinline__ void attn_store(const AttnState& st, bf16_t* o) {
    const float inv = 1.f / st.l;
#pragma unroll
    for (int i = 0; i < 4; ++i) { u32x4 w; w.x = pk2(st.o[8 * i] * inv, st.o[8 * i + 1] * inv); w.y = pk2(st.o[8 * i + 2] * inv, st.o[8 * i + 3] * inv);
        w.z = pk2(st.o[8 * i + 4] * inv, st.o[8 * i + 5] * inv); w.w = pk2(st.o[8 * i + 6] * inv, st.o[8 * i + 7] * inv); *(u32x4*)(o + 8 * i) = w; }
}

__device__ __forceinline__ void phase_mixers(const Params& p, int l, bool with_ctx, int bid, int nb) {
    bid = opaque_s(bid); const int tid = opaque_tid(); const int lane = tid & 63, gw = bid * NWAVES + (tid >> 6), NGW = nb * NWAVES;
    const int ql = lane & 31, hf = lane >> 5;
    const bf16_t* PB = (const bf16_t*)(p.ws + WS_PB); bf16_t* OB = (bf16_t*)(p.ws + WS_OB);
    const float* sink = p.attn_sink + l * 6; const float* rpb = p.na_rpb + (size_t)l * 6 * 15 * 31;
#pragma unroll 1
    for (int it = gw; it < NB * 6 * 256; it += NGW) {
        const int chunk = it & 255, h = (it >> 8) % 6, b = it / (6 * 256), kvh = h / 3;
        const int t = chunk * 32 + ql; const size_t rowb = (size_t)b * SEQ;
        float q[32]; load_row32(PB + (rowb + t) * INW + C_QA + h * 64 + 32 * hf, q, 0.125f);
        AttnState st; attn_init(st);
        const int jlo = max(0, chunk * 32 - 128), jhi = min(SEQ, chunk * 32 + 32 + 128);
        attn_segment(q, st, PB + rowb * INW + C_KA + kvh * 64 + 32 * hf, PB + rowb * INW + C_VA + kvh * 64 + 32 * hf, jlo, jhi,
                     [&](int j, float d) { const int dt = t - j; return (dt <= 128 && dt >= -128) ? d : -INFINITY; });
        const size_t crow = (size_t)NLAT + (size_t)b * CTXL;
        attn_segment(q, st, PB + crow * INW + C_KA + kvh * 64 + 32 * hf, PB + crow * INW + C_VA + kvh * 64 + 32 * hf, 0, CTXL, [&](int, float d) { return d; });
        attn_sink(st, sink[h]);
        attn_store(st, OB + (rowb + t) * DM + h * 64 + 32 * hf);
    }
#pragma unroll 1
    for (int it = gw; it < NB * 6 * 256; it += NGW) {
        const int r = (it & 255) >> 1, ch = it & 1, h = (it >> 8) % 6, b = it / (6 * 256);
        const int cq = ch * 32 + ql; const size_t rowb = (size_t)b * SEQ; const int t = r * 64 + cq;
        float q[32]; load_row32(PB + (rowb + t) * INW + C_QN + h * 64 + 32 * hf, q, 0.125f);
        AttnState st; attn_init(st);
        const int rs = min(max(r - 4, 0), 128 - 8), cs = min(max(cq - 8, 0), 64 - 16);
        const float* bias = rpb + (size_t)h * 15 * 31;
        attn_segment(q, st, PB + (rowb + (size_t)rs * 64) * INW + C_KN + h * 64 + 32 * hf, PB + (rowb + (size_t)rs * 64) * INW + C_VN + h * 64 + 32 * hf, 0, 512,
                     [&](int j, float d) { const int ka = rs + (j >> 6), ck = j & 63; const bool ok = (ck >= cs) && (ck < cs + 16);
                                           const int ro = ka - r + 7, co = min(max(ck - cq, -15), 15) + 15; return ok ? d + bias[ro * 31 + co] : -INFINITY; });
        const size_t crow = (size_t)NLAT + (size_t)b * CTXL;
        attn_segment(q, st, PB + crow * INW + C_KN + h * 64 + 32 * hf, PB + crow * INW + C_VN + h * 64 + 32 * hf, 0, CTXL, [&](int, float d) { return d; });
        attn_store(st, OB + (rowb + t) * DM + 640 + h * 64 + 32 * hf);
    }
    {
        const float* cw = p.conv_w + (size_t)l * 3 * 256;
        const int nrows = with_ctx ? NROWS : NLAT;
        for (long e = (long)bid * NTHREADS + tid; e < (long)nrows * 32; e += (long)nb * NTHREADS) {
            const int row = (int)(e >> 5), ch = (int)(e & 31) * 8;
            const int tpos = row < NLAT ? (row & (SEQ - 1)) : ((row - NLAT) & (CTXL - 1)); const int tlen = row < NLAT ? SEQ : CTXL;
            const bf16_t* pr = PB + (size_t)row * INW;
            float u[3][8];
#pragma unroll
            for (int dlt = -1; dlt <= 1; ++dlt) {
                const bool ok = (tpos + dlt >= 0) && (tpos + dlt < tlen);
                if (ok) { const u32x4 a = *(const u32x4*)(pr + (long)dlt * INW + C_BX + ch), c = *(const u32x4*)(pr + (long)dlt * INW + C_BC + ch);
                    u[dlt + 1][0] = bf_lo(a.x) * bf_lo(c.x); u[dlt + 1][1] = bf_hi(a.x) * bf_hi(c.x); u[dlt + 1][2] = bf_lo(a.y) * bf_lo(c.y); u[dlt + 1][3] = bf_hi(a.y) * bf_hi(c.y);
                    u[dlt + 1][4] = bf_lo(a.z) * bf_lo(c.z); u[dlt + 1][5] = bf_hi(a.z) * bf_hi(c.z); u[dlt + 1][6] = bf_lo(a.w) * bf_lo(c.w); u[dlt + 1][7] = bf_hi(a.w) * bf_hi(c.w); }
                else {
#pragma unroll
                    for (int i = 0; i < 8; ++i) u[dlt + 1][i] = 0.f; }
            }
            const u32x4 gb = *(const u32x4*)(pr + C_BB + ch);
            const float g[8] = {bf_lo(gb.x), bf_hi(gb.x), bf_lo(gb.y), bf_hi(gb.y), bf_lo(gb.z), bf_hi(gb.z), bf_lo(gb.w), bf_hi(gb.w)};
            float y[8];
#pragma unroll
            for (int i = 0; i < 8; ++i) y[i] = g[i] * (u[0][i] * cw[ch + i] + u[1][i] * cw[256 + ch + i] + u[2][i] * cw[512 + ch + i]);
            u32x4 o; o.x = pk2(y[0], y[1]); o.y = pk2(y[2], y[3]); o.z = pk2(y[4], y[5]); o.w = pk2(y[6], y[7]);
            *(u32x4*)(OB + (size_t)row * DM + 384 + ch) = o;
        }
    }
    if (with_ctx) {
#pragma unroll 1
        for (int it = gw; it < 2 * NB * 6 * 8; it += NGW) {
            const int kind = it / (NB * 6 * 8), r = it % (NB * 6 * 8), chunk = r & 7, h = (r >> 3) % 6, b = r / 48;
            const size_t crow = (size_t)NLAT + (size_t)b * CTXL; const int tq = chunk * 32 + ql;
            const int qc = (kind == 0 ? C_QA + h * 64 : C_QN + h * 64) + 32 * hf, kc = (kind == 0 ? C_KA + (h / 3) * 64 : C_KN + h * 64) + 32 * hf, vc = (kind == 0 ? C_VA + (h / 3) * 64 : C_VN + h * 64) + 32 * hf;
            float q[32]; load_row32(PB + (crow + tq) * INW + qc, q, 0.125f);
            AttnState st; attn_init(st);
            attn_segment(q, st, PB + crow * INW + kc, PB + crow * INW + vc, 0, CTXL, [&](int, float d) { return d; });
            if (kind == 0) attn_sink(st, sink[h]);
            attn_store(st, OB + (crow + tq) * DM + (kind == 0 ? 0 : 640) + h * 64 + 32 * hf);
        }
    }
}

__device__ __forceinline__ void phase_ln_router(const Params& p, int l, bool with_ctx, LAS unsigned char* lds, int bid, int nb) {
    bid = opaque_s(bid); const int tid = opaque_tid(), lane = tid & 63, gw = bid * NWAVES + (tid >> 6), NGW = nb * NWAVES;
    LAS float* wr = (LAS float*)lds;
    const float* wrg = p.w_router + (size_t)l * DM * NE;
    for (int i = tid; i < DM * NE; i += NTHREADS) { const int c = i >> 4, e = i & 15; wr[e * DM + c] = wrg[i]; }
    __syncthreads();
    float* XR = p.out; float* CXR = (float*)(p.ws + WS_CXR); bf16_t* HB = (bf16_t*)(p.ws + WS_HB); float* AFF = (float*)(p.ws + WS_AFF);
    const float* g = p.ln1_g + l * DM; const float* bb = p.ln1_b + l * DM;
    const int nrows = with_ctx ? NROWS : NLAT;
    for (int row = gw; row < nrows; row += NGW) {
        float* xr = row < NLAT ? XR + (size_t)row * DM : CXR + (size_t)(row - NLAT) * DM;
        f32x4 v[4]; row_load(xr, lane, v); row_normalize(v); row_affine(v, g, bb, lane); row_store(xr, lane, v);
        row_normalize(v);
        const float* m = mod_ptr(p, l, row_modrow(row)); row_modulate(v, m + 3 * DM, m + 4 * DM, lane);
        row_store_bf16(HB + (size_t)row * DM, lane, v);
        float lg[16];
#pragma unroll
        for (int e = 0; e < 16; ++e) { float s = 0.f;
#pragma unroll
            for (int j = 0; j < 4; ++j) { const f32x4 wv = *(const LAS f32x4*)(wr + e * DM + 256 * j + 4 * lane); s += (v[j][0] * wv[0] + v[j][1] * wv[1]) + (v[j][2] * wv[2] + v[j][3] * wv[3]); }
            lg[e] = wave_sum(s);
            if ((e & 3) == 3) asm volatile("" ::: "memory"); }
        float mx = lg[0];
#pragma unroll
        for (int e = 1; e < 16; ++e) mx = fmaxf(mx, lg[e]);
        float sum = 0.f;
#pragma unroll
        for (int e = 0; e < 16; ++e) { lg[e] = expf(lg[e] - mx); sum += lg[e]; }
        const float inv = 1.f / sum; float mine = 0.f;
#pragma unroll
        for (int e = 0; e < 16; ++e) mine = (lane == e) ? lg[e] * inv : mine;
        if (lane < 16) AFF[(size_t)row * 16 + lane] = mine;
    }
}

__device__ __forceinline__ void topk_item(const float* aff  , int n, int k, int row0  , int e, int slot0,
                                          int* TOK, float* GATE, int* INV, LAS unsigned char* lds) {
    const int tid = opaque_tid(), lane = tid & 63, w = tid >> 6;
    LAS unsigned* keys = (LAS unsigned*)lds;
    LAS unsigned* hist = keys + 8192;
    LAS unsigned* misc = hist + 256;
    for (int i = tid; i < n; i += NTHREADS) keys[i] = __builtin_bit_cast(unsigned, aff[(size_t)i * 16]);
    if (tid == 0) { misc[0] = 0u; misc[1] = (unsigned)k; }
    __syncthreads();
    unsigned maskv = 0u;
    for (int pass = 0; pass < 4; ++pass) {
        const int shift = 24 - 8 * pass;
        if (tid < 256) hist[tid] = 0u;
        __syncthreads();
        const unsigned prefix = misc[0];
        for (int i = tid; i < n; i += NTHREADS) { const unsigned kv = keys[i]; if ((kv & maskv) == prefix) atomicAdd((unsigned*)&hist[(kv >> shift) & 255u], 1u); }
        __syncthreads();
        if (tid == 0) { unsigned rem = misc[1], cum = 0u; int bin = 255;
            for (; bin > 0; --bin) { const unsigned hc = hist[bin]; if (cum + hc >= rem) break; cum += hc; }
            misc[0] = prefix | ((unsigned)bin << shift); misc[1] = rem - cum; }
        __syncthreads();
        maskv |= 255u << shift;
    }
    const unsigned T = misc[0], need_eq = misc[1];
    __syncthreads();
    const int per = n >= NTHREADS ? n / NTHREADS : 1; const int t0 = tid * per; const bool act = t0 < n;
    unsigned ce = 0u;
    if (act) for (int i = 0; i < per; ++i) ce += (keys[t0 + i] == T) ? 1u : 0u;
    unsigned inc = ce;
#pragma unroll
    for (int o = 1; o < 64; o <<= 1) { const unsigned y = __shfl_up(inc, o); if (lane >= o) inc += y; }
    if (lane == 63) misc[16 + w] = inc;
    __syncthreads();
    unsigned base = 0u;
    for (int ww = 0; ww < w; ++ww) base += misc[16 + ww];
    unsigned eqrank = base + inc - ce;
    __syncthreads();
    unsigned cs = 0u;
    if (act) { unsigned er = eqrank; for (int i = 0; i < per; ++i) { const unsigned kv = keys[t0 + i]; if (kv > T) cs++; else if (kv == T) { if (er < need_eq) cs++; er++; } } }
    inc = cs;
#pragma unroll
    for (int o = 1; o < 64; o <<= 1) { const unsigned y = __shfl_up(inc, o); if (lane >= o) inc += y; }
    if (lane == 63) misc[16 + w] = inc;
    __syncthreads();
    base = 0u;
    for (int ww = 0; ww < w; ++ww) base += misc[16 + ww];
    unsigned pos = base + inc - cs;
    if (act) { unsigned er = eqrank; for (int i = 0; i < per; ++i) { const unsigned kv = keys[t0 + i]; bool sel = false;
            if (kv > T) sel = true; else if (kv == T) { sel = er < need_eq; er++; }
            const int row = row0 + t0 + i;
            if (sel) { const int slot = slot0 + (int)pos; TOK[slot] = row; GATE[slot] = __builtin_bit_cast(float, kv); INV[(size_t)row * 16 + e] = slot; pos++; }
            else INV[(size_t)row * 16 + e] = -1; } }
    __syncthreads();
}
__device__ __forceinline__ void phase_topk(const Params& p, bool with_ctx, LAS unsigned char* lds, int bid, int nb) {
    const float* AFF = (const float*)(p.ws + WS_AFF); int* TOK = (int*)(p.ws + WS_TOK); float* GATE = (float*)(p.ws + WS_GATE); int* INV = (int*)(p.ws + WS_INV);
    const int nitems = with_ctx ? 128 : 64;
    for (int it = bid; it < nitems; it += nb) {
        if (it < 64) { const int b = it >> 4, e = it & 15; topk_item(AFF + (size_t)b * SEQ * 16 + e, SEQ, CAP, b * SEQ, e, (b * NE + e) * CAP, TOK, GATE, INV, lds); }
        else { const int b = (it - 64) >> 4, e = it & 15; topk_item(AFF + ((size_t)NLAT + (size_t)b * CTXL) * 16 + e, CTXL, CCAP, NLAT + b * CTXL, e, NSLOT_LAT + (e * NB + b) * CCAP, TOK, GATE, INV, lds); }
    }
}

__device__ __forceinline__ void phase_combine(const Params& p, int l, bool with_ctx, int bid, int nb) {
    bid = opaque_s(bid); const int tid = opaque_tid(); const int lane = tid & 63, gw = bid * NWAVES + (tid >> 6), NGW = nb * NWAVES;
    float* XR = p.out; float* CXR = (float*)(p.ws + WS_CXR); bf16_t* HB = (bf16_t*)(p.ws + WS_HB);
    const bf16_t* Y = (const bf16_t*)(p.ws + WS_Y); const int* INV = (const int*)(p.ws + WS_INV);
    const float* g = p.ln2_g + l * DM; const float* bb = p.ln2_b + l * DM;
    const int nrows = with_ctx ? NROWS : NLAT;
    for (int row = gw; row < nrows; row += NGW) {
        float* xr = row < NLAT ? XR + (size_t)row * DM : CXR + (size_t)(row - NLAT) * DM;
        f32x4 v[4]; row_load(xr, lane, v);
        f32x4 a[4];
#pragma unroll
        for (int j = 0; j < 4; ++j) a[j] = (f32x4){0.f, 0.f, 0.f, 0.f};
        const int myinv = INV[(size_t)row * 16 + (lane & 15)];
        for (int e = 0; e < 16; ++e) {
            const int slot = __shfl(myinv, e);
            if (slot >= 0) { const bf16_t* yr = Y + (size_t)slot * DM;
#pragma unroll
                for (int j = 0; j < 4; ++j) { const u32x2 wv = *(const u32x2*)(yr + 256 * j + 4 * lane); a[j][0] += bf_lo(wv.x); a[j][1] += bf_hi(wv.x); a[j][2] += bf_lo(wv.y); a[j][3] += bf_hi(wv.y); } }
        }
        const float* m = mod_ptr(p, l, row_modrow(row)) + 5 * DM;
#pragma unroll
        for (int j = 0; j < 4; ++j) { const f32x4 g2 = *(const f32x4*)(m + 256 * j + 4 * lane); v[j] = v[j] * ALPHA + g2 * a[j]; }
        row_normalize(v); row_affine(v, g, bb, lane); row_store(xr, lane, v);
        if (l + 1 < DEPTH) { row_normalize(v); const float* m2 = mod_ptr(p, l + 1, row_modrow(row)); row_modulate(v, m2, m2 + DM, lane); row_store_bf16(HB + (size_t)row * DM, lane, v); }
    }
}

constexpr int N_PHASES = 2 + 8 * DEPTH;
#define IN(k) (lo <= (k) && (k) < hi)
#define SEAM(k) do { if (IN(k) && IN((k) + 1)) xcd_barrier(bar); } while (0)
#ifndef PHMASK
#define PHMASK 0x3ff
#endif
#define PHON(i) ((PHMASK >> (i)) & 1)
template <int l>
__device__ __forceinline__ void run_layer(const Params& p, LAS unsigned char* lds, LAS int* idxl, const XcdBarrier& bar, int bid, int nb, int lo, int hi) {
    bf16_t* HB = (bf16_t*)(p.ws + WS_HB); bf16_t* PB = (bf16_t*)(p.ws + WS_PB); bf16_t* OB = (bf16_t*)(p.ws + WS_OB);
    bf16_t* HH = (bf16_t*)(p.ws + WS_HH); bf16_t* Y = (bf16_t*)(p.ws + WS_Y);
    const int* TOK = (const int*)(p.ws + WS_TOK); const float* GATE = (const float*)(p.ws + WS_GATE);
        const int pb = 2 + 8 * l; const bool wc = (l == 0);
        if (IN(pb + 0)) { if (PHON(2)) {
            const bf16_t* W = (const bf16_t*)(p.ws + WS_WIN) + (size_t)l * INW * DM; EpiQKV E{PB, (const float*)(p.ws + WS_ROPE)};
            { SgDesc g{HB + (size_t)NLAT * DM, DM, nullptr, W, 0, 1 << 30, 1, NCTX, INW, DM, NLAT}; sg_gemm(g, E, bid, nb); }
            { mg::Gemm g{HB, W, NLAT, INW, DM, nullptr, 0, 1 << 20, 1}; mg::StaticOrder S; S.init(NLAT, INW, nb, bid); mg::EpiAdapt<EpiQKV> EA{E, 0}; mg::gemm_phase(lds, idxl, g, S, EA); } } }
        SEAM(pb + 0);
        if (IN(pb + 1)) { if (PHON(3)) phase_mixers(p, l, wc, bid, nb); }
        SEAM(pb + 1);
        if (IN(pb + 2)) { if (PHON(4)) {
            const bf16_t* W = (const bf16_t*)(p.ws + WS_WOUT) + (size_t)l * DM * DM;
            EpiOut E{l == 0 ? p.x : p.out, p.ctx, p.out, (float*)(p.ws + WS_CXR), mod_ptr(p, l, 0)};
            if (wc) { SgDesc g{OB + (size_t)NLAT * DM, DM, nullptr, W, 0, 1 << 30, 1, NCTX, DM, DM, NLAT}; sg_gemm(g, E, bid, nb); }
            { mg::Gemm g{OB, W, NLAT, DM, DM, nullptr, 0, 1 << 20, 1}; mg::StaticOrder S; S.init(NLAT, DM, nb, bid); mg::EpiAdapt<EpiOut> EA{E, 0}; mg::gemm_phase(lds, idxl, g, S, EA); } } }
        SEAM(pb + 2);
        if (IN(pb + 3)) { if (PHON(5)) phase_ln_router(p, l, wc, lds, bid, nb); }
        SEAM(pb + 3);
        if (IN(pb + 4)) { if (PHON(6)) phase_topk(p, wc, lds, bid, nb); }
        SEAM(pb + 4);
        if (IN(pb + 5)) { if (PHON(7)) {
            const bf16_t* W = (const bf16_t*)(p.ws + WS_WGU) + (size_t)l * NE * 1024 * DM; EpiGU E{HH};
            if (wc) { SgDesc g{HB, DM, TOK + NSLOT_LAT, W, (size_t)1024 * DM, NB * CCAP, NE, NSLOT_CTX, 1024, DM, NSLOT_LAT}; sg_gemm(g, E, bid, nb); }
            { mg::Gemm g{HB, W, NSLOT_LAT, 1024, DM, TOK, (size_t)1024 * DM, CAP / 256, NE}; mg::StaticOrder S; S.init(NSLOT_LAT, 1024, nb, bid); mg::EpiAdapt<EpiGU> EA{E, 0}; mg::gemm_phase(lds, idxl, g, S, EA); } } }
        SEAM(pb + 5);
        if (IN(pb + 6)) { if (PHON(8)) {
            const bf16_t* W = (const bf16_t*)(p.ws + WS_WD) + (size_t)l * NE * DM * FF; EpiDown E{Y, GATE};
            if (wc) { SgDesc g{HH + (size_t)NSLOT_LAT * FF, FF, nullptr, W, (size_t)DM * FF, NB * CCAP, NE, NSLOT_CTX, DM, FF, NSLOT_LAT}; sg_gemm(g, E, bid, nb); }
            { mg::Gemm g{HH, W, NSLOT_LAT, DM, FF, nullptr, (size_t)DM * FF, CAP / 256, NE}; mg::StaticOrder S; S.init(NSLOT_LAT, DM, nb, bid); mg::EpiAdapt<EpiDown> EA{E, 0}; mg::gemm_phase(lds, idxl, g, S, EA); } } }
        SEAM(pb + 6);
        if (IN(pb + 7)) { if (PHON(9)) phase_combine(p, l, wc, bid, nb); }
        SEAM(pb + 7);
}
__global__ void __launch_bounds__(NTHREADS, 2) fwd_kernel(Params p) {
    extern __shared__ __attribute__((aligned(16))) unsigned char lds_raw[];
    LAS unsigned char* lds = (LAS unsigned char*)lds_raw;
    const int bid = blockIdx.x, nb = gridDim.x;
    volatile LAS unsigned* MISC = (volatile LAS unsigned*)(lds + LDS_BYTES - 64);
    LAS int* idxl = (LAS int*)(lds + mg::STAGE_BYTES);
    if (threadIdx.x < 16) MISC[threadIdx.x] = 0u;
    __syncthreads();
    XcdBarrier bar; bar.bar = (unsigned*)(p.ws + WS_CTL) + CW_BAR; bar.x = 0; bar.st = nullptr;
    const bool multi = p.ph_hi - p.ph_lo > 1;
    if (multi) bar = xcd_barrier_post((unsigned*)(p.ws + WS_CTL) + CW_BAR, MISC + 8);
    bf16_t* HB = (bf16_t*)(p.ws + WS_HB); bf16_t* PB = (bf16_t*)(p.ws + WS_PB); bf16_t* OB = (bf16_t*)(p.ws + WS_OB);
    bf16_t* HH = (bf16_t*)(p.ws + WS_HH); bf16_t* Y = (bf16_t*)(p.ws + WS_Y);
    const int* TOK = (const int*)(p.ws + WS_TOK); const float* GATE = (const float*)(p.ws + WS_GATE);
    const int lo = p.ph_lo, hi = p.ph_hi;
    if (IN(0)) { if (PHON(0)) phase_prologue(p, lds, bid, nb); } SEAM(0);
    if (IN(1)) { if (PHON(1)) phase_ln1(p, bid, nb); } SEAM(1);
    run_layer<0>(p, lds, idxl, bar, bid, nb, lo, hi);
    run_layer<1>(p, lds, idxl, bar, bid, nb, lo, hi);
#undef IN
#undef SEAM
}

#ifndef N_LAUNCH_SPLIT
#define N_LAUNCH_SPLIT 0
#endif
extern "C" void kernel_launch(void* const* d_in, const int* in_sizes, int n_in, void* d_out, int out_size, void* d_ws, size_t ws_size, hipStream_t stream) {
    static int grid = 0;
    if (grid == 0) {
        if (n_in != 19 || in_sizes[0] != NLAT * DM || out_size != NLAT * DM || ws_size < WS_END) { fprintf(stderr, "kernel_launch: unexpected shapes (n_in %d, in0 %d, out %d, ws %zu)\n", n_in, n_in > 0 ? in_sizes[0] : -1, out_size, ws_size); grid = -1; return; }
        int dev = 0, cus = 0, per_cu = 0;
        if (hipGetDevice(&dev) != hipSuccess || hipDeviceGetAttribute(&cus, hipDeviceAttributeMultiprocessorCount, dev) != hipSuccess) { grid = -1; return; }
        if (hipFuncSetAttribute((const void*)fwd_kernel, hipFuncAttributeMaxDynamicSharedMemorySize, LDS_BYTES) != hipSuccess) { fprintf(stderr, "kernel_launch: hipFuncSetAttribute failed\n"); grid = -1; return; }
        if (hipOccupancyMaxActiveBlocksPerMultiprocessor(&per_cu, (const void*)fwd_kernel, NTHREADS, LDS_BYTES) != hipSuccess || per_cu < 1) { fprintf(stderr, "kernel_launch: occupancy query says %d\n", per_cu); per_cu = 1; }
        (void)hipGetLastError();
        grid = cus;
    }
    if (grid < 0) return;
    (void)hipMemsetAsync((char*)d_ws + WS_CTL, 0, CTL_ZERO_BYTES, stream);
    Params p{};
    const float** pp = (const float**)&p;
    for (int i = 0; i < 19; ++i) pp[i] = (const float*)d_in[i];
    p.out = (float*)d_out; p.ws = (unsigned char*)d_ws;
#if N_LAUNCH_SPLIT
    for (int ph = 0; ph < N_PHASES; ++ph) { p.ph_lo = ph; p.ph_hi = ph + 1; hipLaunchKernelGGL(fwd_kernel, dim3(grid), dim3(NTHREADS), LDS_BYTES, stream, p); }
#else
    p.ph_lo = 0; p.ph_hi = N_PHASES;
    void* args[] = {&p};
    hipError_t e = hipLaunchCooperativeKernel((const void*)fwd_kernel, dim3(grid), dim3(NTHREADS), args, LDS_BYTES, stream);
    if (e != hipSuccess) fprintf(stderr, "kernel_launch: cooperative launch failed: %s\n", hipGetErrorString(e));
#endif
}
```

```cpp
#include <hip/hip_runtime.h>
#include <hip/hip_cooperative_groups.h>
#include <cstdio>
#include <cstdint>
#include <cmath>

#define LAS __attribute__((address_space(3)))
typedef unsigned short bf16_t;
typedef short bf16x8 __attribute__((ext_vector_type(8)));
typedef float f32x4 __attribute__((ext_vector_type(4)));
typedef unsigned u32x4 __attribute__((ext_vector_type(4)));
typedef unsigned u32x2 __attribute__((ext_vector_type(2)));

constexpr int NB = 4, SEQ = 8192, DM = 1024, CTXL = 256, DEPTH = 2;
constexpr int NLAT = NB * SEQ, NCTX = NB * CTXL, NROWS = NLAT + NCTX;
constexpr int INW = 2560, NE = 16, FF = 512, CAP = 1024, CCAP = 32;
constexpr int NSLOT_LAT = NB * NE * CAP, NSLOT_CTX = NB * NE * CCAP, NSLOT = NSLOT_LAT + NSLOT_CTX;
constexpr int NMOD = 6 * DM;
constexpr float LN_EPS = 1e-6f;
constexpr float ALPHA = 1.41421356237309515f;
constexpr int C_QA = 0, C_KA = 384, C_VA = 512, C_BX = 640, C_BB = 896, C_BC = 1152, C_QN = 1408, C_KN = 1792, C_VN = 2176;

#ifndef FAST_ATTN
#define FAST_ATTN 1
#endif
constexpr int NTHREADS = 512, NWAVES = 8;
constexpr int LDS_BYTES = 147456;

constexpr size_t MiB = 1u << 20;
constexpr size_t WS_CTL = 0, CTL_ZERO_BYTES = 1 * MiB;
constexpr size_t WS_ROPE = 1 * MiB;
constexpr size_t WS_MOD = 1 * MiB + 65536;
constexpr size_t WS_AFF = 2 * MiB;
constexpr size_t WS_INV = 5 * MiB;
constexpr size_t WS_TOK = 8 * MiB;
constexpr size_t WS_GATE = 8 * MiB + 512 * 1024;
constexpr size_t WS_CXR = 9 * MiB;
constexpr size_t WS_WIN = 16 * MiB;
constexpr size_t WS_WOUT = 26 * MiB;
constexpr size_t WS_WGU = 30 * MiB;
constexpr size_t WS_WD = 94 * MiB;
constexpr size_t WS_HB = 126 * MiB;
constexpr size_t WS_OB = 192 * MiB;
constexpr size_t WS_HH = 192 * MiB;
constexpr size_t WS_PB = 258 * MiB;
constexpr size_t WS_Y = 258 * MiB;
constexpr size_t WS_END = 423 * MiB;
static_assert(WS_HB + (size_t)NROWS * DM * 2 <= WS_OB && WS_OB + (size_t)NROWS * DM * 2 <= WS_PB && WS_PB + (size_t)NROWS * INW * 2 <= WS_END, "ws map");
static_assert((size_t)NSLOT * FF * 2 <= (size_t)NROWS * DM * 2 && (size_t)NSLOT * DM * 2 <= (size_t)NROWS * INW * 2, "overlays");
constexpr int CW_BAR = 4096;

struct Params {
    const float *x, *c, *ctx, *c_ctx, *w_mod, *b_mod, *w_in, *conv_w, *attn_sink, *na_rpb, *w_out, *ln1_g, *ln1_b, *w_router, *w_gate, *w_up, *w_down, *ln2_g, *ln2_b;
    float* out; unsigned char* ws;
    int ph_lo, ph_hi;
};

__device__ __forceinline__ unsigned f2bf(float f) { unsigned u = __builtin_bit_cast(unsigned, f); return (u + 0x7fffu + ((u >> 16) & 1u)) >> 16; }
__device__ __forceinline__ unsigned pk2(float lo, float hi) { return f2bf(lo) | (f2bf(hi) << 16); }
__device__ __forceinline__ float bf_lo(unsigned w) { return __builtin_bit_cast(float, w << 16); }
__device__ __forceinline__ float bf_hi(unsigned w) { return __builtin_bit_cast(float, w & 0xffff0000u); }
__device__ __forceinline__ float wave_sum(float v) {
#pragma unroll
    for (int o = 32; o >= 1; o >>= 1) v += __shfl_xor(v, o);
    return v;
}
#define LDS_WAIT() asm volatile("s_waitcnt lgkmcnt(0)" ::: "memory")
__device__ __forceinline__ int opaque_tid() { int t = threadIdx.x; asm volatile("" : "+v"(t)); return t; }
__device__ __forceinline__ int opaque_s(int v) { asm volatile("" : "+s"(v)); return v; }

__device__ __forceinline__ float* mod_ptr(const Params& p, int l, int r) { return (float*)(p.ws + WS_MOD) + ((size_t)l * 5 + r) * NMOD; }

#define XB_TMO      128
#define XB_XCNT(j)  (256  + 64 * (j))
#define XB_XSUB(j)  (1280 + 64 * (j))
#define XB_XGEN(j)  (2304 + 64 * (j))
#define XB_TOP      3328
#define XB_TOPGEN   3392
#define XCD_BAR_WORDS 3456
#define XB_SPIN_CAP (1u << 20)
__device__ __forceinline__ unsigned xb_ld(unsigned* p)              { return __hip_atomic_load(p, __ATOMIC_RELAXED, __HIP_MEMORY_SCOPE_AGENT); }
__device__ __forceinline__ unsigned xb_add(unsigned* p, unsigned v) { return __hip_atomic_fetch_add(p, v, __ATOMIC_RELAXED, __HIP_MEMORY_SCOPE_AGENT); }
__device__ __forceinline__ unsigned xb_xcc_id() { return (unsigned)__builtin_amdgcn_s_getreg((3 << 11) | 20) & 0xFu; }
#define XB_SPIN(cond, bar) do { unsigned _sp = 0; while (cond) { __builtin_amdgcn_s_sleep(1); \
    if ((++_sp & 255u) == 0u) { if (xb_ld(&(bar)[XB_TMO])) break; if (_sp > XB_SPIN_CAP) { atomicAdd(&(bar)[XB_TMO], 1u); break; } } } } while (0)
struct XcdBarrier { unsigned* bar; unsigned x; volatile LAS unsigned* st; };
__device__ __forceinline__ XcdBarrier xcd_barrier_post(unsigned* bar, volatile LAS unsigned* st) {
    XcdBarrier b; b.bar = bar; b.x = xb_xcc_id(); b.st = st;
    if (threadIdx.x == 0) (void)xb_add(&bar[XB_XCNT(b.x)], 1u);
    return b;
}
__device__ __forceinline__ void xcd_barrier_complete(unsigned* bar, unsigned x, unsigned& nloc, unsigned& nx) {
    const unsigned G = gridDim.x * gridDim.y * gridDim.z;
    unsigned sum, cnt, mine, sp = 0u;
    for (;;) {
        sum = 0u; cnt = 0u; mine = 0u;
#pragma unroll 1
        for (unsigned j = 0; j < 16; ++j) { const unsigned c = xb_ld(&bar[XB_XCNT(j)]); sum += c; cnt += (c > 0u) ? 1u : 0u; mine = (j == x) ? c : mine; }
        if (sum == G) break;
        __builtin_amdgcn_s_sleep(1);
        if ((++sp & 255u) == 0u) { if (xb_ld(&bar[XB_TMO])) break; if (sp > XB_SPIN_CAP) { atomicAdd(&bar[XB_TMO], 1u); break; } }
    }
    nloc = mine > 0u ? mine : 1u; nx = cnt > 0u ? cnt : 1u;
}
__device__ __forceinline__ void xcd_barrier(const XcdBarrier& b) {
    asm volatile("s_waitcnt vmcnt(0)" ::: "memory");
    __syncthreads();
    if (threadIdx.x == 0) {
        unsigned* bar = b.bar; asm volatile("" : "+s"(bar));
        __builtin_amdgcn_s_waitcnt(0);
        unsigned nloc = b.st[0], nx = b.st[1];
        if (nloc == 0u) { xcd_barrier_complete(bar, b.x, nloc, nx); b.st[0] = nloc; b.st[1] = nx; }
        const unsigned old = xb_add(&bar[XB_XSUB(b.x)], 1u);
        const unsigned gen = old / nloc;
        if (old + 1u == (gen + 1u) * nloc) {
            __builtin_amdgcn_fence(__ATOMIC_RELEASE, "agent");
            asm volatile("s_waitcnt vmcnt(0)" ::: "memory");
            const unsigned og = xb_add(&bar[XB_TOP], 1u);
            const unsigned tg = og / nx;
            if (og + 1u == (tg + 1u) * nx) xb_add(&bar[XB_TOPGEN], 1u);
            else XB_SPIN(xb_ld(&bar[XB_TOPGEN]) == tg, bar);
            __builtin_amdgcn_fence(__ATOMIC_ACQUIRE, "agent");
            xb_add(&bar[XB_XGEN(b.x)], 1u);
            asm volatile("s_waitcnt vmcnt(0)" ::: "memory");
        } else {
            XB_SPIN(xb_ld(&bar[XB_XGEN(b.x)]) == gen, bar);
            __builtin_amdgcn_fence(__ATOMIC_ACQUIRE, "agent");
            asm volatile("s_waitcnt vmcnt(0)" ::: "memory");
        }
    }
    __syncthreads();
}

__device__ __forceinline__ void transpose_item(const float* W, int K, int N, bf16_t* WT, int mode, LAS float* scr, int item, int lane) {
    const int nblk = N / 32, kb = item / nblk, nb = item % nblk, k0 = 64 * kb, n0 = 32 * nb;
#pragma unroll 8
    for (int i = 0; i < 32; ++i) { const int kk = 2 * i + (lane >> 5); scr[kk * 33 + (lane & 31)] = W[(size_t)(k0 + kk) * N + n0 + (lane & 31)]; }
    LDS_WAIT();
    const int c = lane & 7;
#pragma unroll
    for (int j = 0; j < 4; ++j) {
        const int n = (lane >> 3) + 8 * j; const LAS float* s = scr + (8 * c) * 33 + n;
        u32x4 o; o.x = pk2(s[0 * 33], s[1 * 33]); o.y = pk2(s[2 * 33], s[3 * 33]); o.z = pk2(s[4 * 33], s[5 * 33]); o.w = pk2(s[6 * 33], s[7 * 33]);
        const int f = n0 + n; const int orow = mode == 0 ? f : (32 * (f >> 4) + (f & 15) + (mode == 2 ? 16 : 0));
        *(u32x4*)(WT + (size_t)orow * K + k0 + 8 * c) = o;
    }
    LDS_WAIT();
}

__device__ __forceinline__ void phase_prologue(const Params& p, LAS unsigned char* lds, int bid, int nb) {
    bid = opaque_s(bid); const int tid = opaque_tid(), lane = tid & 63, w = tid >> 6;
    {
        LAS float* ssil = (LAS float*)lds;
        LAS float* red = ssil + 5 * 1024;
        for (int i = tid; i < 5 * 1024; i += NTHREADS) { const int r = i >> 10, k = i & 1023; const float v = r < 4 ? p.c[r * 1024 + k] : p.c_ctx[k]; ssil[i] = v / (1.f + expf(-v)); }
        __syncthreads();
        for (int item = bid; item < 2 * 96; item += nb) {
            const int l = item / 96, n0 = (item % 96) * 64;
            const float* W = p.w_mod + (size_t)l * DM * NMOD + n0 + lane;
            float a0 = 0.f, a1 = 0.f, a2 = 0.f, a3 = 0.f, a4 = 0.f;
#pragma unroll 8
            for (int k = w * 128; k < w * 128 + 128; ++k) {
                const float wv = W[(size_t)k * NMOD];
                a0 += ssil[k] * wv; a1 += ssil[1024 + k] * wv; a2 += ssil[2048 + k] * wv; a3 += ssil[3072 + k] * wv; a4 += ssil[4096 + k] * wv;
            }
            red[(w * 5 + 0) * 64 + lane] = a0; red[(w * 5 + 1) * 64 + lane] = a1; red[(w * 5 + 2) * 64 + lane] = a2; red[(w * 5 + 3) * 64 + lane] = a3; red[(w * 5 + 4) * 64 + lane] = a4;
            __syncthreads();
            if (tid < 320) { const int r = tid >> 6; float s = 0.f;
#pragma unroll
                for (int ww = 0; ww < 8; ++ww) s += red[(ww * 5 + r) * 64 + lane];
                mod_ptr(p, l, r)[n0 + lane] = s + p.b_mod[l * NMOD + n0 + lane]; }
            __syncthreads();
        }
    }
    if (bid == nb - 1) {
        float* rope = (float*)(p.ws + WS_ROPE);
        for (int e = tid; e < 128 * 16; e += NTHREADS) {
            const int pos = e >> 4, i = e & 15;
            const double a = exp(-((double)i / 16.0) * 9.210340371976184);
            const double a2 = a * a; double c = 1.0, s = a, tc = 1.0, ts = a;
            for (int n = 1; n <= 14; ++n) { tc *= -a2 / (double)((2 * n - 1) * (2 * n)); c += tc; ts *= -a2 / (double)((2 * n) * (2 * n + 1)); s += ts; }
            double rc = 1.0, rs = 0.0, bc = c, bs = s; int q = pos;
            while (q) { if (q & 1) { const double t = rc * bc - rs * bs; rs = rc * bs + rs * bc; rc = t; } const double t = bc * bc - bs * bs; bs = 2.0 * bc * bs; bc = t; q >>= 1; }
            rope[2 * e] = (float)rc; rope[2 * e + 1] = (float)rs;
        }
    }
    __syncthreads();
    {
        LAS float* scr = (LAS float*)lds + w * (64 * 33);
        const int gw = bid * NWAVES + w, NGW = nb * NWAVES;
        constexpr int I_IN = 16 * 80, I_OUT = 16 * 32, I_G = 16 * 16, I_D = 8 * 32;
        constexpr int PER_L = I_IN + I_OUT + 16 * (2 * I_G + I_D);
        for (int it = gw; it < 2 * PER_L; it += NGW) {
            const int l = it / PER_L; int r = it % PER_L;
            if (r < I_IN) { transpose_item(p.w_in + (size_t)l * DM * INW, DM, INW, (bf16_t*)(p.ws + WS_WIN) + (size_t)l * INW * DM, 0, scr, r, lane); continue; } r -= I_IN;
            if (r < I_OUT) { transpose_item(p.w_out + (size_t)l * DM * DM, DM, DM, (bf16_t*)(p.ws + WS_WOUT) + (size_t)l * DM * DM, 0, scr, r, lane); continue; } r -= I_OUT;
            if (r < 16 * I_G) { const int e = r / I_G; transpose_item(p.w_gate + ((size_t)l * NE + e) * DM * FF, DM, FF, (bf16_t*)(p.ws + WS_WGU) + ((size_t)l * NE + e) * 1024 * DM, 1, scr, r % I_G, lane); continue; } r -= 16 * I_G;
            if (r < 16 * I_G) { const int e = r / I_G; transpose_item(p.w_up + ((size_t)l * NE + e) * DM * FF, DM, FF, (bf16_t*)(p.ws + WS_WGU) + ((size_t)l * NE + e) * 1024 * DM, 2, scr, r % I_G, lane); continue; } r -= 16 * I_G;
            { const int e = r / I_D; transpose_item(p.w_down + ((size_t)l * NE + e) * FF * DM, FF, DM, (bf16_t*)(p.ws + WS_WD) + ((size_t)l * NE + e) * DM * FF, 0, scr, r % I_D, lane); }
        }
    }
}

__device__ __forceinline__ void row_load(const float* rowp, int lane, f32x4 (&v)[4]) {
#pragma unroll
    for (int j = 0; j < 4; ++j) v[j] = *(const f32x4*)(rowp + 256 * j + 4 * lane);
}
__device__ __forceinline__ void row_store(float* rowp, int lane, const f32x4 (&v)[4]) {
#pragma unroll
    for (int j = 0; j < 4; ++j) *(f32x4*)(rowp + 256 * j + 4 * lane) = v[j];
}
__device__ __forceinline__ void row_store_bf16(bf16_t* rowp, int lane, const f32x4 (&v)[4]) {
#pragma unroll
    for (int j = 0; j < 4; ++j) { u32x2 o; o.x = pk2(v[j][0], v[j][1]); o.y = pk2(v[j][2], v[j][3]); *(u32x2*)(rowp + 256 * j + 4 * lane) = o; }
}
__device__ __forceinline__ void row_normalize(f32x4 (&v)[4]) {
    float s = 0.f;
#pragma unroll
    for (int j = 0; j < 4; ++j) s += (v[j][0] + v[j][1]) + (v[j][2] + v[j][3]);
    const float mean = wave_sum(s) * (1.f / DM);
    float q = 0.f;
#pragma unroll
    for (int j = 0; j < 4; ++j) { v[j] = v[j] - mean; q += (v[j][0] * v[j][0] + v[j][1] * v[j][1]) + (v[j][2] * v[j][2] + v[j][3] * v[j][3]); }
    const float rstd = 1.f / sqrtf(wave_sum(q) * (1.f / DM) + LN_EPS);
#pragma unroll
    for (int j = 0; j < 4; ++j) v[j] = v[j] * rstd;
}
__device__ __forceinline__ void row_modulate(f32x4 (&v)[4], const float* sh, const float* sc, int lane) {
#pragma unroll
    for (int j = 0; j < 4; ++j) { const f32x4 a = *(const f32x4*)(sc + 256 * j + 4 * lane), b = *(const f32x4*)(sh + 256 * j + 4 * lane); v[j] = v[j] * (a + 1.f) + b; }
}
__device__ __forceinline__ void row_affine(f32x4 (&v)[4], const float* g, const float* bb, int lane) {
#pragma unroll
    for (int j = 0; j < 4; ++j) { const f32x4 a = *(const f32x4*)(g + 256 * j + 4 * lane), b = *(const f32x4*)(bb + 256 * j + 4 * lane); v[j] = v[j] * a + b; }
}
__device__ __forceinline__ int row_modrow(int row) { return row < NLAT ? (row >> 13) : 4; }

__device__ __forceinline__ void phase_ln1(const Params& p, int bid, int nb) {
    bid = opaque_s(bid); const int tid = opaque_tid(), lane = tid & 63, gw = bid * NWAVES + (tid >> 6), NGW = nb * NWAVES;
    bf16_t* HB = (bf16_t*)(p.ws + WS_HB);
    for (int row = gw; row < NROWS; row += NGW) {
        const float* src = row < NLAT ? p.x + (size_t)row * DM : p.ctx + (size_t)(row - NLAT) * DM;
        f32x4 v[4]; row_load(src, lane, v); row_normalize(v);
        const float* m = mod_ptr(p, 0, row_modrow(row)); row_modulate(v, m, m + DM, lane);
        row_store_bf16(HB + (size_t)row * DM, lane, v);
    }
}

struct SgDesc { const bf16_t* A; int lda; const int* rowidx; const bf16_t* Bt; size_t grp_stride; int rows_per_grp, ngrp; int M, N, K; int row_base; };
template <class Epi>
__device__ __forceinline__ void sg_gemm(const SgDesc& g, const Epi& E, int bid, int nb) {
    bid = opaque_s(bid); const int tid = opaque_tid(); const int lane = tid & 63, w = tid >> 6, fr = lane & 15, fq = lane >> 4, wm = w >> 1, wn = w & 1;
    const int tilesN = g.N / 128, tiles = (g.M / 128) * tilesN;
    for (int t = bid; t < tiles; t += nb) {
        const int tm = t / tilesN, tn = t % tilesN;
        const int row0 = tm * 128 + wm * 32, col0 = tn * 128 + wn * 64;
        const bf16_t* Bt = g.Bt + (size_t)(((tm * 128) / g.rows_per_grp) % g.ngrp) * g.grp_stride;
        const bf16_t* ap[2]; const bf16_t* bp[4];
#pragma unroll
        for (int i = 0; i < 2; ++i) { const int r = row0 + 16 * i + fr; const int ar = g.rowidx ? g.rowidx[r] : r; ap[i] = g.A + (size_t)ar * g.lda + 8 * fq; }
#pragma unroll
        for (int n = 0; n < 4; ++n) bp[n] = Bt + (size_t)(col0 + 16 * n + fr) * g.K + 8 * fq;
        f32x4 acc[2][4];
#pragma unroll
        for (int i = 0; i < 2; ++i)
#pragma unroll
            for (int n = 0; n < 4; ++n) acc[i][n] = (f32x4){0.f, 0.f, 0.f, 0.f};
#pragma unroll 2
        for (int k = 0; k < g.K; k += 32) {
            bf16x8 a[2], b[4];
#pragma unroll
            for (int i = 0; i < 2; ++i) a[i] = *(const bf16x8*)(ap[i] + k);
#pragma unroll
            for (int n = 0; n < 4; ++n) b[n] = *(const bf16x8*)(bp[n] + k);
#pragma unroll
            for (int i = 0; i < 2; ++i)
#pragma unroll
                for (int n = 0; n < 4; ++n) acc[i][n] = __builtin_amdgcn_mfma_f32_16x16x32_bf16(b[n], a[i], acc[i][n], 0, 0, 0);
        }
#pragma unroll
        for (int i = 0; i < 2; ++i)
#pragma unroll
            for (int g2 = 0; g2 < 2; ++g2) E(g.row_base + row0 + 16 * i + fr, col0 + 32 * g2, fq, acc[i][2 * g2], acc[i][2 * g2 + 1]);
    }
}

__device__ __forceinline__ void store_bf16x4(bf16_t* p, const f32x4 v) { u32x2 o; o.x = pk2(v[0], v[1]); o.y = pk2(v[2], v[3]); *(u32x2*)p = o; }

struct EpiQKV {
    bf16_t* PB; const float* rope;
    __device__ __forceinline__ void operator()(int row, int c32, int fq, f32x4 v0, f32x4 v1) const {
        if (c32 < 512 && row < NLAT) {
            const int t = row & (SEQ - 1); const int pos = (c32 & 32) ? (t & 63) : (t >> 6);
            const float* rp = rope + (pos * 16 + 4 * fq) * 2;
#pragma unroll
            for (int j = 0; j < 4; ++j) { const float cs = rp[2 * j], sn = rp[2 * j + 1], a = v0[j], b = v1[j]; v0[j] = a * cs - b * sn; v1[j] = b * cs + a * sn; }
        }
        bf16_t* o = PB + (size_t)row * INW + c32 + 4 * fq;
        store_bf16x4(o, v0); store_bf16x4(o + 16, v1);
    }
};
struct EpiOut {
    const float* xl; const float* xc; float* XR; float* CXR; const float* mod;
    __device__ __forceinline__ void operator()(int row, int c32, int fq, f32x4 v0, f32x4 v1) const {
        const int c = c32 + 4 * fq; const float* xin; float* xo; const float* g1;
        if (row < NLAT) { xin = xl + (size_t)row * DM; xo = XR + (size_t)row * DM; g1 = mod + (size_t)(row >> 13) * NMOD + 2 * DM; }
        else { const int r = row - NLAT; xin = xc + (size_t)r * DM; xo = CXR + (size_t)r * DM; g1 = mod + (size_t)4 * NMOD + 2 * DM; }
        const f32x4 x0 = *(const f32x4*)(xin + c), x1 = *(const f32x4*)(xin + c + 16), g0 = *(const f32x4*)(g1 + c), g1v = *(const f32x4*)(g1 + c + 16);
        *(f32x4*)(xo + c) = x0 * ALPHA + g0 * v0; *(f32x4*)(xo + c + 16) = x1 * ALPHA + g1v * v1;
    }
};
struct EpiGU {
    bf16_t* HH;
    __device__ __forceinline__ void operator()(int row, int c32, int fq, f32x4 v0, f32x4 v1) const {
        f32x4 h;
#pragma unroll
        for (int j = 0; j < 4; ++j) h[j] = v0[j] / (1.f + __expf(-v0[j])) * v1[j];
        store_bf16x4(HH + (size_t)row * FF + (c32 >> 1) + 4 * fq, h);
    }
};
struct EpiDown {
    bf16_t* Y; const float* gate;
    __device__ __forceinline__ void operator()(int row, int c32, int fq, f32x4 v0, f32x4 v1) const {
        const float g = gate[row]; bf16_t* o = Y + (size_t)row * DM + c32 + 4 * fq;
        store_bf16x4(o, v0 * g); store_bf16x4(o + 16, v1 * g);
    }
};


namespace mg {
constexpr int BM = 256, BK = 64, HALF = 128, HTB = HALF * BK * 2, STAGE_BYTES = 8 * HTB, NXCD = 8, WGM = 8, MAXU = 8;
__device__ __forceinline__ int lds_byte(int r, int c) { const int st = (r >> 4) * 2 + (c >> 5), rr = r & 15, cc = c & 31, ob = rr * 64 + cc * 2; return st * 1024 + (ob ^ (((ob >> 9) & 1) << 5)); }
__device__ __forceinline__ void stage_rc(int b, int& R, int& C) { const int st = b / 1024, sb = b % 1024, swz = sb ^ (((sb >> 9) & 1) << 5); R = (st >> 1) * 16 + swz / 64; C = (st & 1) * 32 + (swz % 64) / 2; }
struct Unit { int pm, pn; };
struct Gemm { const bf16_t* A; const bf16_t* Bt; int M, N, K; const int* rowidx; size_t grp_stride; int grp_tiles, ngrp; };
struct StaticOrder {
    int nM, nN, nwg, G, c;
    __device__ void init(int M, int N, int G_, int c_) { nM = M / BM; nN = N / BM; nwg = nM * nN; G = G_; c = c_; }
    __device__ bool next(int i, Unit& u) const {
        const long L = (long)i * G + c; if (L >= nwg) return false;
        int wgid = (int)L; { const int q = nwg / NXCD, r = nwg % NXCD, xcd = wgid % NXCD, off = wgid / NXCD; wgid = (xcd < r ? xcd * (q + 1) : r * (q + 1) + (xcd - r) * q) + off; }
        const int nig = WGM * nN, gid = wgid / nig, fm = gid * WGM, gsz = (nM - fm) < WGM ? (nM - fm) : WGM;
        u.pm = fm + ((wgid % nig) % gsz); u.pn = (wgid % nig) / gsz; return true;
    }
};
template <class Epi>
__device__ __forceinline__ void gemm_phase(LAS unsigned char* lds, LAS int* idxl, const Gemm g, const StaticOrder& S, const Epi& E) {
    const int tid = opaque_tid(), wid = __builtin_amdgcn_readfirstlane(tid >> 6), lane = tid & 63, wr = wid >> 2, wc = wid & 3, fr = lane & 15, fq = lane >> 4;
    const int K = g.K, nt = K / BK;
    unsigned voffB[2];
#pragma unroll
    for (int i = 0; i < 2; ++i) { int R_, C_; stage_rc(tid * 16 + i * 8192, R_, C_); voffB[i] = (unsigned)(R_ * K + C_) * 2u; }
    const size_t kstep = (size_t)(BK * 2);
    const size_t hstep = (size_t)HALF * K * 2;
    const size_t tstep = 2 * hstep;
    const unsigned ldsw = (unsigned)wid * 1024u;
    const int aoff = lds_byte(wr * 64 + fr, fq * 8), boff = lds_byte(wc * 32 + fr, fq * 8);
    Unit cur, nxt; int ui = 0;
    if (!S.next(0, cur)) return;
    if (g.rowidx) {
        for (int i = 0; i < MAXU; ++i) { Unit u; if (!S.next(i, u)) break; if (tid < 256) idxl[i * 256 + tid] = g.rowidx[u.pm * BM + tid]; }
        asm volatile("s_waitcnt vmcnt(0) lgkmcnt(0)" ::: "memory"); __builtin_amdgcn_s_barrier(); asm volatile("" ::: "memory");
    }
#define MG_AOFFS(dst, u_, ui_) do { _Pragma("unroll") for (int i_ = 0; i_ < 2; ++i_) { int R_, C_; stage_rc(tid * 16 + i_ * 8192, R_, C_); _Pragma("unroll") for (int h_ = 0; h_ < 2; ++h_) { \
        const int rr_ = g.rowidx ? idxl[(ui_) * 256 + h_ * HALF + R_] : ((u_).pm * BM + h_ * HALF + R_); dst[h_][i_] = (unsigned)(rr_ * K + C_) * 2u; } } } while (0)
#define MG_BPTR(u_) ((const char*)g.Bt + ((size_t)(((u_).pm / g.grp_tiles) % g.ngrp) * g.grp_stride) * 2 + (size_t)(u_).pn * tstep)
#define PG8_SA(b, h) (((b) * 2 + (h)) * HTB)
#define PG8_SB(b, h) ((4 + (b) * 2 + (h)) * HTB)
#define PG8_STAGE(bufoff, gbase, voff) do { _Pragma("unroll") for (int _i = 0; _i < 2; ++_i) \
        __builtin_amdgcn_global_load_lds((const unsigned*)((const char*)(gbase) + (voff)[_i]), (LAS unsigned*)(lds + (bufoff) + ldsw + _i * 8192), 16, 0, 0); } while (0)
#define PG8_LDA(dst, b, h) do { _Pragma("unroll") for (int m = 0; m < 4; ++m) _Pragma("unroll") for (int k = 0; k < 2; ++k) dst[m][k] = *(const LAS bf16x8*)(lds + PG8_SA(b, h) + aoff + m * 2048 + k * 1024); } while (0)
#define PG8_LDB(dst, b, h) do { _Pragma("unroll") for (int n = 0; n < 2; ++n) _Pragma("unroll") for (int k = 0; k < 2; ++k) dst[n][k] = *(const LAS bf16x8*)(lds + PG8_SB(b, h) + boff + n * 2048 + k * 1024); } while (0)
#define PG8_MMA(ai, bj, At, Bt) do { __builtin_amdgcn_s_setprio(1); _Pragma("unroll") for (int m = 0; m < 4; ++m) _Pragma("unroll") for (int n = 0; n < 2; ++n) _Pragma("unroll") for (int k = 0; k < 2; ++k) \
        acc[ai][bj][m][n] = __builtin_amdgcn_mfma_f32_16x16x32_bf16(Bt[n][k], At[m][k], acc[ai][bj][m][n], 0, 0, 0); __builtin_amdgcn_s_setprio(0); } while (0)
#define PG8_WAIT_V(n) asm volatile("s_waitcnt vmcnt(" #n ")" ::: "memory")
#define PG8_WAIT_L(n) asm volatile("s_waitcnt lgkmcnt(" #n ")" ::: "memory")
#define PG8_BAR __builtin_amdgcn_s_barrier()
#define PG8_SCHED __builtin_amdgcn_sched_barrier(0)
    f32x4 acc[2][2][4][2];
#pragma unroll
    for (int a = 0; a < 2; ++a)
#pragma unroll
        for (int b = 0; b < 2; ++b)
#pragma unroll
            for (int m = 0; m < 4; ++m)
#pragma unroll
                for (int n = 0; n < 2; ++n) acc[a][b][m][n] = (f32x4){0.f, 0.f, 0.f, 0.f};
    bf16x8 At[4][2], B0[2][2], B1[2][2];
    unsigned cAo[2][2], o2[2][2];
    MG_AOFFS(cAo, cur, 0);
    const char* const Abase = (const char*)g.A;
    const char* cB = MG_BPTR(cur);
    PG8_STAGE(PG8_SB(0, 0), cB, voffB); PG8_STAGE(PG8_SB(0, 1), cB + hstep, voffB); PG8_STAGE(PG8_SA(0, 0), Abase, cAo[0]); PG8_STAGE(PG8_SA(0, 1), Abase, cAo[1]);
    if (wr == 1) PG8_BAR;
    PG8_WAIT_V(2); PG8_BAR;
    PG8_STAGE(PG8_SB(1, 0), cB + kstep, voffB); PG8_STAGE(PG8_SA(1, 0), Abase + kstep, cAo[0]); PG8_STAGE(PG8_SB(1, 1), cB + hstep + kstep, voffB);
    PG8_WAIT_V(6); PG8_BAR;
    for (;;) {
        const bool has_next = S.next(ui + 1, nxt);
        const char* nB = has_next ? MG_BPTR(nxt) : cB;
        for (int t = 0; t < nt; t += 2) {
            const bool last = (t == nt - 2);
            const char* a1 = Abase + (size_t)(t + 1) * kstep;
            const char* a2 = last ? Abase : Abase + (size_t)(t + 2) * kstep; const char* b2 = last ? nB : cB + (size_t)(t + 2) * kstep;
            const char* a3 = a2 + kstep; const char* b3 = b2 + kstep;
            if (last && has_next) { MG_AOFFS(o2, nxt, ui + 1); } else {
#pragma unroll
                for (int h = 0; h < 2; ++h)
#pragma unroll
                    for (int i = 0; i < 2; ++i) o2[h][i] = cAo[h][i]; }
            PG8_LDB(B0, 0, 0); PG8_LDB(B1, 0, 1); PG8_SCHED; PG8_LDA(At, 0, 0); PG8_STAGE(PG8_SA(1, 1), a1, cAo[1]);
            PG8_WAIT_V(8); PG8_WAIT_L(0); PG8_BAR; PG8_MMA(0, 0, At, B0); PG8_MMA(0, 1, At, B1); PG8_BAR; PG8_SCHED;
            PG8_LDA(At, 0, 1); PG8_STAGE(PG8_SB(0, 0), b2, voffB); PG8_STAGE(PG8_SB(0, 1), b2 + hstep, voffB); PG8_STAGE(PG8_SA(0, 0), a2, o2[0]);
            PG8_WAIT_V(8); PG8_WAIT_L(0); PG8_BAR; PG8_MMA(1, 0, At, B0); PG8_MMA(1, 1, At, B1); PG8_BAR; PG8_SCHED;
            PG8_LDB(B0, 1, 0); PG8_LDB(B1, 1, 1); PG8_SCHED; PG8_LDA(At, 1, 0); PG8_STAGE(PG8_SA(0, 1), a2, o2[1]);
            PG8_WAIT_V(8); PG8_WAIT_L(0); PG8_BAR; PG8_MMA(0, 0, At, B0); PG8_MMA(0, 1, At, B1); PG8_BAR; PG8_SCHED;
            PG8_LDA(At, 1, 1); PG8_STAGE(PG8_SB(1, 0), b3, voffB); PG8_STAGE(PG8_SB(1, 1), b3 + hstep, voffB); PG8_STAGE(PG8_SA(1, 0), a3, o2[0]);
            PG8_WAIT_V(8); PG8_WAIT_L(0); PG8_BAR; PG8_MMA(1, 0, At, B0); PG8_MMA(1, 1, At, B1); PG8_BAR; PG8_SCHED;
        }
        if (wr == 0) PG8_BAR;
        E(acc, cur, wr, wc, fr, fq);
        if (!has_next) break;
#pragma unroll
        for (int a = 0; a < 2; ++a)
#pragma unroll
            for (int b = 0; b < 2; ++b)
#pragma unroll
                for (int m = 0; m < 4; ++m)
#pragma unroll
                    for (int n = 0; n < 2; ++n) acc[a][b][m][n] = (f32x4){0.f, 0.f, 0.f, 0.f};
        cur = nxt; cB = nB; ++ui;
#pragma unroll
        for (int h = 0; h < 2; ++h)
#pragma unroll
            for (int i = 0; i < 2; ++i) cAo[h][i] = o2[h][i];
        if (wr == 1) PG8_BAR;
    }
    PG8_WAIT_V(0);
    PG8_BAR;
#undef MG_AOFFS
#undef MG_BPTR
#undef PG8_SA
#undef PG8_SB
#undef PG8_STAGE
#undef PG8_LDA
#undef PG8_LDB
#undef PG8_MMA
#undef PG8_WAIT_V
#undef PG8_WAIT_L
#undef PG8_BAR
#undef PG8_SCHED
}
template <class EE> struct EpiAdapt {
    EE e; int row_base;
    __device__ __forceinline__ void operator()(const f32x4 (&acc)[2][2][4][2], const Unit& u, int wr, int wc, int fr, int fq) const {
#pragma unroll
        for (int ai = 0; ai < 2; ++ai)
#pragma unroll
            for (int m = 0; m < 4; ++m) { const int row = row_base + u.pm * BM + ai * HALF + wr * 64 + m * 16 + fr;
#pragma unroll
                for (int bj = 0; bj < 2; ++bj) e(row, u.pn * BM + bj * HALF + wc * 32, fq, acc[ai][bj][m][0], acc[ai][bj][m][1]);
                asm volatile("" ::: "memory"); }
    }
};
}

struct AttnState { float m, l; float o[32]; };
__device__ __forceinline__ void attn_init(AttnState& st) { st.m = -INFINITY; st.l = 0.f;
#pragma unroll
    for (int d = 0; d < 32; ++d) st.o[d] = 0.f; }
__device__ __forceinline__ void load_row32(const bf16_t* p, float (&r)[32], float scale) {
#pragma unroll
    for (int i = 0; i < 4; ++i) { const u32x4 w = *(const u32x4*)(p + 8 * i);
        r[8 * i + 0] = bf_lo(w.x) * scale; r[8 * i + 1] = bf_hi(w.x) * scale; r[8 * i + 2] = bf_lo(w.y) * scale; r[8 * i + 3] = bf_hi(w.y) * scale;
        r[8 * i + 4] = bf_lo(w.z) * scale; r[8 * i + 5] = bf_hi(w.z) * scale; r[8 * i + 6] = bf_lo(w.w) * scale; r[8 * i + 7] = bf_hi(w.w) * scale; }
}
__device__ __forceinline__ float dot_row32(const bf16_t* p, const float (&q)[32]) {
    float d0 = 0.f, d1 = 0.f;
#pragma unroll
    for (int i = 0; i < 4; ++i) { const u32x4 w = *(const u32x4*)(p + 8 * i);
        d0 += q[8 * i + 0] * bf_lo(w.x); d1 += q[8 * i + 1] * bf_hi(w.x); d0 += q[8 * i + 2] * bf_lo(w.y); d1 += q[8 * i + 3] * bf_hi(w.y);
        d0 += q[8 * i + 4] * bf_lo(w.z); d1 += q[8 * i + 5] * bf_hi(w.z); d0 += q[8 * i + 6] * bf_lo(w.w); d1 += q[8 * i + 7] * bf_hi(w.w); }
    const float d = d0 + d1;
    return d + __shfl_xor(d, 32);
}
__device__ __forceinline__ void axpy_row32(const bf16_t* p, float a, float (&o)[32]) {
#pragma unroll
    for (int i = 0; i < 4; ++i) { const u32x4 w = *(const u32x4*)(p + 8 * i);
        o[8 * i + 0] += a * bf_lo(w.x); o[8 * i + 1] += a * bf_hi(w.x); o[8 * i + 2] += a * bf_lo(w.y); o[8 * i + 3] += a * bf_hi(w.y);
        o[8 * i + 4] += a * bf_lo(w.z); o[8 * i + 5] += a * bf_hi(w.z); o[8 * i + 6] += a * bf_lo(w.w); o[8 * i + 7] += a * bf_hi(w.w); }
}
template <class ScoreFn>
__device__ __forceinline__ void attn_segment(const float (&q)[32], AttnState& st, const bf16_t* Kb, const bf16_t* Vb, int j0, int j1, ScoreFn sf) {
#pragma unroll 1
    for (int j = j0; j < j1; ++j) {
        const float s0 = sf(j, dot_row32(Kb + (size_t)j * INW, q));
        if (s0 > st.m) { const float corr = __expf(st.m - s0); st.l *= corr;
#pragma unroll
            for (int d = 0; d < 32; ++d) st.o[d] *= corr;
            st.m = s0; }
        const float p0 = (s0 == -INFINITY) ? 0.f : __expf(s0 - st.m);
        st.l += p0;
        axpy_row32(Vb + (size_t)j * INW, p0, st.o);
    }
}
__device__ __forceinline__ void attn_sink(AttnState& st, float sk) {
    if (sk > st.m) { const float corr = __expf(st.m - sk); st.l *= corr;
#pragma unroll
        for (int d = 0; d < 32; ++d) st.o[d] *= corr;
        st.m = sk; }
    st.l += __expf(sk - st.m);
}
__device__ __forceinline__ void attn_store(const AttnState& st, bf16_t* o) {
    const float inv = 1.f / st.l;
#pragma unroll
    for (int i = 0; i < 4; ++i) { u32x4 w; w.x = pk2(st.o[8 * i] * inv, st.o[8 * i + 1] * inv); w.y = pk2(st.o[8 * i + 2] * inv, st.o[8 * i + 3] * inv);
        w.z = pk2(st.o[8 * i + 4] * inv, st.o[8 * i + 5] * inv); w.w = pk2(st.o[8 * i + 6] * inv, st.o[8 * i + 7] * inv); *(u32x4*)(o + 8 * i) = w; }
}

__device__ __forceinline__ void phase_mixers(const Params& p, int l, bool with_ctx, int bid, int nb) {
    bid = opaque_s(bid); const int tid = opaque_tid(); const int lane = tid & 63, gw = bid * NWAVES + (tid >> 6), NGW = nb * NWAVES;
    const int ql = lane & 31, hf = lane >> 5;
    const bf16_t* PB = (const bf16_t*)(p.ws + WS_PB); bf16_t* OB = (bf16_t*)(p.ws + WS_OB);
    const float* sink = p.attn_sink + l * 6; const float* rpb = p.na_rpb + (size_t)l * 6 * 15 * 31;
#if !FAST_ATTN
#pragma unroll 1
    for (int it = gw; it < NB * 6 * 256; it += NGW) {
        const int chunk = it & 255, h = (it >> 8) % 6, b = it / (6 * 256), kvh = h / 3;
        const int t = chunk * 32 + ql; const size_t rowb = (size_t)b * SEQ;
        float q[32]; load_row32(PB + (rowb + t) * INW + C_QA + h * 64 + 32 * hf, q, 0.125f);
        AttnState st; attn_init(st);
        const int jlo = max(0, chunk * 32 - 128), jhi = min(SEQ, chunk * 32 + 32 + 128);
        attn_segment(q, st, PB + rowb * INW + C_KA + kvh * 64 + 32 * hf, PB + rowb * INW + C_VA + kvh * 64 + 32 * hf, jlo, jhi,
                     [&](int j, float d) { const int dt = t - j; return (dt <= 128 && dt >= -128) ? d : -INFINITY; });
        const size_t crow = (size_t)NLAT + (size_t)b * CTXL;
        attn_segment(q, st, PB + crow * INW + C_KA + kvh * 64 + 32 * hf, PB + crow * INW + C_VA + kvh * 64 + 32 * hf, 0, CTXL, [&](int, float d) { return d; });
        attn_sink(st, sink[h]);
        attn_store(st, OB + (rowb + t) * DM + h * 64 + 32 * hf);
    }
#pragma unroll 1
    for (int it = gw; it < NB * 6 * 256; it += NGW) {
        const int r = (it & 255) >> 1, ch = it & 1, h = (it >> 8) % 6, b = it / (6 * 256);
        const int cq = ch * 32 + ql; const size_t rowb = (size_t)b * SEQ; const int t = r * 64 + cq;
        float q[32]; load_row32(PB + (rowb + t) * INW + C_QN + h * 64 + 32 * hf, q, 0.125f);
        AttnState st; attn_init(st);
        const int rs = min(max(r - 4, 0), 128 - 8), cs = min(max(cq - 8, 0), 64 - 16);
        const float* bias = rpb + (size_t)h * 15 * 31;
        attn_segment(q, st, PB + (rowb + (size_t)rs * 64) * INW + C_KN + h * 64 + 32 * hf, PB + (rowb + (size_t)rs * 64) * INW + C_VN + h * 64 + 32 * hf, 0, 512,
                     [&](int j, float d) { const int ka = rs + (j >> 6), ck = j & 63; const bool ok = (ck >= cs) && (ck < cs + 16);
                                           const int ro = ka - r + 7, co = min(max(ck - cq, -15), 15) + 15; return ok ? d + bias[ro * 31 + co] : -INFINITY; });
        const size_t crow = (size_t)NLAT + (size_t)b * CTXL;
        attn_segment(q, st, PB + crow * INW + C_KN + h * 64 + 32 * hf, PB + crow * INW + C_VN + h * 64 + 32 * hf, 0, CTXL, [&](int, float d) { return d; });
        attn_store(st, OB + (rowb + t) * DM + 640 + h * 64 + 32 * hf);
    }
#endif
    {
        const float* cw = p.conv_w + (size_t)l * 3 * 256;
        const int nrows = with_ctx ? NROWS : NLAT;
        for (long e = (long)bid * NTHREADS + tid; e < (long)nrows * 32; e += (long)nb * NTHREADS) {
            const int row = (int)(e >> 5), ch = (int)(e & 31) * 8;
            const int tpos = row < NLAT ? (row & (SEQ - 1)) : ((row - NLAT) & (CTXL - 1)); const int tlen = row < NLAT ? SEQ : CTXL;
            const bf16_t* pr = PB + (size_t)row * INW;
            float u[3][8];
#pragma unroll
            for (int dlt = -1; dlt <= 1; ++dlt) {
                const bool ok = (tpos + dlt >= 0) && (tpos + dlt < tlen);
                if (ok) { const u32x4 a = *(const u32x4*)(pr + (long)dlt * INW + C_BX + ch), c = *(const u32x4*)(pr + (long)dlt * INW + C_BC + ch);
                    u[dlt + 1][0] = bf_lo(a.x) * bf_lo(c.x); u[dlt + 1][1] = bf_hi(a.x) * bf_hi(c.x); u[dlt + 1][2] = bf_lo(a.y) * bf_lo(c.y); u[dlt + 1][3] = bf_hi(a.y) * bf_hi(c.y);
                    u[dlt + 1][4] = bf_lo(a.z) * bf_lo(c.z); u[dlt + 1][5] = bf_hi(a.z) * bf_hi(c.z); u[dlt + 1][6] = bf_lo(a.w) * bf_lo(c.w); u[dlt + 1][7] = bf_hi(a.w) * bf_hi(c.w); }
                else {
#pragma unroll
                    for (int i = 0; i < 8; ++i) u[dlt + 1][i] = 0.f; }
            }
            const u32x4 gb = *(const u32x4*)(pr + C_BB + ch);
            const float g[8] = {bf_lo(gb.x), bf_hi(gb.x), bf_lo(gb.y), bf_hi(gb.y), bf_lo(gb.z), bf_hi(gb.z), bf_lo(gb.w), bf_hi(gb.w)};
            float y[8];
#pragma unroll
            for (int i = 0; i < 8; ++i) y[i] = g[i] * (u[0][i] * cw[ch + i] + u[1][i] * cw[256 + ch + i] + u[2][i] * cw[512 + ch + i]);
            u32x4 o; o.x = pk2(y[0], y[1]); o.y = pk2(y[2], y[3]); o.z = pk2(y[4], y[5]); o.w = pk2(y[6], y[7]);
            *(u32x4*)(OB + (size_t)row * DM + 384 + ch) = o;
        }
    }
#if !FAST_ATTN
    if (with_ctx) {
#pragma unroll 1
        for (int it = gw; it < 2 * NB * 6 * 8; it += NGW) {
            const int kind = it / (NB * 6 * 8), r = it % (NB * 6 * 8), chunk = r & 7, h = (r >> 3) % 6, b = r / 48;
            const size_t crow = (size_t)NLAT + (size_t)b * CTXL; const int tq = chunk * 32 + ql;
            const int qc = (kind == 0 ? C_QA + h * 64 : C_QN + h * 64) + 32 * hf, kc = (kind == 0 ? C_KA + (h / 3) * 64 : C_KN + h * 64) + 32 * hf, vc = (kind == 0 ? C_VA + (h / 3) * 64 : C_VN + h * 64) + 32 * hf;
            float q[32]; load_row32(PB + (crow + tq) * INW + qc, q, 0.125f);
            AttnState st; attn_init(st);
            attn_segment(q, st, PB + crow * INW + kc, PB + crow * INW + vc, 0, CTXL, [&](int, float d) { return d; });
            if (kind == 0) attn_sink(st, sink[h]);
            attn_store(st, OB + (crow + tq) * DM + (kind == 0 ? 0 : 640) + h * 64 + 32 * hf);
        }
    }
#endif
}

namespace fa {
typedef short v4i16_t __attribute__((ext_vector_type(4)));
typedef float f32x2_t __attribute__((ext_vector_type(2))); typedef __bf16 bf16x2_t __attribute__((ext_vector_type(2)));
__device__ __forceinline__ unsigned cvtpk(float lo, float hi) { f32x2_t v = {lo, hi}; bf16x2_t b = __builtin_convertvector(v, bf16x2_t); return __builtin_bit_cast(unsigned, b); }
constexpr float LOG2E = 1.4426950408889634f, SC = 0.125f * LOG2E;
constexpr int CHUNK_BYTES = 16384;
constexpr int BIAS_OFF = 2 * CHUNK_BYTES;
__device__ __forceinline__ int na_rs(int r) { return min(max(r - 4, 0), 128 - 8); }
template <int KIND>
__device__ __forceinline__ void attn_item(const Params& p, int l, int item, LAS unsigned char* lds, int tid) {
    constexpr bool ISA = (KIND == 0 || KIND == 2);
    constexpr int NG = ISA ? 3 : 2;
    const int lane = tid & 63, w = __builtin_amdgcn_readfirstlane(tid >> 6), fr = lane & 15, fq = lane >> 4;
    const bf16_t* PB = (const bf16_t*)(p.ws + WS_PB); bf16_t* OB = (bf16_t*)(p.ws + WS_OB);
    int b, hx, blk;
    if (KIND == 0) { b = item >> 7; hx = (item >> 6) & 1; blk = item & 63; }
    else if (KIND == 1) { b = item / 192; hx = (item >> 5) % 6; blk = item & 31; }
    else if (KIND == 2) { b = item >> 2; hx = (item >> 1) & 1; blk = item & 1; }
    else { b = item / 6; hx = item % 6; blk = 0; }
    const size_t rowb = (size_t)b * SEQ, ctxb = (size_t)NLAT + (size_t)b * CTXL;
    const int kcol = ISA ? C_KA + hx * 64 : C_KN + hx * 64, vcol = ISA ? C_VA + hx * 64 : C_VN + hx * 64;
    int nwin = 0; size_t winrow0 = 0; int winpos0 = 0, krs0 = 0;
    if (KIND == 0) { const int first = blk == 0 ? 2 : 0, last = blk == 63 ? 4 : 6; nwin = last - first; winpos0 = 128 * (blk - 1) + 64 * first; winrow0 = rowb + winpos0; }
    if (KIND == 1) { krs0 = na_rs(4 * blk); nwin = na_rs(4 * blk + 3) + 8 - krs0; winrow0 = rowb + (size_t)krs0 * 64; }
    const int nch = nwin + 4;
    size_t qrow[NG]; int gh[NG], gp0[NG];
#pragma unroll
    for (int gi = 0; gi < NG; ++gi) {
        const int G = NG * w + gi;
        if (KIND == 0) { gh[gi] = 3 * hx + (G >> 3); gp0[gi] = 128 * blk + 16 * (G & 7); qrow[gi] = rowb + gp0[gi] + fr; }
        else if (KIND == 2) { gh[gi] = 3 * hx + (G >> 3); gp0[gi] = 128 * blk + 16 * (G & 7); qrow[gi] = ctxb + gp0[gi] + fr; }
        else if (KIND == 1) { gh[gi] = hx; gp0[gi] = 16 * (G & 3); qrow[gi] = rowb + (size_t)(4 * blk + (G >> 2)) * 64 + gp0[gi] + fr; }
        else { gh[gi] = hx; gp0[gi] = 16 * G; qrow[gi] = ctxb + gp0[gi] + fr; }
    }
    const int nr = 4 * blk + (w >> 1), nrs = na_rs(nr);
    bf16x8 qf[NG][2];
#pragma unroll
    for (int gi = 0; gi < NG; ++gi)
#pragma unroll
        for (int ks = 0; ks < 2; ++ks) qf[gi][ks] = *(const bf16x8*)(PB + qrow[gi] * INW + (ISA ? C_QA : C_QN) + gh[gi] * 64 + 8 * fq + 32 * ks);
    f32x4 o[NG][4]; float m[NG], ls[NG];
#pragma unroll
    for (int gi = 0; gi < NG; ++gi) {
#pragma unroll
        for (int d = 0; d < 4; ++d) o[gi][d] = (f32x4){0.f, 0.f, 0.f, 0.f};
        if (ISA) { m[gi] = p.attn_sink[l * 6 + gh[gi]] * LOG2E; ls[gi] = fq == 0 ? 1.f : 0.f; } else { m[gi] = -1e30f; ls[gi] = 0.f; }
    }
    LAS float* biasL = (LAS float*)(lds + BIAS_OFF);
    if (KIND == 1) { const float* rp = p.na_rpb + ((size_t)l * 6 + hx) * 15 * 31; if (tid < 15 * 31) biasL[tid] = rp[tid] * LOG2E; }
    const int skey = tid >> 3, spc = tid & 7;
    const int koff = skey * 128 + ((spc ^ (skey & 7)) << 4);
    const int voff = skey * 128 + ((((spc >> 1) ^ ((skey >> 1) & 3)) << 5) | ((spc & 1) << 4));
    u32x4 kreg, vreg;
#define FA_GLOAD(ci) do { const size_t r0_ = (ci) < nwin ? winrow0 + (size_t)(ci) * 64 : ctxb + (size_t)((ci) - nwin) * 64; \
        const bf16_t* s_ = PB + (r0_ + skey) * INW + spc * 8; kreg = *(const u32x4*)(s_ + kcol); vreg = *(const u32x4*)(s_ + vcol); } while (0)
#define FA_LWRITE(buf) do { *(LAS u32x4*)(lds + (buf) * CHUNK_BYTES + koff) = kreg; *(LAS u32x4*)(lds + (buf) * CHUNK_BYTES + 8192 + voff) = vreg; } while (0)
    FA_GLOAD(0); FA_LWRITE(0);
    __syncthreads();
#pragma unroll 1
    for (int ci = 0; ci < nch; ++ci) {
        if (ci + 1 < nch) FA_GLOAD(ci + 1);
        const LAS unsigned char* Kb = lds + (ci & 1) * CHUNK_BYTES; const LAS unsigned char* Vb = Kb + 8192;
        const bool iswin = ci < nwin;
        bool chunk_rel = true;
        if (KIND == 1 && iswin) { const int kr = krs0 + ci; chunk_rel = (kr >= nrs) && (kr < nrs + 8); }
        if (chunk_rel) {
#pragma unroll
            for (int hb = 0; hb < 2; ++hb) {
                bool rel[NG], msk[NG]; bool anyrel = false;
#pragma unroll
                for (int gi = 0; gi < NG; ++gi) {
                    rel[gi] = true; msk[gi] = false;
                    if (KIND == 0 && iswin) { const int j0 = winpos0 + 64 * ci + 32 * hb, p0 = gp0[gi];
                        rel[gi] = (j0 + 31 >= p0 - 128) && (j0 <= p0 + 15 + 128); msk[gi] = !((j0 >= p0 + 15 - 128) && (j0 + 31 <= p0 + 128)); }
                    if (KIND == 1 && iswin) { const int a = gp0[gi] >> 4; rel[gi] = !((a == 0 && hb == 1) || (a == 3 && hb == 0)); msk[gi] = true; }
                    anyrel = anyrel || rel[gi];
                }
                if (!anyrel) continue;
                bf16x8 kf[2][2];
#pragma unroll
                for (int kh = 0; kh < 2; ++kh)
#pragma unroll
                    for (int ks = 0; ks < 2; ++ks) { const int key = 32 * hb + 16 * kh + fr, c = fq + 4 * ks; kf[kh][ks] = *(const LAS bf16x8*)(Kb + key * 128 + ((c ^ (key & 7)) << 4)); }
                bf16x8 vf[4];
#pragma unroll
                for (int db = 0; db < 4; ++db) {
                    v4i16_t t[2];
#pragma unroll
                    for (int tr = 0; tr < 2; ++tr) { const int key = 32 * hb + 16 * tr + 4 * fq + ((lane & 15) >> 2);
                        t[tr] = __builtin_amdgcn_ds_read_tr16_b64_v4i16((LAS v4i16_t*)(Vb + key * 128 + ((db ^ ((key >> 1) & 3)) << 5) + ((lane & 3) << 3))); }
                    vf[db] = (bf16x8){t[0][0], t[0][1], t[0][2], t[0][3], t[1][0], t[1][1], t[1][2], t[1][3]};
                }
#pragma unroll
                for (int gi = 0; gi < NG; ++gi) {
                    if (!rel[gi]) continue;
                    f32x4 s[2];
#pragma unroll
                    for (int kh = 0; kh < 2; ++kh) { s[kh] = __builtin_amdgcn_mfma_f32_16x16x32_bf16(kf[kh][0], qf[gi][0], (f32x4){0.f, 0.f, 0.f, 0.f}, 0, 0, 0);
                        s[kh] = __builtin_amdgcn_mfma_f32_16x16x32_bf16(kf[kh][1], qf[gi][1], s[kh], 0, 0, 0); }
                    if (KIND == 1 && iswin) {
                        const int cq = gp0[gi] + fr, cs = min(max(cq - 8, 0), 48), brow = (krs0 + ci - nr + 7) * 31;
#pragma unroll
                        for (int kh = 0; kh < 2; ++kh)
#pragma unroll
                            for (int r = 0; r < 4; ++r) { const int ck = 32 * hb + 16 * kh + 4 * fq + r; const bool ok = (ck >= cs) && (ck < cs + 16);
                                const float bv = biasL[brow + min(max(ck - cq + 15, 0), 30)]; s[kh][r] = ok ? s[kh][r] * SC + bv : -INFINITY; }
                    } else if (KIND == 0 && iswin && msk[gi]) {
                        const int t = gp0[gi] + fr, j0 = winpos0 + 64 * ci + 32 * hb;
#pragma unroll
                        for (int kh = 0; kh < 2; ++kh)
#pragma unroll
                            for (int r = 0; r < 4; ++r) { const int dt = t - (j0 + 16 * kh + 4 * fq + r); s[kh][r] = (dt <= 128 && dt >= -128) ? s[kh][r] * SC : -INFINITY; }
                    } else {
#pragma unroll
                        for (int kh = 0; kh < 2; ++kh) s[kh] = s[kh] * SC;
                    }
                    float tm = fmaxf(fmaxf(fmaxf(s[0][0], s[0][1]), fmaxf(s[0][2], s[0][3])), fmaxf(fmaxf(s[1][0], s[1][1]), fmaxf(s[1][2], s[1][3])));
                    tm = fmaxf(tm, __shfl_xor(tm, 16)); tm = fmaxf(tm, __shfl_xor(tm, 32));
                    if (__any(tm > m[gi])) {
                        const float mn = fmaxf(m[gi], tm), al = __builtin_amdgcn_exp2f(m[gi] - mn); m[gi] = mn; ls[gi] *= al;
#pragma unroll
                        for (int d = 0; d < 4; ++d) o[gi][d] = o[gi][d] * al;
                    }
                    float ps = 0.f;
#pragma unroll
                    for (int kh = 0; kh < 2; ++kh)
#pragma unroll
                        for (int r = 0; r < 4; ++r) { s[kh][r] = __builtin_amdgcn_exp2f(s[kh][r] - m[gi]); ps += s[kh][r]; }
                    ls[gi] += ps;
                    u32x4 pw; pw.x = cvtpk(s[0][0], s[0][1]); pw.y = cvtpk(s[0][2], s[0][3]); pw.z = cvtpk(s[1][0], s[1][1]); pw.w = cvtpk(s[1][2], s[1][3]);
                    const bf16x8 pb = __builtin_bit_cast(bf16x8, pw);
#pragma unroll
                    for (int d = 0; d < 4; ++d) o[gi][d] = __builtin_amdgcn_mfma_f32_16x16x32_bf16(vf[d], pb, o[gi][d], 0, 0, 0);
                }
            }
        }
        if (ci + 1 < nch) FA_LWRITE((ci + 1) & 1);
        __syncthreads();
    }
#undef FA_GLOAD
#undef FA_LWRITE
#pragma unroll
    for (int gi = 0; gi < NG; ++gi) {
        float lt = ls[gi]; lt += __shfl_xor(lt, 16); lt += __shfl_xor(lt, 32);
        const float inv = 1.f / lt;
        bf16_t* op = OB + qrow[gi] * DM + (ISA ? 0 : 640) + gh[gi] * 64 + 4 * fq;
#pragma unroll
        for (int d = 0; d < 4; ++d) { u32x2 ov; ov.x = cvtpk(o[gi][d][0] * inv, o[gi][d][1] * inv); ov.y = cvtpk(o[gi][d][2] * inv, o[gi][d][3] * inv); *(u32x2*)(op + 16 * d) = ov; }
    }
}
__device__ __forceinline__ void phase_attn(const Params& p, int l, bool with_ctx, LAS unsigned char* lds, int bid, int nb) {
    bid = opaque_s(bid); const int tid = opaque_tid();
    const int n0 = NB * 2 * 64, n1 = NB * 6 * 32, n2 = with_ctx ? NB * 2 * 2 : 0, n3 = with_ctx ? NB * 6 : 0;
#pragma unroll 1
    for (int it = bid; it < n0 + n1 + n2 + n3; it += nb) {
        if (it < n0) attn_item<0>(p, l, it, lds, tid);
        else if (it < n0 + n1) attn_item<1>(p, l, it - n0, lds, tid);
        else if (it < n0 + n1 + n2) attn_item<2>(p, l, it - n0 - n1, lds, tid);
        else attn_item<3>(p, l, it - n0 - n1 - n2, lds, tid);
    }
}
}

__device__ __forceinline__ void phase_ln_router(const Params& p, int l, bool with_ctx, LAS unsigned char* lds, int bid, int nb) {
    bid = opaque_s(bid); const int tid = opaque_tid(), lane = tid & 63, gw = bid * NWAVES + (tid >> 6), NGW = nb * NWAVES;
    LAS float* wr = (LAS float*)lds;
    const float* wrg = p.w_router + (size_t)l * DM * NE;
    for (int i = tid; i < DM * NE; i += NTHREADS) { const int c = i >> 4, e = i & 15; wr[e * DM + c] = wrg[i]; }
    __syncthreads();
    float* XR = p.out; float* CXR = (float*)(p.ws + WS_CXR); bf16_t* HB = (bf16_t*)(p.ws + WS_HB); float* AFF = (float*)(p.ws + WS_AFF);
    const float* g = p.ln1_g + l * DM; const float* bb = p.ln1_b + l * DM;
    const int nrows = with_ctx ? NROWS : NLAT;
    for (int row = gw; row < nrows; row += NGW) {
        float* xr = row < NLAT ? XR + (size_t)row * DM : CXR + (size_t)(row - NLAT) * DM;
        f32x4 v[4]; row_load(xr, lane, v); row_normalize(v); row_affine(v, g, bb, lane); row_store(xr, lane, v);
        row_normalize(v);
        const float* m = mod_ptr(p, l, row_modrow(row)); row_modulate(v, m + 3 * DM, m + 4 * DM, lane);
        row_store_bf16(HB + (size_t)row * DM, lane, v);
        float lg[16];
#pragma unroll
        for (int e = 0; e < 16; ++e) { float s = 0.f;
#pragma unroll
            for (int j = 0; j < 4; ++j) { const f32x4 wv = *(const LAS f32x4*)(wr + e * DM + 256 * j + 4 * lane); s += (v[j][0] * wv[0] + v[j][1] * wv[1]) + (v[j][2] * wv[2] + v[j][3] * wv[3]); }
            lg[e] = wave_sum(s);
            if ((e & 3) == 3) asm volatile("" ::: "memory"); }
        float mx = lg[0];
#pragma unroll
        for (int e = 1; e < 16; ++e) mx = fmaxf(mx, lg[e]);
        float sum = 0.f;
#pragma unroll
        for (int e = 0; e < 16; ++e) { lg[e] = expf(lg[e] - mx); sum += lg[e]; }
        const float inv = 1.f / sum; float mine = 0.f;
#pragma unroll
        for (int e = 0; e < 16; ++e) mine = (lane == e) ? lg[e] * inv : mine;
        if (lane < 16) AFF[(size_t)row * 16 + lane] = mine;
    }
}

__device__ __forceinline__ void topk_item(const float* aff  , int n, int k, int row0  , int e, int slot0,
                                          int* TOK, float* GATE, int* INV, LAS unsigned char* lds) {
    const int tid = opaque_tid(), lane = tid & 63, w = tid >> 6;
    LAS unsigned* keys = (LAS unsigned*)lds;
    LAS unsigned* hist = keys + 8192;
    LAS unsigned* misc = hist + 256;
    for (int i = tid; i < n; i += NTHREADS) keys[i] = __builtin_bit_cast(unsigned, aff[(size_t)i * 16]);
    if (tid == 0) { misc[0] = 0u; misc[1] = (unsigned)k; }
    __syncthreads();
    unsigned maskv = 0u;
    for (int pass = 0; pass < 4; ++pass) {
        const int shift = 24 - 8 * pass;
        if (tid < 256) hist[tid] = 0u;
        __syncthreads();
        const unsigned prefix = misc[0];
        for (int i = tid; i < n; i += NTHREADS) { const unsigned kv = keys[i]; if ((kv & maskv) == prefix) atomicAdd((unsigned*)&hist[(kv >> shift) & 255u], 1u); }
        __syncthreads();
        if (tid == 0) { unsigned rem = misc[1], cum = 0u; int bin = 255;
            for (; bin > 0; --bin) { const unsigned hc = hist[bin]; if (cum + hc >= rem) break; cum += hc; }
            misc[0] = prefix | ((unsigned)bin << shift); misc[1] = rem - cum; }
        __syncthreads();
        maskv |= 255u << shift;
    }
    const unsigned T = misc[0], need_eq = misc[1];
    __syncthreads();
    const int per = n >= NTHREADS ? n / NTHREADS : 1; const int t0 = tid * per; const bool act = t0 < n;
    unsigned ce = 0u;
    if (act) for (int i = 0; i < per; ++i) ce += (keys[t0 + i] == T) ? 1u : 0u;
    unsigned inc = ce;
#pragma unroll
    for (int o = 1; o < 64; o <<= 1) { const unsigned y = __shfl_up(inc, o); if (lane >= o) inc += y; }
    if (lane == 63) misc[16 + w] = inc;
    __syncthreads();
    unsigned base = 0u;
    for (int ww = 0; ww < w; ++ww) base += misc[16 + ww];
    unsigned eqrank = base + inc - ce;
    __syncthreads();
    unsigned cs = 0u;
    if (act) { unsigned er = eqrank; for (int i = 0; i < per; ++i) { const unsigned kv = keys[t0 + i]; if (kv > T) cs++; else if (kv == T) { if (er < need_eq) cs++; er++; } } }
    inc = cs;
#pragma unroll
    for (int o = 1; o < 64; o <<= 1) { const unsigned y = __shfl_up(inc, o); if (lane >= o) inc += y; }
    if (lane == 63) misc[16 + w] = inc;
    __syncthreads();
    base = 0u;
    for (int ww = 0; ww < w; ++ww) base += misc[16 + ww];
    unsigned pos = base + inc - cs;
    if (act) { unsigned er = eqrank; for (int i = 0; i < per; ++i) { const unsigned kv = keys[t0 + i]; bool sel = false;
            if (kv > T) sel = true; else if (kv == T) { sel = er < need_eq; er++; }
            const int row = row0 + t0 + i;
            if (sel) { const int slot = slot0 + (int)pos; TOK[slot] = row; GATE[slot] = __builtin_bit_cast(float, kv); INV[(size_t)row * 16 + e] = slot; pos++; }
            else INV[(size_t)row * 16 + e] = -1; } }
    __syncthreads();
}
__device__ __forceinline__ void phase_topk(const Params& p, bool with_ctx, LAS unsigned char* lds, int bid, int nb) {
    const float* AFF = (const float*)(p.ws + WS_AFF); int* TOK = (int*)(p.ws + WS_TOK); float* GATE = (float*)(p.ws + WS_GATE); int* INV = (int*)(p.ws + WS_INV);
    const int nitems = with_ctx ? 128 : 64;
    for (int it = bid; it < nitems; it += nb) {
        if (it < 64) { const int b = it >> 4, e = it & 15; topk_item(AFF + (size_t)b * SEQ * 16 + e, SEQ, CAP, b * SEQ, e, (b * NE + e) * CAP, TOK, GATE, INV, lds); }
        else { const int b = (it - 64) >> 4, e = it & 15; topk_item(AFF + ((size_t)NLAT + (size_t)b * CTXL) * 16 + e, CTXL, CCAP, NLAT + b * CTXL, e, NSLOT_LAT + (e * NB + b) * CCAP, TOK, GATE, INV, lds); }
    }
}

__device__ __forceinline__ void phase_combine(const Params& p, int l, bool with_ctx, int bid, int nb) {
    bid = opaque_s(bid); const int tid = opaque_tid(); const int lane = tid & 63, gw = bid * NWAVES + (tid >> 6), NGW = nb * NWAVES;
    float* XR = p.out; float* CXR = (float*)(p.ws + WS_CXR); bf16_t* HB = (bf16_t*)(p.ws + WS_HB);
    const bf16_t* Y = (const bf16_t*)(p.ws + WS_Y); const int* INV = (const int*)(p.ws + WS_INV);
    const float* g = p.ln2_g + l * DM; const float* bb = p.ln2_b + l * DM;
    const int nrows = with_ctx ? NROWS : NLAT;
    for (int row = gw; row < nrows; row += NGW) {
        float* xr = row < NLAT ? XR + (size_t)row * DM : CXR + (size_t)(row - NLAT) * DM;
        f32x4 v[4]; row_load(xr, lane, v);
        f32x4 a[4];
#pragma unroll
        for (int j = 0; j < 4; ++j) a[j] = (f32x4){0.f, 0.f, 0.f, 0.f};
        const int myinv = INV[(size_t)row * 16 + (lane & 15)];
        for (int e = 0; e < 16; ++e) {
            const int slot = __shfl(myinv, e);
            if (slot >= 0) { const bf16_t* yr = Y + (size_t)slot * DM;
#pragma unroll
                for (int j = 0; j < 4; ++j) { const u32x2 wv = *(const u32x2*)(yr + 256 * j + 4 * lane); a[j][0] += bf_lo(wv.x); a[j][1] += bf_hi(wv.x); a[j][2] += bf_lo(wv.y); a[j][3] += bf_hi(wv.y); } }
        }
        const float* m = mod_ptr(p, l, row_modrow(row)) + 5 * DM;
#pragma unroll
        for (int j = 0; j < 4; ++j) { const f32x4 g2 = *(const f32x4*)(m + 256 * j + 4 * lane); v[j] = v[j] * ALPHA + g2 * a[j]; }
        row_normalize(v); row_affine(v, g, bb, lane); row_store(xr, lane, v);
        if (l + 1 < DEPTH) { row_normalize(v); const float* m2 = mod_ptr(p, l + 1, row_modrow(row)); row_modulate(v, m2, m2 + DM, lane); row_store_bf16(HB + (size_t)row * DM, lane, v); }
    }
}

constexpr int N_PHASES = 2 + 8 * DEPTH;
#define IN(k) (lo <= (k) && (k) < hi)
#define SEAM(k) do { if (IN(k) && IN((k) + 1)) xcd_barrier(bar); } while (0)
#ifndef PHMASK
#define PHMASK 0x3ff
#endif
#define PHON(i) ((PHMASK >> (i)) & 1)
template <int l>
__device__ __forceinline__ void run_layer(const Params& p, LAS unsigned char* lds, LAS int* idxl, const XcdBarrier& bar, int bid, int nb, int lo, int hi) {
    bf16_t* HB = (bf16_t*)(p.ws + WS_HB); bf16_t* PB = (bf16_t*)(p.ws + WS_PB); bf16_t* OB = (bf16_t*)(p.ws + WS_OB);
    bf16_t* HH = (bf16_t*)(p.ws + WS_HH); bf16_t* Y = (bf16_t*)(p.ws + WS_Y);
    const int* TOK = (const int*)(p.ws + WS_TOK); const float* GATE = (const float*)(p.ws + WS_GATE);
        const int pb = 2 + 8 * l; const bool wc = (l == 0);
        if (IN(pb + 0)) { if (PHON(2)) {
            const bf16_t* W = (const bf16_t*)(p.ws + WS_WIN) + (size_t)l * INW * DM; EpiQKV E{PB, (const float*)(p.ws + WS_ROPE)};
            { SgDesc g{HB + (size_t)NLAT * DM, DM, nullptr, W, 0, 1 << 30, 1, NCTX, INW, DM, NLAT}; sg_gemm(g, E, bid, nb); }
            { mg::Gemm g{HB, W, NLAT, INW, DM, nullptr, 0, 1 << 20, 1}; mg::StaticOrder S; S.init(NLAT, INW, nb, bid); mg::EpiAdapt<EpiQKV> EA{E, 0}; mg::gemm_phase(lds, idxl, g, S, EA); } } }
        SEAM(pb + 0);
        if (IN(pb + 1)) { if (PHON(3)) {
#if FAST_ATTN
            fa::phase_attn(p, l, wc, lds, bid, nb);
#endif
            phase_mixers(p, l, wc, bid, nb); } }
        SEAM(pb + 1);
        if (IN(pb + 2)) { if (PHON(4)) {
            const bf16_t* W = (const bf16_t*)(p.ws + WS_WOUT) + (size_t)l * DM * DM;
            EpiOut E{l == 0 ? p.x : p.out, p.ctx, p.out, (float*)(p.ws + WS_CXR), mod_ptr(p, l, 0)};
            if (wc) { SgDesc g{OB + (size_t)NLAT * DM, DM, nullptr, W, 0, 1 << 30, 1, NCTX, DM, DM, NLAT}; sg_gemm(g, E, bid, nb); }
            { mg::Gemm g{OB, W, NLAT, DM, DM, nullptr, 0, 1 << 20, 1}; mg::StaticOrder S; S.init(NLAT, DM, nb, bid); mg::EpiAdapt<EpiOut> EA{E, 0}; mg::gemm_phase(lds, idxl, g, S, EA); } } }
        SEAM(pb + 2);
        if (IN(pb + 3)) { if (PHON(5)) phase_ln_router(p, l, wc, lds, bid, nb); }
        SEAM(pb + 3);
        if (IN(pb + 4)) { if (PHON(6)) phase_topk(p, wc, lds, bid, nb); }
        SEAM(pb + 4);
        if (IN(pb + 5)) { if (PHON(7)) {
            const bf16_t* W = (const bf16_t*)(p.ws + WS_WGU) + (size_t)l * NE * 1024 * DM; EpiGU E{HH};
            if (wc) { SgDesc g{HB, DM, TOK + NSLOT_LAT, W, (size_t)1024 * DM, NB * CCAP, NE, NSLOT_CTX, 1024, DM, NSLOT_LAT}; sg_gemm(g, E, bid, nb); }
            { mg::Gemm g{HB, W, NSLOT_LAT, 1024, DM, TOK, (size_t)1024 * DM, CAP / 256, NE}; mg::StaticOrder S; S.init(NSLOT_LAT, 1024, nb, bid); mg::EpiAdapt<EpiGU> EA{E, 0}; mg::gemm_phase(lds, idxl, g, S, EA); } } }
        SEAM(pb + 5);
        if (IN(pb + 6)) { if (PHON(8)) {
            const bf16_t* W = (const bf16_t*)(p.ws + WS_WD) + (size_t)l * NE * DM * FF; EpiDown E{Y, GATE};
            if (wc) { SgDesc g{HH + (size_t)NSLOT_LAT * FF, FF, nullptr, W, (size_t)DM * FF, NB * CCAP, NE, NSLOT_CTX, DM, FF, NSLOT_LAT}; sg_gemm(g, E, bid, nb); }
            { mg::Gemm g{HH, W, NSLOT_LAT, DM, FF, nullptr, (size_t)DM * FF, CAP / 256, NE}; mg::StaticOrder S; S.init(NSLOT_LAT, DM, nb, bid); mg::EpiAdapt<EpiDown> EA{E, 0}; mg::gemm_phase(lds, idxl, g, S, EA); } } }
        SEAM(pb + 6);
        if (IN(pb + 7)) { if (PHON(9)) phase_combine(p, l, wc, bid, nb); }
        SEAM(pb + 7);
}
__global__ void __launch_bounds__(NTHREADS, 2) fwd_kernel(Params p) {
    extern __shared__ __attribute__((aligned(16))) unsigned char lds_raw[];
    LAS unsigned char* lds = (LAS unsigned char*)lds_raw;
    const int bid = blockIdx.x, nb = gridDim.x;
    volatile LAS unsigned* MISC = (volatile LAS unsigned*)(lds + LDS_BYTES - 64);
    LAS int* idxl = (LAS int*)(lds + mg::STAGE_BYTES);
    if (threadIdx.x < 16) MISC[threadIdx.x] = 0u;
    __syncthreads();
    XcdBarrier bar; bar.bar = (unsigned*)(p.ws + WS_CTL) + CW_BAR; bar.x = 0; bar.st = nullptr;
    const bool multi = p.ph_hi - p.ph_lo > 1;
    if (multi) bar = xcd_barrier_post((unsigned*)(p.ws + WS_CTL) + CW_BAR, MISC + 8);
    bf16_t* HB = (bf16_t*)(p.ws + WS_HB); bf16_t* PB = (bf16_t*)(p.ws + WS_PB); bf16_t* OB = (bf16_t*)(p.ws + WS_OB);
    bf16_t* HH = (bf16_t*)(p.ws + WS_HH); bf16_t* Y = (bf16_t*)(p.ws + WS_Y);
    const int* TOK = (const int*)(p.ws + WS_TOK); const float* GATE = (const float*)(p.ws + WS_GATE);
    const int lo = p.ph_lo, hi = p.ph_hi;
    if (IN(0)) { if (PHON(0)) phase_prologue(p, lds, bid, nb); } SEAM(0);
    if (IN(1)) { if (PHON(1)) phase_ln1(p, bid, nb); } SEAM(1);
    run_layer<0>(p, lds, idxl, bar, bid, nb, lo, hi);
    run_layer<1>(p, lds, idxl, bar, bid, nb, lo, hi);
#undef IN
#undef SEAM
}

#ifndef N_LAUNCH_SPLIT
#define N_LAUNCH_SPLIT 0
#endif
extern "C" void kernel_launch(void* const* d_in, const int* in_sizes, int n_in, void* d_out, int out_size, void* d_ws, size_t ws_size, hipStream_t stream) {
    static int grid = 0;
    if (grid == 0) {
        if (n_in != 19 || in_sizes[0] != NLAT * DM || out_size != NLAT * DM || ws_size < WS_END) { fprintf(stderr, "kernel_launch: unexpected shapes (n_in %d, in0 %d, out %d, ws %zu)\n", n_in, n_in > 0 ? in_sizes[0] : -1, out_size, ws_size); grid = -1; return; }
        int dev = 0, cus = 0, per_cu = 0;
        if (hipGetDevice(&dev) != hipSuccess || hipDeviceGetAttribute(&cus, hipDeviceAttributeMultiprocessorCount, dev) != hipSuccess) { grid = -1; return; }
        if (hipFuncSetAttribute((const void*)fwd_kernel, hipFuncAttributeMaxDynamicSharedMemorySize, LDS_BYTES) != hipSuccess) { fprintf(stderr, "kernel_launch: hipFuncSetAttribute failed\n"); grid = -1; return; }
        if (hipOccupancyMaxActiveBlocksPerMultiprocessor(&per_cu, (const void*)fwd_kernel, NTHREADS, LDS_BYTES) != hipSuccess || per_cu < 1) { fprintf(stderr, "kernel_launch: occupancy query says %d\n", per_cu); per_cu = 1; }
        (void)hipGetLastError();
        grid = cus;
    }
    if (grid < 0) return;
    (void)hipMemsetAsync((char*)d_ws + WS_CTL, 0, CTL_ZERO_BYTES, stream);
    Params p{};
    const float** pp = (const float**)&p;
    for (int i = 0; i < 19; ++i) pp[i] = (const float*)d_in[i];
    p.out = (float*)d_out; p.ws = (unsigned char*)d_ws;
#if N_LAUNCH_SPLIT
    for (int ph = 0; ph < N_PHASES; ++ph) { p.ph_lo = ph; p.ph_hi = ph + 1; hipLaunchKernelGGL(fwd_kernel, dim3(grid), dim3(NTHREADS), LDS_BYTES, stream, p); }
#else
    p.ph_lo = 0; p.ph_hi = N_PHASES;
    void* args[] = {&p};
    hipError_t e = hipLaunchCooperativeKernel((const void*)fwd_kernel, dim3(grid), dim3(NTHREADS), args, LDS_BYTES, stream);
    if (e != hipSuccess) fprintf(stderr, "kernel_launch: cooperative launch failed: %s\n", hipGetErrorString(e));
#endif
}
```

```cpp
#include <hip/hip_runtime.h>
#include <hip/hip_cooperative_groups.h>
#include <cstdio>
#include <cstdint>
#include <cmath>

#define LAS __attribute__((address_space(3)))
typedef unsigned short bf16_t;
typedef short bf16x8 __attribute__((ext_vector_type(8)));
typedef float f32x4 __attribute__((ext_vector_type(4)));
typedef unsigned u32x4 __attribute__((ext_vector_type(4)));
typedef unsigned u32x2 __attribute__((ext_vector_type(2)));

constexpr int NB = 4, SEQ = 8192, DM = 1024, CTXL = 256, DEPTH = 2;
constexpr int NLAT = NB * SEQ, NCTX = NB * CTXL, NROWS = NLAT + NCTX;
constexpr int INW = 2560, NE = 16, FF = 512, CAP = 1024, CCAP = 32;
constexpr int NSLOT_LAT = NB * NE * CAP, NSLOT_CTX = NB * NE * CCAP, NSLOT = NSLOT_LAT + NSLOT_CTX;
constexpr int NMOD = 6 * DM;
constexpr float LN_EPS = 1e-6f;
constexpr float ALPHA = 1.41421356237309515f;
constexpr int C_QA = 0, C_KA = 384, C_VA = 512, C_BX = 640, C_BB = 896, C_BC = 1152, C_QN = 1408, C_KN = 1792, C_VN = 2176;

#ifndef FAST_ATTN
#define FAST_ATTN 1
#endif
constexpr int NTHREADS = 512, NWAVES = 8;
constexpr int LDS_BYTES = 147456;

constexpr size_t MiB = 1u << 20;
constexpr size_t WS_CTL = 0, CTL_ZERO_BYTES = 1 * MiB;
constexpr size_t WS_ROPE = 1 * MiB;
constexpr size_t WS_MOD = 1 * MiB + 65536;
constexpr size_t WS_AFF = 2 * MiB;
constexpr size_t WS_INV = 5 * MiB;
constexpr size_t WS_TOK = 8 * MiB;
constexpr size_t WS_GATE = 8 * MiB + 512 * 1024;
constexpr size_t WS_CXR = 9 * MiB;
constexpr size_t WS_WIN = 16 * MiB;
constexpr size_t WS_WOUT = 26 * MiB;
constexpr size_t WS_WGU = 30 * MiB;
constexpr size_t WS_WD = 94 * MiB;
constexpr size_t WS_HB = 126 * MiB;
constexpr size_t WS_OB = 192 * MiB;
constexpr size_t WS_HH = 192 * MiB;
constexpr size_t WS_PB = 258 * MiB;
constexpr size_t WS_Y = 258 * MiB;
constexpr size_t WS_END = 423 * MiB;
static_assert(WS_HB + (size_t)NROWS * DM * 2 <= WS_OB && WS_OB + (size_t)NROWS * DM * 2 <= WS_PB && WS_PB + (size_t)NROWS * INW * 2 <= WS_END, "ws map");
static_assert((size_t)NSLOT * FF * 2 <= (size_t)NROWS * DM * 2 && (size_t)NSLOT * DM * 2 <= (size_t)NROWS * INW * 2, "overlays");
constexpr int CW_BAR = 4096;

struct Params {
    const float *x, *c, *ctx, *c_ctx, *w_mod, *b_mod, *w_in, *conv_w, *attn_sink, *na_rpb, *w_out, *ln1_g, *ln1_b, *w_router, *w_gate, *w_up, *w_down, *ln2_g, *ln2_b;
    float* out; unsigned char* ws;
    int ph_lo, ph_hi;
};

__device__ __forceinline__ unsigned f2bf(float f) { unsigned u = __builtin_bit_cast(unsigned, f); return (u + 0x7fffu + ((u >> 16) & 1u)) >> 16; }
__device__ __forceinline__ unsigned pk2(float lo, float hi) { return f2bf(lo) | (f2bf(hi) << 16); }
__device__ __forceinline__ float bf_lo(unsigned w) { return __builtin_bit_cast(float, w << 16); }
__device__ __forceinline__ float bf_hi(unsigned w) { return __builtin_bit_cast(float, w & 0xffff0000u); }
template <int CTRL> __device__ __forceinline__ float dppf(float v) { return __builtin_bit_cast(float, __builtin_amdgcn_update_dpp(0, __builtin_bit_cast(int, v), CTRL, 0xf, 0xf, true)); }
__device__ __forceinline__ void swap16(float v, float& a, float& b) { a = v; b = v; asm volatile("s_nop 1\n\tv_permlane16_swap_b32 %0, %1" : "+v"(a), "+v"(b)); }
__device__ __forceinline__ void swap32(float v, float& a, float& b) { a = v; b = v; asm volatile("s_nop 1\n\tv_permlane32_swap_b32 %0, %1" : "+v"(a), "+v"(b)); }
__device__ __forceinline__ float xor16_sum(float v) { float a, b; swap16(v, a, b); return a + b; }
__device__ __forceinline__ float xor32_sum(float v) { float a, b; swap32(v, a, b); return a + b; }
__device__ __forceinline__ float xor16_max(float v) { float a, b; swap16(v, a, b); return fmaxf(a, b); }
__device__ __forceinline__ float xor32_max(float v) { float a, b; swap32(v, a, b); return fmaxf(a, b); }
__device__ __forceinline__ float wave_sum(float v) {
    v += dppf<0xB1>(v); v += dppf<0x4E>(v); v += dppf<0x141>(v); v += dppf<0x140>(v);
    return xor32_sum(xor16_sum(v));
}
#define LDS_WAIT() asm volatile("s_waitcnt lgkmcnt(0)" ::: "memory")
__device__ __forceinline__ int opaque_tid() { int t = threadIdx.x; asm volatile("" : "+v"(t)); return t; }
__device__ __forceinline__ int opaque_s(int v) { asm volatile("" : "+s"(v)); return v; }

__device__ __forceinline__ float* mod_ptr(const Params& p, int l, int r) { return (float*)(p.ws + WS_MOD) + ((size_t)l * 5 + r) * NMOD; }

#define XB_TMO      128
#define XB_XCNT(j)  (256  + 64 * (j))
#define XB_XSUB(j)  (1280 + 64 * (j))
#define XB_XGEN(j)  (2304 + 64 * (j))
#define XB_TOP      3328
#define XB_TOPGEN   3392
#define XCD_BAR_WORDS 3456
#define XB_SPIN_CAP (1u << 20)
__device__ __forceinline__ unsigned xb_ld(unsigned* p)              { return __hip_atomic_load(p, __ATOMIC_RELAXED, __HIP_MEMORY_SCOPE_AGENT); }
__device__ __forceinline__ unsigned xb_add(unsigned* p, unsigned v) { return __hip_atomic_fetch_add(p, v, __ATOMIC_RELAXED, __HIP_MEMORY_SCOPE_AGENT); }
__device__ __forceinline__ unsigned xb_xcc_id() { return (unsigned)__builtin_amdgcn_s_getreg((3 << 11) | 20) & 0xFu; }
#define XB_SPIN(cond, bar) do { unsigned _sp = 0; while (cond) { __builtin_amdgcn_s_sleep(1); \
    if ((++_sp & 255u) == 0u) { if (xb_ld(&(bar)[XB_TMO])) break; if (_sp > XB_SPIN_CAP) { atomicAdd(&(bar)[XB_TMO], 1u); break; } } } } while (0)
struct XcdBarrier { unsigned* bar; unsigned x; volatile LAS unsigned* st; };
__device__ __forceinline__ XcdBarrier xcd_barrier_post(unsigned* bar, volatile LAS unsigned* st) {
    XcdBarrier b; b.bar = bar; b.x = xb_xcc_id(); b.st = st;
    if (threadIdx.x == 0) (void)xb_add(&bar[XB_XCNT(b.x)], 1u);
    return b;
}
__device__ __forceinline__ void xcd_barrier_complete(unsigned* bar, unsigned x, unsigned& nloc, unsigned& nx) {
    const unsigned G = gridDim.x * gridDim.y * gridDim.z;
    unsigned sum, cnt, mine, sp = 0u;
    for (;;) {
        sum = 0u; cnt = 0u; mine = 0u;
#pragma unroll 1
        for (unsigned j = 0; j < 16; ++j) { const unsigned c = xb_ld(&bar[XB_XCNT(j)]); sum += c; cnt += (c > 0u) ? 1u : 0u; mine = (j == x) ? c : mine; }
        if (sum == G) break;
        __builtin_amdgcn_s_sleep(1);
        if ((++sp & 255u) == 0u) { if (xb_ld(&bar[XB_TMO])) break; if (sp > XB_SPIN_CAP) { atomicAdd(&bar[XB_TMO], 1u); break; } }
    }
    nloc = mine > 0u ? mine : 1u; nx = cnt > 0u ? cnt : 1u;
}
__device__ __forceinline__ void xcd_barrier(const XcdBarrier& b) {
    asm volatile("s_waitcnt vmcnt(0)" ::: "memory");
    __syncthreads();
    if (threadIdx.x == 0) {
        unsigned* bar = b.bar; asm volatile("" : "+s"(bar));
        __builtin_amdgcn_s_waitcnt(0);
        unsigned nloc = b.st[0], nx = b.st[1];
        if (nloc == 0u) { xcd_barrier_complete(bar, b.x, nloc, nx); b.st[0] = nloc; b.st[1] = nx; }
        const unsigned old = xb_add(&bar[XB_XSUB(b.x)], 1u);
        const unsigned gen = old / nloc;
        if (old + 1u == (gen + 1u) * nloc) {
            __builtin_amdgcn_fence(__ATOMIC_RELEASE, "agent");
            asm volatile("s_waitcnt vmcnt(0)" ::: "memory");
            const unsigned og = xb_add(&bar[XB_TOP], 1u);
            const unsigned tg = og / nx;
            if (og + 1u == (tg + 1u) * nx) xb_add(&bar[XB_TOPGEN], 1u);
            else XB_SPIN(xb_ld(&bar[XB_TOPGEN]) == tg, bar);
            __builtin_amdgcn_fence(__ATOMIC_ACQUIRE, "agent");
            xb_add(&bar[XB_XGEN(b.x)], 1u);
            asm volatile("s_waitcnt vmcnt(0)" ::: "memory");
        } else {
            XB_SPIN(xb_ld(&bar[XB_XGEN(b.x)]) == gen, bar);
            __builtin_amdgcn_fence(__ATOMIC_ACQUIRE, "agent");
            asm volatile("s_waitcnt vmcnt(0)" ::: "memory");
        }
    }
    __syncthreads();
}

struct TrItem { const float* W; bf16_t* WT; int K, N, mode, item; };
__device__ __forceinline__ void tr_load(const TrItem& t, int lane, float (&r)[32]) {
    const int nblk = t.N / 32, kb = t.item / nblk, nb = t.item % nblk, k0 = 64 * kb, n0 = 32 * nb;
    const float* src = t.W + (size_t)(k0 + (lane >> 5)) * t.N + n0 + (lane & 31);
#pragma unroll
    for (int i = 0; i < 32; ++i) r[i] = src[(size_t)(2 * i) * t.N];
}
__device__ __forceinline__ void tr_finish(const TrItem& t, int lane, const float (&r)[32], LAS float* scr) {
    const int nblk = t.N / 32, kb = t.item / nblk, nb = t.item % nblk, k0 = 64 * kb, n0 = 32 * nb;
#pragma unroll
    for (int i = 0; i < 32; ++i) scr[(2 * i + (lane >> 5)) * 33 + (lane & 31)] = r[i];
    LDS_WAIT();
    const int c = lane & 7;
#pragma unroll
    for (int j = 0; j < 4; ++j) {
        const int n = (lane >> 3) + 8 * j; const LAS float* s = scr + (8 * c) * 33 + n;
        u32x4 o; o.x = pk2(s[0 * 33], s[1 * 33]); o.y = pk2(s[2 * 33], s[3 * 33]); o.z = pk2(s[4 * 33], s[5 * 33]); o.w = pk2(s[6 * 33], s[7 * 33]);
        const int f = n0 + n; const int orow = t.mode == 0 ? f : (32 * (f >> 4) + (f & 15) + (t.mode == 2 ? 16 : 0));
        *(u32x4*)(t.WT + (size_t)orow * t.K + k0 + 8 * c) = o;
    }
    LDS_WAIT();
}
__device__ __forceinline__ void phase_prologue(const Params& p, LAS unsigned char* lds, int bid, int nb) {
    bid = opaque_s(bid); const int tid = opaque_tid(), lane = tid & 63, w = tid >> 6;
    {
        LAS float* ssil = (LAS float*)lds;
        LAS float* red = ssil + 5 * 1024;
        for (int i = tid; i < 5 * 1024; i += NTHREADS) { const int r = i >> 10, k = i & 1023; const float v = r < 4 ? p.c[r * 1024 + k] : p.c_ctx[k]; ssil[i] = v / (1.f + expf(-v)); }
        __syncthreads();
        for (int item = bid; item < 2 * 96; item += nb) {
            const int l = item / 96, n0 = (item % 96) * 64;
            const float* W = p.w_mod + (size_t)l * DM * NMOD + n0 + lane;
            float a0 = 0.f, a1 = 0.f, a2 = 0.f, a3 = 0.f, a4 = 0.f;
#pragma unroll 8
            for (int k = w * 128; k < w * 128 + 128; ++k) {
                const float wv = W[(size_t)k * NMOD];
                a0 += ssil[k] * wv; a1 += ssil[1024 + k] * wv; a2 += ssil[2048 + k] * wv; a3 += ssil[3072 + k] * wv; a4 += ssil[4096 + k] * wv;
            }
            red[(w * 5 + 0) * 64 + lane] = a0; red[(w * 5 + 1) * 64 + lane] = a1; red[(w * 5 + 2) * 64 + lane] = a2; red[(w * 5 + 3) * 64 + lane] = a3; red[(w * 5 + 4) * 64 + lane] = a4;
            __syncthreads();
            if (tid < 320) { const int r = tid >> 6; float s = 0.f;
#pragma unroll
                for (int ww = 0; ww < 8; ++ww) s += red[(ww * 5 + r) * 64 + lane];
                mod_ptr(p, l, r)[n0 + lane] = s + p.b_mod[l * NMOD + n0 + lane]; }
            __syncthreads();
        }
    }
    if (bid == nb - 1) {
        float* rope = (float*)(p.ws + WS_ROPE);
        for (int e = tid; e < 128 * 16; e += NTHREADS) {
            const int pos = e >> 4, i = e & 15;
            const double a = exp(-((double)i / 16.0) * 9.210340371976184);
            const double a2 = a * a; double c = 1.0, s = a, tc = 1.0, ts = a;
            for (int n = 1; n <= 14; ++n) { tc *= -a2 / (double)((2 * n - 1) * (2 * n)); c += tc; ts *= -a2 / (double)((2 * n) * (2 * n + 1)); s += ts; }
            double rc = 1.0, rs = 0.0, bc = c, bs = s; int q = pos;
            while (q) { if (q & 1) { const double t = rc * bc - rs * bs; rs = rc * bs + rs * bc; rc = t; } const double t = bc * bc - bs * bs; bs = 2.0 * bc * bs; bc = t; q >>= 1; }
            rope[2 * e] = (float)rc; rope[2 * e + 1] = (float)rs;
        }
    }
    __syncthreads();
    {
        LAS float* scr = (LAS float*)lds + w * (64 * 33);
        const int gw = bid * NWAVES + w, NGW = nb * NWAVES;
        constexpr int I_IN = 16 * 80, I_OUT = 16 * 32, I_G = 16 * 16, I_D = 8 * 32;
        constexpr int PER_L = I_IN + I_OUT + 16 * (2 * I_G + I_D);
        auto decode = [&](int it) -> TrItem {
            const int l = it / PER_L; int r = it % PER_L;
            if (r < I_IN) return TrItem{p.w_in + (size_t)l * DM * INW, (bf16_t*)(p.ws + WS_WIN) + (size_t)l * INW * DM, DM, INW, 0, r}; r -= I_IN;
            if (r < I_OUT) return TrItem{p.w_out + (size_t)l * DM * DM, (bf16_t*)(p.ws + WS_WOUT) + (size_t)l * DM * DM, DM, DM, 0, r}; r -= I_OUT;
            if (r < 16 * I_G) { const int e = r / I_G; return TrItem{p.w_gate + ((size_t)l * NE + e) * DM * FF, (bf16_t*)(p.ws + WS_WGU) + ((size_t)l * NE + e) * 1024 * DM, DM, FF, 1, r % I_G}; } r -= 16 * I_G;
            if (r < 16 * I_G) { const int e = r / I_G; return TrItem{p.w_up + ((size_t)l * NE + e) * DM * FF, (bf16_t*)(p.ws + WS_WGU) + ((size_t)l * NE + e) * 1024 * DM, DM, FF, 2, r % I_G}; } r -= 16 * I_G;
            const int e = r / I_D; return TrItem{p.w_down + ((size_t)l * NE + e) * FF * DM, (bf16_t*)(p.ws + WS_WD) + ((size_t)l * NE + e) * DM * FF, FF, DM, 0, r % I_D};
        };
        float ra[32], rb[32];
        int it = gw;
        if (it < 2 * PER_L) { TrItem cur = decode(it); tr_load(cur, lane, ra);
#pragma unroll 1
            for (;;) {
                const int itn = it + NGW; const bool hn = itn < 2 * PER_L; TrItem nx = cur;
                if (hn) { nx = decode(itn); tr_load(nx, lane, rb); }
                tr_finish(cur, lane, ra, scr);
                if (!hn) break;
                const int itn2 = itn + NGW; const bool hn2 = itn2 < 2 * PER_L; TrItem nx2 = nx;
                if (hn2) { nx2 = decode(itn2); tr_load(nx2, lane, ra); }
                tr_finish(nx, lane, rb, scr);
                if (!hn2) break;
                cur = nx2; it = itn2;
            }
        }
    }
}

__device__ __forceinline__ void row_load(const float* rowp, int lane, f32x4 (&v)[4]) {
#pragma unroll
    for (int j = 0; j < 4; ++j) v[j] = *(const f32x4*)(rowp + 256 * j + 4 * lane);
}
__device__ __forceinline__ void row_store(float* rowp, int lane, const f32x4 (&v)[4]) {
#pragma unroll
    for (int j = 0; j < 4; ++j) *(f32x4*)(rowp + 256 * j + 4 * lane) = v[j];
}
__device__ __forceinline__ void row_store_bf16(bf16_t* rowp, int lane, const f32x4 (&v)[4]) {
#pragma unroll
    for (int j = 0; j < 4; ++j) { u32x2 o; o.x = pk2(v[j][0], v[j][1]); o.y = pk2(v[j][2], v[j][3]); *(u32x2*)(rowp + 256 * j + 4 * lane) = o; }
}
__device__ __forceinline__ void row_normalize(f32x4 (&v)[4]) {
    float s = 0.f;
#pragma unroll
    for (int j = 0; j < 4; ++j) s += (v[j][0] + v[j][1]) + (v[j][2] + v[j][3]);
    const float mean = wave_sum(s) * (1.f / DM);
    float q = 0.f;
#pragma unroll
    for (int j = 0; j < 4; ++j) { v[j] = v[j] - mean; q += (v[j][0] * v[j][0] + v[j][1] * v[j][1]) + (v[j][2] * v[j][2] + v[j][3] * v[j][3]); }
    const float rstd = 1.f / sqrtf(wave_sum(q) * (1.f / DM) + LN_EPS);
#pragma unroll
    for (int j = 0; j < 4; ++j) v[j] = v[j] * rstd;
}
__device__ __forceinline__ void row_modulate(f32x4 (&v)[4], const float* sh, const float* sc, int lane) {
#pragma unroll
    for (int j = 0; j < 4; ++j) { const f32x4 a = *(const f32x4*)(sc + 256 * j + 4 * lane), b = *(const f32x4*)(sh + 256 * j + 4 * lane); v[j] = v[j] * (a + 1.f) + b; }
}
__device__ __forceinline__ void row_affine(f32x4 (&v)[4], const float* g, const float* bb, int lane) {
#pragma unroll
    for (int j = 0; j < 4; ++j) { const f32x4 a = *(const f32x4*)(g + 256 * j + 4 * lane), b = *(const f32x4*)(bb + 256 * j + 4 * lane); v[j] = v[j] * a + b; }
}
__device__ __forceinline__ int row_modrow(int row) { return row < NLAT ? (row >> 13) : 4; }

__device__ __forceinline__ void phase_ln1(const Params& p, int bid, int nb) {
    bid = opaque_s(bid); const int tid = opaque_tid(), lane = tid & 63, gw = bid * NWAVES + (tid >> 6), NGW = nb * NWAVES;
    bf16_t* HB = (bf16_t*)(p.ws + WS_HB);
    f32x4 v[4], vn[4];
    if (gw < NROWS) row_load(gw < NLAT ? p.x + (size_t)gw * DM : p.ctx + (size_t)(gw - NLAT) * DM, lane, v);
#pragma unroll 1
    for (int row = gw; row < NROWS; row += NGW) {
        const int rn = row + NGW;
        if (rn < NROWS) row_load(rn < NLAT ? p.x + (size_t)rn * DM : p.ctx + (size_t)(rn - NLAT) * DM, lane, vn);
        row_normalize(v);
        const float* m = mod_ptr(p, 0, row_modrow(row)); row_modulate(v, m, m + DM, lane);
        row_store_bf16(HB + (size_t)row * DM, lane, v);
#pragma unroll
        for (int j = 0; j < 4; ++j) v[j] = vn[j];
    }
}

struct SgDesc { const bf16_t* A; int lda; const int* rowidx; const bf16_t* Bt; size_t grp_stride; int rows_per_grp, ngrp; int M, N, K; int row_base; };
template <class Epi>
__device__ __forceinline__ void sg_gemm(const SgDesc& g, const Epi& E, int bid, int nb) {
    bid = opaque_s(bid); const int tid = opaque_tid(); const int lane = tid & 63, w = __builtin_amdgcn_readfirstlane(tid >> 6), fr = lane & 15, fq = lane >> 4;
    const int tilesN = g.N / 64, tiles = (g.M / 64) * tilesN;
#pragma unroll 1
    for (int t = bid + nb * w; t < tiles; t += nb * NWAVES) {
        const int tm = t / tilesN, tn = t % tilesN;
        const int row0 = tm * 64, col0 = tn * 64;
        const bf16_t* Bt = g.Bt + (size_t)((row0 / g.rows_per_grp) % g.ngrp) * g.grp_stride;
        const bf16_t* ap[4]; const bf16_t* bp[4];
#pragma unroll
        for (int i = 0; i < 4; ++i) { const int r = row0 + 16 * i + fr; const int ar = g.rowidx ? g.rowidx[r] : r; ap[i] = g.A + (size_t)ar * g.lda + 8 * fq; }
#pragma unroll
        for (int n = 0; n < 4; ++n) bp[n] = Bt + (size_t)(col0 + 16 * n + fr) * g.K + 8 * fq;
        f32x4 acc[4][4];
#pragma unroll
        for (int i = 0; i < 4; ++i)
#pragma unroll
            for (int n = 0; n < 4; ++n) acc[i][n] = (f32x4){0.f, 0.f, 0.f, 0.f};
        bf16x8 a0[4], b0[4], a1[4], b1[4], a2[4], b2[4], a3[4], b3[4];
#define SG_LOAD(A_, B_, k_) do { _Pragma("unroll") for (int i = 0; i < 4; ++i) { A_[i] = *(const bf16x8*)(ap[i] + (k_)); B_[i] = *(const bf16x8*)(bp[i] + (k_)); } } while (0)
#define SG_MMA(A_, B_) do { _Pragma("unroll") for (int i = 0; i < 4; ++i) _Pragma("unroll") for (int n = 0; n < 4; ++n) acc[i][n] = __builtin_amdgcn_mfma_f32_16x16x32_bf16(B_[n], A_[i], acc[i][n], 0, 0, 0); } while (0)
        SG_LOAD(a0, b0, 0); SG_LOAD(a1, b1, 32); SG_LOAD(a2, b2, 64);
#pragma unroll 1
        for (int k = 0; k < g.K; k += 128) {
            SG_LOAD(a3, b3, k + 96); SG_MMA(a0, b0);
            if (k + 128 < g.K) SG_LOAD(a0, b0, k + 128);
            SG_MMA(a1, b1);
            if (k + 128 < g.K) SG_LOAD(a1, b1, k + 160);
            SG_MMA(a2, b2);
            if (k + 128 < g.K) SG_LOAD(a2, b2, k + 192);
            SG_MMA(a3, b3);
        }
#undef SG_LOAD
#undef SG_MMA
#pragma unroll
        for (int i = 0; i < 4; ++i) {
            const float rv = E.rowval(g.row_base + row0 + 16 * i + fr);
#pragma unroll
            for (int g2 = 0; g2 < 2; ++g2) E(g.row_base + row0 + 16 * i + fr, col0 + 32 * g2, fq, acc[i][2 * g2], acc[i][2 * g2 + 1], rv);
            asm volatile("" ::: "memory"); }
    }
}

__device__ __forceinline__ void store_bf16x4(bf16_t* p, const f32x4 v) { u32x2 o; o.x = pk2(v[0], v[1]); o.y = pk2(v[2], v[3]); *(u32x2*)p = o; }

struct EpiQKV {
    bf16_t* PB; const float* rope;
    __device__ __forceinline__ float rowval(int) const { return 0.f; }
    __device__ __forceinline__ void operator()(int row, int c32, int fq, f32x4 v0, f32x4 v1, float) const {
        if (c32 < 512 && row < NLAT) {
            const int t = row & (SEQ - 1); const int pos = (c32 & 32) ? (t & 63) : (t >> 6);
            const float* rp = rope + (pos * 16 + 4 * fq) * 2;
#pragma unroll
            for (int j = 0; j < 4; ++j) { const float cs = rp[2 * j], sn = rp[2 * j + 1], a = v0[j], b = v1[j]; v0[j] = a * cs - b * sn; v1[j] = b * cs + a * sn; }
        }
        bf16_t* o = PB + (size_t)row * INW + c32 + 4 * fq;
        store_bf16x4(o, v0); store_bf16x4(o + 16, v1);
    }
};
struct EpiOut {
    const float* xl; const float* xc; float* XR; float* CXR; const float* mod;
    __device__ __forceinline__ float rowval(int) const { return 0.f; }
    __device__ __forceinline__ void operator()(int row, int c32, int fq, f32x4 v0, f32x4 v1, float) const {
        const int c = c32 + 4 * fq; const float* xin; float* xo; const float* g1;
        if (row < NLAT) { xin = xl + (size_t)row * DM; xo = XR + (size_t)row * DM; g1 = mod + (size_t)(row >> 13) * NMOD + 2 * DM; }
        else { const int r = row - NLAT; xin = xc + (size_t)r * DM; xo = CXR + (size_t)r * DM; g1 = mod + (size_t)4 * NMOD + 2 * DM; }
        const f32x4 x0 = *(const f32x4*)(xin + c), x1 = *(const f32x4*)(xin + c + 16), g0 = *(const f32x4*)(g1 + c), g1v = *(const f32x4*)(g1 + c + 16);
        *(f32x4*)(xo + c) = x0 * ALPHA + g0 * v0; *(f32x4*)(xo + c + 16) = x1 * ALPHA + g1v * v1;
    }
};
struct EpiGU {
    bf16_t* HH;
    __device__ __forceinline__ float rowval(int) const { return 0.f; }
    __device__ __forceinline__ void operator()(int row, int c32, int fq, f32x4 v0, f32x4 v1, float) const {
        f32x4 h;
#pragma unroll
        for (int j = 0; j < 4; ++j) h[j] = v0[j] / (1.f + __expf(-v0[j])) * v1[j];
        store_bf16x4(HH + (size_t)row * FF + (c32 >> 1) + 4 * fq, h);
    }
};
struct EpiDown {
    bf16_t* Y; const float* gate;
    __device__ __forceinline__ float rowval(int row) const { return gate[row]; }
    __device__ __forceinline__ void operator()(int row, int c32, int fq, f32x4 v0, f32x4 v1, float g) const {
        bf16_t* o = Y + (size_t)row * DM + c32 + 4 * fq;
        store_bf16x4(o, v0 * g); store_bf16x4(o + 16, v1 * g);
    }
};


namespace mg {
constexpr int BM = 256, BK = 64, HALF = 128, HTB = HALF * BK * 2, STAGE_BYTES = 8 * HTB, NXCD = 8, WGM = 8, MAXU = 8;
__device__ __forceinline__ int lds_byte(int r, int c) { const int st = (r >> 4) * 2 + (c >> 5), rr = r & 15, cc = c & 31, ob = rr * 64 + cc * 2; return st * 1024 + (ob ^ (((ob >> 9) & 1) << 5)); }
__device__ __forceinline__ void stage_rc(int b, int& R, int& C) { const int st = b / 1024, sb = b % 1024, swz = sb ^ (((sb >> 9) & 1) << 5); R = (st >> 1) * 16 + swz / 64; C = (st & 1) * 32 + (swz % 64) / 2; }
struct Unit { int pm, pn; };
struct Gemm { const bf16_t* A; const bf16_t* Bt; int M, N, K; const int* rowidx; size_t grp_stride; int grp_tiles, ngrp; };
struct StaticOrder {
    int nM, nN, nwg, G, c;
    __device__ void init(int M, int N, int G_, int c_) { nM = M / BM; nN = N / BM; nwg = nM * nN; G = G_; c = c_; }
    __device__ bool next(int i, Unit& u) const {
        const long L = (long)i * G + c; if (L >= nwg) return false;
        int wgid = (int)L; { const int q = nwg / NXCD, r = nwg % NXCD, xcd = wgid % NXCD, off = wgid / NXCD; wgid = (xcd < r ? xcd * (q + 1) : r * (q + 1) + (xcd - r) * q) + off; }
        const int nig = WGM * nN, gid = wgid / nig, fm = gid * WGM, gsz = (nM - fm) < WGM ? (nM - fm) : WGM;
        u.pm = fm + ((wgid % nig) % gsz); u.pn = (wgid % nig) / gsz; return true;
    }
};
template <class Epi>
__device__ __forceinline__ void gemm_phase(LAS unsigned char* lds, LAS int* idxl, const Gemm g, const StaticOrder& S, const Epi& E) {
    const int tid = opaque_tid(), wid = __builtin_amdgcn_readfirstlane(tid >> 6), lane = tid & 63, wr = wid >> 2, wc = wid & 3, fr = lane & 15, fq = lane >> 4;
    const int K = g.K, nt = K / BK;
    unsigned voffB[2];
#pragma unroll
    for (int i = 0; i < 2; ++i) { int R_, C_; stage_rc(tid * 16 + i * 8192, R_, C_); voffB[i] = (unsigned)(R_ * K + C_) * 2u; }
    const size_t kstep = (size_t)(BK * 2);
    const size_t hstep = (size_t)HALF * K * 2;
    const size_t tstep = 2 * hstep;
    const unsigned ldsw = (unsigned)wid * 1024u;
    const int aoff = lds_byte(wr * 64 + fr, fq * 8), boff = lds_byte(wc * 32 + fr, fq * 8);
    Unit cur, nxt; int ui = 0;
    if (!S.next(0, cur)) return;
    if (g.rowidx) {
        for (int i = 0; i < MAXU; ++i) { Unit u; if (!S.next(i, u)) break; if (tid < 256) idxl[i * 256 + tid] = g.rowidx[u.pm * BM + tid]; }
        asm volatile("s_waitcnt vmcnt(0) lgkmcnt(0)" ::: "memory"); __builtin_amdgcn_s_barrier(); asm volatile("" ::: "memory");
    }
#define MG_AOFFS(dst, u_, ui_) do { _Pragma("unroll") for (int i_ = 0; i_ < 2; ++i_) { int R_, C_; stage_rc(tid * 16 + i_ * 8192, R_, C_); _Pragma("unroll") for (int h_ = 0; h_ < 2; ++h_) { \
        const int rr_ = g.rowidx ? idxl[(ui_) * 256 + h_ * HALF + R_] : ((u_).pm * BM + h_ * HALF + R_); dst[h_][i_] = (unsigned)(rr_ * K + C_) * 2u; } } } while (0)
#define MG_BPTR(u_) ((const char*)g.Bt + ((size_t)(((u_).pm / g.grp_tiles) % g.ngrp) * g.grp_stride) * 2 + (size_t)(u_).pn * tstep)
#define PG8_SA(b, h) (((b) * 2 + (h)) * HTB)
#define PG8_SB(b, h) ((4 + (b) * 2 + (h)) * HTB)
#define PG8_STAGE(bufoff, gbase, voff) do { _Pragma("unroll") for (int _i = 0; _i < 2; ++_i) \
        __builtin_amdgcn_global_load_lds((const unsigned*)((const char*)(gbase) + (voff)[_i]), (LAS unsigned*)(lds + (bufoff) + ldsw + _i * 8192), 16, 0, 0); } while (0)
#define PG8_LDA(dst, b, h) do { _Pragma("unroll") for (int m = 0; m < 4; ++m) _Pragma("unroll") for (int k = 0; k < 2; ++k) dst[m][k] = *(const LAS bf16x8*)(lds + PG8_SA(b, h) + aoff + m * 2048 + k * 1024); } while (0)
#define PG8_LDB(dst, b, h) do { _Pragma("unroll") for (int n = 0; n < 2; ++n) _Pragma("unroll") for (int k = 0; k < 2; ++k) dst[n][k] = *(const LAS bf16x8*)(lds + PG8_SB(b, h) + boff + n * 2048 + k * 1024); } while (0)
#define PG8_MMA(ai, bj, At, Bt) do { __builtin_amdgcn_s_setprio(1); _Pragma("unroll") for (int m = 0; m < 4; ++m) _Pragma("unroll") for (int n = 0; n < 2; ++n) _Pragma("unroll") for (int k = 0; k < 2; ++k) \
        acc[ai][bj][m][n] = __builtin_amdgcn_mfma_f32_16x16x32_bf16(Bt[n][k], At[m][k], acc[ai][bj][m][n], 0, 0, 0); __builtin_amdgcn_s_setprio(0); } while (0)
#define PG8_WAIT_V(n) asm volatile("s_waitcnt vmcnt(" #n ")" ::: "memory")
#define PG8_WAIT_L(n) asm volatile("s_waitcnt lgkmcnt(" #n ")" ::: "memory")
#define PG8_BAR __builtin_amdgcn_s_barrier()
#define PG8_SCHED __builtin_amdgcn_sched_barrier(0)
    f32x4 acc[2][2][4][2];
#pragma unroll
    for (int a = 0; a < 2; ++a)
#pragma unroll
        for (int b = 0; b < 2; ++b)
#pragma unroll
            for (int m = 0; m < 4; ++m)
#pragma unroll
                for (int n = 0; n < 2; ++n) acc[a][b][m][n] = (f32x4){0.f, 0.f, 0.f, 0.f};
    bf16x8 At[4][2], B0[2][2], B1[2][2];
    unsigned cAo[2][2], o2[2][2];
    MG_AOFFS(cAo, cur, 0);
    const char* const Abase = (const char*)g.A;
    const char* cB = MG_BPTR(cur);
    PG8_STAGE(PG8_SB(0, 0), cB, voffB); PG8_STAGE(PG8_SB(0, 1), cB + hstep, voffB); PG8_STAGE(PG8_SA(0, 0), Abase, cAo[0]); PG8_STAGE(PG8_SA(0, 1), Abase, cAo[1]);
    if (wr == 1) PG8_BAR;
    PG8_WAIT_V(2); PG8_BAR;
    PG8_STAGE(PG8_SB(1, 0), cB + kstep, voffB); PG8_STAGE(PG8_SA(1, 0), Abase + kstep, cAo[0]); PG8_STAGE(PG8_SB(1, 1), cB + hstep + kstep, voffB);
    PG8_WAIT_V(6); PG8_BAR;
    for (;;) {
        const bool has_next = S.next(ui + 1, nxt);
        const char* nB = has_next ? MG_BPTR(nxt) : cB;
        for (int t = 0; t < nt; t += 2) {
            const bool last = (t == nt - 2);
            const char* a1 = Abase + (size_t)(t + 1) * kstep;
            const char* a2 = last ? Abase : Abase + (size_t)(t + 2) * kstep; const char* b2 = last ? nB : cB + (size_t)(t + 2) * kstep;
            const char* a3 = a2 + kstep; const char* b3 = b2 + kstep;
            if (last && has_next) { MG_AOFFS(o2, nxt, ui + 1); } else {
#pragma unroll
                for (int h = 0; h < 2; ++h)
#pragma unroll
                    for (int i = 0; i < 2; ++i) o2[h][i] = cAo[h][i]; }
            PG8_LDB(B0, 0, 0); PG8_LDB(B1, 0, 1); PG8_SCHED; PG8_LDA(At, 0, 0); PG8_STAGE(PG8_SA(1, 1), a1, cAo[1]);
            PG8_WAIT_V(8); PG8_WAIT_L(0); PG8_BAR; PG8_MMA(0, 0, At, B0); PG8_MMA(0, 1, At, B1); PG8_BAR; PG8_SCHED;
            PG8_LDA(At, 0, 1); PG8_STAGE(PG8_SB(0, 0), b2, voffB); PG8_STAGE(PG8_SB(0, 1), b2 + hstep, voffB); PG8_STAGE(PG8_SA(0, 0), a2, o2[0]);
            PG8_WAIT_V(8); PG8_WAIT_L(0); PG8_BAR; PG8_MMA(1, 0, At, B0); PG8_MMA(1, 1, At, B1); PG8_BAR; PG8_SCHED;
            PG8_LDB(B0, 1, 0); PG8_LDB(B1, 1, 1); PG8_SCHED; PG8_LDA(At, 1, 0); PG8_STAGE(PG8_SA(0, 1), a2, o2[1]);
            PG8_WAIT_V(8); PG8_WAIT_L(0); PG8_BAR; PG8_MMA(0, 0, At, B0); PG8_MMA(0, 1, At, B1); PG8_BAR; PG8_SCHED;
            PG8_LDA(At, 1, 1); PG8_STAGE(PG8_SB(1, 0), b3, voffB); PG8_STAGE(PG8_SB(1, 1), b3 + hstep, voffB); PG8_STAGE(PG8_SA(1, 0), a3, o2[0]);
            PG8_WAIT_V(8); PG8_WAIT_L(0); PG8_BAR; PG8_MMA(1, 0, At, B0); PG8_MMA(1, 1, At, B1); PG8_BAR; PG8_SCHED;
        }
        if (wr == 0) PG8_BAR;
        E(acc, cur, wr, wc, fr, fq);
        if (!has_next) break;
#pragma unroll
        for (int a = 0; a < 2; ++a)
#pragma unroll
            for (int b = 0; b < 2; ++b)
#pragma unroll
                for (int m = 0; m < 4; ++m)
#pragma unroll
                    for (int n = 0; n < 2; ++n) acc[a][b][m][n] = (f32x4){0.f, 0.f, 0.f, 0.f};
        cur = nxt; cB = nB; ++ui;
#pragma unroll
        for (int h = 0; h < 2; ++h)
#pragma unroll
            for (int i = 0; i < 2; ++i) cAo[h][i] = o2[h][i];
        if (wr == 1) PG8_BAR;
    }
    PG8_WAIT_V(0);
    PG8_BAR;
#undef MG_AOFFS
#undef MG_BPTR
#undef PG8_SA
#undef PG8_SB
#undef PG8_STAGE
#undef PG8_LDA
#undef PG8_LDB
#undef PG8_MMA
#undef PG8_WAIT_V
#undef PG8_WAIT_L
#undef PG8_BAR
#undef PG8_SCHED
}
template <class EE> struct EpiAdapt {
    EE e; int row_base;
    __device__ __forceinline__ void operator()(const f32x4 (&acc)[2][2][4][2], const Unit& u, int wr, int wc, int fr, int fq) const {
        float rv[2][4];
#pragma unroll
        for (int ai = 0; ai < 2; ++ai)
#pragma unroll
            for (int m = 0; m < 4; ++m) rv[ai][m] = e.rowval(row_base + u.pm * BM + ai * HALF + wr * 64 + m * 16 + fr);
#pragma unroll
        for (int ai = 0; ai < 2; ++ai)
#pragma unroll
            for (int m = 0; m < 4; ++m) { const int row = row_base + u.pm * BM + ai * HALF + wr * 64 + m * 16 + fr;
#pragma unroll
                for (int bj = 0; bj < 2; ++bj) e(row, u.pn * BM + bj * HALF + wc * 32, fq, acc[ai][bj][m][0], acc[ai][bj][m][1], rv[ai][m]);
                if (m & 1) asm volatile("" ::: "memory"); }
    }
};
}

struct AttnState { float m, l; float o[32]; };
__device__ __forceinline__ void attn_init(AttnState& st) { st.m = -INFINITY; st.l = 0.f;
#pragma unroll
    for (int d = 0; d < 32; ++d) st.o[d] = 0.f; }
__device__ __forceinline__ void load_row32(const bf16_t* p, float (&r)[32], float scale) {
#pragma unroll
    for (int i = 0; i < 4; ++i) { const u32x4 w = *(const u32x4*)(p + 8 * i);
        r[8 * i + 0] = bf_lo(w.x) * scale; r[8 * i + 1] = bf_hi(w.x) * scale; r[8 * i + 2] = bf_lo(w.y) * scale; r[8 * i + 3] = bf_hi(w.y) * scale;
        r[8 * i + 4] = bf_lo(w.z) * scale; r[8 * i + 5] = bf_hi(w.z) * scale; r[8 * i + 6] = bf_lo(w.w) * scale; r[8 * i + 7] = bf_hi(w.w) * scale; }
}
__device__ __forceinline__ float dot_row32(const bf16_t* p, const float (&q)[32]) {
    float d0 = 0.f, d1 = 0.f;
#pragma unroll
    for (int i = 0; i < 4; ++i) { const u32x4 w = *(const u32x4*)(p + 8 * i);
        d0 += q[8 * i + 0] * bf_lo(w.x); d1 += q[8 * i + 1] * bf_hi(w.x); d0 += q[8 * i + 2] * bf_lo(w.y); d1 += q[8 * i + 3] * bf_hi(w.y);
        d0 += q[8 * i + 4] * bf_lo(w.z); d1 += q[8 * i + 5] * bf_hi(w.z); d0 += q[8 * i + 6] * bf_lo(w.w); d1 += q[8 * i + 7] * bf_hi(w.w); }
    const float d = d0 + d1;
    return d + __shfl_xor(d, 32);
}
__device__ __forceinline__ void axpy_row32(const bf16_t* p, float a, float (&o)[32]) {
#pragma unroll
    for (int i = 0; i < 4; ++i) { const u32x4 w = *(const u32x4*)(p + 8 * i);
        o[8 * i + 0] += a * bf_lo(w.x); o[8 * i + 1] += a * bf_hi(w.x); o[8 * i + 2] += a * bf_lo(w.y); o[8 * i + 3] += a * bf_hi(w.y);
        o[8 * i + 4] += a * bf_lo(w.z); o[8 * i + 5] += a * bf_hi(w.z); o[8 * i + 6] += a * bf_lo(w.w); o[8 * i + 7] += a * bf_hi(w.w); }
}
template <class ScoreFn>
__device__ __forceinline__ void attn_segment(const float (&q)[32], AttnState& st, const bf16_t* Kb, const bf16_t* Vb, int j0, int j1, ScoreFn sf) {
#pragma unroll 1
    for (int j = j0; j < j1; ++j) {
        const float s0 = sf(j, dot_row32(Kb + (size_t)j * INW, q));
        if (s0 > st.m) { const float corr = __expf(st.m - s0); st.l *= corr;
#pragma unroll
            for (int d = 0; d < 32; ++d) st.o[d] *= corr;
            st.m = s0; }
        const float p0 = (s0 == -INFINITY) ? 0.f : __expf(s0 - st.m);
        st.l += p0;
        axpy_row32(Vb + (size_t)j * INW, p0, st.o);
    }
}
__device__ __forceinline__ void attn_sink(AttnState& st, float sk) {
    if (sk > st.m) { const float corr = __expf(st.m - sk); st.l *= corr;
#pragma unroll
        for (int d = 0; d < 32; ++d) st.o[d] *= corr;
        st.m = sk; }
    st.l += __expf(sk - st.m);
}
__device__ __forceinline__ void attn_store(const AttnState& st, bf16_t* o) {
    const float inv = 1.f / st.l;
#pragma unroll
    for (int i = 0; i < 4; ++i) { u32x4 w; w.x = pk2(st.o[8 * i] * inv, st.o[8 * i + 1] * inv); w.y = pk2(st.o[8 * i + 2] * inv, st.o[8 * i + 3] * inv);
        w.z = pk2(st.o[8 * i + 4] * inv, st.o[8 * i + 5] * inv); w.w = pk2(st.o[8 * i + 6] * inv, st.o[8 * i + 7] * inv); *(u32x4*)(o + 8 * i) = w; }
}

__device__ __forceinline__ void phase_mixers(const Params& p, int l, bool with_ctx, int bid, int nb) {
    bid = opaque_s(bid); const int tid = opaque_tid(); const int lane = tid & 63, gw = bid * NWAVES + (tid >> 6), NGW = nb * NWAVES;
    const int ql = lane & 31, hf = lane >> 5;
    const bf16_t* PB = (const bf16_t*)(p.ws + WS_PB); bf16_t* OB = (bf16_t*)(p.ws + WS_OB);
    const float* sink = p.attn_sink + l * 6; const float* rpb = p.na_rpb + (size_t)l * 6 * 15 * 31;
#if !FAST_ATTN
#pragma unroll 1
    for (int it = gw; it < NB * 6 * 256; it += NGW) {
        const int chunk = it & 255, h = (it >> 8) % 6, b = it / (6 * 256), kvh = h / 3;
        const int t = chunk * 32 + ql; const size_t rowb = (size_t)b * SEQ;
        float q[32]; load_row32(PB + (rowb + t) * INW + C_QA + h * 64 + 32 * hf, q, 0.125f);
        AttnState st; attn_init(st);
        const int jlo = max(0, chunk * 32 - 128), jhi = min(SEQ, chunk * 32 + 32 + 128);
        attn_segment(q, st, PB + rowb * INW + C_KA + kvh * 64 + 32 * hf, PB + rowb * INW + C_VA + kvh * 64 + 32 * hf, jlo, jhi,
                     [&](int j, float d) { const int dt = t - j; return (dt <= 128 && dt >= -128) ? d : -INFINITY; });
        const size_t crow = (size_t)NLAT + (size_t)b * CTXL;
        attn_segment(q, st, PB + crow * INW + C_KA + kvh * 64 + 32 * hf, PB + crow * INW + C_VA + kvh * 64 + 32 * hf, 0, CTXL, [&](int, float d) { return d; });
        attn_sink(st, sink[h]);
        attn_store(st, OB + (rowb + t) * DM + h * 64 + 32 * hf);
    }
#pragma unroll 1
    for (int it = gw; it < NB * 6 * 256; it += NGW) {
        const int r = (it & 255) >> 1, ch = it & 1, h = (it >> 8) % 6, b = it / (6 * 256);
        const int cq = ch * 32 + ql; const size_t rowb = (size_t)b * SEQ; const int t = r * 64 + cq;
        float q[32]; load_row32(PB + (rowb + t) * INW + C_QN + h * 64 + 32 * hf, q, 0.125f);
        AttnState st; attn_init(st);
        const int rs = min(max(r - 4, 0), 128 - 8), cs = min(max(cq - 8, 0), 64 - 16);
        const float* bias = rpb + (size_t)h * 15 * 31;
        attn_segment(q, st, PB + (rowb + (size_t)rs * 64) * INW + C_KN + h * 64 + 32 * hf, PB + (rowb + (size_t)rs * 64) * INW + C_VN + h * 64 + 32 * hf, 0, 512,
                     [&](int j, float d) { const int ka = rs + (j >> 6), ck = j & 63; const bool ok = (ck >= cs) && (ck < cs + 16);
                                           const int ro = ka - r + 7, co = min(max(ck - cq, -15), 15) + 15; return ok ? d + bias[ro * 31 + co] : -INFINITY; });
        const size_t crow = (size_t)NLAT + (size_t)b * CTXL;
        attn_segment(q, st, PB + crow * INW + C_KN + h * 64 + 32 * hf, PB + crow * INW + C_VN + h * 64 + 32 * hf, 0, CTXL, [&](int, float d) { return d; });
        attn_store(st, OB + (rowb + t) * DM + 640 + h * 64 + 32 * hf);
    }
#endif
    {
        const float* cw = p.conv_w + (size_t)l * 3 * 256;
        const int nrows = with_ctx ? NROWS : NLAT;
        for (long e = (long)bid * NTHREADS + tid; e < (long)nrows * 32; e += (long)nb * NTHREADS) {
            const int row = (int)(e >> 5), ch = (int)(e & 31) * 8;
            const int tpos = row < NLAT ? (row & (SEQ - 1)) : ((row - NLAT) & (CTXL - 1)); const int tlen = row < NLAT ? SEQ : CTXL;
            const bf16_t* pr = PB + (size_t)row * INW;
            float u[3][8];
#pragma unroll
            for (int dlt = -1; dlt <= 1; ++dlt) {
                const bool ok = (tpos + dlt >= 0) && (tpos + dlt < tlen);
                if (ok) { const u32x4 a = *(const u32x4*)(pr + (long)dlt * INW + C_BX + ch), c = *(const u32x4*)(pr + (long)dlt * INW + C_BC + ch);
                    u[dlt + 1][0] = bf_lo(a.x) * bf_lo(c.x); u[dlt + 1][1] = bf_hi(a.x) * bf_hi(c.x); u[dlt + 1][2] = bf_lo(a.y) * bf_lo(c.y); u[dlt + 1][3] = bf_hi(a.y) * bf_hi(c.y);
                    u[dlt + 1][4] = bf_lo(a.z) * bf_lo(c.z); u[dlt + 1][5] = bf_hi(a.z) * bf_hi(c.z); u[dlt + 1][6] = bf_lo(a.w) * bf_lo(c.w); u[dlt + 1][7] = bf_hi(a.w) * bf_hi(c.w); }
                else {
#pragma unroll
                    for (int i = 0; i < 8; ++i) u[dlt + 1][i] = 0.f; }
            }
            const u32x4 gb = *(const u32x4*)(pr + C_BB + ch);
            const float g[8] = {bf_lo(gb.x), bf_hi(gb.x), bf_lo(gb.y), bf_hi(gb.y), bf_lo(gb.z), bf_hi(gb.z), bf_lo(gb.w), bf_hi(gb.w)};
            float y[8];
#pragma unroll
            for (int i = 0; i < 8; ++i) y[i] = g[i] * (u[0][i] * cw[ch + i] + u[1][i] * cw[256 + ch + i] + u[2][i] * cw[512 + ch + i]);
            u32x4 o; o.x = pk2(y[0], y[1]); o.y = pk2(y[2], y[3]); o.z = pk2(y[4], y[5]); o.w = pk2(y[6], y[7]);
            *(u32x4*)(OB + (size_t)row * DM + 384 + ch) = o;
        }
    }
#if !FAST_ATTN
    if (with_ctx) {
#pragma unroll 1
        for (int it = gw; it < 2 * NB * 6 * 8; it += NGW) {
            const int kind = it / (NB * 6 * 8), r = it % (NB * 6 * 8), chunk = r & 7, h = (r >> 3) % 6, b = r / 48;
            const size_t crow = (size_t)NLAT + (size_t)b * CTXL; const int tq = chunk * 32 + ql;
            const int qc = (kind == 0 ? C_QA + h * 64 : C_QN + h * 64) + 32 * hf, kc = (kind == 0 ? C_KA + (h / 3) * 64 : C_KN + h * 64) + 32 * hf, vc = (kind == 0 ? C_VA + (h / 3) * 64 : C_VN + h * 64) + 32 * hf;
            float q[32]; load_row32(PB + (crow + tq) * INW + qc, q, 0.125f);
            AttnState st; attn_init(st);
            attn_segment(q, st, PB + crow * INW + kc, PB + crow * INW + vc, 0, CTXL, [&](int, float d) { return d; });
            if (kind == 0) attn_sink(st, sink[h]);
            attn_store(st, OB + (crow + tq) * DM + (kind == 0 ? 0 : 640) + h * 64 + 32 * hf);
        }
    }
#endif
}

namespace fa {
typedef short v4i16_t __attribute__((ext_vector_type(4)));
typedef float f32x2_t __attribute__((ext_vector_type(2))); typedef __bf16 bf16x2_t __attribute__((ext_vector_type(2)));
__device__ __forceinline__ unsigned cvtpk(float lo, float hi) { f32x2_t v = {lo, hi}; bf16x2_t b = __builtin_convertvector(v, bf16x2_t); return __builtin_bit_cast(unsigned, b); }
constexpr float LOG2E = 1.4426950408889634f, SC = 0.125f * LOG2E;
constexpr int CHUNK_BYTES = 32768;
constexpr int BIAS_OFF = 3 * CHUNK_BYTES;
constexpr float THR = 8.f;
__device__ __forceinline__ int na_rs(int r) { return min(max(r - 4, 0), 128 - 8); }
__device__ __forceinline__ void glds16(const void* gsrc, unsigned lds_dst) { unsigned keep;
    asm volatile("s_mov_b32 %0, m0\n\ts_mov_b32 m0, %2\n\ts_nop 0\n\tglobal_load_lds_dwordx4 %1, off\n\ts_mov_b32 m0, %0" : "=&s"(keep) : "v"(gsrc), "s"(lds_dst) : "memory"); }
#define FA_WAIT_BAR(N) asm volatile("s_waitcnt vmcnt(" #N ") lgkmcnt(0)\n\ts_barrier" ::: "memory")
__device__ __forceinline__ float max3f(float a, float b, float c) { float r; asm("v_max3_f32 %0, %1, %2, %3" : "=v"(r) : "v"(a), "v"(b), "v"(c)); return r; }
__device__ __forceinline__ float max8f(const f32x4& a, const f32x4& b) { return max3f(max3f(max3f(a[0], a[1], a[2]), a[3], b[0]), max3f(b[1], b[2], b[3]), -INFINITY); }
__device__ __forceinline__ void load_kf(bf16x8 (&kf)[2][2], const LAS unsigned char* Kt, const int (&kb)[2]) {
#pragma unroll
    for (int kh = 0; kh < 2; ++kh)
#pragma unroll
        for (int ks = 0; ks < 2; ++ks) kf[kh][ks] = *(const LAS bf16x8*)(Kt + kh * 2048 + kb[ks]);
}
__device__ __forceinline__ void load_vf(bf16x8 (&vf)[4], const LAS unsigned char* Vt, const int (&vb)[4]) {
#pragma unroll
    for (int db = 0; db < 4; ++db) {
        const v4i16_t t0 = __builtin_amdgcn_ds_read_tr16_b64_v4i16((LAS v4i16_t*)(Vt + vb[db])), t1 = __builtin_amdgcn_ds_read_tr16_b64_v4i16((LAS v4i16_t*)(Vt + 2048 + vb[db]));
        vf[db] = (bf16x8){t0[0], t0[1], t0[2], t0[3], t1[0], t1[1], t1[2], t1[3]}; }
}
template <int MODE, bool LOADV>
__device__ __forceinline__ void unit_update(f32x4 (&o)[4], float& m, float& ls, const bf16x8 (&q)[2], const bf16x8 (&kf)[2][2][2], const bf16x8 (&vfs)[2][4],
                                            bool rel0, bool rel1, bool mk0, bool mk1, int tb0, int tb1, unsigned vmask, const LAS float* bp0, const LAS float* bp1,
                                            const LAS unsigned char* Vt0, const LAS unsigned char* Vt1, const int (&vb)[4]) {
    f32x4 s[2][2]; float tm = -INFINITY;
#pragma unroll
    for (int t = 0; t < 2; ++t) {
        if (!(t == 0 ? rel0 : rel1)) continue;
#pragma unroll
        for (int kh = 0; kh < 2; ++kh) { s[t][kh] = __builtin_amdgcn_mfma_f32_16x16x32_bf16(kf[t][kh][0], q[0], (f32x4){0.f, 0.f, 0.f, 0.f}, 0, 0, 0);
            s[t][kh] = __builtin_amdgcn_mfma_f32_16x16x32_bf16(kf[t][kh][1], q[1], s[t][kh], 0, 0, 0); }
        if (MODE == 1) { if (t == 0 ? mk0 : mk1) { const int tb = t == 0 ? tb0 : tb1;
#pragma unroll
                for (int kh = 0; kh < 2; ++kh)
#pragma unroll
                    for (int r = 0; r < 4; ++r) s[t][kh][r] = ((unsigned)(tb - 16 * kh - r) <= 256u) ? s[t][kh][r] : -INFINITY; } }
        if (MODE != 2) {
#pragma unroll
            for (int kh = 0; kh < 2; ++kh) s[t][kh] = s[t][kh] * SC; }
        if (MODE == 2) { const LAS float* bp = t == 0 ? bp0 : bp1;
#pragma unroll
            for (int kh = 0; kh < 2; ++kh)
#pragma unroll
                for (int r = 0; r < 4; ++r) s[t][kh][r] = (vmask & (1u << (4 * kh + r))) ? __builtin_fmaf(s[t][kh][r], SC, bp[16 * kh + r]) : -INFINITY; }
        tm = fmaxf(tm, max8f(s[t][0], s[t][1]));
    }
    tm = xor32_max(xor16_max(tm));
    if (__any(tm > m + THR)) {
        const float mn = fmaxf(m, tm), al = __builtin_amdgcn_exp2f(m - mn); m = mn; ls *= al;
#pragma unroll
        for (int d = 0; d < 4; ++d) o[d] = o[d] * al;
    }
    const float nm = -m; float ps = 0.f;
#pragma unroll
    for (int t = 0; t < 2; ++t) {
        if (!(t == 0 ? rel0 : rel1)) continue;
#pragma unroll
        for (int kh = 0; kh < 2; ++kh)
#pragma unroll
            for (int r = 0; r < 4; ++r) { s[t][kh][r] = __builtin_amdgcn_exp2f(s[t][kh][r] + nm); ps += s[t][kh][r]; }
        u32x4 pw; pw.x = cvtpk(s[t][0][0], s[t][0][1]); pw.y = cvtpk(s[t][0][2], s[t][0][3]); pw.z = cvtpk(s[t][1][0], s[t][1][1]); pw.w = cvtpk(s[t][1][2], s[t][1][3]);
        const bf16x8 pb = __builtin_bit_cast(bf16x8, pw);
        if (LOADV) { bf16x8 vl[4]; load_vf(vl, t == 0 ? Vt0 : Vt1, vb);
#pragma unroll
            for (int d = 0; d < 4; ++d) o[d] = __builtin_amdgcn_mfma_f32_16x16x32_bf16(vl[d], pb, o[d], 0, 0, 0); }
        else {
#pragma unroll
            for (int d = 0; d < 4; ++d) o[d] = __builtin_amdgcn_mfma_f32_16x16x32_bf16(vfs[t][d], pb, o[d], 0, 0, 0); }
    }
    ls += ps;
}
template <int KIND>
__device__ __forceinline__ void attn_item(const Params& p, int l, int item, LAS unsigned char* lds, int tid) {
    constexpr bool ISA = (KIND == 0 || KIND == 2);
    constexpr int NG = ISA ? 3 : 2;
    const int lane = tid & 63, w = __builtin_amdgcn_readfirstlane(tid >> 6), fr = lane & 15, fq = lane >> 4;
    const bf16_t* PB = (const bf16_t*)(p.ws + WS_PB); bf16_t* OB = (bf16_t*)(p.ws + WS_OB);
    int b, hx, blk;
    if (KIND == 0) { b = item >> 7; hx = (item >> 6) & 1; blk = item & 63; }
    else if (KIND == 1) { b = item / 192; hx = (item >> 5) % 6; blk = item & 31; }
    else if (KIND == 2) { b = item >> 2; hx = (item >> 1) & 1; blk = item & 1; }
    else { b = item / 6; hx = item % 6; blk = 0; }
    const size_t rowb = (size_t)b * SEQ, ctxb = (size_t)NLAT + (size_t)b * CTXL;
    const int kcol = ISA ? C_KA + hx * 64 : C_KN + hx * 64, vcol = ISA ? C_VA + hx * 64 : C_VN + hx * 64;
    int nwin = 0; size_t winrow0 = 0; int winpos0 = 0, krs0 = 0;
    if (KIND == 0) { const int first = blk == 0 ? 1 : 0, last = blk == 63 ? 2 : 3; nwin = last - first; winpos0 = 128 * (blk - 1 + first); winrow0 = rowb + winpos0; }
    if (KIND == 1) { krs0 = na_rs(4 * blk); nwin = (na_rs(4 * blk + 3) + 8 - krs0 + 1) >> 1; winrow0 = rowb + (size_t)krs0 * 64; }
    const int nch = nwin + 2;
    int gh[NG], gp0[NG];
#pragma unroll
    for (int gi = 0; gi < NG; ++gi) {
        const int G = NG * w + gi;
        if (ISA) { gh[gi] = 3 * hx + (G >> 3); gp0[gi] = 128 * blk + 16 * (G & 7); }
        else if (KIND == 1) { gh[gi] = hx; gp0[gi] = 16 * (G & 3); }
        else { gh[gi] = hx; gp0[gi] = 16 * G; }
    }
#define FA_QROW(gi, fr_) (KIND == 0 ? rowb + gp0[gi] + (fr_) : KIND == 2 ? ctxb + gp0[gi] + (fr_) : KIND == 1 ? rowb + (size_t)(4 * blk + ((NG * w + (gi)) >> 2)) * 64 + gp0[gi] + (fr_) : ctxb + gp0[gi] + (fr_))
    const int nr = 4 * blk + (w >> 1), nrs = na_rs(nr);
    const int skey = 8 * w + (lane >> 3), spc = lane & 7;
    const int ksrc = skey * INW + kcol + ((spc ^ (skey & 7)) << 3);
    const int vsrc = skey * INW + vcol + (((((spc >> 1) ^ ((skey >> 1) & 3)) << 1) | (spc & 1)) << 3);
    const unsigned lds0 = (unsigned)(uintptr_t)lds;
    int kb[2], vb[4];
#pragma unroll
    for (int ks = 0; ks < 2; ++ks) kb[ks] = fr * 128 + (((fq + 4 * ks) ^ (fr & 7)) << 4);
    { const int vk = 4 * fq + ((lane & 15) >> 2);
#pragma unroll
      for (int db = 0; db < 4; ++db) vb[db] = vk * 128 + ((db ^ ((vk >> 1) & 3)) << 5) + ((lane & 3) << 3); }
#define FA_DMA(ci) do { const size_t r0_ = (ci) < nwin ? winrow0 + (size_t)(ci) * 128 : ctxb + (size_t)((ci) - nwin) * 128; const bf16_t* s_ = PB + r0_ * INW; \
        const unsigned d_ = (unsigned)__builtin_amdgcn_readfirstlane((int)(lds0 + ((ci) % 3) * CHUNK_BYTES + w * 1024)); \
        glds16(s_ + ksrc, d_); glds16(s_ + 64 * INW + ksrc, d_ + 8192u); glds16(s_ + vsrc, d_ + 16384u); glds16(s_ + 64 * INW + vsrc, d_ + 24576u); } while (0)
    FA_DMA(0); FA_DMA(1);
    bf16x8 qf[NG][2];
#pragma unroll
    for (int gi = 0; gi < NG; ++gi)
#pragma unroll
        for (int ks = 0; ks < 2; ++ks) qf[gi][ks] = *(const bf16x8*)(PB + FA_QROW(gi, fr) * INW + (ISA ? C_QA : C_QN) + gh[gi] * 64 + 8 * fq + 32 * ks);
    f32x4 o[NG][4]; float m[NG], ls[NG]; unsigned vmask[NG]; int noff[NG];
#pragma unroll
    for (int gi = 0; gi < NG; ++gi) {
#pragma unroll
        for (int d = 0; d < 4; ++d) o[gi][d] = (f32x4){0.f, 0.f, 0.f, 0.f};
        if (ISA) { m[gi] = p.attn_sink[l * 6 + gh[gi]] * LOG2E; ls[gi] = fq == 0 ? 1.f : 0.f; } else { m[gi] = -1e30f; ls[gi] = 0.f; }
        vmask[gi] = 0u; noff[gi] = 0;
        if (KIND == 1) { const int a = gp0[gi] >> 4; noff[gi] = a == 0 ? 0 : (a == 1 ? 8 : (a == 2 ? 24 : 32));
            const int cq = gp0[gi] + fr, cs = min(max(cq - 8, 0), 48);
#pragma unroll
            for (int bit = 0; bit < 8; ++bit) { const int ck = noff[gi] + 16 * (bit >> 2) + 4 * fq + (bit & 3); vmask[gi] |= ((ck >= cs) && (ck < cs + 16)) ? (1u << bit) : 0u; } }
    }
    LAS float* biasL = (LAS float*)(lds + BIAS_OFF);
    if (KIND == 1) { const float* rp = p.na_rpb + ((size_t)l * 6 + hx) * 15 * 31;
        for (int i = tid; i < 15 * 128; i += NTHREADS) { const int x = (i & 127) - 64; biasL[i] = (x >= -15 && x <= 15) ? rp[(i >> 7) * 31 + x + 15] * LOG2E : 0.f; } }
    FA_WAIT_BAR(4);
#pragma unroll
    for (int gi = 0; gi < NG; ++gi) { asm volatile("" : "+v"(qf[gi][0]), "+v"(qf[gi][1])); }
#pragma unroll 1
    for (int ci = 0; ci < nch; ++ci) {
        if (ci + 2 < nch) FA_DMA(ci + 2);
        const LAS unsigned char* Kb = lds + (ci % 3) * CHUNK_BYTES; const LAS unsigned char* Vb = Kb + 16384;
        const bool iswin = ci < nwin;
        if (KIND == 1 && iswin) {
            const int kr0 = krs0 + 2 * ci; const bool rel0 = (kr0 >= nrs) && (kr0 < nrs + 8), rel1 = (kr0 + 1 >= nrs) && (kr0 + 1 < nrs + 8);
            if (rel0 || rel1) {
#pragma unroll
                for (int gi = 0; gi < NG; ++gi) {
                    asm volatile("" ::: "memory");
                    bf16x8 kf[2][2][2], vf[2][4];
                    load_kf(kf[0], Kb + noff[gi] * 128, kb); load_kf(kf[1], Kb + (64 + noff[gi]) * 128, kb);
                    const LAS float* bp = biasL + (kr0 - nr + 7) * 128 + 64 + noff[gi] + 4 * fq - (gp0[gi] + fr);
                    unit_update<2, true>(o[gi], m[gi], ls[gi], qf[gi], kf, vf, rel0, rel1, false, false, 0, 0, vmask[gi], bp, bp + 128, Vb + noff[gi] * 128, Vb + (64 + noff[gi]) * 128, vb);
                }
            }
        } else {
#pragma unroll
            for (int u = 0; u < 2; ++u) {
                bool rel[NG][2], msk[NG][2]; bool anyrel = false;
#pragma unroll
                for (int gi = 0; gi < NG; ++gi)
#pragma unroll
                    for (int t = 0; t < 2; ++t) {
                        rel[gi][t] = true; msk[gi][t] = false;
                        if (KIND == 0 && iswin) { const int j0 = winpos0 + 128 * ci + 64 * u + 32 * t, p0 = gp0[gi];
                            rel[gi][t] = (j0 + 31 >= p0 - 128) && (j0 <= p0 + 15 + 128); msk[gi][t] = !((j0 >= p0 + 15 - 128) && (j0 + 31 <= p0 + 128)); }
                        anyrel = anyrel || rel[gi][t];
                    }
                if (!anyrel) continue;
                asm volatile("" ::: "memory");
                bf16x8 kf[2][2][2], vf[2][4];
#pragma unroll
                for (int t = 0; t < 2; ++t) { load_kf(kf[t], Kb + (64 * u + 32 * t) * 128, kb); load_vf(vf[t], Vb + (64 * u + 32 * t) * 128, vb); }
#pragma unroll
                for (int gi = 0; gi < NG; ++gi) {
                    if (!(rel[gi][0] || rel[gi][1])) continue;
                    if (KIND == 0 && iswin) { const int tb0 = gp0[gi] + fr - (winpos0 + 128 * ci + 64 * u) - 4 * fq + 128;
                        unit_update<1, false>(o[gi], m[gi], ls[gi], qf[gi], kf, vf, rel[gi][0], rel[gi][1], msk[gi][0], msk[gi][1], tb0, tb0 - 32, 0u, nullptr, nullptr, nullptr, nullptr, vb); }
                    else unit_update<0, false>(o[gi], m[gi], ls[gi], qf[gi], kf, vf, true, true, false, false, 0, 0, 0u, nullptr, nullptr, nullptr, nullptr, vb);
                }
            }
        }
        if (ci + 2 < nch) FA_WAIT_BAR(4); else FA_WAIT_BAR(0);
    }
#undef FA_DMA
    int fr2 = lane & 15; asm volatile("" : "+v"(fr2));
#pragma unroll
    for (int gi = 0; gi < NG; ++gi) {
        const float lt = xor32_sum(xor16_sum(ls[gi]));
        const float inv = 1.f / lt;
        bf16_t* op = OB + FA_QROW(gi, fr2) * DM + (ISA ? 0 : 640) + gh[gi] * 64 + 4 * fq;
#pragma unroll
        for (int d = 0; d < 4; ++d) { u32x2 ov; ov.x = cvtpk(o[gi][d][0] * inv, o[gi][d][1] * inv); ov.y = cvtpk(o[gi][d][2] * inv, o[gi][d][3] * inv); *(u32x2*)(op + 16 * d) = ov; }
    }
#undef FA_QROW
}
__device__ __forceinline__ void phase_attn(const Params& p, int l, bool with_ctx, LAS unsigned char* lds, int bid, int nb) {
    bid = opaque_s(bid);
    const int n0 = NB * 2 * 64, n1 = NB * 6 * 32, n2 = with_ctx ? NB * 2 * 2 : 0, n3 = with_ctx ? NB * 6 : 0;
#pragma unroll 1
    for (int it = bid; it < n0 + n1 + n2 + n3; it += nb) {
        const int tid = opaque_tid();
#ifndef KMASK
#define KMASK 15
#endif
        if (it < n0) { if (KMASK & 1) attn_item<0>(p, l, it, lds, tid); }
        else if (it < n0 + n1) { if (KMASK & 2) attn_item<1>(p, l, it - n0, lds, tid); }
        else if (it < n0 + n1 + n2) { if (KMASK & 4) attn_item<2>(p, l, it - n0 - n1, lds, tid); }
        else { if (KMASK & 8) attn_item<3>(p, l, it - n0 - n1 - n2, lds, tid); }
    }
}
}

__device__ __forceinline__ float reduce16(const float (&t)[16], int lane) {
    float u[8], w4[4], x2[2];
#pragma unroll
    for (int e = 0; e < 8; ++e) { float a = t[e], b = t[e + 8]; asm volatile("s_nop 1\n\tv_permlane32_swap_b32 %0, %1" : "+v"(a), "+v"(b)); u[e] = a + b; }
#pragma unroll
    for (int e = 0; e < 4; ++e) { float a = u[e], b = u[e + 4]; asm volatile("s_nop 1\n\tv_permlane16_swap_b32 %0, %1" : "+v"(a), "+v"(b)); w4[e] = a + b; }
    const bool b3 = (lane & 8) != 0, b2 = (lane & 4) != 0;
#pragma unroll
    for (int e = 0; e < 2; ++e) { const float keep = b3 ? w4[e + 2] : w4[e], send = b3 ? w4[e] : w4[e + 2]; x2[e] = keep + dppf<0x128>(send); }
    const float keep = b2 ? x2[1] : x2[0], send = b2 ? x2[0] : x2[1];
    float y = keep + dppf<0x141>(send);
    y += dppf<0xB1>(y); y += dppf<0x4E>(y);
    return y;
}
__device__ __forceinline__ float wave_max(float v) {
    v = fmaxf(v, dppf<0xB1>(v)); v = fmaxf(v, dppf<0x4E>(v)); v = fmaxf(v, dppf<0x141>(v)); v = fmaxf(v, dppf<0x140>(v));
    return xor32_max(xor16_max(v));
}
__device__ __forceinline__ void phase_ln_router(const Params& p, int l, bool with_ctx, LAS unsigned char* lds, int bid, int nb) {
    bid = opaque_s(bid); const int tid = opaque_tid(), lane = tid & 63, gw = bid * NWAVES + (tid >> 6), NGW = nb * NWAVES;
    LAS float* wr = (LAS float*)lds;
    const float* wrg = p.w_router + (size_t)l * DM * NE;
    for (int i = tid; i < DM * NE; i += NTHREADS) { const int c = i >> 4, e = i & 15; wr[e * DM + c] = wrg[i]; }
    __syncthreads();
    const float* XR = p.out; const float* CXR = (const float*)(p.ws + WS_CXR); bf16_t* HB = (bf16_t*)(p.ws + WS_HB); float* AFF = (float*)(p.ws + WS_AFF);
    const float* g = p.ln1_g + l * DM; const float* bb = p.ln1_b + l * DM;
    const int nrows = with_ctx ? NROWS : NLAT;
    int myexp; { float idx[16];
#pragma unroll
        for (int e = 0; e < 16; ++e) idx[e] = (float)e;
        myexp = (int)(reduce16(idx, lane) * (1.f / 64.f) + 0.5f); }
    f32x4 v[4], vn[4];
    if (gw < nrows) row_load(gw < NLAT ? XR + (size_t)gw * DM : CXR + (size_t)(gw - NLAT) * DM, lane, v);
#pragma unroll 1
    for (int row = gw; row < nrows; row += NGW) {
        const int rn = row + NGW;
        if (rn < nrows) row_load(rn < NLAT ? XR + (size_t)rn * DM : CXR + (size_t)(rn - NLAT) * DM, lane, vn);
        row_normalize(v); row_affine(v, g, bb, lane);
        row_normalize(v);
        const float* m = mod_ptr(p, l, row_modrow(row)); row_modulate(v, m + 3 * DM, m + 4 * DM, lane);
        row_store_bf16(HB + (size_t)row * DM, lane, v);
        float t[16];
#pragma unroll
        for (int e = 0; e < 16; ++e) { float s = 0.f;
#pragma unroll
            for (int j = 0; j < 4; ++j) { const f32x4 wv = *(const LAS f32x4*)(wr + e * DM + 256 * j + 4 * lane); s += (v[j][0] * wv[0] + v[j][1] * wv[1]) + (v[j][2] * wv[2] + v[j][3] * wv[3]); }
            t[e] = s;
            if ((e & 3) == 3) asm volatile("" ::: "memory"); }
        const float lg = reduce16(t, lane);
        const float mx = wave_max(lg), ex = expf(lg - mx), sum = wave_sum(ex) * 0.25f;
        if ((lane & 3) == 0) AFF[(size_t)row * 16 + myexp] = ex / sum;
#pragma unroll
        for (int j = 0; j < 4; ++j) v[j] = vn[j];
    }
}

__device__ __forceinline__ void topk_item(const float* aff  , int n, int k, int row0  , int e, int slot0,
                                          int* TOK, float* GATE, int* INV, LAS unsigned char* lds) {
    const int tid = opaque_tid(), lane = tid & 63, w = tid >> 6;
    LAS unsigned* keys = (LAS unsigned*)lds;
    LAS unsigned* hist = keys + 8192;
    LAS unsigned* misc = hist + 256;
    for (int i = tid; i < n; i += NTHREADS) keys[i] = __builtin_bit_cast(unsigned, aff[(size_t)i * 16]);
    if (tid == 0) { misc[0] = 0u; misc[1] = (unsigned)k; }
    __syncthreads();
    unsigned maskv = 0u;
    for (int pass = 0; pass < 4; ++pass) {
        const int shift = 24 - 8 * pass;
        if (tid < 256) hist[tid] = 0u;
        __syncthreads();
        const unsigned prefix = misc[0];
        for (int i = tid; i < n; i += NTHREADS) { const unsigned kv = keys[i]; if ((kv & maskv) == prefix) atomicAdd((unsigned*)&hist[(kv >> shift) & 255u], 1u); }
        __syncthreads();
        if (w == 0) {
            const unsigned rem = misc[1];
            const unsigned h0 = hist[4 * lane], h1 = hist[4 * lane + 1], h2 = hist[4 * lane + 2], h3 = hist[4 * lane + 3], s4 = h0 + h1 + h2 + h3;
            unsigned S = s4;
#pragma unroll
            for (int o = 1; o < 64; o <<= 1) { const unsigned y = __shfl_down(S, o); if (lane + o < 64) S += y; }
            const unsigned above = S - s4;
            if (above < rem && rem <= S) { unsigned cum = above; int bin;
                if (cum + h3 >= rem) bin = 3; else { cum += h3; if (cum + h2 >= rem) bin = 2; else { cum += h2; if (cum + h1 >= rem) bin = 1; else { cum += h1; bin = 0; } } }
                misc[0] = prefix | ((unsigned)(4 * lane + bin) << shift); misc[1] = rem - cum; }
        }
        __syncthreads();
        maskv |= 255u << shift;
    }
    const unsigned T = misc[0], need_eq = misc[1];
    __syncthreads();
    const int per = n >= NTHREADS ? n / NTHREADS : 1; const int t0 = tid * per; const bool act = t0 < n;
    unsigned ce = 0u;
    if (act) for (int i = 0; i < per; ++i) ce += (keys[t0 + i] == T) ? 1u : 0u;
    unsigned inc = ce;
#pragma unroll
    for (int o = 1; o < 64; o <<= 1) { const unsigned y = __shfl_up(inc, o); if (lane >= o) inc += y; }
    if (lane == 63) misc[16 + w] = inc;
    __syncthreads();
    unsigned base = 0u;
    for (int ww = 0; ww < w; ++ww) base += misc[16 + ww];
    unsigned eqrank = base + inc - ce;
    __syncthreads();
    unsigned cs = 0u;
    if (act) { unsigned er = eqrank; for (int i = 0; i < per; ++i) { const unsigned kv = keys[t0 + i]; if (kv > T) cs++; else if (kv == T) { if (er < need_eq) cs++; er++; } } }
    inc = cs;
#pragma unroll
    for (int o = 1; o < 64; o <<= 1) { const unsigned y = __shfl_up(inc, o); if (lane >= o) inc += y; }
    if (lane == 63) misc[16 + w] = inc;
    __syncthreads();
    base = 0u;
    for (int ww = 0; ww < w; ++ww) base += misc[16 + ww];
    unsigned pos = base + inc - cs;
    if (act) { unsigned er = eqrank; for (int i = 0; i < per; ++i) { const unsigned kv = keys[t0 + i]; bool sel = false;
            if (kv > T) sel = true; else if (kv == T) { sel = er < need_eq; er++; }
            const int row = row0 + t0 + i;
            if (sel) { const int slot = slot0 + (int)pos; TOK[slot] = row; GATE[slot] = __builtin_bit_cast(float, kv); INV[(size_t)row * 16 + e] = slot; pos++; }
            else INV[(size_t)row * 16 + e] = -1; } }
    __syncthreads();
}
__device__ __forceinline__ void phase_topk(const Params& p, bool with_ctx, LAS unsigned char* lds, int bid, int nb) {
    const float* AFF = (const float*)(p.ws + WS_AFF); int* TOK = (int*)(p.ws + WS_TOK); float* GATE = (float*)(p.ws + WS_GATE); int* INV = (int*)(p.ws + WS_INV);
    const int nitems = with_ctx ? 128 : 64;
    for (int it = bid; it < nitems; it += nb) {
        if (it < 64) { const int b = it >> 4, e = it & 15; topk_item(AFF + (size_t)b * SEQ * 16 + e, SEQ, CAP, b * SEQ, e, (b * NE + e) * CAP, TOK, GATE, INV, lds); }
        else { const int b = (it - 64) >> 4, e = it & 15; topk_item(AFF + ((size_t)NLAT + (size_t)b * CTXL) * 16 + e, CTXL, CCAP, NLAT + b * CTXL, e, NSLOT_LAT + (e * NB + b) * CCAP, TOK, GATE, INV, lds); }
    }
}

__device__ __forceinline__ void phase_combine(const Params& p, int l, bool with_ctx, int bid, int nb) {
    bid = opaque_s(bid); const int tid = opaque_tid(); const int lane = tid & 63, gw = bid * NWAVES + (tid >> 6), NGW = nb * NWAVES;
    float* XR = p.out; float* CXR = (float*)(p.ws + WS_CXR); bf16_t* HB = (bf16_t*)(p.ws + WS_HB);
    const bf16_t* Y = (const bf16_t*)(p.ws + WS_Y); const int* INV = (const int*)(p.ws + WS_INV);
    const float* g = p.ln2_g + l * DM; const float* bb = p.ln2_b + l * DM;
    const int nrows = with_ctx ? NROWS : NLAT;
    for (int row = gw; row < nrows; row += NGW) {
        float* xr = row < NLAT ? XR + (size_t)row * DM : CXR + (size_t)(row - NLAT) * DM;
        f32x4 v[4]; row_load(xr, lane, v);
        row_normalize(v); row_affine(v, p.ln1_g + l * DM, p.ln1_b + l * DM, lane);
        f32x4 a[4];
#pragma unroll
        for (int j = 0; j < 4; ++j) a[j] = (f32x4){0.f, 0.f, 0.f, 0.f};
        const int myinv = INV[(size_t)row * 16 + (lane & 15)];
#pragma unroll
        for (int e = 0; e < 16; ++e) {
            const int slot = __builtin_amdgcn_readlane(myinv, e);
            if (slot >= 0) { const bf16_t* yr = Y + (size_t)slot * DM;
#pragma unroll
                for (int j = 0; j < 4; ++j) { const u32x2 wv = *(const u32x2*)(yr + 256 * j + 4 * lane); a[j][0] += bf_lo(wv.x); a[j][1] += bf_hi(wv.x); a[j][2] += bf_lo(wv.y); a[j][3] += bf_hi(wv.y); } }
        }
        const float* m = mod_ptr(p, l, row_modrow(row)) + 5 * DM;
#pragma unroll
        for (int j = 0; j < 4; ++j) { const f32x4 g2 = *(const f32x4*)(m + 256 * j + 4 * lane); v[j] = v[j] * ALPHA + g2 * a[j]; }
        row_normalize(v); row_affine(v, g, bb, lane); row_store(xr, lane, v);
        if (l + 1 < DEPTH) { row_normalize(v); const float* m2 = mod_ptr(p, l + 1, row_modrow(row)); row_modulate(v, m2, m2 + DM, lane); row_store_bf16(HB + (size_t)row * DM, lane, v); }
    }
}

constexpr int N_PHASES = 2 + 8 * DEPTH;
#define IN(k) (lo <= (k) && (k) < hi)
#ifndef TS_SEL
#define TS_SEL -1
#endif
#define TS_MULT 8
#define SEAM(k) do { if (IN(k) && IN((k) + 1)) xcd_barrier(bar); if (TS_SEL >= 0 && blockIdx.x == 0 && threadIdx.x == 0) ((unsigned long long*)(p.ws + WS_CTL + 65536))[(k) + 1] = __builtin_amdgcn_s_memrealtime(); } while (0)
#ifndef PHMASK
#define PHMASK 0x3ff
#endif
#define PHON(i) ((PHMASK >> (i)) & 1)
#ifndef DUP_MASK
#define DUP_MASK 0
#endif
#define DUP(i) ((DUP_MASK >> (i)) & 1)
template <int l>
__device__ __forceinline__ void run_layer(const Params& p, LAS unsigned char* lds, LAS int* idxl, const XcdBarrier& bar, int bid, int nb, int lo, int hi) {
    bf16_t* HB = (bf16_t*)(p.ws + WS_HB); bf16_t* PB = (bf16_t*)(p.ws + WS_PB); bf16_t* OB = (bf16_t*)(p.ws + WS_OB);
    bf16_t* HH = (bf16_t*)(p.ws + WS_HH); bf16_t* Y = (bf16_t*)(p.ws + WS_Y);
    const int* TOK = (const int*)(p.ws + WS_TOK); const float* GATE = (const float*)(p.ws + WS_GATE);
        const int pb = 2 + 8 * l; const bool wc = (l == 0);
        if (IN(pb + 0)) { if (PHON(2)) {
            const bf16_t* W = (const bf16_t*)(p.ws + WS_WIN) + (size_t)l * INW * DM; EpiQKV E{PB, (const float*)(p.ws + WS_ROPE)};
            { SgDesc g{HB + (size_t)NLAT * DM, DM, nullptr, W, 0, 1 << 30, 1, NCTX, INW, DM, NLAT}; sg_gemm(g, E, bid, nb); }
            { mg::Gemm g{HB, W, NLAT, INW, DM, nullptr, 0, 1 << 20, 1}; mg::StaticOrder S; S.init(NLAT, INW, nb, bid); mg::EpiAdapt<EpiQKV> EA{E, 0}; mg::gemm_phase(lds, idxl, g, S, EA); if (DUP(2)) mg::gemm_phase(lds, idxl, g, S, EA); } } }
        SEAM(pb + 0);
        if (IN(pb + 1)) { if (PHON(3)) {
#if FAST_ATTN
            fa::phase_attn(p, l, wc, lds, bid, nb); if (DUP(3)) fa::phase_attn(p, l, wc, lds, bid, nb);
#endif
            phase_mixers(p, l, wc, bid, nb); } }
        SEAM(pb + 1);
        if (IN(pb + 2)) { if (PHON(4)) {
            const bf16_t* W = (const bf16_t*)(p.ws + WS_WOUT) + (size_t)l * DM * DM;
            EpiOut E{l == 0 ? p.x : p.out, p.ctx, p.out, (float*)(p.ws + WS_CXR), mod_ptr(p, l, 0)};
            if (wc) { SgDesc g{OB + (size_t)NLAT * DM, DM, nullptr, W, 0, 1 << 30, 1, NCTX, DM, DM, NLAT}; sg_gemm(g, E, bid, nb); }
            { mg::Gemm g{OB, W, NLAT, DM, DM, nullptr, 0, 1 << 20, 1}; mg::StaticOrder S; S.init(NLAT, DM, nb, bid); mg::EpiAdapt<EpiOut> EA{E, 0}; mg::gemm_phase(lds, idxl, g, S, EA); if (DUP(4) && l == 0) mg::gemm_phase(lds, idxl, g, S, EA); } } }
        SEAM(pb + 2);
        if (IN(pb + 3)) { if (PHON(5)) phase_ln_router(p, l, wc, lds, bid, nb); }
        SEAM(pb + 3);
        if (IN(pb + 4)) { if (PHON(6)) phase_topk(p, wc, lds, bid, nb); if (DUP(6)) phase_topk(p, wc, lds, bid, nb); }
        SEAM(pb + 4);
        if (IN(pb + 5)) { if (PHON(7)) {
            const bf16_t* W = (const bf16_t*)(p.ws + WS_WGU) + (size_t)l * NE * 1024 * DM; EpiGU E{HH};
            if (wc) { SgDesc g{HB, DM, TOK + NSLOT_LAT, W, (size_t)1024 * DM, NB * CCAP, NE, NSLOT_CTX, 1024, DM, NSLOT_LAT}; sg_gemm(g, E, bid, nb); }
            { mg::Gemm g{HB, W, NSLOT_LAT, 1024, DM, TOK, (size_t)1024 * DM, CAP / 256, NE}; mg::StaticOrder S; S.init(NSLOT_LAT, 1024, nb, bid); mg::EpiAdapt<EpiGU> EA{E, 0}; mg::gemm_phase(lds, idxl, g, S, EA); if (DUP(7)) mg::gemm_phase(lds, idxl, g, S, EA); } } }
        SEAM(pb + 5);
        if (IN(pb + 6)) { if (PHON(8)) {
            const bf16_t* W = (const bf16_t*)(p.ws + WS_WD) + (size_t)l * NE * DM * FF; EpiDown E{Y, GATE};
            if (wc) { SgDesc g{HH + (size_t)NSLOT_LAT * FF, FF, nullptr, W, (size_t)DM * FF, NB * CCAP, NE, NSLOT_CTX, DM, FF, NSLOT_LAT}; sg_gemm(g, E, bid, nb); }
            { mg::Gemm g{HH, W, NSLOT_LAT, DM, FF, nullptr, (size_t)DM * FF, CAP / 256, NE}; mg::StaticOrder S; S.init(NSLOT_LAT, DM, nb, bid); mg::EpiAdapt<EpiDown> EA{E, 0}; mg::gemm_phase(lds, idxl, g, S, EA); if (DUP(8)) mg::gemm_phase(lds, idxl, g, S, EA); } } }
        SEAM(pb + 6);
        if (IN(pb + 7)) { if (PHON(9)) phase_combine(p, l, wc, bid, nb); }
        SEAM(pb + 7);
}
__global__ void __launch_bounds__(NTHREADS, 2) fwd_kernel(Params p) {
    extern __shared__ __attribute__((aligned(16))) unsigned char lds_raw[];
    LAS unsigned char* lds = (LAS unsigned char*)lds_raw;
    const int bid = blockIdx.x, nb = gridDim.x;
    volatile LAS unsigned* MISC = (volatile LAS unsigned*)(lds + LDS_BYTES - 64);
    LAS int* idxl = (LAS int*)(lds + mg::STAGE_BYTES);
    if (threadIdx.x < 16) MISC[threadIdx.x] = 0u;
    __syncthreads();
    XcdBarrier bar; bar.bar = (unsigned*)(p.ws + WS_CTL) + CW_BAR; bar.x = 0; bar.st = nullptr;
    const bool multi = p.ph_hi - p.ph_lo > 1;
    if (multi) bar = xcd_barrier_post((unsigned*)(p.ws + WS_CTL) + CW_BAR, MISC + 8);
    bf16_t* HB = (bf16_t*)(p.ws + WS_HB); bf16_t* PB = (bf16_t*)(p.ws + WS_PB); bf16_t* OB = (bf16_t*)(p.ws + WS_OB);
    bf16_t* HH = (bf16_t*)(p.ws + WS_HH); bf16_t* Y = (bf16_t*)(p.ws + WS_Y);
    const int* TOK = (const int*)(p.ws + WS_TOK); const float* GATE = (const float*)(p.ws + WS_GATE);
    const int lo = p.ph_lo, hi = p.ph_hi;
    if (TS_SEL >= 0 && blockIdx.x == 0 && threadIdx.x == 0) ((unsigned long long*)(p.ws + WS_CTL + 65536))[0] = __builtin_amdgcn_s_memrealtime();
    if (IN(0)) { if (PHON(0)) phase_prologue(p, lds, bid, nb); if (DUP(0)) { __syncthreads(); phase_prologue(p, lds, bid, nb); } } SEAM(0);
    if (IN(1)) { if (PHON(1)) phase_ln1(p, bid, nb); if (DUP(1)) phase_ln1(p, bid, nb); } SEAM(1);
    run_layer<0>(p, lds, idxl, bar, bid, nb, lo, hi);
    run_layer<1>(p, lds, idxl, bar, bid, nb, lo, hi);
    if (TS_SEL >= 0 && blockIdx.x == 0 && threadIdx.x == 0) {
        volatile unsigned long long* ts = (volatile unsigned long long*)(p.ws + WS_CTL + 65536); const unsigned long long dt = (ts[TS_SEL + 1] - ts[TS_SEL]) * TS_MULT, t0 = __builtin_amdgcn_s_memrealtime();
        while (__builtin_amdgcn_s_memrealtime() - t0 < dt) __builtin_amdgcn_s_sleep(8); }
#undef IN
#undef SEAM
}

#ifndef N_LAUNCH_SPLIT
#define N_LAUNCH_SPLIT 0
#endif
extern "C" void kernel_launch(void* const* d_in, const int* in_sizes, int n_in, void* d_out, int out_size, void* d_ws, size_t ws_size, hipStream_t stream) {
    static int grid = 0;
    if (grid == 0) {
        if (n_in != 19 || in_sizes[0] != NLAT * DM || out_size != NLAT * DM || ws_size < WS_END) { fprintf(stderr, "kernel_launch: unexpected shapes (n_in %d, in0 %d, out %d, ws %zu)\n", n_in, n_in > 0 ? in_sizes[0] : -1, out_size, ws_size); grid = -1; return; }
        int dev = 0, cus = 0, per_cu = 0;
        if (hipGetDevice(&dev) != hipSuccess || hipDeviceGetAttribute(&cus, hipDeviceAttributeMultiprocessorCount, dev) != hipSuccess) { grid = -1; return; }
        if (hipFuncSetAttribute((const void*)fwd_kernel, hipFuncAttributeMaxDynamicSharedMemorySize, LDS_BYTES) != hipSuccess) { fprintf(stderr, "kernel_launch: hipFuncSetAttribute failed\n"); grid = -1; return; }
        if (hipOccupancyMaxActiveBlocksPerMultiprocessor(&per_cu, (const void*)fwd_kernel, NTHREADS, LDS_BYTES) != hipSuccess || per_cu < 1) { fprintf(stderr, "kernel_launch: occupancy query says %d\n", per_cu); per_cu = 1; }
        (void)hipGetLastError();
        grid = cus;
    }
    if (grid < 0) return;
    (void)hipMemsetAsync((char*)d_ws + WS_CTL, 0, CTL_ZERO_BYTES, stream);
    Params p{};
    const float** pp = (const float**)&p;
    for (int i = 0; i < 19; ++i) pp[i] = (const float*)d_in[i];
    p.out = (float*)d_out; p.ws = (unsigned char*)d_ws;
#if N_LAUNCH_SPLIT
    for (int ph = 0; ph < N_PHASES; ++ph) { p.ph_lo = ph; p.ph_hi = ph + 1; hipLaunchKernelGGL(fwd_kernel, dim3(grid), dim3(NTHREADS), LDS_BYTES, stream, p); }
#else
    p.ph_lo = 0; p.ph_hi = N_PHASES;
    void* args[] = {&p};
    hipError_t e = hipLaunchCooperativeKernel((const void*)fwd_kernel, dim3(grid), dim3(NTHREADS), args, LDS_BYTES, stream);
    if (e != hipSuccess) fprintf(stderr, "kernel_launch: cooperative launch failed: %s\n", hipGetErrorString(e));
#endif
}
```

```cpp
#include <hip/hip_runtime.h>
#include <hip/hip_cooperative_groups.h>
#include <cstdio>
#include <cstdint>
#include <cmath>

#define LAS __attribute__((address_space(3)))
typedef unsigned short bf16_t;
typedef short bf16x8 __attribute__((ext_vector_type(8)));
typedef float f32x4 __attribute__((ext_vector_type(4)));
typedef unsigned u32x4 __attribute__((ext_vector_type(4)));
typedef unsigned u32x2 __attribute__((ext_vector_type(2)));

constexpr int NB = 4, SEQ = 8192, DM = 1024, CTXL = 256, DEPTH = 2;
constexpr int NLAT = NB * SEQ, NCTX = NB * CTXL, NROWS = NLAT + NCTX;
constexpr int INW = 2560, NE = 16, FF = 512, CAP = 1024, CCAP = 32;
constexpr int NSLOT_LAT = NB * NE * CAP, NSLOT_CTX = NB * NE * CCAP, NSLOT = NSLOT_LAT + NSLOT_CTX;
constexpr int NMOD = 6 * DM;
constexpr float LN_EPS = 1e-6f;
constexpr float ALPHA = 1.41421356237309515f;
constexpr int C_QA = 0, C_KA = 384, C_VA = 512, C_BX = 640, C_BB = 896, C_BC = 1152, C_QN = 1408, C_KN = 1792, C_VN = 2176;

#ifndef FAST_ATTN
#define FAST_ATTN 1
#endif
constexpr int NTHREADS = 512, NWAVES = 8;
constexpr int LDS_BYTES = 147456;

constexpr size_t MiB = 1u << 20;
constexpr size_t WS_CTL = 0, CTL_ZERO_BYTES = 1 * MiB;
constexpr size_t WS_ROPE = 1 * MiB;
constexpr size_t WS_MOD = 1 * MiB + 65536;
constexpr size_t WS_AFF = 2 * MiB;
constexpr size_t WS_INV = 5 * MiB;
constexpr size_t WS_TOK = 8 * MiB;
constexpr size_t WS_GATE = 8 * MiB + 512 * 1024;
constexpr size_t WS_CXR = 9 * MiB;
constexpr size_t WS_WIN = 16 * MiB;
constexpr size_t WS_WOUT = 26 * MiB;
constexpr size_t WS_WGU = 30 * MiB;
constexpr size_t WS_WD = 94 * MiB;
constexpr size_t WS_HB = 126 * MiB;
constexpr size_t WS_OB = 192 * MiB;
constexpr size_t WS_HH = 192 * MiB;
constexpr size_t WS_PB = 258 * MiB;
constexpr size_t WS_Y = 258 * MiB;
constexpr size_t WS_XB = 424 * MiB;
constexpr size_t WS_END = 490 * MiB;
static_assert(WS_HB + (size_t)NROWS * DM * 2 <= WS_OB && WS_OB + (size_t)NROWS * DM * 2 <= WS_PB && WS_PB + (size_t)NROWS * INW * 2 <= WS_XB && WS_XB + (size_t)NROWS * DM * 2 <= WS_END, "ws map");
static_assert((size_t)NSLOT * FF * 2 <= (size_t)NROWS * DM * 2 && (size_t)NSLOT * DM * 2 <= (size_t)NROWS * INW * 2, "overlays");
constexpr int CW_BAR = 4096;

struct Params {
    const float *x, *c, *ctx, *c_ctx, *w_mod, *b_mod, *w_in, *conv_w, *attn_sink, *na_rpb, *w_out, *ln1_g, *ln1_b, *w_router, *w_gate, *w_up, *w_down, *ln2_g, *ln2_b;
    float* out; unsigned char* ws;
    int ph_lo, ph_hi;
};

__device__ __forceinline__ unsigned f2bf(float f) { unsigned u = __builtin_bit_cast(unsigned, f); return (u + 0x7fffu + ((u >> 16) & 1u)) >> 16; }
__device__ __forceinline__ unsigned pk2(float lo, float hi) { return f2bf(lo) | (f2bf(hi) << 16); }
__device__ __forceinline__ float bf_lo(unsigned w) { return __builtin_bit_cast(float, w << 16); }
__device__ __forceinline__ float bf_hi(unsigned w) { return __builtin_bit_cast(float, w & 0xffff0000u); }
template <int CTRL> __device__ __forceinline__ float dppf(float v) { return __builtin_bit_cast(float, __builtin_amdgcn_update_dpp(0, __builtin_bit_cast(int, v), CTRL, 0xf, 0xf, true)); }
__device__ __forceinline__ void swap16(float v, float& a, float& b) { a = v; b = v; asm volatile("s_nop 1\n\tv_permlane16_swap_b32 %0, %1" : "+v"(a), "+v"(b)); }
__device__ __forceinline__ void swap32(float v, float& a, float& b) { a = v; b = v; asm volatile("s_nop 1\n\tv_permlane32_swap_b32 %0, %1" : "+v"(a), "+v"(b)); }
__device__ __forceinline__ float xor16_sum(float v) { float a, b; swap16(v, a, b); return a + b; }
__device__ __forceinline__ float xor32_sum(float v) { float a, b; swap32(v, a, b); return a + b; }
__device__ __forceinline__ float xor16_max(float v) { float a, b; swap16(v, a, b); return fmaxf(a, b); }
__device__ __forceinline__ float xor32_max(float v) { float a, b; swap32(v, a, b); return fmaxf(a, b); }
__device__ __forceinline__ float wave_sum(float v) {
    v += dppf<0xB1>(v); v += dppf<0x4E>(v); v += dppf<0x141>(v); v += dppf<0x140>(v);
    return xor32_sum(xor16_sum(v));
}
#define LDS_WAIT() asm volatile("s_waitcnt lgkmcnt(0)" ::: "memory")
__device__ __forceinline__ int opaque_tid() { int t = threadIdx.x; asm volatile("" : "+v"(t)); return t; }
__device__ __forceinline__ int opaque_s(int v) { asm volatile("" : "+s"(v)); return v; }

__device__ __forceinline__ float* mod_ptr(const Params& p, int l, int r) { return (float*)(p.ws + WS_MOD) + ((size_t)l * 5 + r) * NMOD; }

#define XB_TMO      128
#define XB_XCNT(j)  (256  + 64 * (j))
#define XB_XSUB(j)  (1280 + 64 * (j))
#define XB_XGEN(j)  (2304 + 64 * (j))
#define XB_TOP      3328
#define XB_TOPGEN   3392
#define XCD_BAR_WORDS 3456
#define XB_SPIN_CAP (1u << 20)
__device__ __forceinline__ unsigned xb_ld(unsigned* p)              { return __hip_atomic_load(p, __ATOMIC_RELAXED, __HIP_MEMORY_SCOPE_AGENT); }
__device__ __forceinline__ unsigned xb_add(unsigned* p, unsigned v) { return __hip_atomic_fetch_add(p, v, __ATOMIC_RELAXED, __HIP_MEMORY_SCOPE_AGENT); }
__device__ __forceinline__ unsigned xb_xcc_id() { return (unsigned)__builtin_amdgcn_s_getreg((3 << 11) | 20) & 0xFu; }
#define XB_SPIN(cond, bar) do { unsigned _sp = 0; while (cond) { __builtin_amdgcn_s_sleep(1); \
    if ((++_sp & 255u) == 0u) { if (xb_ld(&(bar)[XB_TMO])) break; if (_sp > XB_SPIN_CAP) { atomicAdd(&(bar)[XB_TMO], 1u); break; } } } } while (0)
struct XcdBarrier { unsigned* bar; unsigned x; volatile LAS unsigned* st; };
__device__ __forceinline__ XcdBarrier xcd_barrier_post(unsigned* bar, volatile LAS unsigned* st) {
    XcdBarrier b; b.bar = bar; b.x = xb_xcc_id(); b.st = st;
    if (threadIdx.x == 0) (void)xb_add(&bar[XB_XCNT(b.x)], 1u);
    return b;
}
__device__ __forceinline__ void xcd_barrier_complete(unsigned* bar, unsigned x, unsigned& nloc, unsigned& nx) {
    const unsigned G = gridDim.x * gridDim.y * gridDim.z;
    unsigned sum, cnt, mine, sp = 0u;
    for (;;) {
        sum = 0u; cnt = 0u; mine = 0u;
#pragma unroll 1
        for (unsigned j = 0; j < 16; ++j) { const unsigned c = xb_ld(&bar[XB_XCNT(j)]); sum += c; cnt += (c > 0u) ? 1u : 0u; mine = (j == x) ? c : mine; }
        if (sum == G) break;
        __builtin_amdgcn_s_sleep(1);
        if ((++sp & 255u) == 0u) { if (xb_ld(&bar[XB_TMO])) break; if (sp > XB_SPIN_CAP) { atomicAdd(&bar[XB_TMO], 1u); break; } }
    }
    nloc = mine > 0u ? mine : 1u; nx = cnt > 0u ? cnt : 1u;
}
__device__ __forceinline__ void xcd_barrier(const XcdBarrier& b) {
    asm volatile("s_waitcnt vmcnt(0)" ::: "memory");
    __syncthreads();
    if (threadIdx.x == 0) {
        unsigned* bar = b.bar; asm volatile("" : "+s"(bar));
        __builtin_amdgcn_s_waitcnt(0);
        unsigned nloc = b.st[0], nx = b.st[1];
        if (nloc == 0u) { xcd_barrier_complete(bar, b.x, nloc, nx); b.st[0] = nloc; b.st[1] = nx; }
        const unsigned old = xb_add(&bar[XB_XSUB(b.x)], 1u);
        const unsigned gen = old / nloc;
        if (old + 1u == (gen + 1u) * nloc) {
            __builtin_amdgcn_fence(__ATOMIC_RELEASE, "agent");
            asm volatile("s_waitcnt vmcnt(0)" ::: "memory");
            const unsigned og = xb_add(&bar[XB_TOP], 1u);
            const unsigned tg = og / nx;
            if (og + 1u == (tg + 1u) * nx) xb_add(&bar[XB_TOPGEN], 1u);
            else XB_SPIN(xb_ld(&bar[XB_TOPGEN]) == tg, bar);
            __builtin_amdgcn_fence(__ATOMIC_ACQUIRE, "agent");
            xb_add(&bar[XB_XGEN(b.x)], 1u);
            asm volatile("s_waitcnt vmcnt(0)" ::: "memory");
        } else {
            XB_SPIN(xb_ld(&bar[XB_XGEN(b.x)]) == gen, bar);
            __builtin_amdgcn_fence(__ATOMIC_ACQUIRE, "agent");
            asm volatile("s_waitcnt vmcnt(0)" ::: "memory");
        }
    }
    __syncthreads();
}

struct TrItem { const float* W; bf16_t* WT; int K, N, mode, item; };
__device__ __forceinline__ void tr_load(const TrItem& t, int lane, float (&r)[32]) {
    const int nblk = t.N / 32, kb = t.item / nblk, nb = t.item % nblk, k0 = 64 * kb, n0 = 32 * nb;
    const float* src = t.W + (size_t)(k0 + (lane >> 5)) * t.N + n0 + (lane & 31);
#pragma unroll
    for (int i = 0; i < 32; ++i) r[i] = src[(size_t)(2 * i) * t.N];
}
__device__ __forceinline__ void tr_finish(const TrItem& t, int lane, const float (&r)[32], LAS float* scr) {
    const int nblk = t.N / 32, kb = t.item / nblk, nb = t.item % nblk, k0 = 64 * kb, n0 = 32 * nb;
#pragma unroll
    for (int i = 0; i < 32; ++i) scr[(2 * i + (lane >> 5)) * 33 + (lane & 31)] = r[i];
    LDS_WAIT();
    const int c = lane & 7;
#pragma unroll
    for (int j = 0; j < 4; ++j) {
        const int n = (lane >> 3) + 8 * j; const LAS float* s = scr + (8 * c) * 33 + n;
        u32x4 o; o.x = pk2(s[0 * 33], s[1 * 33]); o.y = pk2(s[2 * 33], s[3 * 33]); o.z = pk2(s[4 * 33], s[5 * 33]); o.w = pk2(s[6 * 33], s[7 * 33]);
        const int f = n0 + n; const int orow = t.mode == 0 ? f : (32 * (f >> 4) + (f & 15) + (t.mode == 2 ? 16 : 0));
        *(u32x4*)(t.WT + (size_t)orow * t.K + k0 + 8 * c) = o;
    }
    LDS_WAIT();
}
__device__ __forceinline__ void phase_prologue(const Params& p, LAS unsigned char* lds, int bid, int nb) {
    bid = opaque_s(bid); const int tid = opaque_tid(), lane = tid & 63, w = tid >> 6;
    {
        LAS float* ssil = (LAS float*)lds;
        LAS float* red = ssil + 5 * 1024;
        for (int i = tid; i < 5 * 1024; i += NTHREADS) { const int r = i >> 10, k = i & 1023; const float v = r < 4 ? p.c[r * 1024 + k] : p.c_ctx[k]; ssil[i] = v / (1.f + expf(-v)); }
        __syncthreads();
        for (int item = bid; item < 2 * 96; item += nb) {
            const int l = item / 96, n0 = (item % 96) * 64;
            const float* W = p.w_mod + (size_t)l * DM * NMOD + n0 + lane;
            float a0 = 0.f, a1 = 0.f, a2 = 0.f, a3 = 0.f, a4 = 0.f;
#pragma unroll 8
            for (int k = w * 128; k < w * 128 + 128; ++k) {
                const float wv = W[(size_t)k * NMOD];
                a0 += ssil[k] * wv; a1 += ssil[1024 + k] * wv; a2 += ssil[2048 + k] * wv; a3 += ssil[3072 + k] * wv; a4 += ssil[4096 + k] * wv;
            }
            red[(w * 5 + 0) * 64 + lane] = a0; red[(w * 5 + 1) * 64 + lane] = a1; red[(w * 5 + 2) * 64 + lane] = a2; red[(w * 5 + 3) * 64 + lane] = a3; red[(w * 5 + 4) * 64 + lane] = a4;
            __syncthreads();
            if (tid < 320) { const int r = tid >> 6; float s = 0.f;
#pragma unroll
                for (int ww = 0; ww < 8; ++ww) s += red[(ww * 5 + r) * 64 + lane];
                mod_ptr(p, l, r)[n0 + lane] = s + p.b_mod[l * NMOD + n0 + lane]; }
            __syncthreads();
        }
    }
    if (bid == nb - 1) {
        float* rope = (float*)(p.ws + WS_ROPE);
        for (int e = tid; e < 128 * 16; e += NTHREADS) {
            const int pos = e >> 4, i = e & 15;
            const double a = exp(-((double)i / 16.0) * 9.210340371976184);
            const double a2 = a * a; double c = 1.0, s = a, tc = 1.0, ts = a;
            for (int n = 1; n <= 14; ++n) { tc *= -a2 / (double)((2 * n - 1) * (2 * n)); c += tc; ts *= -a2 / (double)((2 * n) * (2 * n + 1)); s += ts; }
            double rc = 1.0, rs = 0.0, bc = c, bs = s; int q = pos;
            while (q) { if (q & 1) { const double t = rc * bc - rs * bs; rs = rc * bs + rs * bc; rc = t; } const double t = bc * bc - bs * bs; bs = 2.0 * bc * bs; bc = t; q >>= 1; }
            rope[2 * e] = (float)rc; rope[2 * e + 1] = (float)rs;
        }
    }
    __syncthreads();
    {
        LAS float* scr = (LAS float*)lds + w * (64 * 33);
        const int gw = bid * NWAVES + w, NGW = nb * NWAVES;
        constexpr int I_IN = 16 * 80, I_OUT = 16 * 32, I_G = 16 * 16, I_D = 8 * 32;
        constexpr int PER_L = I_IN + I_OUT + 16 * (2 * I_G + I_D);
        auto decode = [&](int it) -> TrItem {
            const int l = it / PER_L; int r = it % PER_L;
            if (r < I_IN) return TrItem{p.w_in + (size_t)l * DM * INW, (bf16_t*)(p.ws + WS_WIN) + (size_t)l * INW * DM, DM, INW, 0, r}; r -= I_IN;
            if (r < I_OUT) return TrItem{p.w_out + (size_t)l * DM * DM, (bf16_t*)(p.ws + WS_WOUT) + (size_t)l * DM * DM, DM, DM, 0, r}; r -= I_OUT;
            if (r < 16 * I_G) { const int e = r / I_G; return TrItem{p.w_gate + ((size_t)l * NE + e) * DM * FF, (bf16_t*)(p.ws + WS_WGU) + ((size_t)l * NE + e) * 1024 * DM, DM, FF, 1, r % I_G}; } r -= 16 * I_G;
            if (r < 16 * I_G) { const int e = r / I_G; return TrItem{p.w_up + ((size_t)l * NE + e) * DM * FF, (bf16_t*)(p.ws + WS_WGU) + ((size_t)l * NE + e) * 1024 * DM, DM, FF, 2, r % I_G}; } r -= 16 * I_G;
            const int e = r / I_D; return TrItem{p.w_down + ((size_t)l * NE + e) * FF * DM, (bf16_t*)(p.ws + WS_WD) + ((size_t)l * NE + e) * DM * FF, FF, DM, 0, r % I_D};
        };
        float ra[32], rb[32];
        int it = gw;
        if (it < 2 * PER_L) { TrItem cur = decode(it); tr_load(cur, lane, ra);
#pragma unroll 1
            for (;;) {
                const int itn = it + NGW; const bool hn = itn < 2 * PER_L; TrItem nx = cur;
                if (hn) { nx = decode(itn); tr_load(nx, lane, rb); }
                tr_finish(cur, lane, ra, scr);
                if (!hn) break;
                const int itn2 = itn + NGW; const bool hn2 = itn2 < 2 * PER_L; TrItem nx2 = nx;
                if (hn2) { nx2 = decode(itn2); tr_load(nx2, lane, ra); }
                tr_finish(nx, lane, rb, scr);
                if (!hn2) break;
                cur = nx2; it = itn2;
            }
        }
    }
}

__device__ __forceinline__ void row_load(const float* rowp, int lane, f32x4 (&v)[4]) {
#pragma unroll
    for (int j = 0; j < 4; ++j) v[j] = *(const f32x4*)(rowp + 256 * j + 4 * lane);
}
__device__ __forceinline__ void row_load_bf16(const bf16_t* rowp, int lane, f32x4 (&v)[4]) {
#pragma unroll
    for (int j = 0; j < 4; ++j) { const u32x2 w = *(const u32x2*)(rowp + 256 * j + 4 * lane); v[j] = (f32x4){bf_lo(w.x), bf_hi(w.x), bf_lo(w.y), bf_hi(w.y)}; }
}
__device__ __forceinline__ void row_store(float* rowp, int lane, const f32x4 (&v)[4]) {
#pragma unroll
    for (int j = 0; j < 4; ++j) *(f32x4*)(rowp + 256 * j + 4 * lane) = v[j];
}
__device__ __forceinline__ void row_store_bf16(bf16_t* rowp, int lane, const f32x4 (&v)[4]) {
#pragma unroll
    for (int j = 0; j < 4; ++j) { u32x2 o; o.x = pk2(v[j][0], v[j][1]); o.y = pk2(v[j][2], v[j][3]); *(u32x2*)(rowp + 256 * j + 4 * lane) = o; }
}
__device__ __forceinline__ void row_normalize(f32x4 (&v)[4]) {
    float s = 0.f;
#pragma unroll
    for (int j = 0; j < 4; ++j) s += (v[j][0] + v[j][1]) + (v[j][2] + v[j][3]);
    const float mean = wave_sum(s) * (1.f / DM);
    float q = 0.f;
#pragma unroll
    for (int j = 0; j < 4; ++j) { v[j] = v[j] - mean; q += (v[j][0] * v[j][0] + v[j][1] * v[j][1]) + (v[j][2] * v[j][2] + v[j][3] * v[j][3]); }
    const float rstd = 1.f / sqrtf(wave_sum(q) * (1.f / DM) + LN_EPS);
#pragma unroll
    for (int j = 0; j < 4; ++j) v[j] = v[j] * rstd;
}
__device__ __forceinline__ void row_modulate(f32x4 (&v)[4], const float* sh, const float* sc, int lane) {
#pragma unroll
    for (int j = 0; j < 4; ++j) { const f32x4 a = *(const f32x4*)(sc + 256 * j + 4 * lane), b = *(const f32x4*)(sh + 256 * j + 4 * lane); v[j] = v[j] * (a + 1.f) + b; }
}
__device__ __forceinline__ void row_affine(f32x4 (&v)[4], const float* g, const float* bb, int lane) {
#pragma unroll
    for (int j = 0; j < 4; ++j) { const f32x4 a = *(const f32x4*)(g + 256 * j + 4 * lane), b = *(const f32x4*)(bb + 256 * j + 4 * lane); v[j] = v[j] * a + b; }
}
__device__ __forceinline__ int row_modrow(int row) { return row < NLAT ? (row >> 13) : 4; }

__device__ __forceinline__ void phase_ln1(const Params& p, int bid, int nb) {
    bid = opaque_s(bid); const int tid = opaque_tid(), lane = tid & 63, gw = bid * NWAVES + (tid >> 6), NGW = nb * NWAVES;
    bf16_t* HB = (bf16_t*)(p.ws + WS_HB);
    f32x4 v[4], vn[4];
    if (gw < NROWS) row_load(gw < NLAT ? p.x + (size_t)gw * DM : p.ctx + (size_t)(gw - NLAT) * DM, lane, v);
#pragma unroll 1
    for (int row = gw; row < NROWS; row += NGW) {
        const int rn = row + NGW;
        if (rn < NROWS) row_load(rn < NLAT ? p.x + (size_t)rn * DM : p.ctx + (size_t)(rn - NLAT) * DM, lane, vn);
        row_normalize(v);
        const float* m = mod_ptr(p, 0, row_modrow(row)); row_modulate(v, m, m + DM, lane);
        row_store_bf16(HB + (size_t)row * DM, lane, v);
#pragma unroll
        for (int j = 0; j < 4; ++j) v[j] = vn[j];
    }
}

struct SgDesc { const bf16_t* A; int lda; const int* rowidx; const bf16_t* Bt; size_t grp_stride; int rows_per_grp, ngrp; int M, N, K; int row_base; };
template <class Epi>
__device__ __forceinline__ void sg_gemm(const SgDesc& g, const Epi& E, int bid, int nb) {
    bid = opaque_s(bid); const int tid = opaque_tid(); const int lane = tid & 63, w = __builtin_amdgcn_readfirstlane(tid >> 6), fr = lane & 15, fq = lane >> 4;
    const int tilesN = g.N / 64, tiles = (g.M / 64) * tilesN;
#pragma unroll 1
    for (int t = bid + nb * w; t < tiles; t += nb * NWAVES) {
        const int tm = t / tilesN, tn = t % tilesN;
        const int row0 = tm * 64, col0 = tn * 64;
        const bf16_t* Bt = g.Bt + (size_t)((row0 / g.rows_per_grp) % g.ngrp) * g.grp_stride;
        const bf16_t* ap[4]; const bf16_t* bp[4];
#pragma unroll
        for (int i = 0; i < 4; ++i) { const int r = row0 + 16 * i + fr; const int ar = g.rowidx ? g.rowidx[r] : r; ap[i] = g.A + (size_t)ar * g.lda + 8 * fq; }
#pragma unroll
        for (int n = 0; n < 4; ++n) bp[n] = Bt + (size_t)(col0 + 16 * n + fr) * g.K + 8 * fq;
        f32x4 acc[4][4];
#pragma unroll
        for (int i = 0; i < 4; ++i)
#pragma unroll
            for (int n = 0; n < 4; ++n) acc[i][n] = (f32x4){0.f, 0.f, 0.f, 0.f};
        bf16x8 a0[4], b0[4], a1[4], b1[4], a2[4], b2[4], a3[4], b3[4];
#define SG_LOAD(A_, B_, k_) do { _Pragma("unroll") for (int i = 0; i < 4; ++i) { A_[i] = *(const bf16x8*)(ap[i] + (k_)); B_[i] = *(const bf16x8*)(bp[i] + (k_)); } } while (0)
#define SG_MMA(A_, B_) do { _Pragma("unroll") for (int i = 0; i < 4; ++i) _Pragma("unroll") for (int n = 0; n < 4; ++n) acc[i][n] = __builtin_amdgcn_mfma_f32_16x16x32_bf16(B_[n], A_[i], acc[i][n], 0, 0, 0); } while (0)
        SG_LOAD(a0, b0, 0); SG_LOAD(a1, b1, 32); SG_LOAD(a2, b2, 64);
#pragma unroll 1
        for (int k = 0; k < g.K; k += 128) {
            SG_LOAD(a3, b3, k + 96); SG_MMA(a0, b0);
            if (k + 128 < g.K) SG_LOAD(a0, b0, k + 128);
            SG_MMA(a1, b1);
            if (k + 128 < g.K) SG_LOAD(a1, b1, k + 160);
            SG_MMA(a2, b2);
            if (k + 128 < g.K) SG_LOAD(a2, b2, k + 192);
            SG_MMA(a3, b3);
        }
#undef SG_LOAD
#undef SG_MMA
#pragma unroll
        for (int i = 0; i < 4; ++i) {
            const float rv = E.rowval(g.row_base + row0 + 16 * i + fr);
#pragma unroll
            for (int g2 = 0; g2 < 2; ++g2) E(g.row_base + row0 + 16 * i + fr, col0 + 32 * g2, fq, acc[i][2 * g2], acc[i][2 * g2 + 1], rv);
            asm volatile("" ::: "memory"); }
    }
}

__device__ __forceinline__ void store_bf16x4(bf16_t* p, const f32x4 v) { u32x2 o; o.x = pk2(v[0], v[1]); o.y = pk2(v[2], v[3]); *(u32x2*)p = o; }

struct EpiQKV {
    bf16_t* PB; const float* rope;
    __device__ __forceinline__ float rowval(int) const { return 0.f; }
    __device__ __forceinline__ void operator()(int row, int c32, int fq, f32x4 v0, f32x4 v1, float) const {
        if (c32 < 512 && row < NLAT) {
            const int t = row & (SEQ - 1); const int pos = (c32 & 32) ? (t & 63) : (t >> 6);
            const float* rp = rope + (pos * 16 + 4 * fq) * 2;
#pragma unroll
            for (int j = 0; j < 4; ++j) { const float cs = rp[2 * j], sn = rp[2 * j + 1], a = v0[j], b = v1[j]; v0[j] = a * cs - b * sn; v1[j] = b * cs + a * sn; }
        }
        bf16_t* o = PB + (size_t)row * INW + c32 + 4 * fq;
        store_bf16x4(o, v0); store_bf16x4(o + 16, v1);
    }
};
template <bool FIRST> struct EpiOut {
    const float* xl; const float* xc; bf16_t* XB; const float* mod;
    __device__ __forceinline__ float rowval(int) const { return 0.f; }
    __device__ __forceinline__ void operator()(int row, int c32, int fq, f32x4 v0, f32x4 v1, float) const {
        const int c = c32 + 4 * fq; bf16_t* xo = XB + (size_t)row * DM + c;
        const float* g1 = mod + (size_t)row_modrow(row) * NMOD + 2 * DM + c;
        f32x4 x0, x1;
        if (FIRST) { const float* xin = row < NLAT ? xl + (size_t)row * DM + c : xc + (size_t)(row - NLAT) * DM + c; x0 = *(const f32x4*)xin; x1 = *(const f32x4*)(xin + 16); }
        else { const u32x2 a = *(const u32x2*)xo, b = *(const u32x2*)(xo + 16); x0 = (f32x4){bf_lo(a.x), bf_hi(a.x), bf_lo(a.y), bf_hi(a.y)}; x1 = (f32x4){bf_lo(b.x), bf_hi(b.x), bf_lo(b.y), bf_hi(b.y)}; }
        const f32x4 g0 = *(const f32x4*)g1, g1v = *(const f32x4*)(g1 + 16);
        store_bf16x4(xo, x0 * ALPHA + g0 * v0); store_bf16x4(xo + 16, x1 * ALPHA + g1v * v1);
    }
};
struct EpiGU {
    bf16_t* HH;
    __device__ __forceinline__ float rowval(int) const { return 0.f; }
    __device__ __forceinline__ void operator()(int row, int c32, int fq, f32x4 v0, f32x4 v1, float) const {
        f32x4 h;
#pragma unroll
        for (int j = 0; j < 4; ++j) h[j] = v0[j] / (1.f + __expf(-v0[j])) * v1[j];
        store_bf16x4(HH + (size_t)row * FF + (c32 >> 1) + 4 * fq, h);
    }
};
struct EpiDown {
    bf16_t* Y; const float* gate;
    __device__ __forceinline__ float rowval(int row) const { return gate[row]; }
    __device__ __forceinline__ void operator()(int row, int c32, int fq, f32x4 v0, f32x4 v1, float g) const {
        bf16_t* o = Y + (size_t)row * DM + c32 + 4 * fq;
        store_bf16x4(o, v0 * g); store_bf16x4(o + 16, v1 * g);
    }
};


namespace mg {
constexpr int BM = 256, BK = 64, HALF = 128, HTB = HALF * BK * 2, STAGE_BYTES = 8 * HTB, NXCD = 8, WGM = 8, MAXU = 8;
__device__ __forceinline__ int lds_byte(int r, int c) { const int st = (r >> 4) * 2 + (c >> 5), rr = r & 15, cc = c & 31, ob = rr * 64 + cc * 2; return st * 1024 + (ob ^ (((ob >> 9) & 1) << 5)); }
__device__ __forceinline__ void stage_rc(int b, int& R, int& C) { const int st = b / 1024, sb = b % 1024, swz = sb ^ (((sb >> 9) & 1) << 5); R = (st >> 1) * 16 + swz / 64; C = (st & 1) * 32 + (swz % 64) / 2; }
struct Unit { int pm, pn; };
struct Gemm { const bf16_t* A; const bf16_t* Bt; int M, N, K; const int* rowidx; size_t grp_stride; int grp_tiles, ngrp; };
struct StaticOrder {
    int nM, nN, nwg, G, c;
    __device__ void init(int M, int N, int G_, int c_) { nM = M / BM; nN = N / BM; nwg = nM * nN; G = G_; c = c_; }
    __device__ bool next(int i, Unit& u) const {
        const long L = (long)i * G + c; if (L >= nwg) return false;
        int wgid = (int)L; { const int q = nwg / NXCD, r = nwg % NXCD, xcd = wgid % NXCD, off = wgid / NXCD; wgid = (xcd < r ? xcd * (q + 1) : r * (q + 1) + (xcd - r) * q) + off; }
        const int nig = WGM * nN, gid = wgid / nig, fm = gid * WGM, gsz = (nM - fm) < WGM ? (nM - fm) : WGM;
        u.pm = fm + ((wgid % nig) % gsz); u.pn = (wgid % nig) / gsz; return true;
    }
};
template <class Epi>
__device__ __forceinline__ void gemm_phase(LAS unsigned char* lds, LAS int* idxl, const Gemm g, const StaticOrder& S, const Epi& E) {
    const int tid = opaque_tid(), wid = __builtin_amdgcn_readfirstlane(tid >> 6), lane = tid & 63, wr = wid >> 2, wc = wid & 3, fr = lane & 15, fq = lane >> 4;
    const int K = g.K, nt = K / BK;
    unsigned voffB[2];
#pragma unroll
    for (int i = 0; i < 2; ++i) { int R_, C_; stage_rc(tid * 16 + i * 8192, R_, C_); voffB[i] = (unsigned)(R_ * K + C_) * 2u; }
    const size_t kstep = (size_t)(BK * 2);
    const size_t hstep = (size_t)HALF * K * 2;
    const size_t tstep = 2 * hstep;
    const unsigned ldsw = (unsigned)wid * 1024u;
    const int aoff = lds_byte(wr * 64 + fr, fq * 8), boff = lds_byte(wc * 32 + fr, fq * 8);
    Unit cur, nxt; int ui = 0;
    if (!S.next(0, cur)) return;
    if (g.rowidx) {
        for (int i = 0; i < MAXU; ++i) { Unit u; if (!S.next(i, u)) break; if (tid < 256) idxl[i * 256 + tid] = g.rowidx[u.pm * BM + tid]; }
        asm volatile("s_waitcnt vmcnt(0) lgkmcnt(0)" ::: "memory"); __builtin_amdgcn_s_barrier(); asm volatile("" ::: "memory");
    }
#define MG_AOFFS(dst, u_, ui_) do { _Pragma("unroll") for (int i_ = 0; i_ < 2; ++i_) { int R_, C_; stage_rc(tid * 16 + i_ * 8192, R_, C_); _Pragma("unroll") for (int h_ = 0; h_ < 2; ++h_) { \
        const int rr_ = g.rowidx ? idxl[(ui_) * 256 + h_ * HALF + R_] : ((u_).pm * BM + h_ * HALF + R_); dst[h_][i_] = (unsigned)(rr_ * K + C_) * 2u; } } } while (0)
#define MG_BPTR(u_) ((const char*)g.Bt + ((size_t)(((u_).pm / g.grp_tiles) % g.ngrp) * g.grp_stride) * 2 + (size_t)(u_).pn * tstep)
#define PG8_SA(b, h) (((b) * 2 + (h)) * HTB)
#define PG8_SB(b, h) ((4 + (b) * 2 + (h)) * HTB)
#define PG8_STAGE(bufoff, gbase, voff) do { _Pragma("unroll") for (int _i = 0; _i < 2; ++_i) \
        __builtin_amdgcn_global_load_lds((const unsigned*)((const char*)(gbase) + (voff)[_i]), (LAS unsigned*)(lds + (bufoff) + ldsw + _i * 8192), 16, 0, 0); } while (0)
#define PG8_LDA(dst, b, h) do { _Pragma("unroll") for (int m = 0; m < 4; ++m) _Pragma("unroll") for (int k = 0; k < 2; ++k) dst[m][k] = *(const LAS bf16x8*)(lds + PG8_SA(b, h) + aoff + m * 2048 + k * 1024); } while (0)
#define PG8_LDB(dst, b, h) do { _Pragma("unroll") for (int n = 0; n < 2; ++n) _Pragma("unroll") for (int k = 0; k < 2; ++k) dst[n][k] = *(const LAS bf16x8*)(lds + PG8_SB(b, h) + boff + n * 2048 + k * 1024); } while (0)
#define PG8_MMA(ai, bj, At, Bt) do { __builtin_amdgcn_s_setprio(1); _Pragma("unroll") for (int m = 0; m < 4; ++m) _Pragma("unroll") for (int n = 0; n < 2; ++n) _Pragma("unroll") for (int k = 0; k < 2; ++k) \
        acc[ai][bj][m][n] = __builtin_amdgcn_mfma_f32_16x16x32_bf16(Bt[n][k], At[m][k], acc[ai][bj][m][n], 0, 0, 0); __builtin_amdgcn_s_setprio(0); } while (0)
#define PG8_WAIT_V(n) asm volatile("s_waitcnt vmcnt(" #n ")" ::: "memory")
#define PG8_WAIT_L(n) asm volatile("s_waitcnt lgkmcnt(" #n ")" ::: "memory")
#define PG8_BAR __builtin_amdgcn_s_barrier()
#define PG8_SCHED __builtin_amdgcn_sched_barrier(0)
    f32x4 acc[2][2][4][2];
#pragma unroll
    for (int a = 0; a < 2; ++a)
#pragma unroll
        for (int b = 0; b < 2; ++b)
#pragma unroll
            for (int m = 0; m < 4; ++m)
#pragma unroll
                for (int n = 0; n < 2; ++n) acc[a][b][m][n] = (f32x4){0.f, 0.f, 0.f, 0.f};
    bf16x8 At[4][2], B0[2][2], B1[2][2];
    unsigned cAo[2][2], o2[2][2];
    MG_AOFFS(cAo, cur, 0);
    const char* const Abase = (const char*)g.A;
    const char* cB = MG_BPTR(cur);
    PG8_STAGE(PG8_SB(0, 0), cB, voffB); PG8_STAGE(PG8_SB(0, 1), cB + hstep, voffB); PG8_STAGE(PG8_SA(0, 0), Abase, cAo[0]); PG8_STAGE(PG8_SA(0, 1), Abase, cAo[1]);
    if (wr == 1) PG8_BAR;
    PG8_WAIT_V(2); PG8_BAR;
    PG8_STAGE(PG8_SB(1, 0), cB + kstep, voffB); PG8_STAGE(PG8_SA(1, 0), Abase + kstep, cAo[0]); PG8_STAGE(PG8_SB(1, 1), cB + hstep + kstep, voffB);
    PG8_WAIT_V(6); PG8_BAR;
    for (;;) {
        const bool has_next = S.next(ui + 1, nxt);
        const char* nB = has_next ? MG_BPTR(nxt) : cB;
        for (int t = 0; t < nt; t += 2) {
            const bool last = (t == nt - 2);
            const char* a1 = Abase + (size_t)(t + 1) * kstep;
            const char* a2 = last ? Abase : Abase + (size_t)(t + 2) * kstep; const char* b2 = last ? nB : cB + (size_t)(t + 2) * kstep;
            const char* a3 = a2 + kstep; const char* b3 = b2 + kstep;
            if (last && has_next) { MG_AOFFS(o2, nxt, ui + 1); } else {
#pragma unroll
                for (int h = 0; h < 2; ++h)
#pragma unroll
                    for (int i = 0; i < 2; ++i) o2[h][i] = cAo[h][i]; }
            PG8_LDB(B0, 0, 0); PG8_LDB(B1, 0, 1); PG8_SCHED; PG8_LDA(At, 0, 0); PG8_STAGE(PG8_SA(1, 1), a1, cAo[1]);
            PG8_WAIT_V(8); PG8_WAIT_L(0); PG8_BAR; PG8_MMA(0, 0, At, B0); PG8_MMA(0, 1, At, B1); PG8_BAR; PG8_SCHED;
            PG8_LDA(At, 0, 1); PG8_STAGE(PG8_SB(0, 0), b2, voffB); PG8_STAGE(PG8_SB(0, 1), b2 + hstep, voffB); PG8_STAGE(PG8_SA(0, 0), a2, o2[0]);
            PG8_WAIT_V(8); PG8_WAIT_L(0); PG8_BAR; PG8_MMA(1, 0, At, B0); PG8_MMA(1, 1, At, B1); PG8_BAR; PG8_SCHED;
            PG8_LDB(B0, 1, 0); PG8_LDB(B1, 1, 1); PG8_SCHED; PG8_LDA(At, 1, 0); PG8_STAGE(PG8_SA(0, 1), a2, o2[1]);
            PG8_WAIT_V(8); PG8_WAIT_L(0); PG8_BAR; PG8_MMA(0, 0, At, B0); PG8_MMA(0, 1, At, B1); PG8_BAR; PG8_SCHED;
            PG8_LDA(At, 1, 1); PG8_STAGE(PG8_SB(1, 0), b3, voffB); PG8_STAGE(PG8_SB(1, 1), b3 + hstep, voffB); PG8_STAGE(PG8_SA(1, 0), a3, o2[0]);
            PG8_WAIT_V(8); PG8_WAIT_L(0); PG8_BAR; PG8_MMA(1, 0, At, B0); PG8_MMA(1, 1, At, B1); PG8_BAR; PG8_SCHED;
        }
        if (wr == 0) PG8_BAR;
        E(acc, cur, wr, wc, fr, fq);
        if (!has_next) break;
#pragma unroll
        for (int a = 0; a < 2; ++a)
#pragma unroll
            for (int b = 0; b < 2; ++b)
#pragma unroll
                for (int m = 0; m < 4; ++m)
#pragma unroll
                    for (int n = 0; n < 2; ++n) acc[a][b][m][n] = (f32x4){0.f, 0.f, 0.f, 0.f};
        cur = nxt; cB = nB; ++ui;
#pragma unroll
        for (int h = 0; h < 2; ++h)
#pragma unroll
            for (int i = 0; i < 2; ++i) cAo[h][i] = o2[h][i];
        if (wr == 1) PG8_BAR;
    }
    PG8_WAIT_V(0);
    PG8_BAR;
#undef MG_AOFFS
#undef MG_BPTR
#undef PG8_SA
#undef PG8_SB
#undef PG8_STAGE
#undef PG8_LDA
#undef PG8_LDB
#undef PG8_MMA
#undef PG8_WAIT_V
#undef PG8_WAIT_L
#undef PG8_BAR
#undef PG8_SCHED
}
template <class EE> struct EpiAdapt {
    EE e; int row_base;
    __device__ __forceinline__ void operator()(const f32x4 (&acc)[2][2][4][2], const Unit& u, int wr, int wc, int fr, int fq) const {
        float rv[2][4];
#pragma unroll
        for (int ai = 0; ai < 2; ++ai)
#pragma unroll
            for (int m = 0; m < 4; ++m) rv[ai][m] = e.rowval(row_base + u.pm * BM + ai * HALF + wr * 64 + m * 16 + fr);
#pragma unroll
        for (int ai = 0; ai < 2; ++ai)
#pragma unroll
            for (int m = 0; m < 4; ++m) { const int row = row_base + u.pm * BM + ai * HALF + wr * 64 + m * 16 + fr;
#pragma unroll
                for (int bj = 0; bj < 2; ++bj) e(row, u.pn * BM + bj * HALF + wc * 32, fq, acc[ai][bj][m][0], acc[ai][bj][m][1], rv[ai][m]);
                if (m & 1) asm volatile("" ::: "memory"); }
    }
};
}

struct AttnState { float m, l; float o[32]; };
__device__ __forceinline__ void attn_init(AttnState& st) { st.m = -INFINITY; st.l = 0.f;
#pragma unroll
    for (int d = 0; d < 32; ++d) st.o[d] = 0.f; }
__device__ __forceinline__ void load_row32(const bf16_t* p, float (&r)[32], float scale) {
#pragma unroll
    for (int i = 0; i < 4; ++i) { const u32x4 w = *(const u32x4*)(p + 8 * i);
        r[8 * i + 0] = bf_lo(w.x) * scale; r[8 * i + 1] = bf_hi(w.x) * scale; r[8 * i + 2] = bf_lo(w.y) * scale; r[8 * i + 3] = bf_hi(w.y) * scale;
        r[8 * i + 4] = bf_lo(w.z) * scale; r[8 * i + 5] = bf_hi(w.z) * scale; r[8 * i + 6] = bf_lo(w.w) * scale; r[8 * i + 7] = bf_hi(w.w) * scale; }
}
__device__ __forceinline__ float dot_row32(const bf16_t* p, const float (&q)[32]) {
    float d0 = 0.f, d1 = 0.f;
#pragma unroll
    for (int i = 0; i < 4; ++i) { const u32x4 w = *(const u32x4*)(p + 8 * i);
        d0 += q[8 * i + 0] * bf_lo(w.x); d1 += q[8 * i + 1] * bf_hi(w.x); d0 += q[8 * i + 2] * bf_lo(w.y); d1 += q[8 * i + 3] * bf_hi(w.y);
        d0 += q[8 * i + 4] * bf_lo(w.z); d1 += q[8 * i + 5] * bf_hi(w.z); d0 += q[8 * i + 6] * bf_lo(w.w); d1 += q[8 * i + 7] * bf_hi(w.w); }
    const float d = d0 + d1;
    return d + __shfl_xor(d, 32);
}
__device__ __forceinline__ void axpy_row32(const bf16_t* p, float a, float (&o)[32]) {
#pragma unroll
    for (int i = 0; i < 4; ++i) { const u32x4 w = *(const u32x4*)(p + 8 * i);
        o[8 * i + 0] += a * bf_lo(w.x); o[8 * i + 1] += a * bf_hi(w.x); o[8 * i + 2] += a * bf_lo(w.y); o[8 * i + 3] += a * bf_hi(w.y);
        o[8 * i + 4] += a * bf_lo(w.z); o[8 * i + 5] += a * bf_hi(w.z); o[8 * i + 6] += a * bf_lo(w.w); o[8 * i + 7] += a * bf_hi(w.w); }
}
template <class ScoreFn>
__device__ __forceinline__ void attn_segment(const float (&q)[32], AttnState& st, const bf16_t* Kb, const bf16_t* Vb, int j0, int j1, ScoreFn sf) {
#pragma unroll 1
    for (int j = j0; j < j1; ++j) {
        const float s0 = sf(j, dot_row32(Kb + (size_t)j * INW, q));
        if (s0 > st.m) { const float corr = __expf(st.m - s0); st.l *= corr;
#pragma unroll
            for (int d = 0; d < 32; ++d) st.o[d] *= corr;
            st.m = s0; }
        const float p0 = (s0 == -INFINITY) ? 0.f : __expf(s0 - st.m);
        st.l += p0;
        axpy_row32(Vb + (size_t)j * INW, p0, st.o);
    }
}
__device__ __forceinline__ void attn_sink(AttnState& st, float sk) {
    if (sk > st.m) { const float corr = __expf(st.m - sk); st.l *= corr;
#pragma unroll
        for (int d = 0; d < 32; ++d) st.o[d] *= corr;
        st.m = sk; }
    st.l += __expf(sk - st.m);
}
__device__ __forceinline__ void attn_store(const AttnState& st, bf16_t* o) {
    const float inv = 1.f / st.l;
#pragma unroll
    for (int i = 0; i < 4; ++i) { u32x4 w; w.x = pk2(st.o[8 * i] * inv, st.o[8 * i + 1] * inv); w.y = pk2(st.o[8 * i + 2] * inv, st.o[8 * i + 3] * inv);
        w.z = pk2(st.o[8 * i + 4] * inv, st.o[8 * i + 5] * inv); w.w = pk2(st.o[8 * i + 6] * inv, st.o[8 * i + 7] * inv); *(u32x4*)(o + 8 * i) = w; }
}

__device__ __forceinline__ void phase_mixers(const Params& p, int l, bool with_ctx, int bid, int nb) {
    bid = opaque_s(bid); const int tid = opaque_tid(); const int lane = tid & 63, gw = bid * NWAVES + (tid >> 6), NGW = nb * NWAVES;
    const int ql = lane & 31, hf = lane >> 5;
    const bf16_t* PB = (const bf16_t*)(p.ws + WS_PB); bf16_t* OB = (bf16_t*)(p.ws + WS_OB);
    const float* sink = p.attn_sink + l * 6; const float* rpb = p.na_rpb + (size_t)l * 6 * 15 * 31;
#if !FAST_ATTN
#pragma unroll 1
    for (int it = gw; it < NB * 6 * 256; it += NGW) {
        const int chunk = it & 255, h = (it >> 8) % 6, b = it / (6 * 256), kvh = h / 3;
        const int t = chunk * 32 + ql; const size_t rowb = (size_t)b * SEQ;
        float q[32]; load_row32(PB + (rowb + t) * INW + C_QA + h * 64 + 32 * hf, q, 0.125f);
        AttnState st; attn_init(st);
        const int jlo = max(0, chunk * 32 - 128), jhi = min(SEQ, chunk * 32 + 32 + 128);
        attn_segment(q, st, PB + rowb * INW + C_KA + kvh * 64 + 32 * hf, PB + rowb * INW + C_VA + kvh * 64 + 32 * hf, jlo, jhi,
                     [&](int j, float d) { const int dt = t - j; return (dt <= 128 && dt >= -128) ? d : -INFINITY; });
        const size_t crow = (size_t)NLAT + (size_t)b * CTXL;
        attn_segment(q, st, PB + crow * INW + C_KA + kvh * 64 + 32 * hf, PB + crow * INW + C_VA + kvh * 64 + 32 * hf, 0, CTXL, [&](int, float d) { return d; });
        attn_sink(st, sink[h]);
        attn_store(st, OB + (rowb + t) * DM + h * 64 + 32 * hf);
    }
#pragma unroll 1
    for (int it = gw; it < NB * 6 * 256; it += NGW) {
        const int r = (it & 255) >> 1, ch = it & 1, h = (it >> 8) % 6, b = it / (6 * 256);
        const int cq = ch * 32 + ql; const size_t rowb = (size_t)b * SEQ; const int t = r * 64 + cq;
        float q[32]; load_row32(PB + (rowb + t) * INW + C_QN + h * 64 + 32 * hf, q, 0.125f);
        AttnState st; attn_init(st);
        const int rs = min(max(r - 4, 0), 128 - 8), cs = min(max(cq - 8, 0), 64 - 16);
        const float* bias = rpb + (size_t)h * 15 * 31;
        attn_segment(q, st, PB + (rowb + (size_t)rs * 64) * INW + C_KN + h * 64 + 32 * hf, PB + (rowb + (size_t)rs * 64) * INW + C_VN + h * 64 + 32 * hf, 0, 512,
                     [&](int j, float d) { const int ka = rs + (j >> 6), ck = j & 63; const bool ok = (ck >= cs) && (ck < cs + 16);
                                           const int ro = ka - r + 7, co = min(max(ck - cq, -15), 15) + 15; return ok ? d + bias[ro * 31 + co] : -INFINITY; });
        const size_t crow = (size_t)NLAT + (size_t)b * CTXL;
        attn_segment(q, st, PB + crow * INW + C_KN + h * 64 + 32 * hf, PB + crow * INW + C_VN + h * 64 + 32 * hf, 0, CTXL, [&](int, float d) { return d; });
        attn_store(st, OB + (rowb + t) * DM + 640 + h * 64 + 32 * hf);
    }
#endif
    {
        const float* cw = p.conv_w + (size_t)l * 3 * 256;
        const int nrows = with_ctx ? NROWS : NLAT;
        for (long e = (long)bid * NTHREADS + tid; e < (long)nrows * 32; e += (long)nb * NTHREADS) {
            const int row = (int)(e >> 5), ch = (int)(e & 31) * 8;
            const int tpos = row < NLAT ? (row & (SEQ - 1)) : ((row - NLAT) & (CTXL - 1)); const int tlen = row < NLAT ? SEQ : CTXL;
            const bf16_t* pr = PB + (size_t)row * INW;
            float u[3][8];
#pragma unroll
            for (int dlt = -1; dlt <= 1; ++dlt) {
                const bool ok = (tpos + dlt >= 0) && (tpos + dlt < tlen);
                if (ok) { const u32x4 a = *(const u32x4*)(pr + (long)dlt * INW + C_BX + ch), c = *(const u32x4*)(pr + (long)dlt * INW + C_BC + ch);
                    u[dlt + 1][0] = bf_lo(a.x) * bf_lo(c.x); u[dlt + 1][1] = bf_hi(a.x) * bf_hi(c.x); u[dlt + 1][2] = bf_lo(a.y) * bf_lo(c.y); u[dlt + 1][3] = bf_hi(a.y) * bf_hi(c.y);
                    u[dlt + 1][4] = bf_lo(a.z) * bf_lo(c.z); u[dlt + 1][5] = bf_hi(a.z) * bf_hi(c.z); u[dlt + 1][6] = bf_lo(a.w) * bf_lo(c.w); u[dlt + 1][7] = bf_hi(a.w) * bf_hi(c.w); }
                else {
#pragma unroll
                    for (int i = 0; i < 8; ++i) u[dlt + 1][i] = 0.f; }
            }
            const u32x4 gb = *(const u32x4*)(pr + C_BB + ch);
            const float g[8] = {bf_lo(gb.x), bf_hi(gb.x), bf_lo(gb.y), bf_hi(gb.y), bf_lo(gb.z), bf_hi(gb.z), bf_lo(gb.w), bf_hi(gb.w)};
            float y[8];
#pragma unroll
            for (int i = 0; i < 8; ++i) y[i] = g[i] * (u[0][i] * cw[ch + i] + u[1][i] * cw[256 + ch + i] + u[2][i] * cw[512 + ch + i]);
            u32x4 o; o.x = pk2(y[0], y[1]); o.y = pk2(y[2], y[3]); o.z = pk2(y[4], y[5]); o.w = pk2(y[6], y[7]);
            *(u32x4*)(OB + (size_t)row * DM + 384 + ch) = o;
        }
    }
#if !FAST_ATTN
    if (with_ctx) {
#pragma unroll 1
        for (int it = gw; it < 2 * NB * 6 * 8; it += NGW) {
            const int kind = it / (NB * 6 * 8), r = it % (NB * 6 * 8), chunk = r & 7, h = (r >> 3) % 6, b = r / 48;
            const size_t crow = (size_t)NLAT + (size_t)b * CTXL; const int tq = chunk * 32 + ql;
            const int qc = (kind == 0 ? C_QA + h * 64 : C_QN + h * 64) + 32 * hf, kc = (kind == 0 ? C_KA + (h / 3) * 64 : C_KN + h * 64) + 32 * hf, vc = (kind == 0 ? C_VA + (h / 3) * 64 : C_VN + h * 64) + 32 * hf;
            float q[32]; load_row32(PB + (crow + tq) * INW + qc, q, 0.125f);
            AttnState st; attn_init(st);
            attn_segment(q, st, PB + crow * INW + kc, PB + crow * INW + vc, 0, CTXL, [&](int, float d) { return d; });
            if (kind == 0) attn_sink(st, sink[h]);
            attn_store(st, OB + (crow + tq) * DM + (kind == 0 ? 0 : 640) + h * 64 + 32 * hf);
        }
    }
#endif
}

namespace fa {
typedef short v4i16_t __attribute__((ext_vector_type(4)));
typedef float f32x2_t __attribute__((ext_vector_type(2))); typedef __bf16 bf16x2_t __attribute__((ext_vector_type(2)));
__device__ __forceinline__ unsigned cvtpk(float lo, float hi) { f32x2_t v = {lo, hi}; bf16x2_t b = __builtin_convertvector(v, bf16x2_t); return __builtin_bit_cast(unsigned, b); }
constexpr float LOG2E = 1.4426950408889634f, SC = 0.125f * LOG2E;
constexpr int CHUNK_BYTES = 32768;
constexpr int BIAS_OFF = 3 * CHUNK_BYTES;
constexpr float THR = 8.f;
__device__ __forceinline__ int na_rs(int r) { return min(max(r - 4, 0), 128 - 8); }
__device__ __forceinline__ void glds16(const void* gsrc, unsigned lds_dst) { unsigned keep;
    asm volatile("s_mov_b32 %0, m0\n\ts_mov_b32 m0, %2\n\ts_nop 0\n\tglobal_load_lds_dwordx4 %1, off\n\ts_mov_b32 m0, %0" : "=&s"(keep) : "v"(gsrc), "s"(lds_dst) : "memory"); }
#define FA_WAIT_BAR(N) asm volatile("s_waitcnt vmcnt(" #N ") lgkmcnt(0)\n\ts_barrier" ::: "memory")
__device__ __forceinline__ float max3f(float a, float b, float c) { float r; asm("v_max3_f32 %0, %1, %2, %3" : "=v"(r) : "v"(a), "v"(b), "v"(c)); return r; }
__device__ __forceinline__ float max8f(const f32x4& a, const f32x4& b) { return max3f(max3f(max3f(a[0], a[1], a[2]), a[3], b[0]), max3f(b[1], b[2], b[3]), -INFINITY); }
typedef float f32x16 __attribute__((ext_vector_type(16)));
__device__ __forceinline__ float max16f(const f32x16& a) {
    float x = max3f(a[0], a[1], a[2]); x = max3f(x, a[3], a[4]); x = max3f(x, a[5], a[6]); x = max3f(x, a[7], a[8]); x = max3f(x, a[9], a[10]); x = max3f(x, a[11], a[12]); x = max3f(x, a[13], a[14]);
    return fmaxf(x, a[15]);
}
typedef float f32x2v __attribute__((ext_vector_type(2)));
template <int MODE>
__device__ __forceinline__ void unit32(f32x16 (&o)[2], float& m, float& ls, const bf16x8 (&q)[4], const LAS unsigned char* Kt0, const LAS unsigned char* Kt1, const LAS unsigned char* Vt0, const LAS unsigned char* Vt1,
                                       const int (&kb)[4], const int (&vb)[2], bool rel0, bool rel1, bool mk0, bool mk1, int tb0, int tb1, const f32x16& fmask, const LAS float* bp0, const LAS float* bp1) {
    f32x16 s[2]; float tm = -INFINITY;
#pragma unroll
    for (int t = 0; t < 2; ++t) {
        if (!(t == 0 ? rel0 : rel1)) continue;
        const LAS unsigned char* Kt = t == 0 ? Kt0 : Kt1;
        bf16x8 kf[4];
#pragma unroll
        for (int ks = 0; ks < 4; ++ks) kf[ks] = *(const LAS bf16x8*)(Kt + kb[ks]);
        f32x16 acc = __builtin_amdgcn_mfma_f32_32x32x16_bf16(kf[0], q[0], (f32x16){0.f, 0.f, 0.f, 0.f, 0.f, 0.f, 0.f, 0.f, 0.f, 0.f, 0.f, 0.f, 0.f, 0.f, 0.f, 0.f}, 0, 0, 0);
#pragma unroll
        for (int ks = 1; ks < 4; ++ks) acc = __builtin_amdgcn_mfma_f32_32x32x16_bf16(kf[ks], q[ks], acc, 0, 0, 0);
        if (MODE == 2) {
            const LAS float* bp = t == 0 ? bp0 : bp1;
#pragma unroll
            for (int r = 0; r < 16; ++r) acc[r] = __builtin_fmaf(acc[r], SC, bp[(r & 3) + 8 * (r >> 2)]) + fmask[r];
        } else {
            if (MODE == 1 && (t == 0 ? mk0 : mk1)) { const int tb = t == 0 ? tb0 : tb1;
#pragma unroll
                for (int r = 0; r < 16; ++r) acc[r] = ((unsigned)(tb - ((r & 3) + 8 * (r >> 2))) <= 256u) ? acc[r] : -INFINITY;
            } else asm volatile("s_nop 15\n\ts_nop 7" : "+v"(acc));
        }
        s[t] = acc;
        tm = fmaxf(tm, max16f(acc));
    }
    if (MODE != 2) tm *= SC;
    if (__any(tm > m + THR)) {
        const float mn = fmaxf(m, xor32_max(tm)), al = __builtin_amdgcn_exp2f(m - mn); m = mn; ls *= al;
#pragma unroll
        for (int d = 0; d < 2; ++d) o[d] = o[d] * al;
    }
    const float nm = -m; f32x2v ps2 = {0.f, 0.f};
#pragma unroll
    for (int t = 0; t < 2; ++t) {
        if (!(t == 0 ? rel0 : rel1)) continue;
        const LAS unsigned char* Vt = t == 0 ? Vt0 : Vt1;
        f32x16 pv = MODE == 2 ? s[t] + nm : s[t] * SC + nm;
#pragma unroll
        for (int r = 0; r < 16; ++r) pv[r] = __builtin_amdgcn_exp2f(pv[r]);
#pragma unroll
        for (int r = 0; r < 16; r += 2) ps2 += (f32x2v){pv[r], pv[r + 1]};
#pragma unroll
        for (int st = 0; st < 2; ++st) {
            u32x4 pw; pw.x = cvtpk(pv[8 * st + 0], pv[8 * st + 1]); pw.y = cvtpk(pv[8 * st + 2], pv[8 * st + 3]); pw.z = cvtpk(pv[8 * st + 4], pv[8 * st + 5]); pw.w = cvtpk(pv[8 * st + 6], pv[8 * st + 7]);
            const bf16x8 pb = __builtin_bit_cast(bf16x8, pw);
#pragma unroll
            for (int db = 0; db < 2; ++db) {
                const v4i16_t t0 = __builtin_amdgcn_ds_read_tr16_b64_v4i16((LAS v4i16_t*)(Vt + st * 2048 + vb[db])), t1 = __builtin_amdgcn_ds_read_tr16_b64_v4i16((LAS v4i16_t*)(Vt + st * 2048 + 1024 + vb[db]));
                const bf16x8 vf = (bf16x8){t0[0], t0[1], t0[2], t0[3], t1[0], t1[1], t1[2], t1[3]};
                o[db] = __builtin_amdgcn_mfma_f32_32x32x16_bf16(vf, pb, o[db], 0, 0, 0);
            }
        }
    }
    ls += ps2[0] + ps2[1];
}
template <int KIND>
__device__ __forceinline__ void attn_item(const Params& p, int l, int item, LAS unsigned char* lds, int tid) {
    constexpr bool ISA = (KIND == 0 || KIND == 2);
    constexpr int NG = ISA ? 2 : 1;
    const int lane = tid & 63, w = __builtin_amdgcn_readfirstlane(tid >> 6), ql = lane & 31, hh = lane >> 5;
    const bf16_t* PB = (const bf16_t*)(p.ws + WS_PB); bf16_t* OB = (bf16_t*)(p.ws + WS_OB);
    int b, hx, blk;
    if (KIND == 0) { b = item >> 7; hx = (item >> 6) & 1; blk = item & 63; }
    else if (KIND == 1) { b = item / 192; hx = (item >> 5) % 6; blk = item & 31; }
    else if (KIND == 2) { b = item >> 2; hx = (item >> 1) & 1; blk = item & 1; }
    else { b = item / 6; hx = item % 6; blk = 0; }
    const size_t rowb = (size_t)b * SEQ, ctxb = (size_t)NLAT + (size_t)b * CTXL;
    const int kcol = ISA ? C_KA + hx * 64 : C_KN + hx * 64, vcol = ISA ? C_VA + hx * 64 : C_VN + hx * 64;
    int nwin = 0; size_t winrow0 = 0; int winpos0 = 0, krs0 = 0;
    if (KIND == 0) { const int first = blk == 0 ? 1 : 0, last = blk == 63 ? 2 : 3; nwin = last - first; winpos0 = 128 * (blk - 1 + first); winrow0 = rowb + winpos0; }
    if (KIND == 1) { krs0 = na_rs(4 * blk); nwin = (na_rs(4 * blk + 3) + 8 - krs0 + 1) >> 1; winrow0 = rowb + (size_t)krs0 * 64; }
    const int nch = nwin + 2;
    const bool active = true;
    int gh[NG], gp0[NG];
#pragma unroll
    for (int gi = 0; gi < NG; ++gi) {
        const int G = ISA ? (w < 4 ? 2 * w + gi : 8 + (w - 4)) : w;
        if (ISA) { gh[gi] = 3 * hx + (G >> 2); gp0[gi] = 128 * blk + 32 * (G & 3); }
        else if (KIND == 1) { gh[gi] = hx; gp0[gi] = 16 * (G & 3); }
        else { gh[gi] = hx; gp0[gi] = 32 * G; }
    }
    const int nrow0 = 4 * blk + 2 * (w >> 2);
    const int nrq = nrow0 + (ql >> 4), ncq = gp0[0] + (ql & 15);
#define FA_QROW(gi, ql_) (KIND == 0 ? rowb + gp0[gi] + (ql_) : KIND == 2 ? ctxb + gp0[gi] + (ql_) : KIND == 1 ? rowb + (size_t)(nrow0 + ((ql_) >> 4)) * 64 + gp0[gi] + ((ql_) & 15) : ctxb + gp0[gi] + (ql_))
    const int skey = 8 * w + (lane >> 3), spc = lane & 7;
    const int ksrc = skey * INW + kcol + ((spc ^ ((skey >> 1) & 7)) << 3);
    const int vsrc = skey * INW + vcol + (((((spc >> 1) ^ (skey & 2)) << 1) | (spc & 1)) << 3);
    const unsigned lds0 = (unsigned)(uintptr_t)lds;
    const int noff = KIND == 1 ? ((gp0[0] >> 4) == 0 ? 0 : ((gp0[0] >> 4) == 1 ? 8 : ((gp0[0] >> 4) == 2 ? 24 : 32))) : 0;
    int kb[4], kbw[4], vb[2];
#pragma unroll
    for (int ks = 0; ks < 4; ++ks) { kb[ks] = ql * 128 + (((2 * ks + hh) ^ ((ql >> 1) & 7)) << 4); kbw[ks] = ql * 128 + (((2 * ks + hh) ^ (((noff + ql) >> 1) & 7)) << 4); }
    { const int vk = 4 * hh + ((lane & 15) >> 2);
#pragma unroll
      for (int db = 0; db < 2; ++db) vb[db] = vk * 128 + (((2 * db + ((lane >> 4) & 1)) ^ (vk & 2)) << 5) + ((lane & 3) << 3); }
#define FA_DMA(ci) do { const size_t r0_ = (ci) < nwin ? winrow0 + (size_t)(ci) * 128 : ctxb + (size_t)((ci) - nwin) * 128; const bf16_t* s_ = PB + r0_ * INW; \
        const unsigned d_ = (unsigned)__builtin_amdgcn_readfirstlane((int)(lds0 + ((ci) % 3) * CHUNK_BYTES + w * 1024)); \
        glds16(s_ + ksrc, d_); glds16(s_ + 64 * INW + ksrc, d_ + 8192u); glds16(s_ + vsrc, d_ + 16384u); glds16(s_ + 64 * INW + vsrc, d_ + 24576u); } while (0)
    FA_DMA(0); FA_DMA(1);
    bf16x8 qf[NG][4];
#pragma unroll
    for (int gi = 0; gi < NG; ++gi)
#pragma unroll
        for (int ks = 0; ks < 4; ++ks) qf[gi][ks] = *(const bf16x8*)(PB + FA_QROW(gi, ql) * INW + (ISA ? C_QA : C_QN) + gh[gi] * 64 + 16 * ks + 8 * hh);
    f32x16 o[NG][2]; float m[NG], ls[NG];
#pragma unroll
    for (int gi = 0; gi < NG; ++gi) {
#pragma unroll
        for (int d = 0; d < 2; ++d)
#pragma unroll
            for (int r = 0; r < 16; ++r) o[gi][d][r] = 0.f;
        if (ISA) { m[gi] = p.attn_sink[l * 6 + gh[gi]] * LOG2E; ls[gi] = hh == 0 ? 1.f : 0.f; } else { m[gi] = -1e30f; ls[gi] = 0.f; }
    }
    f32x16 fmask;
#pragma unroll
    for (int r = 0; r < 16; ++r) fmask[r] = 0.f;
    if (KIND == 1) { const int cs = min(max(ncq - 8, 0), 48);
#pragma unroll
        for (int r = 0; r < 16; ++r) { const int ck = noff + (r & 3) + 8 * (r >> 2) + 4 * hh; fmask[r] = ((ck >= cs) && (ck < cs + 16)) ? 0.f : -INFINITY; } }
    const int nqrs = na_rs(nrq);
    LAS float* biasL = (LAS float*)(lds + BIAS_OFF);
    if (KIND == 1) { const float* rp = p.na_rpb + ((size_t)l * 6 + hx) * 15 * 31;
        for (int i = tid; i < 16 * 128; i += NTHREADS) { const int x = (i & 127) - 64; biasL[i] = (i >> 7) == 15 ? -INFINITY : ((x >= -15 && x <= 15) ? rp[(i >> 7) * 31 + x + 15] * LOG2E : 0.f); } }
    FA_WAIT_BAR(4);
#pragma unroll
    for (int gi = 0; gi < NG; ++gi) { asm volatile("" : "+v"(qf[gi][0]), "+v"(qf[gi][1]), "+v"(qf[gi][2]), "+v"(qf[gi][3])); }
#pragma unroll 1
    for (int ci = 0; ci < nch; ++ci) {
        if (ci + 2 < nch) FA_DMA(ci + 2);
        const LAS unsigned char* Kb = lds + (ci % 3) * CHUNK_BYTES; const LAS unsigned char* Vb = Kb + 16384;
        const bool iswin = ci < nwin;
        if (active) {
            if (KIND == 1 && iswin) {
                const int kr0 = krs0 + 2 * ci, rsA = na_rs(nrow0), rsB = na_rs(nrow0 + 1);
                const bool rel0 = (kr0 >= rsA) && (kr0 < rsB + 8), rel1 = (kr0 + 1 >= rsA) && (kr0 + 1 < rsB + 8);
                if (rel0 || rel1) {
                    const bool rowok0 = (kr0 >= nqrs) && (kr0 < nqrs + 8), rowok1 = (kr0 + 1 >= nqrs) && (kr0 + 1 < nqrs + 8);
                    const int bcol = 64 + noff + 4 * hh - ncq;
                    const LAS float* bp0 = biasL + (rowok0 ? kr0 - nrq + 7 : 15) * 128 + bcol; const LAS float* bp1 = biasL + (rowok1 ? kr0 + 1 - nrq + 7 : 15) * 128 + bcol;
                    unit32<2>(o[0], m[0], ls[0], qf[0], Kb + noff * 128, Kb + (64 + noff) * 128, Vb + noff * 128, Vb + (64 + noff) * 128, kbw, vb, rel0, rel1, false, false, 0, 0, fmask, bp0, bp1);
                }
            } else {
#pragma unroll 1
                for (int u = 0; u < 2; ++u) {
                    const LAS unsigned char* Kt = Kb + (64 * u) * 128; const LAS unsigned char* Vt = Vb + (64 * u) * 128;
#pragma unroll
                    for (int gi = 0; gi < NG; ++gi) {
                        if (ISA && gi == 1 && w >= 4) continue;
                        if (KIND == 0) {
                            bool rel[2] = {true, true}, msk[2] = {false, false};
                            if (iswin) {
#pragma unroll
                                for (int t = 0; t < 2; ++t) { const int j0 = winpos0 + 128 * ci + 64 * u + 32 * t, p0 = gp0[gi];
                                    rel[t] = (j0 + 31 >= p0 - 128) && (j0 <= p0 + 31 + 128); msk[t] = !((j0 >= p0 + 31 - 128) && (j0 + 31 <= p0 + 128)); } }
                            if (!(rel[0] || rel[1])) continue;
                            const int tb0 = gp0[gi] + ql - (winpos0 + 128 * ci + 64 * u) - 4 * hh + 128;
                            unit32<1>(o[gi], m[gi], ls[gi], qf[gi], Kt, Kt + 4096, Vt, Vt + 4096, kb, vb, rel[0], rel[1], msk[0], msk[1], tb0, tb0 - 32, fmask, nullptr, nullptr);
                        } else unit32<0>(o[gi], m[gi], ls[gi], qf[gi], Kt, Kt + 4096, Vt, Vt + 4096, kb, vb, true, true, false, false, 0, 0, fmask, nullptr, nullptr);
                    }
                }
            }
        }
        if (ci + 2 < nch) FA_WAIT_BAR(4); else FA_WAIT_BAR(0);
    }
#undef FA_DMA
    if (active) {
        int ql2 = lane & 31; asm volatile("" : "+v"(ql2));
#pragma unroll
        for (int gi = 0; gi < NG; ++gi) {
            if (ISA && gi == 1 && w >= 4) continue;
            const float lt = xor32_sum(ls[gi]);
            const float inv = 1.f / lt;
            bf16_t* op = OB + FA_QROW(gi, ql2) * DM + (ISA ? 0 : 640) + gh[gi] * 64 + 4 * hh;
#pragma unroll
            for (int db = 0; db < 2; ++db)
#pragma unroll
                for (int i = 0; i < 4; ++i) { u32x2 ov; ov.x = cvtpk(o[gi][db][4 * i] * inv, o[gi][db][4 * i + 1] * inv); ov.y = cvtpk(o[gi][db][4 * i + 2] * inv, o[gi][db][4 * i + 3] * inv); *(u32x2*)(op + 32 * db + 8 * i) = ov; }
        }
    }
#undef FA_QROW
}
__device__ __forceinline__ void phase_attn(const Params& p, int l, bool with_ctx, LAS unsigned char* lds, int bid, int nb) {
    bid = opaque_s(bid);
    const int n0 = NB * 2 * 64, n1 = NB * 6 * 32, n2 = with_ctx ? NB * 2 * 2 : 0, n3 = with_ctx ? NB * 6 : 0;
#pragma unroll 1
    for (int it = bid; it < n0 + n1 + n2 + n3; it += nb) {
        const int tid = opaque_tid();
#ifndef KMASK
#define KMASK 15
#endif
#ifndef ATT_DUP
#define ATT_DUP 0
#endif
        if (it < n0) { if (KMASK & 1) attn_item<0>(p, l, it, lds, tid); if (ATT_DUP & 1) attn_item<0>(p, l, it, lds, tid); }
        else if (it < n0 + n1) { if (KMASK & 2) attn_item<1>(p, l, it - n0, lds, tid); if (ATT_DUP & 2) attn_item<1>(p, l, it - n0, lds, tid); }
        else if (it < n0 + n1 + n2) { if (KMASK & 4) attn_item<2>(p, l, it - n0 - n1, lds, tid); }
        else { if (KMASK & 8) attn_item<3>(p, l, it - n0 - n1 - n2, lds, tid); }
    }
}
}

__device__ __forceinline__ float reduce16(const float (&t)[16], int lane) {
    float u[8], w4[4], x2[2];
#pragma unroll
    for (int e = 0; e < 8; ++e) { float a = t[e], b = t[e + 8]; asm volatile("s_nop 1\n\tv_permlane32_swap_b32 %0, %1" : "+v"(a), "+v"(b)); u[e] = a + b; }
#pragma unroll
    for (int e = 0; e < 4; ++e) { float a = u[e], b = u[e + 4]; asm volatile("s_nop 1\n\tv_permlane16_swap_b32 %0, %1" : "+v"(a), "+v"(b)); w4[e] = a + b; }
    const bool b3 = (lane & 8) != 0, b2 = (lane & 4) != 0;
#pragma unroll
    for (int e = 0; e < 2; ++e) { const float keep = b3 ? w4[e + 2] : w4[e], send = b3 ? w4[e] : w4[e + 2]; x2[e] = keep + dppf<0x128>(send); }
    const float keep = b2 ? x2[1] : x2[0], send = b2 ? x2[0] : x2[1];
    float y = keep + dppf<0x141>(send);
    y += dppf<0xB1>(y); y += dppf<0x4E>(y);
    return y;
}
__device__ __forceinline__ float wave_max(float v) {
    v = fmaxf(v, dppf<0xB1>(v)); v = fmaxf(v, dppf<0x4E>(v)); v = fmaxf(v, dppf<0x141>(v)); v = fmaxf(v, dppf<0x140>(v));
    return xor32_max(xor16_max(v));
}
__device__ __forceinline__ void phase_ln_router(const Params& p, int l, bool with_ctx, LAS unsigned char* lds, int bid, int nb) {
    bid = opaque_s(bid); const int tid = opaque_tid(), lane = tid & 63, gw = bid * NWAVES + (tid >> 6), NGW = nb * NWAVES;
    LAS float* wr = (LAS float*)lds;
    const float* wrg = p.w_router + (size_t)l * DM * NE;
    for (int i = tid; i < DM * NE; i += NTHREADS) { const int c = i >> 4, e = i & 15; wr[e * DM + c] = wrg[i]; }
    __syncthreads();
    const bf16_t* XB = (const bf16_t*)(p.ws + WS_XB); bf16_t* HB = (bf16_t*)(p.ws + WS_HB); float* AFF = (float*)(p.ws + WS_AFF);
    const float* g = p.ln1_g + l * DM; const float* bb = p.ln1_b + l * DM;
    const int nrows = with_ctx ? NROWS : NLAT;
    int myexp; { float idx[16];
#pragma unroll
        for (int e = 0; e < 16; ++e) idx[e] = (float)e;
        myexp = (int)(reduce16(idx, lane) * (1.f / 64.f) + 0.5f); }
    f32x4 v[4], vn[4];
    if (gw < nrows) row_load_bf16(XB + (size_t)gw * DM, lane, v);
#pragma unroll 1
    for (int row = gw; row < nrows; row += NGW) {
        const int rn = row + NGW;
        if (rn < nrows) row_load_bf16(XB + (size_t)rn * DM, lane, vn);
        row_normalize(v); row_affine(v, g, bb, lane);
        row_normalize(v);
        const float* m = mod_ptr(p, l, row_modrow(row)); row_modulate(v, m + 3 * DM, m + 4 * DM, lane);
        row_store_bf16(HB + (size_t)row * DM, lane, v);
        float t[16];
#pragma unroll
        for (int e = 0; e < 16; ++e) { float s = 0.f;
#pragma unroll
            for (int j = 0; j < 4; ++j) { const f32x4 wv = *(const LAS f32x4*)(wr + e * DM + 256 * j + 4 * lane); s += (v[j][0] * wv[0] + v[j][1] * wv[1]) + (v[j][2] * wv[2] + v[j][3] * wv[3]); }
            t[e] = s;
            if ((e & 3) == 3) asm volatile("" ::: "memory"); }
        const float lg = reduce16(t, lane);
        const float mx = wave_max(lg), ex = expf(lg - mx), sum = wave_sum(ex) * 0.25f;
        if ((lane & 3) == 0) AFF[(size_t)row * 16 + myexp] = ex / sum;
#pragma unroll
        for (int j = 0; j < 4; ++j) v[j] = vn[j];
    }
}

__device__ __forceinline__ void topk_item(const float* aff  , int n, int k, int row0  , int e, int slot0,
                                          int* TOK, float* GATE, int* INV, LAS unsigned char* lds) {
    const int tid = opaque_tid(), lane = tid & 63, w = tid >> 6;
    LAS unsigned* keys = (LAS unsigned*)lds;
    LAS unsigned* hist = keys + 8192;
    LAS unsigned* misc = hist + 256;
    for (int i = tid; i < n; i += NTHREADS) keys[i] = __builtin_bit_cast(unsigned, aff[(size_t)i * 16]);
    if (tid == 0) { misc[0] = 0u; misc[1] = (unsigned)k; }
    __syncthreads();
    unsigned maskv = 0u;
    for (int pass = 0; pass < 4; ++pass) {
        const int shift = 24 - 8 * pass;
        if (tid < 256) hist[tid] = 0u;
        __syncthreads();
        const unsigned prefix = misc[0];
        for (int i = tid; i < n; i += NTHREADS) { const unsigned kv = keys[i]; if ((kv & maskv) == prefix) atomicAdd((unsigned*)&hist[(kv >> shift) & 255u], 1u); }
        __syncthreads();
        if (w == 0) {
            const unsigned rem = misc[1];
            const unsigned h0 = hist[4 * lane], h1 = hist[4 * lane + 1], h2 = hist[4 * lane + 2], h3 = hist[4 * lane + 3], s4 = h0 + h1 + h2 + h3;
            unsigned S = s4;
#pragma unroll
            for (int o = 1; o < 64; o <<= 1) { const unsigned y = __shfl_down(S, o); if (lane + o < 64) S += y; }
            const unsigned above = S - s4;
            if (above < rem && rem <= S) { unsigned cum = above; int bin;
                if (cum + h3 >= rem) bin = 3; else { cum += h3; if (cum + h2 >= rem) bin = 2; else { cum += h2; if (cum + h1 >= rem) bin = 1; else { cum += h1; bin = 0; } } }
                misc[0] = prefix | ((unsigned)(4 * lane + bin) << shift); misc[1] = rem - cum; }
        }
        __syncthreads();
        maskv |= 255u << shift;
    }
    const unsigned T = misc[0], need_eq = misc[1];
    __syncthreads();
    const int per = n >= NTHREADS ? n / NTHREADS : 1; const int t0 = tid * per; const bool act = t0 < n;
    unsigned ce = 0u;
    if (act) for (int i = 0; i < per; ++i) ce += (keys[t0 + i] == T) ? 1u : 0u;
    unsigned inc = ce;
#pragma unroll
    for (int o = 1; o < 64; o <<= 1) { const unsigned y = __shfl_up(inc, o); if (lane >= o) inc += y; }
    if (lane == 63) misc[16 + w] = inc;
    __syncthreads();
    unsigned base = 0u;
    for (int ww = 0; ww < w; ++ww) base += misc[16 + ww];
    unsigned eqrank = base + inc - ce;
    __syncthreads();
    unsigned cs = 0u;
    if (act) { unsigned er = eqrank; for (int i = 0; i < per; ++i) { const unsigned kv = keys[t0 + i]; if (kv > T) cs++; else if (kv == T) { if (er < need_eq) cs++; er++; } } }
    inc = cs;
#pragma unroll
    for (int o = 1; o < 64; o <<= 1) { const unsigned y = __shfl_up(inc, o); if (lane >= o) inc += y; }
    if (lane == 63) misc[16 + w] = inc;
    __syncthreads();
    base = 0u;
    for (int ww = 0; ww < w; ++ww) base += misc[16 + ww];
    unsigned pos = base + inc - cs;
    if (act) { unsigned er = eqrank; for (int i = 0; i < per; ++i) { const unsigned kv = keys[t0 + i]; bool sel = false;
            if (kv > T) sel = true; else if (kv == T) { sel = er < need_eq; er++; }
            const int row = row0 + t0 + i;
            if (sel) { const int slot = slot0 + (int)pos; TOK[slot] = row; GATE[slot] = __builtin_bit_cast(float, kv); INV[(size_t)row * 16 + e] = slot; pos++; }
            else INV[(size_t)row * 16 + e] = -1; } }
    __syncthreads();
}
__device__ __forceinline__ void phase_topk(const Params& p, bool with_ctx, LAS unsigned char* lds, int bid, int nb) {
    const float* AFF = (const float*)(p.ws + WS_AFF); int* TOK = (int*)(p.ws + WS_TOK); float* GATE = (float*)(p.ws + WS_GATE); int* INV = (int*)(p.ws + WS_INV);
    const int nitems = with_ctx ? 128 : 64;
    for (int it = bid; it < nitems; it += nb) {
        if (it < 64) { const int b = it >> 4, e = it & 15; topk_item(AFF + (size_t)b * SEQ * 16 + e, SEQ, CAP, b * SEQ, e, (b * NE + e) * CAP, TOK, GATE, INV, lds); }
        else { const int b = (it - 64) >> 4, e = it & 15; topk_item(AFF + ((size_t)NLAT + (size_t)b * CTXL) * 16 + e, CTXL, CCAP, NLAT + b * CTXL, e, NSLOT_LAT + (e * NB + b) * CCAP, TOK, GATE, INV, lds); }
    }
}

__device__ __forceinline__ void phase_combine(const Params& p, int l, bool with_ctx, int bid, int nb) {
    bid = opaque_s(bid); const int tid = opaque_tid(); const int lane = tid & 63, gw = bid * NWAVES + (tid >> 6), NGW = nb * NWAVES;
    bf16_t* XB = (bf16_t*)(p.ws + WS_XB); bf16_t* HB = (bf16_t*)(p.ws + WS_HB);
    const bf16_t* Y = (const bf16_t*)(p.ws + WS_Y); const int* INV = (const int*)(p.ws + WS_INV);
    const float* g = p.ln2_g + l * DM; const float* bb = p.ln2_b + l * DM;
    const int nrows = with_ctx ? NROWS : NLAT;
    for (int row = gw; row < nrows; row += NGW) {
        bf16_t* xr = XB + (size_t)row * DM;
        f32x4 v[4]; row_load_bf16(xr, lane, v);
        row_normalize(v); row_affine(v, p.ln1_g + l * DM, p.ln1_b + l * DM, lane);
        f32x4 a[4];
#pragma unroll
        for (int j = 0; j < 4; ++j) a[j] = (f32x4){0.f, 0.f, 0.f, 0.f};
        const int myinv = INV[(size_t)row * 16 + (lane & 15)];
#pragma unroll
        for (int e = 0; e < 16; ++e) {
            const int slot = __builtin_amdgcn_readlane(myinv, e);
            if (slot >= 0) { const bf16_t* yr = Y + (size_t)slot * DM;
#pragma unroll
                for (int j = 0; j < 4; ++j) { const u32x2 wv = *(const u32x2*)(yr + 256 * j + 4 * lane); a[j][0] += bf_lo(wv.x); a[j][1] += bf_hi(wv.x); a[j][2] += bf_lo(wv.y); a[j][3] += bf_hi(wv.y); } }
        }
        const float* m = mod_ptr(p, l, row_modrow(row)) + 5 * DM;
#pragma unroll
        for (int j = 0; j < 4; ++j) { const f32x4 g2 = *(const f32x4*)(m + 256 * j + 4 * lane); v[j] = v[j] * ALPHA + g2 * a[j]; }
        row_normalize(v); row_affine(v, g, bb, lane);
        if (l + 1 < DEPTH) row_store_bf16(xr, lane, v); else row_store(p.out + (size_t)row * DM, lane, v);
        if (l + 1 < DEPTH) { row_normalize(v); const float* m2 = mod_ptr(p, l + 1, row_modrow(row)); row_modulate(v, m2, m2 + DM, lane); row_store_bf16(HB + (size_t)row * DM, lane, v); }
    }
}

constexpr int N_PHASES = 2 + 8 * DEPTH;
#define IN(k) (lo <= (k) && (k) < hi)
#ifndef TS_SEL
#define TS_SEL -1
#endif
#define TS_MULT 8
#define SEAM(k) do { if (IN(k) && IN((k) + 1)) xcd_barrier(bar); if (TS_SEL >= 0 && blockIdx.x == 0 && threadIdx.x == 0) ((unsigned long long*)(p.ws + WS_CTL + 65536))[(k) + 1] = __builtin_amdgcn_s_memrealtime(); } while (0)
#ifndef PHMASK
#define PHMASK 0x3ff
#endif
#define PHON(i) ((PHMASK >> (i)) & 1)
#ifndef DUP_MASK
#define DUP_MASK 0
#endif
#define DUP(i) ((DUP_MASK >> (i)) & 1)
template <int l>
__device__ __forceinline__ void run_layer(const Params& p, LAS unsigned char* lds, LAS int* idxl, const XcdBarrier& bar, int bid, int nb, int lo, int hi) {
    bf16_t* HB = (bf16_t*)(p.ws + WS_HB); bf16_t* PB = (bf16_t*)(p.ws + WS_PB); bf16_t* OB = (bf16_t*)(p.ws + WS_OB);
    bf16_t* HH = (bf16_t*)(p.ws + WS_HH); bf16_t* Y = (bf16_t*)(p.ws + WS_Y);
    const int* TOK = (const int*)(p.ws + WS_TOK); const float* GATE = (const float*)(p.ws + WS_GATE);
        const int pb = 2 + 8 * l; const bool wc = (l == 0);
        if (IN(pb + 0)) { if (PHON(2)) {
            const bf16_t* W = (const bf16_t*)(p.ws + WS_WIN) + (size_t)l * INW * DM; EpiQKV E{PB, (const float*)(p.ws + WS_ROPE)};
            { SgDesc g{HB + (size_t)NLAT * DM, DM, nullptr, W, 0, 1 << 30, 1, NCTX, INW, DM, NLAT}; sg_gemm(g, E, bid, nb); }
            { mg::Gemm g{HB, W, NLAT, INW, DM, nullptr, 0, 1 << 20, 1}; mg::StaticOrder S; S.init(NLAT, INW, nb, bid); mg::EpiAdapt<EpiQKV> EA{E, 0}; mg::gemm_phase(lds, idxl, g, S, EA); if (DUP(2)) mg::gemm_phase(lds, idxl, g, S, EA); } } }
        SEAM(pb + 0);
        if (IN(pb + 1)) { if (PHON(3)) {
#if FAST_ATTN
            fa::phase_attn(p, l, wc, lds, bid, nb); if (DUP(3)) fa::phase_attn(p, l, wc, lds, bid, nb);
#endif
            phase_mixers(p, l, wc, bid, nb); } }
        SEAM(pb + 1);
        if (IN(pb + 2)) { if (PHON(4)) {
            const bf16_t* W = (const bf16_t*)(p.ws + WS_WOUT) + (size_t)l * DM * DM;
            EpiOut<l == 0> E{p.x, p.ctx, (bf16_t*)(p.ws + WS_XB), mod_ptr(p, l, 0)};
            if (wc) { SgDesc g{OB + (size_t)NLAT * DM, DM, nullptr, W, 0, 1 << 30, 1, NCTX, DM, DM, NLAT}; sg_gemm(g, E, bid, nb); }
            { mg::Gemm g{OB, W, NLAT, DM, DM, nullptr, 0, 1 << 20, 1}; mg::StaticOrder S; S.init(NLAT, DM, nb, bid); mg::EpiAdapt<EpiOut<l == 0>> EA{E, 0}; mg::gemm_phase(lds, idxl, g, S, EA); if (DUP(4) && l == 0) mg::gemm_phase(lds, idxl, g, S, EA); } } }
        SEAM(pb + 2);
        if (IN(pb + 3)) { if (PHON(5)) phase_ln_router(p, l, wc, lds, bid, nb); }
        SEAM(pb + 3);
        if (IN(pb + 4)) { if (PHON(6)) phase_topk(p, wc, lds, bid, nb); if (DUP(6)) phase_topk(p, wc, lds, bid, nb); }
        SEAM(pb + 4);
        if (IN(pb + 5)) { if (PHON(7)) {
            const bf16_t* W = (const bf16_t*)(p.ws + WS_WGU) + (size_t)l * NE * 1024 * DM; EpiGU E{HH};
            if (wc) { SgDesc g{HB, DM, TOK + NSLOT_LAT, W, (size_t)1024 * DM, NB * CCAP, NE, NSLOT_CTX, 1024, DM, NSLOT_LAT}; sg_gemm(g, E, bid, nb); }
            { mg::Gemm g{HB, W, NSLOT_LAT, 1024, DM, TOK, (size_t)1024 * DM, CAP / 256, NE}; mg::StaticOrder S; S.init(NSLOT_LAT, 1024, nb, bid); mg::EpiAdapt<EpiGU> EA{E, 0}; mg::gemm_phase(lds, idxl, g, S, EA); if (DUP(7)) mg::gemm_phase(lds, idxl, g, S, EA); } } }
        SEAM(pb + 5);
        if (IN(pb + 6)) { if (PHON(8)) {
            const bf16_t* W = (const bf16_t*)(p.ws + WS_WD) + (size_t)l * NE * DM * FF; EpiDown E{Y, GATE};
            if (wc) { SgDesc g{HH + (size_t)NSLOT_LAT * FF, FF, nullptr, W, (size_t)DM * FF, NB * CCAP, NE, NSLOT_CTX, DM, FF, NSLOT_LAT}; sg_gemm(g, E, bid, nb); }
            { mg::Gemm g{HH, W, NSLOT_LAT, DM, FF, nullptr, (size_t)DM * FF, CAP / 256, NE}; mg::StaticOrder S; S.init(NSLOT_LAT, DM, nb, bid); mg::EpiAdapt<EpiDown> EA{E, 0}; mg::gemm_phase(lds, idxl, g, S, EA); if (DUP(8)) mg::gemm_phase(lds, idxl, g, S, EA); } } }
        SEAM(pb + 6);
        if (IN(pb + 7)) { if (PHON(9)) phase_combine(p, l, wc, bid, nb); }
        SEAM(pb + 7);
}
__global__ void __launch_bounds__(NTHREADS, 2) fwd_kernel(Params p) {
    extern __shared__ __attribute__((aligned(16))) unsigned char lds_raw[];
    LAS unsigned char* lds = (LAS unsigned char*)lds_raw;
    const int bid = blockIdx.x, nb = gridDim.x;
    volatile LAS unsigned* MISC = (volatile LAS unsigned*)(lds + LDS_BYTES - 64);
    LAS int* idxl = (LAS int*)(lds + mg::STAGE_BYTES);
    if (threadIdx.x < 16) MISC[threadIdx.x] = 0u;
    __syncthreads();
    XcdBarrier bar; bar.bar = (unsigned*)(p.ws + WS_CTL) + CW_BAR; bar.x = 0; bar.st = nullptr;
    const bool multi = p.ph_hi - p.ph_lo > 1;
    if (multi) bar = xcd_barrier_post((unsigned*)(p.ws + WS_CTL) + CW_BAR, MISC + 8);
    bf16_t* HB = (bf16_t*)(p.ws + WS_HB); bf16_t* PB = (bf16_t*)(p.ws + WS_PB); bf16_t* OB = (bf16_t*)(p.ws + WS_OB);
    bf16_t* HH = (bf16_t*)(p.ws + WS_HH); bf16_t* Y = (bf16_t*)(p.ws + WS_Y);
    const int* TOK = (const int*)(p.ws + WS_TOK); const float* GATE = (const float*)(p.ws + WS_GATE);
    const int lo = p.ph_lo, hi = p.ph_hi;
    if (TS_SEL >= 0 && blockIdx.x == 0 && threadIdx.x == 0) ((unsigned long long*)(p.ws + WS_CTL + 65536))[0] = __builtin_amdgcn_s_memrealtime();
    if (IN(0)) { if (PHON(0)) phase_prologue(p, lds, bid, nb); if (DUP(0)) { __syncthreads(); phase_prologue(p, lds, bid, nb); } } SEAM(0);
    if (IN(1)) { if (PHON(1)) phase_ln1(p, bid, nb); if (DUP(1)) phase_ln1(p, bid, nb); } SEAM(1);
    run_layer<0>(p, lds, idxl, bar, bid, nb, lo, hi);
    run_layer<1>(p, lds, idxl, bar, bid, nb, lo, hi);
    if (TS_SEL >= 0 && blockIdx.x == 0 && threadIdx.x == 0) {
        volatile unsigned long long* ts = (volatile unsigned long long*)(p.ws + WS_CTL + 65536); const unsigned long long dt = (ts[TS_SEL + 1] - ts[TS_SEL]) * TS_MULT, t0 = __builtin_amdgcn_s_memrealtime();
        while (__builtin_amdgcn_s_memrealtime() - t0 < dt) __builtin_amdgcn_s_sleep(8); }
#undef IN
#undef SEAM
}

#ifndef N_LAUNCH_SPLIT
#define N_LAUNCH_SPLIT 0
#endif
extern "C" void kernel_launch(void* const* d_in, const int* in_sizes, int n_in, void* d_out, int out_size, void* d_ws, size_t ws_size, hipStream_t stream) {
    static int grid = 0;
    if (grid == 0) {
        if (n_in != 19 || in_sizes[0] != NLAT * DM || out_size != NLAT * DM || ws_size < WS_END) { fprintf(stderr, "kernel_launch: unexpected shapes (n_in %d, in0 %d, out %d, ws %zu)\n", n_in, n_in > 0 ? in_sizes[0] : -1, out_size, ws_size); grid = -1; return; }
        int dev = 0, cus = 0, per_cu = 0;
        if (hipGetDevice(&dev) != hipSuccess || hipDeviceGetAttribute(&cus, hipDeviceAttributeMultiprocessorCount, dev) != hipSuccess) { grid = -1; return; }
        if (hipFuncSetAttribute((const void*)fwd_kernel, hipFuncAttributeMaxDynamicSharedMemorySize, LDS_BYTES) != hipSuccess) { fprintf(stderr, "kernel_launch: hipFuncSetAttribute failed\n"); grid = -1; return; }
        if (hipOccupancyMaxActiveBlocksPerMultiprocessor(&per_cu, (const void*)fwd_kernel, NTHREADS, LDS_BYTES) != hipSuccess || per_cu < 1) { fprintf(stderr, "kernel_launch: occupancy query says %d\n", per_cu); per_cu = 1; }
        (void)hipGetLastError();
        grid = cus;
    }
    if (grid < 0) return;
    (void)hipMemsetAsync((char*)d_ws + WS_CTL, 0, CTL_ZERO_BYTES, stream);
    Params p{};
    const float** pp = (const float**)&p;
    for (int i = 0; i < 19; ++i) pp[i] = (const float*)d_in[i];
    p.out = (float*)d_out; p.ws = (unsigned char*)d_ws;
#if N_LAUNCH_SPLIT
    for (int ph = 0; ph < N_PHASES; ++ph) { p.ph_lo = ph; p.ph_hi = ph + 1; hipLaunchKernelGGL(fwd_kernel, dim3(grid), dim3(NTHREADS), LDS_BYTES, stream, p); }
#else
    p.ph_lo = 0; p.ph_hi = N_PHASES;
    void* args[] = {&p};
    hipError_t e = hipLaunchCooperativeKernel((const void*)fwd_kernel, dim3(grid), dim3(NTHREADS), args, LDS_BYTES, stream);
    if (e != hipSuccess) fprintf(stderr, "kernel_launch: cooperative launch failed: %s\n", hipGetErrorString(e));
#endif
}
```

```cpp
#include <hip/hip_runtime.h>
#include <hip/hip_cooperative_groups.h>
#include <cstdio>
#include <cstdint>
#include <cmath>

#define LAS __attribute__((address_space(3)))
typedef unsigned short bf16_t;
typedef short bf16x8 __attribute__((ext_vector_type(8)));
typedef float f32x4 __attribute__((ext_vector_type(4)));
typedef unsigned u32x4 __attribute__((ext_vector_type(4)));
typedef unsigned u32x2 __attribute__((ext_vector_type(2)));

constexpr int NB = 4, SEQ = 8192, DM = 1024, CTXL = 256, DEPTH = 2;
constexpr int NLAT = NB * SEQ, NCTX = NB * CTXL, NROWS = NLAT + NCTX;
constexpr int INW = 2560, NE = 16, FF = 512, CAP = 1024, CCAP = 32;
constexpr int NSLOT_LAT = NB * NE * CAP, NSLOT_CTX = NB * NE * CCAP, NSLOT = NSLOT_LAT + NSLOT_CTX;
constexpr int NMOD = 6 * DM;
constexpr float LN_EPS = 1e-6f;
constexpr float ALPHA = 1.41421356237309515f;
constexpr int C_QA = 0, C_KA = 384, C_VA = 512, C_BX = 640, C_BB = 896, C_BC = 1152, C_QN = 1408, C_KN = 1792, C_VN = 2176;

#ifndef FAST_ATTN
#define FAST_ATTN 1
#endif
constexpr int NTHREADS = 512, NWAVES = 8;
constexpr int LDS_BYTES = 147456;

constexpr size_t MiB = 1u << 20;
constexpr size_t WS_CTL = 0, CTL_ZERO_BYTES = 1 * MiB;
constexpr size_t WS_ROPE = 1 * MiB;
constexpr size_t WS_MOD = 1 * MiB + 65536;
constexpr size_t WS_AFF = 2 * MiB;
constexpr size_t WS_INV = 5 * MiB;
constexpr size_t WS_TOK = 8 * MiB;
constexpr size_t WS_GATE = 8 * MiB + 512 * 1024;
constexpr size_t WS_CXR = 9 * MiB;
constexpr size_t WS_WIN = 16 * MiB;
constexpr size_t WS_WOUT = 26 * MiB;
constexpr size_t WS_WGU = 30 * MiB;
constexpr size_t WS_WD = 94 * MiB;
constexpr size_t WS_HB = 126 * MiB;
constexpr size_t WS_OB = 192 * MiB;
constexpr size_t WS_HH = 192 * MiB;
constexpr size_t WS_PB = 258 * MiB;
constexpr size_t WS_Y = 258 * MiB;
constexpr size_t WS_XB = 424 * MiB;
constexpr size_t WS_END = 490 * MiB;
static_assert(WS_HB + (size_t)NROWS * DM * 2 <= WS_OB && WS_OB + (size_t)NROWS * DM * 2 <= WS_PB && WS_PB + (size_t)NROWS * INW * 2 <= WS_XB && WS_XB + (size_t)NROWS * DM * 2 <= WS_END, "ws map");
static_assert((size_t)NSLOT * FF * 2 <= (size_t)NROWS * DM * 2 && (size_t)NSLOT * DM * 2 <= (size_t)NROWS * INW * 2, "overlays");
constexpr int CW_BAR = 4096;

struct Params {
    const float *x, *c, *ctx, *c_ctx, *w_mod, *b_mod, *w_in, *conv_w, *attn_sink, *na_rpb, *w_out, *ln1_g, *ln1_b, *w_router, *w_gate, *w_up, *w_down, *ln2_g, *ln2_b;
    float* out; unsigned char* ws;
    int ph_lo, ph_hi;
};

__device__ __forceinline__ unsigned f2bf(float f) { unsigned u = __builtin_bit_cast(unsigned, f); return (u + 0x7fffu + ((u >> 16) & 1u)) >> 16; }
__device__ __forceinline__ unsigned pk2(float lo, float hi) { return f2bf(lo) | (f2bf(hi) << 16); }
__device__ __forceinline__ float bf_lo(unsigned w) { return __builtin_bit_cast(float, w << 16); }
__device__ __forceinline__ float bf_hi(unsigned w) { return __builtin_bit_cast(float, w & 0xffff0000u); }
template <int CTRL> __device__ __forceinline__ float dppf(float v) { return __builtin_bit_cast(float, __builtin_amdgcn_update_dpp(0, __builtin_bit_cast(int, v), CTRL, 0xf, 0xf, true)); }
__device__ __forceinline__ void swap16(float v, float& a, float& b) { a = v; b = v; asm volatile("s_nop 1\n\tv_permlane16_swap_b32 %0, %1" : "+v"(a), "+v"(b)); }
__device__ __forceinline__ void swap32(float v, float& a, float& b) { a = v; b = v; asm volatile("s_nop 1\n\tv_permlane32_swap_b32 %0, %1" : "+v"(a), "+v"(b)); }
__device__ __forceinline__ float xor16_sum(float v) { float a, b; swap16(v, a, b); return a + b; }
__device__ __forceinline__ float xor32_sum(float v) { float a, b; swap32(v, a, b); return a + b; }
__device__ __forceinline__ float xor16_max(float v) { float a, b; swap16(v, a, b); return fmaxf(a, b); }
__device__ __forceinline__ float xor32_max(float v) { float a, b; swap32(v, a, b); return fmaxf(a, b); }
__device__ __forceinline__ float wave_sum(float v) {
    v += dppf<0xB1>(v); v += dppf<0x4E>(v); v += dppf<0x141>(v); v += dppf<0x140>(v);
    return xor32_sum(xor16_sum(v));
}
#define LDS_WAIT() asm volatile("s_waitcnt lgkmcnt(0)" ::: "memory")
__device__ __forceinline__ int opaque_tid() { int t = threadIdx.x; asm volatile("" : "+v"(t)); return t; }
__device__ __forceinline__ int opaque_s(int v) { asm volatile("" : "+s"(v)); return v; }

__device__ __forceinline__ float* mod_ptr(const Params& p, int l, int r) { return (float*)(p.ws + WS_MOD) + ((size_t)l * 5 + r) * NMOD; }

#define XB_TMO      128
#define XB_XCNT(j)  (256  + 64 * (j))
#define XB_XSUB(j)  (1280 + 64 * (j))
#define XB_XGEN(j)  (2304 + 64 * (j))
#define XB_TOP      3328
#define XB_TOPGEN   3392
#define XCD_BAR_WORDS 3456
#define XB_SPIN_CAP (1u << 20)
__device__ __forceinline__ unsigned xb_ld(unsigned* p)              { return __hip_atomic_load(p, __ATOMIC_RELAXED, __HIP_MEMORY_SCOPE_AGENT); }
__device__ __forceinline__ unsigned xb_add(unsigned* p, unsigned v) { return __hip_atomic_fetch_add(p, v, __ATOMIC_RELAXED, __HIP_MEMORY_SCOPE_AGENT); }
__device__ __forceinline__ unsigned xb_xcc_id() { return (unsigned)__builtin_amdgcn_s_getreg((3 << 11) | 20) & 0xFu; }
#define XB_SPIN(cond, bar) do { unsigned _sp = 0; while (cond) { __builtin_amdgcn_s_sleep(1); \
    if ((++_sp & 255u) == 0u) { if (xb_ld(&(bar)[XB_TMO])) break; if (_sp > XB_SPIN_CAP) { atomicAdd(&(bar)[XB_TMO], 1u); break; } } } } while (0)
struct XcdBarrier { unsigned* bar; unsigned x; volatile LAS unsigned* st; };
__device__ __forceinline__ XcdBarrier xcd_barrier_post(unsigned* bar, volatile LAS unsigned* st) {
    XcdBarrier b; b.bar = bar; b.x = xb_xcc_id(); b.st = st;
    if (threadIdx.x == 0) (void)xb_add(&bar[XB_XCNT(b.x)], 1u);
    return b;
}
__device__ __forceinline__ void xcd_barrier_complete(unsigned* bar, unsigned x, unsigned& nloc, unsigned& nx) {
    const unsigned G = gridDim.x * gridDim.y * gridDim.z;
    unsigned sum, cnt, mine, sp = 0u;
    for (;;) {
        sum = 0u; cnt = 0u; mine = 0u;
#pragma unroll 1
        for (unsigned j = 0; j < 16; ++j) { const unsigned c = xb_ld(&bar[XB_XCNT(j)]); sum += c; cnt += (c > 0u) ? 1u : 0u; mine = (j == x) ? c : mine; }
        if (sum == G) break;
        __builtin_amdgcn_s_sleep(1);
        if ((++sp & 255u) == 0u) { if (xb_ld(&bar[XB_TMO])) break; if (sp > XB_SPIN_CAP) { atomicAdd(&bar[XB_TMO], 1u); break; } }
    }
    nloc = mine > 0u ? mine : 1u; nx = cnt > 0u ? cnt : 1u;
}
__device__ __forceinline__ void xcd_barrier(const XcdBarrier& b) {
    asm volatile("s_waitcnt vmcnt(0)" ::: "memory");
    __syncthreads();
    if (threadIdx.x == 0) {
        unsigned* bar = b.bar; asm volatile("" : "+s"(bar));
        __builtin_amdgcn_s_waitcnt(0);
        unsigned nloc = b.st[0], nx = b.st[1];
        if (nloc == 0u) { xcd_barrier_complete(bar, b.x, nloc, nx); b.st[0] = nloc; b.st[1] = nx; }
        const unsigned old = xb_add(&bar[XB_XSUB(b.x)], 1u);
        const unsigned gen = old / nloc;
        if (old + 1u == (gen + 1u) * nloc) {
            __builtin_amdgcn_fence(__ATOMIC_RELEASE, "agent");
            asm volatile("s_waitcnt vmcnt(0)" ::: "memory");
            const unsigned og = xb_add(&bar[XB_TOP], 1u);
            const unsigned tg = og / nx;
            if (og + 1u == (tg + 1u) * nx) xb_add(&bar[XB_TOPGEN], 1u);
            else XB_SPIN(xb_ld(&bar[XB_TOPGEN]) == tg, bar);
            __builtin_amdgcn_fence(__ATOMIC_ACQUIRE, "agent");
            xb_add(&bar[XB_XGEN(b.x)], 1u);
            asm volatile("s_waitcnt vmcnt(0)" ::: "memory");
        } else {
            XB_SPIN(xb_ld(&bar[XB_XGEN(b.x)]) == gen, bar);
            __builtin_amdgcn_fence(__ATOMIC_ACQUIRE, "agent");
            asm volatile("s_waitcnt vmcnt(0)" ::: "memory");
        }
    }
    __syncthreads();
}

struct TrItem { const float* W; bf16_t* WT; int K, N, mode, item; };
__device__ __forceinline__ void tr_load(const TrItem& t, int lane, float (&r)[32]) {
    const int nblk = t.N / 32, kb = t.item / nblk, nb = t.item % nblk, k0 = 64 * kb, n0 = 32 * nb;
    const float* src = t.W + (size_t)(k0 + (lane >> 5)) * t.N + n0 + (lane & 31);
#pragma unroll
    for (int i = 0; i < 32; ++i) r[i] = src[(size_t)(2 * i) * t.N];
}
__device__ __forceinline__ void tr_finish(const TrItem& t, int lane, const float (&r)[32], LAS float* scr) {
    const int nblk = t.N / 32, kb = t.item / nblk, nb = t.item % nblk, k0 = 64 * kb, n0 = 32 * nb;
#pragma unroll
    for (int i = 0; i < 32; ++i) scr[(2 * i + (lane >> 5)) * 33 + (lane & 31)] = r[i];
    LDS_WAIT();
    const int c = lane & 7;
#pragma unroll
    for (int j = 0; j < 4; ++j) {
        const int n = (lane >> 3) + 8 * j; const LAS float* s = scr + (8 * c) * 33 + n;
        u32x4 o; o.x = pk2(s[0 * 33], s[1 * 33]); o.y = pk2(s[2 * 33], s[3 * 33]); o.z = pk2(s[4 * 33], s[5 * 33]); o.w = pk2(s[6 * 33], s[7 * 33]);
        const int f = n0 + n;
        const int orow = t.mode == 0 ? ((f & ~255) + 128 * ((f >> 4) & 1) + 32 * ((f >> 6) & 3) + 16 * ((f >> 2) & 1) + 4 * (2 * ((f >> 5) & 1) + ((f >> 3) & 1)) + (f & 3))
                                     : (256 * (f >> 7) + (t.mode == 2 ? 128 : 0) + 32 * ((f >> 5) & 3) + 16 * ((f >> 2) & 1) + 4 * ((f >> 3) & 3) + (f & 3));
        *(u32x4*)(t.WT + (size_t)orow * t.K + k0 + 8 * c) = o;
    }
    LDS_WAIT();
}
__device__ __forceinline__ void phase_prologue(const Params& p, LAS unsigned char* lds, int bid, int nb) {
    bid = opaque_s(bid); const int tid = opaque_tid(), lane = tid & 63, w = tid >> 6;
    {
        LAS float* ssil = (LAS float*)lds;
        LAS float* red = ssil + 5 * 1024;
        for (int i = tid; i < 5 * 1024; i += NTHREADS) { const int r = i >> 10, k = i & 1023; const float v = r < 4 ? p.c[r * 1024 + k] : p.c_ctx[k]; ssil[i] = v / (1.f + expf(-v)); }
        __syncthreads();
        for (int item = bid; item < 2 * 96; item += nb) {
            const int l = item / 96, n0 = (item % 96) * 64;
            const float* W = p.w_mod + (size_t)l * DM * NMOD + n0 + lane;
            float a0 = 0.f, a1 = 0.f, a2 = 0.f, a3 = 0.f, a4 = 0.f;
#pragma unroll 8
            for (int k = w * 128; k < w * 128 + 128; ++k) {
                const float wv = W[(size_t)k * NMOD];
                a0 += ssil[k] * wv; a1 += ssil[1024 + k] * wv; a2 += ssil[2048 + k] * wv; a3 += ssil[3072 + k] * wv; a4 += ssil[4096 + k] * wv;
            }
            red[(w * 5 + 0) * 64 + lane] = a0; red[(w * 5 + 1) * 64 + lane] = a1; red[(w * 5 + 2) * 64 + lane] = a2; red[(w * 5 + 3) * 64 + lane] = a3; red[(w * 5 + 4) * 64 + lane] = a4;
            __syncthreads();
            if (tid < 320) { const int r = tid >> 6; float s = 0.f;
#pragma unroll
                for (int ww = 0; ww < 8; ++ww) s += red[(ww * 5 + r) * 64 + lane];
                mod_ptr(p, l, r)[n0 + lane] = s + p.b_mod[l * NMOD + n0 + lane]; }
            __syncthreads();
        }
    }
    if (bid == nb - 1) {
        float* rope = (float*)(p.ws + WS_ROPE);
        for (int e = tid; e < 128 * 16; e += NTHREADS) {
            const int pos = e >> 4, i = e & 15;
            const double a = exp(-((double)i / 16.0) * 9.210340371976184);
            const double a2 = a * a; double c = 1.0, s = a, tc = 1.0, ts = a;
            for (int n = 1; n <= 14; ++n) { tc *= -a2 / (double)((2 * n - 1) * (2 * n)); c += tc; ts *= -a2 / (double)((2 * n) * (2 * n + 1)); s += ts; }
            double rc = 1.0, rs = 0.0, bc = c, bs = s; int q = pos;
            while (q) { if (q & 1) { const double t = rc * bc - rs * bs; rs = rc * bs + rs * bc; rc = t; } const double t = bc * bc - bs * bs; bs = 2.0 * bc * bs; bc = t; q >>= 1; }
            rope[2 * e] = (float)rc; rope[2 * e + 1] = (float)rs;
        }
    }
    __syncthreads();
    {
        LAS float* scr = (LAS float*)lds + w * (64 * 33);
        const int gw = bid * NWAVES + w, NGW = nb * NWAVES;
        constexpr int I_IN = 16 * 80, I_OUT = 16 * 32, I_G = 16 * 16, I_D = 8 * 32;
        constexpr int PER_L = I_IN + I_OUT + 16 * (2 * I_G + I_D);
        auto decode = [&](int it) -> TrItem {
            const int l = it / PER_L; int r = it % PER_L;
            if (r < I_IN) return TrItem{p.w_in + (size_t)l * DM * INW, (bf16_t*)(p.ws + WS_WIN) + (size_t)l * INW * DM, DM, INW, 0, r}; r -= I_IN;
            if (r < I_OUT) return TrItem{p.w_out + (size_t)l * DM * DM, (bf16_t*)(p.ws + WS_WOUT) + (size_t)l * DM * DM, DM, DM, 0, r}; r -= I_OUT;
            if (r < 16 * I_G) { const int e = r / I_G; return TrItem{p.w_gate + ((size_t)l * NE + e) * DM * FF, (bf16_t*)(p.ws + WS_WGU) + ((size_t)l * NE + e) * 1024 * DM, DM, FF, 1, r % I_G}; } r -= 16 * I_G;
            if (r < 16 * I_G) { const int e = r / I_G; return TrItem{p.w_up + ((size_t)l * NE + e) * DM * FF, (bf16_t*)(p.ws + WS_WGU) + ((size_t)l * NE + e) * 1024 * DM, DM, FF, 2, r % I_G}; } r -= 16 * I_G;
            const int e = r / I_D; return TrItem{p.w_down + ((size_t)l * NE + e) * FF * DM, (bf16_t*)(p.ws + WS_WD) + ((size_t)l * NE + e) * DM * FF, FF, DM, 0, r % I_D};
        };
        float ra[32], rb[32];
        int it = gw;
        if (it < 2 * PER_L) { TrItem cur = decode(it); tr_load(cur, lane, ra);
#pragma unroll 1
            for (;;) {
                const int itn = it + NGW; const bool hn = itn < 2 * PER_L; TrItem nx = cur;
                if (hn) { nx = decode(itn); tr_load(nx, lane, rb); }
                tr_finish(cur, lane, ra, scr);
                if (!hn) break;
                const int itn2 = itn + NGW; const bool hn2 = itn2 < 2 * PER_L; TrItem nx2 = nx;
                if (hn2) { nx2 = decode(itn2); tr_load(nx2, lane, ra); }
                tr_finish(nx, lane, rb, scr);
                if (!hn2) break;
                cur = nx2; it = itn2;
            }
        }
    }
}

__device__ __forceinline__ void row_load(const float* rowp, int lane, f32x4 (&v)[4]) {
#pragma unroll
    for (int j = 0; j < 4; ++j) v[j] = *(const f32x4*)(rowp + 256 * j + 4 * lane);
}
__device__ __forceinline__ void row_load_bf16(const bf16_t* rowp, int lane, f32x4 (&v)[4]) {
#pragma unroll
    for (int j = 0; j < 4; ++j) { const u32x2 w = *(const u32x2*)(rowp + 256 * j + 4 * lane); v[j] = (f32x4){bf_lo(w.x), bf_hi(w.x), bf_lo(w.y), bf_hi(w.y)}; }
}
__device__ __forceinline__ void row_store(float* rowp, int lane, const f32x4 (&v)[4]) {
#pragma unroll
    for (int j = 0; j < 4; ++j) *(f32x4*)(rowp + 256 * j + 4 * lane) = v[j];
}
__device__ __forceinline__ void row_store_bf16(bf16_t* rowp, int lane, const f32x4 (&v)[4]) {
#pragma unroll
    for (int j = 0; j < 4; ++j) { u32x2 o; o.x = pk2(v[j][0], v[j][1]); o.y = pk2(v[j][2], v[j][3]); *(u32x2*)(rowp + 256 * j + 4 * lane) = o; }
}
__device__ __forceinline__ void row_normalize(f32x4 (&v)[4]) {
    float s = 0.f;
#pragma unroll
    for (int j = 0; j < 4; ++j) s += (v[j][0] + v[j][1]) + (v[j][2] + v[j][3]);
    const float mean = wave_sum(s) * (1.f / DM);
    float q = 0.f;
#pragma unroll
    for (int j = 0; j < 4; ++j) { v[j] = v[j] - mean; q += (v[j][0] * v[j][0] + v[j][1] * v[j][1]) + (v[j][2] * v[j][2] + v[j][3] * v[j][3]); }
    const float rstd = 1.f / sqrtf(wave_sum(q) * (1.f / DM) + LN_EPS);
#pragma unroll
    for (int j = 0; j < 4; ++j) v[j] = v[j] * rstd;
}
__device__ __forceinline__ void row_modulate(f32x4 (&v)[4], const float* sh, const float* sc, int lane) {
#pragma unroll
    for (int j = 0; j < 4; ++j) { const f32x4 a = *(const f32x4*)(sc + 256 * j + 4 * lane), b = *(const f32x4*)(sh + 256 * j + 4 * lane); v[j] = v[j] * (a + 1.f) + b; }
}
__device__ __forceinline__ void row_affine(f32x4 (&v)[4], const float* g, const float* bb, int lane) {
#pragma unroll
    for (int j = 0; j < 4; ++j) { const f32x4 a = *(const f32x4*)(g + 256 * j + 4 * lane), b = *(const f32x4*)(bb + 256 * j + 4 * lane); v[j] = v[j] * a + b; }
}
__device__ __forceinline__ int row_modrow(int row) { return row < NLAT ? (row >> 13) : 4; }

__device__ __forceinline__ void phase_ln1(const Params& p, int bid, int nb) {
    bid = opaque_s(bid); const int tid = opaque_tid(), lane = tid & 63, gw = bid * NWAVES + (tid >> 6), NGW = nb * NWAVES;
    bf16_t* HB = (bf16_t*)(p.ws + WS_HB);
    f32x4 v[4], vn[4];
    if (gw < NROWS) row_load(gw < NLAT ? p.x + (size_t)gw * DM : p.ctx + (size_t)(gw - NLAT) * DM, lane, v);
#pragma unroll 1
    for (int row = gw; row < NROWS; row += NGW) {
        const int rn = row + NGW;
        if (rn < NROWS) row_load(rn < NLAT ? p.x + (size_t)rn * DM : p.ctx + (size_t)(rn - NLAT) * DM, lane, vn);
        row_normalize(v);
        const float* m = mod_ptr(p, 0, row_modrow(row)); row_modulate(v, m, m + DM, lane);
        row_store_bf16(HB + (size_t)row * DM, lane, v);
#pragma unroll
        for (int j = 0; j < 4; ++j) v[j] = vn[j];
    }
}

struct SgDesc { const bf16_t* A; int lda; const int* rowidx; const bf16_t* Bt; size_t grp_stride; int rows_per_grp, ngrp; int M, N, K; int row_base; };
template <class Epi>
__device__ __forceinline__ void sg_gemm(const SgDesc& g, const Epi& E, int bid, int nb) {
    bid = opaque_s(bid); const int tid = opaque_tid(); const int lane = tid & 63, w = __builtin_amdgcn_readfirstlane(tid >> 6), fr = lane & 15, fq = lane >> 4;
    const int tilesN = g.N / 64, tiles = (g.M / 64) * tilesN;
#pragma unroll 1
    for (int t = bid + nb * w; t < tiles; t += nb * NWAVES) {
        const int tm = t / tilesN, tn = t % tilesN, pn = tn >> 2, wc = tn & 3;
        const int row0 = tm * 64;
        const bf16_t* Bt = g.Bt + (size_t)((row0 / g.rows_per_grp) % g.ngrp) * g.grp_stride;
        const bf16_t* ap[4]; const bf16_t* bp[4];
#pragma unroll
        for (int i = 0; i < 4; ++i) { const int r = row0 + 16 * i + fr; const int ar = g.rowidx ? g.rowidx[r] : r; ap[i] = g.A + (size_t)ar * g.lda + 8 * fq; }
#pragma unroll
        for (int n = 0; n < 4; ++n) bp[n] = Bt + (size_t)(256 * pn + 128 * (n >> 1) + 32 * wc + 16 * (n & 1) + fr) * g.K + 8 * fq;
        f32x4 acc[4][4];
#pragma unroll
        for (int i = 0; i < 4; ++i)
#pragma unroll
            for (int n = 0; n < 4; ++n) acc[i][n] = (f32x4){0.f, 0.f, 0.f, 0.f};
        bf16x8 a0[4], b0[4], a1[4], b1[4], a2[4], b2[4], a3[4], b3[4];
#define SG_LOAD(A_, B_, k_) do { _Pragma("unroll") for (int i = 0; i < 4; ++i) { A_[i] = *(const bf16x8*)(ap[i] + (k_)); B_[i] = *(const bf16x8*)(bp[i] + (k_)); } } while (0)
#define SG_MMA(A_, B_) do { _Pragma("unroll") for (int i = 0; i < 4; ++i) _Pragma("unroll") for (int n = 0; n < 4; ++n) acc[i][n] = __builtin_amdgcn_mfma_f32_16x16x32_bf16(B_[n], A_[i], acc[i][n], 0, 0, 0); } while (0)
        SG_LOAD(a0, b0, 0); SG_LOAD(a1, b1, 32); SG_LOAD(a2, b2, 64);
#pragma unroll 1
        for (int k = 0; k < g.K; k += 128) {
            SG_LOAD(a3, b3, k + 96); SG_MMA(a0, b0);
            if (k + 128 < g.K) SG_LOAD(a0, b0, k + 128);
            SG_MMA(a1, b1);
            if (k + 128 < g.K) SG_LOAD(a1, b1, k + 160);
            SG_MMA(a2, b2);
            if (k + 128 < g.K) SG_LOAD(a2, b2, k + 192);
            SG_MMA(a3, b3);
        }
#undef SG_LOAD
#undef SG_MMA
#pragma unroll
        for (int i = 0; i < 4; ++i) {
            const float rv = E.rowval(g.row_base + row0 + 16 * i + fr);
            E(g.row_base + row0 + 16 * i + fr, pn, wc, fq, acc[i][0], acc[i][1], acc[i][2], acc[i][3], rv);
            asm volatile("" ::: "memory"); }
    }
}

__device__ __forceinline__ void store_bf16x8(bf16_t* p, const f32x4 a, const f32x4 b) { u32x4 o; o.x = pk2(a[0], a[1]); o.y = pk2(a[2], a[3]); o.z = pk2(b[0], b[1]); o.w = pk2(b[2], b[3]); *(u32x4*)p = o; }
__device__ __forceinline__ int epi_col(int pn, int wc, int fq) { return 256 * pn + 64 * wc + 32 * (fq >> 1) + 8 * (fq & 1); }

struct EpiQKV {
    bf16_t* PB; const float* rope;
    __device__ __forceinline__ float rowval(int) const { return 0.f; }
    __device__ __forceinline__ void operator()(int row, int pn, int wc, int fq, f32x4 a0, f32x4 a1, f32x4 b0, f32x4 b1, float) const {
        const int c = epi_col(pn, wc, fq);
        if (c < 512 && row < NLAT) {
            const int t = row & (SEQ - 1); const int pos = (fq >> 1) ? (t & 63) : (t >> 6);
            const f32x4* rp = (const f32x4*)(rope + (pos * 16 + 8 * (fq & 1)) * 2);
            const f32x4 r0 = rp[0], r1 = rp[1], r2 = rp[2], r3 = rp[3];
            const f32x4 cs0 = {r0[0], r0[2], r1[0], r1[2]}, sn0 = {r0[1], r0[3], r1[1], r1[3]}, cs1 = {r2[0], r2[2], r3[0], r3[2]}, sn1 = {r2[1], r2[3], r3[1], r3[3]};
            const f32x4 na0 = a0 * cs0 - b0 * sn0, nb0 = b0 * cs0 + a0 * sn0, na1 = a1 * cs1 - b1 * sn1, nb1 = b1 * cs1 + a1 * sn1;
            a0 = na0; b0 = nb0; a1 = na1; b1 = nb1;
        }
        bf16_t* o = PB + (size_t)row * INW + c;
        store_bf16x8(o, a0, a1); store_bf16x8(o + 16, b0, b1);
    }
};
template <bool FIRST> struct EpiOut {
    const float* xl; const float* xc; bf16_t* XB; const float* mod;
    __device__ __forceinline__ float rowval(int) const { return 0.f; }
    __device__ __forceinline__ void operator()(int row, int pn, int wc, int fq, f32x4 a0, f32x4 a1, f32x4 b0, f32x4 b1, float) const {
        const int c = epi_col(pn, wc, fq); bf16_t* xo = XB + (size_t)row * DM + c;
        const float* g1 = mod + (size_t)row_modrow(row) * NMOD + 2 * DM + c;
        f32x4 xa0, xa1, xb0, xb1;
        if (FIRST) { const float* xin = row < NLAT ? xl + (size_t)row * DM + c : xc + (size_t)(row - NLAT) * DM + c;
            xa0 = *(const f32x4*)xin; xa1 = *(const f32x4*)(xin + 4); xb0 = *(const f32x4*)(xin + 16); xb1 = *(const f32x4*)(xin + 20); }
        else { const u32x4 wa = *(const u32x4*)xo, wb = *(const u32x4*)(xo + 16);
            xa0 = (f32x4){bf_lo(wa.x), bf_hi(wa.x), bf_lo(wa.y), bf_hi(wa.y)}; xa1 = (f32x4){bf_lo(wa.z), bf_hi(wa.z), bf_lo(wa.w), bf_hi(wa.w)};
            xb0 = (f32x4){bf_lo(wb.x), bf_hi(wb.x), bf_lo(wb.y), bf_hi(wb.y)}; xb1 = (f32x4){bf_lo(wb.z), bf_hi(wb.z), bf_lo(wb.w), bf_hi(wb.w)}; }
        const f32x4 ga0 = *(const f32x4*)g1, ga1 = *(const f32x4*)(g1 + 4), gb0 = *(const f32x4*)(g1 + 16), gb1 = *(const f32x4*)(g1 + 20);
        store_bf16x8(xo, xa0 * ALPHA + ga0 * a0, xa1 * ALPHA + ga1 * a1); store_bf16x8(xo + 16, xb0 * ALPHA + gb0 * b0, xb1 * ALPHA + gb1 * b1);
    }
};
struct EpiGU {
    bf16_t* HH;
    __device__ __forceinline__ float rowval(int) const { return 0.f; }
    __device__ __forceinline__ void operator()(int row, int pn, int wc, int fq, f32x4 a0, f32x4 a1, f32x4 b0, f32x4 b1, float) const {
        f32x4 h0, h1;
#pragma unroll
        for (int j = 0; j < 4; ++j) { h0[j] = a0[j] * __builtin_amdgcn_rcpf(1.f + __expf(-a0[j])) * b0[j]; h1[j] = a1[j] * __builtin_amdgcn_rcpf(1.f + __expf(-a1[j])) * b1[j]; }
        store_bf16x8(HH + (size_t)row * FF + 128 * pn + 32 * wc + 8 * fq, h0, h1);
    }
};
struct EpiDown {
    bf16_t* Y; const float* gate;
    __device__ __forceinline__ float rowval(int row) const { return gate[row]; }
    __device__ __forceinline__ void operator()(int row, int pn, int wc, int fq, f32x4 a0, f32x4 a1, f32x4 b0, f32x4 b1, float g) const {
        bf16_t* o = Y + (size_t)row * DM + epi_col(pn, wc, fq);
        store_bf16x8(o, a0 * g, a1 * g); store_bf16x8(o + 16, b0 * g, b1 * g);
    }
};

namespace mg {
constexpr int BM = 256, BK = 64, HALF = 128, HTB = HALF * BK * 2, STAGE_BYTES = 8 * HTB, NXCD = 8, WGM = 8, MAXU = 8;
__device__ __forceinline__ int lds_byte(int r, int c) { const int st = (r >> 4) * 2 + (c >> 5), rr = r & 15, cc = c & 31, ob = rr * 64 + cc * 2; return st * 1024 + (ob ^ (((ob >> 9) & 1) << 5)); }
__device__ __forceinline__ void stage_rc(int b, int& R, int& C) { const int st = b / 1024, sb = b % 1024, swz = sb ^ (((sb >> 9) & 1) << 5); R = (st >> 1) * 16 + swz / 64; C = (st & 1) * 32 + (swz % 64) / 2; }
struct Unit { int pm, pn; };
struct Gemm { const bf16_t* A; const bf16_t* Bt; int M, N, K; const int* rowidx; size_t grp_stride; int grp_tiles, ngrp; };
struct StaticOrder {
    int nM, nN, nwg, G, c;
    __device__ void init(int M, int N, int G_, int c_) { nM = M / BM; nN = N / BM; nwg = nM * nN; G = G_; c = c_; }
    __device__ bool next(int i, Unit& u) const {
        const long L = (long)i * G + c; if (L >= nwg) return false;
        int wgid = (int)L; { const int q = nwg / NXCD, r = nwg % NXCD, xcd = wgid % NXCD, off = wgid / NXCD; wgid = (xcd < r ? xcd * (q + 1) : r * (q + 1) + (xcd - r) * q) + off; }
        const int nig = WGM * nN, gid = wgid / nig, fm = gid * WGM, gsz = (nM - fm) < WGM ? (nM - fm) : WGM;
        u.pm = fm + ((wgid % nig) % gsz); u.pn = (wgid % nig) / gsz; return true;
    }
};
template <class Epi>
__device__ __forceinline__ void gemm_phase(LAS unsigned char* lds, LAS int* idxl, const Gemm g, const StaticOrder& S, const Epi& E) {
    const int tid = opaque_tid(), wid = __builtin_amdgcn_readfirstlane(tid >> 6), lane = tid & 63, wr = wid >> 2, wc = wid & 3, fr = lane & 15, fq = lane >> 4;
    const int K = g.K, nt = K / BK;
    unsigned voffB[2];
#pragma unroll
    for (int i = 0; i < 2; ++i) { int R_, C_; stage_rc(tid * 16 + i * 8192, R_, C_); voffB[i] = (unsigned)(R_ * K + C_) * 2u; }
    const size_t kstep = (size_t)(BK * 2);
    const size_t hstep = (size_t)HALF * K * 2;
    const size_t tstep = 2 * hstep;
    const unsigned ldsw = (unsigned)wid * 1024u;
    const int aoff = lds_byte(wr * 64 + fr, fq * 8), boff = lds_byte(wc * 32 + fr, fq * 8);
    Unit cur, nxt; int ui = 0;
    if (!S.next(0, cur)) return;
    if (g.rowidx) {
        for (int i = 0; i < MAXU; ++i) { Unit u; if (!S.next(i, u)) break; if (tid < 256) idxl[i * 256 + tid] = g.rowidx[u.pm * BM + tid]; }
        asm volatile("s_waitcnt vmcnt(0) lgkmcnt(0)" ::: "memory"); __builtin_amdgcn_s_barrier(); asm volatile("" ::: "memory");
    }
#define MG_AOFFS(dst, u_, ui_) do { _Pragma("unroll") for (int i_ = 0; i_ < 2; ++i_) { int R_, C_; stage_rc(tid * 16 + i_ * 8192, R_, C_); _Pragma("unroll") for (int h_ = 0; h_ < 2; ++h_) { \
        const int rr_ = g.rowidx ? idxl[(ui_) * 256 + h_ * HALF + R_] : ((u_).pm * BM + h_ * HALF + R_); dst[h_][i_] = (unsigned)(rr_ * K + C_) * 2u; } } } while (0)
#define MG_BPTR(u_) ((const char*)g.Bt + ((size_t)(((u_).pm / g.grp_tiles) % g.ngrp) * g.grp_stride) * 2 + (size_t)(u_).pn * tstep)
#define PG8_SA(b, h) (((b) * 2 + (h)) * HTB)
#define PG8_SB(b, h) ((4 + (b) * 2 + (h)) * HTB)
#define PG8_STAGE(bufoff, gbase, voff) do { _Pragma("unroll") for (int _i = 0; _i < 2; ++_i) \
        __builtin_amdgcn_global_load_lds((const unsigned*)((const char*)(gbase) + (voff)[_i]), (LAS unsigned*)(lds + (bufoff) + ldsw + _i * 8192), 16, 0, 0); } while (0)
#define PG8_LDA(dst, b, h) do { _Pragma("unroll") for (int m = 0; m < 4; ++m) _Pragma("unroll") for (int k = 0; k < 2; ++k) dst[m][k] = *(const LAS bf16x8*)(lds + PG8_SA(b, h) + aoff + m * 2048 + k * 1024); } while (0)
#define PG8_LDB(dst, b, h) do { _Pragma("unroll") for (int n = 0; n < 2; ++n) _Pragma("unroll") for (int k = 0; k < 2; ++k) dst[n][k] = *(const LAS bf16x8*)(lds + PG8_SB(b, h) + boff + n * 2048 + k * 1024); } while (0)
#define PG8_MMA(ai, bj, At, Bt) do { __builtin_amdgcn_s_setprio(1); _Pragma("unroll") for (int m = 0; m < 4; ++m) _Pragma("unroll") for (int n = 0; n < 2; ++n) _Pragma("unroll") for (int k = 0; k < 2; ++k) \
        acc[ai][bj][m][n] = __builtin_amdgcn_mfma_f32_16x16x32_bf16(Bt[n][k], At[m][k], acc[ai][bj][m][n], 0, 0, 0); __builtin_amdgcn_s_setprio(0); } while (0)
#define PG8_WAIT_V(n) asm volatile("s_waitcnt vmcnt(" #n ")" ::: "memory")
#define PG8_WAIT_L(n) asm volatile("s_waitcnt lgkmcnt(" #n ")" ::: "memory")
#define PG8_BAR __builtin_amdgcn_s_barrier()
#define PG8_SCHED __builtin_amdgcn_sched_barrier(0)
    f32x4 acc[2][2][4][2];
#pragma unroll
    for (int a = 0; a < 2; ++a)
#pragma unroll
        for (int b = 0; b < 2; ++b)
#pragma unroll
            for (int m = 0; m < 4; ++m)
#pragma unroll
                for (int n = 0; n < 2; ++n) acc[a][b][m][n] = (f32x4){0.f, 0.f, 0.f, 0.f};
    bf16x8 At[4][2], B0[2][2], B1[2][2];
    unsigned cAo[2][2], o2[2][2];
    MG_AOFFS(cAo, cur, 0);
    const char* const Abase = (const char*)g.A;
    const char* cB = MG_BPTR(cur);
    PG8_STAGE(PG8_SB(0, 0), cB, voffB); PG8_STAGE(PG8_SB(0, 1), cB + hstep, voffB); PG8_STAGE(PG8_SA(0, 0), Abase, cAo[0]); PG8_STAGE(PG8_SA(0, 1), Abase, cAo[1]);
    if (wr == 1) PG8_BAR;
    PG8_WAIT_V(2); PG8_BAR;
    PG8_STAGE(PG8_SB(1, 0), cB + kstep, voffB); PG8_STAGE(PG8_SA(1, 0), Abase + kstep, cAo[0]); PG8_STAGE(PG8_SB(1, 1), cB + hstep + kstep, voffB);
    PG8_WAIT_V(6); PG8_BAR;
    for (;;) {
        const bool has_next = S.next(ui + 1, nxt);
        const char* nB = has_next ? MG_BPTR(nxt) : cB;
        for (int t = 0; t < nt; t += 2) {
            const bool last = (t == nt - 2);
            const char* a1 = Abase + (size_t)(t + 1) * kstep;
            const char* a2 = last ? Abase : Abase + (size_t)(t + 2) * kstep; const char* b2 = last ? nB : cB + (size_t)(t + 2) * kstep;
            const char* a3 = a2 + kstep; const char* b3 = b2 + kstep;
            if (last && has_next) { MG_AOFFS(o2, nxt, ui + 1); } else {
#pragma unroll
                for (int h = 0; h < 2; ++h)
#pragma unroll
                    for (int i = 0; i < 2; ++i) o2[h][i] = cAo[h][i]; }
            PG8_LDB(B0, 0, 0); PG8_LDB(B1, 0, 1); PG8_SCHED; PG8_LDA(At, 0, 0); PG8_STAGE(PG8_SA(1, 1), a1, cAo[1]);
            PG8_WAIT_V(8); PG8_WAIT_L(0); PG8_BAR; PG8_MMA(0, 0, At, B0); PG8_MMA(0, 1, At, B1); PG8_BAR; PG8_SCHED;
            PG8_LDA(At, 0, 1); PG8_STAGE(PG8_SB(0, 0), b2, voffB); PG8_STAGE(PG8_SB(0, 1), b2 + hstep, voffB); PG8_STAGE(PG8_SA(0, 0), a2, o2[0]);
            PG8_WAIT_V(8); PG8_WAIT_L(0); PG8_BAR; PG8_MMA(1, 0, At, B0); PG8_MMA(1, 1, At, B1); PG8_BAR; PG8_SCHED;
            PG8_LDB(B0, 1, 0); PG8_LDB(B1, 1, 1); PG8_SCHED; PG8_LDA(At, 1, 0); PG8_STAGE(PG8_SA(0, 1), a2, o2[1]);
            PG8_WAIT_V(8); PG8_WAIT_L(0); PG8_BAR; PG8_MMA(0, 0, At, B0); PG8_MMA(0, 1, At, B1); PG8_BAR; PG8_SCHED;
            PG8_LDA(At, 1, 1); PG8_STAGE(PG8_SB(1, 0), b3, voffB); PG8_STAGE(PG8_SB(1, 1), b3 + hstep, voffB); PG8_STAGE(PG8_SA(1, 0), a3, o2[0]);
            PG8_WAIT_V(8); PG8_WAIT_L(0); PG8_BAR; PG8_MMA(1, 0, At, B0); PG8_MMA(1, 1, At, B1); PG8_BAR; PG8_SCHED;
        }
        if (wr == 0) PG8_BAR;
        E(acc, cur, wr, wc, fr, fq);
        if (!has_next) break;
#pragma unroll
        for (int a = 0; a < 2; ++a)
#pragma unroll
            for (int b = 0; b < 2; ++b)
#pragma unroll
                for (int m = 0; m < 4; ++m)
#pragma unroll
                    for (int n = 0; n < 2; ++n) acc[a][b][m][n] = (f32x4){0.f, 0.f, 0.f, 0.f};
        cur = nxt; cB = nB; ++ui;
#pragma unroll
        for (int h = 0; h < 2; ++h)
#pragma unroll
            for (int i = 0; i < 2; ++i) cAo[h][i] = o2[h][i];
        if (wr == 1) PG8_BAR;
    }
    PG8_WAIT_V(0);
    PG8_BAR;
#undef MG_AOFFS
#undef MG_BPTR
#undef PG8_SA
#undef PG8_SB
#undef PG8_STAGE
#undef PG8_LDA
#undef PG8_LDB
#undef PG8_MMA
#undef PG8_WAIT_V
#undef PG8_WAIT_L
#undef PG8_BAR
#undef PG8_SCHED
}
template <class EE> struct EpiAdapt {
    EE e; int row_base;
    __device__ __forceinline__ void operator()(const f32x4 (&acc)[2][2][4][2], const Unit& u, int wr, int wc, int fr, int fq) const {
        float rv[2][4];
#pragma unroll
        for (int ai = 0; ai < 2; ++ai)
#pragma unroll
            for (int m = 0; m < 4; ++m) rv[ai][m] = e.rowval(row_base + u.pm * BM + ai * HALF + wr * 64 + m * 16 + fr);
#pragma unroll
        for (int ai = 0; ai < 2; ++ai)
#pragma unroll
            for (int m = 0; m < 4; ++m) { const int row = row_base + u.pm * BM + ai * HALF + wr * 64 + m * 16 + fr;
                e(row, u.pn, wc, fq, acc[ai][0][m][0], acc[ai][0][m][1], acc[ai][1][m][0], acc[ai][1][m][1], rv[ai][m]);
                if (m & 1) asm volatile("" ::: "memory"); }
    }
};
}

struct AttnState { float m, l; float o[32]; };
__device__ __forceinline__ void attn_init(AttnState& st) { st.m = -INFINITY; st.l = 0.f;
#pragma unroll
    for (int d = 0; d < 32; ++d) st.o[d] = 0.f; }
__device__ __forceinline__ void load_row32(const bf16_t* p, float (&r)[32], float scale) {
#pragma unroll
    for (int i = 0; i < 4; ++i) { const u32x4 w = *(const u32x4*)(p + 8 * i);
        r[8 * i + 0] = bf_lo(w.x) * scale; r[8 * i + 1] = bf_hi(w.x) * scale; r[8 * i + 2] = bf_lo(w.y) * scale; r[8 * i + 3] = bf_hi(w.y) * scale;
        r[8 * i + 4] = bf_lo(w.z) * scale; r[8 * i + 5] = bf_hi(w.z) * scale; r[8 * i + 6] = bf_lo(w.w) * scale; r[8 * i + 7] = bf_hi(w.w) * scale; }
}
__device__ __forceinline__ float dot_row32(const bf16_t* p, const float (&q)[32]) {
    float d0 = 0.f, d1 = 0.f;
#pragma unroll
    for (int i = 0; i < 4; ++i) { const u32x4 w = *(const u32x4*)(p + 8 * i);
        d0 += q[8 * i + 0] * bf_lo(w.x); d1 += q[8 * i + 1] * bf_hi(w.x); d0 += q[8 * i + 2] * bf_lo(w.y); d1 += q[8 * i + 3] * bf_hi(w.y);
        d0 += q[8 * i + 4] * bf_lo(w.z); d1 += q[8 * i + 5] * bf_hi(w.z); d0 += q[8 * i + 6] * bf_lo(w.w); d1 += q[8 * i + 7] * bf_hi(w.w); }
    const float d = d0 + d1;
    return d + __shfl_xor(d, 32);
}
__device__ __forceinline__ void axpy_row32(const bf16_t* p, float a, float (&o)[32]) {
#pragma unroll
    for (int i = 0; i < 4; ++i) { const u32x4 w = *(const u32x4*)(p + 8 * i);
        o[8 * i + 0] += a * bf_lo(w.x); o[8 * i + 1] += a * bf_hi(w.x); o[8 * i + 2] += a * bf_lo(w.y); o[8 * i + 3] += a * bf_hi(w.y);
        o[8 * i + 4] += a * bf_lo(w.z); o[8 * i + 5] += a * bf_hi(w.z); o[8 * i + 6] += a * bf_lo(w.w); o[8 * i + 7] += a * bf_hi(w.w); }
}
template <class ScoreFn>
__device__ __forceinline__ void attn_segment(const float (&q)[32], AttnState& st, const bf16_t* Kb, const bf16_t* Vb, int j0, int j1, ScoreFn sf) {
#pragma unroll 1
    for (int j = j0; j < j1; ++j) {
        const float s0 = sf(j, dot_row32(Kb + (size_t)j * INW, q));
        if (s0 > st.m) { const float corr = __expf(st.m - s0); st.l *= corr;
#pragma unroll
            for (int d = 0; d < 32; ++d) st.o[d] *= corr;
            st.m = s0; }
        const float p0 = (s0 == -INFINITY) ? 0.f : __expf(s0 - st.m);
        st.l += p0;
        axpy_row32(Vb + (size_t)j * INW, p0, st.o);
    }
}
__device__ __forceinline__ void attn_sink(AttnState& st, float sk) {
    if (sk > st.m) { const float corr = __expf(st.m - sk); st.l *= corr;
#pragma unroll
        for (int d = 0; d < 32; ++d) st.o[d] *= corr;
        st.m = sk; }
    st.l += __expf(sk - st.m);
}
__device__ __forceinline__ void attn_store(const AttnState& st, bf16_t* o) {
    const float inv = 1.f / st.l;
#pragma unroll
    for (int i = 0; i < 4; ++i) { u32x4 w; w.x = pk2(st.o[8 * i] * inv, st.o[8 * i + 1] * inv); w.y = pk2(st.o[8 * i + 2] * inv, st.o[8 * i + 3] * inv);
        w.z = pk2(st.o[8 * i + 4] * inv, st.o[8 * i + 5] * inv); w.w = pk2(st.o[8 * i + 6] * inv, st.o[8 * i + 7] * inv); *(u32x4*)(o + 8 * i) = w; }
}

__device__ __forceinline__ void phase_mixers(const Params& p, int l, bool with_ctx, int bid, int nb) {
    bid = opaque_s(bid); const int tid = opaque_tid(); const int lane = tid & 63, gw = bid * NWAVES + (tid >> 6), NGW = nb * NWAVES;
    const int ql = lane & 31, hf = lane >> 5;
    const bf16_t* PB = (const bf16_t*)(p.ws + WS_PB); bf16_t* OB = (bf16_t*)(p.ws + WS_OB);
    const float* sink = p.attn_sink + l * 6; const float* rpb = p.na_rpb + (size_t)l * 6 * 15 * 31;
#if !FAST_ATTN
#pragma unroll 1
    for (int it = gw; it < NB * 6 * 256; it += NGW) {
        const int chunk = it & 255, h = (it >> 8) % 6, b = it / (6 * 256), kvh = h / 3;
        const int t = chunk * 32 + ql; const size_t rowb = (size_t)b * SEQ;
        float q[32]; load_row32(PB + (rowb + t) * INW + C_QA + h * 64 + 32 * hf, q, 0.125f);
        AttnState st; attn_init(st);
        const int jlo = max(0, chunk * 32 - 128), jhi = min(SEQ, chunk * 32 + 32 + 128);
        attn_segment(q, st, PB + rowb * INW + C_KA + kvh * 64 + 32 * hf, PB + rowb * INW + C_VA + kvh * 64 + 32 * hf, jlo, jhi,
                     [&](int j, float d) { const int dt = t - j; return (dt <= 128 && dt >= -128) ? d : -INFINITY; });
        const size_t crow = (size_t)NLAT + (size_t)b * CTXL;
        attn_segment(q, st, PB + crow * INW + C_KA + kvh * 64 + 32 * hf, PB + crow * INW + C_VA + kvh * 64 + 32 * hf, 0, CTXL, [&](int, float d) { return d; });
        attn_sink(st, sink[h]);
        attn_store(st, OB + (rowb + t) * DM + h * 64 + 32 * hf);
    }
#pragma unroll 1
    for (int it = gw; it < NB * 6 * 256; it += NGW) {
        const int r = (it & 255) >> 1, ch = it & 1, h = (it >> 8) % 6, b = it / (6 * 256);
        const int cq = ch * 32 + ql; const size_t rowb = (size_t)b * SEQ; const int t = r * 64 + cq;
        float q[32]; load_row32(PB + (rowb + t) * INW + C_QN + h * 64 + 32 * hf, q, 0.125f);
        AttnState st; attn_init(st);
        const int rs = min(max(r - 4, 0), 128 - 8), cs = min(max(cq - 8, 0), 64 - 16);
        const float* bias = rpb + (size_t)h * 15 * 31;
        attn_segment(q, st, PB + (rowb + (size_t)rs * 64) * INW + C_KN + h * 64 + 32 * hf, PB + (rowb + (size_t)rs * 64) * INW + C_VN + h * 64 + 32 * hf, 0, 512,
                     [&](int j, float d) { const int ka = rs + (j >> 6), ck = j & 63; const bool ok = (ck >= cs) && (ck < cs + 16);
                                           const int ro = ka - r + 7, co = min(max(ck - cq, -15), 15) + 15; return ok ? d + bias[ro * 31 + co] : -INFINITY; });
        const size_t crow = (size_t)NLAT + (size_t)b * CTXL;
        attn_segment(q, st, PB + crow * INW + C_KN + h * 64 + 32 * hf, PB + crow * INW + C_VN + h * 64 + 32 * hf, 0, CTXL, [&](int, float d) { return d; });
        attn_store(st, OB + (rowb + t) * DM + 640 + h * 64 + 32 * hf);
    }
#endif
    {
        const float* cw = p.conv_w + (size_t)l * 3 * 256;
        const int nrows = with_ctx ? NROWS : NLAT;
        for (long e = (long)bid * NTHREADS + tid; e < (long)nrows * 32; e += (long)nb * NTHREADS) {
            const int row = (int)(e >> 5), ch = (int)(e & 31) * 8;
            const int tpos = row < NLAT ? (row & (SEQ - 1)) : ((row - NLAT) & (CTXL - 1)); const int tlen = row < NLAT ? SEQ : CTXL;
            const bf16_t* pr = PB + (size_t)row * INW;
            float u[3][8];
#pragma unroll
            for (int dlt = -1; dlt <= 1; ++dlt) {
                const bool ok = (tpos + dlt >= 0) && (tpos + dlt < tlen);
                if (ok) { const u32x4 a = *(const u32x4*)(pr + (long)dlt * INW + C_BX + ch), c = *(const u32x4*)(pr + (long)dlt * INW + C_BC + ch);
                    u[dlt + 1][0] = bf_lo(a.x) * bf_lo(c.x); u[dlt + 1][1] = bf_hi(a.x) * bf_hi(c.x); u[dlt + 1][2] = bf_lo(a.y) * bf_lo(c.y); u[dlt + 1][3] = bf_hi(a.y) * bf_hi(c.y);
                    u[dlt + 1][4] = bf_lo(a.z) * bf_lo(c.z); u[dlt + 1][5] = bf_hi(a.z) * bf_hi(c.z); u[dlt + 1][6] = bf_lo(a.w) * bf_lo(c.w); u[dlt + 1][7] = bf_hi(a.w) * bf_hi(c.w); }
                else {
#pragma unroll
                    for (int i = 0; i < 8; ++i) u[dlt + 1][i] = 0.f; }
            }
            const u32x4 gb = *(const u32x4*)(pr + C_BB + ch);
            const float g[8] = {bf_lo(gb.x), bf_hi(gb.x), bf_lo(gb.y), bf_hi(gb.y), bf_lo(gb.z), bf_hi(gb.z), bf_lo(gb.w), bf_hi(gb.w)};
            float y[8];
#pragma unroll
            for (int i = 0; i < 8; ++i) y[i] = g[i] * (u[0][i] * cw[ch + i] + u[1][i] * cw[256 + ch + i] + u[2][i] * cw[512 + ch + i]);
            u32x4 o; o.x = pk2(y[0], y[1]); o.y = pk2(y[2], y[3]); o.z = pk2(y[4], y[5]); o.w = pk2(y[6], y[7]);
            *(u32x4*)(OB + (size_t)row * DM + 384 + ch) = o;
        }
    }
#if !FAST_ATTN
    if (with_ctx) {
#pragma unroll 1
        for (int it = gw; it < 2 * NB * 6 * 8; it += NGW) {
            const int kind = it / (NB * 6 * 8), r = it % (NB * 6 * 8), chunk = r & 7, h = (r >> 3) % 6, b = r / 48;
            const size_t crow = (size_t)NLAT + (size_t)b * CTXL; const int tq = chunk * 32 + ql;
            const int qc = (kind == 0 ? C_QA + h * 64 : C_QN + h * 64) + 32 * hf, kc = (kind == 0 ? C_KA + (h / 3) * 64 : C_KN + h * 64) + 32 * hf, vc = (kind == 0 ? C_VA + (h / 3) * 64 : C_VN + h * 64) + 32 * hf;
            float q[32]; load_row32(PB + (crow + tq) * INW + qc, q, 0.125f);
            AttnState st; attn_init(st);
            attn_segment(q, st, PB + crow * INW + kc, PB + crow * INW + vc, 0, CTXL, [&](int, float d) { return d; });
            if (kind == 0) attn_sink(st, sink[h]);
            attn_store(st, OB + (crow + tq) * DM + (kind == 0 ? 0 : 640) + h * 64 + 32 * hf);
        }
    }
#endif
}

namespace fa {
typedef short v4i16_t __attribute__((ext_vector_type(4)));
typedef float f32x2_t __attribute__((ext_vector_type(2))); typedef __bf16 bf16x2_t __attribute__((ext_vector_type(2)));
__device__ __forceinline__ unsigned cvtpk(float lo, float hi) { f32x2_t v = {lo, hi}; bf16x2_t b = __builtin_convertvector(v, bf16x2_t); return __builtin_bit_cast(unsigned, b); }
constexpr float LOG2E = 1.4426950408889634f, SC = 0.125f * LOG2E;
constexpr int CHUNK_BYTES = 32768;
constexpr int BIAS_OFF = 3 * CHUNK_BYTES;
constexpr float THR = 8.f;
__device__ __forceinline__ int na_rs(int r) { return min(max(r - 4, 0), 128 - 8); }
__device__ __forceinline__ void glds16(const void* gsrc, unsigned lds_dst) { unsigned keep;
    asm volatile("s_mov_b32 %0, m0\n\ts_mov_b32 m0, %2\n\ts_nop 0\n\tglobal_load_lds_dwordx4 %1, off\n\ts_mov_b32 m0, %0" : "=&s"(keep) : "v"(gsrc), "s"(lds_dst) : "memory"); }
#define FA_WAIT_BAR(N) asm volatile("s_waitcnt vmcnt(" #N ") lgkmcnt(0)\n\ts_barrier" ::: "memory")
__device__ __forceinline__ float max3f(float a, float b, float c) { float r; asm("v_max3_f32 %0, %1, %2, %3" : "=v"(r) : "v"(a), "v"(b), "v"(c)); return r; }
__device__ __forceinline__ float max8f(const f32x4& a, const f32x4& b) { return max3f(max3f(max3f(a[0], a[1], a[2]), a[3], b[0]), max3f(b[1], b[2], b[3]), -INFINITY); }
typedef float f32x16 __attribute__((ext_vector_type(16)));
__device__ __forceinline__ float max16f(const f32x16& a) {
    float x = max3f(a[0], a[1], a[2]); x = max3f(x, a[3], a[4]); x = max3f(x, a[5], a[6]); x = max3f(x, a[7], a[8]); x = max3f(x, a[9], a[10]); x = max3f(x, a[11], a[12]); x = max3f(x, a[13], a[14]);
    return fmaxf(x, a[15]);
}
typedef float f32x2v __attribute__((ext_vector_type(2)));
template <int MODE>
__device__ __forceinline__ void unit32(f32x16 (&o)[2], float& m, float& ls, const bf16x8 (&q)[4], const LAS unsigned char* Kt0, const LAS unsigned char* Kt1, const LAS unsigned char* Vt0, const LAS unsigned char* Vt1,
                                       const int (&kb)[4], const int (&vb)[2], bool rel0, bool rel1, bool mk0, bool mk1, int tb0, int tb1, const f32x16& fmask, const LAS float* bp0, const LAS float* bp1) {
    f32x16 s[2]; float tm = -INFINITY;
#pragma unroll
    for (int t = 0; t < 2; ++t) {
        if (!(t == 0 ? rel0 : rel1)) continue;
        const LAS unsigned char* Kt = t == 0 ? Kt0 : Kt1;
        bf16x8 kf[4];
#pragma unroll
        for (int ks = 0; ks < 4; ++ks) kf[ks] = *(const LAS bf16x8*)(Kt + kb[ks]);
        f32x16 acc = __builtin_amdgcn_mfma_f32_32x32x16_bf16(kf[0], q[0], (f32x16){0.f, 0.f, 0.f, 0.f, 0.f, 0.f, 0.f, 0.f, 0.f, 0.f, 0.f, 0.f, 0.f, 0.f, 0.f, 0.f}, 0, 0, 0);
#pragma unroll
        for (int ks = 1; ks < 4; ++ks) acc = __builtin_amdgcn_mfma_f32_32x32x16_bf16(kf[ks], q[ks], acc, 0, 0, 0);
        if (MODE == 2) {
            const LAS float* bp = t == 0 ? bp0 : bp1;
#pragma unroll
            for (int r = 0; r < 16; ++r) acc[r] = __builtin_fmaf(acc[r], SC, bp[(r & 3) + 8 * (r >> 2)]) + fmask[r];
        } else {
            if (MODE == 1 && (t == 0 ? mk0 : mk1)) { const int tb = t == 0 ? tb0 : tb1;
#pragma unroll
                for (int r = 0; r < 16; ++r) acc[r] = ((unsigned)(tb - ((r & 3) + 8 * (r >> 2))) <= 256u) ? acc[r] : -INFINITY;
            } else asm volatile("s_nop 15\n\ts_nop 7" : "+v"(acc));
        }
        s[t] = acc;
        tm = fmaxf(tm, max16f(acc));
    }
    if (MODE != 2) tm *= SC;
    if (__any(tm > m + THR)) {
        const float mn = fmaxf(m, xor32_max(tm)), al = __builtin_amdgcn_exp2f(m - mn); m = mn; ls *= al;
#pragma unroll
        for (int d = 0; d < 2; ++d) o[d] = o[d] * al;
    }
    const float nm = -m; f32x2v ps2 = {0.f, 0.f};
#pragma unroll
    for (int t = 0; t < 2; ++t) {
        if (!(t == 0 ? rel0 : rel1)) continue;
        const LAS unsigned char* Vt = t == 0 ? Vt0 : Vt1;
        f32x16 pv = MODE == 2 ? s[t] + nm : s[t] * SC + nm;
#pragma unroll
        for (int r = 0; r < 16; ++r) pv[r] = __builtin_amdgcn_exp2f(pv[r]);
#pragma unroll
        for (int r = 0; r < 16; r += 2) ps2 += (f32x2v){pv[r], pv[r + 1]};
#pragma unroll
        for (int st = 0; st < 2; ++st) {
            u32x4 pw; pw.x = cvtpk(pv[8 * st + 0], pv[8 * st + 1]); pw.y = cvtpk(pv[8 * st + 2], pv[8 * st + 3]); pw.z = cvtpk(pv[8 * st + 4], pv[8 * st + 5]); pw.w = cvtpk(pv[8 * st + 6], pv[8 * st + 7]);
            const bf16x8 pb = __builtin_bit_cast(bf16x8, pw);
#pragma unroll
            for (int db = 0; db < 2; ++db) {
                const v4i16_t t0 = __builtin_amdgcn_ds_read_tr16_b64_v4i16((LAS v4i16_t*)(Vt + st * 2048 + vb[db])), t1 = __builtin_amdgcn_ds_read_tr16_b64_v4i16((LAS v4i16_t*)(Vt + st * 2048 + 1024 + vb[db]));
                const bf16x8 vf = (bf16x8){t0[0], t0[1], t0[2], t0[3], t1[0], t1[1], t1[2], t1[3]};
                o[db] = __builtin_amdgcn_mfma_f32_32x32x16_bf16(vf, pb, o[db], 0, 0, 0);
            }
        }
    }
    ls += ps2[0] + ps2[1];
}
template <int KIND>
__device__ __forceinline__ void attn_item(const Params& p, int l, int item, LAS unsigned char* lds, int tid) {
    constexpr bool ISA = (KIND == 0 || KIND == 2);
    constexpr int NG = ISA ? 2 : 1;
    const int lane = tid & 63, w = __builtin_amdgcn_readfirstlane(tid >> 6), ql = lane & 31, hh = lane >> 5;
    const bf16_t* PB = (const bf16_t*)(p.ws + WS_PB); bf16_t* OB = (bf16_t*)(p.ws + WS_OB);
    int b, hx, blk;
    if (KIND == 0) { b = item >> 7; hx = (item >> 6) & 1; blk = item & 63; }
    else if (KIND == 1) { b = item / 192; hx = (item >> 5) % 6; blk = item & 31; }
    else if (KIND == 2) { b = item >> 2; hx = (item >> 1) & 1; blk = item & 1; }
    else { b = item / 6; hx = item % 6; blk = 0; }
    const size_t rowb = (size_t)b * SEQ, ctxb = (size_t)NLAT + (size_t)b * CTXL;
    const int kcol = ISA ? C_KA + hx * 64 : C_KN + hx * 64, vcol = ISA ? C_VA + hx * 64 : C_VN + hx * 64;
    int nwin = 0; size_t winrow0 = 0; int winpos0 = 0, krs0 = 0;
    if (KIND == 0) { const int first = blk == 0 ? 1 : 0, last = blk == 63 ? 2 : 3; nwin = last - first; winpos0 = 128 * (blk - 1 + first); winrow0 = rowb + winpos0; }
    if (KIND == 1) { krs0 = na_rs(4 * blk); nwin = (na_rs(4 * blk + 3) + 8 - krs0 + 1) >> 1; winrow0 = rowb + (size_t)krs0 * 64; }
    const int nch = nwin + 2;
    const bool active = true;
    int gh[NG], gp0[NG];
#pragma unroll
    for (int gi = 0; gi < NG; ++gi) {
        const int G = ISA ? (w < 4 ? 2 * w + gi : 8 + (w - 4)) : w;
        if (ISA) { gh[gi] = 3 * hx + (G >> 2); gp0[gi] = 128 * blk + 32 * (G & 3); }
        else if (KIND == 1) { gh[gi] = hx; gp0[gi] = 16 * (G & 3); }
        else { gh[gi] = hx; gp0[gi] = 32 * G; }
    }
    const int nrow0 = 4 * blk + 2 * (w >> 2);
    const int nrq = nrow0 + (ql >> 4), ncq = gp0[0] + (ql & 15);
#define FA_QROW(gi, ql_) (KIND == 0 ? rowb + gp0[gi] + (ql_) : KIND == 2 ? ctxb + gp0[gi] + (ql_) : KIND == 1 ? rowb + (size_t)(nrow0 + ((ql_) >> 4)) * 64 + gp0[gi] + ((ql_) & 15) : ctxb + gp0[gi] + (ql_))
    const int skey = 8 * w + (lane >> 3), spc = lane & 7;
    const int ksrc = skey * INW + kcol + ((spc ^ ((skey >> 1) & 7)) << 3);
    const int vsrc = skey * INW + vcol + (((((spc >> 1) ^ (skey & 2)) << 1) | (spc & 1)) << 3);
    const unsigned lds0 = (unsigned)(uintptr_t)lds;
    const int noff = KIND == 1 ? ((gp0[0] >> 4) == 0 ? 0 : ((gp0[0] >> 4) == 1 ? 8 : ((gp0[0] >> 4) == 2 ? 24 : 32))) : 0;
    int kb[4], kbw[4], vb[2];
#pragma unroll
    for (int ks = 0; ks < 4; ++ks) { kb[ks] = ql * 128 + (((2 * ks + hh) ^ ((ql >> 1) & 7)) << 4); kbw[ks] = ql * 128 + (((2 * ks + hh) ^ (((noff + ql) >> 1) & 7)) << 4); }
    { const int vk = 4 * hh + ((lane & 15) >> 2);
#pragma unroll
      for (int db = 0; db < 2; ++db) vb[db] = vk * 128 + (((2 * db + ((lane >> 4) & 1)) ^ (vk & 2)) << 5) + ((lane & 3) << 3); }
#define FA_DMA(ci) do { const size_t r0_ = (ci) < nwin ? winrow0 + (size_t)(ci) * 128 : ctxb + (size_t)((ci) - nwin) * 128; const bf16_t* s_ = PB + r0_ * INW; \
        const unsigned d_ = (unsigned)__builtin_amdgcn_readfirstlane((int)(lds0 + ((ci) % 3) * CHUNK_BYTES + w * 1024)); \
        glds16(s_ + ksrc, d_); glds16(s_ + 64 * INW + ksrc, d_ + 8192u); glds16(s_ + vsrc, d_ + 16384u); glds16(s_ + 64 * INW + vsrc, d_ + 24576u); } while (0)
    FA_DMA(0); FA_DMA(1);
    bf16x8 qf[NG][4];
#pragma unroll
    for (int gi = 0; gi < NG; ++gi)
#pragma unroll
        for (int ks = 0; ks < 4; ++ks) qf[gi][ks] = *(const bf16x8*)(PB + FA_QROW(gi, ql) * INW + (ISA ? C_QA : C_QN) + gh[gi] * 64 + 16 * ks + 8 * hh);
    f32x16 o[NG][2]; float m[NG], ls[NG];
#pragma unroll
    for (int gi = 0; gi < NG; ++gi) {
#pragma unroll
        for (int d = 0; d < 2; ++d)
#pragma unroll
            for (int r = 0; r < 16; ++r) o[gi][d][r] = 0.f;
        if (ISA) { m[gi] = p.attn_sink[l * 6 + gh[gi]] * LOG2E; ls[gi] = hh == 0 ? 1.f : 0.f; } else { m[gi] = -1e30f; ls[gi] = 0.f; }
    }
    f32x16 fmask;
#pragma unroll
    for (int r = 0; r < 16; ++r) fmask[r] = 0.f;
    if (KIND == 1) { const int cs = min(max(ncq - 8, 0), 48);
#pragma unroll
        for (int r = 0; r < 16; ++r) { const int ck = noff + (r & 3) + 8 * (r >> 2) + 4 * hh; fmask[r] = ((ck >= cs) && (ck < cs + 16)) ? 0.f : -INFINITY; } }
    const int nqrs = na_rs(nrq);
    LAS float* biasL = (LAS float*)(lds + BIAS_OFF);
    if (KIND == 1) { const float* rp = p.na_rpb + ((size_t)l * 6 + hx) * 15 * 31;
        for (int i = tid; i < 16 * 128; i += NTHREADS) { const int x = (i & 127) - 64; biasL[i] = (i >> 7) == 15 ? -INFINITY : ((x >= -15 && x <= 15) ? rp[(i >> 7) * 31 + x + 15] * LOG2E : 0.f); } }
    FA_WAIT_BAR(4);
#pragma unroll
    for (int gi = 0; gi < NG; ++gi) { asm volatile("" : "+v"(qf[gi][0]), "+v"(qf[gi][1]), "+v"(qf[gi][2]), "+v"(qf[gi][3])); }
#pragma unroll 1
    for (int ci = 0; ci < nch; ++ci) {
        if (ci + 2 < nch) FA_DMA(ci + 2);
        const LAS unsigned char* Kb = lds + (ci % 3) * CHUNK_BYTES; const LAS unsigned char* Vb = Kb + 16384;
        const bool iswin = ci < nwin;
        if (active) {
            if (KIND == 1 && iswin) {
                const int kr0 = krs0 + 2 * ci, rsA = na_rs(nrow0), rsB = na_rs(nrow0 + 1);
                const bool rel0 = (kr0 >= rsA) && (kr0 < rsB + 8), rel1 = (kr0 + 1 >= rsA) && (kr0 + 1 < rsB + 8);
                if (rel0 || rel1) {
                    const bool rowok0 = (kr0 >= nqrs) && (kr0 < nqrs + 8), rowok1 = (kr0 + 1 >= nqrs) && (kr0 + 1 < nqrs + 8);
                    const int bcol = 64 + noff + 4 * hh - ncq;
                    const LAS float* bp0 = biasL + (rowok0 ? kr0 - nrq + 7 : 15) * 128 + bcol; const LAS float* bp1 = biasL + (rowok1 ? kr0 + 1 - nrq + 7 : 15) * 128 + bcol;
                    unit32<2>(o[0], m[0], ls[0], qf[0], Kb + noff * 128, Kb + (64 + noff) * 128, Vb + noff * 128, Vb + (64 + noff) * 128, kbw, vb, rel0, rel1, false, false, 0, 0, fmask, bp0, bp1);
                }
            } else {
#pragma unroll 1
                for (int u = 0; u < 2; ++u) {
                    const LAS unsigned char* Kt = Kb + (64 * u) * 128; const LAS unsigned char* Vt = Vb + (64 * u) * 128;
#pragma unroll
                    for (int gi = 0; gi < NG; ++gi) {
                        if (ISA && gi == 1 && w >= 4) continue;
                        if (KIND == 0) {
                            bool rel[2] = {true, true}, msk[2] = {false, false};
                            if (iswin) {
#pragma unroll
                                for (int t = 0; t < 2; ++t) { const int j0 = winpos0 + 128 * ci + 64 * u + 32 * t, p0 = gp0[gi];
                                    rel[t] = (j0 + 31 >= p0 - 128) && (j0 <= p0 + 31 + 128); msk[t] = !((j0 >= p0 + 31 - 128) && (j0 + 31 <= p0 + 128)); } }
                            if (!(rel[0] || rel[1])) continue;
                            const int tb0 = gp0[gi] + ql - (winpos0 + 128 * ci + 64 * u) - 4 * hh + 128;
                            unit32<1>(o[gi], m[gi], ls[gi], qf[gi], Kt, Kt + 4096, Vt, Vt + 4096, kb, vb, rel[0], rel[1], msk[0], msk[1], tb0, tb0 - 32, fmask, nullptr, nullptr);
                        } else unit32<0>(o[gi], m[gi], ls[gi], qf[gi], Kt, Kt + 4096, Vt, Vt + 4096, kb, vb, true, true, false, false, 0, 0, fmask, nullptr, nullptr);
                    }
                }
            }
        }
        if (ci + 2 < nch) FA_WAIT_BAR(4); else FA_WAIT_BAR(0);
    }
#undef FA_DMA
    if (active) {
        int ql2 = lane & 31; asm volatile("" : "+v"(ql2));
#pragma unroll
        for (int gi = 0; gi < NG; ++gi) {
            if (ISA && gi == 1 && w >= 4) continue;
            const float lt = xor32_sum(ls[gi]);
            const float inv = 1.f / lt;
            bf16_t* op = OB + FA_QROW(gi, ql2) * DM + (ISA ? 0 : 640) + gh[gi] * 64 + 4 * hh;
#pragma unroll
            for (int db = 0; db < 2; ++db)
#pragma unroll
                for (int i = 0; i < 4; ++i) { u32x2 ov; ov.x = cvtpk(o[gi][db][4 * i] * inv, o[gi][db][4 * i + 1] * inv); ov.y = cvtpk(o[gi][db][4 * i + 2] * inv, o[gi][db][4 * i + 3] * inv); *(u32x2*)(op + 32 * db + 8 * i) = ov; }
        }
    }
#undef FA_QROW
}
__device__ __forceinline__ void phase_attn(const Params& p, int l, bool with_ctx, LAS unsigned char* lds, int bid, int nb) {
    bid = opaque_s(bid);
    const int n0 = NB * 2 * 64, n1 = NB * 6 * 32, n2 = with_ctx ? NB * 2 * 2 : 0, n3 = with_ctx ? NB * 6 : 0;
#pragma unroll 1
    for (int it = bid; it < n0 + n1 + n2 + n3; it += nb) {
        const int tid = opaque_tid();
#ifndef KMASK
#define KMASK 15
#endif
#ifndef ATT_DUP
#define ATT_DUP 0
#endif
        if (it < n0) { if (KMASK & 1) attn_item<0>(p, l, it, lds, tid); if (ATT_DUP & 1) attn_item<0>(p, l, it, lds, tid); }
        else if (it < n0 + n1) { if (KMASK & 2) attn_item<1>(p, l, it - n0, lds, tid); if (ATT_DUP & 2) attn_item<1>(p, l, it - n0, lds, tid); }
        else if (it < n0 + n1 + n2) { if (KMASK & 4) attn_item<2>(p, l, it - n0 - n1, lds, tid); }
        else { if (KMASK & 8) attn_item<3>(p, l, it - n0 - n1 - n2, lds, tid); }
    }
}
}

__device__ __forceinline__ float reduce16(const float (&t)[16], int lane) {
    float u[8], w4[4], x2[2];
#pragma unroll
    for (int e = 0; e < 8; ++e) { float a = t[e], b = t[e + 8]; asm volatile("s_nop 1\n\tv_permlane32_swap_b32 %0, %1" : "+v"(a), "+v"(b)); u[e] = a + b; }
#pragma unroll
    for (int e = 0; e < 4; ++e) { float a = u[e], b = u[e + 4]; asm volatile("s_nop 1\n\tv_permlane16_swap_b32 %0, %1" : "+v"(a), "+v"(b)); w4[e] = a + b; }
    const bool b3 = (lane & 8) != 0, b2 = (lane & 4) != 0;
#pragma unroll
    for (int e = 0; e < 2; ++e) { const float keep = b3 ? w4[e + 2] : w4[e], send = b3 ? w4[e] : w4[e + 2]; x2[e] = keep + dppf<0x128>(send); }
    const float keep = b2 ? x2[1] : x2[0], send = b2 ? x2[0] : x2[1];
    float y = keep + dppf<0x141>(send);
    y += dppf<0xB1>(y); y += dppf<0x4E>(y);
    return y;
}
__device__ __forceinline__ float wave_max(float v) {
    v = fmaxf(v, dppf<0xB1>(v)); v = fmaxf(v, dppf<0x4E>(v)); v = fmaxf(v, dppf<0x141>(v)); v = fmaxf(v, dppf<0x140>(v));
    return xor32_max(xor16_max(v));
}
__device__ __forceinline__ void phase_ln_router(const Params& p, int l, bool with_ctx, LAS unsigned char* lds, int bid, int nb) {
    bid = opaque_s(bid); const int tid = opaque_tid(), lane = tid & 63, gw = bid * NWAVES + (tid >> 6), NGW = nb * NWAVES;
    LAS float* wr = (LAS float*)lds;
    const float* wrg = p.w_router + (size_t)l * DM * NE;
    for (int i = tid; i < DM * NE; i += NTHREADS) { const int c = i >> 4, e = i & 15; wr[e * DM + c] = wrg[i]; }
    __syncthreads();
    const bf16_t* XB = (const bf16_t*)(p.ws + WS_XB); bf16_t* HB = (bf16_t*)(p.ws + WS_HB); float* AFF = (float*)(p.ws + WS_AFF);
    const float* g = p.ln1_g + l * DM; const float* bb = p.ln1_b + l * DM;
    const int nrows = with_ctx ? NROWS : NLAT;
    int myexp; { float idx[16];
#pragma unroll
        for (int e = 0; e < 16; ++e) idx[e] = (float)e;
        myexp = (int)(reduce16(idx, lane) * (1.f / 64.f) + 0.5f); }
    f32x4 v[4], vn[4];
    if (gw < nrows) row_load_bf16(XB + (size_t)gw * DM, lane, v);
#pragma unroll 1
    for (int row = gw; row < nrows; row += NGW) {
        const int rn = row + NGW;
        if (rn < nrows) row_load_bf16(XB + (size_t)rn * DM, lane, vn);
        row_normalize(v); row_affine(v, g, bb, lane);
        row_normalize(v);
        const float* m = mod_ptr(p, l, row_modrow(row)); row_modulate(v, m + 3 * DM, m + 4 * DM, lane);
        row_store_bf16(HB + (size_t)row * DM, lane, v);
        float t[16];
#pragma unroll
        for (int e = 0; e < 16; ++e) { float s = 0.f;
#pragma unroll
            for (int j = 0; j < 4; ++j) { const f32x4 wv = *(const LAS f32x4*)(wr + e * DM + 256 * j + 4 * lane); s += (v[j][0] * wv[0] + v[j][1] * wv[1]) + (v[j][2] * wv[2] + v[j][3] * wv[3]); }
            t[e] = s;
            if ((e & 3) == 3) asm volatile("" ::: "memory"); }
        const float lg = reduce16(t, lane);
        const float mx = wave_max(lg), ex = expf(lg - mx), sum = wave_sum(ex) * 0.25f;
        if ((lane & 3) == 0) AFF[(size_t)row * 16 + myexp] = ex / sum;
#pragma unroll
        for (int j = 0; j < 4; ++j) v[j] = vn[j];
    }
}

__device__ __forceinline__ void topk_item(const float* aff  , int n, int k, int row0  , int e, int slot0,
                                          int* TOK, float* GATE, int* INV, LAS unsigned char* lds) {
    const int tid = opaque_tid(), lane = tid & 63, w = tid >> 6;
    LAS unsigned* keys = (LAS unsigned*)lds;
    LAS unsigned* hist = keys + 8192;
    LAS unsigned* misc = hist + 256;
    for (int i = tid; i < n; i += NTHREADS) keys[i] = __builtin_bit_cast(unsigned, aff[(size_t)i * 16]);
    if (tid == 0) { misc[0] = 0u; misc[1] = (unsigned)k; }
    __syncthreads();
    unsigned maskv = 0u;
    for (int pass = 0; pass < 4; ++pass) {
        const int shift = 24 - 8 * pass;
        if (tid < 256) hist[tid] = 0u;
        __syncthreads();
        const unsigned prefix = misc[0];
        for (int i = tid; i < n; i += NTHREADS) { const unsigned kv = keys[i]; if ((kv & maskv) == prefix) atomicAdd((unsigned*)&hist[(kv >> shift) & 255u], 1u); }
        __syncthreads();
        if (w == 0) {
            const unsigned rem = misc[1];
            const unsigned h0 = hist[4 * lane], h1 = hist[4 * lane + 1], h2 = hist[4 * lane + 2], h3 = hist[4 * lane + 3], s4 = h0 + h1 + h2 + h3;
            unsigned S = s4;
#pragma unroll
            for (int o = 1; o < 64; o <<= 1) { const unsigned y = __shfl_down(S, o); if (lane + o < 64) S += y; }
            const unsigned above = S - s4;
            if (above < rem && rem <= S) { unsigned cum = above; int bin;
                if (cum + h3 >= rem) bin = 3; else { cum += h3; if (cum + h2 >= rem) bin = 2; else { cum += h2; if (cum + h1 >= rem) bin = 1; else { cum += h1; bin = 0; } } }
                misc[0] = prefix | ((unsigned)(4 * lane + bin) << shift); misc[1] = rem - cum; }
        }
        __syncthreads();
        maskv |= 255u << shift;
    }
    const unsigned T = misc[0], need_eq = misc[1];
    __syncthreads();
    const int per = n >= NTHREADS ? n / NTHREADS : 1; const int t0 = tid * per; const bool act = t0 < n;
    unsigned ce = 0u;
    if (act) for (int i = 0; i < per; ++i) ce += (keys[t0 + i] == T) ? 1u : 0u;
    unsigned inc = ce;
#pragma unroll
    for (int o = 1; o < 64; o <<= 1) { const unsigned y = __shfl_up(inc, o); if (lane >= o) inc += y; }
    if (lane == 63) misc[16 + w] = inc;
    __syncthreads();
    unsigned base = 0u;
    for (int ww = 0; ww < w; ++ww) base += misc[16 + ww];
    unsigned eqrank = base + inc - ce;
    __syncthreads();
    unsigned cs = 0u;
    if (act) { unsigned er = eqrank; for (int i = 0; i < per; ++i) { const unsigned kv = keys[t0 + i]; if (kv > T) cs++; else if (kv == T) { if (er < need_eq) cs++; er++; } } }
    inc = cs;
#pragma unroll
    for (int o = 1; o < 64; o <<= 1) { const unsigned y = __shfl_up(inc, o); if (lane >= o) inc += y; }
    if (lane == 63) misc[16 + w] = inc;
    __syncthreads();
    base = 0u;
    for (int ww = 0; ww < w; ++ww) base += misc[16 + ww];
    unsigned pos = base + inc - cs;
    if (act) { unsigned er = eqrank; for (int i = 0; i < per; ++i) { const unsigned kv = keys[t0 + i]; bool sel = false;
            if (kv > T) sel = true; else if (kv == T) { sel = er < need_eq; er++; }
            const int row = row0 + t0 + i;
            if (sel) { const int slot = slot0 + (int)pos; TOK[slot] = row; GATE[slot] = __builtin_bit_cast(float, kv); INV[(size_t)row * 16 + e] = slot; pos++; }
            else INV[(size_t)row * 16 + e] = -1; } }
    __syncthreads();
}
__device__ __forceinline__ void phase_topk(const Params& p, bool with_ctx, LAS unsigned char* lds, int bid, int nb) {
    const float* AFF = (const float*)(p.ws + WS_AFF); int* TOK = (int*)(p.ws + WS_TOK); float* GATE = (float*)(p.ws + WS_GATE); int* INV = (int*)(p.ws + WS_INV);
    const int nitems = with_ctx ? 128 : 64;
    for (int it = bid; it < nitems; it += nb) {
        if (it < 64) { const int b = it >> 4, e = it & 15; topk_item(AFF + (size_t)b * SEQ * 16 + e, SEQ, CAP, b * SEQ, e, (b * NE + e) * CAP, TOK, GATE, INV, lds); }
        else { const int b = (it - 64) >> 4, e = it & 15; topk_item(AFF + ((size_t)NLAT + (size_t)b * CTXL) * 16 + e, CTXL, CCAP, NLAT + b * CTXL, e, NSLOT_LAT + (e * NB + b) * CCAP, TOK, GATE, INV, lds); }
    }
}

__device__ __forceinline__ void phase_combine(const Params& p, int l, bool with_ctx, int bid, int nb) {
    bid = opaque_s(bid); const int tid = opaque_tid(); const int lane = tid & 63, gw = bid * NWAVES + (tid >> 6), NGW = nb * NWAVES;
    bf16_t* XB = (bf16_t*)(p.ws + WS_XB); bf16_t* HB = (bf16_t*)(p.ws + WS_HB);
    const bf16_t* Y = (const bf16_t*)(p.ws + WS_Y); const int* INV = (const int*)(p.ws + WS_INV);
    const float* g = p.ln2_g + l * DM; const float* bb = p.ln2_b + l * DM;
    const int nrows = with_ctx ? NROWS : NLAT;
    for (int row = gw; row < nrows; row += NGW) {
        bf16_t* xr = XB + (size_t)row * DM;
        f32x4 v[4]; row_load_bf16(xr, lane, v);
        row_normalize(v); row_affine(v, p.ln1_g + l * DM, p.ln1_b + l * DM, lane);
        f32x4 a[4];
#pragma unroll
        for (int j = 0; j < 4; ++j) a[j] = (f32x4){0.f, 0.f, 0.f, 0.f};
        const int myinv = INV[(size_t)row * 16 + (lane & 15)];
#pragma unroll
        for (int e = 0; e < 16; ++e) {
            const int slot = __builtin_amdgcn_readlane(myinv, e);
            if (slot >= 0) { const bf16_t* yr = Y + (size_t)slot * DM;
#pragma unroll
                for (int j = 0; j < 4; ++j) { const u32x2 wv = *(const u32x2*)(yr + 256 * j + 4 * lane); a[j][0] += bf_lo(wv.x); a[j][1] += bf_hi(wv.x); a[j][2] += bf_lo(wv.y); a[j][3] += bf_hi(wv.y); } }
        }
        const float* m = mod_ptr(p, l, row_modrow(row)) + 5 * DM;
#pragma unroll
        for (int j = 0; j < 4; ++j) { const f32x4 g2 = *(const f32x4*)(m + 256 * j + 4 * lane); v[j] = v[j] * ALPHA + g2 * a[j]; }
        row_normalize(v); row_affine(v, g, bb, lane);
        if (l + 1 < DEPTH) row_store_bf16(xr, lane, v); else row_store(p.out + (size_t)row * DM, lane, v);
        if (l + 1 < DEPTH) { row_normalize(v); const float* m2 = mod_ptr(p, l + 1, row_modrow(row)); row_modulate(v, m2, m2 + DM, lane); row_store_bf16(HB + (size_t)row * DM, lane, v); }
    }
}

constexpr int N_PHASES = 2 + 8 * DEPTH;
#define IN(k) (lo <= (k) && (k) < hi)
#ifndef TS_SEL
#define TS_SEL -1
#endif
#define TS_MULT 8
#define SEAM(k) do { if (IN(k) && IN((k) + 1)) xcd_barrier(bar); if (TS_SEL >= 0 && blockIdx.x == 0 && threadIdx.x == 0) ((unsigned long long*)(p.ws + WS_CTL + 65536))[(k) + 1] = __builtin_amdgcn_s_memrealtime(); } while (0)
#ifndef PHMASK
#define PHMASK 0x3ff
#endif
#define PHON(i) ((PHMASK >> (i)) & 1)
#ifndef DUP_MASK
#define DUP_MASK 0
#endif
#define DUP(i) ((DUP_MASK >> (i)) & 1)
template <int l>
__device__ __forceinline__ void run_layer(const Params& p, LAS unsigned char* lds, LAS int* idxl, const XcdBarrier& bar, int bid, int nb, int lo, int hi) {
    bf16_t* HB = (bf16_t*)(p.ws + WS_HB); bf16_t* PB = (bf16_t*)(p.ws + WS_PB); bf16_t* OB = (bf16_t*)(p.ws + WS_OB);
    bf16_t* HH = (bf16_t*)(p.ws + WS_HH); bf16_t* Y = (bf16_t*)(p.ws + WS_Y);
    const int* TOK = (const int*)(p.ws + WS_TOK); const float* GATE = (const float*)(p.ws + WS_GATE);
        const int pb = 2 + 8 * l; const bool wc = (l == 0);
        if (IN(pb + 0)) { if (PHON(2)) {
            const bf16_t* W = (const bf16_t*)(p.ws + WS_WIN) + (size_t)l * INW * DM; EpiQKV E{PB, (const float*)(p.ws + WS_ROPE)};
            { SgDesc g{HB + (size_t)NLAT * DM, DM, nullptr, W, 0, 1 << 30, 1, NCTX, INW, DM, NLAT}; sg_gemm(g, E, bid, nb); }
            { mg::Gemm g{HB, W, NLAT, INW, DM, nullptr, 0, 1 << 20, 1}; mg::StaticOrder S; S.init(NLAT, INW, nb, bid); mg::EpiAdapt<EpiQKV> EA{E, 0}; mg::gemm_phase(lds, idxl, g, S, EA); if (DUP(2)) mg::gemm_phase(lds, idxl, g, S, EA); } } }
        SEAM(pb + 0);
        if (IN(pb + 1)) { if (PHON(3)) {
#if FAST_ATTN
            fa::phase_attn(p, l, wc, lds, bid, nb); if (DUP(3)) fa::phase_attn(p, l, wc, lds, bid, nb);
#endif
            phase_mixers(p, l, wc, bid, nb); } }
        SEAM(pb + 1);
        if (IN(pb + 2)) { if (PHON(4)) {
            const bf16_t* W = (const bf16_t*)(p.ws + WS_WOUT) + (size_t)l * DM * DM;
            EpiOut<l == 0> E{p.x, p.ctx, (bf16_t*)(p.ws + WS_XB), mod_ptr(p, l, 0)};
            if (wc) { SgDesc g{OB + (size_t)NLAT * DM, DM, nullptr, W, 0, 1 << 30, 1, NCTX, DM, DM, NLAT}; sg_gemm(g, E, bid, nb); }
            { mg::Gemm g{OB, W, NLAT, DM, DM, nullptr, 0, 1 << 20, 1}; mg::StaticOrder S; S.init(NLAT, DM, nb, bid); mg::EpiAdapt<EpiOut<l == 0>> EA{E, 0}; mg::gemm_phase(lds, idxl, g, S, EA); if (DUP(4) && l == 0) mg::gemm_phase(lds, idxl, g, S, EA); } } }
        SEAM(pb + 2);
        if (IN(pb + 3)) { if (PHON(5)) phase_ln_router(p, l, wc, lds, bid, nb); }
        SEAM(pb + 3);
        if (IN(pb + 4)) { if (PHON(6)) phase_topk(p, wc, lds, bid, nb); if (DUP(6)) phase_topk(p, wc, lds, bid, nb); }
        SEAM(pb + 4);
        if (IN(pb + 5)) { if (PHON(7)) {
            const bf16_t* W = (const bf16_t*)(p.ws + WS_WGU) + (size_t)l * NE * 1024 * DM; EpiGU E{HH};
            if (wc) { SgDesc g{HB, DM, TOK + NSLOT_LAT, W, (size_t)1024 * DM, NB * CCAP, NE, NSLOT_CTX, 1024, DM, NSLOT_LAT}; sg_gemm(g, E, bid, nb); }
            { mg::Gemm g{HB, W, NSLOT_LAT, 1024, DM, TOK, (size_t)1024 * DM, CAP / 256, NE}; mg::StaticOrder S; S.init(NSLOT_LAT, 1024, nb, bid); mg::EpiAdapt<EpiGU> EA{E, 0}; mg::gemm_phase(lds, idxl, g, S, EA); if (DUP(7)) mg::gemm_phase(lds, idxl, g, S, EA); } } }
        SEAM(pb + 5);
        if (IN(pb + 6)) { if (PHON(8)) {
            const bf16_t* W = (const bf16_t*)(p.ws + WS_WD) + (size_t)l * NE * DM * FF; EpiDown E{Y, GATE};
            if (wc) { SgDesc g{HH + (size_t)NSLOT_LAT * FF, FF, nullptr, W, (size_t)DM * FF, NB * CCAP, NE, NSLOT_CTX, DM, FF, NSLOT_LAT}; sg_gemm(g, E, bid, nb); }
            { mg::Gemm g{HH, W, NSLOT_LAT, DM, FF, nullptr, (size_t)DM * FF, CAP / 256, NE}; mg::StaticOrder S; S.init(NSLOT_LAT, DM, nb, bid); mg::EpiAdapt<EpiDown> EA{E, 0}; mg::gemm_phase(lds, idxl, g, S, EA); if (DUP(8)) mg::gemm_phase(lds, idxl, g, S, EA); } } }
        SEAM(pb + 6);
        if (IN(pb + 7)) { if (PHON(9)) phase_combine(p, l, wc, bid, nb); }
        SEAM(pb + 7);
}
__global__ void __launch_bounds__(NTHREADS, 2) fwd_kernel(Params p) {
    extern __shared__ __attribute__((aligned(16))) unsigned char lds_raw[];
    LAS unsigned char* lds = (LAS unsigned char*)lds_raw;
    const int bid = blockIdx.x, nb = gridDim.x;
    volatile LAS unsigned* MISC = (volatile LAS unsigned*)(lds + LDS_BYTES - 64);
    LAS int* idxl = (LAS int*)(lds + mg::STAGE_BYTES);
    if (threadIdx.x < 16) MISC[threadIdx.x] = 0u;
    __syncthreads();
    XcdBarrier bar; bar.bar = (unsigned*)(p.ws + WS_CTL) + CW_BAR; bar.x = 0; bar.st = nullptr;
    const bool multi = p.ph_hi - p.ph_lo > 1;
    if (multi) bar = xcd_barrier_post((unsigned*)(p.ws + WS_CTL) + CW_BAR, MISC + 8);
    bf16_t* HB = (bf16_t*)(p.ws + WS_HB); bf16_t* PB = (bf16_t*)(p.ws + WS_PB); bf16_t* OB = (bf16_t*)(p.ws + WS_OB);
    bf16_t* HH = (bf16_t*)(p.ws + WS_HH); bf16_t* Y = (bf16_t*)(p.ws + WS_Y);
    const int* TOK = (const int*)(p.ws + WS_TOK); const float* GATE = (const float*)(p.ws + WS_GATE);
    const int lo = p.ph_lo, hi = p.ph_hi;
    if (TS_SEL >= 0 && blockIdx.x == 0 && threadIdx.x == 0) ((unsigned long long*)(p.ws + WS_CTL + 65536))[0] = __builtin_amdgcn_s_memrealtime();
    if (IN(0)) { if (PHON(0)) phase_prologue(p, lds, bid, nb); if (DUP(0)) { __syncthreads(); phase_prologue(p, lds, bid, nb); } } SEAM(0);
    if (IN(1)) { if (PHON(1)) phase_ln1(p, bid, nb); if (DUP(1)) phase_ln1(p, bid, nb); } SEAM(1);
    run_layer<0>(p, lds, idxl, bar, bid, nb, lo, hi);
    run_layer<1>(p, lds, idxl, bar, bid, nb, lo, hi);
    if (TS_SEL >= 0 && blockIdx.x == 0 && threadIdx.x == 0) {
        volatile unsigned long long* ts = (volatile unsigned long long*)(p.ws + WS_CTL + 65536); const unsigned long long dt = (ts[TS_SEL + 1] - ts[TS_SEL]) * TS_MULT, t0 = __builtin_amdgcn_s_memrealtime();
        while (__builtin_amdgcn_s_memrealtime() - t0 < dt) __builtin_amdgcn_s_sleep(8); }
#undef IN
#undef SEAM
}

#ifndef N_LAUNCH_SPLIT
#define N_LAUNCH_SPLIT 0
#endif
extern "C" void kernel_launch(void* const* d_in, const int* in_sizes, int n_in, void* d_out, int out_size, void* d_ws, size_t ws_size, hipStream_t stream) {
    static int grid = 0;
    if (grid == 0) {
        if (n_in != 19 || in_sizes[0] != NLAT * DM || out_size != NLAT * DM || ws_size < WS_END) { fprintf(stderr, "kernel_launch: unexpected shapes (n_in %d, in0 %d, out %d, ws %zu)\n", n_in, n_in > 0 ? in_sizes[0] : -1, out_size, ws_size); grid = -1; return; }
        int dev = 0, cus = 0, per_cu = 0;
        if (hipGetDevice(&dev) != hipSuccess || hipDeviceGetAttribute(&cus, hipDeviceAttributeMultiprocessorCount, dev) != hipSuccess) { grid = -1; return; }
        if (hipFuncSetAttribute((const void*)fwd_kernel, hipFuncAttributeMaxDynamicSharedMemorySize, LDS_BYTES) != hipSuccess) { fprintf(stderr, "kernel_launch: hipFuncSetAttribute failed\n"); grid = -1; return; }
        if (hipOccupancyMaxActiveBlocksPerMultiprocessor(&per_cu, (const void*)fwd_kernel, NTHREADS, LDS_BYTES) != hipSuccess || per_cu < 1) { fprintf(stderr, "kernel_launch: occupancy query says %d\n", per_cu); per_cu = 1; }
        (void)hipGetLastError();
        grid = cus;
    }
    if (grid < 0) return;
    (void)hipMemsetAsync((char*)d_ws + WS_CTL, 0, CTL_ZERO_BYTES, stream);
    Params p{};
    const float** pp = (const float**)&p;
    for (int i = 0; i < 19; ++i) pp[i] = (const float*)d_in[i];
    p.out = (float*)d_out; p.ws = (unsigned char*)d_ws;
#if N_LAUNCH_SPLIT
    for (int ph = 0; ph < N_PHASES; ++ph) { p.ph_lo = ph; p.ph_hi = ph + 1; hipLaunchKernelGGL(fwd_kernel, dim3(grid), dim3(NTHREADS), LDS_BYTES, stream, p); }
#else
    p.ph_lo = 0; p.ph_hi = N_PHASES;
    void* args[] = {&p};
    hipError_t e = hipLaunchCooperativeKernel((const void*)fwd_kernel, dim3(grid), dim3(NTHREADS), args, LDS_BYTES, stream);
    if (e != hipSuccess) fprintf(stderr, "kernel_launch: cooperative launch failed: %s\n", hipGetErrorString(e));
#endif
}
```

```cpp
#include <hip/hip_runtime.h>
#include <hip/hip_cooperative_groups.h>
#include <cstdio>
#include <cstdint>
#include <cmath>

#define LAS __attribute__((address_space(3)))
typedef unsigned short bf16_t;
typedef short bf16x8 __attribute__((ext_vector_type(8)));
typedef float f32x4 __attribute__((ext_vector_type(4)));
typedef unsigned u32x4 __attribute__((ext_vector_type(4)));
typedef unsigned u32x2 __attribute__((ext_vector_type(2)));

constexpr int NB = 4, SEQ = 8192, DM = 1024, CTXL = 256, DEPTH = 2;
constexpr int NLAT = NB * SEQ, NCTX = NB * CTXL, NROWS = NLAT + NCTX;
constexpr int INW = 2560, NE = 16, FF = 512, CAP = 1024, CCAP = 32;
constexpr int NSLOT_LAT = NB * NE * CAP, NSLOT_CTX = NB * NE * CCAP, NSLOT = NSLOT_LAT + NSLOT_CTX;
constexpr int NMOD = 6 * DM;
constexpr float LN_EPS = 1e-6f;
constexpr float ALPHA = 1.41421356237309515f;
constexpr int C_QA = 0, C_KA = 384, C_VA = 512, C_BX = 640, C_BB = 896, C_BC = 1152, C_QN = 1408, C_KN = 1792, C_VN = 2176;

#ifndef FAST_ATTN
#define FAST_ATTN 1
#endif
constexpr int NTHREADS = 512, NWAVES = 8;
constexpr int LDS_BYTES = 147456;

constexpr size_t MiB = 1u << 20;
constexpr size_t WS_CTL = 0, CTL_ZERO_BYTES = 1 * MiB;
constexpr size_t WS_ROPE = 1 * MiB;
constexpr size_t WS_MOD = 1 * MiB + 65536;
constexpr size_t WS_AFF = 2 * MiB;
constexpr size_t WS_INV = 5 * MiB;
constexpr size_t WS_TOK = 8 * MiB;
constexpr size_t WS_GATE = 8 * MiB + 512 * 1024;
constexpr size_t WS_CXR = 9 * MiB;
constexpr size_t WS_WIN = 16 * MiB;
constexpr size_t WS_WOUT = 26 * MiB;
constexpr size_t WS_WGU = 30 * MiB;
constexpr size_t WS_WD = 94 * MiB;
constexpr size_t WS_HB = 126 * MiB;
constexpr size_t WS_OB = 192 * MiB;
constexpr size_t WS_HH = 192 * MiB;
constexpr size_t WS_PB = 258 * MiB;
constexpr size_t WS_Y = 258 * MiB;
constexpr size_t WS_XB = 424 * MiB;
constexpr size_t WS_END = 490 * MiB;
static_assert(WS_HB + (size_t)NROWS * DM * 2 <= WS_OB && WS_OB + (size_t)NROWS * DM * 2 <= WS_PB && WS_PB + (size_t)NROWS * INW * 2 <= WS_XB && WS_XB + (size_t)NROWS * DM * 2 <= WS_END, "ws map");
static_assert((size_t)NSLOT * FF * 2 <= (size_t)NROWS * DM * 2 && (size_t)NSLOT * DM * 2 <= (size_t)NROWS * INW * 2, "overlays");
constexpr int CW_BAR = 4096;

struct Params {
    const float *x, *c, *ctx, *c_ctx, *w_mod, *b_mod, *w_in, *conv_w, *attn_sink, *na_rpb, *w_out, *ln1_g, *ln1_b, *w_router, *w_gate, *w_up, *w_down, *ln2_g, *ln2_b;
    float* out; unsigned char* ws;
    int ph_lo, ph_hi;
};

__device__ __forceinline__ unsigned f2bf(float f) { unsigned u = __builtin_bit_cast(unsigned, f); return (u + 0x7fffu + ((u >> 16) & 1u)) >> 16; }
__device__ __forceinline__ unsigned pk2(float lo, float hi) { return f2bf(lo) | (f2bf(hi) << 16); }
__device__ __forceinline__ float bf_lo(unsigned w) { return __builtin_bit_cast(float, w << 16); }
__device__ __forceinline__ float bf_hi(unsigned w) { return __builtin_bit_cast(float, w & 0xffff0000u); }
template <int CTRL> __device__ __forceinline__ float dppf(float v) { return __builtin_bit_cast(float, __builtin_amdgcn_update_dpp(0, __builtin_bit_cast(int, v), CTRL, 0xf, 0xf, true)); }
__device__ __forceinline__ void swap16(float v, float& a, float& b) { a = v; b = v; asm volatile("s_nop 1\n\tv_permlane16_swap_b32 %0, %1" : "+v"(a), "+v"(b)); }
__device__ __forceinline__ void swap32(float v, float& a, float& b) { a = v; b = v; asm volatile("s_nop 1\n\tv_permlane32_swap_b32 %0, %1" : "+v"(a), "+v"(b)); }
__device__ __forceinline__ float xor16_sum(float v) { float a, b; swap16(v, a, b); return a + b; }
__device__ __forceinline__ float xor32_sum(float v) { float a, b; swap32(v, a, b); return a + b; }
__device__ __forceinline__ float xor16_max(float v) { float a, b; swap16(v, a, b); return fmaxf(a, b); }
__device__ __forceinline__ float xor32_max(float v) { float a, b; swap32(v, a, b); return fmaxf(a, b); }
__device__ __forceinline__ float wave_sum(float v) {
    v += dppf<0xB1>(v); v += dppf<0x4E>(v); v += dppf<0x141>(v); v += dppf<0x140>(v);
    return xor32_sum(xor16_sum(v));
}
#define LDS_WAIT() asm volatile("s_waitcnt lgkmcnt(0)" ::: "memory")
__device__ __forceinline__ int opaque_tid() { int t = threadIdx.x; asm volatile("" : "+v"(t)); return t; }
__device__ __forceinline__ int opaque_s(int v) { asm volatile("" : "+s"(v)); return v; }

__device__ __forceinline__ float* mod_ptr(const Params& p, int l, int r) { return (float*)(p.ws + WS_MOD) + ((size_t)l * 5 + r) * NMOD; }

#define XB_TMO      128
#define XB_XCNT(j)  (256  + 64 * (j))
#define XB_XSUB(j)  (1280 + 64 * (j))
#define XB_XGEN(j)  (2304 + 64 * (j))
#define XB_TOP      3328
#define XB_TOPGEN   3392
#define XCD_BAR_WORDS 3456
#define XB_SPIN_CAP (1u << 20)
__device__ __forceinline__ unsigned xb_ld(unsigned* p)              { return __hip_atomic_load(p, __ATOMIC_RELAXED, __HIP_MEMORY_SCOPE_AGENT); }
__device__ __forceinline__ unsigned xb_add(unsigned* p, unsigned v) { return __hip_atomic_fetch_add(p, v, __ATOMIC_RELAXED, __HIP_MEMORY_SCOPE_AGENT); }
__device__ __forceinline__ unsigned xb_xcc_id() { return (unsigned)__builtin_amdgcn_s_getreg((3 << 11) | 20) & 0xFu; }
#define XB_SPIN(cond, bar) do { unsigned _sp = 0; while (cond) { __builtin_amdgcn_s_sleep(1); \
    if ((++_sp & 255u) == 0u) { if (xb_ld(&(bar)[XB_TMO])) break; if (_sp > XB_SPIN_CAP) { atomicAdd(&(bar)[XB_TMO], 1u); break; } } } } while (0)
struct XcdBarrier { unsigned* bar; unsigned x; volatile LAS unsigned* st; };
__device__ __forceinline__ XcdBarrier xcd_barrier_post(unsigned* bar, volatile LAS unsigned* st) {
    XcdBarrier b; b.bar = bar; b.x = xb_xcc_id(); b.st = st;
    if (threadIdx.x == 0) (void)xb_add(&bar[XB_XCNT(b.x)], 1u);
    return b;
}
__device__ __forceinline__ void xcd_barrier_complete(unsigned* bar, unsigned x, unsigned& nloc, unsigned& nx) {
    const unsigned G = gridDim.x * gridDim.y * gridDim.z;
    unsigned sum, cnt, mine, sp = 0u;
    for (;;) {
        sum = 0u; cnt = 0u; mine = 0u;
#pragma unroll 1
        for (unsigned j = 0; j < 16; ++j) { const unsigned c = xb_ld(&bar[XB_XCNT(j)]); sum += c; cnt += (c > 0u) ? 1u : 0u; mine = (j == x) ? c : mine; }
        if (sum == G) break;
        __builtin_amdgcn_s_sleep(1);
        if ((++sp & 255u) == 0u) { if (xb_ld(&bar[XB_TMO])) break; if (sp > XB_SPIN_CAP) { atomicAdd(&bar[XB_TMO], 1u); break; } }
    }
    nloc = mine > 0u ? mine : 1u; nx = cnt > 0u ? cnt : 1u;
}
__device__ __forceinline__ void xcd_barrier(const XcdBarrier& b) {
    asm volatile("s_waitcnt vmcnt(0)" ::: "memory");
    __syncthreads();
    if (threadIdx.x == 0) {
        unsigned* bar = b.bar; asm volatile("" : "+s"(bar));
        __builtin_amdgcn_s_waitcnt(0);
        unsigned nloc = b.st[0], nx = b.st[1];
        if (nloc == 0u) { xcd_barrier_complete(bar, b.x, nloc, nx); b.st[0] = nloc; b.st[1] = nx; }
        const unsigned old = xb_add(&bar[XB_XSUB(b.x)], 1u);
        const unsigned gen = old / nloc;
        if (old + 1u == (gen + 1u) * nloc) {
            __builtin_amdgcn_fence(__ATOMIC_RELEASE, "agent");
            asm volatile("s_waitcnt vmcnt(0)" ::: "memory");
            const unsigned og = xb_add(&bar[XB_TOP], 1u);
            const unsigned tg = og / nx;
            if (og + 1u == (tg + 1u) * nx) xb_add(&bar[XB_TOPGEN], 1u);
            else XB_SPIN(xb_ld(&bar[XB_TOPGEN]) == tg, bar);
            __builtin_amdgcn_fence(__ATOMIC_ACQUIRE, "agent");
            xb_add(&bar[XB_XGEN(b.x)], 1u);
            asm volatile("s_waitcnt vmcnt(0)" ::: "memory");
        } else {
            XB_SPIN(xb_ld(&bar[XB_XGEN(b.x)]) == gen, bar);
            __builtin_amdgcn_fence(__ATOMIC_ACQUIRE, "agent");
            asm volatile("s_waitcnt vmcnt(0)" ::: "memory");
        }
    }
    __syncthreads();
}

struct TrItem { const float* W; bf16_t* WT; int K, N, mode, item; };
__device__ __forceinline__ void tr_load(const TrItem& t, int lane, float (&r)[32]) {
    const int nblk = t.N / 32, kb = t.item / nblk, nb = t.item % nblk, k0 = 64 * kb, n0 = 32 * nb;
    const float* src = t.W + (size_t)(k0 + (lane >> 5)) * t.N + n0 + (lane & 31);
#pragma unroll
    for (int i = 0; i < 32; ++i) r[i] = src[(size_t)(2 * i) * t.N];
}
__device__ __forceinline__ void tr_finish(const TrItem& t, int lane, const float (&r)[32], LAS float* scr) {
    const int nblk = t.N / 32, kb = t.item / nblk, nb = t.item % nblk, k0 = 64 * kb, n0 = 32 * nb;
#pragma unroll
    for (int i = 0; i < 32; ++i) scr[(2 * i + (lane >> 5)) * 33 + (lane & 31)] = r[i];
    LDS_WAIT();
    const int c = lane & 7;
#pragma unroll
    for (int j = 0; j < 4; ++j) {
        const int n = (lane >> 3) + 8 * j; const LAS float* s = scr + (8 * c) * 33 + n;
        u32x4 o; o.x = pk2(s[0 * 33], s[1 * 33]); o.y = pk2(s[2 * 33], s[3 * 33]); o.z = pk2(s[4 * 33], s[5 * 33]); o.w = pk2(s[6 * 33], s[7 * 33]);
        const int f = n0 + n;
        const int orow = t.mode == 0 ? ((f & ~255) + 128 * ((f >> 4) & 1) + 32 * ((f >> 6) & 3) + 16 * ((f >> 2) & 1) + 4 * (2 * ((f >> 5) & 1) + ((f >> 3) & 1)) + (f & 3))
                                     : (256 * (f >> 7) + (t.mode == 2 ? 128 : 0) + 32 * ((f >> 5) & 3) + 16 * ((f >> 2) & 1) + 4 * ((f >> 3) & 3) + (f & 3));
        *(u32x4*)(t.WT + (size_t)orow * t.K + k0 + 8 * c) = o;
    }
    LDS_WAIT();
}
__device__ __forceinline__ void phase_prologue(const Params& p, LAS unsigned char* lds, int bid, int nb) {
    bid = opaque_s(bid); const int tid = opaque_tid(), lane = tid & 63, w = tid >> 6;
    {
        LAS float* ssil = (LAS float*)lds;
        LAS float* red = ssil + 5 * 1024;
        for (int i = tid; i < 5 * 1024; i += NTHREADS) { const int r = i >> 10, k = i & 1023; const float v = r < 4 ? p.c[r * 1024 + k] : p.c_ctx[k]; ssil[i] = v / (1.f + expf(-v)); }
        __syncthreads();
        for (int item = bid; item < 2 * 96; item += nb) {
            const int l = item / 96, n0 = (item % 96) * 64;
            const float* W = p.w_mod + (size_t)l * DM * NMOD + n0 + lane;
            float a0 = 0.f, a1 = 0.f, a2 = 0.f, a3 = 0.f, a4 = 0.f;
#pragma unroll 8
            for (int k = w * 128; k < w * 128 + 128; ++k) {
                const float wv = W[(size_t)k * NMOD];
                a0 += ssil[k] * wv; a1 += ssil[1024 + k] * wv; a2 += ssil[2048 + k] * wv; a3 += ssil[3072 + k] * wv; a4 += ssil[4096 + k] * wv;
            }
            red[(w * 5 + 0) * 64 + lane] = a0; red[(w * 5 + 1) * 64 + lane] = a1; red[(w * 5 + 2) * 64 + lane] = a2; red[(w * 5 + 3) * 64 + lane] = a3; red[(w * 5 + 4) * 64 + lane] = a4;
            __syncthreads();
            if (tid < 320) { const int r = tid >> 6; float s = 0.f;
#pragma unroll
                for (int ww = 0; ww < 8; ++ww) s += red[(ww * 5 + r) * 64 + lane];
                mod_ptr(p, l, r)[n0 + lane] = s + p.b_mod[l * NMOD + n0 + lane]; }
            __syncthreads();
        }
    }
    if (bid == nb - 1) {
        float* rope = (float*)(p.ws + WS_ROPE);
        for (int e = tid; e < 128 * 16; e += NTHREADS) {
            const int pos = e >> 4, i = e & 15;
            const double a = exp(-((double)i / 16.0) * 9.210340371976184);
            const double a2 = a * a; double c = 1.0, s = a, tc = 1.0, ts = a;
            for (int n = 1; n <= 14; ++n) { tc *= -a2 / (double)((2 * n - 1) * (2 * n)); c += tc; ts *= -a2 / (double)((2 * n) * (2 * n + 1)); s += ts; }
            double rc = 1.0, rs = 0.0, bc = c, bs = s; int q = pos;
            while (q) { if (q & 1) { const double t = rc * bc - rs * bs; rs = rc * bs + rs * bc; rc = t; } const double t = bc * bc - bs * bs; bs = 2.0 * bc * bs; bc = t; q >>= 1; }
            rope[2 * e] = (float)rc; rope[2 * e + 1] = (float)rs;
        }
    }
}

__device__ __forceinline__ void phase_weights(const Params& p, LAS unsigned char* lds, int bid, int nb) {
    bid = opaque_s(bid); const int tid = opaque_tid(), lane = tid & 63, w = tid >> 6;
    {
        LAS float* scr = (LAS float*)lds + w * (64 * 33);
        const int gw = bid * NWAVES + w, NGW = nb * NWAVES;
        constexpr int I_IN = 16 * 80, I_OUT = 16 * 32, I_G = 16 * 16, I_D = 8 * 32;
        constexpr int PER_L = I_IN + I_OUT + 16 * (2 * I_G + I_D);
        auto decode = [&](int it) -> TrItem {
            const int l = it / PER_L; int r = it % PER_L;
            if (r < I_IN) return TrItem{p.w_in + (size_t)l * DM * INW, (bf16_t*)(p.ws + WS_WIN) + (size_t)l * INW * DM, DM, INW, 0, r}; r -= I_IN;
            if (r < I_OUT) return TrItem{p.w_out + (size_t)l * DM * DM, (bf16_t*)(p.ws + WS_WOUT) + (size_t)l * DM * DM, DM, DM, 0, r}; r -= I_OUT;
            if (r < 16 * I_G) { const int e = r / I_G; return TrItem{p.w_gate + ((size_t)l * NE + e) * DM * FF, (bf16_t*)(p.ws + WS_WGU) + ((size_t)l * NE + e) * 1024 * DM, DM, FF, 1, r % I_G}; } r -= 16 * I_G;
            if (r < 16 * I_G) { const int e = r / I_G; return TrItem{p.w_up + ((size_t)l * NE + e) * DM * FF, (bf16_t*)(p.ws + WS_WGU) + ((size_t)l * NE + e) * 1024 * DM, DM, FF, 2, r % I_G}; } r -= 16 * I_G;
            const int e = r / I_D; return TrItem{p.w_down + ((size_t)l * NE + e) * FF * DM, (bf16_t*)(p.ws + WS_WD) + ((size_t)l * NE + e) * DM * FF, FF, DM, 0, r % I_D};
        };
        float ra[32], rb[32];
        int it = gw;
        if (it < 2 * PER_L) { TrItem cur = decode(it); tr_load(cur, lane, ra);
#pragma unroll 1
            for (;;) {
                const int itn = it + NGW; const bool hn = itn < 2 * PER_L; TrItem nx = cur;
                if (hn) { nx = decode(itn); tr_load(nx, lane, rb); }
                tr_finish(cur, lane, ra, scr);
                if (!hn) break;
                const int itn2 = itn + NGW; const bool hn2 = itn2 < 2 * PER_L; TrItem nx2 = nx;
                if (hn2) { nx2 = decode(itn2); tr_load(nx2, lane, ra); }
                tr_finish(nx, lane, rb, scr);
                if (!hn2) break;
                cur = nx2; it = itn2;
            }
        }
    }
}

__device__ __forceinline__ void row_load(const float* rowp, int lane, f32x4 (&v)[4]) {
#pragma unroll
    for (int j = 0; j < 4; ++j) v[j] = *(const f32x4*)(rowp + 256 * j + 4 * lane);
}
__device__ __forceinline__ void row_load_bf16(const bf16_t* rowp, int lane, f32x4 (&v)[4]) {
#pragma unroll
    for (int j = 0; j < 4; ++j) { const u32x2 w = *(const u32x2*)(rowp + 256 * j + 4 * lane); v[j] = (f32x4){bf_lo(w.x), bf_hi(w.x), bf_lo(w.y), bf_hi(w.y)}; }
}
__device__ __forceinline__ void row_store(float* rowp, int lane, const f32x4 (&v)[4]) {
#pragma unroll
    for (int j = 0; j < 4; ++j) *(f32x4*)(rowp + 256 * j + 4 * lane) = v[j];
}
__device__ __forceinline__ void row_store_bf16(bf16_t* rowp, int lane, const f32x4 (&v)[4]) {
#pragma unroll
    for (int j = 0; j < 4; ++j) { u32x2 o; o.x = pk2(v[j][0], v[j][1]); o.y = pk2(v[j][2], v[j][3]); *(u32x2*)(rowp + 256 * j + 4 * lane) = o; }
}
__device__ __forceinline__ void row_normalize(f32x4 (&v)[4]) {
    float s = 0.f;
#pragma unroll
    for (int j = 0; j < 4; ++j) s += (v[j][0] + v[j][1]) + (v[j][2] + v[j][3]);
    const float mean = wave_sum(s) * (1.f / DM);
    float q = 0.f;
#pragma unroll
    for (int j = 0; j < 4; ++j) { v[j] = v[j] - mean; q += (v[j][0] * v[j][0] + v[j][1] * v[j][1]) + (v[j][2] * v[j][2] + v[j][3] * v[j][3]); }
    const float rstd = 1.f / sqrtf(wave_sum(q) * (1.f / DM) + LN_EPS);
#pragma unroll
    for (int j = 0; j < 4; ++j) v[j] = v[j] * rstd;
}
__device__ __forceinline__ void row_modulate(f32x4 (&v)[4], const float* sh, const float* sc, int lane) {
#pragma unroll
    for (int j = 0; j < 4; ++j) { const f32x4 a = *(const f32x4*)(sc + 256 * j + 4 * lane), b = *(const f32x4*)(sh + 256 * j + 4 * lane); v[j] = v[j] * (a + 1.f) + b; }
}
__device__ __forceinline__ void row_affine(f32x4 (&v)[4], const float* g, const float* bb, int lane) {
#pragma unroll
    for (int j = 0; j < 4; ++j) { const f32x4 a = *(const f32x4*)(g + 256 * j + 4 * lane), b = *(const f32x4*)(bb + 256 * j + 4 * lane); v[j] = v[j] * a + b; }
}
__device__ __forceinline__ void row_modulate_l(f32x4 (&v)[4], const LAS float* sh, const LAS float* sc, int lane) {
#pragma unroll
    for (int j = 0; j < 4; ++j) { const f32x4 a = *(const LAS f32x4*)(sc + 256 * j + 4 * lane), b = *(const LAS f32x4*)(sh + 256 * j + 4 * lane); v[j] = v[j] * (a + 1.f) + b; }
}
__device__ __forceinline__ void row_affine_l(f32x4 (&v)[4], const LAS float* g, const LAS float* bb, int lane) {
#pragma unroll
    for (int j = 0; j < 4; ++j) { const f32x4 a = *(const LAS f32x4*)(g + 256 * j + 4 * lane), b = *(const LAS f32x4*)(bb + 256 * j + 4 * lane); v[j] = v[j] * a + b; }
}
__device__ __forceinline__ int row_modrow(int row) { return row < NLAT ? (row >> 13) : 4; }
__device__ __forceinline__ void lds_fill(LAS float* dst, const float* src, int n, int tid) { for (int i = tid * 4; i < n; i += NTHREADS * 4) *(LAS f32x4*)(dst + i) = *(const f32x4*)(src + i); }

__device__ __forceinline__ void phase_ln1(const Params& p, int bid, int nb) {
    bid = opaque_s(bid); const int tid = opaque_tid(), lane = tid & 63, gw = bid * NWAVES + (tid >> 6), NGW = nb * NWAVES;
    bf16_t* HB = (bf16_t*)(p.ws + WS_HB);
    f32x4 v[4], vn[4];
    if (gw < NROWS) row_load(gw < NLAT ? p.x + (size_t)gw * DM : p.ctx + (size_t)(gw - NLAT) * DM, lane, v);
#pragma unroll 1
    for (int row = gw; row < NROWS; row += NGW) {
        const int rn = row + NGW;
        if (rn < NROWS) row_load(rn < NLAT ? p.x + (size_t)rn * DM : p.ctx + (size_t)(rn - NLAT) * DM, lane, vn);
        row_normalize(v);
        const float* m = mod_ptr(p, 0, row_modrow(row)); row_modulate(v, m, m + DM, lane);
        row_store_bf16(HB + (size_t)row * DM, lane, v);
#pragma unroll
        for (int j = 0; j < 4; ++j) v[j] = vn[j];
    }
}

struct SgDesc { const bf16_t* A; int lda; const int* rowidx; const bf16_t* Bt; size_t grp_stride; int rows_per_grp, ngrp; int M, N, K; int row_base; };
template <class Epi>
__device__ __forceinline__ void sg_gemm(const SgDesc& g, const Epi& E, int bid, int nb) {
    bid = opaque_s(bid); const int tid = opaque_tid(); const int lane = tid & 63, w = __builtin_amdgcn_readfirstlane(tid >> 6), fr = lane & 15, fq = lane >> 4;
    const int tilesN = g.N / 64, tiles = (g.M / 64) * tilesN;
#pragma unroll 1
    for (int t = bid + nb * w; t < tiles; t += nb * NWAVES) {
        const int tm = t / tilesN, tn = t % tilesN, pn = tn >> 2, wc = tn & 3;
        const int row0 = tm * 64;
        const bf16_t* Bt = g.Bt + (size_t)((row0 / g.rows_per_grp) % g.ngrp) * g.grp_stride;
        const bf16_t* ap[4]; const bf16_t* bp[4];
#pragma unroll
        for (int i = 0; i < 4; ++i) { const int r = row0 + 16 * i + fr; const int ar = g.rowidx ? g.rowidx[r] : r; ap[i] = g.A + (size_t)ar * g.lda + 8 * fq; }
#pragma unroll
        for (int n = 0; n < 4; ++n) bp[n] = Bt + (size_t)(256 * pn + 128 * (n >> 1) + 32 * wc + 16 * (n & 1) + fr) * g.K + 8 * fq;
        f32x4 acc[4][4];
#pragma unroll
        for (int i = 0; i < 4; ++i)
#pragma unroll
            for (int n = 0; n < 4; ++n) acc[i][n] = (f32x4){0.f, 0.f, 0.f, 0.f};
        bf16x8 a0[4], b0[4], a1[4], b1[4], a2[4], b2[4], a3[4], b3[4];
#define SG_LOAD(A_, B_, k_) do { _Pragma("unroll") for (int i = 0; i < 4; ++i) { A_[i] = *(const bf16x8*)(ap[i] + (k_)); B_[i] = *(const bf16x8*)(bp[i] + (k_)); } } while (0)
#define SG_MMA(A_, B_) do { _Pragma("unroll") for (int i = 0; i < 4; ++i) _Pragma("unroll") for (int n = 0; n < 4; ++n) acc[i][n] = __builtin_amdgcn_mfma_f32_16x16x32_bf16(B_[n], A_[i], acc[i][n], 0, 0, 0); } while (0)
        SG_LOAD(a0, b0, 0); SG_LOAD(a1, b1, 32); SG_LOAD(a2, b2, 64);
#pragma unroll 1
        for (int k = 0; k < g.K; k += 128) {
            SG_LOAD(a3, b3, k + 96); SG_MMA(a0, b0);
            if (k + 128 < g.K) SG_LOAD(a0, b0, k + 128);
            SG_MMA(a1, b1);
            if (k + 128 < g.K) SG_LOAD(a1, b1, k + 160);
            SG_MMA(a2, b2);
            if (k + 128 < g.K) SG_LOAD(a2, b2, k + 192);
            SG_MMA(a3, b3);
        }
#undef SG_LOAD
#undef SG_MMA
#pragma unroll
        for (int i = 0; i < 4; ++i) {
            const float rv = E.rowval(g.row_base + row0 + 16 * i + fr);
            E(g.row_base + row0 + 16 * i + fr, pn, wc, fq, acc[i][0], acc[i][1], acc[i][2], acc[i][3], rv);
            asm volatile("" ::: "memory"); }
    }
}

__device__ __forceinline__ void store_bf16x8(bf16_t* p, const f32x4 a, const f32x4 b) { u32x4 o; o.x = pk2(a[0], a[1]); o.y = pk2(a[2], a[3]); o.z = pk2(b[0], b[1]); o.w = pk2(b[2], b[3]); *(u32x4*)p = o; }
__device__ __forceinline__ int epi_col(int pn, int wc, int fq) { return 256 * pn + 64 * wc + 32 * (fq >> 1) + 8 * (fq & 1); }

struct EpiQKV {
    bf16_t* PB; const float* rope;
    __device__ __forceinline__ float rowval(int) const { return 0.f; }
    __device__ __forceinline__ void operator()(int row, int pn, int wc, int fq, f32x4 a0, f32x4 a1, f32x4 b0, f32x4 b1, float) const {
        const int c = epi_col(pn, wc, fq);
        if (c < 512 && row < NLAT) {
            const int t = row & (SEQ - 1); const int pos = (fq >> 1) ? (t & 63) : (t >> 6);
            const f32x4* rp = (const f32x4*)(rope + (pos * 16 + 8 * (fq & 1)) * 2);
            const f32x4 r0 = rp[0], r1 = rp[1], r2 = rp[2], r3 = rp[3];
            const f32x4 cs0 = {r0[0], r0[2], r1[0], r1[2]}, sn0 = {r0[1], r0[3], r1[1], r1[3]}, cs1 = {r2[0], r2[2], r3[0], r3[2]}, sn1 = {r2[1], r2[3], r3[1], r3[3]};
            const f32x4 na0 = a0 * cs0 - b0 * sn0, nb0 = b0 * cs0 + a0 * sn0, na1 = a1 * cs1 - b1 * sn1, nb1 = b1 * cs1 + a1 * sn1;
            a0 = na0; b0 = nb0; a1 = na1; b1 = nb1;
        }
        bf16_t* o = PB + (size_t)row * INW + c;
        store_bf16x8(o, a0, a1); store_bf16x8(o + 16, b0, b1);
    }
};
template <bool FIRST> struct EpiOut {
    const float* xl; const float* xc; bf16_t* XB; const float* mod;
    __device__ __forceinline__ float rowval(int) const { return 0.f; }
    __device__ __forceinline__ void operator()(int row, int pn, int wc, int fq, f32x4 a0, f32x4 a1, f32x4 b0, f32x4 b1, float) const {
        const int c = epi_col(pn, wc, fq); bf16_t* xo = XB + (size_t)row * DM + c;
        const float* g1 = mod + (size_t)row_modrow(row) * NMOD + 2 * DM + c;
        f32x4 xa0, xa1, xb0, xb1;
        if (FIRST) { const float* xin = row < NLAT ? xl + (size_t)row * DM + c : xc + (size_t)(row - NLAT) * DM + c;
            xa0 = *(const f32x4*)xin; xa1 = *(const f32x4*)(xin + 4); xb0 = *(const f32x4*)(xin + 16); xb1 = *(const f32x4*)(xin + 20); }
        else { const u32x4 wa = *(const u32x4*)xo, wb = *(const u32x4*)(xo + 16);
            xa0 = (f32x4){bf_lo(wa.x), bf_hi(wa.x), bf_lo(wa.y), bf_hi(wa.y)}; xa1 = (f32x4){bf_lo(wa.z), bf_hi(wa.z), bf_lo(wa.w), bf_hi(wa.w)};
            xb0 = (f32x4){bf_lo(wb.x), bf_hi(wb.x), bf_lo(wb.y), bf_hi(wb.y)}; xb1 = (f32x4){bf_lo(wb.z), bf_hi(wb.z), bf_lo(wb.w), bf_hi(wb.w)}; }
        const f32x4 ga0 = *(const f32x4*)g1, ga1 = *(const f32x4*)(g1 + 4), gb0 = *(const f32x4*)(g1 + 16), gb1 = *(const f32x4*)(g1 + 20);
        store_bf16x8(xo, xa0 * ALPHA + ga0 * a0, xa1 * ALPHA + ga1 * a1); store_bf16x8(xo + 16, xb0 * ALPHA + gb0 * b0, xb1 * ALPHA + gb1 * b1);
    }
};
struct EpiGU {
    bf16_t* HH;
    __device__ __forceinline__ float rowval(int) const { return 0.f; }
    __device__ __forceinline__ void operator()(int row, int pn, int wc, int fq, f32x4 a0, f32x4 a1, f32x4 b0, f32x4 b1, float) const {
        f32x4 h0, h1;
#pragma unroll
        for (int j = 0; j < 4; ++j) { h0[j] = a0[j] * __builtin_amdgcn_rcpf(1.f + __expf(-a0[j])) * b0[j]; h1[j] = a1[j] * __builtin_amdgcn_rcpf(1.f + __expf(-a1[j])) * b1[j]; }
        store_bf16x8(HH + (size_t)row * FF + 128 * pn + 32 * wc + 8 * fq, h0, h1);
    }
};
struct EpiDown {
    bf16_t* Y; const float* gate;
    __device__ __forceinline__ float rowval(int row) const { return gate[row]; }
    __device__ __forceinline__ void operator()(int row, int pn, int wc, int fq, f32x4 a0, f32x4 a1, f32x4 b0, f32x4 b1, float g) const {
        bf16_t* o = Y + (size_t)row * DM + epi_col(pn, wc, fq);
        store_bf16x8(o, a0 * g, a1 * g); store_bf16x8(o + 16, b0 * g, b1 * g);
    }
};

namespace mg {
constexpr int BM = 256, BK = 64, HALF = 128, HTB = HALF * BK * 2, STAGE_BYTES = 8 * HTB, NXCD = 8, WGM = 8, MAXU = 8;
__device__ __forceinline__ int lds_byte(int r, int c) { const int st = (r >> 4) * 2 + (c >> 5), rr = r & 15, cc = c & 31, ob = rr * 64 + cc * 2; return st * 1024 + (ob ^ (((ob >> 9) & 1) << 5)); }
__device__ __forceinline__ void stage_rc(int b, int& R, int& C) { const int st = b / 1024, sb = b % 1024, swz = sb ^ (((sb >> 9) & 1) << 5); R = (st >> 1) * 16 + swz / 64; C = (st & 1) * 32 + (swz % 64) / 2; }
struct Unit { int pm, pn; };
struct Gemm { const bf16_t* A; const bf16_t* Bt; int M, N, K; const int* rowidx; size_t grp_stride; int grp_tiles, ngrp; };
struct StaticOrder {
    int nM, nN, nwg, G, c;
    __device__ void init(int M, int N, int G_, int c_) { nM = M / BM; nN = N / BM; nwg = nM * nN; G = G_; c = c_; }
    __device__ bool next(int i, Unit& u) const {
        const long L = (long)i * G + c; if (L >= nwg) return false;
        int wgid = (int)L; { const int q = nwg / NXCD, r = nwg % NXCD, xcd = wgid % NXCD, off = wgid / NXCD; wgid = (xcd < r ? xcd * (q + 1) : r * (q + 1) + (xcd - r) * q) + off; }
        const int nig = WGM * nN, gid = wgid / nig, fm = gid * WGM, gsz = (nM - fm) < WGM ? (nM - fm) : WGM;
        u.pm = fm + ((wgid % nig) % gsz); u.pn = (wgid % nig) / gsz; return true;
    }
};
template <class Epi>
__device__ __forceinline__ void gemm_phase(LAS unsigned char* lds, LAS int* idxl, const Gemm g, const StaticOrder& S, const Epi& E) {
    const int tid = opaque_tid(), wid = __builtin_amdgcn_readfirstlane(tid >> 6), lane = tid & 63, wr = wid >> 2, wc = wid & 3, fr = lane & 15, fq = lane >> 4;
    const int K = g.K, nt = K / BK;
    unsigned voffB[2];
#pragma unroll
    for (int i = 0; i < 2; ++i) { int R_, C_; stage_rc(tid * 16 + i * 8192, R_, C_); voffB[i] = (unsigned)(R_ * K + C_) * 2u; }
    const size_t kstep = (size_t)(BK * 2);
    const size_t hstep = (size_t)HALF * K * 2;
    const size_t tstep = 2 * hstep;
    const unsigned ldsw = (unsigned)wid * 1024u;
    const int aoff = lds_byte(wr * 64 + fr, fq * 8), boff = lds_byte(wc * 32 + fr, fq * 8);
    Unit cur, nxt; int ui = 0;
    if (!S.next(0, cur)) return;
#ifndef MG_STAGGER_TICKS
#define MG_STAGGER_TICKS 0
#endif
    if (MG_STAGGER_TICKS && (blockIdx.x & 8)) { const unsigned long long t0 = __builtin_amdgcn_s_memrealtime(); while (__builtin_amdgcn_s_memrealtime() - t0 < MG_STAGGER_TICKS) __builtin_amdgcn_s_sleep(16); }
    if (g.rowidx) {
        for (int i = 0; i < MAXU; ++i) { Unit u; if (!S.next(i, u)) break; if (tid < 256) idxl[i * 256 + tid] = g.rowidx[u.pm * BM + tid]; }
        asm volatile("s_waitcnt vmcnt(0) lgkmcnt(0)" ::: "memory"); __builtin_amdgcn_s_barrier(); asm volatile("" ::: "memory");
    }
#define MG_AOFFS(dst, u_, ui_) do { _Pragma("unroll") for (int i_ = 0; i_ < 2; ++i_) { int R_, C_; stage_rc(tid * 16 + i_ * 8192, R_, C_); _Pragma("unroll") for (int h_ = 0; h_ < 2; ++h_) { \
        const int rr_ = g.rowidx ? idxl[(ui_) * 256 + h_ * HALF + R_] : ((u_).pm * BM + h_ * HALF + R_); dst[h_][i_] = (unsigned)(rr_ * K + C_) * 2u; } } } while (0)
#define MG_BPTR(u_) ((const char*)g.Bt + ((size_t)(((u_).pm / g.grp_tiles) % g.ngrp) * g.grp_stride) * 2 + (size_t)(u_).pn * tstep)
#define PG8_SA(b, h) (((b) * 2 + (h)) * HTB)
#define PG8_SB(b, h) ((4 + (b) * 2 + (h)) * HTB)
#define PG8_STAGE(bufoff, gbase, voff) do { _Pragma("unroll") for (int _i = 0; _i < 2; ++_i) \
        __builtin_amdgcn_global_load_lds((const unsigned*)((const char*)(gbase) + (voff)[_i]), (LAS unsigned*)(lds + (bufoff) + ldsw + _i * 8192), 16, 0, 0); } while (0)
#define PG8_LDA(dst, b, h) do { _Pragma("unroll") for (int m = 0; m < 4; ++m) _Pragma("unroll") for (int k = 0; k < 2; ++k) dst[m][k] = *(const LAS bf16x8*)(lds + PG8_SA(b, h) + aoff + m * 2048 + k * 1024); } while (0)
#define PG8_LDB(dst, b, h) do { _Pragma("unroll") for (int n = 0; n < 2; ++n) _Pragma("unroll") for (int k = 0; k < 2; ++k) dst[n][k] = *(const LAS bf16x8*)(lds + PG8_SB(b, h) + boff + n * 2048 + k * 1024); } while (0)
#define PG8_MMA(ai, bj, At, Bt) do { __builtin_amdgcn_s_setprio(1); _Pragma("unroll") for (int m = 0; m < 4; ++m) _Pragma("unroll") for (int n = 0; n < 2; ++n) _Pragma("unroll") for (int k = 0; k < 2; ++k) \
        acc[ai][bj][m][n] = __builtin_amdgcn_mfma_f32_16x16x32_bf16(Bt[n][k], At[m][k], acc[ai][bj][m][n], 0, 0, 0); __builtin_amdgcn_s_setprio(0); } while (0)
#define PG8_WAIT_V(n) asm volatile("s_waitcnt vmcnt(" #n ")" ::: "memory")
#define PG8_WAIT_L(n) asm volatile("s_waitcnt lgkmcnt(" #n ")" ::: "memory")
#define PG8_BAR __builtin_amdgcn_s_barrier()
#define PG8_SCHED __builtin_amdgcn_sched_barrier(0)
    f32x4 acc[2][2][4][2];
#pragma unroll
    for (int a = 0; a < 2; ++a)
#pragma unroll
        for (int b = 0; b < 2; ++b)
#pragma unroll
            for (int m = 0; m < 4; ++m)
#pragma unroll
                for (int n = 0; n < 2; ++n) acc[a][b][m][n] = (f32x4){0.f, 0.f, 0.f, 0.f};
    bf16x8 At[4][2], B0[2][2], B1[2][2];
    unsigned cAo[2][2], o2[2][2];
    MG_AOFFS(cAo, cur, 0);
    const char* const Abase = (const char*)g.A;
    const char* cB = MG_BPTR(cur);
    PG8_STAGE(PG8_SB(0, 0), cB, voffB); PG8_STAGE(PG8_SB(0, 1), cB + hstep, voffB); PG8_STAGE(PG8_SA(0, 0), Abase, cAo[0]); PG8_STAGE(PG8_SA(0, 1), Abase, cAo[1]);
    if (wr == 1) PG8_BAR;
    PG8_WAIT_V(2); PG8_BAR;
    PG8_STAGE(PG8_SB(1, 0), cB + kstep, voffB); PG8_STAGE(PG8_SA(1, 0), Abase + kstep, cAo[0]); PG8_STAGE(PG8_SB(1, 1), cB + hstep + kstep, voffB);
    PG8_WAIT_V(6); PG8_BAR;
    for (;;) {
        const bool has_next = S.next(ui + 1, nxt);
        const char* nB = has_next ? MG_BPTR(nxt) : cB;
        for (int t = 0; t < nt; t += 2) {
            const bool last = (t == nt - 2);
            const char* a1 = Abase + (size_t)(t + 1) * kstep;
            const char* a2 = last ? Abase : Abase + (size_t)(t + 2) * kstep; const char* b2 = last ? nB : cB + (size_t)(t + 2) * kstep;
            const char* a3 = a2 + kstep; const char* b3 = b2 + kstep;
            if (last && has_next) { MG_AOFFS(o2, nxt, ui + 1); } else {
#pragma unroll
                for (int h = 0; h < 2; ++h)
#pragma unroll
                    for (int i = 0; i < 2; ++i) o2[h][i] = cAo[h][i]; }
            PG8_LDB(B0, 0, 0); PG8_LDB(B1, 0, 1); PG8_SCHED; PG8_LDA(At, 0, 0); PG8_STAGE(PG8_SA(1, 1), a1, cAo[1]);
            PG8_WAIT_V(8); PG8_WAIT_L(0); PG8_BAR; PG8_MMA(0, 0, At, B0); PG8_MMA(0, 1, At, B1); PG8_BAR; PG8_SCHED;
            PG8_LDA(At, 0, 1); PG8_STAGE(PG8_SB(0, 0), b2, voffB); PG8_STAGE(PG8_SB(0, 1), b2 + hstep, voffB); PG8_STAGE(PG8_SA(0, 0), a2, o2[0]);
            PG8_WAIT_V(8); PG8_WAIT_L(0); PG8_BAR; PG8_MMA(1, 0, At, B0); PG8_MMA(1, 1, At, B1); PG8_BAR; PG8_SCHED;
            PG8_LDB(B0, 1, 0); PG8_LDB(B1, 1, 1); PG8_SCHED; PG8_LDA(At, 1, 0); PG8_STAGE(PG8_SA(0, 1), a2, o2[1]);
            PG8_WAIT_V(8); PG8_WAIT_L(0); PG8_BAR; PG8_MMA(0, 0, At, B0); PG8_MMA(0, 1, At, B1); PG8_BAR; PG8_SCHED;
            PG8_LDA(At, 1, 1); PG8_STAGE(PG8_SB(1, 0), b3, voffB); PG8_STAGE(PG8_SB(1, 1), b3 + hstep, voffB); PG8_STAGE(PG8_SA(1, 0), a3, o2[0]);
            PG8_WAIT_V(8); PG8_WAIT_L(0); PG8_BAR; PG8_MMA(1, 0, At, B0); PG8_MMA(1, 1, At, B1); PG8_BAR; PG8_SCHED;
        }
        if (wr == 0) PG8_BAR;
        E(acc, cur, wr, wc, fr, fq);
        if (!has_next) break;
#pragma unroll
        for (int a = 0; a < 2; ++a)
#pragma unroll
            for (int b = 0; b < 2; ++b)
#pragma unroll
                for (int m = 0; m < 4; ++m)
#pragma unroll
                    for (int n = 0; n < 2; ++n) acc[a][b][m][n] = (f32x4){0.f, 0.f, 0.f, 0.f};
        cur = nxt; cB = nB; ++ui;
#pragma unroll
        for (int h = 0; h < 2; ++h)
#pragma unroll
            for (int i = 0; i < 2; ++i) cAo[h][i] = o2[h][i];
        if (wr == 1) PG8_BAR;
    }
    PG8_WAIT_V(0);
    PG8_BAR;
#undef MG_AOFFS
#undef MG_BPTR
#undef PG8_SA
#undef PG8_SB
#undef PG8_STAGE
#undef PG8_LDA
#undef PG8_LDB
#undef PG8_MMA
#undef PG8_WAIT_V
#undef PG8_WAIT_L
#undef PG8_BAR
#undef PG8_SCHED
}
template <class EE> struct EpiAdapt {
    EE e; int row_base;
    __device__ __forceinline__ void operator()(const f32x4 (&acc)[2][2][4][2], const Unit& u, int wr, int wc, int fr, int fq) const {
        float rv[2][4];
#pragma unroll
        for (int ai = 0; ai < 2; ++ai)
#pragma unroll
            for (int m = 0; m < 4; ++m) rv[ai][m] = e.rowval(row_base + u.pm * BM + ai * HALF + wr * 64 + m * 16 + fr);
#pragma unroll
        for (int ai = 0; ai < 2; ++ai)
#pragma unroll
            for (int m = 0; m < 4; ++m) { const int row = row_base + u.pm * BM + ai * HALF + wr * 64 + m * 16 + fr;
                e(row, u.pn, wc, fq, acc[ai][0][m][0], acc[ai][0][m][1], acc[ai][1][m][0], acc[ai][1][m][1], rv[ai][m]);
                if (m & 1) asm volatile("" ::: "memory"); }
    }
};
}

struct AttnState { float m, l; float o[32]; };
__device__ __forceinline__ void attn_init(AttnState& st) { st.m = -INFINITY; st.l = 0.f;
#pragma unroll
    for (int d = 0; d < 32; ++d) st.o[d] = 0.f; }
__device__ __forceinline__ void load_row32(const bf16_t* p, float (&r)[32], float scale) {
#pragma unroll
    for (int i = 0; i < 4; ++i) { const u32x4 w = *(const u32x4*)(p + 8 * i);
        r[8 * i + 0] = bf_lo(w.x) * scale; r[8 * i + 1] = bf_hi(w.x) * scale; r[8 * i + 2] = bf_lo(w.y) * scale; r[8 * i + 3] = bf_hi(w.y) * scale;
        r[8 * i + 4] = bf_lo(w.z) * scale; r[8 * i + 5] = bf_hi(w.z) * scale; r[8 * i + 6] = bf_lo(w.w) * scale; r[8 * i + 7] = bf_hi(w.w) * scale; }
}
__device__ __forceinline__ float dot_row32(const bf16_t* p, const float (&q)[32]) {
    float d0 = 0.f, d1 = 0.f;
#pragma unroll
    for (int i = 0; i < 4; ++i) { const u32x4 w = *(const u32x4*)(p + 8 * i);
        d0 += q[8 * i + 0] * bf_lo(w.x); d1 += q[8 * i + 1] * bf_hi(w.x); d0 += q[8 * i + 2] * bf_lo(w.y); d1 += q[8 * i + 3] * bf_hi(w.y);
        d0 += q[8 * i + 4] * bf_lo(w.z); d1 += q[8 * i + 5] * bf_hi(w.z); d0 += q[8 * i + 6] * bf_lo(w.w); d1 += q[8 * i + 7] * bf_hi(w.w); }
    const float d = d0 + d1;
    return d + __shfl_xor(d, 32);
}
__device__ __forceinline__ void axpy_row32(const bf16_t* p, float a, float (&o)[32]) {
#pragma unroll
    for (int i = 0; i < 4; ++i) { const u32x4 w = *(const u32x4*)(p + 8 * i);
        o[8 * i + 0] += a * bf_lo(w.x); o[8 * i + 1] += a * bf_hi(w.x); o[8 * i + 2] += a * bf_lo(w.y); o[8 * i + 3] += a * bf_hi(w.y);
        o[8 * i + 4] += a * bf_lo(w.z); o[8 * i + 5] += a * bf_hi(w.z); o[8 * i + 6] += a * bf_lo(w.w); o[8 * i + 7] += a * bf_hi(w.w); }
}
template <class ScoreFn>
__device__ __forceinline__ void attn_segment(const float (&q)[32], AttnState& st, const bf16_t* Kb, const bf16_t* Vb, int j0, int j1, ScoreFn sf) {
#pragma unroll 1
    for (int j = j0; j < j1; ++j) {
        const float s0 = sf(j, dot_row32(Kb + (size_t)j * INW, q));
        if (s0 > st.m) { const float corr = __expf(st.m - s0); st.l *= corr;
#pragma unroll
            for (int d = 0; d < 32; ++d) st.o[d] *= corr;
            st.m = s0; }
        const float p0 = (s0 == -INFINITY) ? 0.f : __expf(s0 - st.m);
        st.l += p0;
        axpy_row32(Vb + (size_t)j * INW, p0, st.o);
    }
}
__device__ __forceinline__ void attn_sink(AttnState& st, float sk) {
    if (sk > st.m) { const float corr = __expf(st.m - sk); st.l *= corr;
#pragma unroll
        for (int d = 0; d < 32; ++d) st.o[d] *= corr;
        st.m = sk; }
    st.l += __expf(sk - st.m);
}
__device__ __forceinline__ void attn_store(const AttnState& st, bf16_t* o) {
    const float inv = 1.f / st.l;
#pragma unroll
    for (int i = 0; i < 4; ++i) { u32x4 w; w.x = pk2(st.o[8 * i] * inv, st.o[8 * i + 1] * inv); w.y = pk2(st.o[8 * i + 2] * inv, st.o[8 * i + 3] * inv);
        w.z = pk2(st.o[8 * i + 4] * inv, st.o[8 * i + 5] * inv); w.w = pk2(st.o[8 * i + 6] * inv, st.o[8 * i + 7] * inv); *(u32x4*)(o + 8 * i) = w; }
}

__device__ __forceinline__ void phase_mixers(const Params& p, int l, bool with_ctx, int bid, int nb) {
    bid = opaque_s(bid); const int tid = opaque_tid(); const int lane = tid & 63, gw = bid * NWAVES + (tid >> 6), NGW = nb * NWAVES;
    const int ql = lane & 31, hf = lane >> 5;
    const bf16_t* PB = (const bf16_t*)(p.ws + WS_PB); bf16_t* OB = (bf16_t*)(p.ws + WS_OB);
    const float* sink = p.attn_sink + l * 6; const float* rpb = p.na_rpb + (size_t)l * 6 * 15 * 31;
#if !FAST_ATTN
#pragma unroll 1
    for (int it = gw; it < NB * 6 * 256; it += NGW) {
        const int chunk = it & 255, h = (it >> 8) % 6, b = it / (6 * 256), kvh = h / 3;
        const int t = chunk * 32 + ql; const size_t rowb = (size_t)b * SEQ;
        float q[32]; load_row32(PB + (rowb + t) * INW + C_QA + h * 64 + 32 * hf, q, 0.125f);
        AttnState st; attn_init(st);
        const int jlo = max(0, chunk * 32 - 128), jhi = min(SEQ, chunk * 32 + 32 + 128);
        attn_segment(q, st, PB + rowb * INW + C_KA + kvh * 64 + 32 * hf, PB + rowb * INW + C_VA + kvh * 64 + 32 * hf, jlo, jhi,
                     [&](int j, float d) { const int dt = t - j; return (dt <= 128 && dt >= -128) ? d : -INFINITY; });
        const size_t crow = (size_t)NLAT + (size_t)b * CTXL;
        attn_segment(q, st, PB + crow * INW + C_KA + kvh * 64 + 32 * hf, PB + crow * INW + C_VA + kvh * 64 + 32 * hf, 0, CTXL, [&](int, float d) { return d; });
        attn_sink(st, sink[h]);
        attn_store(st, OB + (rowb + t) * DM + h * 64 + 32 * hf);
    }
#pragma unroll 1
    for (int it = gw; it < NB * 6 * 256; it += NGW) {
        const int r = (it & 255) >> 1, ch = it & 1, h = (it >> 8) % 6, b = it / (6 * 256);
        const int cq = ch * 32 + ql; const size_t rowb = (size_t)b * SEQ; const int t = r * 64 + cq;
        float q[32]; load_row32(PB + (rowb + t) * INW + C_QN + h * 64 + 32 * hf, q, 0.125f);
        AttnState st; attn_init(st);
        const int rs = min(max(r - 4, 0), 128 - 8), cs = min(max(cq - 8, 0), 64 - 16);
        const float* bias = rpb + (size_t)h * 15 * 31;
        attn_segment(q, st, PB + (rowb + (size_t)rs * 64) * INW + C_KN + h * 64 + 32 * hf, PB + (rowb + (size_t)rs * 64) * INW + C_VN + h * 64 + 32 * hf, 0, 512,
                     [&](int j, float d) { const int ka = rs + (j >> 6), ck = j & 63; const bool ok = (ck >= cs) && (ck < cs + 16);
                                           const int ro = ka - r + 7, co = min(max(ck - cq, -15), 15) + 15; return ok ? d + bias[ro * 31 + co] : -INFINITY; });
        const size_t crow = (size_t)NLAT + (size_t)b * CTXL;
        attn_segment(q, st, PB + crow * INW + C_KN + h * 64 + 32 * hf, PB + crow * INW + C_VN + h * 64 + 32 * hf, 0, CTXL, [&](int, float d) { return d; });
        attn_store(st, OB + (rowb + t) * DM + 640 + h * 64 + 32 * hf);
    }
#endif
    {
        const float* cw = p.conv_w + (size_t)l * 3 * 256;
        const int nrows = with_ctx ? NROWS : NLAT;
        for (long e = (long)bid * NTHREADS + tid; e < (long)nrows * 32; e += (long)nb * NTHREADS) {
            const int row = (int)(e >> 5), ch = (int)(e & 31) * 8;
            const int tpos = row < NLAT ? (row & (SEQ - 1)) : ((row - NLAT) & (CTXL - 1)); const int tlen = row < NLAT ? SEQ : CTXL;
            const bf16_t* pr = PB + (size_t)row * INW;
            float u[3][8];
#pragma unroll
            for (int dlt = -1; dlt <= 1; ++dlt) {
                const bool ok = (tpos + dlt >= 0) && (tpos + dlt < tlen);
                if (ok) { const u32x4 a = *(const u32x4*)(pr + (long)dlt * INW + C_BX + ch), c = *(const u32x4*)(pr + (long)dlt * INW + C_BC + ch);
                    u[dlt + 1][0] = bf_lo(a.x) * bf_lo(c.x); u[dlt + 1][1] = bf_hi(a.x) * bf_hi(c.x); u[dlt + 1][2] = bf_lo(a.y) * bf_lo(c.y); u[dlt + 1][3] = bf_hi(a.y) * bf_hi(c.y);
                    u[dlt + 1][4] = bf_lo(a.z) * bf_lo(c.z); u[dlt + 1][5] = bf_hi(a.z) * bf_hi(c.z); u[dlt + 1][6] = bf_lo(a.w) * bf_lo(c.w); u[dlt + 1][7] = bf_hi(a.w) * bf_hi(c.w); }
                else {
#pragma unroll
                    for (int i = 0; i < 8; ++i) u[dlt + 1][i] = 0.f; }
            }
            const u32x4 gb = *(const u32x4*)(pr + C_BB + ch);
            const float g[8] = {bf_lo(gb.x), bf_hi(gb.x), bf_lo(gb.y), bf_hi(gb.y), bf_lo(gb.z), bf_hi(gb.z), bf_lo(gb.w), bf_hi(gb.w)};
            float y[8];
#pragma unroll
            for (int i = 0; i < 8; ++i) y[i] = g[i] * (u[0][i] * cw[ch + i] + u[1][i] * cw[256 + ch + i] + u[2][i] * cw[512 + ch + i]);
            u32x4 o; o.x = pk2(y[0], y[1]); o.y = pk2(y[2], y[3]); o.z = pk2(y[4], y[5]); o.w = pk2(y[6], y[7]);
            *(u32x4*)(OB + (size_t)row * DM + 384 + ch) = o;
        }
    }
#if !FAST_ATTN
    if (with_ctx) {
#pragma unroll 1
        for (int it = gw; it < 2 * NB * 6 * 8; it += NGW) {
            const int kind = it / (NB * 6 * 8), r = it % (NB * 6 * 8), chunk = r & 7, h = (r >> 3) % 6, b = r / 48;
            const size_t crow = (size_t)NLAT + (size_t)b * CTXL; const int tq = chunk * 32 + ql;
            const int qc = (kind == 0 ? C_QA + h * 64 : C_QN + h * 64) + 32 * hf, kc = (kind == 0 ? C_KA + (h / 3) * 64 : C_KN + h * 64) + 32 * hf, vc = (kind == 0 ? C_VA + (h / 3) * 64 : C_VN + h * 64) + 32 * hf;
            float q[32]; load_row32(PB + (crow + tq) * INW + qc, q, 0.125f);
            AttnState st; attn_init(st);
            attn_segment(q, st, PB + crow * INW + kc, PB + crow * INW + vc, 0, CTXL, [&](int, float d) { return d; });
            if (kind == 0) attn_sink(st, sink[h]);
            attn_store(st, OB + (crow + tq) * DM + (kind == 0 ? 0 : 640) + h * 64 + 32 * hf);
        }
    }
#endif
}

namespace fa {
typedef short v4i16_t __attribute__((ext_vector_type(4)));
typedef float f32x2_t __attribute__((ext_vector_type(2))); typedef __bf16 bf16x2_t __attribute__((ext_vector_type(2)));
__device__ __forceinline__ unsigned cvtpk(float lo, float hi) { f32x2_t v = {lo, hi}; bf16x2_t b = __builtin_convertvector(v, bf16x2_t); return __builtin_bit_cast(unsigned, b); }
constexpr float LOG2E = 1.4426950408889634f, SC = 0.125f * LOG2E;
constexpr int CHUNK_BYTES = 32768;
constexpr int BIAS_OFF = 3 * CHUNK_BYTES;
constexpr float THR = 8.f;
__device__ __forceinline__ int na_rs(int r) { return min(max(r - 4, 0), 128 - 8); }
__device__ __forceinline__ void glds16(const void* gsrc, unsigned lds_dst) { unsigned keep;
    asm volatile("s_mov_b32 %0, m0\n\ts_mov_b32 m0, %2\n\ts_nop 0\n\tglobal_load_lds_dwordx4 %1, off\n\ts_mov_b32 m0, %0" : "=&s"(keep) : "v"(gsrc), "s"(lds_dst) : "memory"); }
#define FA_WAIT_BAR(N) asm volatile("s_waitcnt vmcnt(" #N ") lgkmcnt(0)\n\ts_barrier" ::: "memory")
__device__ __forceinline__ float max3f(float a, float b, float c) { float r; asm("v_max3_f32 %0, %1, %2, %3" : "=v"(r) : "v"(a), "v"(b), "v"(c)); return r; }
__device__ __forceinline__ float max8f(const f32x4& a, const f32x4& b) { return max3f(max3f(max3f(a[0], a[1], a[2]), a[3], b[0]), max3f(b[1], b[2], b[3]), -INFINITY); }
typedef float f32x16 __attribute__((ext_vector_type(16)));
__device__ __forceinline__ float max16f(const f32x16& a) {
    float x = max3f(a[0], a[1], a[2]); x = max3f(x, a[3], a[4]); x = max3f(x, a[5], a[6]); x = max3f(x, a[7], a[8]); x = max3f(x, a[9], a[10]); x = max3f(x, a[11], a[12]); x = max3f(x, a[13], a[14]);
    return fmaxf(x, a[15]);
}
typedef float f32x2v __attribute__((ext_vector_type(2)));
template <int MODE>
__device__ __forceinline__ void unit32(f32x16 (&o)[2], float& m, float& ls, const bf16x8 (&q)[4], const LAS unsigned char* Kt0, const LAS unsigned char* Kt1, const LAS unsigned char* Vt0, const LAS unsigned char* Vt1,
                                       const int (&kb)[4], const int (&vb)[2], bool rel0, bool rel1, bool mk0, bool mk1, int tb0, int tb1, const f32x16& fmask, const LAS float* bp0, const LAS float* bp1) {
    f32x16 s[2]; float tm = -INFINITY;
#pragma unroll
    for (int t = 0; t < 2; ++t) {
        if (!(t == 0 ? rel0 : rel1)) continue;
        const LAS unsigned char* Kt = t == 0 ? Kt0 : Kt1;
        bf16x8 kf[4];
#pragma unroll
        for (int ks = 0; ks < 4; ++ks) kf[ks] = *(const LAS bf16x8*)(Kt + kb[ks]);
        f32x16 acc = __builtin_amdgcn_mfma_f32_32x32x16_bf16(kf[0], q[0], (f32x16){0.f, 0.f, 0.f, 0.f, 0.f, 0.f, 0.f, 0.f, 0.f, 0.f, 0.f, 0.f, 0.f, 0.f, 0.f, 0.f}, 0, 0, 0);
#pragma unroll
        for (int ks = 1; ks < 4; ++ks) acc = __builtin_amdgcn_mfma_f32_32x32x16_bf16(kf[ks], q[ks], acc, 0, 0, 0);
        if (MODE == 2) {
            const LAS float* bp = t == 0 ? bp0 : bp1;
#pragma unroll
            for (int r = 0; r < 16; ++r) acc[r] = __builtin_fmaf(acc[r], SC, bp[(r & 3) + 8 * (r >> 2)]) + fmask[r];
        } else {
            if (MODE == 1 && (t == 0 ? mk0 : mk1)) { const int tb = t == 0 ? tb0 : tb1;
#pragma unroll
                for (int r = 0; r < 16; ++r) acc[r] = ((unsigned)(tb - ((r & 3) + 8 * (r >> 2))) <= 256u) ? acc[r] : -INFINITY;
            } else asm volatile("s_nop 15\n\ts_nop 7" : "+v"(acc));
        }
        s[t] = acc;
        tm = fmaxf(tm, max16f(acc));
    }
    if (MODE != 2) tm *= SC;
    if (__any(tm > m + THR)) {
        const float mn = fmaxf(m, xor32_max(tm)), al = __builtin_amdgcn_exp2f(m - mn); m = mn; ls *= al;
#pragma unroll
        for (int d = 0; d < 2; ++d) o[d] = o[d] * al;
    }
    const float nm = -m; f32x2v ps2 = {0.f, 0.f};
#pragma unroll
    for (int t = 0; t < 2; ++t) {
        if (!(t == 0 ? rel0 : rel1)) continue;
        const LAS unsigned char* Vt = t == 0 ? Vt0 : Vt1;
        f32x16 pv = MODE == 2 ? s[t] + nm : s[t] * SC + nm;
#pragma unroll
        for (int r = 0; r < 16; ++r) pv[r] = __builtin_amdgcn_exp2f(pv[r]);
#pragma unroll
        for (int r = 0; r < 16; r += 2) ps2 += (f32x2v){pv[r], pv[r + 1]};
#pragma unroll
        for (int st = 0; st < 2; ++st) {
            u32x4 pw; pw.x = cvtpk(pv[8 * st + 0], pv[8 * st + 1]); pw.y = cvtpk(pv[8 * st + 2], pv[8 * st + 3]); pw.z = cvtpk(pv[8 * st + 4], pv[8 * st + 5]); pw.w = cvtpk(pv[8 * st + 6], pv[8 * st + 7]);
            const bf16x8 pb = __builtin_bit_cast(bf16x8, pw);
#pragma unroll
            for (int db = 0; db < 2; ++db) {
                const v4i16_t t0 = __builtin_amdgcn_ds_read_tr16_b64_v4i16((LAS v4i16_t*)(Vt + st * 2048 + vb[db])), t1 = __builtin_amdgcn_ds_read_tr16_b64_v4i16((LAS v4i16_t*)(Vt + st * 2048 + 1024 + vb[db]));
                const bf16x8 vf = (bf16x8){t0[0], t0[1], t0[2], t0[3], t1[0], t1[1], t1[2], t1[3]};
                o[db] = __builtin_amdgcn_mfma_f32_32x32x16_bf16(vf, pb, o[db], 0, 0, 0);
            }
        }
    }
    ls += ps2[0] + ps2[1];
}
template <int KIND>
__device__ __forceinline__ void attn_item(const Params& p, int l, int item, LAS unsigned char* lds, int tid) {
    constexpr bool ISA = (KIND == 0 || KIND == 2);
    constexpr int NG = ISA ? 2 : 1;
    const int lane = tid & 63, w = __builtin_amdgcn_readfirstlane(tid >> 6), ql = lane & 31, hh = lane >> 5;
    const bf16_t* PB = (const bf16_t*)(p.ws + WS_PB); bf16_t* OB = (bf16_t*)(p.ws + WS_OB);
    int b, hx, blk;
    if (KIND == 0) { b = item >> 7; hx = (item >> 6) & 1; blk = item & 63; }
    else if (KIND == 1) { b = item / 192; hx = (item >> 5) % 6; blk = item & 31; }
    else if (KIND == 2) { b = item >> 2; hx = (item >> 1) & 1; blk = item & 1; }
    else { b = item / 6; hx = item % 6; blk = 0; }
    const size_t rowb = (size_t)b * SEQ, ctxb = (size_t)NLAT + (size_t)b * CTXL;
    const int kcol = ISA ? C_KA + hx * 64 : C_KN + hx * 64, vcol = ISA ? C_VA + hx * 64 : C_VN + hx * 64;
    int nwin = 0; size_t winrow0 = 0; int winpos0 = 0, krs0 = 0;
    if (KIND == 0) { const int first = blk == 0 ? 1 : 0, last = blk == 63 ? 2 : 3; nwin = last - first; winpos0 = 128 * (blk - 1 + first); winrow0 = rowb + winpos0; }
    if (KIND == 1) { krs0 = na_rs(4 * blk); nwin = (na_rs(4 * blk + 3) + 8 - krs0 + 1) >> 1; winrow0 = rowb + (size_t)krs0 * 64; }
    const int nch = nwin + 2;
    const bool active = true;
    int gh[NG], gp0[NG];
#pragma unroll
    for (int gi = 0; gi < NG; ++gi) {
        const int G = ISA ? (w < 4 ? 2 * w + gi : 8 + (w - 4)) : w;
        if (ISA) { gh[gi] = 3 * hx + (G >> 2); gp0[gi] = 128 * blk + 32 * (G & 3); }
        else if (KIND == 1) { gh[gi] = hx; gp0[gi] = 16 * (G & 3); }
        else { gh[gi] = hx; gp0[gi] = 32 * G; }
    }
    const int nrow0 = 4 * blk + 2 * (w >> 2);
    const int nrq = nrow0 + (ql >> 4), ncq = gp0[0] + (ql & 15);
#define FA_QROW(gi, ql_) (KIND == 0 ? rowb + gp0[gi] + (ql_) : KIND == 2 ? ctxb + gp0[gi] + (ql_) : KIND == 1 ? rowb + (size_t)(nrow0 + ((ql_) >> 4)) * 64 + gp0[gi] + ((ql_) & 15) : ctxb + gp0[gi] + (ql_))
    const int skey = 8 * w + (lane >> 3), spc = lane & 7;
    const int ksrc = skey * INW + kcol + ((spc ^ ((skey >> 1) & 7)) << 3);
    const int vsrc = skey * INW + vcol + (((((spc >> 1) ^ (skey & 2)) << 1) | (spc & 1)) << 3);
    const unsigned lds0 = (unsigned)(uintptr_t)lds;
    const int noff = KIND == 1 ? ((gp0[0] >> 4) == 0 ? 0 : ((gp0[0] >> 4) == 1 ? 8 : ((gp0[0] >> 4) == 2 ? 24 : 32))) : 0;
    int kb[4], kbw[4], vb[2];
#pragma unroll
    for (int ks = 0; ks < 4; ++ks) { kb[ks] = ql * 128 + (((2 * ks + hh) ^ ((ql >> 1) & 7)) << 4); kbw[ks] = ql * 128 + (((2 * ks + hh) ^ (((noff + ql) >> 1) & 7)) << 4); }
    { const int vk = 4 * hh + ((lane & 15) >> 2);
#pragma unroll
      for (int db = 0; db < 2; ++db) vb[db] = vk * 128 + (((2 * db + ((lane >> 4) & 1)) ^ (vk & 2)) << 5) + ((lane & 3) << 3); }
#define FA_DMA(ci) do { const size_t r0_ = (ci) < nwin ? winrow0 + (size_t)(ci) * 128 : ctxb + (size_t)((ci) - nwin) * 128; const bf16_t* s_ = PB + r0_ * INW; \
        const unsigned d_ = (unsigned)__builtin_amdgcn_readfirstlane((int)(lds0 + ((ci) % 3) * CHUNK_BYTES + w * 1024)); \
        glds16(s_ + ksrc, d_); glds16(s_ + 64 * INW + ksrc, d_ + 8192u); glds16(s_ + vsrc, d_ + 16384u); glds16(s_ + 64 * INW + vsrc, d_ + 24576u); } while (0)
    FA_DMA(0); FA_DMA(1);
    bf16x8 qf[NG][4];
#pragma unroll
    for (int gi = 0; gi < NG; ++gi)
#pragma unroll
        for (int ks = 0; ks < 4; ++ks) qf[gi][ks] = *(const bf16x8*)(PB + FA_QROW(gi, ql) * INW + (ISA ? C_QA : C_QN) + gh[gi] * 64 + 16 * ks + 8 * hh);
    f32x16 o[NG][2]; float m[NG], ls[NG];
#pragma unroll
    for (int gi = 0; gi < NG; ++gi) {
#pragma unroll
        for (int d = 0; d < 2; ++d)
#pragma unroll
            for (int r = 0; r < 16; ++r) o[gi][d][r] = 0.f;
        if (ISA) { m[gi] = p.attn_sink[l * 6 + gh[gi]] * LOG2E; ls[gi] = hh == 0 ? 1.f : 0.f; } else { m[gi] = -1e30f; ls[gi] = 0.f; }
    }
    f32x16 fmask;
#pragma unroll
    for (int r = 0; r < 16; ++r) fmask[r] = 0.f;
    if (KIND == 1) { const int cs = min(max(ncq - 8, 0), 48);
#pragma unroll
        for (int r = 0; r < 16; ++r) { const int ck = noff + (r & 3) + 8 * (r >> 2) + 4 * hh; fmask[r] = ((ck >= cs) && (ck < cs + 16)) ? 0.f : -INFINITY; } }
    const int nqrs = na_rs(nrq);
    LAS float* biasL = (LAS float*)(lds + BIAS_OFF);
    if (KIND == 1) { const float* rp = p.na_rpb + ((size_t)l * 6 + hx) * 15 * 31;
        for (int i = tid; i < 16 * 128; i += NTHREADS) { const int x = (i & 127) - 64; biasL[i] = (i >> 7) == 15 ? -INFINITY : ((x >= -15 && x <= 15) ? rp[(i >> 7) * 31 + x + 15] * LOG2E : 0.f); } }
    FA_WAIT_BAR(4);
#pragma unroll
    for (int gi = 0; gi < NG; ++gi) { asm volatile("" : "+v"(qf[gi][0]), "+v"(qf[gi][1]), "+v"(qf[gi][2]), "+v"(qf[gi][3])); }
#pragma unroll 1
    for (int ci = 0; ci < nch; ++ci) {
        if (ci + 2 < nch) FA_DMA(ci + 2);
        const LAS unsigned char* Kb = lds + (ci % 3) * CHUNK_BYTES; const LAS unsigned char* Vb = Kb + 16384;
        const bool iswin = ci < nwin;
        if (active) {
            if (KIND == 1 && iswin) {
                const int kr0 = krs0 + 2 * ci, rsA = na_rs(nrow0), rsB = na_rs(nrow0 + 1);
                const bool rel0 = (kr0 >= rsA) && (kr0 < rsB + 8), rel1 = (kr0 + 1 >= rsA) && (kr0 + 1 < rsB + 8);
                if (rel0 || rel1) {
                    const bool rowok0 = (kr0 >= nqrs) && (kr0 < nqrs + 8), rowok1 = (kr0 + 1 >= nqrs) && (kr0 + 1 < nqrs + 8);
                    const int bcol = 64 + noff + 4 * hh - ncq;
                    const LAS float* bp0 = biasL + (rowok0 ? kr0 - nrq + 7 : 15) * 128 + bcol; const LAS float* bp1 = biasL + (rowok1 ? kr0 + 1 - nrq + 7 : 15) * 128 + bcol;
                    unit32<2>(o[0], m[0], ls[0], qf[0], Kb + noff * 128, Kb + (64 + noff) * 128, Vb + noff * 128, Vb + (64 + noff) * 128, kbw, vb, rel0, rel1, false, false, 0, 0, fmask, bp0, bp1);
                }
            } else {
#pragma unroll 1
                for (int u = 0; u < 2; ++u) {
                    const LAS unsigned char* Kt = Kb + (64 * u) * 128; const LAS unsigned char* Vt = Vb + (64 * u) * 128;
#pragma unroll
                    for (int gi = 0; gi < NG; ++gi) {
                        if (ISA && gi == 1 && w >= 4) continue;
                        if (KIND == 0) {
                            bool rel[2] = {true, true}, msk[2] = {false, false};
                            if (iswin) {
#pragma unroll
                                for (int t = 0; t < 2; ++t) { const int j0 = winpos0 + 128 * ci + 64 * u + 32 * t, p0 = gp0[gi];
                                    rel[t] = (j0 + 31 >= p0 - 128) && (j0 <= p0 + 31 + 128); msk[t] = !((j0 >= p0 + 31 - 128) && (j0 + 31 <= p0 + 128)); } }
                            if (!(rel[0] || rel[1])) continue;
                            const int tb0 = gp0[gi] + ql - (winpos0 + 128 * ci + 64 * u) - 4 * hh + 128;
                            unit32<1>(o[gi], m[gi], ls[gi], qf[gi], Kt, Kt + 4096, Vt, Vt + 4096, kb, vb, rel[0], rel[1], msk[0], msk[1], tb0, tb0 - 32, fmask, nullptr, nullptr);
                        } else unit32<0>(o[gi], m[gi], ls[gi], qf[gi], Kt, Kt + 4096, Vt, Vt + 4096, kb, vb, true, true, false, false, 0, 0, fmask, nullptr, nullptr);
                    }
                }
            }
        }
        if (ci + 2 < nch) FA_WAIT_BAR(4); else FA_WAIT_BAR(0);
    }
#undef FA_DMA
    if (active) {
        int ql2 = lane & 31; asm volatile("" : "+v"(ql2));
#pragma unroll
        for (int gi = 0; gi < NG; ++gi) {
            if (ISA && gi == 1 && w >= 4) continue;
            const float lt = xor32_sum(ls[gi]);
            const float inv = 1.f / lt;
            bf16_t* op = OB + FA_QROW(gi, ql2) * DM + (ISA ? 0 : 640) + gh[gi] * 64 + 4 * hh;
#pragma unroll
            for (int db = 0; db < 2; ++db)
#pragma unroll
                for (int i = 0; i < 4; ++i) { u32x2 ov; ov.x = cvtpk(o[gi][db][4 * i] * inv, o[gi][db][4 * i + 1] * inv); ov.y = cvtpk(o[gi][db][4 * i + 2] * inv, o[gi][db][4 * i + 3] * inv); *(u32x2*)(op + 32 * db + 8 * i) = ov; }
        }
    }
#undef FA_QROW
}
__device__ __forceinline__ void phase_attn(const Params& p, int l, bool with_ctx, LAS unsigned char* lds, int bid, int nb) {
    bid = opaque_s(bid);
    const int n0 = NB * 2 * 64, n1 = NB * 6 * 32, n2 = with_ctx ? NB * 2 * 2 : 0, n3 = with_ctx ? NB * 6 : 0;
#pragma unroll 1
    for (int it = bid; it < n0 + n1 + n2 + n3; it += nb) {
        const int tid = opaque_tid();
#ifndef KMASK
#define KMASK 15
#endif
#ifndef ATT_DUP
#define ATT_DUP 0
#endif
        if (it < n0) { if (KMASK & 1) attn_item<0>(p, l, it, lds, tid); if (ATT_DUP & 1) attn_item<0>(p, l, it, lds, tid); }
        else if (it < n0 + n1) { if (KMASK & 2) attn_item<1>(p, l, it - n0, lds, tid); if (ATT_DUP & 2) attn_item<1>(p, l, it - n0, lds, tid); }
        else if (it < n0 + n1 + n2) { if (KMASK & 4) attn_item<2>(p, l, it - n0 - n1, lds, tid); }
        else { if (KMASK & 8) attn_item<3>(p, l, it - n0 - n1 - n2, lds, tid); }
    }
}
}

__device__ __forceinline__ float reduce16(const float (&t)[16], int lane) {
    float u[8], w4[4], x2[2];
#pragma unroll
    for (int e = 0; e < 8; ++e) { float a = t[e], b = t[e + 8]; asm volatile("s_nop 1\n\tv_permlane32_swap_b32 %0, %1" : "+v"(a), "+v"(b)); u[e] = a + b; }
#pragma unroll
    for (int e = 0; e < 4; ++e) { float a = u[e], b = u[e + 4]; asm volatile("s_nop 1\n\tv_permlane16_swap_b32 %0, %1" : "+v"(a), "+v"(b)); w4[e] = a + b; }
    const bool b3 = (lane & 8) != 0, b2 = (lane & 4) != 0;
#pragma unroll
    for (int e = 0; e < 2; ++e) { const float keep = b3 ? w4[e + 2] : w4[e], send = b3 ? w4[e] : w4[e + 2]; x2[e] = keep + dppf<0x128>(send); }
    const float keep = b2 ? x2[1] : x2[0], send = b2 ? x2[0] : x2[1];
    float y = keep + dppf<0x141>(send);
    y += dppf<0xB1>(y); y += dppf<0x4E>(y);
    return y;
}
__device__ __forceinline__ float wave_max(float v) {
    v = fmaxf(v, dppf<0xB1>(v)); v = fmaxf(v, dppf<0x4E>(v)); v = fmaxf(v, dppf<0x141>(v)); v = fmaxf(v, dppf<0x140>(v));
    return xor32_max(xor16_max(v));
}
__device__ __forceinline__ void phase_ln_router(const Params& p, int l, bool with_ctx, LAS unsigned char* lds, int bid, int nb) {
    bid = opaque_s(bid); const int tid = opaque_tid(), lane = tid & 63, gw = bid * NWAVES + (tid >> 6), NGW = nb * NWAVES;
    LAS float* wr = (LAS float*)lds;
    const float* wrg = p.w_router + (size_t)l * DM * NE;
    for (int i = tid; i < DM * NE; i += NTHREADS) { const int c = i >> 4, e = i & 15; wr[e * DM + c] = wrg[i]; }
    LAS float* lg = wr + NE * DM; LAS float* lb = lg + DM; LAS float* lsh = lb + DM; LAS float* lsc = lsh + 5 * DM;
    lds_fill(lg, p.ln1_g + l * DM, DM, tid); lds_fill(lb, p.ln1_b + l * DM, DM, tid);
    for (int r = 0; r < 5; ++r) { lds_fill(lsh + r * DM, mod_ptr(p, l, r) + 3 * DM, DM, tid); lds_fill(lsc + r * DM, mod_ptr(p, l, r) + 4 * DM, DM, tid); }
    __syncthreads();
    const bf16_t* XB = (const bf16_t*)(p.ws + WS_XB); bf16_t* HB = (bf16_t*)(p.ws + WS_HB); float* AFF = (float*)(p.ws + WS_AFF);
    const float* g = p.ln1_g + l * DM; const float* bb = p.ln1_b + l * DM;
    const int nrows = with_ctx ? NROWS : NLAT;
    int myexp; { float idx[16];
#pragma unroll
        for (int e = 0; e < 16; ++e) idx[e] = (float)e;
        myexp = (int)(reduce16(idx, lane) * (1.f / 64.f) + 0.5f); }
    f32x4 v[4], vn[4];
    if (gw < nrows) row_load_bf16(XB + (size_t)gw * DM, lane, v);
#pragma unroll 1
    for (int row = gw; row < nrows; row += NGW) {
        const int rn = row + NGW;
        if (rn < nrows) row_load_bf16(XB + (size_t)rn * DM, lane, vn);
        row_normalize(v); row_affine_l(v, lg, lb, lane);
        row_normalize(v);
        { const int mr = row_modrow(row); row_modulate_l(v, lsh + mr * DM, lsc + mr * DM, lane); }
        row_store_bf16(HB + (size_t)row * DM, lane, v);
        float t[16];
#pragma unroll
        for (int e = 0; e < 16; ++e) { float s = 0.f;
#pragma unroll
            for (int j = 0; j < 4; ++j) { const f32x4 wv = *(const LAS f32x4*)(wr + e * DM + 256 * j + 4 * lane); s += (v[j][0] * wv[0] + v[j][1] * wv[1]) + (v[j][2] * wv[2] + v[j][3] * wv[3]); }
            t[e] = s;
            if ((e & 3) == 3) asm volatile("" ::: "memory"); }
        const float lg = reduce16(t, lane);
        const float mx = wave_max(lg), ex = expf(lg - mx), sum = wave_sum(ex) * 0.25f;
        if ((lane & 3) == 0) AFF[(size_t)myexp * NROWS + row] = ex / sum;
#pragma unroll
        for (int j = 0; j < 4; ++j) v[j] = vn[j];
    }
}

__device__ __forceinline__ void topk_item(const float* aff  , int n, int k, int row0  , int e, int slot0,
                                          int* TOK, float* GATE, int* INV, LAS unsigned char* lds) {
    const int tid = opaque_tid(), lane = tid & 63, w = tid >> 6;
    LAS unsigned* keys = (LAS unsigned*)lds;
    LAS unsigned* hist = keys + 8192;
    LAS unsigned* misc = hist + 256;
    for (int i = tid; i < n; i += NTHREADS) keys[i] = __builtin_bit_cast(unsigned, aff[i]);
    if (tid == 0) { misc[0] = 0u; misc[1] = (unsigned)k; }
    __syncthreads();
    unsigned maskv = 0u;
    for (int pass = 0; pass < 4; ++pass) {
        const int shift = 24 - 8 * pass;
        if (tid < 256) hist[tid] = 0u;
        __syncthreads();
        const unsigned prefix = misc[0];
        for (int i = tid; i < n; i += NTHREADS) { const unsigned kv = keys[i]; if ((kv & maskv) == prefix) atomicAdd((unsigned*)&hist[(kv >> shift) & 255u], 1u); }
        __syncthreads();
        if (w == 0) {
            const unsigned rem = misc[1];
            const unsigned h0 = hist[4 * lane], h1 = hist[4 * lane + 1], h2 = hist[4 * lane + 2], h3 = hist[4 * lane + 3], s4 = h0 + h1 + h2 + h3;
            unsigned S = s4;
#pragma unroll
            for (int o = 1; o < 64; o <<= 1) { const unsigned y = __shfl_down(S, o); if (lane + o < 64) S += y; }
            const unsigned above = S - s4;
            if (above < rem && rem <= S) { unsigned cum = above; int bin;
                if (cum + h3 >= rem) bin = 3; else { cum += h3; if (cum + h2 >= rem) bin = 2; else { cum += h2; if (cum + h1 >= rem) bin = 1; else { cum += h1; bin = 0; } } }
                misc[0] = prefix | ((unsigned)(4 * lane + bin) << shift); misc[1] = rem - cum; }
        }
        __syncthreads();
        maskv |= 255u << shift;
    }
    const unsigned T = misc[0], need_eq = misc[1];
    __syncthreads();
    const int per = n >= NTHREADS ? n / NTHREADS : 1; const int t0 = tid * per; const bool act = t0 < n;
    unsigned ce = 0u;
    if (act) for (int i = 0; i < per; ++i) ce += (keys[t0 + i] == T) ? 1u : 0u;
    unsigned inc = ce;
#pragma unroll
    for (int o = 1; o < 64; o <<= 1) { const unsigned y = __shfl_up(inc, o); if (lane >= o) inc += y; }
    if (lane == 63) misc[16 + w] = inc;
    __syncthreads();
    unsigned base = 0u;
    for (int ww = 0; ww < w; ++ww) base += misc[16 + ww];
    unsigned eqrank = base + inc - ce;
    __syncthreads();
    unsigned cs = 0u;
    if (act) { unsigned er = eqrank; for (int i = 0; i < per; ++i) { const unsigned kv = keys[t0 + i]; if (kv > T) cs++; else if (kv == T) { if (er < need_eq) cs++; er++; } } }
    inc = cs;
#pragma unroll
    for (int o = 1; o < 64; o <<= 1) { const unsigned y = __shfl_up(inc, o); if (lane >= o) inc += y; }
    if (lane == 63) misc[16 + w] = inc;
    __syncthreads();
    base = 0u;
    for (int ww = 0; ww < w; ++ww) base += misc[16 + ww];
    unsigned pos = base + inc - cs;
    if (act) { unsigned er = eqrank; for (int i = 0; i < per; ++i) { const unsigned kv = keys[t0 + i]; bool sel = false;
            if (kv > T) sel = true; else if (kv == T) { sel = er < need_eq; er++; }
            const int row = row0 + t0 + i;
            if (sel) { const int slot = slot0 + (int)pos; TOK[slot] = row; GATE[slot] = __builtin_bit_cast(float, kv); INV[(size_t)e * NROWS + row] = slot; pos++; }
            else INV[(size_t)e * NROWS + row] = -1; } }
    __syncthreads();
}
__device__ __forceinline__ void phase_topk(const Params& p, bool with_ctx, LAS unsigned char* lds, int bid, int nb) {
    const float* AFF = (const float*)(p.ws + WS_AFF); int* TOK = (int*)(p.ws + WS_TOK); float* GATE = (float*)(p.ws + WS_GATE); int* INV = (int*)(p.ws + WS_INV);
    const int nitems = with_ctx ? 128 : 64;
    for (int it = bid; it < nitems; it += nb) {
        if (it < 64) { const int b = it >> 4, e = it & 15; topk_item(AFF + (size_t)e * NROWS + (size_t)b * SEQ, SEQ, CAP, b * SEQ, e, (b * NE + e) * CAP, TOK, GATE, INV, lds); }
        else { const int b = (it - 64) >> 4, e = it & 15; topk_item(AFF + (size_t)e * NROWS + NLAT + (size_t)b * CTXL, CTXL, CCAP, NLAT + b * CTXL, e, NSLOT_LAT + (e * NB + b) * CCAP, TOK, GATE, INV, lds); }
    }
}

__device__ __forceinline__ void phase_combine(const Params& p, int l, bool with_ctx, LAS unsigned char* lds, int bid, int nb) {
    bid = opaque_s(bid); const int tid = opaque_tid(); const int lane = tid & 63, gw = bid * NWAVES + (tid >> 6), NGW = nb * NWAVES;
    LAS float* l1g = (LAS float*)lds; LAS float* l1b = l1g + DM; LAS float* l2g = l1b + DM; LAS float* l2b = l2g + DM; LAS float* lg2 = l2b + DM; LAS float* lsh = lg2 + 5 * DM; LAS float* lsc = lsh + 5 * DM;
    lds_fill(l1g, p.ln1_g + l * DM, DM, tid); lds_fill(l1b, p.ln1_b + l * DM, DM, tid); lds_fill(l2g, p.ln2_g + l * DM, DM, tid); lds_fill(l2b, p.ln2_b + l * DM, DM, tid);
    for (int r = 0; r < 5; ++r) { lds_fill(lg2 + r * DM, mod_ptr(p, l, r) + 5 * DM, DM, tid); if (l + 1 < DEPTH) { lds_fill(lsh + r * DM, mod_ptr(p, l + 1, r), DM, tid); lds_fill(lsc + r * DM, mod_ptr(p, l + 1, r) + DM, DM, tid); } }
    __syncthreads();
    bf16_t* XB = (bf16_t*)(p.ws + WS_XB); bf16_t* HB = (bf16_t*)(p.ws + WS_HB);
    const bf16_t* Y = (const bf16_t*)(p.ws + WS_Y); const int* INV = (const int*)(p.ws + WS_INV);
    const float* g = p.ln2_g + l * DM; const float* bb = p.ln2_b + l * DM;
    const int nrows = with_ctx ? NROWS : NLAT;
    f32x4 v[4], vn[4]; int myinv = -1, myinvn = -1;
    if (gw < nrows) { row_load_bf16(XB + (size_t)gw * DM, lane, v); myinv = INV[(size_t)(lane & 15) * NROWS + gw]; }
#pragma unroll 1
    for (int row = gw; row < nrows; row += NGW) {
        bf16_t* xr = XB + (size_t)row * DM;
        const int rn = row + NGW;
        if (rn < nrows) { row_load_bf16(XB + (size_t)rn * DM, lane, vn); myinvn = INV[(size_t)(lane & 15) * NROWS + rn]; }
        f32x4 a[4];
#pragma unroll
        for (int j = 0; j < 4; ++j) a[j] = (f32x4){0.f, 0.f, 0.f, 0.f};
#pragma unroll
        for (int e = 0; e < 16; ++e) {
            const int slot = __builtin_amdgcn_readlane(myinv, e);
            if (slot >= 0) { const bf16_t* yr = Y + (size_t)slot * DM;
#pragma unroll
                for (int j = 0; j < 4; ++j) { const u32x2 wv = *(const u32x2*)(yr + 256 * j + 4 * lane); a[j][0] += bf_lo(wv.x); a[j][1] += bf_hi(wv.x); a[j][2] += bf_lo(wv.y); a[j][3] += bf_hi(wv.y); } }
        }
        row_normalize(v); row_affine_l(v, l1g, l1b, lane);
        const int mr = row_modrow(row);
#pragma unroll
        for (int j = 0; j < 4; ++j) { const f32x4 g2 = *(const LAS f32x4*)(lg2 + mr * DM + 256 * j + 4 * lane); v[j] = v[j] * ALPHA + g2 * a[j]; }
        row_normalize(v); row_affine_l(v, l2g, l2b, lane);
        if (l + 1 < DEPTH) row_store_bf16(xr, lane, v); else row_store(p.out + (size_t)row * DM, lane, v);
        if (l + 1 < DEPTH) { row_normalize(v); row_modulate_l(v, lsh + mr * DM, lsc + mr * DM, lane); row_store_bf16(HB + (size_t)row * DM, lane, v); }
#pragma unroll
        for (int j = 0; j < 4; ++j) v[j] = vn[j];
        myinv = myinvn;
    }
}

constexpr int N_PHASES = 2 + 8 * DEPTH;
#define IN(k) (lo <= (k) && (k) < hi)
#ifndef TS_SEL
#define TS_SEL -1
#endif
#define TS_MULT 8
#define SEAM(k) do { if (IN(k) && IN((k) + 1)) xcd_barrier(bar); if (TS_SEL >= 0 && blockIdx.x == 0 && threadIdx.x == 0) ((unsigned long long*)(p.ws + WS_CTL + 65536))[(k) + 1] = __builtin_amdgcn_s_memrealtime(); } while (0)
#ifndef PHMASK
#define PHMASK 0x3ff
#endif
#define PHON(i) ((PHMASK >> (i)) & 1)
#ifndef DUP_MASK
#define DUP_MASK 0
#endif
#define DUP(i) ((DUP_MASK >> (i)) & 1)
template <int l>
__device__ __forceinline__ void run_layer(const Params& p, LAS unsigned char* lds, LAS int* idxl, const XcdBarrier& bar, int bid, int nb, int lo, int hi) {
    bf16_t* HB = (bf16_t*)(p.ws + WS_HB); bf16_t* PB = (bf16_t*)(p.ws + WS_PB); bf16_t* OB = (bf16_t*)(p.ws + WS_OB);
    bf16_t* HH = (bf16_t*)(p.ws + WS_HH); bf16_t* Y = (bf16_t*)(p.ws + WS_Y);
    const int* TOK = (const int*)(p.ws + WS_TOK); const float* GATE = (const float*)(p.ws + WS_GATE);
        const int pb = 2 + 8 * l; const bool wc = (l == 0);
        if (IN(pb + 0)) { if (PHON(2)) {
            const bf16_t* W = (const bf16_t*)(p.ws + WS_WIN) + (size_t)l * INW * DM; EpiQKV E{PB, (const float*)(p.ws + WS_ROPE)};
            { SgDesc g{HB + (size_t)NLAT * DM, DM, nullptr, W, 0, 1 << 30, 1, NCTX, INW, DM, NLAT}; sg_gemm(g, E, bid, nb); }
            { mg::Gemm g{HB, W, NLAT, INW, DM, nullptr, 0, 1 << 20, 1}; mg::StaticOrder S; S.init(NLAT, INW, nb, bid); mg::EpiAdapt<EpiQKV> EA{E, 0}; mg::gemm_phase(lds, idxl, g, S, EA); if (DUP(2)) mg::gemm_phase(lds, idxl, g, S, EA); } } }
        SEAM(pb + 0);
        if (IN(pb + 1)) { if (PHON(3)) {
#if FAST_ATTN
            fa::phase_attn(p, l, wc, lds, bid, nb); if (DUP(3)) fa::phase_attn(p, l, wc, lds, bid, nb);
#endif
            phase_mixers(p, l, wc, bid, nb); } }
        SEAM(pb + 1);
        if (IN(pb + 2)) { if (PHON(4)) {
            const bf16_t* W = (const bf16_t*)(p.ws + WS_WOUT) + (size_t)l * DM * DM;
            EpiOut<l == 0> E{p.x, p.ctx, (bf16_t*)(p.ws + WS_XB), mod_ptr(p, l, 0)};
            if (wc) { SgDesc g{OB + (size_t)NLAT * DM, DM, nullptr, W, 0, 1 << 30, 1, NCTX, DM, DM, NLAT}; sg_gemm(g, E, bid, nb); }
            { mg::Gemm g{OB, W, NLAT, DM, DM, nullptr, 0, 1 << 20, 1}; mg::StaticOrder S; S.init(NLAT, DM, nb, bid); mg::EpiAdapt<EpiOut<l == 0>> EA{E, 0}; mg::gemm_phase(lds, idxl, g, S, EA); if (DUP(4) && l == 0) mg::gemm_phase(lds, idxl, g, S, EA); } } }
        SEAM(pb + 2);
        if (IN(pb + 3)) { if (PHON(5)) phase_ln_router(p, l, wc, lds, bid, nb); }
        SEAM(pb + 3);
        if (IN(pb + 4)) { if (PHON(6)) phase_topk(p, wc, lds, bid, nb); if (DUP(6)) phase_topk(p, wc, lds, bid, nb); }
        SEAM(pb + 4);
        if (IN(pb + 5)) { if (PHON(7)) {
            const bf16_t* W = (const bf16_t*)(p.ws + WS_WGU) + (size_t)l * NE * 1024 * DM; EpiGU E{HH};
            if (wc) { SgDesc g{HB, DM, TOK + NSLOT_LAT, W, (size_t)1024 * DM, NB * CCAP, NE, NSLOT_CTX, 1024, DM, NSLOT_LAT}; sg_gemm(g, E, bid, nb); }
            { mg::Gemm g{HB, W, NSLOT_LAT, 1024, DM, TOK, (size_t)1024 * DM, CAP / 256, NE}; mg::StaticOrder S; S.init(NSLOT_LAT, 1024, nb, bid); mg::EpiAdapt<EpiGU> EA{E, 0}; mg::gemm_phase(lds, idxl, g, S, EA); if (DUP(7)) mg::gemm_phase(lds, idxl, g, S, EA); } } }
        SEAM(pb + 5);
        if (IN(pb + 6)) { if (PHON(8)) {
            const bf16_t* W = (const bf16_t*)(p.ws + WS_WD) + (size_t)l * NE * DM * FF; EpiDown E{Y, GATE};
            if (wc) { SgDesc g{HH + (size_t)NSLOT_LAT * FF, FF, nullptr, W, (size_t)DM * FF, NB * CCAP, NE, NSLOT_CTX, DM, FF, NSLOT_LAT}; sg_gemm(g, E, bid, nb); }
            { mg::Gemm g{HH, W, NSLOT_LAT, DM, FF, nullptr, (size_t)DM * FF, CAP / 256, NE}; mg::StaticOrder S; S.init(NSLOT_LAT, DM, nb, bid); mg::EpiAdapt<EpiDown> EA{E, 0}; mg::gemm_phase(lds, idxl, g, S, EA); if (DUP(8)) mg::gemm_phase(lds, idxl, g, S, EA); } } }
        SEAM(pb + 6);
        if (IN(pb + 7)) { if (PHON(9)) phase_combine(p, l, wc, lds, bid, nb); }
        SEAM(pb + 7);
}
__global__ void __launch_bounds__(NTHREADS, 2) fwd_kernel(Params p) {
    extern __shared__ __attribute__((aligned(16))) unsigned char lds_raw[];
    LAS unsigned char* lds = (LAS unsigned char*)lds_raw;
    const int bid = blockIdx.x, nb = gridDim.x;
    volatile LAS unsigned* MISC = (volatile LAS unsigned*)(lds + LDS_BYTES - 64);
    LAS int* idxl = (LAS int*)(lds + mg::STAGE_BYTES);
    if (threadIdx.x < 16) MISC[threadIdx.x] = 0u;
    __syncthreads();
    XcdBarrier bar; bar.bar = (unsigned*)(p.ws + WS_CTL) + CW_BAR; bar.x = 0; bar.st = nullptr;
    const bool multi = p.ph_hi - p.ph_lo > 1;
    if (multi) bar = xcd_barrier_post((unsigned*)(p.ws + WS_CTL) + CW_BAR, MISC + 8);
    bf16_t* HB = (bf16_t*)(p.ws + WS_HB); bf16_t* PB = (bf16_t*)(p.ws + WS_PB); bf16_t* OB = (bf16_t*)(p.ws + WS_OB);
    bf16_t* HH = (bf16_t*)(p.ws + WS_HH); bf16_t* Y = (bf16_t*)(p.ws + WS_Y);
    const int* TOK = (const int*)(p.ws + WS_TOK); const float* GATE = (const float*)(p.ws + WS_GATE);
    const int lo = p.ph_lo, hi = p.ph_hi;
    if (TS_SEL >= 0 && blockIdx.x == 0 && threadIdx.x == 0) ((unsigned long long*)(p.ws + WS_CTL + 65536))[0] = __builtin_amdgcn_s_memrealtime();
    if (IN(0)) { if (PHON(0)) phase_prologue(p, lds, bid, nb); if (DUP(0)) { __syncthreads(); phase_prologue(p, lds, bid, nb); } } SEAM(0);
    if (IN(1)) { if (PHON(1)) { phase_weights(p, lds, bid, nb); phase_ln1(p, bid, nb); } if (DUP(1)) phase_ln1(p, bid, nb); } SEAM(1);
    run_layer<0>(p, lds, idxl, bar, bid, nb, lo, hi);
    run_layer<1>(p, lds, idxl, bar, bid, nb, lo, hi);
    if (TS_SEL >= 0 && blockIdx.x == 0 && threadIdx.x == 0) {
        volatile unsigned long long* ts = (volatile unsigned long long*)(p.ws + WS_CTL + 65536); const unsigned long long dt = (ts[TS_SEL + 1] - ts[TS_SEL]) * TS_MULT, t0 = __builtin_amdgcn_s_memrealtime();
        while (__builtin_amdgcn_s_memrealtime() - t0 < dt) __builtin_amdgcn_s_sleep(8); }
#undef IN
#undef SEAM
}

#ifndef N_LAUNCH_SPLIT
#define N_LAUNCH_SPLIT 0
#endif
extern "C" void kernel_launch(void* const* d_in, const int* in_sizes, int n_in, void* d_out, int out_size, void* d_ws, size_t ws_size, hipStream_t stream) {
    static int grid = 0;
    if (grid == 0) {
        if (n_in != 19 || in_sizes[0] != NLAT * DM || out_size != NLAT * DM || ws_size < WS_END) { fprintf(stderr, "kernel_launch: unexpected shapes (n_in %d, in0 %d, out %d, ws %zu)\n", n_in, n_in > 0 ? in_sizes[0] : -1, out_size, ws_size); grid = -1; return; }
        int dev = 0, cus = 0, per_cu = 0;
        if (hipGetDevice(&dev) != hipSuccess || hipDeviceGetAttribute(&cus, hipDeviceAttributeMultiprocessorCount, dev) != hipSuccess) { grid = -1; return; }
        if (hipFuncSetAttribute((const void*)fwd_kernel, hipFuncAttributeMaxDynamicSharedMemorySize, LDS_BYTES) != hipSuccess) { fprintf(stderr, "kernel_launch: hipFuncSetAttribute failed\n"); grid = -1; return; }
        if (hipOccupancyMaxActiveBlocksPerMultiprocessor(&per_cu, (const void*)fwd_kernel, NTHREADS, LDS_BYTES) != hipSuccess || per_cu < 1) { fprintf(stderr, "kernel_launch: occupancy query says %d\n", per_cu); per_cu = 1; }
        (void)hipGetLastError();
        grid = cus;
    }
    if (grid < 0) return;
    (void)hipMemsetAsync((char*)d_ws + WS_CTL, 0, CTL_ZERO_BYTES, stream);
    Params p{};
    const float** pp = (const float**)&p;
    for (int i = 0; i < 19; ++i) pp[i] = (const float*)d_in[i];
    p.out = (float*)d_out; p.ws = (unsigned char*)d_ws;
#if N_LAUNCH_SPLIT
    for (int ph = 0; ph < N_PHASES; ++ph) { p.ph_lo = ph; p.ph_hi = ph + 1; hipLaunchKernelGGL(fwd_kernel, dim3(grid), dim3(NTHREADS), LDS_BYTES, stream, p); }
#else
    p.ph_lo = 0; p.ph_hi = N_PHASES;
    void* args[] = {&p};
    hipError_t e = hipLaunchCooperativeKernel((const void*)fwd_kernel, dim3(grid), dim3(NTHREADS), args, LDS_BYTES, stream);
    if (e != hipSuccess) fprintf(stderr, "kernel_launch: cooperative launch failed: %s\n", hipGetErrorString(e));
#endif
}
```

```cpp
#include <hip/hip_runtime.h>
#include <hip/hip_cooperative_groups.h>
#include <cstdio>
#include <cstdint>
#include <cmath>

#define LAS __attribute__((address_space(3)))
typedef unsigned short bf16_t;
typedef short bf16x8 __attribute__((ext_vector_type(8)));
typedef float f32x4 __attribute__((ext_vector_type(4)));
typedef unsigned u32x4 __attribute__((ext_vector_type(4)));
typedef unsigned u32x2 __attribute__((ext_vector_type(2)));

constexpr int NB = 4, SEQ = 8192, DM = 1024, CTXL = 256, DEPTH = 2;
constexpr int NLAT = NB * SEQ, NCTX = NB * CTXL, NROWS = NLAT + NCTX;
constexpr int INW = 2560, NE = 16, FF = 512, CAP = 1024, CCAP = 32;
constexpr int NSLOT_LAT = NB * NE * CAP, NSLOT_CTX = NB * NE * CCAP, NSLOT = NSLOT_LAT + NSLOT_CTX;
constexpr int NMOD = 6 * DM;
constexpr float LN_EPS = 1e-6f;
constexpr float ALPHA = 1.41421356237309515f;
constexpr int C_QA = 0, C_KA = 384, C_VA = 512, C_BX = 640, C_BB = 896, C_BC = 1152, C_QN = 1408, C_KN = 1792, C_VN = 2176;

#ifndef FAST_ATTN
#define FAST_ATTN 1
#endif
constexpr int NTHREADS = 512, NWAVES = 8;
constexpr int LDS_BYTES = 147456;

constexpr size_t MiB = 1u << 20;
constexpr size_t WS_CTL = 0, CTL_ZERO_BYTES = 1 * MiB;
constexpr size_t WS_ROPE = 1 * MiB;
constexpr size_t WS_MOD = 1 * MiB + 65536;
constexpr size_t WS_AFF = 2 * MiB;
constexpr size_t WS_INV = 5 * MiB;
constexpr size_t WS_TOK = 8 * MiB;
constexpr size_t WS_GATE = 8 * MiB + 512 * 1024;
constexpr size_t WS_CXR = 9 * MiB;
constexpr size_t WS_WIN = 16 * MiB;
constexpr size_t WS_WOUT = 26 * MiB;
constexpr size_t WS_WGU = 30 * MiB;
constexpr size_t WS_WD = 94 * MiB;
constexpr size_t WS_HB = 126 * MiB;
constexpr size_t WS_OB = 192 * MiB;
constexpr size_t WS_HH = 192 * MiB;
constexpr size_t WS_PB = 258 * MiB;
constexpr size_t WS_Y = 258 * MiB;
constexpr size_t WS_XB = 424 * MiB;
constexpr size_t WS_END = 490 * MiB;
static_assert(WS_HB + (size_t)NROWS * DM * 2 <= WS_OB && WS_OB + (size_t)NROWS * DM * 2 <= WS_PB && WS_PB + (size_t)NROWS * INW * 2 <= WS_XB && WS_XB + (size_t)NROWS * DM * 2 <= WS_END, "ws map");
static_assert((size_t)NSLOT * FF * 2 <= (size_t)NROWS * DM * 2 && (size_t)NSLOT * DM * 2 <= (size_t)NROWS * INW * 2, "overlays");
constexpr int CW_BAR = 4096;

struct Params {
    const float *x, *c, *ctx, *c_ctx, *w_mod, *b_mod, *w_in, *conv_w, *attn_sink, *na_rpb, *w_out, *ln1_g, *ln1_b, *w_router, *w_gate, *w_up, *w_down, *ln2_g, *ln2_b;
    float* out; unsigned char* ws;
    int ph_lo, ph_hi;
};

__device__ __forceinline__ unsigned f2bf(float f) { unsigned u = __builtin_bit_cast(unsigned, f); return (u + 0x7fffu + ((u >> 16) & 1u)) >> 16; }
typedef float f32x2_cv __attribute__((ext_vector_type(2))); typedef __bf16 bf16x2_cv __attribute__((ext_vector_type(2)));
__device__ __forceinline__ unsigned pk2(float lo, float hi) { f32x2_cv v = {lo, hi}; bf16x2_cv b = __builtin_convertvector(v, bf16x2_cv); return __builtin_bit_cast(unsigned, b); }
__device__ __forceinline__ float bf_lo(unsigned w) { return __builtin_bit_cast(float, w << 16); }
__device__ __forceinline__ float bf_hi(unsigned w) { return __builtin_bit_cast(float, w & 0xffff0000u); }
template <int CTRL> __device__ __forceinline__ float dppf(float v) { return __builtin_bit_cast(float, __builtin_amdgcn_update_dpp(0, __builtin_bit_cast(int, v), CTRL, 0xf, 0xf, true)); }
__device__ __forceinline__ void swap16(float v, float& a, float& b) { a = v; b = v; asm volatile("s_nop 1\n\tv_permlane16_swap_b32 %0, %1" : "+v"(a), "+v"(b)); }
__device__ __forceinline__ void swap32(float v, float& a, float& b) { a = v; b = v; asm volatile("s_nop 1\n\tv_permlane32_swap_b32 %0, %1" : "+v"(a), "+v"(b)); }
__device__ __forceinline__ float xor16_sum(float v) { float a, b; swap16(v, a, b); return a + b; }
__device__ __forceinline__ float xor32_sum(float v) { float a, b; swap32(v, a, b); return a + b; }
__device__ __forceinline__ float xor16_max(float v) { float a, b; swap16(v, a, b); return fmaxf(a, b); }
__device__ __forceinline__ float xor32_max(float v) { float a, b; swap32(v, a, b); return fmaxf(a, b); }
__device__ __forceinline__ float wave_sum(float v) {
    v += dppf<0xB1>(v); v += dppf<0x4E>(v); v += dppf<0x141>(v); v += dppf<0x140>(v);
    return xor32_sum(xor16_sum(v));
}
#define LDS_WAIT() asm volatile("s_waitcnt lgkmcnt(0)" ::: "memory")
__device__ __forceinline__ int opaque_tid() { int t = threadIdx.x; asm volatile("" : "+v"(t)); return t; }
__device__ __forceinline__ int opaque_s(int v) { asm volatile("" : "+s"(v)); return v; }

__device__ __forceinline__ float* mod_ptr(const Params& p, int l, int r) { return (float*)(p.ws + WS_MOD) + ((size_t)l * 5 + r) * NMOD; }

#define XB_TMO      128
#define XB_XCNT(j)  (256  + 64 * (j))
#define XB_XSUB(j)  (1280 + 64 * (j))
#define XB_XGEN(j)  (2304 + 64 * (j))
#define XB_TOP      3328
#define XB_TOPGEN   3392
#define XCD_BAR_WORDS 3456
#define XB_SPIN_CAP (1u << 20)
__device__ __forceinline__ unsigned xb_ld(unsigned* p)              { return __hip_atomic_load(p, __ATOMIC_RELAXED, __HIP_MEMORY_SCOPE_AGENT); }
__device__ __forceinline__ unsigned xb_add(unsigned* p, unsigned v) { return __hip_atomic_fetch_add(p, v, __ATOMIC_RELAXED, __HIP_MEMORY_SCOPE_AGENT); }
__device__ __forceinline__ unsigned xb_xcc_id() { return (unsigned)__builtin_amdgcn_s_getreg((3 << 11) | 20) & 0xFu; }
#define XB_SPIN(cond, bar) do { unsigned _sp = 0; while (cond) { __builtin_amdgcn_s_sleep(1); \
    if ((++_sp & 255u) == 0u) { if (xb_ld(&(bar)[XB_TMO])) break; if (_sp > XB_SPIN_CAP) { atomicAdd(&(bar)[XB_TMO], 1u); break; } } } } while (0)
struct XcdBarrier { unsigned* bar; unsigned x; volatile LAS unsigned* st; };
__device__ __forceinline__ XcdBarrier xcd_barrier_post(unsigned* bar, volatile LAS unsigned* st) {
    XcdBarrier b; b.bar = bar; b.x = xb_xcc_id(); b.st = st;
    if (threadIdx.x == 0) (void)xb_add(&bar[XB_XCNT(b.x)], 1u);
    return b;
}
__device__ __forceinline__ void xcd_barrier_complete(unsigned* bar, unsigned x, unsigned& nloc, unsigned& nx) {
    const unsigned G = gridDim.x * gridDim.y * gridDim.z;
    unsigned sum, cnt, mine, sp = 0u;
    for (;;) {
        sum = 0u; cnt = 0u; mine = 0u;
#pragma unroll 1
        for (unsigned j = 0; j < 16; ++j) { const unsigned c = xb_ld(&bar[XB_XCNT(j)]); sum += c; cnt += (c > 0u) ? 1u : 0u; mine = (j == x) ? c : mine; }
        if (sum == G) break;
        __builtin_amdgcn_s_sleep(1);
        if ((++sp & 255u) == 0u) { if (xb_ld(&bar[XB_TMO])) break; if (sp > XB_SPIN_CAP) { atomicAdd(&bar[XB_TMO], 1u); break; } }
    }
    nloc = mine > 0u ? mine : 1u; nx = cnt > 0u ? cnt : 1u;
}
__device__ __forceinline__ void xcd_barrier(const XcdBarrier& b) {
    asm volatile("s_waitcnt vmcnt(0)" ::: "memory");
    __syncthreads();
    if (threadIdx.x == 0) {
        unsigned* bar = b.bar; asm volatile("" : "+s"(bar));
        __builtin_amdgcn_s_waitcnt(0);
        unsigned nloc = b.st[0], nx = b.st[1];
        if (nloc == 0u) { xcd_barrier_complete(bar, b.x, nloc, nx); b.st[0] = nloc; b.st[1] = nx; }
        const unsigned old = xb_add(&bar[XB_XSUB(b.x)], 1u);
        const unsigned gen = old / nloc;
        if (old + 1u == (gen + 1u) * nloc) {
            __builtin_amdgcn_fence(__ATOMIC_RELEASE, "agent");
            asm volatile("s_waitcnt vmcnt(0)" ::: "memory");
            const unsigned og = xb_add(&bar[XB_TOP], 1u);
            const unsigned tg = og / nx;
            if (og + 1u == (tg + 1u) * nx) xb_add(&bar[XB_TOPGEN], 1u);
            else XB_SPIN(xb_ld(&bar[XB_TOPGEN]) == tg, bar);
            __builtin_amdgcn_fence(__ATOMIC_ACQUIRE, "agent");
            xb_add(&bar[XB_XGEN(b.x)], 1u);
            asm volatile("s_waitcnt vmcnt(0)" ::: "memory");
        } else {
            XB_SPIN(xb_ld(&bar[XB_XGEN(b.x)]) == gen, bar);
            __builtin_amdgcn_fence(__ATOMIC_ACQUIRE, "agent");
            asm volatile("s_waitcnt vmcnt(0)" ::: "memory");
        }
    }
    __syncthreads();
}

struct TrItem { const float* W; bf16_t* WT; int K, N, mode, item; };
__device__ __forceinline__ void tr_load(const TrItem& t, int lane, float (&r)[32]) {
    const int nblk = t.N / 32, kb = t.item / nblk, nb = t.item % nblk, k0 = 64 * kb, n0 = 32 * nb;
    const float* src = t.W + (size_t)(k0 + (lane >> 5)) * t.N + n0 + (lane & 31);
#pragma unroll
    for (int i = 0; i < 32; ++i) r[i] = src[(size_t)(2 * i) * t.N];
}
__device__ __forceinline__ void tr_finish(const TrItem& t, int lane, const float (&r)[32], LAS float* scr) {
    const int nblk = t.N / 32, kb = t.item / nblk, nb = t.item % nblk, k0 = 64 * kb, n0 = 32 * nb;
#pragma unroll
    for (int i = 0; i < 32; ++i) scr[(2 * i + (lane >> 5)) * 33 + (lane & 31)] = r[i];
    LDS_WAIT();
    const int c = lane & 7;
#pragma unroll
    for (int j = 0; j < 4; ++j) {
        const int n = (lane >> 3) + 8 * j; const LAS float* s = scr + (8 * c) * 33 + n;
        u32x4 o; o.x = pk2(s[0 * 33], s[1 * 33]); o.y = pk2(s[2 * 33], s[3 * 33]); o.z = pk2(s[4 * 33], s[5 * 33]); o.w = pk2(s[6 * 33], s[7 * 33]);
        const int f = n0 + n;
        const int orow = t.mode == 0 ? ((f & ~255) + 128 * ((f >> 4) & 1) + 32 * ((f >> 6) & 3) + 16 * ((f >> 2) & 1) + 4 * (2 * ((f >> 5) & 1) + ((f >> 3) & 1)) + (f & 3))
                                     : (256 * (f >> 7) + (t.mode == 2 ? 128 : 0) + 32 * ((f >> 5) & 3) + 16 * ((f >> 2) & 1) + 4 * ((f >> 3) & 3) + (f & 3));
        *(u32x4*)(t.WT + (size_t)orow * t.K + k0 + 8 * c) = o;
    }
    LDS_WAIT();
}
__device__ __forceinline__ void phase_prologue(const Params& p, LAS unsigned char* lds, int bid, int nb) {
    bid = opaque_s(bid); const int tid = opaque_tid(), lane = tid & 63, w = tid >> 6;
    {
        LAS float* ssil = (LAS float*)lds;
        LAS float* red = ssil + 5 * 1024;
        for (int i = tid; i < 5 * 1024; i += NTHREADS) { const int r = i >> 10, k = i & 1023; const float v = r < 4 ? p.c[r * 1024 + k] : p.c_ctx[k]; ssil[i] = v / (1.f + expf(-v)); }
        __syncthreads();
        for (int item = bid; item < 2 * 96; item += nb) {
            const int l = item / 96, n0 = (item % 96) * 64;
            const float* W = p.w_mod + (size_t)l * DM * NMOD + n0 + lane;
            float a0 = 0.f, a1 = 0.f, a2 = 0.f, a3 = 0.f, a4 = 0.f;
#pragma unroll 8
            for (int k = w * 128; k < w * 128 + 128; ++k) {
                const float wv = W[(size_t)k * NMOD];
                a0 += ssil[k] * wv; a1 += ssil[1024 + k] * wv; a2 += ssil[2048 + k] * wv; a3 += ssil[3072 + k] * wv; a4 += ssil[4096 + k] * wv;
            }
            red[(w * 5 + 0) * 64 + lane] = a0; red[(w * 5 + 1) * 64 + lane] = a1; red[(w * 5 + 2) * 64 + lane] = a2; red[(w * 5 + 3) * 64 + lane] = a3; red[(w * 5 + 4) * 64 + lane] = a4;
            __syncthreads();
            if (tid < 320) { const int r = tid >> 6; float s = 0.f;
#pragma unroll
                for (int ww = 0; ww < 8; ++ww) s += red[(ww * 5 + r) * 64 + lane];
                mod_ptr(p, l, r)[n0 + lane] = s + p.b_mod[l * NMOD + n0 + lane]; }
            __syncthreads();
        }
    }
    if (bid == nb - 1) {
        float* rope = (float*)(p.ws + WS_ROPE);
        for (int e = tid; e < 128 * 16; e += NTHREADS) {
            const int pos = e >> 4, i = e & 15;
            const double a = exp(-((double)i / 16.0) * 9.210340371976184);
            const double a2 = a * a; double c = 1.0, s = a, tc = 1.0, ts = a;
            for (int n = 1; n <= 14; ++n) { tc *= -a2 / (double)((2 * n - 1) * (2 * n)); c += tc; ts *= -a2 / (double)((2 * n) * (2 * n + 1)); s += ts; }
            double rc = 1.0, rs = 0.0, bc = c, bs = s; int q = pos;
            while (q) { if (q & 1) { const double t = rc * bc - rs * bs; rs = rc * bs + rs * bc; rc = t; } const double t = bc * bc - bs * bs; bs = 2.0 * bc * bs; bc = t; q >>= 1; }
            rope[2 * e] = (float)rc; rope[2 * e + 1] = (float)rs;
        }
    }
}

__device__ __forceinline__ void phase_weights(const Params& p, LAS unsigned char* lds, int bid, int nb) {
    bid = opaque_s(bid); const int tid = opaque_tid(), lane = tid & 63, w = tid >> 6;
    {
        LAS float* scr = (LAS float*)lds + w * (64 * 33);
        const int gw = bid * NWAVES + w, NGW = nb * NWAVES;
        constexpr int I_IN = 16 * 80, I_OUT = 16 * 32, I_G = 16 * 16, I_D = 8 * 32;
        constexpr int PER_L = I_IN + I_OUT + 16 * (2 * I_G + I_D);
        auto decode = [&](int it) -> TrItem {
            const int l = it / PER_L; int r = it % PER_L;
            if (r < I_IN) return TrItem{p.w_in + (size_t)l * DM * INW, (bf16_t*)(p.ws + WS_WIN) + (size_t)l * INW * DM, DM, INW, 0, r}; r -= I_IN;
            if (r < I_OUT) return TrItem{p.w_out + (size_t)l * DM * DM, (bf16_t*)(p.ws + WS_WOUT) + (size_t)l * DM * DM, DM, DM, 0, r}; r -= I_OUT;
            if (r < 16 * I_G) { const int e = r / I_G; return TrItem{p.w_gate + ((size_t)l * NE + e) * DM * FF, (bf16_t*)(p.ws + WS_WGU) + ((size_t)l * NE + e) * 1024 * DM, DM, FF, 1, r % I_G}; } r -= 16 * I_G;
            if (r < 16 * I_G) { const int e = r / I_G; return TrItem{p.w_up + ((size_t)l * NE + e) * DM * FF, (bf16_t*)(p.ws + WS_WGU) + ((size_t)l * NE + e) * 1024 * DM, DM, FF, 2, r % I_G}; } r -= 16 * I_G;
            const int e = r / I_D; return TrItem{p.w_down + ((size_t)l * NE + e) * FF * DM, (bf16_t*)(p.ws + WS_WD) + ((size_t)l * NE + e) * DM * FF, FF, DM, 0, r % I_D};
        };
        float ra[32], rb[32];
        int it = gw;
        if (it < 2 * PER_L) { TrItem cur = decode(it); tr_load(cur, lane, ra);
#pragma unroll 1
            for (;;) {
                const int itn = it + NGW; const bool hn = itn < 2 * PER_L; TrItem nx = cur;
                if (hn) { nx = decode(itn); tr_load(nx, lane, rb); }
                tr_finish(cur, lane, ra, scr);
                if (!hn) break;
                const int itn2 = itn + NGW; const bool hn2 = itn2 < 2 * PER_L; TrItem nx2 = nx;
                if (hn2) { nx2 = decode(itn2); tr_load(nx2, lane, ra); }
                tr_finish(nx, lane, rb, scr);
                if (!hn2) break;
                cur = nx2; it = itn2;
            }
        }
    }
}

__device__ __forceinline__ void row_load(const float* rowp, int lane, f32x4 (&v)[4]) {
#pragma unroll
    for (int j = 0; j < 4; ++j) v[j] = *(const f32x4*)(rowp + 256 * j + 4 * lane);
}
__device__ __forceinline__ void row_load_bf16(const bf16_t* rowp, int lane, f32x4 (&v)[4]) {
#pragma unroll
    for (int j = 0; j < 4; ++j) { const u32x2 w = *(const u32x2*)(rowp + 256 * j + 4 * lane); v[j] = (f32x4){bf_lo(w.x), bf_hi(w.x), bf_lo(w.y), bf_hi(w.y)}; }
}
__device__ __forceinline__ void row_store(float* rowp, int lane, const f32x4 (&v)[4]) {
#pragma unroll
    for (int j = 0; j < 4; ++j) *(f32x4*)(rowp + 256 * j + 4 * lane) = v[j];
}
__device__ __forceinline__ void row_store_bf16(bf16_t* rowp, int lane, const f32x4 (&v)[4]) {
#pragma unroll
    for (int j = 0; j < 4; ++j) { u32x2 o; o.x = pk2(v[j][0], v[j][1]); o.y = pk2(v[j][2], v[j][3]); *(u32x2*)(rowp + 256 * j + 4 * lane) = o; }
}
__device__ __forceinline__ void row_normalize(f32x4 (&v)[4]) {
    float s = 0.f;
#pragma unroll
    for (int j = 0; j < 4; ++j) s += (v[j][0] + v[j][1]) + (v[j][2] + v[j][3]);
    const float mean = wave_sum(s) * (1.f / DM);
    float q = 0.f;
#pragma unroll
    for (int j = 0; j < 4; ++j) { v[j] = v[j] - mean; q += (v[j][0] * v[j][0] + v[j][1] * v[j][1]) + (v[j][2] * v[j][2] + v[j][3] * v[j][3]); }
    const float rstd = 1.f / sqrtf(wave_sum(q) * (1.f / DM) + LN_EPS);
#pragma unroll
    for (int j = 0; j < 4; ++j) v[j] = v[j] * rstd;
}
__device__ __forceinline__ void row_modulate(f32x4 (&v)[4], const float* sh, const float* sc, int lane) {
#pragma unroll
    for (int j = 0; j < 4; ++j) { const f32x4 a = *(const f32x4*)(sc + 256 * j + 4 * lane), b = *(const f32x4*)(sh + 256 * j + 4 * lane); v[j] = v[j] * (a + 1.f) + b; }
}
__device__ __forceinline__ void row_affine(f32x4 (&v)[4], const float* g, const float* bb, int lane) {
#pragma unroll
    for (int j = 0; j < 4; ++j) { const f32x4 a = *(const f32x4*)(g + 256 * j + 4 * lane), b = *(const f32x4*)(bb + 256 * j + 4 * lane); v[j] = v[j] * a + b; }
}
__device__ __forceinline__ void row_modulate_l(f32x4 (&v)[4], const LAS float* sh, const LAS float* sc, int lane) {
#pragma unroll
    for (int j = 0; j < 4; ++j) { const f32x4 a = *(const LAS f32x4*)(sc + 256 * j + 4 * lane), b = *(const LAS f32x4*)(sh + 256 * j + 4 * lane); v[j] = v[j] * (a + 1.f) + b; }
}
__device__ __forceinline__ void row_affine_l(f32x4 (&v)[4], const LAS float* g, const LAS float* bb, int lane) {
#pragma unroll
    for (int j = 0; j < 4; ++j) { const f32x4 a = *(const LAS f32x4*)(g + 256 * j + 4 * lane), b = *(const LAS f32x4*)(bb + 256 * j + 4 * lane); v[j] = v[j] * a + b; }
}
__device__ __forceinline__ int row_modrow(int row) { return row < NLAT ? (row >> 13) : 4; }
__device__ __forceinline__ void lds_fill(LAS float* dst, const float* src, int n, int tid) { for (int i = tid * 4; i < n; i += NTHREADS * 4) *(LAS f32x4*)(dst + i) = *(const f32x4*)(src + i); }

__device__ __forceinline__ void phase_ln1(const Params& p, int bid, int nb) {
    bid = opaque_s(bid); const int tid = opaque_tid(), lane = tid & 63, gw = bid * NWAVES + (tid >> 6), NGW = nb * NWAVES;
    bf16_t* HB = (bf16_t*)(p.ws + WS_HB);
    f32x4 v[4], vn[4];
    if (gw < NROWS) row_load(gw < NLAT ? p.x + (size_t)gw * DM : p.ctx + (size_t)(gw - NLAT) * DM, lane, v);
#pragma unroll 1
    for (int row = gw; row < NROWS; row += NGW) {
        const int rn = row + NGW;
        if (rn < NROWS) row_load(rn < NLAT ? p.x + (size_t)rn * DM : p.ctx + (size_t)(rn - NLAT) * DM, lane, vn);
        row_normalize(v);
        const float* m = mod_ptr(p, 0, row_modrow(row)); row_modulate(v, m, m + DM, lane);
        row_store_bf16(HB + (size_t)row * DM, lane, v);
#pragma unroll
        for (int j = 0; j < 4; ++j) v[j] = vn[j];
    }
}

struct SgDesc { const bf16_t* A; int lda; const int* rowidx; const bf16_t* Bt; size_t grp_stride; int rows_per_grp, ngrp; int M, N, K; int row_base; };
template <class Epi>
__device__ __forceinline__ void sg_gemm(const SgDesc& g, const Epi& E, LAS unsigned char* lds, int bid, int nb) {
    bid = opaque_s(bid); const int tid = opaque_tid(); const int lane = tid & 63, w = __builtin_amdgcn_readfirstlane(tid >> 6), fr = lane & 15, fq = lane >> 4, wm = w >> 1, wn = w & 1;
    const int tilesN = g.N / 128, tiles = (g.M / 128) * tilesN, nk = g.K / 64;
    const int sr = tid >> 3, sp = tid & 7;
    const int soff = sr * 128 + ((sp ^ ((sr >> 1) & 7)) << 4);
    int aoff[2][2], boff[4][2];
#pragma unroll
    for (int ks = 0; ks < 2; ++ks) {
#pragma unroll
        for (int i = 0; i < 2; ++i) { const int r = 32 * wm + 16 * i + fr; aoff[i][ks] = r * 128 + (((fq + 4 * ks) ^ ((r >> 1) & 7)) << 4); }
#pragma unroll
        for (int n = 0; n < 4; ++n) { const int r = 64 * (n >> 1) + 32 * wn + 16 * (n & 1) + fr; boff[n][ks] = 16384 + r * 128 + (((fq + 4 * ks) ^ ((r >> 1) & 7)) << 4); }
    }
#pragma unroll 1
    for (int t = bid; t < tiles; t += nb) {
        const int tm = t / tilesN, tn = t % tilesN, pn = tn >> 1, wp = tn & 1;
        const int row0 = tm * 128;
        const bf16_t* Bt = g.Bt + (size_t)((row0 / g.rows_per_grp) % g.ngrp) * g.grp_stride;
        const bf16_t* as[2]; const bf16_t* bs[2];
#pragma unroll
        for (int h = 0; h < 2; ++h) { const int r = row0 + sr + 64 * h; const int ar = g.rowidx ? g.rowidx[r] : r; as[h] = g.A + (size_t)ar * g.lda + sp * 8;
            bs[h] = Bt + (size_t)(256 * pn + 128 * h + 64 * wp + sr) * g.K + sp * 8; }
        f32x4 acc[2][4];
#pragma unroll
        for (int i = 0; i < 2; ++i)
#pragma unroll
            for (int n = 0; n < 4; ++n) acc[i][n] = (f32x4){0.f, 0.f, 0.f, 0.f};
        u32x4 ra[2], rb[2];
#pragma unroll
        for (int h = 0; h < 2; ++h) { ra[h] = *(const u32x4*)(as[h]); rb[h] = *(const u32x4*)(bs[h]); }
#pragma unroll
        for (int h = 0; h < 2; ++h) { *(LAS u32x4*)(lds + soff + h * 8192) = ra[h]; *(LAS u32x4*)(lds + 16384 + soff + h * 8192) = rb[h]; }
        __syncthreads();
#pragma unroll 1
        for (int k = 0; k < nk; ++k) {
            const LAS unsigned char* buf = lds + (k & 1) * 32768;
            if (k + 1 < nk) {
#pragma unroll
                for (int h = 0; h < 2; ++h) { ra[h] = *(const u32x4*)(as[h] + (k + 1) * 64); rb[h] = *(const u32x4*)(bs[h] + (k + 1) * 64); } }
#pragma unroll
            for (int ks = 0; ks < 2; ++ks) {
                bf16x8 a[2], b[4];
#pragma unroll
                for (int i = 0; i < 2; ++i) a[i] = *(const LAS bf16x8*)(buf + aoff[i][ks]);
#pragma unroll
                for (int n = 0; n < 4; ++n) b[n] = *(const LAS bf16x8*)(buf + boff[n][ks]);
#pragma unroll
                for (int i = 0; i < 2; ++i)
#pragma unroll
                    for (int n = 0; n < 4; ++n) acc[i][n] = __builtin_amdgcn_mfma_f32_16x16x32_bf16(b[n], a[i], acc[i][n], 0, 0, 0);
            }
            if (k + 1 < nk) { LAS unsigned char* nbuf = lds + ((k + 1) & 1) * 32768;
#pragma unroll
                for (int h = 0; h < 2; ++h) { *(LAS u32x4*)(nbuf + soff + h * 8192) = ra[h]; *(LAS u32x4*)(nbuf + 16384 + soff + h * 8192) = rb[h]; } }
            __syncthreads();
        }
#pragma unroll
        for (int i = 0; i < 2; ++i) {
            const int row = g.row_base + row0 + 32 * wm + 16 * i + fr; const float rv = E.rowval(row);
            E(row, pn, 2 * wp + wn, fq, acc[i][0], acc[i][1], acc[i][2], acc[i][3], rv);
        }
    }
}

__device__ __forceinline__ void store_bf16x8(bf16_t* p, const f32x4 a, const f32x4 b) { u32x4 o; o.x = pk2(a[0], a[1]); o.y = pk2(a[2], a[3]); o.z = pk2(b[0], b[1]); o.w = pk2(b[2], b[3]); *(u32x4*)p = o; }
__device__ __forceinline__ int epi_col(int pn, int wc, int fq) { return 256 * pn + 64 * wc + 32 * (fq >> 1) + 8 * (fq & 1); }

struct EpiQKV {
    bf16_t* PB; const float* rope;
    __device__ __forceinline__ float rowval(int) const { return 0.f; }
    __device__ __forceinline__ void operator()(int row, int pn, int wc, int fq, f32x4 a0, f32x4 a1, f32x4 b0, f32x4 b1, float) const {
        const int c = epi_col(pn, wc, fq);
        if (c < 512 && row < NLAT) {
            const int t = row & (SEQ - 1); const int pos = (fq >> 1) ? (t & 63) : (t >> 6);
            const f32x4* rp = (const f32x4*)(rope + (pos * 16 + 8 * (fq & 1)) * 2);
            const f32x4 r0 = rp[0], r1 = rp[1], r2 = rp[2], r3 = rp[3];
            const f32x4 cs0 = {r0[0], r0[2], r1[0], r1[2]}, sn0 = {r0[1], r0[3], r1[1], r1[3]}, cs1 = {r2[0], r2[2], r3[0], r3[2]}, sn1 = {r2[1], r2[3], r3[1], r3[3]};
            const f32x4 na0 = a0 * cs0 - b0 * sn0, nb0 = b0 * cs0 + a0 * sn0, na1 = a1 * cs1 - b1 * sn1, nb1 = b1 * cs1 + a1 * sn1;
            a0 = na0; b0 = nb0; a1 = na1; b1 = nb1;
        }
        bf16_t* o = PB + (size_t)row * INW + c;
        store_bf16x8(o, a0, a1); store_bf16x8(o + 16, b0, b1);
    }
};
template <bool FIRST> struct EpiOut {
    const float* xl; const float* xc; bf16_t* XB; const float* mod;
    __device__ __forceinline__ float rowval(int) const { return 0.f; }
    __device__ __forceinline__ void operator()(int row, int pn, int wc, int fq, f32x4 a0, f32x4 a1, f32x4 b0, f32x4 b1, float) const {
        const int c = epi_col(pn, wc, fq); bf16_t* xo = XB + (size_t)row * DM + c;
        const float* g1 = mod + (size_t)row_modrow(row) * NMOD + 2 * DM + c;
        f32x4 xa0, xa1, xb0, xb1;
        if (FIRST) { const float* xin = row < NLAT ? xl + (size_t)row * DM + c : xc + (size_t)(row - NLAT) * DM + c;
            xa0 = *(const f32x4*)xin; xa1 = *(const f32x4*)(xin + 4); xb0 = *(const f32x4*)(xin + 16); xb1 = *(const f32x4*)(xin + 20); }
        else { const u32x4 wa = *(const u32x4*)xo, wb = *(const u32x4*)(xo + 16);
            xa0 = (f32x4){bf_lo(wa.x), bf_hi(wa.x), bf_lo(wa.y), bf_hi(wa.y)}; xa1 = (f32x4){bf_lo(wa.z), bf_hi(wa.z), bf_lo(wa.w), bf_hi(wa.w)};
            xb0 = (f32x4){bf_lo(wb.x), bf_hi(wb.x), bf_lo(wb.y), bf_hi(wb.y)}; xb1 = (f32x4){bf_lo(wb.z), bf_hi(wb.z), bf_lo(wb.w), bf_hi(wb.w)}; }
        const f32x4 ga0 = *(const f32x4*)g1, ga1 = *(const f32x4*)(g1 + 4), gb0 = *(const f32x4*)(g1 + 16), gb1 = *(const f32x4*)(g1 + 20);
        store_bf16x8(xo, xa0 * ALPHA + ga0 * a0, xa1 * ALPHA + ga1 * a1); store_bf16x8(xo + 16, xb0 * ALPHA + gb0 * b0, xb1 * ALPHA + gb1 * b1);
    }
};
struct EpiGU {
    bf16_t* HH;
    __device__ __forceinline__ float rowval(int) const { return 0.f; }
    __device__ __forceinline__ void operator()(int row, int pn, int wc, int fq, f32x4 a0, f32x4 a1, f32x4 b0, f32x4 b1, float) const {
        f32x4 h0, h1;
#pragma unroll
        for (int j = 0; j < 4; ++j) { h0[j] = a0[j] * __builtin_amdgcn_rcpf(1.f + __expf(-a0[j])) * b0[j]; h1[j] = a1[j] * __builtin_amdgcn_rcpf(1.f + __expf(-a1[j])) * b1[j]; }
        store_bf16x8(HH + (size_t)row * FF + 128 * pn + 32 * wc + 8 * fq, h0, h1);
    }
};
struct EpiDown {
    bf16_t* Y; const float* gate;
    __device__ __forceinline__ float rowval(int row) const { return gate[row]; }
    __device__ __forceinline__ void operator()(int row, int pn, int wc, int fq, f32x4 a0, f32x4 a1, f32x4 b0, f32x4 b1, float g) const {
        bf16_t* o = Y + (size_t)row * DM + epi_col(pn, wc, fq);
        store_bf16x8(o, a0 * g, a1 * g); store_bf16x8(o + 16, b0 * g, b1 * g);
    }
};

namespace mg {
constexpr int BM = 256, BK = 64, HALF = 128, HTB = HALF * BK * 2, STAGE_BYTES = 8 * HTB, NXCD = 8, WGM = 8, MAXU = 8;
__device__ __forceinline__ int lds_byte(int r, int c) { const int st = (r >> 4) * 2 + (c >> 5), rr = r & 15, cc = c & 31, ob = rr * 64 + cc * 2; return st * 1024 + (ob ^ (((ob >> 9) & 1) << 5)); }
__device__ __forceinline__ void stage_rc(int b, int& R, int& C) { const int st = b / 1024, sb = b % 1024, swz = sb ^ (((sb >> 9) & 1) << 5); R = (st >> 1) * 16 + swz / 64; C = (st & 1) * 32 + (swz % 64) / 2; }
struct Unit { int pm, pn; };
struct Gemm { const bf16_t* A; const bf16_t* Bt; int M, N, K; const int* rowidx; size_t grp_stride; int grp_tiles, ngrp; };
struct StaticOrder {
    int nM, nN, nwg, G, c;
    __device__ void init(int M, int N, int G_, int c_) { nM = M / BM; nN = N / BM; nwg = nM * nN; G = G_; c = c_; }
    __device__ bool next(int i, Unit& u) const {
        const long L = (long)i * G + c; if (L >= nwg) return false;
        int wgid = (int)L; { const int q = nwg / NXCD, r = nwg % NXCD, xcd = wgid % NXCD, off = wgid / NXCD; wgid = (xcd < r ? xcd * (q + 1) : r * (q + 1) + (xcd - r) * q) + off; }
        const int nig = WGM * nN, gid = wgid / nig, fm = gid * WGM, gsz = (nM - fm) < WGM ? (nM - fm) : WGM;
        u.pm = fm + ((wgid % nig) % gsz); u.pn = (wgid % nig) / gsz; return true;
    }
};
template <class Epi>
__device__ __forceinline__ void gemm_phase(LAS unsigned char* lds, LAS int* idxl, const Gemm g, const StaticOrder& S, const Epi& E) {
    const int tid = opaque_tid(), wid = __builtin_amdgcn_readfirstlane(tid >> 6), lane = tid & 63, wr = wid >> 2, wc = wid & 3, fr = lane & 15, fq = lane >> 4;
    const int K = g.K, nt = K / BK;
    unsigned voffB[2];
#pragma unroll
    for (int i = 0; i < 2; ++i) { int R_, C_; stage_rc(tid * 16 + i * 8192, R_, C_); voffB[i] = (unsigned)(R_ * K + C_) * 2u; }
    const size_t kstep = (size_t)(BK * 2);
    const size_t hstep = (size_t)HALF * K * 2;
    const size_t tstep = 2 * hstep;
    const unsigned ldsw = (unsigned)wid * 1024u;
    const int aoff = lds_byte(wr * 64 + fr, fq * 8), boff = lds_byte(wc * 32 + fr, fq * 8);
    Unit cur, nxt; int ui = 0;
    if (!S.next(0, cur)) return;
#ifndef MG_STAGGER_TICKS
#define MG_STAGGER_TICKS 0
#endif
    if (MG_STAGGER_TICKS && (blockIdx.x & 8)) { const unsigned long long t0 = __builtin_amdgcn_s_memrealtime(); while (__builtin_amdgcn_s_memrealtime() - t0 < MG_STAGGER_TICKS) __builtin_amdgcn_s_sleep(16); }
    if (g.rowidx) {
        for (int i = 0; i < MAXU; ++i) { Unit u; if (!S.next(i, u)) break; if (tid < 256) idxl[i * 256 + tid] = g.rowidx[u.pm * BM + tid]; }
        asm volatile("s_waitcnt vmcnt(0) lgkmcnt(0)" ::: "memory"); __builtin_amdgcn_s_barrier(); asm volatile("" ::: "memory");
    }
#define MG_AOFFS(dst, u_, ui_) do { _Pragma("unroll") for (int i_ = 0; i_ < 2; ++i_) { int R_, C_; stage_rc(tid * 16 + i_ * 8192, R_, C_); _Pragma("unroll") for (int h_ = 0; h_ < 2; ++h_) { \
        const int rr_ = g.rowidx ? idxl[(ui_) * 256 + h_ * HALF + R_] : ((u_).pm * BM + h_ * HALF + R_); dst[h_][i_] = (unsigned)(rr_ * K + C_) * 2u; } } } while (0)
#define MG_BPTR(u_) ((const char*)g.Bt + ((size_t)(((u_).pm / g.grp_tiles) % g.ngrp) * g.grp_stride) * 2 + (size_t)(u_).pn * tstep)
#define PG8_SA(b, h) (((b) * 2 + (h)) * HTB)
#define PG8_SB(b, h) ((4 + (b) * 2 + (h)) * HTB)
#define PG8_STAGE(bufoff, gbase, voff) do { _Pragma("unroll") for (int _i = 0; _i < 2; ++_i) \
        __builtin_amdgcn_global_load_lds((const unsigned*)((const char*)(gbase) + (voff)[_i]), (LAS unsigned*)(lds + (bufoff) + ldsw + _i * 8192), 16, 0, 0); } while (0)
#define PG8_LDA(dst, b, h) do { _Pragma("unroll") for (int m = 0; m < 4; ++m) _Pragma("unroll") for (int k = 0; k < 2; ++k) dst[m][k] = *(const LAS bf16x8*)(lds + PG8_SA(b, h) + aoff + m * 2048 + k * 1024); } while (0)
#define PG8_LDB(dst, b, h) do { _Pragma("unroll") for (int n = 0; n < 2; ++n) _Pragma("unroll") for (int k = 0; k < 2; ++k) dst[n][k] = *(const LAS bf16x8*)(lds + PG8_SB(b, h) + boff + n * 2048 + k * 1024); } while (0)
#define PG8_MMA(ai, bj, At, Bt) do { __builtin_amdgcn_s_setprio(1); _Pragma("unroll") for (int m = 0; m < 4; ++m) _Pragma("unroll") for (int n = 0; n < 2; ++n) _Pragma("unroll") for (int k = 0; k < 2; ++k) \
        acc[ai][bj][m][n] = __builtin_amdgcn_mfma_f32_16x16x32_bf16(Bt[n][k], At[m][k], acc[ai][bj][m][n], 0, 0, 0); __builtin_amdgcn_s_setprio(0); } while (0)
#define PG8_WAIT_V(n) asm volatile("s_waitcnt vmcnt(" #n ")" ::: "memory")
#define PG8_WAIT_L(n) asm volatile("s_waitcnt lgkmcnt(" #n ")" ::: "memory")
#define PG8_BAR __builtin_amdgcn_s_barrier()
#define PG8_SCHED __builtin_amdgcn_sched_barrier(0)
    f32x4 acc[2][2][4][2];
#pragma unroll
    for (int a = 0; a < 2; ++a)
#pragma unroll
        for (int b = 0; b < 2; ++b)
#pragma unroll
            for (int m = 0; m < 4; ++m)
#pragma unroll
                for (int n = 0; n < 2; ++n) acc[a][b][m][n] = (f32x4){0.f, 0.f, 0.f, 0.f};
    bf16x8 At[4][2], B0[2][2], B1[2][2];
    unsigned cAo[2][2], o2[2][2];
    MG_AOFFS(cAo, cur, 0);
    const char* const Abase = (const char*)g.A;
    const char* cB = MG_BPTR(cur);
    PG8_STAGE(PG8_SB(0, 0), cB, voffB); PG8_STAGE(PG8_SB(0, 1), cB + hstep, voffB); PG8_STAGE(PG8_SA(0, 0), Abase, cAo[0]); PG8_STAGE(PG8_SA(0, 1), Abase, cAo[1]);
    if (wr == 1) PG8_BAR;
    PG8_WAIT_V(2); PG8_BAR;
    PG8_STAGE(PG8_SB(1, 0), cB + kstep, voffB); PG8_STAGE(PG8_SA(1, 0), Abase + kstep, cAo[0]); PG8_STAGE(PG8_SB(1, 1), cB + hstep + kstep, voffB);
    PG8_WAIT_V(6); PG8_BAR;
    for (;;) {
        const bool has_next = S.next(ui + 1, nxt);
        const char* nB = has_next ? MG_BPTR(nxt) : cB;
        for (int t = 0; t < nt; t += 2) {
            const bool last = (t == nt - 2);
            const char* a1 = Abase + (size_t)(t + 1) * kstep;
            const char* a2 = last ? Abase : Abase + (size_t)(t + 2) * kstep; const char* b2 = last ? nB : cB + (size_t)(t + 2) * kstep;
            const char* a3 = a2 + kstep; const char* b3 = b2 + kstep;
            if (last && has_next) { MG_AOFFS(o2, nxt, ui + 1); } else {
#pragma unroll
                for (int h = 0; h < 2; ++h)
#pragma unroll
                    for (int i = 0; i < 2; ++i) o2[h][i] = cAo[h][i]; }
            PG8_LDB(B0, 0, 0); PG8_LDB(B1, 0, 1); PG8_SCHED; PG8_LDA(At, 0, 0); PG8_STAGE(PG8_SA(1, 1), a1, cAo[1]);
            PG8_WAIT_V(8); PG8_WAIT_L(0); PG8_BAR; PG8_MMA(0, 0, At, B0); PG8_MMA(0, 1, At, B1); PG8_BAR; PG8_SCHED;
            PG8_LDA(At, 0, 1); PG8_STAGE(PG8_SB(0, 0), b2, voffB); PG8_STAGE(PG8_SB(0, 1), b2 + hstep, voffB); PG8_STAGE(PG8_SA(0, 0), a2, o2[0]);
            PG8_WAIT_V(8); PG8_WAIT_L(0); PG8_BAR; PG8_MMA(1, 0, At, B0); PG8_MMA(1, 1, At, B1); PG8_BAR; PG8_SCHED;
            PG8_LDB(B0, 1, 0); PG8_LDB(B1, 1, 1); PG8_SCHED; PG8_LDA(At, 1, 0); PG8_STAGE(PG8_SA(0, 1), a2, o2[1]);
            PG8_WAIT_V(8); PG8_WAIT_L(0); PG8_BAR; PG8_MMA(0, 0, At, B0); PG8_MMA(0, 1, At, B1); PG8_BAR; PG8_SCHED;
            PG8_LDA(At, 1, 1); PG8_STAGE(PG8_SB(1, 0), b3, voffB); PG8_STAGE(PG8_SB(1, 1), b3 + hstep, voffB); PG8_STAGE(PG8_SA(1, 0), a3, o2[0]);
            PG8_WAIT_V(8); PG8_WAIT_L(0); PG8_BAR; PG8_MMA(1, 0, At, B0); PG8_MMA(1, 1, At, B1); PG8_BAR; PG8_SCHED;
        }
        if (wr == 0) PG8_BAR;
        E(acc, cur, wr, wc, fr, fq);
        if (!has_next) break;
#pragma unroll
        for (int a = 0; a < 2; ++a)
#pragma unroll
            for (int b = 0; b < 2; ++b)
#pragma unroll
                for (int m = 0; m < 4; ++m)
#pragma unroll
                    for (int n = 0; n < 2; ++n) acc[a][b][m][n] = (f32x4){0.f, 0.f, 0.f, 0.f};
        cur = nxt; cB = nB; ++ui;
#pragma unroll
        for (int h = 0; h < 2; ++h)
#pragma unroll
            for (int i = 0; i < 2; ++i) cAo[h][i] = o2[h][i];
        if (wr == 1) PG8_BAR;
    }
    PG8_WAIT_V(0);
    PG8_BAR;
#undef MG_AOFFS
#undef MG_BPTR
#undef PG8_SA
#undef PG8_SB
#undef PG8_STAGE
#undef PG8_LDA
#undef PG8_LDB
#undef PG8_MMA
#undef PG8_WAIT_V
#undef PG8_WAIT_L
#undef PG8_BAR
#undef PG8_SCHED
}
template <class EE> struct EpiAdapt {
    EE e; int row_base;
    __device__ __forceinline__ void operator()(const f32x4 (&acc)[2][2][4][2], const Unit& u, int wr, int wc, int fr, int fq) const {
        float rv[2][4];
#pragma unroll
        for (int ai = 0; ai < 2; ++ai)
#pragma unroll
            for (int m = 0; m < 4; ++m) rv[ai][m] = e.rowval(row_base + u.pm * BM + ai * HALF + wr * 64 + m * 16 + fr);
#pragma unroll
        for (int ai = 0; ai < 2; ++ai)
#pragma unroll
            for (int m = 0; m < 4; ++m) { const int row = row_base + u.pm * BM + ai * HALF + wr * 64 + m * 16 + fr;
                e(row, u.pn, wc, fq, acc[ai][0][m][0], acc[ai][0][m][1], acc[ai][1][m][0], acc[ai][1][m][1], rv[ai][m]);
                if (m & 1) asm volatile("" ::: "memory"); }
    }
};
}

struct AttnState { float m, l; float o[32]; };
__device__ __forceinline__ void attn_init(AttnState& st) { st.m = -INFINITY; st.l = 0.f;
#pragma unroll
    for (int d = 0; d < 32; ++d) st.o[d] = 0.f; }
__device__ __forceinline__ void load_row32(const bf16_t* p, float (&r)[32], float scale) {
#pragma unroll
    for (int i = 0; i < 4; ++i) { const u32x4 w = *(const u32x4*)(p + 8 * i);
        r[8 * i + 0] = bf_lo(w.x) * scale; r[8 * i + 1] = bf_hi(w.x) * scale; r[8 * i + 2] = bf_lo(w.y) * scale; r[8 * i + 3] = bf_hi(w.y) * scale;
        r[8 * i + 4] = bf_lo(w.z) * scale; r[8 * i + 5] = bf_hi(w.z) * scale; r[8 * i + 6] = bf_lo(w.w) * scale; r[8 * i + 7] = bf_hi(w.w) * scale; }
}
__device__ __forceinline__ float dot_row32(const bf16_t* p, const float (&q)[32]) {
    float d0 = 0.f, d1 = 0.f;
#pragma unroll
    for (int i = 0; i < 4; ++i) { const u32x4 w = *(const u32x4*)(p + 8 * i);
        d0 += q[8 * i + 0] * bf_lo(w.x); d1 += q[8 * i + 1] * bf_hi(w.x); d0 += q[8 * i + 2] * bf_lo(w.y); d1 += q[8 * i + 3] * bf_hi(w.y);
        d0 += q[8 * i + 4] * bf_lo(w.z); d1 += q[8 * i + 5] * bf_hi(w.z); d0 += q[8 * i + 6] * bf_lo(w.w); d1 += q[8 * i + 7] * bf_hi(w.w); }
    const float d = d0 + d1;
    return d + __shfl_xor(d, 32);
}
__device__ __forceinline__ void axpy_row32(const bf16_t* p, float a, float (&o)[32]) {
#pragma unroll
    for (int i = 0; i < 4; ++i) { const u32x4 w = *(const u32x4*)(p + 8 * i);
        o[8 * i + 0] += a * bf_lo(w.x); o[8 * i + 1] += a * bf_hi(w.x); o[8 * i + 2] += a * bf_lo(w.y); o[8 * i + 3] += a * bf_hi(w.y);
        o[8 * i + 4] += a * bf_lo(w.z); o[8 * i + 5] += a * bf_hi(w.z); o[8 * i + 6] += a * bf_lo(w.w); o[8 * i + 7] += a * bf_hi(w.w); }
}
template <class ScoreFn>
__device__ __forceinline__ void attn_segment(const float (&q)[32], AttnState& st, const bf16_t* Kb, const bf16_t* Vb, int j0, int j1, ScoreFn sf) {
#pragma unroll 1
    for (int j = j0; j < j1; ++j) {
        const float s0 = sf(j, dot_row32(Kb + (size_t)j * INW, q));
        if (s0 > st.m) { const float corr = __expf(st.m - s0); st.l *= corr;
#pragma unroll
            for (int d = 0; d < 32; ++d) st.o[d] *= corr;
            st.m = s0; }
        const float p0 = (s0 == -INFINITY) ? 0.f : __expf(s0 - st.m);
        st.l += p0;
        axpy_row32(Vb + (size_t)j * INW, p0, st.o);
    }
}
__device__ __forceinline__ void attn_sink(AttnState& st, float sk) {
    if (sk > st.m) { const float corr = __expf(st.m - sk); st.l *= corr;
#pragma unroll
        for (int d = 0; d < 32; ++d) st.o[d] *= corr;
        st.m = sk; }
    st.l += __expf(sk - st.m);
}
__device__ __forceinline__ void attn_store(const AttnState& st, bf16_t* o) {
    const float inv = 1.f / st.l;
#pragma unroll
    for (int i = 0; i < 4; ++i) { u32x4 w; w.x = pk2(st.o[8 * i] * inv, st.o[8 * i + 1] * inv); w.y = pk2(st.o[8 * i + 2] * inv, st.o[8 * i + 3] * inv);
        w.z = pk2(st.o[8 * i + 4] * inv, st.o[8 * i + 5] * inv); w.w = pk2(st.o[8 * i + 6] * inv, st.o[8 * i + 7] * inv); *(u32x4*)(o + 8 * i) = w; }
}

__device__ __forceinline__ void phase_mixers(const Params& p, int l, bool with_ctx, int bid, int nb) {
    bid = opaque_s(bid); const int tid = opaque_tid(); const int lane = tid & 63, gw = bid * NWAVES + (tid >> 6), NGW = nb * NWAVES;
    const int ql = lane & 31, hf = lane >> 5;
    const bf16_t* PB = (const bf16_t*)(p.ws + WS_PB); bf16_t* OB = (bf16_t*)(p.ws + WS_OB);
    const float* sink = p.attn_sink + l * 6; const float* rpb = p.na_rpb + (size_t)l * 6 * 15 * 31;
#if !FAST_ATTN
#pragma unroll 1
    for (int it = gw; it < NB * 6 * 256; it += NGW) {
        const int chunk = it & 255, h = (it >> 8) % 6, b = it / (6 * 256), kvh = h / 3;
        const int t = chunk * 32 + ql; const size_t rowb = (size_t)b * SEQ;
        float q[32]; load_row32(PB + (rowb + t) * INW + C_QA + h * 64 + 32 * hf, q, 0.125f);
        AttnState st; attn_init(st);
        const int jlo = max(0, chunk * 32 - 128), jhi = min(SEQ, chunk * 32 + 32 + 128);
        attn_segment(q, st, PB + rowb * INW + C_KA + kvh * 64 + 32 * hf, PB + rowb * INW + C_VA + kvh * 64 + 32 * hf, jlo, jhi,
                     [&](int j, float d) { const int dt = t - j; return (dt <= 128 && dt >= -128) ? d : -INFINITY; });
        const size_t crow = (size_t)NLAT + (size_t)b * CTXL;
        attn_segment(q, st, PB + crow * INW + C_KA + kvh * 64 + 32 * hf, PB + crow * INW + C_VA + kvh * 64 + 32 * hf, 0, CTXL, [&](int, float d) { return d; });
        attn_sink(st, sink[h]);
        attn_store(st, OB + (rowb + t) * DM + h * 64 + 32 * hf);
    }
#pragma unroll 1
    for (int it = gw; it < NB * 6 * 256; it += NGW) {
        const int r = (it & 255) >> 1, ch = it & 1, h = (it >> 8) % 6, b = it / (6 * 256);
        const int cq = ch * 32 + ql; const size_t rowb = (size_t)b * SEQ; const int t = r * 64 + cq;
        float q[32]; load_row32(PB + (rowb + t) * INW + C_QN + h * 64 + 32 * hf, q, 0.125f);
        AttnState st; attn_init(st);
        const int rs = min(max(r - 4, 0), 128 - 8), cs = min(max(cq - 8, 0), 64 - 16);
        const float* bias = rpb + (size_t)h * 15 * 31;
        attn_segment(q, st, PB + (rowb + (size_t)rs * 64) * INW + C_KN + h * 64 + 32 * hf, PB + (rowb + (size_t)rs * 64) * INW + C_VN + h * 64 + 32 * hf, 0, 512,
                     [&](int j, float d) { const int ka = rs + (j >> 6), ck = j & 63; const bool ok = (ck >= cs) && (ck < cs + 16);
                                           const int ro = ka - r + 7, co = min(max(ck - cq, -15), 15) + 15; return ok ? d + bias[ro * 31 + co] : -INFINITY; });
        const size_t crow = (size_t)NLAT + (size_t)b * CTXL;
        attn_segment(q, st, PB + crow * INW + C_KN + h * 64 + 32 * hf, PB + crow * INW + C_VN + h * 64 + 32 * hf, 0, CTXL, [&](int, float d) { return d; });
        attn_store(st, OB + (rowb + t) * DM + 640 + h * 64 + 32 * hf);
    }
#endif
    {
        const float* cw = p.conv_w + (size_t)l * 3 * 256;
        const int nrows = with_ctx ? NROWS : NLAT;
        for (long e = (long)bid * NTHREADS + tid; e < (long)nrows * 32; e += (long)nb * NTHREADS) {
            const int row = (int)(e >> 5), ch = (int)(e & 31) * 8;
            const int tpos = row < NLAT ? (row & (SEQ - 1)) : ((row - NLAT) & (CTXL - 1)); const int tlen = row < NLAT ? SEQ : CTXL;
            const bf16_t* pr = PB + (size_t)row * INW;
            float u[3][8];
#pragma unroll
            for (int dlt = -1; dlt <= 1; ++dlt) {
                const bool ok = (tpos + dlt >= 0) && (tpos + dlt < tlen);
                if (ok) { const u32x4 a = *(const u32x4*)(pr + (long)dlt * INW + C_BX + ch), c = *(const u32x4*)(pr + (long)dlt * INW + C_BC + ch);
                    u[dlt + 1][0] = bf_lo(a.x) * bf_lo(c.x); u[dlt + 1][1] = bf_hi(a.x) * bf_hi(c.x); u[dlt + 1][2] = bf_lo(a.y) * bf_lo(c.y); u[dlt + 1][3] = bf_hi(a.y) * bf_hi(c.y);
                    u[dlt + 1][4] = bf_lo(a.z) * bf_lo(c.z); u[dlt + 1][5] = bf_hi(a.z) * bf_hi(c.z); u[dlt + 1][6] = bf_lo(a.w) * bf_lo(c.w); u[dlt + 1][7] = bf_hi(a.w) * bf_hi(c.w); }
                else {
#pragma unroll
                    for (int i = 0; i < 8; ++i) u[dlt + 1][i] = 0.f; }
            }
            const u32x4 gb = *(const u32x4*)(pr + C_BB + ch);
            const float g[8] = {bf_lo(gb.x), bf_hi(gb.x), bf_lo(gb.y), bf_hi(gb.y), bf_lo(gb.z), bf_hi(gb.z), bf_lo(gb.w), bf_hi(gb.w)};
            float y[8];
#pragma unroll
            for (int i = 0; i < 8; ++i) y[i] = g[i] * (u[0][i] * cw[ch + i] + u[1][i] * cw[256 + ch + i] + u[2][i] * cw[512 + ch + i]);
            u32x4 o; o.x = pk2(y[0], y[1]); o.y = pk2(y[2], y[3]); o.z = pk2(y[4], y[5]); o.w = pk2(y[6], y[7]);
            *(u32x4*)(OB + (size_t)row * DM + 384 + ch) = o;
        }
    }
#if !FAST_ATTN
    if (with_ctx) {
#pragma unroll 1
        for (int it = gw; it < 2 * NB * 6 * 8; it += NGW) {
            const int kind = it / (NB * 6 * 8), r = it % (NB * 6 * 8), chunk = r & 7, h = (r >> 3) % 6, b = r / 48;
            const size_t crow = (size_t)NLAT + (size_t)b * CTXL; const int tq = chunk * 32 + ql;
            const int qc = (kind == 0 ? C_QA + h * 64 : C_QN + h * 64) + 32 * hf, kc = (kind == 0 ? C_KA + (h / 3) * 64 : C_KN + h * 64) + 32 * hf, vc = (kind == 0 ? C_VA + (h / 3) * 64 : C_VN + h * 64) + 32 * hf;
            float q[32]; load_row32(PB + (crow + tq) * INW + qc, q, 0.125f);
            AttnState st; attn_init(st);
            attn_segment(q, st, PB + crow * INW + kc, PB + crow * INW + vc, 0, CTXL, [&](int, float d) { return d; });
            if (kind == 0) attn_sink(st, sink[h]);
            attn_store(st, OB + (crow + tq) * DM + (kind == 0 ? 0 : 640) + h * 64 + 32 * hf);
        }
    }
#endif
}

namespace fa {
typedef short v4i16_t __attribute__((ext_vector_type(4)));
typedef float f32x2_t __attribute__((ext_vector_type(2))); typedef __bf16 bf16x2_t __attribute__((ext_vector_type(2)));
__device__ __forceinline__ unsigned cvtpk(float lo, float hi) { f32x2_t v = {lo, hi}; bf16x2_t b = __builtin_convertvector(v, bf16x2_t); return __builtin_bit_cast(unsigned, b); }
constexpr float LOG2E = 1.4426950408889634f, SC = 0.125f * LOG2E;
constexpr int CHUNK_BYTES = 32768;
constexpr int BIAS_OFF = 3 * CHUNK_BYTES;
constexpr float THR = 8.f;
__device__ __forceinline__ int na_rs(int r) { return min(max(r - 4, 0), 128 - 8); }
__device__ __forceinline__ void glds16(const void* gsrc, unsigned lds_dst) { unsigned keep;
    asm volatile("s_mov_b32 %0, m0\n\ts_mov_b32 m0, %2\n\ts_nop 0\n\tglobal_load_lds_dwordx4 %1, off\n\ts_mov_b32 m0, %0" : "=&s"(keep) : "v"(gsrc), "s"(lds_dst) : "memory"); }
#define FA_WAIT_BAR(N) asm volatile("s_waitcnt vmcnt(" #N ") lgkmcnt(0)\n\ts_barrier" ::: "memory")
__device__ __forceinline__ float max3f(float a, float b, float c) { float r; asm("v_max3_f32 %0, %1, %2, %3" : "=v"(r) : "v"(a), "v"(b), "v"(c)); return r; }
__device__ __forceinline__ float max8f(const f32x4& a, const f32x4& b) { return max3f(max3f(max3f(a[0], a[1], a[2]), a[3], b[0]), max3f(b[1], b[2], b[3]), -INFINITY); }
typedef float f32x16 __attribute__((ext_vector_type(16)));
__device__ __forceinline__ float max16f(const f32x16& a) {
    float x = max3f(a[0], a[1], a[2]); x = max3f(x, a[3], a[4]); x = max3f(x, a[5], a[6]); x = max3f(x, a[7], a[8]); x = max3f(x, a[9], a[10]); x = max3f(x, a[11], a[12]); x = max3f(x, a[13], a[14]);
    return fmaxf(x, a[15]);
}
typedef float f32x2v __attribute__((ext_vector_type(2)));
template <int MODE>
__device__ __forceinline__ void unit32(f32x16 (&o)[2], float& m, float& ls, const bf16x8 (&q)[4], const LAS unsigned char* Kt0, const LAS unsigned char* Kt1, const LAS unsigned char* Vt0, const LAS unsigned char* Vt1,
                                       const int (&kb)[4], const int (&vb)[2], bool rel0, bool rel1, bool mk0, bool mk1, int tb0, int tb1, const f32x16& fmask, const LAS float* bp0, const LAS float* bp1) {
    f32x16 s[2]; float tm = -INFINITY;
#pragma unroll
    for (int t = 0; t < 2; ++t) {
        if (!(t == 0 ? rel0 : rel1)) continue;
        const LAS unsigned char* Kt = t == 0 ? Kt0 : Kt1;
        bf16x8 kf[4];
#pragma unroll
        for (int ks = 0; ks < 4; ++ks) kf[ks] = *(const LAS bf16x8*)(Kt + kb[ks]);
        f32x16 acc = __builtin_amdgcn_mfma_f32_32x32x16_bf16(kf[0], q[0], (f32x16){0.f, 0.f, 0.f, 0.f, 0.f, 0.f, 0.f, 0.f, 0.f, 0.f, 0.f, 0.f, 0.f, 0.f, 0.f, 0.f}, 0, 0, 0);
#pragma unroll
        for (int ks = 1; ks < 4; ++ks) acc = __builtin_amdgcn_mfma_f32_32x32x16_bf16(kf[ks], q[ks], acc, 0, 0, 0);
        if (MODE == 2) {
            const LAS float* bp = t == 0 ? bp0 : bp1;
#pragma unroll
            for (int r = 0; r < 16; ++r) acc[r] = __builtin_fmaf(acc[r], SC, bp[(r & 3) + 8 * (r >> 2)]) + fmask[r];
        } else {
            if (MODE == 1 && (t == 0 ? mk0 : mk1)) { const int tb = t == 0 ? tb0 : tb1;
#pragma unroll
                for (int r = 0; r < 16; ++r) acc[r] = ((unsigned)(tb - ((r & 3) + 8 * (r >> 2))) <= 256u) ? acc[r] : -INFINITY;
            } else asm volatile("s_nop 15\n\ts_nop 7" : "+v"(acc));
        }
        s[t] = acc;
        tm = fmaxf(tm, max16f(acc));
    }
    if (MODE != 2) tm *= SC;
    if (__any(tm > m + THR)) {
        const float mn = fmaxf(m, xor32_max(tm)), al = __builtin_amdgcn_exp2f(m - mn); m = mn; ls *= al;
#pragma unroll
        for (int d = 0; d < 2; ++d) o[d] = o[d] * al;
    }
    const float nm = -m; f32x2v ps2 = {0.f, 0.f};
#pragma unroll
    for (int t = 0; t < 2; ++t) {
        if (!(t == 0 ? rel0 : rel1)) continue;
        const LAS unsigned char* Vt = t == 0 ? Vt0 : Vt1;
        f32x16 pv = MODE == 2 ? s[t] + nm : s[t] * SC + nm;
#pragma unroll
        for (int r = 0; r < 16; ++r) pv[r] = __builtin_amdgcn_exp2f(pv[r]);
#pragma unroll
        for (int r = 0; r < 16; r += 2) ps2 += (f32x2v){pv[r], pv[r + 1]};
#pragma unroll
        for (int st = 0; st < 2; ++st) {
            u32x4 pw; pw.x = cvtpk(pv[8 * st + 0], pv[8 * st + 1]); pw.y = cvtpk(pv[8 * st + 2], pv[8 * st + 3]); pw.z = cvtpk(pv[8 * st + 4], pv[8 * st + 5]); pw.w = cvtpk(pv[8 * st + 6], pv[8 * st + 7]);
            const bf16x8 pb = __builtin_bit_cast(bf16x8, pw);
#pragma unroll
            for (int db = 0; db < 2; ++db) {
                const v4i16_t t0 = __builtin_amdgcn_ds_read_tr16_b64_v4i16((LAS v4i16_t*)(Vt + st * 2048 + vb[db])), t1 = __builtin_amdgcn_ds_read_tr16_b64_v4i16((LAS v4i16_t*)(Vt + st * 2048 + 1024 + vb[db]));
                const bf16x8 vf = (bf16x8){t0[0], t0[1], t0[2], t0[3], t1[0], t1[1], t1[2], t1[3]};
                o[db] = __builtin_amdgcn_mfma_f32_32x32x16_bf16(vf, pb, o[db], 0, 0, 0);
            }
        }
    }
    ls += ps2[0] + ps2[1];
}
template <int KIND>
__device__ __forceinline__ void attn_item(const Params& p, int l, int item, LAS unsigned char* lds, int tid) {
    constexpr bool ISA = (KIND == 0 || KIND == 2);
    constexpr int NG = ISA ? 2 : 1;
    const int lane = tid & 63, w = __builtin_amdgcn_readfirstlane(tid >> 6), ql = lane & 31, hh = lane >> 5;
    const bf16_t* PB = (const bf16_t*)(p.ws + WS_PB); bf16_t* OB = (bf16_t*)(p.ws + WS_OB);
    int b, hx, blk;
    if (KIND == 0) { b = item >> 7; hx = (item >> 6) & 1; blk = item & 63; }
    else if (KIND == 1) { b = item / 192; hx = (item >> 5) % 6; blk = item & 31; }
    else if (KIND == 2) { b = item >> 2; hx = (item >> 1) & 1; blk = item & 1; }
    else { b = item / 6; hx = item % 6; blk = 0; }
    const size_t rowb = (size_t)b * SEQ, ctxb = (size_t)NLAT + (size_t)b * CTXL;
    const int kcol = ISA ? C_KA + hx * 64 : C_KN + hx * 64, vcol = ISA ? C_VA + hx * 64 : C_VN + hx * 64;
    int nwin = 0; size_t winrow0 = 0; int winpos0 = 0, krs0 = 0;
    if (KIND == 0) { const int first = blk == 0 ? 1 : 0, last = blk == 63 ? 2 : 3; nwin = last - first; winpos0 = 128 * (blk - 1 + first); winrow0 = rowb + winpos0; }
    if (KIND == 1) { krs0 = na_rs(4 * blk); nwin = (na_rs(4 * blk + 3) + 8 - krs0 + 1) >> 1; winrow0 = rowb + (size_t)krs0 * 64; }
    const int nch = nwin + 2;
    const bool active = true;
    int gh[NG], gp0[NG];
#pragma unroll
    for (int gi = 0; gi < NG; ++gi) {
        const int G = ISA ? (w < 4 ? 2 * w + gi : 8 + (w - 4)) : w;
        if (ISA) { gh[gi] = 3 * hx + (G >> 2); gp0[gi] = 128 * blk + 32 * (G & 3); }
        else if (KIND == 1) { gh[gi] = hx; gp0[gi] = 16 * (G & 3); }
        else { gh[gi] = hx; gp0[gi] = 32 * G; }
    }
    const int nrow0 = 4 * blk + 2 * (w >> 2);
    const int nrq = nrow0 + (ql >> 4), ncq = gp0[0] + (ql & 15);
#define FA_QROW(gi, ql_) (KIND == 0 ? rowb + gp0[gi] + (ql_) : KIND == 2 ? ctxb + gp0[gi] + (ql_) : KIND == 1 ? rowb + (size_t)(nrow0 + ((ql_) >> 4)) * 64 + gp0[gi] + ((ql_) & 15) : ctxb + gp0[gi] + (ql_))
    const int skey = 8 * w + (lane >> 3), spc = lane & 7;
    const int ksrc = skey * INW + kcol + ((spc ^ ((skey >> 1) & 7)) << 3);
    const int vsrc = skey * INW + vcol + (((((spc >> 1) ^ (skey & 2)) << 1) | (spc & 1)) << 3);
    const unsigned lds0 = (unsigned)(uintptr_t)lds;
    const int noff = KIND == 1 ? ((gp0[0] >> 4) == 0 ? 0 : ((gp0[0] >> 4) == 1 ? 8 : ((gp0[0] >> 4) == 2 ? 24 : 32))) : 0;
    int kb[4], kbw[4], vb[2];
#pragma unroll
    for (int ks = 0; ks < 4; ++ks) { kb[ks] = ql * 128 + (((2 * ks + hh) ^ ((ql >> 1) & 7)) << 4); kbw[ks] = ql * 128 + (((2 * ks + hh) ^ (((noff + ql) >> 1) & 7)) << 4); }
    { const int vk = 4 * hh + ((lane & 15) >> 2);
#pragma unroll
      for (int db = 0; db < 2; ++db) vb[db] = vk * 128 + (((2 * db + ((lane >> 4) & 1)) ^ (vk & 2)) << 5) + ((lane & 3) << 3); }
#define FA_DMA(ci) do { const size_t r0_ = (ci) < nwin ? winrow0 + (size_t)(ci) * 128 : ctxb + (size_t)((ci) - nwin) * 128; const bf16_t* s_ = PB + r0_ * INW; \
        const unsigned d_ = (unsigned)__builtin_amdgcn_readfirstlane((int)(lds0 + ((ci) % 3) * CHUNK_BYTES + w * 1024)); \
        glds16(s_ + ksrc, d_); glds16(s_ + 64 * INW + ksrc, d_ + 8192u); glds16(s_ + vsrc, d_ + 16384u); glds16(s_ + 64 * INW + vsrc, d_ + 24576u); } while (0)
    FA_DMA(0); FA_DMA(1);
    bf16x8 qf[NG][4];
#pragma unroll
    for (int gi = 0; gi < NG; ++gi)
#pragma unroll
        for (int ks = 0; ks < 4; ++ks) qf[gi][ks] = *(const bf16x8*)(PB + FA_QROW(gi, ql) * INW + (ISA ? C_QA : C_QN) + gh[gi] * 64 + 16 * ks + 8 * hh);
    f32x16 o[NG][2]; float m[NG], ls[NG];
#pragma unroll
    for (int gi = 0; gi < NG; ++gi) {
#pragma unroll
        for (int d = 0; d < 2; ++d)
#pragma unroll
            for (int r = 0; r < 16; ++r) o[gi][d][r] = 0.f;
        if (ISA) { m[gi] = p.attn_sink[l * 6 + gh[gi]] * LOG2E; ls[gi] = hh == 0 ? 1.f : 0.f; } else { m[gi] = -1e30f; ls[gi] = 0.f; }
    }
    f32x16 fmask;
#pragma unroll
    for (int r = 0; r < 16; ++r) fmask[r] = 0.f;
    if (KIND == 1) { const int cs = min(max(ncq - 8, 0), 48);
#pragma unroll
        for (int r = 0; r < 16; ++r) { const int ck = noff + (r & 3) + 8 * (r >> 2) + 4 * hh; fmask[r] = ((ck >= cs) && (ck < cs + 16)) ? 0.f : -INFINITY; } }
    const int nqrs = na_rs(nrq);
    LAS float* biasL = (LAS float*)(lds + BIAS_OFF);
    if (KIND == 1) { const float* rp = p.na_rpb + ((size_t)l * 6 + hx) * 15 * 31;
        for (int i = tid; i < 16 * 128; i += NTHREADS) { const int x = (i & 127) - 64; biasL[i] = (i >> 7) == 15 ? -INFINITY : ((x >= -15 && x <= 15) ? rp[(i >> 7) * 31 + x + 15] * LOG2E : 0.f); } }
    FA_WAIT_BAR(4);
#pragma unroll
    for (int gi = 0; gi < NG; ++gi) { asm volatile("" : "+v"(qf[gi][0]), "+v"(qf[gi][1]), "+v"(qf[gi][2]), "+v"(qf[gi][3])); }
#pragma unroll 1
    for (int ci = 0; ci < nch; ++ci) {
        if (ci + 2 < nch) FA_DMA(ci + 2);
        const LAS unsigned char* Kb = lds + (ci % 3) * CHUNK_BYTES; const LAS unsigned char* Vb = Kb + 16384;
        const bool iswin = ci < nwin;
        if (active) {
            if (KIND == 1 && iswin) {
                const int kr0 = krs0 + 2 * ci, rsA = na_rs(nrow0), rsB = na_rs(nrow0 + 1);
                const bool rel0 = (kr0 >= rsA) && (kr0 < rsB + 8), rel1 = (kr0 + 1 >= rsA) && (kr0 + 1 < rsB + 8);
                if (rel0 || rel1) {
                    const bool rowok0 = (kr0 >= nqrs) && (kr0 < nqrs + 8), rowok1 = (kr0 + 1 >= nqrs) && (kr0 + 1 < nqrs + 8);
                    const int bcol = 64 + noff + 4 * hh - ncq;
                    const LAS float* bp0 = biasL + (rowok0 ? kr0 - nrq + 7 : 15) * 128 + bcol; const LAS float* bp1 = biasL + (rowok1 ? kr0 + 1 - nrq + 7 : 15) * 128 + bcol;
                    unit32<2>(o[0], m[0], ls[0], qf[0], Kb + noff * 128, Kb + (64 + noff) * 128, Vb + noff * 128, Vb + (64 + noff) * 128, kbw, vb, rel0, rel1, false, false, 0, 0, fmask, bp0, bp1);
                }
            } else {
#pragma unroll 1
                for (int u = 0; u < 2; ++u) {
                    const LAS unsigned char* Kt = Kb + (64 * u) * 128; const LAS unsigned char* Vt = Vb + (64 * u) * 128;
#pragma unroll
                    for (int gi = 0; gi < NG; ++gi) {
                        if (ISA && gi == 1 && w >= 4) continue;
                        if (KIND == 0) {
                            bool rel[2] = {true, true}, msk[2] = {false, false};
                            if (iswin) {
#pragma unroll
                                for (int t = 0; t < 2; ++t) { const int j0 = winpos0 + 128 * ci + 64 * u + 32 * t, p0 = gp0[gi];
                                    rel[t] = (j0 + 31 >= p0 - 128) && (j0 <= p0 + 31 + 128); msk[t] = !((j0 >= p0 + 31 - 128) && (j0 + 31 <= p0 + 128)); } }
                            if (!(rel[0] || rel[1])) continue;
                            const int tb0 = gp0[gi] + ql - (winpos0 + 128 * ci + 64 * u) - 4 * hh + 128;
                            unit32<1>(o[gi], m[gi], ls[gi], qf[gi], Kt, Kt + 4096, Vt, Vt + 4096, kb, vb, rel[0], rel[1], msk[0], msk[1], tb0, tb0 - 32, fmask, nullptr, nullptr);
                        } else unit32<0>(o[gi], m[gi], ls[gi], qf[gi], Kt, Kt + 4096, Vt, Vt + 4096, kb, vb, true, true, false, false, 0, 0, fmask, nullptr, nullptr);
                    }
                }
            }
        }
        if (ci + 2 < nch) FA_WAIT_BAR(4); else FA_WAIT_BAR(0);
    }
#undef FA_DMA
    if (active) {
        int ql2 = lane & 31; asm volatile("" : "+v"(ql2));
#pragma unroll
        for (int gi = 0; gi < NG; ++gi) {
            if (ISA && gi == 1 && w >= 4) continue;
            const float lt = xor32_sum(ls[gi]);
            const float inv = 1.f / lt;
            bf16_t* op = OB + FA_QROW(gi, ql2) * DM + (ISA ? 0 : 640) + gh[gi] * 64 + 4 * hh;
#pragma unroll
            for (int db = 0; db < 2; ++db)
#pragma unroll
                for (int i = 0; i < 4; ++i) { u32x2 ov; ov.x = cvtpk(o[gi][db][4 * i] * inv, o[gi][db][4 * i + 1] * inv); ov.y = cvtpk(o[gi][db][4 * i + 2] * inv, o[gi][db][4 * i + 3] * inv); *(u32x2*)(op + 32 * db + 8 * i) = ov; }
        }
    }
#undef FA_QROW
}
__device__ __forceinline__ void phase_attn(const Params& p, int l, bool with_ctx, LAS unsigned char* lds, int bid, int nb) {
    bid = opaque_s(bid);
    const int n0 = NB * 2 * 64, n1 = NB * 6 * 32, n2 = with_ctx ? NB * 2 * 2 : 0, n3 = with_ctx ? NB * 6 : 0;
#pragma unroll 1
    for (int it = bid; it < n0 + n1 + n2 + n3; it += nb) {
        const int tid = opaque_tid();
#ifndef KMASK
#define KMASK 15
#endif
#ifndef ATT_DUP
#define ATT_DUP 0
#endif
        if (it < n0) { if (KMASK & 1) attn_item<0>(p, l, it, lds, tid); if (ATT_DUP & 1) attn_item<0>(p, l, it, lds, tid); }
        else if (it < n0 + n1) { if (KMASK & 2) attn_item<1>(p, l, it - n0, lds, tid); if (ATT_DUP & 2) attn_item<1>(p, l, it - n0, lds, tid); }
        else if (it < n0 + n1 + n2) { if (KMASK & 4) attn_item<2>(p, l, it - n0 - n1, lds, tid); }
        else { if (KMASK & 8) attn_item<3>(p, l, it - n0 - n1 - n2, lds, tid); }
    }
}
}

__device__ __forceinline__ float reduce16(const float (&t)[16], int lane) {
    float u[8], w4[4], x2[2];
#pragma unroll
    for (int e = 0; e < 8; ++e) { float a = t[e], b = t[e + 8]; asm volatile("s_nop 1\n\tv_permlane32_swap_b32 %0, %1" : "+v"(a), "+v"(b)); u[e] = a + b; }
#pragma unroll
    for (int e = 0; e < 4; ++e) { float a = u[e], b = u[e + 4]; asm volatile("s_nop 1\n\tv_permlane16_swap_b32 %0, %1" : "+v"(a), "+v"(b)); w4[e] = a + b; }
    const bool b3 = (lane & 8) != 0, b2 = (lane & 4) != 0;
#pragma unroll
    for (int e = 0; e < 2; ++e) { const float keep = b3 ? w4[e + 2] : w4[e], send = b3 ? w4[e] : w4[e + 2]; x2[e] = keep + dppf<0x128>(send); }
    const float keep = b2 ? x2[1] : x2[0], send = b2 ? x2[0] : x2[1];
    float y = keep + dppf<0x141>(send);
    y += dppf<0xB1>(y); y += dppf<0x4E>(y);
    return y;
}
__device__ __forceinline__ float wave_max(float v) {
    v = fmaxf(v, dppf<0xB1>(v)); v = fmaxf(v, dppf<0x4E>(v)); v = fmaxf(v, dppf<0x141>(v)); v = fmaxf(v, dppf<0x140>(v));
    return xor32_max(xor16_max(v));
}
__device__ __forceinline__ void phase_ln_router(const Params& p, int l, bool with_ctx, LAS unsigned char* lds, int bid, int nb) {
    bid = opaque_s(bid); const int tid = opaque_tid(), lane = tid & 63, gw = bid * NWAVES + (tid >> 6), NGW = nb * NWAVES;
    LAS float* wr = (LAS float*)lds;
    const float* wrg = p.w_router + (size_t)l * DM * NE;
    for (int i = tid; i < DM * NE; i += NTHREADS) { const int c = i >> 4, e = i & 15; wr[e * DM + c] = wrg[i]; }
    LAS float* lg = wr + NE * DM; LAS float* lb = lg + DM; LAS float* lsh = lb + DM; LAS float* lsc = lsh + 5 * DM;
    lds_fill(lg, p.ln1_g + l * DM, DM, tid); lds_fill(lb, p.ln1_b + l * DM, DM, tid);
    for (int r = 0; r < 5; ++r) { lds_fill(lsh + r * DM, mod_ptr(p, l, r) + 3 * DM, DM, tid); lds_fill(lsc + r * DM, mod_ptr(p, l, r) + 4 * DM, DM, tid); }
    __syncthreads();
    const bf16_t* XB = (const bf16_t*)(p.ws + WS_XB); bf16_t* HB = (bf16_t*)(p.ws + WS_HB); float* AFF = (float*)(p.ws + WS_AFF);
    const float* g = p.ln1_g + l * DM; const float* bb = p.ln1_b + l * DM;
    const int nrows = with_ctx ? NROWS : NLAT;
    int myexp; { float idx[16];
#pragma unroll
        for (int e = 0; e < 16; ++e) idx[e] = (float)e;
        myexp = (int)(reduce16(idx, lane) * (1.f / 64.f) + 0.5f); }
    f32x4 v[4], vn[4];
    if (gw < nrows) row_load_bf16(XB + (size_t)gw * DM, lane, v);
#pragma unroll 1
    for (int row = gw; row < nrows; row += NGW) {
        const int rn = row + NGW;
        if (rn < nrows) row_load_bf16(XB + (size_t)rn * DM, lane, vn);
        row_normalize(v); row_affine_l(v, lg, lb, lane);
        row_normalize(v);
        { const int mr = row_modrow(row); row_modulate_l(v, lsh + mr * DM, lsc + mr * DM, lane); }
        row_store_bf16(HB + (size_t)row * DM, lane, v);
        float t[16];
#pragma unroll
        for (int e = 0; e < 16; ++e) { float s = 0.f;
#pragma unroll
            for (int j = 0; j < 4; ++j) { const f32x4 wv = *(const LAS f32x4*)(wr + e * DM + 256 * j + 4 * lane); s += (v[j][0] * wv[0] + v[j][1] * wv[1]) + (v[j][2] * wv[2] + v[j][3] * wv[3]); }
            t[e] = s;
            if ((e & 3) == 3) asm volatile("" ::: "memory"); }
        const float lg = reduce16(t, lane);
        const float mx = wave_max(lg), ex = expf(lg - mx), sum = wave_sum(ex) * 0.25f;
        if ((lane & 3) == 0) AFF[(size_t)myexp * NROWS + row] = ex / sum;
#pragma unroll
        for (int j = 0; j < 4; ++j) v[j] = vn[j];
    }
}

__device__ __forceinline__ void topk_item(const float* aff  , int n, int k, int row0  , int e, int slot0,
                                          int* TOK, float* GATE, int* INV, LAS unsigned char* lds) {
    const int tid = opaque_tid(), lane = tid & 63, w = tid >> 6;
    LAS unsigned* keys = (LAS unsigned*)lds;
    LAS unsigned* hist = keys + 8192;
    LAS unsigned* misc = hist + 256;
    for (int i = tid; i < n; i += NTHREADS) keys[i] = __builtin_bit_cast(unsigned, aff[i]);
    if (tid == 0) { misc[0] = 0u; misc[1] = (unsigned)k; }
    __syncthreads();
    unsigned maskv = 0u;
    for (int pass = 0; pass < 4; ++pass) {
        const int shift = 24 - 8 * pass;
        if (tid < 256) hist[tid] = 0u;
        __syncthreads();
        const unsigned prefix = misc[0];
        for (int i = tid; i < n; i += NTHREADS) { const unsigned kv = keys[i]; if ((kv & maskv) == prefix) atomicAdd((unsigned*)&hist[(kv >> shift) & 255u], 1u); }
        __syncthreads();
        if (w == 0) {
            const unsigned rem = misc[1];
            const unsigned h0 = hist[4 * lane], h1 = hist[4 * lane + 1], h2 = hist[4 * lane + 2], h3 = hist[4 * lane + 3], s4 = h0 + h1 + h2 + h3;
            unsigned S = s4;
#pragma unroll
            for (int o = 1; o < 64; o <<= 1) { const unsigned y = __shfl_down(S, o); if (lane + o < 64) S += y; }
            const unsigned above = S - s4;
            if (above < rem && rem <= S) { unsigned cum = above; int bin;
                if (cum + h3 >= rem) bin = 3; else { cum += h3; if (cum + h2 >= rem) bin = 2; else { cum += h2; if (cum + h1 >= rem) bin = 1; else { cum += h1; bin = 0; } } }
                misc[0] = prefix | ((unsigned)(4 * lane + bin) << shift); misc[1] = rem - cum; }
        }
        __syncthreads();
        maskv |= 255u << shift;
    }
    const unsigned T = misc[0], need_eq = misc[1];
    __syncthreads();
    const int per = n >= NTHREADS ? n / NTHREADS : 1; const int t0 = tid * per; const bool act = t0 < n;
    unsigned ce = 0u;
    if (act) for (int i = 0; i < per; ++i) ce += (keys[t0 + i] == T) ? 1u : 0u;
    unsigned inc = ce;
#pragma unroll
    for (int o = 1; o < 64; o <<= 1) { const unsigned y = __shfl_up(inc, o); if (lane >= o) inc += y; }
    if (lane == 63) misc[16 + w] = inc;
    __syncthreads();
    unsigned base = 0u;
    for (int ww = 0; ww < w; ++ww) base += misc[16 + ww];
    unsigned eqrank = base + inc - ce;
    __syncthreads();
    unsigned cs = 0u;
    if (act) { unsigned er = eqrank; for (int i = 0; i < per; ++i) { const unsigned kv = keys[t0 + i]; if (kv > T) cs++; else if (kv == T) { if (er < need_eq) cs++; er++; } } }
    inc = cs;
#pragma unroll
    for (int o = 1; o < 64; o <<= 1) { const unsigned y = __shfl_up(inc, o); if (lane >= o) inc += y; }
    if (lane == 63) misc[16 + w] = inc;
    __syncthreads();
    base = 0u;
    for (int ww = 0; ww < w; ++ww) base += misc[16 + ww];
    unsigned pos = base + inc - cs;
    if (act) { unsigned er = eqrank; for (int i = 0; i < per; ++i) { const unsigned kv = keys[t0 + i]; bool sel = false;
            if (kv > T) sel = true; else if (kv == T) { sel = er < need_eq; er++; }
            const int row = row0 + t0 + i;
            if (sel) { const int slot = slot0 + (int)pos; TOK[slot] = row; GATE[slot] = __builtin_bit_cast(float, kv); INV[(size_t)e * NROWS + row] = slot; pos++; }
            else INV[(size_t)e * NROWS + row] = -1; } }
    __syncthreads();
}
__device__ __forceinline__ void phase_topk(const Params& p, bool with_ctx, LAS unsigned char* lds, int bid, int nb) {
    const float* AFF = (const float*)(p.ws + WS_AFF); int* TOK = (int*)(p.ws + WS_TOK); float* GATE = (float*)(p.ws + WS_GATE); int* INV = (int*)(p.ws + WS_INV);
    const int nitems = with_ctx ? 128 : 64;
    for (int it = bid; it < nitems; it += nb) {
        if (it < 64) { const int b = it >> 4, e = it & 15; topk_item(AFF + (size_t)e * NROWS + (size_t)b * SEQ, SEQ, CAP, b * SEQ, e, (b * NE + e) * CAP, TOK, GATE, INV, lds); }
        else { const int b = (it - 64) >> 4, e = it & 15; topk_item(AFF + (size_t)e * NROWS + NLAT + (size_t)b * CTXL, CTXL, CCAP, NLAT + b * CTXL, e, NSLOT_LAT + (e * NB + b) * CCAP, TOK, GATE, INV, lds); }
    }
}

__device__ __forceinline__ void phase_combine(const Params& p, int l, bool with_ctx, LAS unsigned char* lds, int bid, int nb) {
    bid = opaque_s(bid); const int tid = opaque_tid(); const int lane = tid & 63, gw = bid * NWAVES + (tid >> 6), NGW = nb * NWAVES;
    LAS float* l1g = (LAS float*)lds; LAS float* l1b = l1g + DM; LAS float* l2g = l1b + DM; LAS float* l2b = l2g + DM; LAS float* lg2 = l2b + DM; LAS float* lsh = lg2 + 5 * DM; LAS float* lsc = lsh + 5 * DM;
    lds_fill(l1g, p.ln1_g + l * DM, DM, tid); lds_fill(l1b, p.ln1_b + l * DM, DM, tid); lds_fill(l2g, p.ln2_g + l * DM, DM, tid); lds_fill(l2b, p.ln2_b + l * DM, DM, tid);
    for (int r = 0; r < 5; ++r) { lds_fill(lg2 + r * DM, mod_ptr(p, l, r) + 5 * DM, DM, tid); if (l + 1 < DEPTH) { lds_fill(lsh + r * DM, mod_ptr(p, l + 1, r), DM, tid); lds_fill(lsc + r * DM, mod_ptr(p, l + 1, r) + DM, DM, tid); } }
    __syncthreads();
    bf16_t* XB = (bf16_t*)(p.ws + WS_XB); bf16_t* HB = (bf16_t*)(p.ws + WS_HB);
    const bf16_t* Y = (const bf16_t*)(p.ws + WS_Y); const int* INV = (const int*)(p.ws + WS_INV);
    const float* g = p.ln2_g + l * DM; const float* bb = p.ln2_b + l * DM;
    const int nrows = with_ctx ? NROWS : NLAT;
    f32x4 v[4], vn[4]; int myinv = -1, myinvn = -1;
    if (gw < nrows) { row_load_bf16(XB + (size_t)gw * DM, lane, v); myinv = INV[(size_t)(lane & 15) * NROWS + gw]; }
#pragma unroll 1
    for (int row = gw; row < nrows; row += NGW) {
        bf16_t* xr = XB + (size_t)row * DM;
        const int rn = row + NGW;
        if (rn < nrows) { row_load_bf16(XB + (size_t)rn * DM, lane, vn); myinvn = INV[(size_t)(lane & 15) * NROWS + rn]; }
        f32x4 a[4];
#pragma unroll
        for (int j = 0; j < 4; ++j) a[j] = (f32x4){0.f, 0.f, 0.f, 0.f};
#pragma unroll
        for (int e = 0; e < 16; ++e) {
            const int slot = __builtin_amdgcn_readlane(myinv, e);
            if (slot >= 0) { const bf16_t* yr = Y + (size_t)slot * DM;
#pragma unroll
                for (int j = 0; j < 4; ++j) { const u32x2 wv = *(const u32x2*)(yr + 256 * j + 4 * lane); a[j][0] += bf_lo(wv.x); a[j][1] += bf_hi(wv.x); a[j][2] += bf_lo(wv.y); a[j][3] += bf_hi(wv.y); } }
        }
        row_normalize(v); row_affine_l(v, l1g, l1b, lane);
        const int mr = row_modrow(row);
#pragma unroll
        for (int j = 0; j < 4; ++j) { const f32x4 g2 = *(const LAS f32x4*)(lg2 + mr * DM + 256 * j + 4 * lane); v[j] = v[j] * ALPHA + g2 * a[j]; }
        row_normalize(v); row_affine_l(v, l2g, l2b, lane);
        if (l + 1 < DEPTH) row_store_bf16(xr, lane, v); else row_store(p.out + (size_t)row * DM, lane, v);
        if (l + 1 < DEPTH) { row_normalize(v); row_modulate_l(v, lsh + mr * DM, lsc + mr * DM, lane); row_store_bf16(HB + (size_t)row * DM, lane, v); }
#pragma unroll
        for (int j = 0; j < 4; ++j) v[j] = vn[j];
        myinv = myinvn;
    }
}

constexpr int N_PHASES = 2 + 8 * DEPTH;
#define IN(k) (lo <= (k) && (k) < hi)
#ifndef TS_SEL
#define TS_SEL -1
#endif
#define TS_MULT 8
#define SEAM(k) do { if (IN(k) && IN((k) + 1)) xcd_barrier(bar); if (TS_SEL >= 0 && blockIdx.x == 0 && threadIdx.x == 0) ((unsigned long long*)(p.ws + WS_CTL + 65536))[(k) + 1] = __builtin_amdgcn_s_memrealtime(); } while (0)
#ifndef PHMASK
#define PHMASK 0x3ff
#endif
#define PHON(i) ((PHMASK >> (i)) & 1)
#ifndef DUP_MASK
#define DUP_MASK 0
#endif
#define DUP(i) ((DUP_MASK >> (i)) & 1)
template <int l>
__device__ __forceinline__ void run_layer(const Params& p, LAS unsigned char* lds, LAS int* idxl, const XcdBarrier& bar, int bid, int nb, int lo, int hi) {
    bf16_t* HB = (bf16_t*)(p.ws + WS_HB); bf16_t* PB = (bf16_t*)(p.ws + WS_PB); bf16_t* OB = (bf16_t*)(p.ws + WS_OB);
    bf16_t* HH = (bf16_t*)(p.ws + WS_HH); bf16_t* Y = (bf16_t*)(p.ws + WS_Y);
    const int* TOK = (const int*)(p.ws + WS_TOK); const float* GATE = (const float*)(p.ws + WS_GATE);
        const int pb = 2 + 8 * l; const bool wc = (l == 0);
        if (IN(pb + 0)) { if (PHON(2)) {
            const bf16_t* W = (const bf16_t*)(p.ws + WS_WIN) + (size_t)l * INW * DM; EpiQKV E{PB, (const float*)(p.ws + WS_ROPE)};
            { SgDesc g{HB + (size_t)NLAT * DM, DM, nullptr, W, 0, 1 << 30, 1, NCTX, INW, DM, NLAT}; sg_gemm(g, E, lds, bid, nb); }
            { mg::Gemm g{HB, W, NLAT, INW, DM, nullptr, 0, 1 << 20, 1}; mg::StaticOrder S; S.init(NLAT, INW, nb, bid); mg::EpiAdapt<EpiQKV> EA{E, 0}; mg::gemm_phase(lds, idxl, g, S, EA); if (DUP(2)) mg::gemm_phase(lds, idxl, g, S, EA); } } }
        SEAM(pb + 0);
        if (IN(pb + 1)) { if (PHON(3)) {
#if FAST_ATTN
            fa::phase_attn(p, l, wc, lds, bid, nb); if (DUP(3)) fa::phase_attn(p, l, wc, lds, bid, nb);
#endif
            phase_mixers(p, l, wc, bid, nb); } }
        SEAM(pb + 1);
        if (IN(pb + 2)) { if (PHON(4)) {
            const bf16_t* W = (const bf16_t*)(p.ws + WS_WOUT) + (size_t)l * DM * DM;
            EpiOut<l == 0> E{p.x, p.ctx, (bf16_t*)(p.ws + WS_XB), mod_ptr(p, l, 0)};
            if (wc) { SgDesc g{OB + (size_t)NLAT * DM, DM, nullptr, W, 0, 1 << 30, 1, NCTX, DM, DM, NLAT}; sg_gemm(g, E, lds, bid, nb); }
            { mg::Gemm g{OB, W, NLAT, DM, DM, nullptr, 0, 1 << 20, 1}; mg::StaticOrder S; S.init(NLAT, DM, nb, bid); mg::EpiAdapt<EpiOut<l == 0>> EA{E, 0}; mg::gemm_phase(lds, idxl, g, S, EA); if (DUP(4) && l == 0) mg::gemm_phase(lds, idxl, g, S, EA); } } }
        SEAM(pb + 2);
        if (IN(pb + 3)) { if (PHON(5)) phase_ln_router(p, l, wc, lds, bid, nb); }
        SEAM(pb + 3);
        if (IN(pb + 4)) { if (PHON(6)) phase_topk(p, wc, lds, bid, nb); if (DUP(6)) phase_topk(p, wc, lds, bid, nb); }
        SEAM(pb + 4);
        if (IN(pb + 5)) { if (PHON(7)) {
            const bf16_t* W = (const bf16_t*)(p.ws + WS_WGU) + (size_t)l * NE * 1024 * DM; EpiGU E{HH};
            if (wc) { SgDesc g{HB, DM, TOK + NSLOT_LAT, W, (size_t)1024 * DM, NB * CCAP, NE, NSLOT_CTX, 1024, DM, NSLOT_LAT}; sg_gemm(g, E, lds, bid, nb); }
            { mg::Gemm g{HB, W, NSLOT_LAT, 1024, DM, TOK, (size_t)1024 * DM, CAP / 256, NE}; mg::StaticOrder S; S.init(NSLOT_LAT, 1024, nb, bid); mg::EpiAdapt<EpiGU> EA{E, 0}; mg::gemm_phase(lds, idxl, g, S, EA); if (DUP(7)) mg::gemm_phase(lds, idxl, g, S, EA); } } }
        SEAM(pb + 5);
        if (IN(pb + 6)) { if (PHON(8)) {
            const bf16_t* W = (const bf16_t*)(p.ws + WS_WD) + (size_t)l * NE * DM * FF; EpiDown E{Y, GATE};
            if (wc) { SgDesc g{HH + (size_t)NSLOT_LAT * FF, FF, nullptr, W, (size_t)DM * FF, NB * CCAP, NE, NSLOT_CTX, DM, FF, NSLOT_LAT}; sg_gemm(g, E, lds, bid, nb); }
            { mg::Gemm g{HH, W, NSLOT_LAT, DM, FF, nullptr, (size_t)DM * FF, CAP / 256, NE}; mg::StaticOrder S; S.init(NSLOT_LAT, DM, nb, bid); mg::EpiAdapt<EpiDown> EA{E, 0}; mg::gemm_phase(lds, idxl, g, S, EA); if (DUP(8)) mg::gemm_phase(lds, idxl, g, S, EA); } } }
        SEAM(pb + 6);
        if (IN(pb + 7)) { if (PHON(9)) phase_combine(p, l, wc, lds, bid, nb); }
        SEAM(pb + 7);
}
__global__ void __launch_bounds__(NTHREADS, 2) fwd_kernel(Params p) {
    extern __shared__ __attribute__((aligned(16))) unsigned char lds_raw[];
    LAS unsigned char* lds = (LAS unsigned char*)lds_raw;
    const int bid = blockIdx.x, nb = gridDim.x;
    volatile LAS unsigned* MISC = (volatile LAS unsigned*)(lds + LDS_BYTES - 64);
    LAS int* idxl = (LAS int*)(lds + mg::STAGE_BYTES);
    if (threadIdx.x < 16) MISC[threadIdx.x] = 0u;
    __syncthreads();
    XcdBarrier bar; bar.bar = (unsigned*)(p.ws + WS_CTL) + CW_BAR; bar.x = 0; bar.st = nullptr;
    const bool multi = p.ph_hi - p.ph_lo > 1;
    if (multi) bar = xcd_barrier_post((unsigned*)(p.ws + WS_CTL) + CW_BAR, MISC + 8);
    bf16_t* HB = (bf16_t*)(p.ws + WS_HB); bf16_t* PB = (bf16_t*)(p.ws + WS_PB); bf16_t* OB = (bf16_t*)(p.ws + WS_OB);
    bf16_t* HH = (bf16_t*)(p.ws + WS_HH); bf16_t* Y = (bf16_t*)(p.ws + WS_Y);
    const int* TOK = (const int*)(p.ws + WS_TOK); const float* GATE = (const float*)(p.ws + WS_GATE);
    const int lo = p.ph_lo, hi = p.ph_hi;
    if (TS_SEL >= 0 && blockIdx.x == 0 && threadIdx.x == 0) ((unsigned long long*)(p.ws + WS_CTL + 65536))[0] = __builtin_amdgcn_s_memrealtime();
    if (IN(0)) { if (PHON(0)) { phase_prologue(p, lds, bid, nb); __syncthreads(); phase_weights(p, lds, bid, nb); } } SEAM(0);
    if (IN(1)) { if (PHON(1)) phase_ln1(p, bid, nb); if (DUP(1)) phase_ln1(p, bid, nb); } SEAM(1);
    run_layer<0>(p, lds, idxl, bar, bid, nb, lo, hi);
    run_layer<1>(p, lds, idxl, bar, bid, nb, lo, hi);
    if (TS_SEL >= 0 && blockIdx.x == 0 && threadIdx.x == 0) {
        volatile unsigned long long* ts = (volatile unsigned long long*)(p.ws + WS_CTL + 65536); const unsigned long long dt = (ts[TS_SEL + 1] - ts[TS_SEL]) * TS_MULT, t0 = __builtin_amdgcn_s_memrealtime();
        while (__builtin_amdgcn_s_memrealtime() - t0 < dt) __builtin_amdgcn_s_sleep(8); }
#undef IN
#undef SEAM
}

#ifndef N_LAUNCH_SPLIT
#define N_LAUNCH_SPLIT 0
#endif
extern "C" void kernel_launch(void* const* d_in, const int* in_sizes, int n_in, void* d_out, int out_size, void* d_ws, size_t ws_size, hipStream_t stream) {
    static int grid = 0;
    if (grid == 0) {
        if (n_in != 19 || in_sizes[0] != NLAT * DM || out_size != NLAT * DM || ws_size < WS_END) { fprintf(stderr, "kernel_launch: unexpected shapes (n_in %d, in0 %d, out %d, ws %zu)\n", n_in, n_in > 0 ? in_sizes[0] : -1, out_size, ws_size); grid = -1; return; }
        int dev = 0, cus = 0, per_cu = 0;
        if (hipGetDevice(&dev) != hipSuccess || hipDeviceGetAttribute(&cus, hipDeviceAttributeMultiprocessorCount, dev) != hipSuccess) { grid = -1; return; }
        if (hipFuncSetAttribute((const void*)fwd_kernel, hipFuncAttributeMaxDynamicSharedMemorySize, LDS_BYTES) != hipSuccess) { fprintf(stderr, "kernel_launch: hipFuncSetAttribute failed\n"); grid = -1; return; }
        if (hipOccupancyMaxActiveBlocksPerMultiprocessor(&per_cu, (const void*)fwd_kernel, NTHREADS, LDS_BYTES) != hipSuccess || per_cu < 1) { fprintf(stderr, "kernel_launch: occupancy query says %d\n", per_cu); per_cu = 1; }
        (void)hipGetLastError();
        grid = cus;
    }
    if (grid < 0) return;
    (void)hipMemsetAsync((char*)d_ws + WS_CTL, 0, CTL_ZERO_BYTES, stream);
    Params p{};
    const float** pp = (const float**)&p;
    for (int i = 0; i < 19; ++i) pp[i] = (const float*)d_in[i];
    p.out = (float*)d_out; p.ws = (unsigned char*)d_ws;
#if N_LAUNCH_SPLIT
    for (int ph = 0; ph < N_PHASES; ++ph) { p.ph_lo = ph; p.ph_hi = ph + 1; hipLaunchKernelGGL(fwd_kernel, dim3(grid), dim3(NTHREADS), LDS_BYTES, stream, p); }
#else
    p.ph_lo = 0; p.ph_hi = N_PHASES;
    void* args[] = {&p};
    hipError_t e = hipLaunchCooperativeKernel((const void*)fwd_kernel, dim3(grid), dim3(NTHREADS), args, LDS_BYTES, stream);
    if (e != hipSuccess) fprintf(stderr, "kernel_launch: cooperative launch failed: %s\n", hipGetErrorString(e));
#endif
}
```

```cpp
#include <hip/hip_runtime.h>
#include <hip/hip_cooperative_groups.h>
#include <cstdio>
#include <cstdint>
#include <cmath>

#define LAS __attribute__((address_space(3)))
typedef unsigned short bf16_t;
typedef short bf16x8 __attribute__((ext_vector_type(8)));
typedef float f32x4 __attribute__((ext_vector_type(4)));
typedef unsigned u32x4 __attribute__((ext_vector_type(4)));
typedef unsigned u32x2 __attribute__((ext_vector_type(2)));

constexpr int NB = 4, SEQ = 8192, DM = 1024, CTXL = 256, DEPTH = 2;
constexpr int NLAT = NB * SEQ, NCTX = NB * CTXL, NROWS = NLAT + NCTX;
constexpr int INW = 2560, NE = 16, FF = 512, CAP = 1024, CCAP = 32;
constexpr int NSLOT_LAT = NB * NE * CAP, NSLOT_CTX = NB * NE * CCAP, NSLOT = NSLOT_LAT + NSLOT_CTX;
constexpr int NMOD = 6 * DM;
constexpr float LN_EPS = 1e-6f;
constexpr float ALPHA = 1.41421356237309515f;
constexpr int C_QA = 0, C_KA = 384, C_VA = 512, C_BX = 640, C_BB = 896, C_BC = 1152, C_QN = 1408, C_KN = 1792, C_VN = 2176;

#ifndef FAST_ATTN
#define FAST_ATTN 1
#endif
constexpr int NTHREADS = 512, NWAVES = 8;
constexpr int LDS_BYTES = 147456;

constexpr size_t MiB = 1u << 20;
constexpr size_t WS_CTL = 0, CTL_ZERO_BYTES = 128 * 1024;
constexpr size_t WS_ROPE = 1 * MiB;
constexpr size_t WS_MOD = 1 * MiB + 65536;
constexpr size_t WS_AFF = 2 * MiB;
constexpr size_t WS_INV = 5 * MiB;
constexpr size_t WS_TOK = 8 * MiB;
constexpr size_t WS_GATE = 8 * MiB + 512 * 1024;
constexpr size_t WS_CXR = 9 * MiB;
constexpr size_t WS_WIN = 16 * MiB;
constexpr size_t WS_WOUT = 26 * MiB;
constexpr size_t WS_WGU = 30 * MiB;
constexpr size_t WS_WD = 94 * MiB;
constexpr size_t WS_HB = 126 * MiB;
constexpr size_t WS_OB = 192 * MiB;
constexpr size_t WS_HH = 192 * MiB;
constexpr size_t WS_PB = 258 * MiB;
constexpr size_t WS_Y = 258 * MiB;
constexpr size_t WS_XB = 424 * MiB;
constexpr size_t WS_END = 490 * MiB;
static_assert(WS_HB + (size_t)NROWS * DM * 2 <= WS_OB && WS_OB + (size_t)NROWS * DM * 2 <= WS_PB && WS_PB + (size_t)NROWS * INW * 2 <= WS_XB && WS_XB + (size_t)NROWS * DM * 2 <= WS_END, "ws map");
static_assert((size_t)NSLOT * FF * 2 <= (size_t)NROWS * DM * 2 && (size_t)NSLOT * DM * 2 <= (size_t)NROWS * INW * 2, "overlays");
constexpr int CW_BAR = 4096;

struct Params {
    const float *x, *c, *ctx, *c_ctx, *w_mod, *b_mod, *w_in, *conv_w, *attn_sink, *na_rpb, *w_out, *ln1_g, *ln1_b, *w_router, *w_gate, *w_up, *w_down, *ln2_g, *ln2_b;
    float* out; unsigned char* ws;
    int ph_lo, ph_hi;
};

__device__ __forceinline__ unsigned f2bf(float f) { unsigned u = __builtin_bit_cast(unsigned, f); return (u + 0x7fffu + ((u >> 16) & 1u)) >> 16; }
typedef float f32x2_cv __attribute__((ext_vector_type(2))); typedef __bf16 bf16x2_cv __attribute__((ext_vector_type(2)));
__device__ __forceinline__ unsigned pk2(float lo, float hi) { f32x2_cv v = {lo, hi}; bf16x2_cv b = __builtin_convertvector(v, bf16x2_cv); return __builtin_bit_cast(unsigned, b); }
__device__ __forceinline__ float bf_lo(unsigned w) { return __builtin_bit_cast(float, w << 16); }
__device__ __forceinline__ float bf_hi(unsigned w) { return __builtin_bit_cast(float, w & 0xffff0000u); }
template <int CTRL> __device__ __forceinline__ float dppf(float v) { return __builtin_bit_cast(float, __builtin_amdgcn_update_dpp(0, __builtin_bit_cast(int, v), CTRL, 0xf, 0xf, true)); }
__device__ __forceinline__ void swap16(float v, float& a, float& b) { a = v; b = v; asm volatile("s_nop 1\n\tv_permlane16_swap_b32 %0, %1" : "+v"(a), "+v"(b)); }
__device__ __forceinline__ void swap32(float v, float& a, float& b) { a = v; b = v; asm volatile("s_nop 1\n\tv_permlane32_swap_b32 %0, %1" : "+v"(a), "+v"(b)); }
__device__ __forceinline__ float xor16_sum(float v) { float a, b; swap16(v, a, b); return a + b; }
__device__ __forceinline__ float xor32_sum(float v) { float a, b; swap32(v, a, b); return a + b; }
__device__ __forceinline__ float xor16_max(float v) { float a, b; swap16(v, a, b); return fmaxf(a, b); }
__device__ __forceinline__ float xor32_max(float v) { float a, b; swap32(v, a, b); return fmaxf(a, b); }
__device__ __forceinline__ float wave_sum(float v) {
    v += dppf<0xB1>(v); v += dppf<0x4E>(v); v += dppf<0x141>(v); v += dppf<0x140>(v);
    return xor32_sum(xor16_sum(v));
}
#define LDS_WAIT() asm volatile("s_waitcnt lgkmcnt(0)" ::: "memory")
__device__ __forceinline__ int opaque_tid() { int t = threadIdx.x; asm volatile("" : "+v"(t)); return t; }
__device__ __forceinline__ int opaque_s(int v) { asm volatile("" : "+s"(v)); return v; }

__device__ __forceinline__ float* mod_ptr(const Params& p, int l, int r) { return (float*)(p.ws + WS_MOD) + ((size_t)l * 5 + r) * NMOD; }

#define XB_TMO      128
#define XB_XCNT(j)  (256  + 64 * (j))
#define XB_XSUB(j)  (1280 + 64 * (j))
#define XB_XGEN(j)  (2304 + 64 * (j))
#define XB_TOP      3328
#define XB_TOPGEN   3392
#define XCD_BAR_WORDS 3456
#define XB_SPIN_CAP (1u << 20)
__device__ __forceinline__ unsigned xb_ld(unsigned* p)              { return __hip_atomic_load(p, __ATOMIC_RELAXED, __HIP_MEMORY_SCOPE_AGENT); }
__device__ __forceinline__ unsigned xb_add(unsigned* p, unsigned v) { return __hip_atomic_fetch_add(p, v, __ATOMIC_RELAXED, __HIP_MEMORY_SCOPE_AGENT); }
__device__ __forceinline__ unsigned xb_xcc_id() { return (unsigned)__builtin_amdgcn_s_getreg((3 << 11) | 20) & 0xFu; }
#define XB_SPIN(cond, bar) do { unsigned _sp = 0; while (cond) { __builtin_amdgcn_s_sleep(1); \
    if ((++_sp & 255u) == 0u) { if (xb_ld(&(bar)[XB_TMO])) break; if (_sp > XB_SPIN_CAP) { atomicAdd(&(bar)[XB_TMO], 1u); break; } } } } while (0)
struct XcdBarrier { unsigned* bar; unsigned x; volatile LAS unsigned* st; };
__device__ __forceinline__ XcdBarrier xcd_barrier_post(unsigned* bar, volatile LAS unsigned* st) {
    XcdBarrier b; b.bar = bar; b.x = xb_xcc_id(); b.st = st;
    if (threadIdx.x == 0) (void)xb_add(&bar[XB_XCNT(b.x)], 1u);
    return b;
}
__device__ __forceinline__ void xcd_barrier_complete(unsigned* bar, unsigned x, unsigned& nloc, unsigned& nx) {
    const unsigned G = gridDim.x * gridDim.y * gridDim.z;
    unsigned sum, cnt, mine, sp = 0u;
    for (;;) {
        sum = 0u; cnt = 0u; mine = 0u;
#pragma unroll 1
        for (unsigned j = 0; j < 16; ++j) { const unsigned c = xb_ld(&bar[XB_XCNT(j)]); sum += c; cnt += (c > 0u) ? 1u : 0u; mine = (j == x) ? c : mine; }
        if (sum == G) break;
        __builtin_amdgcn_s_sleep(1);
        if ((++sp & 255u) == 0u) { if (xb_ld(&bar[XB_TMO])) break; if (sp > XB_SPIN_CAP) { atomicAdd(&bar[XB_TMO], 1u); break; } }
    }
    nloc = mine > 0u ? mine : 1u; nx = cnt > 0u ? cnt : 1u;
}
__device__ __forceinline__ void xcd_barrier(const XcdBarrier& b) {
    asm volatile("s_waitcnt vmcnt(0)" ::: "memory");
    __syncthreads();
    if (threadIdx.x == 0) {
        unsigned* bar = b.bar; asm volatile("" : "+s"(bar));
        __builtin_amdgcn_s_waitcnt(0);
        unsigned nloc = b.st[0], nx = b.st[1];
        if (nloc == 0u) { xcd_barrier_complete(bar, b.x, nloc, nx); b.st[0] = nloc; b.st[1] = nx; }
        const unsigned old = xb_add(&bar[XB_XSUB(b.x)], 1u);
        const unsigned gen = old / nloc;
        if (old + 1u == (gen + 1u) * nloc) {
            __builtin_amdgcn_fence(__ATOMIC_RELEASE, "agent");
            asm volatile("s_waitcnt vmcnt(0)" ::: "memory");
            const unsigned og = xb_add(&bar[XB_TOP], 1u);
            const unsigned tg = og / nx;
            if (og + 1u == (tg + 1u) * nx) xb_add(&bar[XB_TOPGEN], 1u);
            else XB_SPIN(xb_ld(&bar[XB_TOPGEN]) == tg, bar);
            __builtin_amdgcn_fence(__ATOMIC_ACQUIRE, "agent");
            xb_add(&bar[XB_XGEN(b.x)], 1u);
            asm volatile("s_waitcnt vmcnt(0)" ::: "memory");
        } else {
            XB_SPIN(xb_ld(&bar[XB_XGEN(b.x)]) == gen, bar);
            __builtin_amdgcn_fence(__ATOMIC_ACQUIRE, "agent");
            asm volatile("s_waitcnt vmcnt(0)" ::: "memory");
        }
    }
    __syncthreads();
}

struct TrItem { const float* W; bf16_t* WT; int K, N, mode, item; };
__device__ __forceinline__ void tr_load(const TrItem& t, int lane, float (&r)[32]) {
    const int nblk = t.N / 32, kb = t.item / nblk, nb = t.item % nblk, k0 = 64 * kb, n0 = 32 * nb;
    const float* src = t.W + (size_t)(k0 + (lane >> 5)) * t.N + n0 + (lane & 31);
#pragma unroll
    for (int i = 0; i < 32; ++i) r[i] = src[(size_t)(2 * i) * t.N];
}
__device__ __forceinline__ void tr_finish(const TrItem& t, int lane, const float (&r)[32], LAS float* scr) {
    const int nblk = t.N / 32, kb = t.item / nblk, nb = t.item % nblk, k0 = 64 * kb, n0 = 32 * nb;
#pragma unroll
    for (int i = 0; i < 32; ++i) scr[(2 * i + (lane >> 5)) * 33 + (lane & 31)] = r[i];
    LDS_WAIT();
    const int c = lane & 7;
#pragma unroll
    for (int j = 0; j < 4; ++j) {
        const int n = (lane >> 3) + 8 * j; const LAS float* s = scr + (8 * c) * 33 + n;
        u32x4 o; o.x = pk2(s[0 * 33], s[1 * 33]); o.y = pk2(s[2 * 33], s[3 * 33]); o.z = pk2(s[4 * 33], s[5 * 33]); o.w = pk2(s[6 * 33], s[7 * 33]);
        const int f = n0 + n;
        const int orow = t.mode == 0 ? ((f & ~255) + 128 * ((f >> 4) & 1) + 32 * ((f >> 6) & 3) + 16 * ((f >> 2) & 1) + 4 * (2 * ((f >> 5) & 1) + ((f >> 3) & 1)) + (f & 3))
                                     : (256 * (f >> 7) + (t.mode == 2 ? 128 : 0) + 32 * ((f >> 5) & 3) + 16 * ((f >> 2) & 1) + 4 * ((f >> 3) & 3) + (f & 3));
        *(u32x4*)(t.WT + (size_t)orow * t.K + k0 + 8 * c) = o;
    }
    LDS_WAIT();
}
__device__ __forceinline__ void phase_prologue(const Params& p, LAS unsigned char* lds, int bid, int nb) {
    bid = opaque_s(bid); const int tid = opaque_tid(), lane = tid & 63, w = tid >> 6;
    {
        LAS float* ssil = (LAS float*)lds;
        LAS float* red = ssil + 5 * 1024;
        for (int i = tid; i < 5 * 1024; i += NTHREADS) { const int r = i >> 10, k = i & 1023; const float v = r < 4 ? p.c[r * 1024 + k] : p.c_ctx[k]; ssil[i] = v / (1.f + expf(-v)); }
        __syncthreads();
        for (int item = bid; item < 2 * 96; item += nb) {
            const int l = item / 96, n0 = (item % 96) * 64;
            const float* W = p.w_mod + (size_t)l * DM * NMOD + n0 + lane;
            float a0 = 0.f, a1 = 0.f, a2 = 0.f, a3 = 0.f, a4 = 0.f;
#pragma unroll 8
            for (int k = w * 128; k < w * 128 + 128; ++k) {
                const float wv = W[(size_t)k * NMOD];
                a0 += ssil[k] * wv; a1 += ssil[1024 + k] * wv; a2 += ssil[2048 + k] * wv; a3 += ssil[3072 + k] * wv; a4 += ssil[4096 + k] * wv;
            }
            red[(w * 5 + 0) * 64 + lane] = a0; red[(w * 5 + 1) * 64 + lane] = a1; red[(w * 5 + 2) * 64 + lane] = a2; red[(w * 5 + 3) * 64 + lane] = a3; red[(w * 5 + 4) * 64 + lane] = a4;
            __syncthreads();
            if (tid < 320) { const int r = tid >> 6; float s = 0.f;
#pragma unroll
                for (int ww = 0; ww < 8; ++ww) s += red[(ww * 5 + r) * 64 + lane];
                mod_ptr(p, l, r)[n0 + lane] = s + p.b_mod[l * NMOD + n0 + lane]; }
            __syncthreads();
        }
    }
    if (bid == nb - 1) {
        float* rope = (float*)(p.ws + WS_ROPE);
        for (int e = tid; e < 128 * 16; e += NTHREADS) {
            const int pos = e >> 4, i = e & 15;
            const double a = exp(-((double)i / 16.0) * 9.210340371976184);
            const double a2 = a * a; double c = 1.0, s = a, tc = 1.0, ts = a;
            for (int n = 1; n <= 14; ++n) { tc *= -a2 / (double)((2 * n - 1) * (2 * n)); c += tc; ts *= -a2 / (double)((2 * n) * (2 * n + 1)); s += ts; }
            double rc = 1.0, rs = 0.0, bc = c, bs = s; int q = pos;
            while (q) { if (q & 1) { const double t = rc * bc - rs * bs; rs = rc * bs + rs * bc; rc = t; } const double t = bc * bc - bs * bs; bs = 2.0 * bc * bs; bc = t; q >>= 1; }
            rope[2 * e] = (float)rc; rope[2 * e + 1] = (float)rs;
        }
    }
}

constexpr int TR_I_IN = 16 * 80, TR_I_OUT = 16 * 32, TR_I_G = 16 * 16, TR_I_D = 8 * 32, TR_PER_L = TR_I_IN + TR_I_OUT + 16 * (2 * TR_I_G + TR_I_D);
constexpr int TR_P0 = TR_I_IN + TR_I_OUT, TR_SPLIT = TR_PER_L + TR_I_IN + TR_I_OUT;
__device__ __forceinline__ void phase_weights(const Params& p, LAS unsigned char* lds, int bid, int nb, int lo, int hi) {
    bid = opaque_s(bid); const int tid = opaque_tid(), lane = tid & 63, w = tid >> 6;
    {
        LAS float* scr = (LAS float*)lds + w * (64 * 33);
        const int gw = bid * NWAVES + w, NGW = nb * NWAVES;
        constexpr int I_IN = TR_I_IN, I_OUT = TR_I_OUT, I_G = TR_I_G, I_D = TR_I_D, PER_L = TR_PER_L;
        auto decode = [&](int it) -> TrItem {
            const int l = it / PER_L; int r = it % PER_L;
            if (r < I_IN) return TrItem{p.w_in + (size_t)l * DM * INW, (bf16_t*)(p.ws + WS_WIN) + (size_t)l * INW * DM, DM, INW, 0, r}; r -= I_IN;
            if (r < I_OUT) return TrItem{p.w_out + (size_t)l * DM * DM, (bf16_t*)(p.ws + WS_WOUT) + (size_t)l * DM * DM, DM, DM, 0, r}; r -= I_OUT;
            if (r < 16 * I_G) { const int e = r / I_G; return TrItem{p.w_gate + ((size_t)l * NE + e) * DM * FF, (bf16_t*)(p.ws + WS_WGU) + ((size_t)l * NE + e) * 1024 * DM, DM, FF, 1, r % I_G}; } r -= 16 * I_G;
            if (r < 16 * I_G) { const int e = r / I_G; return TrItem{p.w_up + ((size_t)l * NE + e) * DM * FF, (bf16_t*)(p.ws + WS_WGU) + ((size_t)l * NE + e) * 1024 * DM, DM, FF, 2, r % I_G}; } r -= 16 * I_G;
            const int e = r / I_D; return TrItem{p.w_down + ((size_t)l * NE + e) * FF * DM, (bf16_t*)(p.ws + WS_WD) + ((size_t)l * NE + e) * DM * FF, FF, DM, 0, r % I_D};
        };
        float ra[32], rb[32];
        int it = lo + gw;
        if (it < hi) { TrItem cur = decode(it); tr_load(cur, lane, ra);
#pragma unroll 1
            for (;;) {
                const int itn = it + NGW; const bool hn = itn < hi; TrItem nx = cur;
                if (hn) { nx = decode(itn); tr_load(nx, lane, rb); }
                tr_finish(cur, lane, ra, scr);
                if (!hn) break;
                const int itn2 = itn + NGW; const bool hn2 = itn2 < hi; TrItem nx2 = nx;
                if (hn2) { nx2 = decode(itn2); tr_load(nx2, lane, ra); }
                tr_finish(nx, lane, rb, scr);
                if (!hn2) break;
                cur = nx2; it = itn2;
            }
        }
    }
}

__device__ __forceinline__ void row_load(const float* rowp, int lane, f32x4 (&v)[4]) {
#pragma unroll
    for (int j = 0; j < 4; ++j) v[j] = *(const f32x4*)(rowp + 256 * j + 4 * lane);
}
__device__ __forceinline__ void row_load_bf16(const bf16_t* rowp, int lane, f32x4 (&v)[4]) {
#pragma unroll
    for (int j = 0; j < 4; ++j) { const u32x2 w = *(const u32x2*)(rowp + 256 * j + 4 * lane); v[j] = (f32x4){bf_lo(w.x), bf_hi(w.x), bf_lo(w.y), bf_hi(w.y)}; }
}
__device__ __forceinline__ void row_store(float* rowp, int lane, const f32x4 (&v)[4]) {
#pragma unroll
    for (int j = 0; j < 4; ++j) *(f32x4*)(rowp + 256 * j + 4 * lane) = v[j];
}
__device__ __forceinline__ void row_store_bf16(bf16_t* rowp, int lane, const f32x4 (&v)[4]) {
#pragma unroll
    for (int j = 0; j < 4; ++j) { u32x2 o; o.x = pk2(v[j][0], v[j][1]); o.y = pk2(v[j][2], v[j][3]); *(u32x2*)(rowp + 256 * j + 4 * lane) = o; }
}
__device__ __forceinline__ void row_normalize(f32x4 (&v)[4]) {
    float s = 0.f;
#pragma unroll
    for (int j = 0; j < 4; ++j) s += (v[j][0] + v[j][1]) + (v[j][2] + v[j][3]);
    const float mean = wave_sum(s) * (1.f / DM);
    float q = 0.f;
#pragma unroll
    for (int j = 0; j < 4; ++j) { v[j] = v[j] - mean; q += (v[j][0] * v[j][0] + v[j][1] * v[j][1]) + (v[j][2] * v[j][2] + v[j][3] * v[j][3]); }
    const float rstd = 1.f / sqrtf(wave_sum(q) * (1.f / DM) + LN_EPS);
#pragma unroll
    for (int j = 0; j < 4; ++j) v[j] = v[j] * rstd;
}
__device__ __forceinline__ void row_modulate(f32x4 (&v)[4], const float* sh, const float* sc, int lane) {
#pragma unroll
    for (int j = 0; j < 4; ++j) { const f32x4 a = *(const f32x4*)(sc + 256 * j + 4 * lane), b = *(const f32x4*)(sh + 256 * j + 4 * lane); v[j] = v[j] * (a + 1.f) + b; }
}
__device__ __forceinline__ void row_affine(f32x4 (&v)[4], const float* g, const float* bb, int lane) {
#pragma unroll
    for (int j = 0; j < 4; ++j) { const f32x4 a = *(const f32x4*)(g + 256 * j + 4 * lane), b = *(const f32x4*)(bb + 256 * j + 4 * lane); v[j] = v[j] * a + b; }
}
__device__ __forceinline__ void row_modulate_l(f32x4 (&v)[4], const LAS float* sh, const LAS float* sc, int lane) {
#pragma unroll
    for (int j = 0; j < 4; ++j) { const f32x4 a = *(const LAS f32x4*)(sc + 256 * j + 4 * lane), b = *(const LAS f32x4*)(sh + 256 * j + 4 * lane); v[j] = v[j] * (a + 1.f) + b; }
}
__device__ __forceinline__ void row_affine_l(f32x4 (&v)[4], const LAS float* g, const LAS float* bb, int lane) {
#pragma unroll
    for (int j = 0; j < 4; ++j) { const f32x4 a = *(const LAS f32x4*)(g + 256 * j + 4 * lane), b = *(const LAS f32x4*)(bb + 256 * j + 4 * lane); v[j] = v[j] * a + b; }
}
__device__ __forceinline__ int row_modrow(int row) { return row < NLAT ? (row >> 13) : 4; }
__device__ __forceinline__ void lds_fill(LAS float* dst, const float* src, int n, int tid) { for (int i = tid * 4; i < n; i += NTHREADS * 4) *(LAS f32x4*)(dst + i) = *(const f32x4*)(src + i); }

__device__ __forceinline__ void phase_ln1(const Params& p, int bid, int nb) {
    bid = opaque_s(bid); const int tid = opaque_tid(), lane = tid & 63, gw = bid * NWAVES + (tid >> 6), NGW = nb * NWAVES;
    bf16_t* HB = (bf16_t*)(p.ws + WS_HB);
    f32x4 v[4], vn[4];
    if (gw < NROWS) row_load(gw < NLAT ? p.x + (size_t)gw * DM : p.ctx + (size_t)(gw - NLAT) * DM, lane, v);
#pragma unroll 1
    for (int row = gw; row < NROWS; row += NGW) {
        const int rn = row + NGW;
        if (rn < NROWS) row_load(rn < NLAT ? p.x + (size_t)rn * DM : p.ctx + (size_t)(rn - NLAT) * DM, lane, vn);
        row_normalize(v);
        const float* m = mod_ptr(p, 0, row_modrow(row)); row_modulate(v, m, m + DM, lane);
        row_store_bf16(HB + (size_t)row * DM, lane, v);
#pragma unroll
        for (int j = 0; j < 4; ++j) v[j] = vn[j];
    }
}

struct SgDesc { const bf16_t* A; int lda; const int* rowidx; const bf16_t* Bt; size_t grp_stride; int rows_per_grp, ngrp; int M, N, K; int row_base; };
template <class Epi>
__device__ __forceinline__ void sg_gemm(const SgDesc& g, const Epi& E, LAS unsigned char* lds, int bid, int nb) {
    bid = opaque_s(bid); const int tid = opaque_tid(); const int lane = tid & 63, w = __builtin_amdgcn_readfirstlane(tid >> 6), fr = lane & 15, fq = lane >> 4, wm = w >> 1, wn = w & 1;
    const int tilesN = g.N / 128, tiles = (g.M / 128) * tilesN, nk = g.K / 64;
    const int sr = tid >> 3, sp = tid & 7;
    const int soff = sr * 128 + ((sp ^ ((sr >> 1) & 7)) << 4);
    int aoff[2][2], boff[4][2];
#pragma unroll
    for (int ks = 0; ks < 2; ++ks) {
#pragma unroll
        for (int i = 0; i < 2; ++i) { const int r = 32 * wm + 16 * i + fr; aoff[i][ks] = r * 128 + (((fq + 4 * ks) ^ ((r >> 1) & 7)) << 4); }
#pragma unroll
        for (int n = 0; n < 4; ++n) { const int r = 64 * (n >> 1) + 32 * wn + 16 * (n & 1) + fr; boff[n][ks] = 16384 + r * 128 + (((fq + 4 * ks) ^ ((r >> 1) & 7)) << 4); }
    }
#pragma unroll 1
    for (int t = bid; t < tiles; t += nb) {
        const int tm = t / tilesN, tn = t % tilesN, pn = tn >> 1, wp = tn & 1;
        const int row0 = tm * 128;
        const bf16_t* Bt = g.Bt + (size_t)((row0 / g.rows_per_grp) % g.ngrp) * g.grp_stride;
        const bf16_t* as[2]; const bf16_t* bs[2];
#pragma unroll
        for (int h = 0; h < 2; ++h) { const int r = row0 + sr + 64 * h; const int ar = g.rowidx ? g.rowidx[r] : r; as[h] = g.A + (size_t)ar * g.lda + sp * 8;
            bs[h] = Bt + (size_t)(256 * pn + 128 * h + 64 * wp + sr) * g.K + sp * 8; }
        f32x4 acc[2][4];
#pragma unroll
        for (int i = 0; i < 2; ++i)
#pragma unroll
            for (int n = 0; n < 4; ++n) acc[i][n] = (f32x4){0.f, 0.f, 0.f, 0.f};
        u32x4 ra[2], rb[2];
#pragma unroll
        for (int h = 0; h < 2; ++h) { ra[h] = *(const u32x4*)(as[h]); rb[h] = *(const u32x4*)(bs[h]); }
#pragma unroll
        for (int h = 0; h < 2; ++h) { *(LAS u32x4*)(lds + soff + h * 8192) = ra[h]; *(LAS u32x4*)(lds + 16384 + soff + h * 8192) = rb[h]; }
        __syncthreads();
#pragma unroll 1
        for (int k = 0; k < nk; ++k) {
            const LAS unsigned char* buf = lds + (k & 1) * 32768;
            if (k + 1 < nk) {
#pragma unroll
                for (int h = 0; h < 2; ++h) { ra[h] = *(const u32x4*)(as[h] + (k + 1) * 64); rb[h] = *(const u32x4*)(bs[h] + (k + 1) * 64); } }
#pragma unroll
            for (int ks = 0; ks < 2; ++ks) {
                bf16x8 a[2], b[4];
#pragma unroll
                for (int i = 0; i < 2; ++i) a[i] = *(const LAS bf16x8*)(buf + aoff[i][ks]);
#pragma unroll
                for (int n = 0; n < 4; ++n) b[n] = *(const LAS bf16x8*)(buf + boff[n][ks]);
#pragma unroll
                for (int i = 0; i < 2; ++i)
#pragma unroll
                    for (int n = 0; n < 4; ++n) acc[i][n] = __builtin_amdgcn_mfma_f32_16x16x32_bf16(b[n], a[i], acc[i][n], 0, 0, 0);
            }
            if (k + 1 < nk) { LAS unsigned char* nbuf = lds + ((k + 1) & 1) * 32768;
#pragma unroll
                for (int h = 0; h < 2; ++h) { *(LAS u32x4*)(nbuf + soff + h * 8192) = ra[h]; *(LAS u32x4*)(nbuf + 16384 + soff + h * 8192) = rb[h]; } }
            __syncthreads();
        }
#pragma unroll
        for (int i = 0; i < 2; ++i) {
            const int row = g.row_base + row0 + 32 * wm + 16 * i + fr; const float rv = E.rowval(row);
            E(row, pn, 2 * wp + wn, fq, acc[i][0], acc[i][1], acc[i][2], acc[i][3], rv);
        }
    }
}

__device__ __forceinline__ void store_bf16x8(bf16_t* p, const f32x4 a, const f32x4 b) { u32x4 o; o.x = pk2(a[0], a[1]); o.y = pk2(a[2], a[3]); o.z = pk2(b[0], b[1]); o.w = pk2(b[2], b[3]); *(u32x4*)p = o; }
__device__ __forceinline__ int epi_col(int pn, int wc, int fq) { return 256 * pn + 64 * wc + 32 * (fq >> 1) + 8 * (fq & 1); }

struct EpiQKV {
    bf16_t* PB; const float* rope;
    __device__ __forceinline__ float rowval(int) const { return 0.f; }
    __device__ __forceinline__ void operator()(int row, int pn, int wc, int fq, f32x4 a0, f32x4 a1, f32x4 b0, f32x4 b1, float) const {
        const int c = epi_col(pn, wc, fq);
        if (c < 512 && row < NLAT) {
            const int t = row & (SEQ - 1); const int pos = (fq >> 1) ? (t & 63) : (t >> 6);
            const f32x4* rp = (const f32x4*)(rope + (pos * 16 + 8 * (fq & 1)) * 2);
            const f32x4 r0 = rp[0], r1 = rp[1], r2 = rp[2], r3 = rp[3];
            const f32x4 cs0 = {r0[0], r0[2], r1[0], r1[2]}, sn0 = {r0[1], r0[3], r1[1], r1[3]}, cs1 = {r2[0], r2[2], r3[0], r3[2]}, sn1 = {r2[1], r2[3], r3[1], r3[3]};
            const f32x4 na0 = a0 * cs0 - b0 * sn0, nb0 = b0 * cs0 + a0 * sn0, na1 = a1 * cs1 - b1 * sn1, nb1 = b1 * cs1 + a1 * sn1;
            a0 = na0; b0 = nb0; a1 = na1; b1 = nb1;
        }
        bf16_t* o = PB + (size_t)row * INW + c;
        store_bf16x8(o, a0, a1); store_bf16x8(o + 16, b0, b1);
    }
};
template <bool FIRST> struct EpiOut {
    const float* xl; const float* xc; bf16_t* XB; const float* mod;
    __device__ __forceinline__ float rowval(int) const { return 0.f; }
    __device__ __forceinline__ void operator()(int row, int pn, int wc, int fq, f32x4 a0, f32x4 a1, f32x4 b0, f32x4 b1, float) const {
        const int c = epi_col(pn, wc, fq); bf16_t* xo = XB + (size_t)row * DM + c;
        const float* g1 = mod + (size_t)row_modrow(row) * NMOD + 2 * DM + c;
        f32x4 xa0, xa1, xb0, xb1;
        if (FIRST) { const float* xin = row < NLAT ? xl + (size_t)row * DM + c : xc + (size_t)(row - NLAT) * DM + c;
            xa0 = *(const f32x4*)xin; xa1 = *(const f32x4*)(xin + 4); xb0 = *(const f32x4*)(xin + 16); xb1 = *(const f32x4*)(xin + 20); }
        else { const u32x4 wa = *(const u32x4*)xo, wb = *(const u32x4*)(xo + 16);
            xa0 = (f32x4){bf_lo(wa.x), bf_hi(wa.x), bf_lo(wa.y), bf_hi(wa.y)}; xa1 = (f32x4){bf_lo(wa.z), bf_hi(wa.z), bf_lo(wa.w), bf_hi(wa.w)};
            xb0 = (f32x4){bf_lo(wb.x), bf_hi(wb.x), bf_lo(wb.y), bf_hi(wb.y)}; xb1 = (f32x4){bf_lo(wb.z), bf_hi(wb.z), bf_lo(wb.w), bf_hi(wb.w)}; }
        const f32x4 ga0 = *(const f32x4*)g1, ga1 = *(const f32x4*)(g1 + 4), gb0 = *(const f32x4*)(g1 + 16), gb1 = *(const f32x4*)(g1 + 20);
        store_bf16x8(xo, xa0 * ALPHA + ga0 * a0, xa1 * ALPHA + ga1 * a1); store_bf16x8(xo + 16, xb0 * ALPHA + gb0 * b0, xb1 * ALPHA + gb1 * b1);
    }
};
struct EpiGU {
    bf16_t* HH;
    __device__ __forceinline__ float rowval(int) const { return 0.f; }
    __device__ __forceinline__ void operator()(int row, int pn, int wc, int fq, f32x4 a0, f32x4 a1, f32x4 b0, f32x4 b1, float) const {
        f32x4 h0, h1;
#pragma unroll
        for (int j = 0; j < 4; ++j) { h0[j] = a0[j] * __builtin_amdgcn_rcpf(1.f + __expf(-a0[j])) * b0[j]; h1[j] = a1[j] * __builtin_amdgcn_rcpf(1.f + __expf(-a1[j])) * b1[j]; }
        store_bf16x8(HH + (size_t)row * FF + 128 * pn + 32 * wc + 8 * fq, h0, h1);
    }
};
struct EpiDown {
    bf16_t* Y; const float* gate;
    __device__ __forceinline__ float rowval(int row) const { return gate[row]; }
    __device__ __forceinline__ void operator()(int row, int pn, int wc, int fq, f32x4 a0, f32x4 a1, f32x4 b0, f32x4 b1, float g) const {
        bf16_t* o = Y + (size_t)row * DM + epi_col(pn, wc, fq);
        store_bf16x8(o, a0 * g, a1 * g); store_bf16x8(o + 16, b0 * g, b1 * g);
    }
};

namespace mg {
constexpr int BM = 256, BK = 64, HALF = 128, HTB = HALF * BK * 2, STAGE_BYTES = 8 * HTB, NXCD = 8, WGM = 8, MAXU = 8;
__device__ __forceinline__ int lds_byte(int r, int c) { const int st = (r >> 4) * 2 + (c >> 5), rr = r & 15, cc = c & 31, ob = rr * 64 + cc * 2; return st * 1024 + (ob ^ (((ob >> 9) & 1) << 5)); }
__device__ __forceinline__ void stage_rc(int b, int& R, int& C) { const int st = b / 1024, sb = b % 1024, swz = sb ^ (((sb >> 9) & 1) << 5); R = (st >> 1) * 16 + swz / 64; C = (st & 1) * 32 + (swz % 64) / 2; }
struct Unit { int pm, pn; };
struct Gemm { const bf16_t* A; const bf16_t* Bt; int M, N, K; const int* rowidx; size_t grp_stride; int grp_tiles, ngrp; };
struct StaticOrder {
    int nM, nN, nwg, G, c;
    __device__ void init(int M, int N, int G_, int c_) { nM = M / BM; nN = N / BM; nwg = nM * nN; G = G_; c = c_; }
    __device__ bool next(int i, Unit& u) const {
        const long L = (long)i * G + c; if (L >= nwg) return false;
        int wgid = (int)L; { const int q = nwg / NXCD, r = nwg % NXCD, xcd = wgid % NXCD, off = wgid / NXCD; wgid = (xcd < r ? xcd * (q + 1) : r * (q + 1) + (xcd - r) * q) + off; }
        const int nig = WGM * nN, gid = wgid / nig, fm = gid * WGM, gsz = (nM - fm) < WGM ? (nM - fm) : WGM;
        u.pm = fm + ((wgid % nig) % gsz); u.pn = (wgid % nig) / gsz; return true;
    }
};
template <class Epi>
__device__ __forceinline__ void gemm_phase(LAS unsigned char* lds, LAS int* idxl, const Gemm g, const StaticOrder& S, const Epi& E) {
    const int tid = opaque_tid(), wid = __builtin_amdgcn_readfirstlane(tid >> 6), lane = tid & 63, wr = wid >> 2, wc = wid & 3, fr = lane & 15, fq = lane >> 4;
    const int K = g.K, nt = K / BK;
    unsigned voffB[2];
#pragma unroll
    for (int i = 0; i < 2; ++i) { int R_, C_; stage_rc(tid * 16 + i * 8192, R_, C_); voffB[i] = (unsigned)(R_ * K + C_) * 2u; }
    const size_t kstep = (size_t)(BK * 2);
    const size_t hstep = (size_t)HALF * K * 2;
    const size_t tstep = 2 * hstep;
    const unsigned ldsw = (unsigned)wid * 1024u;
    const int aoff = lds_byte(wr * 64 + fr, fq * 8), boff = lds_byte(wc * 32 + fr, fq * 8);
    Unit cur, nxt; int ui = 0;
    if (!S.next(0, cur)) return;
#ifndef MG_STAGGER_TICKS
#define MG_STAGGER_TICKS 0
#endif
    if (MG_STAGGER_TICKS && (blockIdx.x & 8)) { const unsigned long long t0 = __builtin_amdgcn_s_memrealtime(); while (__builtin_amdgcn_s_memrealtime() - t0 < MG_STAGGER_TICKS) __builtin_amdgcn_s_sleep(16); }
    if (g.rowidx) {
        for (int i = 0; i < MAXU; ++i) { Unit u; if (!S.next(i, u)) break; if (tid < 256) idxl[i * 256 + tid] = g.rowidx[u.pm * BM + tid]; }
        asm volatile("s_waitcnt vmcnt(0) lgkmcnt(0)" ::: "memory"); __builtin_amdgcn_s_barrier(); asm volatile("" ::: "memory");
    }
#define MG_AOFFS(dst, u_, ui_) do { _Pragma("unroll") for (int i_ = 0; i_ < 2; ++i_) { int R_, C_; stage_rc(tid * 16 + i_ * 8192, R_, C_); _Pragma("unroll") for (int h_ = 0; h_ < 2; ++h_) { \
        const int rr_ = g.rowidx ? idxl[(ui_) * 256 + h_ * HALF + R_] : ((u_).pm * BM + h_ * HALF + R_); dst[h_][i_] = (unsigned)(rr_ * K + C_) * 2u; } } } while (0)
#define MG_BPTR(u_) ((const char*)g.Bt + ((size_t)(((u_).pm / g.grp_tiles) % g.ngrp) * g.grp_stride) * 2 + (size_t)(u_).pn * tstep)
#define PG8_SA(b, h) (((b) * 2 + (h)) * HTB)
#define PG8_SB(b, h) ((4 + (b) * 2 + (h)) * HTB)
#define PG8_STAGE(bufoff, gbase, voff) do { _Pragma("unroll") for (int _i = 0; _i < 2; ++_i) \
        __builtin_amdgcn_global_load_lds((const unsigned*)((const char*)(gbase) + (voff)[_i]), (LAS unsigned*)(lds + (bufoff) + ldsw + _i * 8192), 16, 0, 0); } while (0)
#define PG8_LDA(dst, b, h) do { _Pragma("unroll") for (int m = 0; m < 4; ++m) _Pragma("unroll") for (int k = 0; k < 2; ++k) dst[m][k] = *(const LAS bf16x8*)(lds + PG8_SA(b, h) + aoff + m * 2048 + k * 1024); } while (0)
#define PG8_LDB(dst, b, h) do { _Pragma("unroll") for (int n = 0; n < 2; ++n) _Pragma("unroll") for (int k = 0; k < 2; ++k) dst[n][k] = *(const LAS bf16x8*)(lds + PG8_SB(b, h) + boff + n * 2048 + k * 1024); } while (0)
#define PG8_MMA(ai, bj, At, Bt) do { __builtin_amdgcn_s_setprio(1); _Pragma("unroll") for (int m = 0; m < 4; ++m) _Pragma("unroll") for (int n = 0; n < 2; ++n) _Pragma("unroll") for (int k = 0; k < 2; ++k) \
        acc[ai][bj][m][n] = __builtin_amdgcn_mfma_f32_16x16x32_bf16(Bt[n][k], At[m][k], acc[ai][bj][m][n], 0, 0, 0); __builtin_amdgcn_s_setprio(0); } while (0)
#define PG8_WAIT_V(n) asm volatile("s_waitcnt vmcnt(" #n ")" ::: "memory")
#define PG8_WAIT_L(n) asm volatile("s_waitcnt lgkmcnt(" #n ")" ::: "memory")
#define PG8_BAR __builtin_amdgcn_s_barrier()
#define PG8_SCHED __builtin_amdgcn_sched_barrier(0)
    f32x4 acc[2][2][4][2];
#pragma unroll
    for (int a = 0; a < 2; ++a)
#pragma unroll
        for (int b = 0; b < 2; ++b)
#pragma unroll
            for (int m = 0; m < 4; ++m)
#pragma unroll
                for (int n = 0; n < 2; ++n) acc[a][b][m][n] = (f32x4){0.f, 0.f, 0.f, 0.f};
    bf16x8 At[4][2], B0[2][2], B1[2][2];
    unsigned cAo[2][2], o2[2][2];
    MG_AOFFS(cAo, cur, 0);
    const char* const Abase = (const char*)g.A;
    const char* cB = MG_BPTR(cur);
    PG8_STAGE(PG8_SB(0, 0), cB, voffB); PG8_STAGE(PG8_SB(0, 1), cB + hstep, voffB); PG8_STAGE(PG8_SA(0, 0), Abase, cAo[0]); PG8_STAGE(PG8_SA(0, 1), Abase, cAo[1]);
    if (wr == 1) PG8_BAR;
    PG8_WAIT_V(2); PG8_BAR;
    PG8_STAGE(PG8_SB(1, 0), cB + kstep, voffB); PG8_STAGE(PG8_SA(1, 0), Abase + kstep, cAo[0]); PG8_STAGE(PG8_SB(1, 1), cB + hstep + kstep, voffB);
    PG8_WAIT_V(6); PG8_BAR;
    for (;;) {
        const bool has_next = S.next(ui + 1, nxt);
        const char* nB = has_next ? MG_BPTR(nxt) : cB;
        for (int t = 0; t < nt; t += 2) {
            const bool last = (t == nt - 2);
            const char* a1 = Abase + (size_t)(t + 1) * kstep;
            const char* a2 = last ? Abase : Abase + (size_t)(t + 2) * kstep; const char* b2 = last ? nB : cB + (size_t)(t + 2) * kstep;
            const char* a3 = a2 + kstep; const char* b3 = b2 + kstep;
            if (last && has_next) { MG_AOFFS(o2, nxt, ui + 1); } else {
#pragma unroll
                for (int h = 0; h < 2; ++h)
#pragma unroll
                    for (int i = 0; i < 2; ++i) o2[h][i] = cAo[h][i]; }
            PG8_LDB(B0, 0, 0); PG8_LDB(B1, 0, 1); PG8_SCHED; PG8_LDA(At, 0, 0); PG8_STAGE(PG8_SA(1, 1), a1, cAo[1]);
            PG8_WAIT_V(8); PG8_WAIT_L(0); PG8_BAR; PG8_MMA(0, 0, At, B0); PG8_MMA(0, 1, At, B1); PG8_BAR; PG8_SCHED;
            PG8_LDA(At, 0, 1); PG8_STAGE(PG8_SB(0, 0), b2, voffB); PG8_STAGE(PG8_SB(0, 1), b2 + hstep, voffB); PG8_STAGE(PG8_SA(0, 0), a2, o2[0]);
            PG8_WAIT_V(8); PG8_WAIT_L(0); PG8_BAR; PG8_MMA(1, 0, At, B0); PG8_MMA(1, 1, At, B1); PG8_BAR; PG8_SCHED;
            PG8_LDB(B0, 1, 0); PG8_LDB(B1, 1, 1); PG8_SCHED; PG8_LDA(At, 1, 0); PG8_STAGE(PG8_SA(0, 1), a2, o2[1]);
            PG8_WAIT_V(8); PG8_WAIT_L(0); PG8_BAR; PG8_MMA(0, 0, At, B0); PG8_MMA(0, 1, At, B1); PG8_BAR; PG8_SCHED;
            PG8_LDA(At, 1, 1); PG8_STAGE(PG8_SB(1, 0), b3, voffB); PG8_STAGE(PG8_SB(1, 1), b3 + hstep, voffB); PG8_STAGE(PG8_SA(1, 0), a3, o2[0]);
            PG8_WAIT_V(8); PG8_WAIT_L(0); PG8_BAR; PG8_MMA(1, 0, At, B0); PG8_MMA(1, 1, At, B1); PG8_BAR; PG8_SCHED;
        }
        if (wr == 0) PG8_BAR;
        E(acc, cur, wr, wc, fr, fq);
        if (!has_next) break;
#pragma unroll
        for (int a = 0; a < 2; ++a)
#pragma unroll
            for (int b = 0; b < 2; ++b)
#pragma unroll
                for (int m = 0; m < 4; ++m)
#pragma unroll
                    for (int n = 0; n < 2; ++n) acc[a][b][m][n] = (f32x4){0.f, 0.f, 0.f, 0.f};
        cur = nxt; cB = nB; ++ui;
#pragma unroll
        for (int h = 0; h < 2; ++h)
#pragma unroll
            for (int i = 0; i < 2; ++i) cAo[h][i] = o2[h][i];
        if (wr == 1) PG8_BAR;
    }
    PG8_WAIT_V(0);
    PG8_BAR;
#undef MG_AOFFS
#undef MG_BPTR
#undef PG8_SA
#undef PG8_SB
#undef PG8_STAGE
#undef PG8_LDA
#undef PG8_LDB
#undef PG8_MMA
#undef PG8_WAIT_V
#undef PG8_WAIT_L
#undef PG8_BAR
#undef PG8_SCHED
}
template <class EE> struct EpiAdapt {
    EE e; int row_base;
    __device__ __forceinline__ void operator()(const f32x4 (&acc)[2][2][4][2], const Unit& u, int wr, int wc, int fr, int fq) const {
        float rv[2][4];
#pragma unroll
        for (int ai = 0; ai < 2; ++ai)
#pragma unroll
            for (int m = 0; m < 4; ++m) rv[ai][m] = e.rowval(row_base + u.pm * BM + ai * HALF + wr * 64 + m * 16 + fr);
#pragma unroll
        for (int ai = 0; ai < 2; ++ai)
#pragma unroll
            for (int m = 0; m < 4; ++m) { const int row = row_base + u.pm * BM + ai * HALF + wr * 64 + m * 16 + fr;
                e(row, u.pn, wc, fq, acc[ai][0][m][0], acc[ai][0][m][1], acc[ai][1][m][0], acc[ai][1][m][1], rv[ai][m]);
                if (m & 1) asm volatile("" ::: "memory"); }
    }
};
}

struct AttnState { float m, l; float o[32]; };
__device__ __forceinline__ void attn_init(AttnState& st) { st.m = -INFINITY; st.l = 0.f;
#pragma unroll
    for (int d = 0; d < 32; ++d) st.o[d] = 0.f; }
__device__ __forceinline__ void load_row32(const bf16_t* p, float (&r)[32], float scale) {
#pragma unroll
    for (int i = 0; i < 4; ++i) { const u32x4 w = *(const u32x4*)(p + 8 * i);
        r[8 * i + 0] = bf_lo(w.x) * scale; r[8 * i + 1] = bf_hi(w.x) * scale; r[8 * i + 2] = bf_lo(w.y) * scale; r[8 * i + 3] = bf_hi(w.y) * scale;
        r[8 * i + 4] = bf_lo(w.z) * scale; r[8 * i + 5] = bf_hi(w.z) * scale; r[8 * i + 6] = bf_lo(w.w) * scale; r[8 * i + 7] = bf_hi(w.w) * scale; }
}
__device__ __forceinline__ float dot_row32(const bf16_t* p, const float (&q)[32]) {
    float d0 = 0.f, d1 = 0.f;
#pragma unroll
    for (int i = 0; i < 4; ++i) { const u32x4 w = *(const u32x4*)(p + 8 * i);
        d0 += q[8 * i + 0] * bf_lo(w.x); d1 += q[8 * i + 1] * bf_hi(w.x); d0 += q[8 * i + 2] * bf_lo(w.y); d1 += q[8 * i + 3] * bf_hi(w.y);
        d0 += q[8 * i + 4] * bf_lo(w.z); d1 += q[8 * i + 5] * bf_hi(w.z); d0 += q[8 * i + 6] * bf_lo(w.w); d1 += q[8 * i + 7] * bf_hi(w.w); }
    const float d = d0 + d1;
    return d + __shfl_xor(d, 32);
}
__device__ __forceinline__ void axpy_row32(const bf16_t* p, float a, float (&o)[32]) {
#pragma unroll
    for (int i = 0; i < 4; ++i) { const u32x4 w = *(const u32x4*)(p + 8 * i);
        o[8 * i + 0] += a * bf_lo(w.x); o[8 * i + 1] += a * bf_hi(w.x); o[8 * i + 2] += a * bf_lo(w.y); o[8 * i + 3] += a * bf_hi(w.y);
        o[8 * i + 4] += a * bf_lo(w.z); o[8 * i + 5] += a * bf_hi(w.z); o[8 * i + 6] += a * bf_lo(w.w); o[8 * i + 7] += a * bf_hi(w.w); }
}
template <class ScoreFn>
__device__ __forceinline__ void attn_segment(const float (&q)[32], AttnState& st, const bf16_t* Kb, const bf16_t* Vb, int j0, int j1, ScoreFn sf) {
#pragma unroll 1
    for (int j = j0; j < j1; ++j) {
        const float s0 = sf(j, dot_row32(Kb + (size_t)j * INW, q));
        if (s0 > st.m) { const float corr = __expf(st.m - s0); st.l *= corr;
#pragma unroll
            for (int d = 0; d < 32; ++d) st.o[d] *= corr;
            st.m = s0; }
        const float p0 = (s0 == -INFINITY) ? 0.f : __expf(s0 - st.m);
        st.l += p0;
        axpy_row32(Vb + (size_t)j * INW, p0, st.o);
    }
}
__device__ __forceinline__ void attn_sink(AttnState& st, float sk) {
    if (sk > st.m) { const float corr = __expf(st.m - sk); st.l *= corr;
#pragma unroll
        for (int d = 0; d < 32; ++d) st.o[d] *= corr;
        st.m = sk; }
    st.l += __expf(sk - st.m);
}
__device__ __forceinline__ void attn_store(const AttnState& st, bf16_t* o) {
    const float inv = 1.f / st.l;
#pragma unroll
    for (int i = 0; i < 4; ++i) { u32x4 w; w.x = pk2(st.o[8 * i] * inv, st.o[8 * i + 1] * inv); w.y = pk2(st.o[8 * i + 2] * inv, st.o[8 * i + 3] * inv);
        w.z = pk2(st.o[8 * i + 4] * inv, st.o[8 * i + 5] * inv); w.w = pk2(st.o[8 * i + 6] * inv, st.o[8 * i + 7] * inv); *(u32x4*)(o + 8 * i) = w; }
}

__device__ __forceinline__ void phase_mixers(const Params& p, int l, bool with_ctx, int bid, int nb) {
    bid = opaque_s(bid); const int tid = opaque_tid(); const int lane = tid & 63, gw = bid * NWAVES + (tid >> 6), NGW = nb * NWAVES;
    const int ql = lane & 31, hf = lane >> 5;
    const bf16_t* PB = (const bf16_t*)(p.ws + WS_PB); bf16_t* OB = (bf16_t*)(p.ws + WS_OB);
    const float* sink = p.attn_sink + l * 6; const float* rpb = p.na_rpb + (size_t)l * 6 * 15 * 31;
#if !FAST_ATTN
#pragma unroll 1
    for (int it = gw; it < NB * 6 * 256; it += NGW) {
        const int chunk = it & 255, h = (it >> 8) % 6, b = it / (6 * 256), kvh = h / 3;
        const int t = chunk * 32 + ql; const size_t rowb = (size_t)b * SEQ;
        float q[32]; load_row32(PB + (rowb + t) * INW + C_QA + h * 64 + 32 * hf, q, 0.125f);
        AttnState st; attn_init(st);
        const int jlo = max(0, chunk * 32 - 128), jhi = min(SEQ, chunk * 32 + 32 + 128);
        attn_segment(q, st, PB + rowb * INW + C_KA + kvh * 64 + 32 * hf, PB + rowb * INW + C_VA + kvh * 64 + 32 * hf, jlo, jhi,
                     [&](int j, float d) { const int dt = t - j; return (dt <= 128 && dt >= -128) ? d : -INFINITY; });
        const size_t crow = (size_t)NLAT + (size_t)b * CTXL;
        attn_segment(q, st, PB + crow * INW + C_KA + kvh * 64 + 32 * hf, PB + crow * INW + C_VA + kvh * 64 + 32 * hf, 0, CTXL, [&](int, float d) { return d; });
        attn_sink(st, sink[h]);
        attn_store(st, OB + (rowb + t) * DM + h * 64 + 32 * hf);
    }
#pragma unroll 1
    for (int it = gw; it < NB * 6 * 256; it += NGW) {
        const int r = (it & 255) >> 1, ch = it & 1, h = (it >> 8) % 6, b = it / (6 * 256);
        const int cq = ch * 32 + ql; const size_t rowb = (size_t)b * SEQ; const int t = r * 64 + cq;
        float q[32]; load_row32(PB + (rowb + t) * INW + C_QN + h * 64 + 32 * hf, q, 0.125f);
        AttnState st; attn_init(st);
        const int rs = min(max(r - 4, 0), 128 - 8), cs = min(max(cq - 8, 0), 64 - 16);
        const float* bias = rpb + (size_t)h * 15 * 31;
        attn_segment(q, st, PB + (rowb + (size_t)rs * 64) * INW + C_KN + h * 64 + 32 * hf, PB + (rowb + (size_t)rs * 64) * INW + C_VN + h * 64 + 32 * hf, 0, 512,
                     [&](int j, float d) { const int ka = rs + (j >> 6), ck = j & 63; const bool ok = (ck >= cs) && (ck < cs + 16);
                                           const int ro = ka - r + 7, co = min(max(ck - cq, -15), 15) + 15; return ok ? d + bias[ro * 31 + co] : -INFINITY; });
        const size_t crow = (size_t)NLAT + (size_t)b * CTXL;
        attn_segment(q, st, PB + crow * INW + C_KN + h * 64 + 32 * hf, PB + crow * INW + C_VN + h * 64 + 32 * hf, 0, CTXL, [&](int, float d) { return d; });
        attn_store(st, OB + (rowb + t) * DM + 640 + h * 64 + 32 * hf);
    }
#endif
    {
        const float* cw = p.conv_w + (size_t)l * 3 * 256;
        const int nrows = with_ctx ? NROWS : NLAT;
        for (long e = (long)bid * NTHREADS + tid; e < (long)nrows * 32; e += (long)nb * NTHREADS) {
            const int row = (int)(e >> 5), ch = (int)(e & 31) * 8;
            const int tpos = row < NLAT ? (row & (SEQ - 1)) : ((row - NLAT) & (CTXL - 1)); const int tlen = row < NLAT ? SEQ : CTXL;
            const bf16_t* pr = PB + (size_t)row * INW;
            float u[3][8];
#pragma unroll
            for (int dlt = -1; dlt <= 1; ++dlt) {
                const bool ok = (tpos + dlt >= 0) && (tpos + dlt < tlen);
                if (ok) { const u32x4 a = *(const u32x4*)(pr + (long)dlt * INW + C_BX + ch), c = *(const u32x4*)(pr + (long)dlt * INW + C_BC + ch);
                    u[dlt + 1][0] = bf_lo(a.x) * bf_lo(c.x); u[dlt + 1][1] = bf_hi(a.x) * bf_hi(c.x); u[dlt + 1][2] = bf_lo(a.y) * bf_lo(c.y); u[dlt + 1][3] = bf_hi(a.y) * bf_hi(c.y);
                    u[dlt + 1][4] = bf_lo(a.z) * bf_lo(c.z); u[dlt + 1][5] = bf_hi(a.z) * bf_hi(c.z); u[dlt + 1][6] = bf_lo(a.w) * bf_lo(c.w); u[dlt + 1][7] = bf_hi(a.w) * bf_hi(c.w); }
                else {
#pragma unroll
                    for (int i = 0; i < 8; ++i) u[dlt + 1][i] = 0.f; }
            }
            const u32x4 gb = *(const u32x4*)(pr + C_BB + ch);
            const float g[8] = {bf_lo(gb.x), bf_hi(gb.x), bf_lo(gb.y), bf_hi(gb.y), bf_lo(gb.z), bf_hi(gb.z), bf_lo(gb.w), bf_hi(gb.w)};
            float y[8];
#pragma unroll
            for (int i = 0; i < 8; ++i) y[i] = g[i] * (u[0][i] * cw[ch + i] + u[1][i] * cw[256 + ch + i] + u[2][i] * cw[512 + ch + i]);
            u32x4 o; o.x = pk2(y[0], y[1]); o.y = pk2(y[2], y[3]); o.z = pk2(y[4], y[5]); o.w = pk2(y[6], y[7]);
            *(u32x4*)(OB + (size_t)row * DM + 384 + ch) = o;
        }
    }
#if !FAST_ATTN
    if (with_ctx) {
#pragma unroll 1
        for (int it = gw; it < 2 * NB * 6 * 8; it += NGW) {
            const int kind = it / (NB * 6 * 8), r = it % (NB * 6 * 8), chunk = r & 7, h = (r >> 3) % 6, b = r / 48;
            const size_t crow = (size_t)NLAT + (size_t)b * CTXL; const int tq = chunk * 32 + ql;
            const int qc = (kind == 0 ? C_QA + h * 64 : C_QN + h * 64) + 32 * hf, kc = (kind == 0 ? C_KA + (h / 3) * 64 : C_KN + h * 64) + 32 * hf, vc = (kind == 0 ? C_VA + (h / 3) * 64 : C_VN + h * 64) + 32 * hf;
            float q[32]; load_row32(PB + (crow + tq) * INW + qc, q, 0.125f);
            AttnState st; attn_init(st);
            attn_segment(q, st, PB + crow * INW + kc, PB + crow * INW + vc, 0, CTXL, [&](int, float d) { return d; });
            if (kind == 0) attn_sink(st, sink[h]);
            attn_store(st, OB + (crow + tq) * DM + (kind == 0 ? 0 : 640) + h * 64 + 32 * hf);
        }
    }
#endif
}

namespace fa {
typedef short v4i16_t __attribute__((ext_vector_type(4)));
typedef float f32x2_t __attribute__((ext_vector_type(2))); typedef __bf16 bf16x2_t __attribute__((ext_vector_type(2)));
__device__ __forceinline__ unsigned cvtpk(float lo, float hi) { f32x2_t v = {lo, hi}; bf16x2_t b = __builtin_convertvector(v, bf16x2_t); return __builtin_bit_cast(unsigned, b); }
constexpr float LOG2E = 1.4426950408889634f, SC = 0.125f * LOG2E;
constexpr int CHUNK_BYTES = 32768;
constexpr int BIAS_OFF = 3 * CHUNK_BYTES;
constexpr float THR = 8.f;
__device__ __forceinline__ int na_rs(int r) { return min(max(r - 4, 0), 128 - 8); }
__device__ __forceinline__ void glds16(const void* gsrc, unsigned lds_dst) { unsigned keep;
    asm volatile("s_mov_b32 %0, m0\n\ts_mov_b32 m0, %2\n\ts_nop 0\n\tglobal_load_lds_dwordx4 %1, off\n\ts_mov_b32 m0, %0" : "=&s"(keep) : "v"(gsrc), "s"(lds_dst) : "memory"); }
#define FA_WAIT_BAR(N) asm volatile("s_waitcnt vmcnt(" #N ") lgkmcnt(0)\n\ts_barrier" ::: "memory")
__device__ __forceinline__ float max3f(float a, float b, float c) { float r; asm("v_max3_f32 %0, %1, %2, %3" : "=v"(r) : "v"(a), "v"(b), "v"(c)); return r; }
__device__ __forceinline__ float max8f(const f32x4& a, const f32x4& b) { return max3f(max3f(max3f(a[0], a[1], a[2]), a[3], b[0]), max3f(b[1], b[2], b[3]), -INFINITY); }
typedef float f32x16 __attribute__((ext_vector_type(16)));
__device__ __forceinline__ float max16f(const f32x16& a) {
    float x = max3f(a[0], a[1], a[2]); x = max3f(x, a[3], a[4]); x = max3f(x, a[5], a[6]); x = max3f(x, a[7], a[8]); x = max3f(x, a[9], a[10]); x = max3f(x, a[11], a[12]); x = max3f(x, a[13], a[14]);
    return fmaxf(x, a[15]);
}
typedef float f32x2v __attribute__((ext_vector_type(2)));
template <int MODE>
__device__ __forceinline__ void unit32(f32x16 (&o)[2], float& m, float& ls, const bf16x8 (&q)[4], const LAS unsigned char* Kt0, const LAS unsigned char* Kt1, const LAS unsigned char* Vt0, const LAS unsigned char* Vt1,
                                       const int (&kb)[4], const int (&vb)[2], bool rel0, bool rel1, bool mk0, bool mk1, int tb0, int tb1, const f32x16& fmask, const LAS float* bp0, const LAS float* bp1) {
    f32x16 s[2]; float tm = -INFINITY;
#pragma unroll
    for (int t = 0; t < 2; ++t) {
        if (!(t == 0 ? rel0 : rel1)) continue;
        const LAS unsigned char* Kt = t == 0 ? Kt0 : Kt1;
        bf16x8 kf[4];
#pragma unroll
        for (int ks = 0; ks < 4; ++ks) kf[ks] = *(const LAS bf16x8*)(Kt + kb[ks]);
        f32x16 acc = __builtin_amdgcn_mfma_f32_32x32x16_bf16(kf[0], q[0], (f32x16){0.f, 0.f, 0.f, 0.f, 0.f, 0.f, 0.f, 0.f, 0.f, 0.f, 0.f, 0.f, 0.f, 0.f, 0.f, 0.f}, 0, 0, 0);
#pragma unroll
        for (int ks = 1; ks < 4; ++ks) acc = __builtin_amdgcn_mfma_f32_32x32x16_bf16(kf[ks], q[ks], acc, 0, 0, 0);
        if (MODE == 2) {
            const LAS float* bp = t == 0 ? bp0 : bp1;
#pragma unroll
            for (int r = 0; r < 16; ++r) acc[r] = __builtin_fmaf(acc[r], SC, bp[(r & 3) + 8 * (r >> 2)]) + fmask[r];
        } else {
            if (MODE == 1 && (t == 0 ? mk0 : mk1)) { const int tb = t == 0 ? tb0 : tb1;
#pragma unroll
                for (int r = 0; r < 16; ++r) acc[r] = ((unsigned)(tb - ((r & 3) + 8 * (r >> 2))) <= 256u) ? acc[r] : -INFINITY;
            } else asm volatile("s_nop 15\n\ts_nop 7" : "+v"(acc));
        }
        s[t] = acc;
        tm = fmaxf(tm, max16f(acc));
    }
    if (MODE != 2) tm *= SC;
    if (__any(tm > m + THR)) {
        const float mn = fmaxf(m, xor32_max(tm)), al = __builtin_amdgcn_exp2f(m - mn); m = mn; ls *= al;
#pragma unroll
        for (int d = 0; d < 2; ++d) o[d] = o[d] * al;
    }
    const float nm = -m; f32x2v ps2 = {0.f, 0.f};
#pragma unroll
    for (int t = 0; t < 2; ++t) {
        if (!(t == 0 ? rel0 : rel1)) continue;
        const LAS unsigned char* Vt = t == 0 ? Vt0 : Vt1;
        f32x16 pv = MODE == 2 ? s[t] + nm : s[t] * SC + nm;
#pragma unroll
        for (int r = 0; r < 16; ++r) pv[r] = __builtin_amdgcn_exp2f(pv[r]);
#pragma unroll
        for (int r = 0; r < 16; r += 2) ps2 += (f32x2v){pv[r], pv[r + 1]};
#pragma unroll
        for (int st = 0; st < 2; ++st) {
            u32x4 pw; pw.x = cvtpk(pv[8 * st + 0], pv[8 * st + 1]); pw.y = cvtpk(pv[8 * st + 2], pv[8 * st + 3]); pw.z = cvtpk(pv[8 * st + 4], pv[8 * st + 5]); pw.w = cvtpk(pv[8 * st + 6], pv[8 * st + 7]);
            const bf16x8 pb = __builtin_bit_cast(bf16x8, pw);
#pragma unroll
            for (int db = 0; db < 2; ++db) {
                const v4i16_t t0 = __builtin_amdgcn_ds_read_tr16_b64_v4i16((LAS v4i16_t*)(Vt + st * 2048 + vb[db])), t1 = __builtin_amdgcn_ds_read_tr16_b64_v4i16((LAS v4i16_t*)(Vt + st * 2048 + 1024 + vb[db]));
                const bf16x8 vf = (bf16x8){t0[0], t0[1], t0[2], t0[3], t1[0], t1[1], t1[2], t1[3]};
                o[db] = __builtin_amdgcn_mfma_f32_32x32x16_bf16(vf, pb, o[db], 0, 0, 0);
            }
        }
    }
    ls += ps2[0] + ps2[1];
}
template <int KIND>
__device__ __forceinline__ void attn_item(const Params& p, int l, int item, LAS unsigned char* lds, int tid) {
    constexpr bool ISA = (KIND == 0 || KIND == 2);
    constexpr int NG = ISA ? 2 : 1;
    const int lane = tid & 63, w = __builtin_amdgcn_readfirstlane(tid >> 6), ql = lane & 31, hh = lane >> 5;
    const bf16_t* PB = (const bf16_t*)(p.ws + WS_PB); bf16_t* OB = (bf16_t*)(p.ws + WS_OB);
    int b, hx, blk;
    if (KIND == 0) { b = item >> 7; hx = (item >> 6) & 1; blk = item & 63; }
    else if (KIND == 1) { b = item / 192; hx = (item >> 5) % 6; blk = item & 31; }
    else if (KIND == 2) { b = item >> 2; hx = (item >> 1) & 1; blk = item & 1; }
    else { b = item / 6; hx = item % 6; blk = 0; }
    const size_t rowb = (size_t)b * SEQ, ctxb = (size_t)NLAT + (size_t)b * CTXL;
    const int kcol = ISA ? C_KA + hx * 64 : C_KN + hx * 64, vcol = ISA ? C_VA + hx * 64 : C_VN + hx * 64;
    int nwin = 0; size_t winrow0 = 0; int winpos0 = 0, krs0 = 0;
    if (KIND == 0) { const int first = blk == 0 ? 1 : 0, last = blk == 63 ? 2 : 3; nwin = last - first; winpos0 = 128 * (blk - 1 + first); winrow0 = rowb + winpos0; }
    if (KIND == 1) { krs0 = na_rs(4 * blk); nwin = (na_rs(4 * blk + 3) + 8 - krs0 + 1) >> 1; winrow0 = rowb + (size_t)krs0 * 64; }
    const int nch = nwin + 2;
    const bool active = true;
    int gh[NG], gp0[NG];
#pragma unroll
    for (int gi = 0; gi < NG; ++gi) {
        const int G = ISA ? (w < 4 ? 2 * w + gi : 8 + (w - 4)) : w;
        if (ISA) { gh[gi] = 3 * hx + (G >> 2); gp0[gi] = 128 * blk + 32 * (G & 3); }
        else if (KIND == 1) { gh[gi] = hx; gp0[gi] = 16 * (G & 3); }
        else { gh[gi] = hx; gp0[gi] = 32 * G; }
    }
    const int nrow0 = 4 * blk + 2 * (w >> 2);
    const int nrq = nrow0 + (ql >> 4), ncq = gp0[0] + (ql & 15);
#define FA_QROW(gi, ql_) (KIND == 0 ? rowb + gp0[gi] + (ql_) : KIND == 2 ? ctxb + gp0[gi] + (ql_) : KIND == 1 ? rowb + (size_t)(nrow0 + ((ql_) >> 4)) * 64 + gp0[gi] + ((ql_) & 15) : ctxb + gp0[gi] + (ql_))
    const int skey = 8 * w + (lane >> 3), spc = lane & 7;
    const int ksrc = skey * INW + kcol + ((spc ^ ((skey >> 1) & 7)) << 3);
    const int vsrc = skey * INW + vcol + (((((spc >> 1) ^ (skey & 2)) << 1) | (spc & 1)) << 3);
    const unsigned lds0 = (unsigned)(uintptr_t)lds;
    const int noff = KIND == 1 ? ((gp0[0] >> 4) == 0 ? 0 : ((gp0[0] >> 4) == 1 ? 8 : ((gp0[0] >> 4) == 2 ? 24 : 32))) : 0;
    int kb[4], kbw[4], vb[2];
#pragma unroll
    for (int ks = 0; ks < 4; ++ks) { kb[ks] = ql * 128 + (((2 * ks + hh) ^ ((ql >> 1) & 7)) << 4); kbw[ks] = ql * 128 + (((2 * ks + hh) ^ (((noff + ql) >> 1) & 7)) << 4); }
    { const int vk = 4 * hh + ((lane & 15) >> 2);
#pragma unroll
      for (int db = 0; db < 2; ++db) vb[db] = vk * 128 + (((2 * db + ((lane >> 4) & 1)) ^ (vk & 2)) << 5) + ((lane & 3) << 3); }
#define FA_DMA(ci) do { const size_t r0_ = (ci) < nwin ? winrow0 + (size_t)(ci) * 128 : ctxb + (size_t)((ci) - nwin) * 128; const bf16_t* s_ = PB + r0_ * INW; \
        const unsigned d_ = (unsigned)__builtin_amdgcn_readfirstlane((int)(lds0 + ((ci) % 3) * CHUNK_BYTES + w * 1024)); \
        glds16(s_ + ksrc, d_); glds16(s_ + 64 * INW + ksrc, d_ + 8192u); glds16(s_ + vsrc, d_ + 16384u); glds16(s_ + 64 * INW + vsrc, d_ + 24576u); } while (0)
    FA_DMA(0); FA_DMA(1);
    bf16x8 qf[NG][4];
#pragma unroll
    for (int gi = 0; gi < NG; ++gi)
#pragma unroll
        for (int ks = 0; ks < 4; ++ks) qf[gi][ks] = *(const bf16x8*)(PB + FA_QROW(gi, ql) * INW + (ISA ? C_QA : C_QN) + gh[gi] * 64 + 16 * ks + 8 * hh);
    f32x16 o[NG][2]; float m[NG], ls[NG];
#pragma unroll
    for (int gi = 0; gi < NG; ++gi) {
#pragma unroll
        for (int d = 0; d < 2; ++d)
#pragma unroll
            for (int r = 0; r < 16; ++r) o[gi][d][r] = 0.f;
        if (ISA) { m[gi] = p.attn_sink[l * 6 + gh[gi]] * LOG2E; ls[gi] = hh == 0 ? 1.f : 0.f; } else { m[gi] = -1e30f; ls[gi] = 0.f; }
    }
    f32x16 fmask;
#pragma unroll
    for (int r = 0; r < 16; ++r) fmask[r] = 0.f;
    if (KIND == 1) { const int cs = min(max(ncq - 8, 0), 48);
#pragma unroll
        for (int r = 0; r < 16; ++r) { const int ck = noff + (r & 3) + 8 * (r >> 2) + 4 * hh; fmask[r] = ((ck >= cs) && (ck < cs + 16)) ? 0.f : -INFINITY; } }
    const int nqrs = na_rs(nrq);
    LAS float* biasL = (LAS float*)(lds + BIAS_OFF);
    if (KIND == 1) { const float* rp = p.na_rpb + ((size_t)l * 6 + hx) * 15 * 31;
        for (int i = tid; i < 16 * 128; i += NTHREADS) { const int x = (i & 127) - 64; biasL[i] = (i >> 7) == 15 ? -INFINITY : ((x >= -15 && x <= 15) ? rp[(i >> 7) * 31 + x + 15] * LOG2E : 0.f); } }
    FA_WAIT_BAR(4);
#pragma unroll
    for (int gi = 0; gi < NG; ++gi) { asm volatile("" : "+v"(qf[gi][0]), "+v"(qf[gi][1]), "+v"(qf[gi][2]), "+v"(qf[gi][3])); }
#pragma unroll 1
    for (int ci = 0; ci < nch; ++ci) {
        if (ci + 2 < nch) FA_DMA(ci + 2);
        const LAS unsigned char* Kb = lds + (ci % 3) * CHUNK_BYTES; const LAS unsigned char* Vb = Kb + 16384;
        const bool iswin = ci < nwin;
        if (active) {
            if (KIND == 1 && iswin) {
                const int kr0 = krs0 + 2 * ci, rsA = na_rs(nrow0), rsB = na_rs(nrow0 + 1);
                const bool rel0 = (kr0 >= rsA) && (kr0 < rsB + 8), rel1 = (kr0 + 1 >= rsA) && (kr0 + 1 < rsB + 8);
                if (rel0 || rel1) {
                    const bool rowok0 = (kr0 >= nqrs) && (kr0 < nqrs + 8), rowok1 = (kr0 + 1 >= nqrs) && (kr0 + 1 < nqrs + 8);
                    const int bcol = 64 + noff + 4 * hh - ncq;
                    const LAS float* bp0 = biasL + (rowok0 ? kr0 - nrq + 7 : 15) * 128 + bcol; const LAS float* bp1 = biasL + (rowok1 ? kr0 + 1 - nrq + 7 : 15) * 128 + bcol;
                    unit32<2>(o[0], m[0], ls[0], qf[0], Kb + noff * 128, Kb + (64 + noff) * 128, Vb + noff * 128, Vb + (64 + noff) * 128, kbw, vb, rel0, rel1, false, false, 0, 0, fmask, bp0, bp1);
                }
            } else {
#pragma unroll 1
                for (int u = 0; u < 2; ++u) {
                    const LAS unsigned char* Kt = Kb + (64 * u) * 128; const LAS unsigned char* Vt = Vb + (64 * u) * 128;
#pragma unroll
                    for (int gi = 0; gi < NG; ++gi) {
                        if (ISA && gi == 1 && w >= 4) continue;
                        if (KIND == 0) {
                            bool rel[2] = {true, true}, msk[2] = {false, false};
                            if (iswin) {
#pragma unroll
                                for (int t = 0; t < 2; ++t) { const int j0 = winpos0 + 128 * ci + 64 * u + 32 * t, p0 = gp0[gi];
                                    rel[t] = (j0 + 31 >= p0 - 128) && (j0 <= p0 + 31 + 128); msk[t] = !((j0 >= p0 + 31 - 128) && (j0 + 31 <= p0 + 128)); } }
                            if (!(rel[0] || rel[1])) continue;
                            const int tb0 = gp0[gi] + ql - (winpos0 + 128 * ci + 64 * u) - 4 * hh + 128;
                            unit32<1>(o[gi], m[gi], ls[gi], qf[gi], Kt, Kt + 4096, Vt, Vt + 4096, kb, vb, rel[0], rel[1], msk[0], msk[1], tb0, tb0 - 32, fmask, nullptr, nullptr);
                        } else unit32<0>(o[gi], m[gi], ls[gi], qf[gi], Kt, Kt + 4096, Vt, Vt + 4096, kb, vb, true, true, false, false, 0, 0, fmask, nullptr, nullptr);
                    }
                }
            }
        }
        if (ci + 2 < nch) FA_WAIT_BAR(4); else FA_WAIT_BAR(0);
    }
#undef FA_DMA
    if (active) {
        int ql2 = lane & 31; asm volatile("" : "+v"(ql2));
#pragma unroll
        for (int gi = 0; gi < NG; ++gi) {
            if (ISA && gi == 1 && w >= 4) continue;
            const float lt = xor32_sum(ls[gi]);
            const float inv = 1.f / lt;
            bf16_t* op = OB + FA_QROW(gi, ql2) * DM + (ISA ? 0 : 640) + gh[gi] * 64 + 4 * hh;
#pragma unroll
            for (int db = 0; db < 2; ++db)
#pragma unroll
                for (int i = 0; i < 4; ++i) { u32x2 ov; ov.x = cvtpk(o[gi][db][4 * i] * inv, o[gi][db][4 * i + 1] * inv); ov.y = cvtpk(o[gi][db][4 * i + 2] * inv, o[gi][db][4 * i + 3] * inv); *(u32x2*)(op + 32 * db + 8 * i) = ov; }
        }
    }
#undef FA_QROW
}
__device__ __forceinline__ void phase_attn(const Params& p, int l, bool with_ctx, LAS unsigned char* lds, int bid, int nb) {
    bid = opaque_s(bid);
    const int n0 = NB * 2 * 64, n1 = NB * 6 * 32, n2 = with_ctx ? NB * 2 * 2 : 0, n3 = with_ctx ? NB * 6 : 0;
#pragma unroll 1
    for (int it = bid; it < n0 + n1 + n2 + n3; it += nb) {
        const int tid = opaque_tid();
#ifndef KMASK
#define KMASK 15
#endif
#ifndef ATT_DUP
#define ATT_DUP 0
#endif
        if (it < n0) { if (KMASK & 1) attn_item<0>(p, l, it, lds, tid); if (ATT_DUP & 1) attn_item<0>(p, l, it, lds, tid); }
        else if (it < n0 + n1) { if (KMASK & 2) attn_item<1>(p, l, it - n0, lds, tid); if (ATT_DUP & 2) attn_item<1>(p, l, it - n0, lds, tid); }
        else if (it < n0 + n1 + n2) { if (KMASK & 4) attn_item<2>(p, l, it - n0 - n1, lds, tid); }
        else { if (KMASK & 8) attn_item<3>(p, l, it - n0 - n1 - n2, lds, tid); }
    }
}
}

__device__ __forceinline__ float reduce16(const float (&t)[16], int lane) {
    float u[8], w4[4], x2[2];
#pragma unroll
    for (int e = 0; e < 8; ++e) { float a = t[e], b = t[e + 8]; asm volatile("s_nop 1\n\tv_permlane32_swap_b32 %0, %1" : "+v"(a), "+v"(b)); u[e] = a + b; }
#pragma unroll
    for (int e = 0; e < 4; ++e) { float a = u[e], b = u[e + 4]; asm volatile("s_nop 1\n\tv_permlane16_swap_b32 %0, %1" : "+v"(a), "+v"(b)); w4[e] = a + b; }
    const bool b3 = (lane & 8) != 0, b2 = (lane & 4) != 0;
#pragma unroll
    for (int e = 0; e < 2; ++e) { const float keep = b3 ? w4[e + 2] : w4[e], send = b3 ? w4[e] : w4[e + 2]; x2[e] = keep + dppf<0x128>(send); }
    const float keep = b2 ? x2[1] : x2[0], send = b2 ? x2[0] : x2[1];
    float y = keep + dppf<0x141>(send);
    y += dppf<0xB1>(y); y += dppf<0x4E>(y);
    return y;
}
__device__ __forceinline__ float wave_max(float v) {
    v = fmaxf(v, dppf<0xB1>(v)); v = fmaxf(v, dppf<0x4E>(v)); v = fmaxf(v, dppf<0x141>(v)); v = fmaxf(v, dppf<0x140>(v));
    return xor32_max(xor16_max(v));
}
__device__ __forceinline__ void phase_ln_router(const Params& p, int l, bool with_ctx, LAS unsigned char* lds, int bid, int nb) {
    bid = opaque_s(bid); const int tid = opaque_tid(), lane = tid & 63, gw = bid * NWAVES + (tid >> 6), NGW = nb * NWAVES;
    LAS float* wr = (LAS float*)lds;
    const float* wrg = p.w_router + (size_t)l * DM * NE;
    for (int i = tid; i < DM * NE; i += NTHREADS) { const int c = i >> 4, e = i & 15; wr[e * DM + c] = wrg[i]; }
    LAS float* lg = wr + NE * DM; LAS float* lb = lg + DM; LAS float* lsh = lb + DM; LAS float* lsc = lsh + 5 * DM;
    lds_fill(lg, p.ln1_g + l * DM, DM, tid); lds_fill(lb, p.ln1_b + l * DM, DM, tid);
    for (int r = 0; r < 5; ++r) { lds_fill(lsh + r * DM, mod_ptr(p, l, r) + 3 * DM, DM, tid); lds_fill(lsc + r * DM, mod_ptr(p, l, r) + 4 * DM, DM, tid); }
    __syncthreads();
    const bf16_t* XB = (const bf16_t*)(p.ws + WS_XB); bf16_t* HB = (bf16_t*)(p.ws + WS_HB); float* AFF = (float*)(p.ws + WS_AFF);
    const float* g = p.ln1_g + l * DM; const float* bb = p.ln1_b + l * DM;
    const int nrows = with_ctx ? NROWS : NLAT;
    int myexp; { float idx[16];
#pragma unroll
        for (int e = 0; e < 16; ++e) idx[e] = (float)e;
        myexp = (int)(reduce16(idx, lane) * (1.f / 64.f) + 0.5f); }
    f32x4 v[4], vn[4];
    if (gw < nrows) row_load_bf16(XB + (size_t)gw * DM, lane, v);
#pragma unroll 1
    for (int row = gw; row < nrows; row += NGW) {
        const int rn = row + NGW;
        if (rn < nrows) row_load_bf16(XB + (size_t)rn * DM, lane, vn);
        row_normalize(v); row_affine_l(v, lg, lb, lane);
        row_normalize(v);
        { const int mr = row_modrow(row); row_modulate_l(v, lsh + mr * DM, lsc + mr * DM, lane); }
        row_store_bf16(HB + (size_t)row * DM, lane, v);
        float t[16];
#pragma unroll
        for (int e = 0; e < 16; ++e) { float s = 0.f;
#pragma unroll
            for (int j = 0; j < 4; ++j) { const f32x4 wv = *(const LAS f32x4*)(wr + e * DM + 256 * j + 4 * lane); s += (v[j][0] * wv[0] + v[j][1] * wv[1]) + (v[j][2] * wv[2] + v[j][3] * wv[3]); }
            t[e] = s;
            if ((e & 3) == 3) asm volatile("" ::: "memory"); }
        const float lg = reduce16(t, lane);
        const float mx = wave_max(lg), ex = expf(lg - mx), sum = wave_sum(ex) * 0.25f;
        if ((lane & 3) == 0) AFF[(size_t)myexp * NROWS + row] = ex / sum;
#pragma unroll
        for (int j = 0; j < 4; ++j) v[j] = vn[j];
    }
}

__device__ __forceinline__ void topk_item(const float* aff  , int n, int k, int row0  , int e, int slot0,
                                          int* TOK, float* GATE, int* INV, LAS unsigned char* lds) {
    const int tid = opaque_tid(), lane = tid & 63, w = tid >> 6;
    LAS unsigned* keys = (LAS unsigned*)lds;
    LAS unsigned* hist = keys + 8192;
    LAS unsigned* misc = hist + 256;
    for (int i = tid; i < n; i += NTHREADS) keys[i] = __builtin_bit_cast(unsigned, aff[i]);
    if (tid == 0) { misc[0] = 0u; misc[1] = (unsigned)k; }
    __syncthreads();
    unsigned maskv = 0u;
    for (int pass = 0; pass < 4; ++pass) {
        const int shift = 24 - 8 * pass;
        if (tid < 256) hist[tid] = 0u;
        __syncthreads();
        const unsigned prefix = misc[0];
        for (int i = tid; i < n; i += NTHREADS) { const unsigned kv = keys[i]; if ((kv & maskv) == prefix) atomicAdd((unsigned*)&hist[(kv >> shift) & 255u], 1u); }
        __syncthreads();
        if (w == 0) {
            const unsigned rem = misc[1];
            const unsigned h0 = hist[4 * lane], h1 = hist[4 * lane + 1], h2 = hist[4 * lane + 2], h3 = hist[4 * lane + 3], s4 = h0 + h1 + h2 + h3;
            unsigned S = s4;
#pragma unroll
            for (int o = 1; o < 64; o <<= 1) { const unsigned y = __shfl_down(S, o); if (lane + o < 64) S += y; }
            const unsigned above = S - s4;
            if (above < rem && rem <= S) { unsigned cum = above; int bin;
                if (cum + h3 >= rem) bin = 3; else { cum += h3; if (cum + h2 >= rem) bin = 2; else { cum += h2; if (cum + h1 >= rem) bin = 1; else { cum += h1; bin = 0; } } }
                misc[0] = prefix | ((unsigned)(4 * lane + bin) << shift); misc[1] = rem - cum; }
        }
        __syncthreads();
        maskv |= 255u << shift;
    }
    const unsigned T = misc[0], need_eq = misc[1];
    __syncthreads();
    const int per = n >= NTHREADS ? n / NTHREADS : 1; const int t0 = tid * per; const bool act = t0 < n;
    unsigned ce = 0u;
    if (act) for (int i = 0; i < per; ++i) ce += (keys[t0 + i] == T) ? 1u : 0u;
    unsigned inc = ce;
#pragma unroll
    for (int o = 1; o < 64; o <<= 1) { const unsigned y = __shfl_up(inc, o); if (lane >= o) inc += y; }
    if (lane == 63) misc[16 + w] = inc;
    __syncthreads();
    unsigned base = 0u;
    for (int ww = 0; ww < w; ++ww) base += misc[16 + ww];
    unsigned eqrank = base + inc - ce;
    __syncthreads();
    unsigned cs = 0u;
    if (act) { unsigned er = eqrank; for (int i = 0; i < per; ++i) { const unsigned kv = keys[t0 + i]; if (kv > T) cs++; else if (kv == T) { if (er < need_eq) cs++; er++; } } }
    inc = cs;
#pragma unroll
    for (int o = 1; o < 64; o <<= 1) { const unsigned y = __shfl_up(inc, o); if (lane >= o) inc += y; }
    if (lane == 63) misc[16 + w] = inc;
    __syncthreads();
    base = 0u;
    for (int ww = 0; ww < w; ++ww) base += misc[16 + ww];
    unsigned pos = base + inc - cs;
    if (act) { unsigned er = eqrank; for (int i = 0; i < per; ++i) { const unsigned kv = keys[t0 + i]; bool sel = false;
            if (kv > T) sel = true; else if (kv == T) { sel = er < need_eq; er++; }
            const int row = row0 + t0 + i;
            if (sel) { const int slot = slot0 + (int)pos; TOK[slot] = row; GATE[slot] = __builtin_bit_cast(float, kv); INV[(size_t)e * NROWS + row] = slot; pos++; }
            else INV[(size_t)e * NROWS + row] = -1; } }
    __syncthreads();
}
__device__ __forceinline__ void phase_topk(const Params& p, bool with_ctx, LAS unsigned char* lds, int bid, int nb) {
    const float* AFF = (const float*)(p.ws + WS_AFF); int* TOK = (int*)(p.ws + WS_TOK); float* GATE = (float*)(p.ws + WS_GATE); int* INV = (int*)(p.ws + WS_INV);
    const int nitems = with_ctx ? 128 : 64;
    for (int it = bid; it < nitems; it += nb) {
        if (it < 64) { const int b = it >> 4, e = it & 15; topk_item(AFF + (size_t)e * NROWS + (size_t)b * SEQ, SEQ, CAP, b * SEQ, e, (b * NE + e) * CAP, TOK, GATE, INV, lds); }
        else { const int b = (it - 64) >> 4, e = it & 15; topk_item(AFF + (size_t)e * NROWS + NLAT + (size_t)b * CTXL, CTXL, CCAP, NLAT + b * CTXL, e, NSLOT_LAT + (e * NB + b) * CCAP, TOK, GATE, INV, lds); }
    }
}

__device__ __forceinline__ void phase_combine(const Params& p, int l, bool with_ctx, LAS unsigned char* lds, int bid, int nb) {
    bid = opaque_s(bid); const int tid = opaque_tid(); const int lane = tid & 63, gw = bid * NWAVES + (tid >> 6), NGW = nb * NWAVES;
    LAS float* l1g = (LAS float*)lds; LAS float* l1b = l1g + DM; LAS float* l2g = l1b + DM; LAS float* l2b = l2g + DM; LAS float* lg2 = l2b + DM; LAS float* lsh = lg2 + 5 * DM; LAS float* lsc = lsh + 5 * DM;
    lds_fill(l1g, p.ln1_g + l * DM, DM, tid); lds_fill(l1b, p.ln1_b + l * DM, DM, tid); lds_fill(l2g, p.ln2_g + l * DM, DM, tid); lds_fill(l2b, p.ln2_b + l * DM, DM, tid);
    for (int r = 0; r < 5; ++r) { lds_fill(lg2 + r * DM, mod_ptr(p, l, r) + 5 * DM, DM, tid); if (l + 1 < DEPTH) { lds_fill(lsh + r * DM, mod_ptr(p, l + 1, r), DM, tid); lds_fill(lsc + r * DM, mod_ptr(p, l + 1, r) + DM, DM, tid); } }
    __syncthreads();
    bf16_t* XB = (bf16_t*)(p.ws + WS_XB); bf16_t* HB = (bf16_t*)(p.ws + WS_HB);
    const bf16_t* Y = (const bf16_t*)(p.ws + WS_Y); const int* INV = (const int*)(p.ws + WS_INV);
    const float* g = p.ln2_g + l * DM; const float* bb = p.ln2_b + l * DM;
    const int nrows = with_ctx ? NROWS : NLAT;
    f32x4 v[4], vn[4]; int myinv = -1, myinvn = -1;
    if (gw < nrows) { row_load_bf16(XB + (size_t)gw * DM, lane, v); myinv = INV[(size_t)(lane & 15) * NROWS + gw]; }
#pragma unroll 1
    for (int row = gw; row < nrows; row += NGW) {
        bf16_t* xr = XB + (size_t)row * DM;
        const int rn = row + NGW;
        if (rn < nrows) { row_load_bf16(XB + (size_t)rn * DM, lane, vn); myinvn = INV[(size_t)(lane & 15) * NROWS + rn]; }
        f32x4 a[4];
#pragma unroll
        for (int j = 0; j < 4; ++j) a[j] = (f32x4){0.f, 0.f, 0.f, 0.f};
#pragma unroll
        for (int e = 0; e < 16; ++e) {
            const int slot = __builtin_amdgcn_readlane(myinv, e);
            if (slot >= 0) { const bf16_t* yr = Y + (size_t)slot * DM;
#pragma unroll
                for (int j = 0; j < 4; ++j) { const u32x2 wv = *(const u32x2*)(yr + 256 * j + 4 * lane); a[j][0] += bf_lo(wv.x); a[j][1] += bf_hi(wv.x); a[j][2] += bf_lo(wv.y); a[j][3] += bf_hi(wv.y); } }
        }
        row_normalize(v); row_affine_l(v, l1g, l1b, lane);
        const int mr = row_modrow(row);
#pragma unroll
        for (int j = 0; j < 4; ++j) { const f32x4 g2 = *(const LAS f32x4*)(lg2 + mr * DM + 256 * j + 4 * lane); v[j] = v[j] * ALPHA + g2 * a[j]; }
        row_normalize(v); row_affine_l(v, l2g, l2b, lane);
        if (l + 1 < DEPTH) row_store_bf16(xr, lane, v); else row_store(p.out + (size_t)row * DM, lane, v);
        if (l + 1 < DEPTH) { row_normalize(v); row_modulate_l(v, lsh + mr * DM, lsc + mr * DM, lane); row_store_bf16(HB + (size_t)row * DM, lane, v); }
#pragma unroll
        for (int j = 0; j < 4; ++j) v[j] = vn[j];
        myinv = myinvn;
    }
}

constexpr int N_PHASES = 2 + 8 * DEPTH;
#define IN(k) (lo <= (k) && (k) < hi)
#ifndef TS_SEL
#define TS_SEL -1
#endif
#define TS_MULT 8
#define SEAM(k) do { if (IN(k) && IN((k) + 1)) xcd_barrier(bar); if (TS_SEL >= 0 && blockIdx.x == 0 && threadIdx.x == 0) ((unsigned long long*)(p.ws + WS_CTL + 65536))[(k) + 1] = __builtin_amdgcn_s_memrealtime(); } while (0)
#ifndef PHMASK
#define PHMASK 0x3ff
#endif
#define PHON(i) ((PHMASK >> (i)) & 1)
#ifndef DUP_MASK
#define DUP_MASK 0
#endif
#define DUP(i) ((DUP_MASK >> (i)) & 1)
template <int l>
__device__ __forceinline__ void run_layer(const Params& p, LAS unsigned char* lds, LAS int* idxl, const XcdBarrier& bar, int bid, int nb, int lo, int hi) {
    bf16_t* HB = (bf16_t*)(p.ws + WS_HB); bf16_t* PB = (bf16_t*)(p.ws + WS_PB); bf16_t* OB = (bf16_t*)(p.ws + WS_OB);
    bf16_t* HH = (bf16_t*)(p.ws + WS_HH); bf16_t* Y = (bf16_t*)(p.ws + WS_Y);
    const int* TOK = (const int*)(p.ws + WS_TOK); const float* GATE = (const float*)(p.ws + WS_GATE);
        const int pb = 2 + 8 * l; const bool wc = (l == 0);
        if (IN(pb + 0)) { if (PHON(2)) {
            const bf16_t* W = (const bf16_t*)(p.ws + WS_WIN) + (size_t)l * INW * DM; EpiQKV E{PB, (const float*)(p.ws + WS_ROPE)};
            { SgDesc g{HB + (size_t)NLAT * DM, DM, nullptr, W, 0, 1 << 30, 1, NCTX, INW, DM, NLAT}; sg_gemm(g, E, lds, bid, nb); }
            { mg::Gemm g{HB, W, NLAT, INW, DM, nullptr, 0, 1 << 20, 1}; mg::StaticOrder S; S.init(NLAT, INW, nb, bid); mg::EpiAdapt<EpiQKV> EA{E, 0}; mg::gemm_phase(lds, idxl, g, S, EA); if (DUP(2)) mg::gemm_phase(lds, idxl, g, S, EA); } } }
        SEAM(pb + 0);
        if (IN(pb + 1)) { if (PHON(3)) {
#if FAST_ATTN
            fa::phase_attn(p, l, wc, lds, bid, nb); if (DUP(3)) fa::phase_attn(p, l, wc, lds, bid, nb);
#endif
            phase_mixers(p, l, wc, bid, nb); } }
        SEAM(pb + 1);
        if (IN(pb + 2)) { if (PHON(4)) {
            const bf16_t* W = (const bf16_t*)(p.ws + WS_WOUT) + (size_t)l * DM * DM;
            EpiOut<l == 0> E{p.x, p.ctx, (bf16_t*)(p.ws + WS_XB), mod_ptr(p, l, 0)};
            if (wc) { SgDesc g{OB + (size_t)NLAT * DM, DM, nullptr, W, 0, 1 << 30, 1, NCTX, DM, DM, NLAT}; sg_gemm(g, E, lds, bid, nb); }
            { mg::Gemm g{OB, W, NLAT, DM, DM, nullptr, 0, 1 << 20, 1}; mg::StaticOrder S; S.init(NLAT, DM, nb, bid); mg::EpiAdapt<EpiOut<l == 0>> EA{E, 0}; mg::gemm_phase(lds, idxl, g, S, EA); if (DUP(4) && l == 0) mg::gemm_phase(lds, idxl, g, S, EA); } } }
        SEAM(pb + 2);
        if (IN(pb + 3)) { if (PHON(5)) phase_ln_router(p, l, wc, lds, bid, nb); }
        SEAM(pb + 3);
        if (IN(pb + 4)) { if (PHON(6)) { phase_topk(p, wc, lds, bid, nb); if (DUP(6)) phase_topk(p, wc, lds, bid, nb);
            { const int busy = wc ? 128 : 64;
              if (bid >= busy && nb > busy) phase_weights(p, lds, bid - busy, nb - busy, l == 0 ? TR_P0 : TR_SPLIT, l == 0 ? TR_SPLIT : 2 * TR_PER_L); } } }
        SEAM(pb + 4);
        if (IN(pb + 5)) { if (PHON(7)) {
            const bf16_t* W = (const bf16_t*)(p.ws + WS_WGU) + (size_t)l * NE * 1024 * DM; EpiGU E{HH};
            if (wc) { SgDesc g{HB, DM, TOK + NSLOT_LAT, W, (size_t)1024 * DM, NB * CCAP, NE, NSLOT_CTX, 1024, DM, NSLOT_LAT}; sg_gemm(g, E, lds, bid, nb); }
            { mg::Gemm g{HB, W, NSLOT_LAT, 1024, DM, TOK, (size_t)1024 * DM, CAP / 256, NE}; mg::StaticOrder S; S.init(NSLOT_LAT, 1024, nb, bid); mg::EpiAdapt<EpiGU> EA{E, 0}; mg::gemm_phase(lds, idxl, g, S, EA); if (DUP(7)) mg::gemm_phase(lds, idxl, g, S, EA); } } }
        SEAM(pb + 5);
        if (IN(pb + 6)) { if (PHON(8)) {
            const bf16_t* W = (const bf16_t*)(p.ws + WS_WD) + (size_t)l * NE * DM * FF; EpiDown E{Y, GATE};
            if (wc) { SgDesc g{HH + (size_t)NSLOT_LAT * FF, FF, nullptr, W, (size_t)DM * FF, NB * CCAP, NE, NSLOT_CTX, DM, FF, NSLOT_LAT}; sg_gemm(g, E, lds, bid, nb); }
            { mg::Gemm g{HH, W, NSLOT_LAT, DM, FF, nullptr, (size_t)DM * FF, CAP / 256, NE}; mg::StaticOrder S; S.init(NSLOT_LAT, DM, nb, bid); mg::EpiAdapt<EpiDown> EA{E, 0}; mg::gemm_phase(lds, idxl, g, S, EA); if (DUP(8)) mg::gemm_phase(lds, idxl, g, S, EA); } } }
        SEAM(pb + 6);
        if (IN(pb + 7)) { if (PHON(9)) phase_combine(p, l, wc, lds, bid, nb); }
        SEAM(pb + 7);
}
__global__ void __launch_bounds__(NTHREADS, 2) fwd_kernel(Params p) {
    extern __shared__ __attribute__((aligned(16))) unsigned char lds_raw[];
    LAS unsigned char* lds = (LAS unsigned char*)lds_raw;
    const int bid = blockIdx.x, nb = gridDim.x;
    volatile LAS unsigned* MISC = (volatile LAS unsigned*)(lds + LDS_BYTES - 64);
    LAS int* idxl = (LAS int*)(lds + mg::STAGE_BYTES);
    if (threadIdx.x < 16) MISC[threadIdx.x] = 0u;
    __syncthreads();
    XcdBarrier bar; bar.bar = (unsigned*)(p.ws + WS_CTL) + CW_BAR; bar.x = 0; bar.st = nullptr;
    const bool multi = p.ph_hi - p.ph_lo > 1;
    if (multi) bar = xcd_barrier_post((unsigned*)(p.ws + WS_CTL) + CW_BAR, MISC + 8);
    bf16_t* HB = (bf16_t*)(p.ws + WS_HB); bf16_t* PB = (bf16_t*)(p.ws + WS_PB); bf16_t* OB = (bf16_t*)(p.ws + WS_OB);
    bf16_t* HH = (bf16_t*)(p.ws + WS_HH); bf16_t* Y = (bf16_t*)(p.ws + WS_Y);
    const int* TOK = (const int*)(p.ws + WS_TOK); const float* GATE = (const float*)(p.ws + WS_GATE);
    const int lo = p.ph_lo, hi = p.ph_hi;
    if (TS_SEL >= 0 && blockIdx.x == 0 && threadIdx.x == 0) ((unsigned long long*)(p.ws + WS_CTL + 65536))[0] = __builtin_amdgcn_s_memrealtime();
    if (IN(0)) { if (PHON(0)) { phase_prologue(p, lds, bid, nb); __syncthreads(); phase_weights(p, lds, bid, nb, 0, TR_P0); } } SEAM(0);
    if (IN(1)) { if (PHON(1)) phase_ln1(p, bid, nb); if (DUP(1)) phase_ln1(p, bid, nb); } SEAM(1);
    run_layer<0>(p, lds, idxl, bar, bid, nb, lo, hi);
    run_layer<1>(p, lds, idxl, bar, bid, nb, lo, hi);
    if (TS_SEL >= 0 && blockIdx.x == 0 && threadIdx.x == 0) {
        volatile unsigned long long* ts = (volatile unsigned long long*)(p.ws + WS_CTL + 65536); const unsigned long long dt = (ts[TS_SEL + 1] - ts[TS_SEL]) * TS_MULT, t0 = __builtin_amdgcn_s_memrealtime();
        while (__builtin_amdgcn_s_memrealtime() - t0 < dt) __builtin_amdgcn_s_sleep(8); }
#undef IN
#undef SEAM
}

#ifndef N_LAUNCH_SPLIT
#define N_LAUNCH_SPLIT 0
#endif
extern "C" void kernel_launch(void* const* d_in, const int* in_sizes, int n_in, void* d_out, int out_size, void* d_ws, size_t ws_size, hipStream_t stream) {
    static int grid = 0;
    if (grid == 0) {
        if (n_in != 19 || in_sizes[0] != NLAT * DM || out_size != NLAT * DM || ws_size < WS_END) { fprintf(stderr, "kernel_launch: unexpected shapes (n_in %d, in0 %d, out %d, ws %zu)\n", n_in, n_in > 0 ? in_sizes[0] : -1, out_size, ws_size); grid = -1; return; }
        int dev = 0, cus = 0, per_cu = 0;
        if (hipGetDevice(&dev) != hipSuccess || hipDeviceGetAttribute(&cus, hipDeviceAttributeMultiprocessorCount, dev) != hipSuccess) { grid = -1; return; }
        if (hipFuncSetAttribute((const void*)fwd_kernel, hipFuncAttributeMaxDynamicSharedMemorySize, LDS_BYTES) != hipSuccess) { fprintf(stderr, "kernel_launch: hipFuncSetAttribute failed\n"); grid = -1; return; }
        if (hipOccupancyMaxActiveBlocksPerMultiprocessor(&per_cu, (const void*)fwd_kernel, NTHREADS, LDS_BYTES) != hipSuccess || per_cu < 1) { fprintf(stderr, "kernel_launch: occupancy query says %d\n", per_cu); per_cu = 1; }
        (void)hipGetLastError();
        grid = cus;
    }
    if (grid < 0) return;
    (void)hipMemsetAsync((char*)d_ws + WS_CTL, 0, CTL_ZERO_BYTES, stream);
    Params p{};
    const float** pp = (const float**)&p;
    for (int i = 0; i < 19; ++i) pp[i] = (const float*)d_in[i];
    p.out = (float*)d_out; p.ws = (unsigned char*)d_ws;
#if N_LAUNCH_SPLIT
    for (int ph = 0; ph < N_PHASES; ++ph) { p.ph_lo = ph; p.ph_hi = ph + 1; hipLaunchKernelGGL(fwd_kernel, dim3(grid), dim3(NTHREADS), LDS_BYTES, stream, p); }
#else
    p.ph_lo = 0; p.ph_hi = N_PHASES;
    void* args[] = {&p};
    hipError_t e = hipLaunchCooperativeKernel((const void*)fwd_kernel, dim3(grid), dim3(NTHREADS), args, LDS_BYTES, stream);
    if (e != hipSuccess) fprintf(stderr, "kernel_launch: cooperative launch failed: %s\n", hipGetErrorString(e));
#endif
}
```

```cpp
#include <hip/hip_runtime.h>
#include <hip/hip_cooperative_groups.h>
#include <cstdio>
#include <cstdint>
#include <cmath>

#define LAS __attribute__((address_space(3)))
typedef unsigned short bf16_t;
typedef short bf16x8 __attribute__((ext_vector_type(8)));
typedef float f32x4 __attribute__((ext_vector_type(4)));
typedef unsigned u32x4 __attribute__((ext_vector_type(4)));
typedef unsigned u32x2 __attribute__((ext_vector_type(2)));

constexpr int NB = 4, SEQ = 8192, DM = 1024, CTXL = 256, DEPTH = 2;
constexpr int NLAT = NB * SEQ, NCTX = NB * CTXL, NROWS = NLAT + NCTX;
constexpr int INW = 2560, NE = 16, FF = 512, CAP = 1024, CCAP = 32;
constexpr int NSLOT_LAT = NB * NE * CAP, NSLOT_CTX = NB * NE * CCAP, NSLOT = NSLOT_LAT + NSLOT_CTX;
constexpr int NMOD = 6 * DM;
constexpr float LN_EPS = 1e-6f;
constexpr float ALPHA = 1.41421356237309515f;
constexpr int C_QA = 0, C_KA = 384, C_VA = 512, C_BX = 640, C_BB = 896, C_BC = 1152, C_QN = 1408, C_KN = 1792, C_VN = 2176;

#ifndef FAST_ATTN
#define FAST_ATTN 1
#endif
constexpr int NTHREADS = 512, NWAVES = 8;
constexpr int LDS_BYTES = 147456;

constexpr size_t MiB = 1u << 20;
constexpr size_t WS_CTL = 0, CTL_ZERO_BYTES = 128 * 1024;
constexpr size_t WS_ROPE = 1 * MiB;
constexpr size_t WS_MOD = 1 * MiB + 65536;
constexpr size_t WS_AFF = 2 * MiB;
constexpr size_t WS_INV = 5 * MiB;
constexpr size_t WS_TOK = 8 * MiB;
constexpr size_t WS_GATE = 8 * MiB + 512 * 1024;
constexpr size_t WS_CXR = 9 * MiB;
constexpr size_t WS_WIN = 16 * MiB;
constexpr size_t WS_WOUT = 26 * MiB;
constexpr size_t WS_WGU = 30 * MiB;
constexpr size_t WS_WD = 94 * MiB;
constexpr size_t WS_HB = 126 * MiB;
constexpr size_t WS_OB = 192 * MiB;
constexpr size_t WS_HH = 192 * MiB;
constexpr size_t WS_PB = 258 * MiB;
constexpr size_t WS_Y = 258 * MiB;
constexpr size_t WS_XB = 424 * MiB;
constexpr size_t WS_END = 490 * MiB;
static_assert(WS_HB + (size_t)NROWS * DM * 2 <= WS_OB && WS_OB + (size_t)NROWS * DM * 2 <= WS_PB && WS_PB + (size_t)NROWS * INW * 2 <= WS_XB && WS_XB + (size_t)NROWS * DM * 2 <= WS_END, "ws map");
static_assert((size_t)NSLOT * FF * 2 <= (size_t)NROWS * DM * 2 && (size_t)NSLOT * DM * 2 <= (size_t)NROWS * INW * 2, "overlays");
constexpr int CW_BAR = 4096;

struct Params {
    const float *x, *c, *ctx, *c_ctx, *w_mod, *b_mod, *w_in, *conv_w, *attn_sink, *na_rpb, *w_out, *ln1_g, *ln1_b, *w_router, *w_gate, *w_up, *w_down, *ln2_g, *ln2_b;
    float* out; unsigned char* ws;
    int ph_lo, ph_hi;
};

__device__ __forceinline__ unsigned f2bf(float f) { unsigned u = __builtin_bit_cast(unsigned, f); return (u + 0x7fffu + ((u >> 16) & 1u)) >> 16; }
typedef float f32x2_cv __attribute__((ext_vector_type(2))); typedef __bf16 bf16x2_cv __attribute__((ext_vector_type(2)));
__device__ __forceinline__ unsigned pk2(float lo, float hi) { f32x2_cv v = {lo, hi}; bf16x2_cv b = __builtin_convertvector(v, bf16x2_cv); return __builtin_bit_cast(unsigned, b); }
__device__ __forceinline__ float bf_lo(unsigned w) { return __builtin_bit_cast(float, w << 16); }
__device__ __forceinline__ float bf_hi(unsigned w) { return __builtin_bit_cast(float, w & 0xffff0000u); }
template <int CTRL> __device__ __forceinline__ float dppf(float v) { return __builtin_bit_cast(float, __builtin_amdgcn_update_dpp(0, __builtin_bit_cast(int, v), CTRL, 0xf, 0xf, true)); }
__device__ __forceinline__ void swap16(float v, float& a, float& b) { a = v; b = v; asm volatile("s_nop 1\n\tv_permlane16_swap_b32 %0, %1" : "+v"(a), "+v"(b)); }
__device__ __forceinline__ void swap32(float v, float& a, float& b) { a = v; b = v; asm volatile("s_nop 1\n\tv_permlane32_swap_b32 %0, %1" : "+v"(a), "+v"(b)); }
__device__ __forceinline__ float xor16_sum(float v) { float a, b; swap16(v, a, b); return a + b; }
__device__ __forceinline__ float xor32_sum(float v) { float a, b; swap32(v, a, b); return a + b; }
__device__ __forceinline__ float xor16_max(float v) { float a, b; swap16(v, a, b); return fmaxf(a, b); }
__device__ __forceinline__ float xor32_max(float v) { float a, b; swap32(v, a, b); return fmaxf(a, b); }
__device__ __forceinline__ float wave_sum(float v) {
    v += dppf<0xB1>(v); v += dppf<0x4E>(v); v += dppf<0x141>(v); v += dppf<0x140>(v);
    return xor32_sum(xor16_sum(v));
}
#define LDS_WAIT() asm volatile("s_waitcnt lgkmcnt(0)" ::: "memory")
__device__ __forceinline__ int opaque_tid() { int t = threadIdx.x; asm volatile("" : "+v"(t)); return t; }
__device__ __forceinline__ int opaque_s(int v) { asm volatile("" : "+s"(v)); return v; }

__device__ __forceinline__ float* mod_ptr(const Params& p, int l, int r) { return (float*)(p.ws + WS_MOD) + ((size_t)l * 5 + r) * NMOD; }

#define XB_TMO      128
#define XB_XCNT(j)  (256  + 64 * (j))
#define XB_XSUB(j)  (1280 + 64 * (j))
#define XB_XGEN(j)  (2304 + 64 * (j))
#define XB_TOP      3328
#define XB_TOPGEN   3392
#define XCD_BAR_WORDS 3456
#define XB_SPIN_CAP (1u << 20)
__device__ __forceinline__ unsigned xb_ld(unsigned* p)              { return __hip_atomic_load(p, __ATOMIC_RELAXED, __HIP_MEMORY_SCOPE_AGENT); }
__device__ __forceinline__ unsigned xb_add(unsigned* p, unsigned v) { return __hip_atomic_fetch_add(p, v, __ATOMIC_RELAXED, __HIP_MEMORY_SCOPE_AGENT); }
__device__ __forceinline__ unsigned xb_xcc_id() { return (unsigned)__builtin_amdgcn_s_getreg((3 << 11) | 20) & 0xFu; }
#define XB_SPIN(cond, bar) do { unsigned _sp = 0; while (cond) { __builtin_amdgcn_s_sleep(1); \
    if ((++_sp & 255u) == 0u) { if (xb_ld(&(bar)[XB_TMO])) break; if (_sp > XB_SPIN_CAP) { atomicAdd(&(bar)[XB_TMO], 1u); break; } } } } while (0)
struct XcdBarrier { unsigned* bar; unsigned x; volatile LAS unsigned* st; };
__device__ __forceinline__ XcdBarrier xcd_barrier_post(unsigned* bar, volatile LAS unsigned* st) {
    XcdBarrier b; b.bar = bar; b.x = xb_xcc_id(); b.st = st;
    if (threadIdx.x == 0) (void)xb_add(&bar[XB_XCNT(b.x)], 1u);
    return b;
}
__device__ __forceinline__ void xcd_barrier_complete(unsigned* bar, unsigned x, unsigned& nloc, unsigned& nx) {
    const unsigned G = gridDim.x * gridDim.y * gridDim.z;
    unsigned sum, cnt, mine, sp = 0u;
    for (;;) {
        sum = 0u; cnt = 0u; mine = 0u;
#pragma unroll 1
        for (unsigned j = 0; j < 16; ++j) { const unsigned c = xb_ld(&bar[XB_XCNT(j)]); sum += c; cnt += (c > 0u) ? 1u : 0u; mine = (j == x) ? c : mine; }
        if (sum == G) break;
        __builtin_amdgcn_s_sleep(1);
        if ((++sp & 255u) == 0u) { if (xb_ld(&bar[XB_TMO])) break; if (sp > XB_SPIN_CAP) { atomicAdd(&bar[XB_TMO], 1u); break; } }
    }
    nloc = mine > 0u ? mine : 1u; nx = cnt > 0u ? cnt : 1u;
}
__device__ __forceinline__ void xcd_barrier(const XcdBarrier& b) {
    asm volatile("s_waitcnt vmcnt(0)" ::: "memory");
    __syncthreads();
    if (threadIdx.x == 0) {
        unsigned* bar = b.bar; asm volatile("" : "+s"(bar));
        __builtin_amdgcn_s_waitcnt(0);
        unsigned nloc = b.st[0], nx = b.st[1];
        if (nloc == 0u) { xcd_barrier_complete(bar, b.x, nloc, nx); b.st[0] = nloc; b.st[1] = nx; }
        const unsigned old = xb_add(&bar[XB_XSUB(b.x)], 1u);
        const unsigned gen = old / nloc;
        if (old + 1u == (gen + 1u) * nloc) {
            __builtin_amdgcn_fence(__ATOMIC_RELEASE, "agent");
            asm volatile("s_waitcnt vmcnt(0)" ::: "memory");
            const unsigned og = xb_add(&bar[XB_TOP], 1u);
            const unsigned tg = og / nx;
            if (og + 1u == (tg + 1u) * nx) xb_add(&bar[XB_TOPGEN], 1u);
            else XB_SPIN(xb_ld(&bar[XB_TOPGEN]) == tg, bar);
            __builtin_amdgcn_fence(__ATOMIC_ACQUIRE, "agent");
            xb_add(&bar[XB_XGEN(b.x)], 1u);
            asm volatile("s_waitcnt vmcnt(0)" ::: "memory");
        } else {
            XB_SPIN(xb_ld(&bar[XB_XGEN(b.x)]) == gen, bar);
            __builtin_amdgcn_fence(__ATOMIC_ACQUIRE, "agent");
            asm volatile("s_waitcnt vmcnt(0)" ::: "memory");
        }
    }
    __syncthreads();
}

struct TrItem { const float* W; bf16_t* WT; int K, N, mode, item; };
__device__ __forceinline__ void tr_load(const TrItem& t, int lane, float (&r)[32]) {
    const int nblk = t.N / 32, kb = t.item / nblk, nb = t.item % nblk, k0 = 64 * kb, n0 = 32 * nb;
    const float* src = t.W + (size_t)(k0 + (lane >> 5)) * t.N + n0 + (lane & 31);
#pragma unroll
    for (int i = 0; i < 32; ++i) r[i] = src[(size_t)(2 * i) * t.N];
}
__device__ __forceinline__ void tr_finish(const TrItem& t, int lane, const float (&r)[32], LAS float* scr) {
    const int nblk = t.N / 32, kb = t.item / nblk, nb = t.item % nblk, k0 = 64 * kb, n0 = 32 * nb;
#pragma unroll
    for (int i = 0; i < 32; ++i) scr[(2 * i + (lane >> 5)) * 33 + (lane & 31)] = r[i];
    LDS_WAIT();
    const int c = lane & 7;
#pragma unroll
    for (int j = 0; j < 4; ++j) {
        const int n = (lane >> 3) + 8 * j; const LAS float* s = scr + (8 * c) * 33 + n;
        u32x4 o; o.x = pk2(s[0 * 33], s[1 * 33]); o.y = pk2(s[2 * 33], s[3 * 33]); o.z = pk2(s[4 * 33], s[5 * 33]); o.w = pk2(s[6 * 33], s[7 * 33]);
        const int f = n0 + n;
        const int orow = t.mode == 0 ? ((f & ~255) + 128 * ((f >> 4) & 1) + 32 * ((f >> 6) & 3) + 16 * ((f >> 2) & 1) + 4 * (2 * ((f >> 5) & 1) + ((f >> 3) & 1)) + (f & 3))
                                     : (256 * (f >> 7) + (t.mode == 2 ? 128 : 0) + 32 * ((f >> 5) & 3) + 16 * ((f >> 2) & 1) + 4 * ((f >> 3) & 3) + (f & 3));
        *(u32x4*)(t.WT + (size_t)orow * t.K + k0 + 8 * c) = o;
    }
    LDS_WAIT();
}
__device__ __forceinline__ void phase_prologue(const Params& p, LAS unsigned char* lds, int bid, int nb) {
    bid = opaque_s(bid); const int tid = opaque_tid(), lane = tid & 63, w = tid >> 6;
    {
        LAS float* ssil = (LAS float*)lds;
        LAS float* red = ssil + 5 * 1024;
        for (int i = tid; i < 5 * 1024; i += NTHREADS) { const int r = i >> 10, k = i & 1023; const float v = r < 4 ? p.c[r * 1024 + k] : p.c_ctx[k]; ssil[i] = v / (1.f + expf(-v)); }
        __syncthreads();
        for (int item = bid; item < 2 * 96; item += nb) {
            const int l = item / 96, n0 = (item % 96) * 64;
            const float* W = p.w_mod + (size_t)l * DM * NMOD + n0 + lane;
            float a0 = 0.f, a1 = 0.f, a2 = 0.f, a3 = 0.f, a4 = 0.f;
#pragma unroll 8
            for (int k = w * 128; k < w * 128 + 128; ++k) {
                const float wv = W[(size_t)k * NMOD];
                a0 += ssil[k] * wv; a1 += ssil[1024 + k] * wv; a2 += ssil[2048 + k] * wv; a3 += ssil[3072 + k] * wv; a4 += ssil[4096 + k] * wv;
            }
            red[(w * 5 + 0) * 64 + lane] = a0; red[(w * 5 + 1) * 64 + lane] = a1; red[(w * 5 + 2) * 64 + lane] = a2; red[(w * 5 + 3) * 64 + lane] = a3; red[(w * 5 + 4) * 64 + lane] = a4;
            __syncthreads();
            if (tid < 320) { const int r = tid >> 6; float s = 0.f;
#pragma unroll
                for (int ww = 0; ww < 8; ++ww) s += red[(ww * 5 + r) * 64 + lane];
                mod_ptr(p, l, r)[n0 + lane] = s + p.b_mod[l * NMOD + n0 + lane]; }
            __syncthreads();
        }
    }
    if (bid == nb - 1) {
        float* rope = (float*)(p.ws + WS_ROPE);
        for (int e = tid; e < 128 * 16; e += NTHREADS) {
            const int pos = e >> 4, i = e & 15;
            const double a = exp(-((double)i / 16.0) * 9.210340371976184);
            const double a2 = a * a; double c = 1.0, s = a, tc = 1.0, ts = a;
            for (int n = 1; n <= 14; ++n) { tc *= -a2 / (double)((2 * n - 1) * (2 * n)); c += tc; ts *= -a2 / (double)((2 * n) * (2 * n + 1)); s += ts; }
            double rc = 1.0, rs = 0.0, bc = c, bs = s; int q = pos;
            while (q) { if (q & 1) { const double t = rc * bc - rs * bs; rs = rc * bs + rs * bc; rc = t; } const double t = bc * bc - bs * bs; bs = 2.0 * bc * bs; bc = t; q >>= 1; }
            rope[2 * e] = (float)rc; rope[2 * e + 1] = (float)rs;
        }
    }
}

constexpr int TR_I_IN = 16 * 80, TR_I_OUT = 16 * 32, TR_I_G = 16 * 16, TR_I_D = 8 * 32, TR_PER_L = TR_I_IN + TR_I_OUT + 16 * (2 * TR_I_G + TR_I_D);
constexpr int TR_P0 = TR_I_IN + TR_I_OUT, TR_SPLIT = TR_PER_L + TR_I_IN + TR_I_OUT;
__device__ __forceinline__ void phase_weights(const Params& p, LAS unsigned char* lds, int bid, int nb, int lo, int hi) {
    bid = opaque_s(bid); const int tid = opaque_tid(), lane = tid & 63, w = tid >> 6;
    {
        LAS float* scr = (LAS float*)lds + w * (64 * 33);
        const int gw = bid * NWAVES + w, NGW = nb * NWAVES;
        constexpr int I_IN = TR_I_IN, I_OUT = TR_I_OUT, I_G = TR_I_G, I_D = TR_I_D, PER_L = TR_PER_L;
        auto decode = [&](int it) -> TrItem {
            const int l = it / PER_L; int r = it % PER_L;
            if (r < I_IN) return TrItem{p.w_in + (size_t)l * DM * INW, (bf16_t*)(p.ws + WS_WIN) + (size_t)l * INW * DM, DM, INW, 0, r}; r -= I_IN;
            if (r < I_OUT) return TrItem{p.w_out + (size_t)l * DM * DM, (bf16_t*)(p.ws + WS_WOUT) + (size_t)l * DM * DM, DM, DM, 0, r}; r -= I_OUT;
            if (r < 16 * I_G) { const int e = r / I_G; return TrItem{p.w_gate + ((size_t)l * NE + e) * DM * FF, (bf16_t*)(p.ws + WS_WGU) + ((size_t)l * NE + e) * 1024 * DM, DM, FF, 1, r % I_G}; } r -= 16 * I_G;
            if (r < 16 * I_G) { const int e = r / I_G; return TrItem{p.w_up + ((size_t)l * NE + e) * DM * FF, (bf16_t*)(p.ws + WS_WGU) + ((size_t)l * NE + e) * 1024 * DM, DM, FF, 2, r % I_G}; } r -= 16 * I_G;
            const int e = r / I_D; return TrItem{p.w_down + ((size_t)l * NE + e) * FF * DM, (bf16_t*)(p.ws + WS_WD) + ((size_t)l * NE + e) * DM * FF, FF, DM, 0, r % I_D};
        };
        float ra[32], rb[32];
        int it = lo + gw;
        if (it < hi) { TrItem cur = decode(it); tr_load(cur, lane, ra);
#pragma unroll 1
            for (;;) {
                const int itn = it + NGW; const bool hn = itn < hi; TrItem nx = cur;
                if (hn) { nx = decode(itn); tr_load(nx, lane, rb); }
                tr_finish(cur, lane, ra, scr);
                if (!hn) break;
                const int itn2 = itn + NGW; const bool hn2 = itn2 < hi; TrItem nx2 = nx;
                if (hn2) { nx2 = decode(itn2); tr_load(nx2, lane, ra); }
                tr_finish(nx, lane, rb, scr);
                if (!hn2) break;
                cur = nx2; it = itn2;
            }
        }
    }
}

__device__ __forceinline__ void row_load(const float* rowp, int lane, f32x4 (&v)[4]) {
#pragma unroll
    for (int j = 0; j < 4; ++j) v[j] = *(const f32x4*)(rowp + 256 * j + 4 * lane);
}
__device__ __forceinline__ void row_load_bf16(const bf16_t* rowp, int lane, f32x4 (&v)[4]) {
#pragma unroll
    for (int j = 0; j < 4; ++j) { const u32x2 w = *(const u32x2*)(rowp + 256 * j + 4 * lane); v[j] = (f32x4){bf_lo(w.x), bf_hi(w.x), bf_lo(w.y), bf_hi(w.y)}; }
}
__device__ __forceinline__ void row_store(float* rowp, int lane, const f32x4 (&v)[4]) {
#pragma unroll
    for (int j = 0; j < 4; ++j) *(f32x4*)(rowp + 256 * j + 4 * lane) = v[j];
}
__device__ __forceinline__ void row_store_bf16(bf16_t* rowp, int lane, const f32x4 (&v)[4]) {
#pragma unroll
    for (int j = 0; j < 4; ++j) { u32x2 o; o.x = pk2(v[j][0], v[j][1]); o.y = pk2(v[j][2], v[j][3]); *(u32x2*)(rowp + 256 * j + 4 * lane) = o; }
}
__device__ __forceinline__ void row_normalize(f32x4 (&v)[4]) {
    float s = 0.f;
#pragma unroll
    for (int j = 0; j < 4; ++j) s += (v[j][0] + v[j][1]) + (v[j][2] + v[j][3]);
    const float mean = wave_sum(s) * (1.f / DM);
    float q = 0.f;
#pragma unroll
    for (int j = 0; j < 4; ++j) { v[j] = v[j] - mean; q += (v[j][0] * v[j][0] + v[j][1] * v[j][1]) + (v[j][2] * v[j][2] + v[j][3] * v[j][3]); }
    const float rstd = 1.f / sqrtf(wave_sum(q) * (1.f / DM) + LN_EPS);
#pragma unroll
    for (int j = 0; j < 4; ++j) v[j] = v[j] * rstd;
}
__device__ __forceinline__ void row_modulate(f32x4 (&v)[4], const float* sh, const float* sc, int lane) {
#pragma unroll
    for (int j = 0; j < 4; ++j) { const f32x4 a = *(const f32x4*)(sc + 256 * j + 4 * lane), b = *(const f32x4*)(sh + 256 * j + 4 * lane); v[j] = v[j] * (a + 1.f) + b; }
}
__device__ __forceinline__ void row_affine(f32x4 (&v)[4], const float* g, const float* bb, int lane) {
#pragma unroll
    for (int j = 0; j < 4; ++j) { const f32x4 a = *(const f32x4*)(g + 256 * j + 4 * lane), b = *(const f32x4*)(bb + 256 * j + 4 * lane); v[j] = v[j] * a + b; }
}
__device__ __forceinline__ void row_modulate_l(f32x4 (&v)[4], const LAS float* sh, const LAS float* sc, int lane) {
#pragma unroll
    for (int j = 0; j < 4; ++j) { const f32x4 a = *(const LAS f32x4*)(sc + 256 * j + 4 * lane), b = *(const LAS f32x4*)(sh + 256 * j + 4 * lane); v[j] = v[j] * (a + 1.f) + b; }
}
__device__ __forceinline__ void row_affine_l(f32x4 (&v)[4], const LAS float* g, const LAS float* bb, int lane) {
#pragma unroll
    for (int j = 0; j < 4; ++j) { const f32x4 a = *(const LAS f32x4*)(g + 256 * j + 4 * lane), b = *(const LAS f32x4*)(bb + 256 * j + 4 * lane); v[j] = v[j] * a + b; }
}
__device__ __forceinline__ int row_modrow(int row) { return row < NLAT ? (row >> 13) : 4; }
__device__ __forceinline__ void lds_fill(LAS float* dst, const float* src, int n, int tid) { for (int i = tid * 4; i < n; i += NTHREADS * 4) *(LAS f32x4*)(dst + i) = *(const f32x4*)(src + i); }

__device__ __forceinline__ void phase_ln1(const Params& p, int bid, int nb) {
    bid = opaque_s(bid); const int tid = opaque_tid(), lane = tid & 63, gw = bid * NWAVES + (tid >> 6), NGW = nb * NWAVES;
    bf16_t* HB = (bf16_t*)(p.ws + WS_HB);
    f32x4 v[4], vn[4];
    if (gw < NROWS) row_load(gw < NLAT ? p.x + (size_t)gw * DM : p.ctx + (size_t)(gw - NLAT) * DM, lane, v);
#pragma unroll 1
    for (int row = gw; row < NROWS; row += NGW) {
        const int rn = row + NGW;
        if (rn < NROWS) row_load(rn < NLAT ? p.x + (size_t)rn * DM : p.ctx + (size_t)(rn - NLAT) * DM, lane, vn);
        row_normalize(v);
        const float* m = mod_ptr(p, 0, row_modrow(row)); row_modulate(v, m, m + DM, lane);
        row_store_bf16(HB + (size_t)row * DM, lane, v);
#pragma unroll
        for (int j = 0; j < 4; ++j) v[j] = vn[j];
    }
}

struct SgDesc { const bf16_t* A; int lda; const int* rowidx; const bf16_t* Bt; size_t grp_stride; int rows_per_grp, ngrp; int M, N, K; int row_base; };
template <class Epi>
__device__ __forceinline__ void sg_gemm(const SgDesc& g, const Epi& E, LAS unsigned char* lds, int bid, int nb) {
    bid = opaque_s(bid); const int tid = opaque_tid(); const int lane = tid & 63, w = __builtin_amdgcn_readfirstlane(tid >> 6), fr = lane & 15, fq = lane >> 4, wm = w >> 1, wn = w & 1;
    const int tilesN = g.N / 128, tiles = (g.M / 128) * tilesN, nk = g.K / 64;
    const int sr = tid >> 3, sp = tid & 7;
    const int soff = sr * 128 + ((sp ^ ((sr >> 1) & 7)) << 4);
    int aoff[2][2], boff[4][2];
#pragma unroll
    for (int ks = 0; ks < 2; ++ks) {
#pragma unroll
        for (int i = 0; i < 2; ++i) { const int r = 32 * wm + 16 * i + fr; aoff[i][ks] = r * 128 + (((fq + 4 * ks) ^ ((r >> 1) & 7)) << 4); }
#pragma unroll
        for (int n = 0; n < 4; ++n) { const int r = 64 * (n >> 1) + 32 * wn + 16 * (n & 1) + fr; boff[n][ks] = 16384 + r * 128 + (((fq + 4 * ks) ^ ((r >> 1) & 7)) << 4); }
    }
#pragma unroll 1
    for (int t = bid; t < tiles; t += nb) {
        const int tm = t / tilesN, tn = t % tilesN, pn = tn >> 1, wp = tn & 1;
        const int row0 = tm * 128;
        const bf16_t* Bt = g.Bt + (size_t)((row0 / g.rows_per_grp) % g.ngrp) * g.grp_stride;
        const bf16_t* as[2]; const bf16_t* bs[2];
#pragma unroll
        for (int h = 0; h < 2; ++h) { const int r = row0 + sr + 64 * h; const int ar = g.rowidx ? g.rowidx[r] : r; as[h] = g.A + (size_t)ar * g.lda + sp * 8;
            bs[h] = Bt + (size_t)(256 * pn + 128 * h + 64 * wp + sr) * g.K + sp * 8; }
        f32x4 acc[2][4];
#pragma unroll
        for (int i = 0; i < 2; ++i)
#pragma unroll
            for (int n = 0; n < 4; ++n) acc[i][n] = (f32x4){0.f, 0.f, 0.f, 0.f};
        u32x4 ra[2], rb[2];
#pragma unroll
        for (int h = 0; h < 2; ++h) { ra[h] = *(const u32x4*)(as[h]); rb[h] = *(const u32x4*)(bs[h]); }
#pragma unroll
        for (int h = 0; h < 2; ++h) { *(LAS u32x4*)(lds + soff + h * 8192) = ra[h]; *(LAS u32x4*)(lds + 16384 + soff + h * 8192) = rb[h]; }
        __syncthreads();
#pragma unroll 1
        for (int k = 0; k < nk; ++k) {
            const LAS unsigned char* buf = lds + (k & 1) * 32768;
            if (k + 1 < nk) {
#pragma unroll
                for (int h = 0; h < 2; ++h) { ra[h] = *(const u32x4*)(as[h] + (k + 1) * 64); rb[h] = *(const u32x4*)(bs[h] + (k + 1) * 64); } }
#pragma unroll
            for (int ks = 0; ks < 2; ++ks) {
                bf16x8 a[2], b[4];
#pragma unroll
                for (int i = 0; i < 2; ++i) a[i] = *(const LAS bf16x8*)(buf + aoff[i][ks]);
#pragma unroll
                for (int n = 0; n < 4; ++n) b[n] = *(const LAS bf16x8*)(buf + boff[n][ks]);
#pragma unroll
                for (int i = 0; i < 2; ++i)
#pragma unroll
                    for (int n = 0; n < 4; ++n) acc[i][n] = __builtin_amdgcn_mfma_f32_16x16x32_bf16(b[n], a[i], acc[i][n], 0, 0, 0);
            }
            if (k + 1 < nk) { LAS unsigned char* nbuf = lds + ((k + 1) & 1) * 32768;
#pragma unroll
                for (int h = 0; h < 2; ++h) { *(LAS u32x4*)(nbuf + soff + h * 8192) = ra[h]; *(LAS u32x4*)(nbuf + 16384 + soff + h * 8192) = rb[h]; } }
            __syncthreads();
        }
#pragma unroll
        for (int i = 0; i < 2; ++i) {
            const int row = g.row_base + row0 + 32 * wm + 16 * i + fr; const float rv = E.rowval(row);
            E(row, pn, 2 * wp + wn, fq, acc[i][0], acc[i][1], acc[i][2], acc[i][3], rv);
        }
    }
}

__device__ __forceinline__ void store_bf16x8(bf16_t* p, const f32x4 a, const f32x4 b) { u32x4 o; o.x = pk2(a[0], a[1]); o.y = pk2(a[2], a[3]); o.z = pk2(b[0], b[1]); o.w = pk2(b[2], b[3]); *(u32x4*)p = o; }
__device__ __forceinline__ int epi_col(int pn, int wc, int fq) { return 256 * pn + 64 * wc + 32 * (fq >> 1) + 8 * (fq & 1); }

struct EpiQKV {
    bf16_t* PB; const float* rope;
    __device__ __forceinline__ float rowval(int) const { return 0.f; }
    __device__ __forceinline__ void operator()(int row, int pn, int wc, int fq, f32x4 a0, f32x4 a1, f32x4 b0, f32x4 b1, float) const {
        const int c = epi_col(pn, wc, fq);
        if (c < 512 && row < NLAT) {
            const int t = row & (SEQ - 1); const int pos = (fq >> 1) ? (t & 63) : (t >> 6);
            const f32x4* rp = (const f32x4*)(rope + (pos * 16 + 8 * (fq & 1)) * 2);
            const f32x4 r0 = rp[0], r1 = rp[1], r2 = rp[2], r3 = rp[3];
            const f32x4 cs0 = {r0[0], r0[2], r1[0], r1[2]}, sn0 = {r0[1], r0[3], r1[1], r1[3]}, cs1 = {r2[0], r2[2], r3[0], r3[2]}, sn1 = {r2[1], r2[3], r3[1], r3[3]};
            const f32x4 na0 = a0 * cs0 - b0 * sn0, nb0 = b0 * cs0 + a0 * sn0, na1 = a1 * cs1 - b1 * sn1, nb1 = b1 * cs1 + a1 * sn1;
            a0 = na0; b0 = nb0; a1 = na1; b1 = nb1;
        }
        bf16_t* o = PB + (size_t)row * INW + c;
        store_bf16x8(o, a0, a1); store_bf16x8(o + 16, b0, b1);
    }
};
template <bool FIRST> struct EpiOut {
    const float* xl; const float* xc; bf16_t* XB; const float* mod;
    __device__ __forceinline__ float rowval(int) const { return 0.f; }
    __device__ __forceinline__ void operator()(int row, int pn, int wc, int fq, f32x4 a0, f32x4 a1, f32x4 b0, f32x4 b1, float) const {
        const int c = epi_col(pn, wc, fq); bf16_t* xo = XB + (size_t)row * DM + c;
        const float* g1 = mod + (size_t)row_modrow(row) * NMOD + 2 * DM + c;
        f32x4 xa0, xa1, xb0, xb1;
        if (FIRST) { const float* xin = row < NLAT ? xl + (size_t)row * DM + c : xc + (size_t)(row - NLAT) * DM + c;
            xa0 = *(const f32x4*)xin; xa1 = *(const f32x4*)(xin + 4); xb0 = *(const f32x4*)(xin + 16); xb1 = *(const f32x4*)(xin + 20); }
        else { const u32x4 wa = *(const u32x4*)xo, wb = *(const u32x4*)(xo + 16);
            xa0 = (f32x4){bf_lo(wa.x), bf_hi(wa.x), bf_lo(wa.y), bf_hi(wa.y)}; xa1 = (f32x4){bf_lo(wa.z), bf_hi(wa.z), bf_lo(wa.w), bf_hi(wa.w)};
            xb0 = (f32x4){bf_lo(wb.x), bf_hi(wb.x), bf_lo(wb.y), bf_hi(wb.y)}; xb1 = (f32x4){bf_lo(wb.z), bf_hi(wb.z), bf_lo(wb.w), bf_hi(wb.w)}; }
        const f32x4 ga0 = *(const f32x4*)g1, ga1 = *(const f32x4*)(g1 + 4), gb0 = *(const f32x4*)(g1 + 16), gb1 = *(const f32x4*)(g1 + 20);
        store_bf16x8(xo, xa0 * ALPHA + ga0 * a0, xa1 * ALPHA + ga1 * a1); store_bf16x8(xo + 16, xb0 * ALPHA + gb0 * b0, xb1 * ALPHA + gb1 * b1);
    }
};
struct EpiGU {
    bf16_t* HH;
    __device__ __forceinline__ float rowval(int) const { return 0.f; }
    __device__ __forceinline__ void operator()(int row, int pn, int wc, int fq, f32x4 a0, f32x4 a1, f32x4 b0, f32x4 b1, float) const {
        f32x4 h0, h1;
#pragma unroll
        for (int j = 0; j < 4; ++j) { h0[j] = a0[j] * __builtin_amdgcn_rcpf(1.f + __expf(-a0[j])) * b0[j]; h1[j] = a1[j] * __builtin_amdgcn_rcpf(1.f + __expf(-a1[j])) * b1[j]; }
        store_bf16x8(HH + (size_t)row * FF + 128 * pn + 32 * wc + 8 * fq, h0, h1);
    }
};
struct EpiDown {
    bf16_t* Y; const float* gate;
    __device__ __forceinline__ float rowval(int row) const { return gate[row]; }
    __device__ __forceinline__ void operator()(int row, int pn, int wc, int fq, f32x4 a0, f32x4 a1, f32x4 b0, f32x4 b1, float g) const {
        bf16_t* o = Y + (size_t)row * DM + epi_col(pn, wc, fq);
        store_bf16x8(o, a0 * g, a1 * g); store_bf16x8(o + 16, b0 * g, b1 * g);
    }
};

namespace mg {
constexpr int BM = 256, BK = 64, HALF = 128, HTB = HALF * BK * 2, STAGE_BYTES = 8 * HTB, NXCD = 8, WGM = 8, MAXU = 8;
__device__ __forceinline__ int lds_byte(int r, int c) { const int st = (r >> 4) * 2 + (c >> 5), rr = r & 15, cc = c & 31, ob = rr * 64 + cc * 2; return st * 1024 + (ob ^ (((ob >> 9) & 1) << 5)); }
__device__ __forceinline__ void stage_rc(int b, int& R, int& C) { const int st = b / 1024, sb = b % 1024, swz = sb ^ (((sb >> 9) & 1) << 5); R = (st >> 1) * 16 + swz / 64; C = (st & 1) * 32 + (swz % 64) / 2; }
struct Unit { int pm, pn; };
struct Gemm { const bf16_t* A; const bf16_t* Bt; int M, N, K; const int* rowidx; size_t grp_stride; int grp_tiles, ngrp; };
struct StaticOrder {
    int nM, nN, nwg, G, c;
    __device__ void init(int M, int N, int G_, int c_) { nM = M / BM; nN = N / BM; nwg = nM * nN; G = G_; c = c_; }
    __device__ bool next(int i, Unit& u) const {
        const long L = (long)i * G + c; if (L >= nwg) return false;
        int wgid = (int)L; { const int q = nwg / NXCD, r = nwg % NXCD, xcd = wgid % NXCD, off = wgid / NXCD; wgid = (xcd < r ? xcd * (q + 1) : r * (q + 1) + (xcd - r) * q) + off; }
        const int nig = WGM * nN, gid = wgid / nig, fm = gid * WGM, gsz = (nM - fm) < WGM ? (nM - fm) : WGM;
        u.pm = fm + ((wgid % nig) % gsz); u.pn = (wgid % nig) / gsz; return true;
    }
};
template <class Epi>
__device__ __forceinline__ void gemm_phase(LAS unsigned char* lds, LAS int* idxl, const Gemm g, const StaticOrder& S, const Epi& E) {
    const int tid = opaque_tid(), wid = __builtin_amdgcn_readfirstlane(tid >> 6), lane = tid & 63, wr = wid >> 2, wc = wid & 3, fr = lane & 15, fq = lane >> 4;
    const int K = g.K, nt = K / BK;
    unsigned voffB[2];
#pragma unroll
    for (int i = 0; i < 2; ++i) { int R_, C_; stage_rc(tid * 16 + i * 8192, R_, C_); voffB[i] = (unsigned)(R_ * K + C_) * 2u; }
    const size_t kstep = (size_t)(BK * 2);
    const size_t hstep = (size_t)HALF * K * 2;
    const size_t tstep = 2 * hstep;
    const unsigned ldsw = (unsigned)wid * 1024u;
    const int aoff = lds_byte(wr * 64 + fr, fq * 8), boff = lds_byte(wc * 32 + fr, fq * 8);
    Unit cur, nxt; int ui = 0;
    if (!S.next(0, cur)) return;
#ifndef MG_STAGGER_TICKS
#define MG_STAGGER_TICKS 0
#endif
    if (MG_STAGGER_TICKS && (blockIdx.x & 8)) { const unsigned long long t0 = __builtin_amdgcn_s_memrealtime(); while (__builtin_amdgcn_s_memrealtime() - t0 < MG_STAGGER_TICKS) __builtin_amdgcn_s_sleep(16); }
    if (g.rowidx) {
        for (int i = 0; i < MAXU; ++i) { Unit u; if (!S.next(i, u)) break; if (tid < 256) idxl[i * 256 + tid] = g.rowidx[u.pm * BM + tid]; }
        asm volatile("s_waitcnt vmcnt(0) lgkmcnt(0)" ::: "memory"); __builtin_amdgcn_s_barrier(); asm volatile("" ::: "memory");
    }
#define MG_AOFFS(dst, u_, ui_) do { _Pragma("unroll") for (int i_ = 0; i_ < 2; ++i_) { int R_, C_; stage_rc(tid * 16 + i_ * 8192, R_, C_); _Pragma("unroll") for (int h_ = 0; h_ < 2; ++h_) { \
        const int rr_ = g.rowidx ? idxl[(ui_) * 256 + h_ * HALF + R_] : ((u_).pm * BM + h_ * HALF + R_); dst[h_][i_] = (unsigned)(rr_ * K + C_) * 2u; } } } while (0)
#define MG_BPTR(u_) ((const char*)g.Bt + ((size_t)(((u_).pm / g.grp_tiles) % g.ngrp) * g.grp_stride) * 2 + (size_t)(u_).pn * tstep)
#define PG8_SA(b, h) (((b) * 2 + (h)) * HTB)
#define PG8_SB(b, h) ((4 + (b) * 2 + (h)) * HTB)
#define PG8_STAGE(bufoff, gbase, voff) do { _Pragma("unroll") for (int _i = 0; _i < 2; ++_i) \
        __builtin_amdgcn_global_load_lds((const unsigned*)((const char*)(gbase) + (voff)[_i]), (LAS unsigned*)(lds + (bufoff) + ldsw + _i * 8192), 16, 0, 0); } while (0)
#define PG8_LDA(dst, b, h) do { _Pragma("unroll") for (int m = 0; m < 4; ++m) _Pragma("unroll") for (int k = 0; k < 2; ++k) dst[m][k] = *(const LAS bf16x8*)(lds + PG8_SA(b, h) + aoff + m * 2048 + k * 1024); } while (0)
#define PG8_LDB(dst, b, h) do { _Pragma("unroll") for (int n = 0; n < 2; ++n) _Pragma("unroll") for (int k = 0; k < 2; ++k) dst[n][k] = *(const LAS bf16x8*)(lds + PG8_SB(b, h) + boff + n * 2048 + k * 1024); } while (0)
#define PG8_MMA(ai, bj, At, Bt) do { __builtin_amdgcn_s_setprio(1); _Pragma("unroll") for (int m = 0; m < 4; ++m) _Pragma("unroll") for (int n = 0; n < 2; ++n) _Pragma("unroll") for (int k = 0; k < 2; ++k) \
        acc[ai][bj][m][n] = __builtin_amdgcn_mfma_f32_16x16x32_bf16(Bt[n][k], At[m][k], acc[ai][bj][m][n], 0, 0, 0); __builtin_amdgcn_s_setprio(0); } while (0)
#define PG8_WAIT_V(n) asm volatile("s_waitcnt vmcnt(" #n ")" ::: "memory")
#define PG8_WAIT_L(n) asm volatile("s_waitcnt lgkmcnt(" #n ")" ::: "memory")
#define PG8_BAR __builtin_amdgcn_s_barrier()
#define PG8_SCHED __builtin_amdgcn_sched_barrier(0)
    f32x4 acc[2][2][4][2];
#pragma unroll
    for (int a = 0; a < 2; ++a)
#pragma unroll
        for (int b = 0; b < 2; ++b)
#pragma unroll
            for (int m = 0; m < 4; ++m)
#pragma unroll
                for (int n = 0; n < 2; ++n) acc[a][b][m][n] = (f32x4){0.f, 0.f, 0.f, 0.f};
    bf16x8 At[4][2], B0[2][2], B1[2][2];
    unsigned cAo[2][2], o2[2][2];
    MG_AOFFS(cAo, cur, 0);
    const char* const Abase = (const char*)g.A;
    const char* cB = MG_BPTR(cur);
    PG8_STAGE(PG8_SB(0, 0), cB, voffB); PG8_STAGE(PG8_SB(0, 1), cB + hstep, voffB); PG8_STAGE(PG8_SA(0, 0), Abase, cAo[0]); PG8_STAGE(PG8_SA(0, 1), Abase, cAo[1]);
    if (wr == 1) PG8_BAR;
    PG8_WAIT_V(2); PG8_BAR;
    PG8_STAGE(PG8_SB(1, 0), cB + kstep, voffB); PG8_STAGE(PG8_SA(1, 0), Abase + kstep, cAo[0]); PG8_STAGE(PG8_SB(1, 1), cB + hstep + kstep, voffB);
    PG8_WAIT_V(6); PG8_BAR;
    for (;;) {
        const bool has_next = S.next(ui + 1, nxt);
        const char* nB = has_next ? MG_BPTR(nxt) : cB;
        for (int t = 0; t < nt; t += 2) {
            const bool last = (t == nt - 2);
            const char* a1 = Abase + (size_t)(t + 1) * kstep;
            const char* a2 = last ? Abase : Abase + (size_t)(t + 2) * kstep; const char* b2 = last ? nB : cB + (size_t)(t + 2) * kstep;
            const char* a3 = a2 + kstep; const char* b3 = b2 + kstep;
            if (last && has_next) { MG_AOFFS(o2, nxt, ui + 1); } else {
#pragma unroll
                for (int h = 0; h < 2; ++h)
#pragma unroll
                    for (int i = 0; i < 2; ++i) o2[h][i] = cAo[h][i]; }
            PG8_LDB(B0, 0, 0); PG8_LDB(B1, 0, 1); PG8_SCHED; PG8_LDA(At, 0, 0); PG8_STAGE(PG8_SA(1, 1), a1, cAo[1]);
            PG8_WAIT_V(8); PG8_WAIT_L(0); PG8_BAR; PG8_MMA(0, 0, At, B0); PG8_MMA(0, 1, At, B1); PG8_BAR; PG8_SCHED;
            PG8_LDA(At, 0, 1); PG8_STAGE(PG8_SB(0, 0), b2, voffB); PG8_STAGE(PG8_SB(0, 1), b2 + hstep, voffB); PG8_STAGE(PG8_SA(0, 0), a2, o2[0]);
            PG8_WAIT_V(8); PG8_WAIT_L(0); PG8_BAR; PG8_MMA(1, 0, At, B0); PG8_MMA(1, 1, At, B1); PG8_BAR; PG8_SCHED;
            PG8_LDB(B0, 1, 0); PG8_LDB(B1, 1, 1); PG8_SCHED; PG8_LDA(At, 1, 0); PG8_STAGE(PG8_SA(0, 1), a2, o2[1]);
            PG8_WAIT_V(8); PG8_WAIT_L(0); PG8_BAR; PG8_MMA(0, 0, At, B0); PG8_MMA(0, 1, At, B1); PG8_BAR; PG8_SCHED;
            PG8_LDA(At, 1, 1); PG8_STAGE(PG8_SB(1, 0), b3, voffB); PG8_STAGE(PG8_SB(1, 1), b3 + hstep, voffB); PG8_STAGE(PG8_SA(1, 0), a3, o2[0]);
            PG8_WAIT_V(8); PG8_WAIT_L(0); PG8_BAR; PG8_MMA(1, 0, At, B0); PG8_MMA(1, 1, At, B1); PG8_BAR; PG8_SCHED;
        }
        if (wr == 0) PG8_BAR;
        E(acc, cur, wr, wc, fr, fq);
        if (!has_next) break;
#pragma unroll
        for (int a = 0; a < 2; ++a)
#pragma unroll
            for (int b = 0; b < 2; ++b)
#pragma unroll
                for (int m = 0; m < 4; ++m)
#pragma unroll
                    for (int n = 0; n < 2; ++n) acc[a][b][m][n] = (f32x4){0.f, 0.f, 0.f, 0.f};
        cur = nxt; cB = nB; ++ui;
#pragma unroll
        for (int h = 0; h < 2; ++h)
#pragma unroll
            for (int i = 0; i < 2; ++i) cAo[h][i] = o2[h][i];
        if (wr == 1) PG8_BAR;
    }
    PG8_WAIT_V(0);
    PG8_BAR;
#undef MG_AOFFS
#undef MG_BPTR
#undef PG8_SA
#undef PG8_SB
#undef PG8_STAGE
#undef PG8_LDA
#undef PG8_LDB
#undef PG8_MMA
#undef PG8_WAIT_V
#undef PG8_WAIT_L
#undef PG8_BAR
#undef PG8_SCHED
}
template <class EE> struct EpiAdapt {
    EE e; int row_base;
    __device__ __forceinline__ void operator()(const f32x4 (&acc)[2][2][4][2], const Unit& u, int wr, int wc, int fr, int fq) const {
        float rv[2][4];
#pragma unroll
        for (int ai = 0; ai < 2; ++ai)
#pragma unroll
            for (int m = 0; m < 4; ++m) rv[ai][m] = e.rowval(row_base + u.pm * BM + ai * HALF + wr * 64 + m * 16 + fr);
#pragma unroll
        for (int ai = 0; ai < 2; ++ai)
#pragma unroll
            for (int m = 0; m < 4; ++m) { const int row = row_base + u.pm * BM + ai * HALF + wr * 64 + m * 16 + fr;
                e(row, u.pn, wc, fq, acc[ai][0][m][0], acc[ai][0][m][1], acc[ai][1][m][0], acc[ai][1][m][1], rv[ai][m]);
                if (m & 1) asm volatile("" ::: "memory"); }
    }
};
}

struct AttnState { float m, l; float o[32]; };
__device__ __forceinline__ void attn_init(AttnState& st) { st.m = -INFINITY; st.l = 0.f;
#pragma unroll
    for (int d = 0; d < 32; ++d) st.o[d] = 0.f; }
__device__ __forceinline__ void load_row32(const bf16_t* p, float (&r)[32], float scale) {
#pragma unroll
    for (int i = 0; i < 4; ++i) { const u32x4 w = *(const u32x4*)(p + 8 * i);
        r[8 * i + 0] = bf_lo(w.x) * scale; r[8 * i + 1] = bf_hi(w.x) * scale; r[8 * i + 2] = bf_lo(w.y) * scale; r[8 * i + 3] = bf_hi(w.y) * scale;
        r[8 * i + 4] = bf_lo(w.z) * scale; r[8 * i + 5] = bf_hi(w.z) * scale; r[8 * i + 6] = bf_lo(w.w) * scale; r[8 * i + 7] = bf_hi(w.w) * scale; }
}
__device__ __forceinline__ float dot_row32(const bf16_t* p, const float (&q)[32]) {
    float d0 = 0.f, d1 = 0.f;
#pragma unroll
    for (int i = 0; i < 4; ++i) { const u32x4 w = *(const u32x4*)(p + 8 * i);
        d0 += q[8 * i + 0] * bf_lo(w.x); d1 += q[8 * i + 1] * bf_hi(w.x); d0 += q[8 * i + 2] * bf_lo(w.y); d1 += q[8 * i + 3] * bf_hi(w.y);
        d0 += q[8 * i + 4] * bf_lo(w.z); d1 += q[8 * i + 5] * bf_hi(w.z); d0 += q[8 * i + 6] * bf_lo(w.w); d1 += q[8 * i + 7] * bf_hi(w.w); }
    const float d = d0 + d1;
    return d + __shfl_xor(d, 32);
}
__device__ __forceinline__ void axpy_row32(const bf16_t* p, float a, float (&o)[32]) {
#pragma unroll
    for (int i = 0; i < 4; ++i) { const u32x4 w = *(const u32x4*)(p + 8 * i);
        o[8 * i + 0] += a * bf_lo(w.x); o[8 * i + 1] += a * bf_hi(w.x); o[8 * i + 2] += a * bf_lo(w.y); o[8 * i + 3] += a * bf_hi(w.y);
        o[8 * i + 4] += a * bf_lo(w.z); o[8 * i + 5] += a * bf_hi(w.z); o[8 * i + 6] += a * bf_lo(w.w); o[8 * i + 7] += a * bf_hi(w.w); }
}
template <class ScoreFn>
__device__ __forceinline__ void attn_segment(const float (&q)[32], AttnState& st, const bf16_t* Kb, const bf16_t* Vb, int j0, int j1, ScoreFn sf) {
#pragma unroll 1
    for (int j = j0; j < j1; ++j) {
        const float s0 = sf(j, dot_row32(Kb + (size_t)j * INW, q));
        if (s0 > st.m) { const float corr = __expf(st.m - s0); st.l *= corr;
#pragma unroll
            for (int d = 0; d < 32; ++d) st.o[d] *= corr;
            st.m = s0; }
        const float p0 = (s0 == -INFINITY) ? 0.f : __expf(s0 - st.m);
        st.l += p0;
        axpy_row32(Vb + (size_t)j * INW, p0, st.o);
    }
}
__device__ __forceinline__ void attn_sink(AttnState& st, float sk) {
    if (sk > st.m) { const float corr = __expf(st.m - sk); st.l *= corr;
#pragma unroll
        for (int d = 0; d < 32; ++d) st.o[d] *= corr;
        st.m = sk; }
    st.l += __expf(sk - st.m);
}
__device__ __forceinline__ void attn_store(const AttnState& st, bf16_t* o) {
    const float inv = 1.f / st.l;
#pragma unroll
    for (int i = 0; i < 4; ++i) { u32x4 w; w.x = pk2(st.o[8 * i] * inv, st.o[8 * i + 1] * inv); w.y = pk2(st.o[8 * i + 2] * inv, st.o[8 * i + 3] * inv);
        w.z = pk2(st.o[8 * i + 4] * inv, st.o[8 * i + 5] * inv); w.w = pk2(st.o[8 * i + 6] * inv, st.o[8 * i + 7] * inv); *(u32x4*)(o + 8 * i) = w; }
}

__device__ __forceinline__ void phase_mixers(const Params& p, int l, bool with_ctx, int bid, int nb) {
    bid = opaque_s(bid); const int tid = opaque_tid(); const int lane = tid & 63, gw = bid * NWAVES + (tid >> 6), NGW = nb * NWAVES;
    const int ql = lane & 31, hf = lane >> 5;
    const bf16_t* PB = (const bf16_t*)(p.ws + WS_PB); bf16_t* OB = (bf16_t*)(p.ws + WS_OB);
    const float* sink = p.attn_sink + l * 6; const float* rpb = p.na_rpb + (size_t)l * 6 * 15 * 31;
#if !FAST_ATTN
#pragma unroll 1
    for (int it = gw; it < NB * 6 * 256; it += NGW) {
        const int chunk = it & 255, h = (it >> 8) % 6, b = it / (6 * 256), kvh = h / 3;
        const int t = chunk * 32 + ql; const size_t rowb = (size_t)b * SEQ;
        float q[32]; load_row32(PB + (rowb + t) * INW + C_QA + h * 64 + 32 * hf, q, 0.125f);
        AttnState st; attn_init(st);
        const int jlo = max(0, chunk * 32 - 128), jhi = min(SEQ, chunk * 32 + 32 + 128);
        attn_segment(q, st, PB + rowb * INW + C_KA + kvh * 64 + 32 * hf, PB + rowb * INW + C_VA + kvh * 64 + 32 * hf, jlo, jhi,
                     [&](int j, float d) { const int dt = t - j; return (dt <= 128 && dt >= -128) ? d : -INFINITY; });
        const size_t crow = (size_t)NLAT + (size_t)b * CTXL;
        attn_segment(q, st, PB + crow * INW + C_KA + kvh * 64 + 32 * hf, PB + crow * INW + C_VA + kvh * 64 + 32 * hf, 0, CTXL, [&](int, float d) { return d; });
        attn_sink(st, sink[h]);
        attn_store(st, OB + (rowb + t) * DM + h * 64 + 32 * hf);
    }
#pragma unroll 1
    for (int it = gw; it < NB * 6 * 256; it += NGW) {
        const int r = (it & 255) >> 1, ch = it & 1, h = (it >> 8) % 6, b = it / (6 * 256);
        const int cq = ch * 32 + ql; const size_t rowb = (size_t)b * SEQ; const int t = r * 64 + cq;
        float q[32]; load_row32(PB + (rowb + t) * INW + C_QN + h * 64 + 32 * hf, q, 0.125f);
        AttnState st; attn_init(st);
        const int rs = min(max(r - 4, 0), 128 - 8), cs = min(max(cq - 8, 0), 64 - 16);
        const float* bias = rpb + (size_t)h * 15 * 31;
        attn_segment(q, st, PB + (rowb + (size_t)rs * 64) * INW + C_KN + h * 64 + 32 * hf, PB + (rowb + (size_t)rs * 64) * INW + C_VN + h * 64 + 32 * hf, 0, 512,
                     [&](int j, float d) { const int ka = rs + (j >> 6), ck = j & 63; const bool ok = (ck >= cs) && (ck < cs + 16);
                                           const int ro = ka - r + 7, co = min(max(ck - cq, -15), 15) + 15; return ok ? d + bias[ro * 31 + co] : -INFINITY; });
        const size_t crow = (size_t)NLAT + (size_t)b * CTXL;
        attn_segment(q, st, PB + crow * INW + C_KN + h * 64 + 32 * hf, PB + crow * INW + C_VN + h * 64 + 32 * hf, 0, CTXL, [&](int, float d) { return d; });
        attn_store(st, OB + (rowb + t) * DM + 640 + h * 64 + 32 * hf);
    }
#endif
    {
        const float* cw = p.conv_w + (size_t)l * 3 * 256;
        const int nrows = with_ctx ? NROWS : NLAT;
        for (long e = (long)bid * NTHREADS + tid; e < (long)nrows * 32; e += (long)nb * NTHREADS) {
            const int row = (int)(e >> 5), ch = (int)(e & 31) * 8;
            const int tpos = row < NLAT ? (row & (SEQ - 1)) : ((row - NLAT) & (CTXL - 1)); const int tlen = row < NLAT ? SEQ : CTXL;
            const bf16_t* pr = PB + (size_t)row * INW;
            float u[3][8];
#pragma unroll
            for (int dlt = -1; dlt <= 1; ++dlt) {
                const bool ok = (tpos + dlt >= 0) && (tpos + dlt < tlen);
                if (ok) { const u32x4 a = *(const u32x4*)(pr + (long)dlt * INW + C_BX + ch), c = *(const u32x4*)(pr + (long)dlt * INW + C_BC + ch);
                    u[dlt + 1][0] = bf_lo(a.x) * bf_lo(c.x); u[dlt + 1][1] = bf_hi(a.x) * bf_hi(c.x); u[dlt + 1][2] = bf_lo(a.y) * bf_lo(c.y); u[dlt + 1][3] = bf_hi(a.y) * bf_hi(c.y);
                    u[dlt + 1][4] = bf_lo(a.z) * bf_lo(c.z); u[dlt + 1][5] = bf_hi(a.z) * bf_hi(c.z); u[dlt + 1][6] = bf_lo(a.w) * bf_lo(c.w); u[dlt + 1][7] = bf_hi(a.w) * bf_hi(c.w); }
                else {
#pragma unroll
                    for (int i = 0; i < 8; ++i) u[dlt + 1][i] = 0.f; }
            }
            const u32x4 gb = *(const u32x4*)(pr + C_BB + ch);
            const float g[8] = {bf_lo(gb.x), bf_hi(gb.x), bf_lo(gb.y), bf_hi(gb.y), bf_lo(gb.z), bf_hi(gb.z), bf_lo(gb.w), bf_hi(gb.w)};
            float y[8];
#pragma unroll
            for (int i = 0; i < 8; ++i) y[i] = g[i] * (u[0][i] * cw[ch + i] + u[1][i] * cw[256 + ch + i] + u[2][i] * cw[512 + ch + i]);
            u32x4 o; o.x = pk2(y[0], y[1]); o.y = pk2(y[2], y[3]); o.z = pk2(y[4], y[5]); o.w = pk2(y[6], y[7]);
            *(u32x4*)(OB + (size_t)row * DM + 384 + ch) = o;
        }
    }
#if !FAST_ATTN
    if (with_ctx) {
#pragma unroll 1
        for (int it = gw; it < 2 * NB * 6 * 8; it += NGW) {
            const int kind = it / (NB * 6 * 8), r = it % (NB * 6 * 8), chunk = r & 7, h = (r >> 3) % 6, b = r / 48;
            const size_t crow = (size_t)NLAT + (size_t)b * CTXL; const int tq = chunk * 32 + ql;
            const int qc = (kind == 0 ? C_QA + h * 64 : C_QN + h * 64) + 32 * hf, kc = (kind == 0 ? C_KA + (h / 3) * 64 : C_KN + h * 64) + 32 * hf, vc = (kind == 0 ? C_VA + (h / 3) * 64 : C_VN + h * 64) + 32 * hf;
            float q[32]; load_row32(PB + (crow + tq) * INW + qc, q, 0.125f);
            AttnState st; attn_init(st);
            attn_segment(q, st, PB + crow * INW + kc, PB + crow * INW + vc, 0, CTXL, [&](int, float d) { return d; });
            if (kind == 0) attn_sink(st, sink[h]);
            attn_store(st, OB + (crow + tq) * DM + (kind == 0 ? 0 : 640) + h * 64 + 32 * hf);
        }
    }
#endif
}

namespace fa {
typedef short v4i16_t __attribute__((ext_vector_type(4)));
typedef float f32x2_t __attribute__((ext_vector_type(2))); typedef __bf16 bf16x2_t __attribute__((ext_vector_type(2)));
__device__ __forceinline__ unsigned cvtpk(float lo, float hi) { f32x2_t v = {lo, hi}; bf16x2_t b = __builtin_convertvector(v, bf16x2_t); return __builtin_bit_cast(unsigned, b); }
constexpr float LOG2E = 1.4426950408889634f, SC = 0.125f * LOG2E;
constexpr int CHUNK_BYTES = 32768;
constexpr int BIAS_OFF = 3 * CHUNK_BYTES;
constexpr float THR = 8.f;
__device__ __forceinline__ int na_rs(int r) { return min(max(r - 4, 0), 128 - 8); }
__device__ __forceinline__ void glds16(const void* gsrc, unsigned lds_dst) { unsigned keep;
    asm volatile("s_mov_b32 %0, m0\n\ts_mov_b32 m0, %2\n\ts_nop 0\n\tglobal_load_lds_dwordx4 %1, off\n\ts_mov_b32 m0, %0" : "=&s"(keep) : "v"(gsrc), "s"(lds_dst) : "memory"); }
#define FA_WAIT_BAR(N) asm volatile("s_waitcnt vmcnt(" #N ") lgkmcnt(0)\n\ts_barrier" ::: "memory")
__device__ __forceinline__ float max3f(float a, float b, float c) { float r; asm("v_max3_f32 %0, %1, %2, %3" : "=v"(r) : "v"(a), "v"(b), "v"(c)); return r; }
__device__ __forceinline__ float max8f(const f32x4& a, const f32x4& b) { return max3f(max3f(max3f(a[0], a[1], a[2]), a[3], b[0]), max3f(b[1], b[2], b[3]), -INFINITY); }
typedef float f32x16 __attribute__((ext_vector_type(16)));
__device__ __forceinline__ float max16f(const f32x16& a) {
    float x = max3f(a[0], a[1], a[2]); x = max3f(x, a[3], a[4]); x = max3f(x, a[5], a[6]); x = max3f(x, a[7], a[8]); x = max3f(x, a[9], a[10]); x = max3f(x, a[11], a[12]); x = max3f(x, a[13], a[14]);
    return fmaxf(x, a[15]);
}
typedef float f32x2v __attribute__((ext_vector_type(2)));
template <int MODE>
__device__ __forceinline__ void unit32(f32x16 (&o)[2], float& m, float& ls, const bf16x8 (&q)[4], const LAS unsigned char* Kt0, const LAS unsigned char* Kt1, const LAS unsigned char* Vt0, const LAS unsigned char* Vt1,
                                       const int (&kb)[4], const int (&vb)[2], bool rel0, bool rel1, bool mk0, bool mk1, int tb0, int tb1, const f32x16& fmask, const LAS float* bp0, const LAS float* bp1) {
    f32x16 s[2]; float tm = -INFINITY;
#pragma unroll
    for (int t = 0; t < 2; ++t) {
        if (!(t == 0 ? rel0 : rel1)) continue;
        const LAS unsigned char* Kt = t == 0 ? Kt0 : Kt1;
        bf16x8 kf[4];
#pragma unroll
        for (int ks = 0; ks < 4; ++ks) kf[ks] = *(const LAS bf16x8*)(Kt + kb[ks]);
        f32x16 acc = __builtin_amdgcn_mfma_f32_32x32x16_bf16(kf[0], q[0], (f32x16){0.f, 0.f, 0.f, 0.f, 0.f, 0.f, 0.f, 0.f, 0.f, 0.f, 0.f, 0.f, 0.f, 0.f, 0.f, 0.f}, 0, 0, 0);
#pragma unroll
        for (int ks = 1; ks < 4; ++ks) acc = __builtin_amdgcn_mfma_f32_32x32x16_bf16(kf[ks], q[ks], acc, 0, 0, 0);
        if (MODE == 2) {
            const LAS float* bp = t == 0 ? bp0 : bp1;
#pragma unroll
            for (int r = 0; r < 16; ++r) acc[r] = __builtin_fmaf(acc[r], SC, bp[(r & 3) + 8 * (r >> 2)]) + fmask[r];
        } else {
            if (MODE == 1 && (t == 0 ? mk0 : mk1)) { const int tb = t == 0 ? tb0 : tb1;
#pragma unroll
                for (int r = 0; r < 16; ++r) acc[r] = ((unsigned)(tb - ((r & 3) + 8 * (r >> 2))) <= 256u) ? acc[r] : -INFINITY;
            } else asm volatile("s_nop 15\n\ts_nop 7" : "+v"(acc));
        }
        s[t] = acc;
        tm = fmaxf(tm, max16f(acc));
    }
    if (MODE != 2) tm *= SC;
    if (__any(tm > m + THR)) {
        const float mn = fmaxf(m, xor32_max(tm)), al = __builtin_amdgcn_exp2f(m - mn); m = mn; ls *= al;
#pragma unroll
        for (int d = 0; d < 2; ++d) o[d] = o[d] * al;
    }
    const float nm = -m; f32x2v ps2 = {0.f, 0.f};
#pragma unroll
    for (int t = 0; t < 2; ++t) {
        if (!(t == 0 ? rel0 : rel1)) continue;
        const LAS unsigned char* Vt = t == 0 ? Vt0 : Vt1;
        f32x16 pv = MODE == 2 ? s[t] + nm : s[t] * SC + nm;
#pragma unroll
        for (int r = 0; r < 16; ++r) pv[r] = __builtin_amdgcn_exp2f(pv[r]);
#pragma unroll
        for (int r = 0; r < 16; r += 2) ps2 += (f32x2v){pv[r], pv[r + 1]};
#pragma unroll
        for (int st = 0; st < 2; ++st) {
            u32x4 pw; pw.x = cvtpk(pv[8 * st + 0], pv[8 * st + 1]); pw.y = cvtpk(pv[8 * st + 2], pv[8 * st + 3]); pw.z = cvtpk(pv[8 * st + 4], pv[8 * st + 5]); pw.w = cvtpk(pv[8 * st + 6], pv[8 * st + 7]);
            const bf16x8 pb = __builtin_bit_cast(bf16x8, pw);
#pragma unroll
            for (int db = 0; db < 2; ++db) {
                const v4i16_t t0 = __builtin_amdgcn_ds_read_tr16_b64_v4i16((LAS v4i16_t*)(Vt + st * 2048 + vb[db])), t1 = __builtin_amdgcn_ds_read_tr16_b64_v4i16((LAS v4i16_t*)(Vt + st * 2048 + 1024 + vb[db]));
                const bf16x8 vf = (bf16x8){t0[0], t0[1], t0[2], t0[3], t1[0], t1[1], t1[2], t1[3]};
                o[db] = __builtin_amdgcn_mfma_f32_32x32x16_bf16(vf, pb, o[db], 0, 0, 0);
            }
        }
    }
    ls += ps2[0] + ps2[1];
}
template <int KIND>
__device__ __forceinline__ void attn_item(const Params& p, int l, int item, LAS unsigned char* lds, int tid) {
    constexpr bool ISA = (KIND == 0 || KIND == 2);
    constexpr int NG = ISA ? 2 : 1;
    const int lane = tid & 63, w = __builtin_amdgcn_readfirstlane(tid >> 6), ql = lane & 31, hh = lane >> 5;
    const bf16_t* PB = (const bf16_t*)(p.ws + WS_PB); bf16_t* OB = (bf16_t*)(p.ws + WS_OB);
    int b, hx, blk;
    if (KIND == 0) { b = item >> 7; hx = (item >> 6) & 1; blk = item & 63; }
    else if (KIND == 1) { b = item / 192; hx = (item >> 5) % 6; blk = item & 31; }
    else if (KIND == 2) { b = item >> 2; hx = (item >> 1) & 1; blk = item & 1; }
    else { b = item / 6; hx = item % 6; blk = 0; }
    const size_t rowb = (size_t)b * SEQ, ctxb = (size_t)NLAT + (size_t)b * CTXL;
    const int kcol = ISA ? C_KA + hx * 64 : C_KN + hx * 64, vcol = ISA ? C_VA + hx * 64 : C_VN + hx * 64;
    int nwin = 0; size_t winrow0 = 0; int winpos0 = 0, krs0 = 0;
    if (KIND == 0) { const int first = blk == 0 ? 1 : 0, last = blk == 63 ? 2 : 3; nwin = last - first; winpos0 = 128 * (blk - 1 + first); winrow0 = rowb + winpos0; }
    if (KIND == 1) { krs0 = na_rs(4 * blk); nwin = (na_rs(4 * blk + 3) + 8 - krs0 + 1) >> 1; winrow0 = rowb + (size_t)krs0 * 64; }
    const int nch = nwin + 2;
    const bool active = true;
    int gh[NG], gp0[NG];
#pragma unroll
    for (int gi = 0; gi < NG; ++gi) {
        const int G = ISA ? (w < 4 ? 2 * w + gi : 8 + (w - 4)) : w;
        if (ISA) { gh[gi] = 3 * hx + (G >> 2); gp0[gi] = 128 * blk + 32 * (G & 3); }
        else if (KIND == 1) { gh[gi] = hx; gp0[gi] = 16 * (G & 3); }
        else { gh[gi] = hx; gp0[gi] = 32 * G; }
    }
    const int nrow0 = 4 * blk + 2 * (w >> 2);
    const int nrq = nrow0 + (ql >> 4), ncq = gp0[0] + (ql & 15);
#define FA_QROW(gi, ql_) (KIND == 0 ? rowb + gp0[gi] + (ql_) : KIND == 2 ? ctxb + gp0[gi] + (ql_) : KIND == 1 ? rowb + (size_t)(nrow0 + ((ql_) >> 4)) * 64 + gp0[gi] + ((ql_) & 15) : ctxb + gp0[gi] + (ql_))
    const int skey = 8 * w + (lane >> 3), spc = lane & 7;
    const int ksrc = skey * INW + kcol + ((spc ^ ((skey >> 1) & 7)) << 3);
    const int vsrc = skey * INW + vcol + (((((spc >> 1) ^ (skey & 2)) << 1) | (spc & 1)) << 3);
    const unsigned lds0 = (unsigned)(uintptr_t)lds;
    const int noff = KIND == 1 ? ((gp0[0] >> 4) == 0 ? 0 : ((gp0[0] >> 4) == 1 ? 8 : ((gp0[0] >> 4) == 2 ? 24 : 32))) : 0;
    int kb[4], kbw[4], vb[2];
#pragma unroll
    for (int ks = 0; ks < 4; ++ks) { kb[ks] = ql * 128 + (((2 * ks + hh) ^ ((ql >> 1) & 7)) << 4); kbw[ks] = ql * 128 + (((2 * ks + hh) ^ (((noff + ql) >> 1) & 7)) << 4); }
    { const int vk = 4 * hh + ((lane & 15) >> 2);
#pragma unroll
      for (int db = 0; db < 2; ++db) vb[db] = vk * 128 + (((2 * db + ((lane >> 4) & 1)) ^ (vk & 2)) << 5) + ((lane & 3) << 3); }
#define FA_DMA(ci) do { const size_t r0_ = (ci) < nwin ? winrow0 + (size_t)(ci) * 128 : ctxb + (size_t)((ci) - nwin) * 128; const bf16_t* s_ = PB + r0_ * INW; \
        const unsigned d_ = (unsigned)__builtin_amdgcn_readfirstlane((int)(lds0 + ((ci) % 3) * CHUNK_BYTES + w * 1024)); \
        glds16(s_ + ksrc, d_); glds16(s_ + 64 * INW + ksrc, d_ + 8192u); glds16(s_ + vsrc, d_ + 16384u); glds16(s_ + 64 * INW + vsrc, d_ + 24576u); } while (0)
    FA_DMA(0); FA_DMA(1);
    bf16x8 qf[NG][4];
#pragma unroll
    for (int gi = 0; gi < NG; ++gi)
#pragma unroll
        for (int ks = 0; ks < 4; ++ks) qf[gi][ks] = *(const bf16x8*)(PB + FA_QROW(gi, ql) * INW + (ISA ? C_QA : C_QN) + gh[gi] * 64 + 16 * ks + 8 * hh);
    f32x16 o[NG][2]; float m[NG], ls[NG];
#pragma unroll
    for (int gi = 0; gi < NG; ++gi) {
#pragma unroll
        for (int d = 0; d < 2; ++d)
#pragma unroll
            for (int r = 0; r < 16; ++r) o[gi][d][r] = 0.f;
        if (ISA) { m[gi] = p.attn_sink[l * 6 + gh[gi]] * LOG2E; ls[gi] = hh == 0 ? 1.f : 0.f; } else { m[gi] = -1e30f; ls[gi] = 0.f; }
    }
    f32x16 fmask;
#pragma unroll
    for (int r = 0; r < 16; ++r) fmask[r] = 0.f;
    if (KIND == 1) { const int cs = min(max(ncq - 8, 0), 48);
#pragma unroll
        for (int r = 0; r < 16; ++r) { const int ck = noff + (r & 3) + 8 * (r >> 2) + 4 * hh; fmask[r] = ((ck >= cs) && (ck < cs + 16)) ? 0.f : -INFINITY; } }
    const int nqrs = na_rs(nrq);
    LAS float* biasL = (LAS float*)(lds + BIAS_OFF);
    if (KIND == 1) { const float* rp = p.na_rpb + ((size_t)l * 6 + hx) * 15 * 31;
        for (int i = tid; i < 16 * 128; i += NTHREADS) { const int x = (i & 127) - 64; biasL[i] = (i >> 7) == 15 ? -INFINITY : ((x >= -15 && x <= 15) ? rp[(i >> 7) * 31 + x + 15] * LOG2E : 0.f); } }
    FA_WAIT_BAR(4);
#pragma unroll
    for (int gi = 0; gi < NG; ++gi) { asm volatile("" : "+v"(qf[gi][0]), "+v"(qf[gi][1]), "+v"(qf[gi][2]), "+v"(qf[gi][3])); }
#pragma unroll 1
    for (int ci = 0; ci < nch; ++ci) {
        if (ci + 2 < nch) FA_DMA(ci + 2);
        const LAS unsigned char* Kb = lds + (ci % 3) * CHUNK_BYTES; const LAS unsigned char* Vb = Kb + 16384;
        const bool iswin = ci < nwin;
        if (active) {
            if (KIND == 1 && iswin) {
                const int kr0 = krs0 + 2 * ci, rsA = na_rs(nrow0), rsB = na_rs(nrow0 + 1);
                const bool rel0 = (kr0 >= rsA) && (kr0 < rsB + 8), rel1 = (kr0 + 1 >= rsA) && (kr0 + 1 < rsB + 8);
                if (rel0 || rel1) {
                    const bool rowok0 = (kr0 >= nqrs) && (kr0 < nqrs + 8), rowok1 = (kr0 + 1 >= nqrs) && (kr0 + 1 < nqrs + 8);
                    const int bcol = 64 + noff + 4 * hh - ncq;
                    const LAS float* bp0 = biasL + (rowok0 ? kr0 - nrq + 7 : 15) * 128 + bcol; const LAS float* bp1 = biasL + (rowok1 ? kr0 + 1 - nrq + 7 : 15) * 128 + bcol;
                    unit32<2>(o[0], m[0], ls[0], qf[0], Kb + noff * 128, Kb + (64 + noff) * 128, Vb + noff * 128, Vb + (64 + noff) * 128, kbw, vb, rel0, rel1, false, false, 0, 0, fmask, bp0, bp1);
                }
            } else {
#pragma unroll 1
                for (int u = 0; u < 2; ++u) {
                    const LAS unsigned char* Kt = Kb + (64 * u) * 128; const LAS unsigned char* Vt = Vb + (64 * u) * 128;
#pragma unroll
                    for (int gi = 0; gi < NG; ++gi) {
                        if (ISA && gi == 1 && w >= 4) continue;
                        if (KIND == 0) {
                            bool rel[2] = {true, true}, msk[2] = {false, false};
                            if (iswin) {
#pragma unroll
                                for (int t = 0; t < 2; ++t) { const int j0 = winpos0 + 128 * ci + 64 * u + 32 * t, p0 = gp0[gi];
                                    rel[t] = (j0 + 31 >= p0 - 128) && (j0 <= p0 + 31 + 128); msk[t] = !((j0 >= p0 + 31 - 128) && (j0 + 31 <= p0 + 128)); } }
                            if (!(rel[0] || rel[1])) continue;
                            const int tb0 = gp0[gi] + ql - (winpos0 + 128 * ci + 64 * u) - 4 * hh + 128;
                            unit32<1>(o[gi], m[gi], ls[gi], qf[gi], Kt, Kt + 4096, Vt, Vt + 4096, kb, vb, rel[0], rel[1], msk[0], msk[1], tb0, tb0 - 32, fmask, nullptr, nullptr);
                        } else unit32<0>(o[gi], m[gi], ls[gi], qf[gi], Kt, Kt + 4096, Vt, Vt + 4096, kb, vb, true, true, false, false, 0, 0, fmask, nullptr, nullptr);
                    }
                }
            }
        }
        if (ci + 2 < nch) FA_WAIT_BAR(4); else FA_WAIT_BAR(0);
    }
#undef FA_DMA
    if (active) {
        int ql2 = lane & 31; asm volatile("" : "+v"(ql2));
#pragma unroll
        for (int gi = 0; gi < NG; ++gi) {
            if (ISA && gi == 1 && w >= 4) continue;
            const float lt = xor32_sum(ls[gi]);
            const float inv = 1.f / lt;
            bf16_t* op = OB + FA_QROW(gi, ql2) * DM + (ISA ? 0 : 640) + gh[gi] * 64 + 4 * hh;
#pragma unroll
            for (int db = 0; db < 2; ++db)
#pragma unroll
                for (int i = 0; i < 4; ++i) { u32x2 ov; ov.x = cvtpk(o[gi][db][4 * i] * inv, o[gi][db][4 * i + 1] * inv); ov.y = cvtpk(o[gi][db][4 * i + 2] * inv, o[gi][db][4 * i + 3] * inv); *(u32x2*)(op + 32 * db + 8 * i) = ov; }
        }
    }
#undef FA_QROW
}
__device__ __forceinline__ void phase_attn(const Params& p, int l, bool with_ctx, LAS unsigned char* lds, int bid, int nb) {
    bid = opaque_s(bid);
    const int n0 = NB * 2 * 64, n1 = NB * 6 * 32, n2 = with_ctx ? NB * 2 * 2 : 0, n3 = with_ctx ? NB * 6 : 0;
#pragma unroll 1
    for (int it = bid; it < n0 + n1 + n2 + n3; it += nb) {
        const int tid = opaque_tid();
#ifndef KMASK
#define KMASK 15
#endif
#ifndef ATT_DUP
#define ATT_DUP 0
#endif
        if (it < n0) { if (KMASK & 1) attn_item<0>(p, l, it, lds, tid); if (ATT_DUP & 1) attn_item<0>(p, l, it, lds, tid); }
        else if (it < n0 + n1) { if (KMASK & 2) attn_item<1>(p, l, it - n0, lds, tid); if (ATT_DUP & 2) attn_item<1>(p, l, it - n0, lds, tid); }
        else if (it < n0 + n1 + n2) { if (KMASK & 4) attn_item<2>(p, l, it - n0 - n1, lds, tid); }
        else { if (KMASK & 8) attn_item<3>(p, l, it - n0 - n1 - n2, lds, tid); }
    }
}
}

__device__ __forceinline__ float reduce16(const float (&t)[16], int lane) {
    float u[8], w4[4], x2[2];
#pragma unroll
    for (int e = 0; e < 8; ++e) { float a = t[e], b = t[e + 8]; asm volatile("s_nop 1\n\tv_permlane32_swap_b32 %0, %1" : "+v"(a), "+v"(b)); u[e] = a + b; }
#pragma unroll
    for (int e = 0; e < 4; ++e) { float a = u[e], b = u[e + 4]; asm volatile("s_nop 1\n\tv_permlane16_swap_b32 %0, %1" : "+v"(a), "+v"(b)); w4[e] = a + b; }
    const bool b3 = (lane & 8) != 0, b2 = (lane & 4) != 0;
#pragma unroll
    for (int e = 0; e < 2; ++e) { const float keep = b3 ? w4[e + 2] : w4[e], send = b3 ? w4[e] : w4[e + 2]; x2[e] = keep + dppf<0x128>(send); }
    const float keep = b2 ? x2[1] : x2[0], send = b2 ? x2[0] : x2[1];
    float y = keep + dppf<0x141>(send);
    y += dppf<0xB1>(y); y += dppf<0x4E>(y);
    return y;
}
__device__ __forceinline__ float wave_max(float v) {
    v = fmaxf(v, dppf<0xB1>(v)); v = fmaxf(v, dppf<0x4E>(v)); v = fmaxf(v, dppf<0x141>(v)); v = fmaxf(v, dppf<0x140>(v));
    return xor32_max(xor16_max(v));
}
__device__ __forceinline__ float row16_sum(float v) { v += dppf<0xB1>(v); v += dppf<0x4E>(v); v += dppf<0x141>(v); v += dppf<0x140>(v); return v; }
__device__ __forceinline__ float row16_max(float v) { v = fmaxf(v, dppf<0xB1>(v)); v = fmaxf(v, dppf<0x4E>(v)); v = fmaxf(v, dppf<0x141>(v)); v = fmaxf(v, dppf<0x140>(v)); return v; }
__device__ __forceinline__ void phase_ln_router(const Params& p, int l, bool with_ctx, LAS unsigned char* lds, int bid, int nb) {
    bid = opaque_s(bid); const int tid = opaque_tid(), lane = tid & 63, w = tid >> 6, gw = bid * NWAVES + w, NGW = nb * NWAVES;
    constexpr int WRS = 2064;
    LAS unsigned char* wrb = lds;
    LAS float* lg = (LAS float*)(lds + 16 * WRS + 32); LAS float* lb = lg + DM; LAS float* lsh = lb + DM; LAS float* lsc = lsh + 5 * DM;
    LAS unsigned char* hst = (LAS unsigned char*)(lsc + 5 * DM) + w * 4096;
    const float* wrg = p.w_router + (size_t)l * DM * NE;
    for (int i = tid; i < DM * NE / 2; i += NTHREADS) { const int c = (i >> 4) * 2, e = i & 15; *(LAS unsigned*)(wrb + e * WRS + c * 2) = pk2(wrg[c * 16 + e], wrg[(c + 1) * 16 + e]); }
    lds_fill(lg, p.ln1_g + l * DM, DM, tid); lds_fill(lb, p.ln1_b + l * DM, DM, tid);
    for (int r = 0; r < 5; ++r) { lds_fill(lsh + r * DM, mod_ptr(p, l, r) + 3 * DM, DM, tid); lds_fill(lsc + r * DM, mod_ptr(p, l, r) + 4 * DM, DM, tid); }
    __syncthreads();
    const bf16_t* XB = (const bf16_t*)(p.ws + WS_XB); bf16_t* HB = (bf16_t*)(p.ws + WS_HB); float* AFF = (float*)(p.ws + WS_AFF);
    const int nrows = with_ctx ? NROWS : NLAT;
    const int fr = lane & 15, fq = lane >> 4;
    const LAS unsigned char* bsrc = wrb + fr * WRS + fq * 16;
    const LAS unsigned char* asrc = hst + (fr & 1) * 2048 + fq * 16;
    auto rowh2 = [&](f32x4 (&v)[4], int row, int slot) {
        row_normalize(v); row_affine_l(v, lg, lb, lane);
        row_normalize(v);
        { const int mr = row_modrow(row); row_modulate_l(v, lsh + mr * DM, lsc + mr * DM, lane); }
#pragma unroll
        for (int j = 0; j < 4; ++j) { u32x2 o; o.x = pk2(v[j][0], v[j][1]); o.y = pk2(v[j][2], v[j][3]); *(u32x2*)(HB + (size_t)row * DM + 256 * j + 4 * lane) = o; *(LAS u32x2*)(hst + slot * 2048 + (256 * j + 4 * lane) * 2) = o; }
    };
    f32x4 va[4], vb[4]; u32x2 na[4], nb2[4];
    auto ldraw = [&](u32x2 (&d)[4], int r) {
#pragma unroll
        for (int j = 0; j < 4; ++j) d[j] = *(const u32x2*)(XB + (size_t)r * DM + 256 * j + 4 * lane); };
    auto unpack = [&](f32x4 (&d)[4], const u32x2 (&sv)[4]) {
#pragma unroll
        for (int j = 0; j < 4; ++j) d[j] = (f32x4){bf_lo(sv[j].x), bf_hi(sv[j].x), bf_lo(sv[j].y), bf_hi(sv[j].y)}; };
    const int step = 2 * NGW;
    ldraw(na, min(gw, nrows - 1)); ldraw(nb2, min(gw + NGW, nrows - 1));
#pragma unroll 1
    for (int row = gw; row < nrows; row += step) {
        const int rowB = min(row + NGW, nrows - 1);
        unpack(va, na); unpack(vb, nb2);
        ldraw(na, min(row + step, nrows - 1)); ldraw(nb2, min(row + step + NGW, nrows - 1));
        rowh2(va, row, 0); asm volatile("" ::: "memory"); rowh2(vb, rowB, 1);
        LDS_WAIT();
        f32x4 acc = {0.f, 0.f, 0.f, 0.f};
#pragma unroll 8
        for (int s = 0; s < 32; ++s) { const bf16x8 af = *(const LAS bf16x8*)(asrc + 64 * s), bf = *(const LAS bf16x8*)(bsrc + 64 * s); acc = __builtin_amdgcn_mfma_f32_16x16x32_bf16(af, bf, acc, 0, 0, 0); }
        const float m0 = row16_max(acc[0]), m1 = row16_max(acc[1]), e0 = expf(acc[0] - m0), e1 = expf(acc[1] - m1);
        float a0 = e0 / row16_sum(e0), a1 = e1 / row16_sum(e1);
        asm volatile("" : "+v"(a0), "+v"(a1));
        if (lane < 16) { AFF[(size_t)lane * NROWS + row] = a0; AFF[(size_t)lane * NROWS + rowB] = a1; }
        LDS_WAIT();
    }
}

__device__ __forceinline__ void topk_item(const float* aff  , int n, int k, int row0  , int e, int slot0,
                                          int* TOK, float* GATE, int* INV, LAS unsigned char* lds) {
    const int tid = opaque_tid(), lane = tid & 63, w = tid >> 6;
    LAS unsigned* keys = (LAS unsigned*)lds;
    LAS unsigned* hist = keys + 8192;
    LAS unsigned* misc = hist + 256;
    for (int i = tid; i < n; i += NTHREADS) keys[i] = __builtin_bit_cast(unsigned, aff[i]);
    if (tid == 0) { misc[0] = 0u; misc[1] = (unsigned)k; }
    __syncthreads();
    unsigned maskv = 0u;
    for (int pass = 0; pass < 4; ++pass) {
        const int shift = 24 - 8 * pass;
        if (tid < 256) hist[tid] = 0u;
        __syncthreads();
        const unsigned prefix = misc[0];
        for (int i = tid; i < n; i += NTHREADS) { const unsigned kv = keys[i]; if ((kv & maskv) == prefix) atomicAdd((unsigned*)&hist[(kv >> shift) & 255u], 1u); }
        __syncthreads();
        if (w == 0) {
            const unsigned rem = misc[1];
            const unsigned h0 = hist[4 * lane], h1 = hist[4 * lane + 1], h2 = hist[4 * lane + 2], h3 = hist[4 * lane + 3], s4 = h0 + h1 + h2 + h3;
            unsigned S = s4;
#pragma unroll
            for (int o = 1; o < 64; o <<= 1) { const unsigned y = __shfl_down(S, o); if (lane + o < 64) S += y; }
            const unsigned above = S - s4;
            if (above < rem && rem <= S) { unsigned cum = above; int bin;
                if (cum + h3 >= rem) bin = 3; else { cum += h3; if (cum + h2 >= rem) bin = 2; else { cum += h2; if (cum + h1 >= rem) bin = 1; else { cum += h1; bin = 0; } } }
                misc[0] = prefix | ((unsigned)(4 * lane + bin) << shift); misc[1] = rem - cum; }
        }
        __syncthreads();
        maskv |= 255u << shift;
    }
    const unsigned T = misc[0], need_eq = misc[1];
    __syncthreads();
    const int per = n >= NTHREADS ? n / NTHREADS : 1; const int t0 = tid * per; const bool act = t0 < n;
    unsigned ce = 0u;
    if (act) for (int i = 0; i < per; ++i) ce += (keys[t0 + i] == T) ? 1u : 0u;
    unsigned inc = ce;
#pragma unroll
    for (int o = 1; o < 64; o <<= 1) { const unsigned y = __shfl_up(inc, o); if (lane >= o) inc += y; }
    if (lane == 63) misc[16 + w] = inc;
    __syncthreads();
    unsigned base = 0u;
    for (int ww = 0; ww < w; ++ww) base += misc[16 + ww];
    unsigned eqrank = base + inc - ce;
    __syncthreads();
    unsigned cs = 0u;
    if (act) { unsigned er = eqrank; for (int i = 0; i < per; ++i) { const unsigned kv = keys[t0 + i]; if (kv > T) cs++; else if (kv == T) { if (er < need_eq) cs++; er++; } } }
    inc = cs;
#pragma unroll
    for (int o = 1; o < 64; o <<= 1) { const unsigned y = __shfl_up(inc, o); if (lane >= o) inc += y; }
    if (lane == 63) misc[16 + w] = inc;
    __syncthreads();
    base = 0u;
    for (int ww = 0; ww < w; ++ww) base += misc[16 + ww];
    unsigned pos = base + inc - cs;
    if (act) { unsigned er = eqrank; for (int i = 0; i < per; ++i) { const unsigned kv = keys[t0 + i]; bool sel = false;
            if (kv > T) sel = true; else if (kv == T) { sel = er < need_eq; er++; }
            const int row = row0 + t0 + i;
            if (sel) { const int slot = slot0 + (int)pos; TOK[slot] = row; GATE[slot] = __builtin_bit_cast(float, kv); INV[(size_t)e * NROWS + row] = slot; pos++; }
            else INV[(size_t)e * NROWS + row] = -1; } }
    __syncthreads();
}
__device__ __forceinline__ void phase_topk(const Params& p, bool with_ctx, LAS unsigned char* lds, int bid, int nb) {
    const float* AFF = (const float*)(p.ws + WS_AFF); int* TOK = (int*)(p.ws + WS_TOK); float* GATE = (float*)(p.ws + WS_GATE); int* INV = (int*)(p.ws + WS_INV);
    const int nitems = with_ctx ? 128 : 64;
    for (int it = bid; it < nitems; it += nb) {
        if (it < 64) { const int b = it >> 4, e = it & 15; topk_item(AFF + (size_t)e * NROWS + (size_t)b * SEQ, SEQ, CAP, b * SEQ, e, (b * NE + e) * CAP, TOK, GATE, INV, lds); }
        else { const int b = (it - 64) >> 4, e = it & 15; topk_item(AFF + (size_t)e * NROWS + NLAT + (size_t)b * CTXL, CTXL, CCAP, NLAT + b * CTXL, e, NSLOT_LAT + (e * NB + b) * CCAP, TOK, GATE, INV, lds); }
    }
}

__device__ __forceinline__ void phase_combine(const Params& p, int l, bool with_ctx, LAS unsigned char* lds, int bid, int nb) {
    bid = opaque_s(bid); const int tid = opaque_tid(); const int lane = tid & 63, gw = bid * NWAVES + (tid >> 6), NGW = nb * NWAVES;
    LAS float* l1g = (LAS float*)lds; LAS float* l1b = l1g + DM; LAS float* l2g = l1b + DM; LAS float* l2b = l2g + DM; LAS float* lg2 = l2b + DM; LAS float* lsh = lg2 + 5 * DM; LAS float* lsc = lsh + 5 * DM;
    lds_fill(l1g, p.ln1_g + l * DM, DM, tid); lds_fill(l1b, p.ln1_b + l * DM, DM, tid); lds_fill(l2g, p.ln2_g + l * DM, DM, tid); lds_fill(l2b, p.ln2_b + l * DM, DM, tid);
    for (int r = 0; r < 5; ++r) { lds_fill(lg2 + r * DM, mod_ptr(p, l, r) + 5 * DM, DM, tid); if (l + 1 < DEPTH) { lds_fill(lsh + r * DM, mod_ptr(p, l + 1, r), DM, tid); lds_fill(lsc + r * DM, mod_ptr(p, l + 1, r) + DM, DM, tid); } }
    __syncthreads();
    bf16_t* XB = (bf16_t*)(p.ws + WS_XB); bf16_t* HB = (bf16_t*)(p.ws + WS_HB);
    const bf16_t* Y = (const bf16_t*)(p.ws + WS_Y); const int* INV = (const int*)(p.ws + WS_INV);
    const float* g = p.ln2_g + l * DM; const float* bb = p.ln2_b + l * DM;
    const int nrows = with_ctx ? NROWS : NLAT;
    f32x4 v[4], vn[4]; int myinv = -1, myinvn = -1;
    if (gw < nrows) { row_load_bf16(XB + (size_t)gw * DM, lane, v); myinv = INV[(size_t)(lane & 15) * NROWS + gw]; }
#pragma unroll 1
    for (int row = gw; row < nrows; row += NGW) {
        bf16_t* xr = XB + (size_t)row * DM;
        const int rn = row + NGW;
        if (rn < nrows) { row_load_bf16(XB + (size_t)rn * DM, lane, vn); myinvn = INV[(size_t)(lane & 15) * NROWS + rn]; }
        f32x4 a[4];
#pragma unroll
        for (int j = 0; j < 4; ++j) a[j] = (f32x4){0.f, 0.f, 0.f, 0.f};
#pragma unroll
        for (int e = 0; e < 16; ++e) {
            const int slot = __builtin_amdgcn_readlane(myinv, e);
            if (slot >= 0) { const bf16_t* yr = Y + (size_t)slot * DM;
#pragma unroll
                for (int j = 0; j < 4; ++j) { const u32x2 wv = *(const u32x2*)(yr + 256 * j + 4 * lane); a[j][0] += bf_lo(wv.x); a[j][1] += bf_hi(wv.x); a[j][2] += bf_lo(wv.y); a[j][3] += bf_hi(wv.y); } }
        }
        row_normalize(v); row_affine_l(v, l1g, l1b, lane);
        const int mr = row_modrow(row);
#pragma unroll
        for (int j = 0; j < 4; ++j) { const f32x4 g2 = *(const LAS f32x4*)(lg2 + mr * DM + 256 * j + 4 * lane); v[j] = v[j] * ALPHA + g2 * a[j]; }
        row_normalize(v); row_affine_l(v, l2g, l2b, lane);
        if (l + 1 < DEPTH) row_store_bf16(xr, lane, v); else row_store(p.out + (size_t)row * DM, lane, v);
        if (l + 1 < DEPTH) { row_normalize(v); row_modulate_l(v, lsh + mr * DM, lsc + mr * DM, lane); row_store_bf16(HB + (size_t)row * DM, lane, v); }
#pragma unroll
        for (int j = 0; j < 4; ++j) v[j] = vn[j];
        myinv = myinvn;
    }
}

constexpr int N_PHASES = 2 + 8 * DEPTH;
#define IN(k) (lo <= (k) && (k) < hi)
#ifndef TS_SEL
#define TS_SEL -1
#endif
#define TS_MULT 8
#define SEAM(k) do { if (IN(k) && IN((k) + 1)) xcd_barrier(bar); if (TS_SEL >= 0 && blockIdx.x == 0 && threadIdx.x == 0) ((unsigned long long*)(p.ws + WS_CTL + 65536))[(k) + 1] = __builtin_amdgcn_s_memrealtime(); } while (0)
#ifndef PHMASK
#define PHMASK 0x3ff
#endif
#define PHON(i) ((PHMASK >> (i)) & 1)
#ifndef DUP_MASK
#define DUP_MASK 0
#endif
#define DUP(i) ((DUP_MASK >> (i)) & 1)
template <int l>
__device__ __forceinline__ void run_layer(const Params& p, LAS unsigned char* lds, LAS int* idxl, const XcdBarrier& bar, int bid, int nb, int lo, int hi) {
    bf16_t* HB = (bf16_t*)(p.ws + WS_HB); bf16_t* PB = (bf16_t*)(p.ws + WS_PB); bf16_t* OB = (bf16_t*)(p.ws + WS_OB);
    bf16_t* HH = (bf16_t*)(p.ws + WS_HH); bf16_t* Y = (bf16_t*)(p.ws + WS_Y);
    const int* TOK = (const int*)(p.ws + WS_TOK); const float* GATE = (const float*)(p.ws + WS_GATE);
        const int pb = 2 + 8 * l; const bool wc = (l == 0);
        if (IN(pb + 0)) { if (PHON(2)) {
            const bf16_t* W = (const bf16_t*)(p.ws + WS_WIN) + (size_t)l * INW * DM; EpiQKV E{PB, (const float*)(p.ws + WS_ROPE)};
            { SgDesc g{HB + (size_t)NLAT * DM, DM, nullptr, W, 0, 1 << 30, 1, NCTX, INW, DM, NLAT}; sg_gemm(g, E, lds, bid, nb); }
            { mg::Gemm g{HB, W, NLAT, INW, DM, nullptr, 0, 1 << 20, 1}; mg::StaticOrder S; S.init(NLAT, INW, nb, bid); mg::EpiAdapt<EpiQKV> EA{E, 0}; mg::gemm_phase(lds, idxl, g, S, EA); if (DUP(2)) mg::gemm_phase(lds, idxl, g, S, EA); } } }
        SEAM(pb + 0);
        if (IN(pb + 1)) { if (PHON(3)) {
#if FAST_ATTN
            fa::phase_attn(p, l, wc, lds, bid, nb); if (DUP(3)) fa::phase_attn(p, l, wc, lds, bid, nb);
#endif
            phase_mixers(p, l, wc, bid, nb); } }
        SEAM(pb + 1);
        if (IN(pb + 2)) { if (PHON(4)) {
            const bf16_t* W = (const bf16_t*)(p.ws + WS_WOUT) + (size_t)l * DM * DM;
            EpiOut<l == 0> E{p.x, p.ctx, (bf16_t*)(p.ws + WS_XB), mod_ptr(p, l, 0)};
            if (wc) { SgDesc g{OB + (size_t)NLAT * DM, DM, nullptr, W, 0, 1 << 30, 1, NCTX, DM, DM, NLAT}; sg_gemm(g, E, lds, bid, nb); }
            { mg::Gemm g{OB, W, NLAT, DM, DM, nullptr, 0, 1 << 20, 1}; mg::StaticOrder S; S.init(NLAT, DM, nb, bid); mg::EpiAdapt<EpiOut<l == 0>> EA{E, 0}; mg::gemm_phase(lds, idxl, g, S, EA); if (DUP(4) && l == 0) mg::gemm_phase(lds, idxl, g, S, EA); } } }
        SEAM(pb + 2);
        if (IN(pb + 3)) { if (PHON(5)) phase_ln_router(p, l, wc, lds, bid, nb); }
        SEAM(pb + 3);
        if (IN(pb + 4)) { if (PHON(6)) { phase_topk(p, wc, lds, bid, nb); if (DUP(6)) phase_topk(p, wc, lds, bid, nb);
            { const int busy = wc ? 128 : 64;
              if (bid >= busy && nb > busy) phase_weights(p, lds, bid - busy, nb - busy, l == 0 ? TR_P0 : TR_SPLIT, l == 0 ? TR_SPLIT : 2 * TR_PER_L); } } }
        SEAM(pb + 4);
        if (IN(pb + 5)) { if (PHON(7)) {
            const bf16_t* W = (const bf16_t*)(p.ws + WS_WGU) + (size_t)l * NE * 1024 * DM; EpiGU E{HH};
            if (wc) { SgDesc g{HB, DM, TOK + NSLOT_LAT, W, (size_t)1024 * DM, NB * CCAP, NE, NSLOT_CTX, 1024, DM, NSLOT_LAT}; sg_gemm(g, E, lds, bid, nb); }
            { mg::Gemm g{HB, W, NSLOT_LAT, 1024, DM, TOK, (size_t)1024 * DM, CAP / 256, NE}; mg::StaticOrder S; S.init(NSLOT_LAT, 1024, nb, bid); mg::EpiAdapt<EpiGU> EA{E, 0}; mg::gemm_phase(lds, idxl, g, S, EA); if (DUP(7)) mg::gemm_phase(lds, idxl, g, S, EA); } } }
        SEAM(pb + 5);
        if (IN(pb + 6)) { if (PHON(8)) {
            const bf16_t* W = (const bf16_t*)(p.ws + WS_WD) + (size_t)l * NE * DM * FF; EpiDown E{Y, GATE};
            if (wc) { SgDesc g{HH + (size_t)NSLOT_LAT * FF, FF, nullptr, W, (size_t)DM * FF, NB * CCAP, NE, NSLOT_CTX, DM, FF, NSLOT_LAT}; sg_gemm(g, E, lds, bid, nb); }
            { mg::Gemm g{HH, W, NSLOT_LAT, DM, FF, nullptr, (size_t)DM * FF, CAP / 256, NE}; mg::StaticOrder S; S.init(NSLOT_LAT, DM, nb, bid); mg::EpiAdapt<EpiDown> EA{E, 0}; mg::gemm_phase(lds, idxl, g, S, EA); if (DUP(8)) mg::gemm_phase(lds, idxl, g, S, EA); } } }
        SEAM(pb + 6);
        if (IN(pb + 7)) { if (PHON(9)) phase_combine(p, l, wc, lds, bid, nb); }
        SEAM(pb + 7);
}
__global__ void __launch_bounds__(NTHREADS, 2) fwd_kernel(Params p) {
    extern __shared__ __attribute__((aligned(16))) unsigned char lds_raw[];
    LAS unsigned char* lds = (LAS unsigned char*)lds_raw;
    const int bid = blockIdx.x, nb = gridDim.x;
    volatile LAS unsigned* MISC = (volatile LAS unsigned*)(lds + LDS_BYTES - 64);
    LAS int* idxl = (LAS int*)(lds + mg::STAGE_BYTES);
    if (threadIdx.x < 16) MISC[threadIdx.x] = 0u;
    __syncthreads();
    XcdBarrier bar; bar.bar = (unsigned*)(p.ws + WS_CTL) + CW_BAR; bar.x = 0; bar.st = nullptr;
    const bool multi = p.ph_hi - p.ph_lo > 1;
    if (multi) bar = xcd_barrier_post((unsigned*)(p.ws + WS_CTL) + CW_BAR, MISC + 8);
    bf16_t* HB = (bf16_t*)(p.ws + WS_HB); bf16_t* PB = (bf16_t*)(p.ws + WS_PB); bf16_t* OB = (bf16_t*)(p.ws + WS_OB);
    bf16_t* HH = (bf16_t*)(p.ws + WS_HH); bf16_t* Y = (bf16_t*)(p.ws + WS_Y);
    const int* TOK = (const int*)(p.ws + WS_TOK); const float* GATE = (const float*)(p.ws + WS_GATE);
    const int lo = p.ph_lo, hi = p.ph_hi;
    if (TS_SEL >= 0 && blockIdx.x == 0 && threadIdx.x == 0) ((unsigned long long*)(p.ws + WS_CTL + 65536))[0] = __builtin_amdgcn_s_memrealtime();
    if (IN(0)) { if (PHON(0)) { phase_prologue(p, lds, bid, nb); __syncthreads(); phase_weights(p, lds, bid, nb, 0, TR_P0); } } SEAM(0);
    if (IN(1)) { if (PHON(1)) phase_ln1(p, bid, nb); if (DUP(1)) phase_ln1(p, bid, nb); } SEAM(1);
    run_layer<0>(p, lds, idxl, bar, bid, nb, lo, hi);
    run_layer<1>(p, lds, idxl, bar, bid, nb, lo, hi);
    if (TS_SEL >= 0 && blockIdx.x == 0 && threadIdx.x == 0) {
        volatile unsigned long long* ts = (volatile unsigned long long*)(p.ws + WS_CTL + 65536); const unsigned long long dt = (ts[TS_SEL + 1] - ts[TS_SEL]) * TS_MULT, t0 = __builtin_amdgcn_s_memrealtime();
        while (__builtin_amdgcn_s_memrealtime() - t0 < dt) __builtin_amdgcn_s_sleep(8); }
#undef IN
#undef SEAM
}

#ifndef N_LAUNCH_SPLIT
#define N_LAUNCH_SPLIT 0
#endif
extern "C" void kernel_launch(void* const* d_in, const int* in_sizes, int n_in, void* d_out, int out_size, void* d_ws, size_t ws_size, hipStream_t stream) {
    static int grid = 0;
    if (grid == 0) {
        if (n_in != 19 || in_sizes[0] != NLAT * DM || out_size != NLAT * DM || ws_size < WS_END) { fprintf(stderr, "kernel_launch: unexpected shapes (n_in %d, in0 %d, out %d, ws %zu)\n", n_in, n_in > 0 ? in_sizes[0] : -1, out_size, ws_size); grid = -1; return; }
        int dev = 0, cus = 0, per_cu = 0;
        if (hipGetDevice(&dev) != hipSuccess || hipDeviceGetAttribute(&cus, hipDeviceAttributeMultiprocessorCount, dev) != hipSuccess) { grid = -1; return; }
        if (hipFuncSetAttribute((const void*)fwd_kernel, hipFuncAttributeMaxDynamicSharedMemorySize, LDS_BYTES) != hipSuccess) { fprintf(stderr, "kernel_launch: hipFuncSetAttribute failed\n"); grid = -1; return; }
        if (hipOccupancyMaxActiveBlocksPerMultiprocessor(&per_cu, (const void*)fwd_kernel, NTHREADS, LDS_BYTES) != hipSuccess || per_cu < 1) { fprintf(stderr, "kernel_launch: occupancy query says %d\n", per_cu); per_cu = 1; }
        (void)hipGetLastError();
        grid = cus;
    }
    if (grid < 0) return;
    (void)hipMemsetAsync((char*)d_ws + WS_CTL, 0, CTL_ZERO_BYTES, stream);
    Params p{};
    const float** pp = (const float**)&p;
    for (int i = 0; i < 19; ++i) pp[i] = (const float*)d_in[i];
    p.out = (float*)d_out; p.ws = (unsigned char*)d_ws;
#if N_LAUNCH_SPLIT
    for (int ph = 0; ph < N_PHASES; ++ph) { p.ph_lo = ph; p.ph_hi = ph + 1; hipLaunchKernelGGL(fwd_kernel, dim3(grid), dim3(NTHREADS), LDS_BYTES, stream, p); }
#else
    p.ph_lo = 0; p.ph_hi = N_PHASES;
    void* args[] = {&p};
    hipError_t e = hipLaunchCooperativeKernel((const void*)fwd_kernel, dim3(grid), dim3(NTHREADS), args, LDS_BYTES, stream);
    if (e != hipSuccess) fprintf(stderr, "kernel_launch: cooperative launch failed: %s\n", hipGetErrorString(e));
#endif
}
```

```cpp
#include <hip/hip_runtime.h>
#include <hip/hip_cooperative_groups.h>
#include <cstdio>
#include <cstdint>
#include <cmath>

#define LAS __attribute__((address_space(3)))
typedef unsigned short bf16_t;
typedef short bf16x8 __attribute__((ext_vector_type(8)));
typedef float f32x4 __attribute__((ext_vector_type(4)));
typedef unsigned u32x4 __attribute__((ext_vector_type(4)));
typedef unsigned u32x2 __attribute__((ext_vector_type(2)));

constexpr int NB = 4, SEQ = 8192, DM = 1024, CTXL = 256, DEPTH = 2;
constexpr int NLAT = NB * SEQ, NCTX = NB * CTXL, NROWS = NLAT + NCTX;
constexpr int INW = 2560, NE = 16, FF = 512, CAP = 1024, CCAP = 32;
constexpr int NSLOT_LAT = NB * NE * CAP, NSLOT_CTX = NB * NE * CCAP, NSLOT = NSLOT_LAT + NSLOT_CTX;
constexpr int NMOD = 6 * DM;
constexpr float LN_EPS = 1e-6f;
constexpr float ALPHA = 1.41421356237309515f;
constexpr int C_QA = 0, C_KA = 384, C_VA = 512, C_BX = 640, C_BB = 896, C_BC = 1152, C_QN = 1408, C_KN = 1792, C_VN = 2176;

#ifndef FAST_ATTN
#define FAST_ATTN 1
#endif
constexpr int KV_TOK = SEQ + CTXL;
constexpr int NTHREADS = 512, NWAVES = 8;
constexpr int LDS_BYTES = 147456;

constexpr size_t MiB = 1u << 20;
constexpr size_t WS_CTL = 0, CTL_ZERO_BYTES = 128 * 1024;
constexpr size_t WS_ROPE = 1 * MiB;
constexpr size_t WS_MOD = 1 * MiB + 65536;
constexpr size_t WS_AFF = 2 * MiB;
constexpr size_t WS_INV = 5 * MiB;
constexpr size_t WS_TOK = 8 * MiB;
constexpr size_t WS_GATE = 8 * MiB + 512 * 1024;
constexpr size_t WS_CXR = 9 * MiB;
constexpr size_t WS_WIN = 16 * MiB;
constexpr size_t WS_WOUT = 26 * MiB;
constexpr size_t WS_WGU = 30 * MiB;
constexpr size_t WS_WD = 94 * MiB;
constexpr size_t WS_HB = 126 * MiB;
constexpr size_t WS_OB = 192 * MiB;
constexpr size_t WS_HH = 192 * MiB;
constexpr size_t WS_PB = 258 * MiB;
constexpr size_t WS_Y = 258 * MiB;
constexpr size_t WS_XB = 424 * MiB;
constexpr size_t WS_END = 490 * MiB;
static_assert(WS_HB + (size_t)NROWS * DM * 2 <= WS_OB && WS_OB + (size_t)NROWS * DM * 2 <= WS_PB && WS_PB + (size_t)NROWS * INW * 2 <= WS_XB && WS_XB + (size_t)NROWS * DM * 2 <= WS_END, "ws map");
static_assert((size_t)NSLOT * FF * 2 <= (size_t)NROWS * DM * 2 && (size_t)NSLOT * DM * 2 <= (size_t)NROWS * INW * 2, "overlays");
constexpr int CW_BAR = 4096;

struct Params {
    const float *x, *c, *ctx, *c_ctx, *w_mod, *b_mod, *w_in, *conv_w, *attn_sink, *na_rpb, *w_out, *ln1_g, *ln1_b, *w_router, *w_gate, *w_up, *w_down, *ln2_g, *ln2_b;
    float* out; unsigned char* ws;
    int ph_lo, ph_hi;
};

__device__ __forceinline__ unsigned f2bf(float f) { unsigned u = __builtin_bit_cast(unsigned, f); return (u + 0x7fffu + ((u >> 16) & 1u)) >> 16; }
typedef float f32x2_cv __attribute__((ext_vector_type(2))); typedef __bf16 bf16x2_cv __attribute__((ext_vector_type(2)));
__device__ __forceinline__ unsigned pk2(float lo, float hi) { f32x2_cv v = {lo, hi}; bf16x2_cv b = __builtin_convertvector(v, bf16x2_cv); return __builtin_bit_cast(unsigned, b); }
__device__ __forceinline__ float bf_lo(unsigned w) { return __builtin_bit_cast(float, w << 16); }
__device__ __forceinline__ float bf_hi(unsigned w) { return __builtin_bit_cast(float, w & 0xffff0000u); }
template <int CTRL> __device__ __forceinline__ float dppf(float v) { return __builtin_bit_cast(float, __builtin_amdgcn_update_dpp(0, __builtin_bit_cast(int, v), CTRL, 0xf, 0xf, true)); }
__device__ __forceinline__ void swap16(float v, float& a, float& b) { a = v; b = v; asm volatile("s_nop 1\n\tv_permlane16_swap_b32 %0, %1" : "+v"(a), "+v"(b)); }
__device__ __forceinline__ void swap32(float v, float& a, float& b) { a = v; b = v; asm volatile("s_nop 1\n\tv_permlane32_swap_b32 %0, %1" : "+v"(a), "+v"(b)); }
__device__ __forceinline__ float xor16_sum(float v) { float a, b; swap16(v, a, b); return a + b; }
__device__ __forceinline__ float xor32_sum(float v) { float a, b; swap32(v, a, b); return a + b; }
__device__ __forceinline__ float xor16_max(float v) { float a, b; swap16(v, a, b); return fmaxf(a, b); }
__device__ __forceinline__ float xor32_max(float v) { float a, b; swap32(v, a, b); return fmaxf(a, b); }
__device__ __forceinline__ float wave_sum(float v) {
    v += dppf<0xB1>(v); v += dppf<0x4E>(v); v += dppf<0x141>(v); v += dppf<0x140>(v);
    return xor32_sum(xor16_sum(v));
}
#define LDS_WAIT() asm volatile("s_waitcnt lgkmcnt(0)" ::: "memory")
__device__ __forceinline__ int opaque_tid() { int t = threadIdx.x; asm volatile("" : "+v"(t)); return t; }
__device__ __forceinline__ int opaque_s(int v) { asm volatile("" : "+s"(v)); return v; }

__device__ __forceinline__ float* mod_ptr(const Params& p, int l, int r) { return (float*)(p.ws + WS_MOD) + ((size_t)l * 5 + r) * NMOD; }

#define XB_TMO      128
#define XB_XCNT(j)  (256  + 64 * (j))
#define XB_XSUB(j)  (1280 + 64 * (j))
#define XB_XGEN(j)  (2304 + 64 * (j))
#define XB_TOP      3328
#define XB_TOPGEN   3392
#define XCD_BAR_WORDS 3456
#define XB_SPIN_CAP (1u << 20)
__device__ __forceinline__ unsigned xb_ld(unsigned* p)              { return __hip_atomic_load(p, __ATOMIC_RELAXED, __HIP_MEMORY_SCOPE_AGENT); }
__device__ __forceinline__ unsigned xb_add(unsigned* p, unsigned v) { return __hip_atomic_fetch_add(p, v, __ATOMIC_RELAXED, __HIP_MEMORY_SCOPE_AGENT); }
__device__ __forceinline__ unsigned xb_xcc_id() { return (unsigned)__builtin_amdgcn_s_getreg((3 << 11) | 20) & 0xFu; }
#define XB_SPIN(cond, bar) do { unsigned _sp = 0; while (cond) { __builtin_amdgcn_s_sleep(1); \
    if ((++_sp & 255u) == 0u) { if (xb_ld(&(bar)[XB_TMO])) break; if (_sp > XB_SPIN_CAP) { atomicAdd(&(bar)[XB_TMO], 1u); break; } } } } while (0)
struct XcdBarrier { unsigned* bar; unsigned x; volatile LAS unsigned* st; };
__device__ __forceinline__ XcdBarrier xcd_barrier_post(unsigned* bar, volatile LAS unsigned* st) {
    XcdBarrier b; b.bar = bar; b.x = xb_xcc_id(); b.st = st;
    if (threadIdx.x == 0) (void)xb_add(&bar[XB_XCNT(b.x)], 1u);
    return b;
}
__device__ __forceinline__ void xcd_barrier_complete(unsigned* bar, unsigned x, unsigned& nloc, unsigned& nx) {
    const unsigned G = gridDim.x * gridDim.y * gridDim.z;
    unsigned sum, cnt, mine, sp = 0u;
    for (;;) {
        sum = 0u; cnt = 0u; mine = 0u;
#pragma unroll 1
        for (unsigned j = 0; j < 16; ++j) { const unsigned c = xb_ld(&bar[XB_XCNT(j)]); sum += c; cnt += (c > 0u) ? 1u : 0u; mine = (j == x) ? c : mine; }
        if (sum == G) break;
        __builtin_amdgcn_s_sleep(1);
        if ((++sp & 255u) == 0u) { if (xb_ld(&bar[XB_TMO])) break; if (sp > XB_SPIN_CAP) { atomicAdd(&bar[XB_TMO], 1u); break; } }
    }
    nloc = mine > 0u ? mine : 1u; nx = cnt > 0u ? cnt : 1u;
}
__device__ __forceinline__ void xcd_barrier(const XcdBarrier& b) {
    asm volatile("s_waitcnt vmcnt(0)" ::: "memory");
    __syncthreads();
    if (threadIdx.x == 0) {
        unsigned* bar = b.bar; asm volatile("" : "+s"(bar));
        __builtin_amdgcn_s_waitcnt(0);
        unsigned nloc = b.st[0], nx = b.st[1];
        if (nloc == 0u) { xcd_barrier_complete(bar, b.x, nloc, nx); b.st[0] = nloc; b.st[1] = nx; }
        const unsigned old = xb_add(&bar[XB_XSUB(b.x)], 1u);
        const unsigned gen = old / nloc;
        if (old + 1u == (gen + 1u) * nloc) {
            __builtin_amdgcn_fence(__ATOMIC_RELEASE, "agent");
            asm volatile("s_waitcnt vmcnt(0)" ::: "memory");
            const unsigned og = xb_add(&bar[XB_TOP], 1u);
            const unsigned tg = og / nx;
            if (og + 1u == (tg + 1u) * nx) xb_add(&bar[XB_TOPGEN], 1u);
            else XB_SPIN(xb_ld(&bar[XB_TOPGEN]) == tg, bar);
            __builtin_amdgcn_fence(__ATOMIC_ACQUIRE, "agent");
            xb_add(&bar[XB_XGEN(b.x)], 1u);
            asm volatile("s_waitcnt vmcnt(0)" ::: "memory");
        } else {
            XB_SPIN(xb_ld(&bar[XB_XGEN(b.x)]) == gen, bar);
            __builtin_amdgcn_fence(__ATOMIC_ACQUIRE, "agent");
            asm volatile("s_waitcnt vmcnt(0)" ::: "memory");
        }
    }
    __syncthreads();
}

struct TrItem { const float* W; bf16_t* WT; int K, N, mode, item; };
__device__ __forceinline__ void tr_load(const TrItem& t, int lane, float (&r)[32]) {
    const int nblk = t.N / 32, kb = t.item / nblk, nb = t.item % nblk, k0 = 64 * kb, n0 = 32 * nb;
    const float* src = t.W + (size_t)(k0 + (lane >> 5)) * t.N + n0 + (lane & 31);
#pragma unroll
    for (int i = 0; i < 32; ++i) r[i] = src[(size_t)(2 * i) * t.N];
}
__device__ __forceinline__ void tr_finish(const TrItem& t, int lane, const float (&r)[32], LAS float* scr) {
    const int nblk = t.N / 32, kb = t.item / nblk, nb = t.item % nblk, k0 = 64 * kb, n0 = 32 * nb;
#pragma unroll
    for (int i = 0; i < 32; ++i) scr[(2 * i + (lane >> 5)) * 33 + (lane & 31)] = r[i];
    LDS_WAIT();
    const int c = lane & 7;
#pragma unroll
    for (int j = 0; j < 4; ++j) {
        const int n = (lane >> 3) + 8 * j; const LAS float* s = scr + (8 * c) * 33 + n;
        u32x4 o; o.x = pk2(s[0 * 33], s[1 * 33]); o.y = pk2(s[2 * 33], s[3 * 33]); o.z = pk2(s[4 * 33], s[5 * 33]); o.w = pk2(s[6 * 33], s[7 * 33]);
        const int f = n0 + n;
        const int orow = t.mode == 0 ? ((f & ~255) + 128 * ((f >> 4) & 1) + 32 * ((f >> 6) & 3) + 16 * ((f >> 2) & 1) + 4 * (2 * ((f >> 5) & 1) + ((f >> 3) & 1)) + (f & 3))
                                     : (256 * (f >> 7) + (t.mode == 2 ? 128 : 0) + 32 * ((f >> 5) & 3) + 16 * ((f >> 2) & 1) + 4 * ((f >> 3) & 3) + (f & 3));
        *(u32x4*)(t.WT + (size_t)orow * t.K + k0 + 8 * c) = o;
    }
    LDS_WAIT();
}
__device__ __forceinline__ void phase_prologue(const Params& p, LAS unsigned char* lds, int bid, int nb) {
    bid = opaque_s(bid); const int tid = opaque_tid(), lane = tid & 63, w = tid >> 6;
    {
        LAS float* ssil = (LAS float*)lds;
        LAS float* red = ssil + 5 * 1024;
        for (int i = tid; i < 5 * 1024; i += NTHREADS) { const int r = i >> 10, k = i & 1023; const float v = r < 4 ? p.c[r * 1024 + k] : p.c_ctx[k]; ssil[i] = v / (1.f + expf(-v)); }
        __syncthreads();
        for (int item = bid; item < 2 * 96; item += nb) {
            const int l = item / 96, n0 = (item % 96) * 64;
            const float* W = p.w_mod + (size_t)l * DM * NMOD + n0 + lane;
            float a0 = 0.f, a1 = 0.f, a2 = 0.f, a3 = 0.f, a4 = 0.f;
#pragma unroll 8
            for (int k = w * 128; k < w * 128 + 128; ++k) {
                const float wv = W[(size_t)k * NMOD];
                a0 += ssil[k] * wv; a1 += ssil[1024 + k] * wv; a2 += ssil[2048 + k] * wv; a3 += ssil[3072 + k] * wv; a4 += ssil[4096 + k] * wv;
            }
            red[(w * 5 + 0) * 64 + lane] = a0; red[(w * 5 + 1) * 64 + lane] = a1; red[(w * 5 + 2) * 64 + lane] = a2; red[(w * 5 + 3) * 64 + lane] = a3; red[(w * 5 + 4) * 64 + lane] = a4;
            __syncthreads();
            if (tid < 320) { const int r = tid >> 6; float s = 0.f;
#pragma unroll
                for (int ww = 0; ww < 8; ++ww) s += red[(ww * 5 + r) * 64 + lane];
                mod_ptr(p, l, r)[n0 + lane] = s + p.b_mod[l * NMOD + n0 + lane]; }
            __syncthreads();
        }
    }
    if (bid == nb - 1) {
        float* rope = (float*)(p.ws + WS_ROPE);
        for (int e = tid; e < 128 * 16; e += NTHREADS) {
            const int pos = e >> 4, i = e & 15;
            const double a = exp(-((double)i / 16.0) * 9.210340371976184);
            const double a2 = a * a; double c = 1.0, s = a, tc = 1.0, ts = a;
            for (int n = 1; n <= 14; ++n) { tc *= -a2 / (double)((2 * n - 1) * (2 * n)); c += tc; ts *= -a2 / (double)((2 * n) * (2 * n + 1)); s += ts; }
            double rc = 1.0, rs = 0.0, bc = c, bs = s; int q = pos;
            while (q) { if (q & 1) { const double t = rc * bc - rs * bs; rs = rc * bs + rs * bc; rc = t; } const double t = bc * bc - bs * bs; bs = 2.0 * bc * bs; bc = t; q >>= 1; }
            rope[2 * e] = (float)rc; rope[2 * e + 1] = (float)rs;
        }
    }
}

constexpr int TR_I_IN = 16 * 80, TR_I_OUT = 16 * 32, TR_I_G = 16 * 16, TR_I_D = 8 * 32, TR_PER_L = TR_I_IN + TR_I_OUT + 16 * (2 * TR_I_G + TR_I_D);
constexpr int TR_P0 = TR_I_IN + TR_I_OUT, TR_SPLIT = TR_PER_L + TR_I_IN + TR_I_OUT;
__device__ __forceinline__ void phase_weights(const Params& p, LAS unsigned char* lds, int bid, int nb, int lo, int hi) {
    bid = opaque_s(bid); const int tid = opaque_tid(), lane = tid & 63, w = tid >> 6;
    {
        LAS float* scr = (LAS float*)lds + w * (64 * 33);
        const int gw = bid * NWAVES + w, NGW = nb * NWAVES;
        constexpr int I_IN = TR_I_IN, I_OUT = TR_I_OUT, I_G = TR_I_G, I_D = TR_I_D, PER_L = TR_PER_L;
        auto decode = [&](int it) -> TrItem {
            const int l = it / PER_L; int r = it % PER_L;
            if (r < I_IN) return TrItem{p.w_in + (size_t)l * DM * INW, (bf16_t*)(p.ws + WS_WIN) + (size_t)l * INW * DM, DM, INW, 0, r}; r -= I_IN;
            if (r < I_OUT) return TrItem{p.w_out + (size_t)l * DM * DM, (bf16_t*)(p.ws + WS_WOUT) + (size_t)l * DM * DM, DM, DM, 0, r}; r -= I_OUT;
            if (r < 16 * I_G) { const int e = r / I_G; return TrItem{p.w_gate + ((size_t)l * NE + e) * DM * FF, (bf16_t*)(p.ws + WS_WGU) + ((size_t)l * NE + e) * 1024 * DM, DM, FF, 1, r % I_G}; } r -= 16 * I_G;
            if (r < 16 * I_G) { const int e = r / I_G; return TrItem{p.w_up + ((size_t)l * NE + e) * DM * FF, (bf16_t*)(p.ws + WS_WGU) + ((size_t)l * NE + e) * 1024 * DM, DM, FF, 2, r % I_G}; } r -= 16 * I_G;
            const int e = r / I_D; return TrItem{p.w_down + ((size_t)l * NE + e) * FF * DM, (bf16_t*)(p.ws + WS_WD) + ((size_t)l * NE + e) * DM * FF, FF, DM, 0, r % I_D};
        };
        float ra[32], rb[32];
        int it = lo + gw;
        if (it < hi) { TrItem cur = decode(it); tr_load(cur, lane, ra);
#pragma unroll 1
            for (;;) {
                const int itn = it + NGW; const bool hn = itn < hi; TrItem nx = cur;
                if (hn) { nx = decode(itn); tr_load(nx, lane, rb); }
                tr_finish(cur, lane, ra, scr);
                if (!hn) break;
                const int itn2 = itn + NGW; const bool hn2 = itn2 < hi; TrItem nx2 = nx;
                if (hn2) { nx2 = decode(itn2); tr_load(nx2, lane, ra); }
                tr_finish(nx, lane, rb, scr);
                if (!hn2) break;
                cur = nx2; it = itn2;
            }
        }
    }
}

__device__ __forceinline__ void row_load(const float* rowp, int lane, f32x4 (&v)[4]) {
#pragma unroll
    for (int j = 0; j < 4; ++j) v[j] = *(const f32x4*)(rowp + 256 * j + 4 * lane);
}
__device__ __forceinline__ void row_load_bf16(const bf16_t* rowp, int lane, f32x4 (&v)[4]) {
#pragma unroll
    for (int j = 0; j < 4; ++j) { const u32x2 w = *(const u32x2*)(rowp + 256 * j + 4 * lane); v[j] = (f32x4){bf_lo(w.x), bf_hi(w.x), bf_lo(w.y), bf_hi(w.y)}; }
}
__device__ __forceinline__ void row_store(float* rowp, int lane, const f32x4 (&v)[4]) {
#pragma unroll
    for (int j = 0; j < 4; ++j) *(f32x4*)(rowp + 256 * j + 4 * lane) = v[j];
}
__device__ __forceinline__ void row_store_bf16(bf16_t* rowp, int lane, const f32x4 (&v)[4]) {
#pragma unroll
    for (int j = 0; j < 4; ++j) { u32x2 o; o.x = pk2(v[j][0], v[j][1]); o.y = pk2(v[j][2], v[j][3]); *(u32x2*)(rowp + 256 * j + 4 * lane) = o; }
}
__device__ __forceinline__ void row_normalize(f32x4 (&v)[4]) {
    float s = 0.f;
#pragma unroll
    for (int j = 0; j < 4; ++j) s += (v[j][0] + v[j][1]) + (v[j][2] + v[j][3]);
    const float mean = wave_sum(s) * (1.f / DM);
    float q = 0.f;
#pragma unroll
    for (int j = 0; j < 4; ++j) { v[j] = v[j] - mean; q += (v[j][0] * v[j][0] + v[j][1] * v[j][1]) + (v[j][2] * v[j][2] + v[j][3] * v[j][3]); }
    const float rstd = 1.f / sqrtf(wave_sum(q) * (1.f / DM) + LN_EPS);
#pragma unroll
    for (int j = 0; j < 4; ++j) v[j] = v[j] * rstd;
}
__device__ __forceinline__ void row_modulate(f32x4 (&v)[4], const float* sh, const float* sc, int lane) {
#pragma unroll
    for (int j = 0; j < 4; ++j) { const f32x4 a = *(const f32x4*)(sc + 256 * j + 4 * lane), b = *(const f32x4*)(sh + 256 * j + 4 * lane); v[j] = v[j] * (a + 1.f) + b; }
}
__device__ __forceinline__ void row_affine(f32x4 (&v)[4], const float* g, const float* bb, int lane) {
#pragma unroll
    for (int j = 0; j < 4; ++j) { const f32x4 a = *(const f32x4*)(g + 256 * j + 4 * lane), b = *(const f32x4*)(bb + 256 * j + 4 * lane); v[j] = v[j] * a + b; }
}
__device__ __forceinline__ void row_modulate_l(f32x4 (&v)[4], const LAS float* sh, const LAS float* sc, int lane) {
#pragma unroll
    for (int j = 0; j < 4; ++j) { const f32x4 a = *(const LAS f32x4*)(sc + 256 * j + 4 * lane), b = *(const LAS f32x4*)(sh + 256 * j + 4 * lane); v[j] = v[j] * (a + 1.f) + b; }
}
__device__ __forceinline__ void row_affine_l(f32x4 (&v)[4], const LAS float* g, const LAS float* bb, int lane) {
#pragma unroll
    for (int j = 0; j < 4; ++j) { const f32x4 a = *(const LAS f32x4*)(g + 256 * j + 4 * lane), b = *(const LAS f32x4*)(bb + 256 * j + 4 * lane); v[j] = v[j] * a + b; }
}
__device__ __forceinline__ int row_modrow(int row) { return row < NLAT ? (row >> 13) : 4; }
__device__ __forceinline__ void lds_fill(LAS float* dst, const float* src, int n, int tid) { for (int i = tid * 4; i < n; i += NTHREADS * 4) *(LAS f32x4*)(dst + i) = *(const f32x4*)(src + i); }

__device__ __forceinline__ void phase_ln1(const Params& p, int bid, int nb) {
    bid = opaque_s(bid); const int tid = opaque_tid(), lane = tid & 63, gw = bid * NWAVES + (tid >> 6), NGW = nb * NWAVES;
    bf16_t* HB = (bf16_t*)(p.ws + WS_HB);
    f32x4 v[4], vn[4];
    if (gw < NROWS) row_load(gw < NLAT ? p.x + (size_t)gw * DM : p.ctx + (size_t)(gw - NLAT) * DM, lane, v);
#pragma unroll 1
    for (int row = gw; row < NROWS; row += NGW) {
        const int rn = row + NGW;
        if (rn < NROWS) row_load(rn < NLAT ? p.x + (size_t)rn * DM : p.ctx + (size_t)(rn - NLAT) * DM, lane, vn);
        row_normalize(v);
        const float* m = mod_ptr(p, 0, row_modrow(row)); row_modulate(v, m, m + DM, lane);
        row_store_bf16(HB + (size_t)row * DM, lane, v);
#pragma unroll
        for (int j = 0; j < 4; ++j) v[j] = vn[j];
    }
}

struct SgDesc { const bf16_t* A; int lda; const int* rowidx; const bf16_t* Bt; size_t grp_stride; int rows_per_grp, ngrp; int M, N, K; int row_base; };
template <class Epi>
__device__ __forceinline__ void sg_gemm(const SgDesc& g, const Epi& E, LAS unsigned char* lds, int bid, int nb) {
    bid = opaque_s(bid); const int tid = opaque_tid(); const int lane = tid & 63, w = __builtin_amdgcn_readfirstlane(tid >> 6), fr = lane & 15, fq = lane >> 4, wm = w >> 1, wn = w & 1;
    const int tilesN = g.N / 128, tiles = (g.M / 128) * tilesN, nk = g.K / 64;
    const int sr = tid >> 3, sp = tid & 7;
    const int soff = sr * 128 + ((sp ^ ((sr >> 1) & 7)) << 4);
    int aoff[2][2], boff[4][2];
#pragma unroll
    for (int ks = 0; ks < 2; ++ks) {
#pragma unroll
        for (int i = 0; i < 2; ++i) { const int r = 32 * wm + 16 * i + fr; aoff[i][ks] = r * 128 + (((fq + 4 * ks) ^ ((r >> 1) & 7)) << 4); }
#pragma unroll
        for (int n = 0; n < 4; ++n) { const int r = 64 * (n >> 1) + 32 * wn + 16 * (n & 1) + fr; boff[n][ks] = 16384 + r * 128 + (((fq + 4 * ks) ^ ((r >> 1) & 7)) << 4); }
    }
#pragma unroll 1
    for (int t = bid; t < tiles; t += nb) {
        const int tm = t / tilesN, tn = t % tilesN, pn = tn >> 1, wp = tn & 1;
        const int row0 = tm * 128;
        const bf16_t* Bt = g.Bt + (size_t)((row0 / g.rows_per_grp) % g.ngrp) * g.grp_stride;
        const bf16_t* as[2]; const bf16_t* bs[2];
#pragma unroll
        for (int h = 0; h < 2; ++h) { const int r = row0 + sr + 64 * h; const int ar = g.rowidx ? g.rowidx[r] : r; as[h] = g.A + (size_t)ar * g.lda + sp * 8;
            bs[h] = Bt + (size_t)(256 * pn + 128 * h + 64 * wp + sr) * g.K + sp * 8; }
        f32x4 acc[2][4];
#pragma unroll
        for (int i = 0; i < 2; ++i)
#pragma unroll
            for (int n = 0; n < 4; ++n) acc[i][n] = (f32x4){0.f, 0.f, 0.f, 0.f};
        u32x4 ra[2], rb[2];
#pragma unroll
        for (int h = 0; h < 2; ++h) { ra[h] = *(const u32x4*)(as[h]); rb[h] = *(const u32x4*)(bs[h]); }
#pragma unroll
        for (int h = 0; h < 2; ++h) { *(LAS u32x4*)(lds + soff + h * 8192) = ra[h]; *(LAS u32x4*)(lds + 16384 + soff + h * 8192) = rb[h]; }
        __syncthreads();
#pragma unroll 1
        for (int k = 0; k < nk; ++k) {
            const LAS unsigned char* buf = lds + (k & 1) * 32768;
            if (k + 1 < nk) {
#pragma unroll
                for (int h = 0; h < 2; ++h) { ra[h] = *(const u32x4*)(as[h] + (k + 1) * 64); rb[h] = *(const u32x4*)(bs[h] + (k + 1) * 64); } }
#pragma unroll
            for (int ks = 0; ks < 2; ++ks) {
                bf16x8 a[2], b[4];
#pragma unroll
                for (int i = 0; i < 2; ++i) a[i] = *(const LAS bf16x8*)(buf + aoff[i][ks]);
#pragma unroll
                for (int n = 0; n < 4; ++n) b[n] = *(const LAS bf16x8*)(buf + boff[n][ks]);
#pragma unroll
                for (int i = 0; i < 2; ++i)
#pragma unroll
                    for (int n = 0; n < 4; ++n) acc[i][n] = __builtin_amdgcn_mfma_f32_16x16x32_bf16(b[n], a[i], acc[i][n], 0, 0, 0);
            }
            if (k + 1 < nk) { LAS unsigned char* nbuf = lds + ((k + 1) & 1) * 32768;
#pragma unroll
                for (int h = 0; h < 2; ++h) { *(LAS u32x4*)(nbuf + soff + h * 8192) = ra[h]; *(LAS u32x4*)(nbuf + 16384 + soff + h * 8192) = rb[h]; } }
            __syncthreads();
        }
#pragma unroll
        for (int i = 0; i < 2; ++i) {
            const int row = g.row_base + row0 + 32 * wm + 16 * i + fr; const float rv = E.rowval(row);
            E(row, pn, 2 * wp + wn, fq, acc[i][0], acc[i][1], acc[i][2], acc[i][3], rv);
        }
    }
}

__device__ __forceinline__ void store_bf16x8(bf16_t* p, const f32x4 a, const f32x4 b) { u32x4 o; o.x = pk2(a[0], a[1]); o.y = pk2(a[2], a[3]); o.z = pk2(b[0], b[1]); o.w = pk2(b[2], b[3]); *(u32x4*)p = o; }
__device__ __forceinline__ int epi_col(int pn, int wc, int fq) { return 256 * pn + 64 * wc + 32 * (fq >> 1) + 8 * (fq & 1); }

struct EpiQKV {
    bf16_t* PB; const float* rope; bf16_t* KV;
    __device__ __forceinline__ float rowval(int) const { return 0.f; }
    __device__ __forceinline__ void operator()(int row, int pn, int wc, int fq, f32x4 a0, f32x4 a1, f32x4 b0, f32x4 b1, float) const {
        const int c = epi_col(pn, wc, fq);
        if (c < 512 && row < NLAT) {
            const int t = row & (SEQ - 1); const int pos = (fq >> 1) ? (t & 63) : (t >> 6);
            const f32x4* rp = (const f32x4*)(rope + (pos * 16 + 8 * (fq & 1)) * 2);
            const f32x4 r0 = rp[0], r1 = rp[1], r2 = rp[2], r3 = rp[3];
            const f32x4 cs0 = {r0[0], r0[2], r1[0], r1[2]}, sn0 = {r0[1], r0[3], r1[1], r1[3]}, cs1 = {r2[0], r2[2], r3[0], r3[2]}, sn1 = {r2[1], r2[3], r3[1], r3[3]};
            const f32x4 na0 = a0 * cs0 - b0 * sn0, nb0 = b0 * cs0 + a0 * sn0, na1 = a1 * cs1 - b1 * sn1, nb1 = b1 * cs1 + a1 * sn1;
            a0 = na0; b0 = nb0; a1 = na1; b1 = nb1;
        }
        const bool isk = (c >= C_KA && c < C_BX) || c >= C_KN;
        if (isk) {
            const int hd = c < C_BX ? ((c - C_KA) >> 6) & 1 : 2 + ((c - C_KN) >> 6) % 6, isv = c < C_BX ? (c >= C_VA) : (c >= C_VN);
            const int bb = row < NLAT ? row >> 13 : (row - NLAT) >> 8, tok = row < NLAT ? row & (SEQ - 1) : SEQ + ((row - NLAT) & (CTXL - 1));
            bf16_t* o = KV + ((size_t)(bb * 8 + hd) * KV_TOK + tok) * 128 + isv * 64 + (c & 63);
            store_bf16x8(o, a0, a1); store_bf16x8(o + 16, b0, b1);
        } else {
            bf16_t* o = PB + (size_t)row * INW + c;
            store_bf16x8(o, a0, a1); store_bf16x8(o + 16, b0, b1);
        }
    }
};
template <bool FIRST> struct EpiOut {
    const float* xl; const float* xc; bf16_t* XB; const float* mod;
    __device__ __forceinline__ float rowval(int) const { return 0.f; }
    __device__ __forceinline__ void operator()(int row, int pn, int wc, int fq, f32x4 a0, f32x4 a1, f32x4 b0, f32x4 b1, float) const {
        const int c = epi_col(pn, wc, fq); bf16_t* xo = XB + (size_t)row * DM + c;
        const float* g1 = mod + (size_t)row_modrow(row) * NMOD + 2 * DM + c;
        f32x4 xa0, xa1, xb0, xb1;
        if (FIRST) { const float* xin = row < NLAT ? xl + (size_t)row * DM + c : xc + (size_t)(row - NLAT) * DM + c;
            xa0 = *(const f32x4*)xin; xa1 = *(const f32x4*)(xin + 4); xb0 = *(const f32x4*)(xin + 16); xb1 = *(const f32x4*)(xin + 20); }
        else { const u32x4 wa = *(const u32x4*)xo, wb = *(const u32x4*)(xo + 16);
            xa0 = (f32x4){bf_lo(wa.x), bf_hi(wa.x), bf_lo(wa.y), bf_hi(wa.y)}; xa1 = (f32x4){bf_lo(wa.z), bf_hi(wa.z), bf_lo(wa.w), bf_hi(wa.w)};
            xb0 = (f32x4){bf_lo(wb.x), bf_hi(wb.x), bf_lo(wb.y), bf_hi(wb.y)}; xb1 = (f32x4){bf_lo(wb.z), bf_hi(wb.z), bf_lo(wb.w), bf_hi(wb.w)}; }
        const f32x4 ga0 = *(const f32x4*)g1, ga1 = *(const f32x4*)(g1 + 4), gb0 = *(const f32x4*)(g1 + 16), gb1 = *(const f32x4*)(g1 + 20);
        store_bf16x8(xo, xa0 * ALPHA + ga0 * a0, xa1 * ALPHA + ga1 * a1); store_bf16x8(xo + 16, xb0 * ALPHA + gb0 * b0, xb1 * ALPHA + gb1 * b1);
    }
};
struct EpiGU {
    bf16_t* HH;
    __device__ __forceinline__ float rowval(int) const { return 0.f; }
    __device__ __forceinline__ void operator()(int row, int pn, int wc, int fq, f32x4 a0, f32x4 a1, f32x4 b0, f32x4 b1, float) const {
        f32x4 h0, h1;
#pragma unroll
        for (int j = 0; j < 4; ++j) { h0[j] = a0[j] * __builtin_amdgcn_rcpf(1.f + __expf(-a0[j])) * b0[j]; h1[j] = a1[j] * __builtin_amdgcn_rcpf(1.f + __expf(-a1[j])) * b1[j]; }
        store_bf16x8(HH + (size_t)row * FF + 128 * pn + 32 * wc + 8 * fq, h0, h1);
    }
};
struct EpiDown {
    bf16_t* Y; const float* gate;
    __device__ __forceinline__ float rowval(int row) const { return gate[row]; }
    __device__ __forceinline__ void operator()(int row, int pn, int wc, int fq, f32x4 a0, f32x4 a1, f32x4 b0, f32x4 b1, float g) const {
        bf16_t* o = Y + (size_t)row * DM + epi_col(pn, wc, fq);
        store_bf16x8(o, a0 * g, a1 * g); store_bf16x8(o + 16, b0 * g, b1 * g);
    }
};

namespace mg {
constexpr int BM = 256, BK = 64, HALF = 128, HTB = HALF * BK * 2, STAGE_BYTES = 8 * HTB, NXCD = 8, WGM = 8, MAXU = 8;
__device__ __forceinline__ int lds_byte(int r, int c) { const int st = (r >> 4) * 2 + (c >> 5), rr = r & 15, cc = c & 31, ob = rr * 64 + cc * 2; return st * 1024 + (ob ^ (((ob >> 9) & 1) << 5)); }
__device__ __forceinline__ void stage_rc(int b, int& R, int& C) { const int st = b / 1024, sb = b % 1024, swz = sb ^ (((sb >> 9) & 1) << 5); R = (st >> 1) * 16 + swz / 64; C = (st & 1) * 32 + (swz % 64) / 2; }
struct Unit { int pm, pn; };
struct Gemm { const bf16_t* A; const bf16_t* Bt; int M, N, K; const int* rowidx; size_t grp_stride; int grp_tiles, ngrp; };
struct StaticOrder {
    int nM, nN, nwg, G, c;
    __device__ void init(int M, int N, int G_, int c_) { nM = M / BM; nN = N / BM; nwg = nM * nN; G = G_; c = c_; }
    __device__ bool next(int i, Unit& u) const {
        const long L = (long)i * G + c; if (L >= nwg) return false;
        int wgid = (int)L; { const int q = nwg / NXCD, r = nwg % NXCD, xcd = wgid % NXCD, off = wgid / NXCD; wgid = (xcd < r ? xcd * (q + 1) : r * (q + 1) + (xcd - r) * q) + off; }
        const int nig = WGM * nN, gid = wgid / nig, fm = gid * WGM, gsz = (nM - fm) < WGM ? (nM - fm) : WGM;
        u.pm = fm + ((wgid % nig) % gsz); u.pn = (wgid % nig) / gsz; return true;
    }
};
template <class Epi>
__device__ __forceinline__ void gemm_phase(LAS unsigned char* lds, LAS int* idxl, const Gemm g, const StaticOrder& S, const Epi& E) {
    const int tid = opaque_tid(), wid = __builtin_amdgcn_readfirstlane(tid >> 6), lane = tid & 63, wr = wid >> 2, wc = wid & 3, fr = lane & 15, fq = lane >> 4;
    const int K = g.K, nt = K / BK;
    unsigned voffB[2];
#pragma unroll
    for (int i = 0; i < 2; ++i) { int R_, C_; stage_rc(tid * 16 + i * 8192, R_, C_); voffB[i] = (unsigned)(R_ * K + C_) * 2u; }
    const size_t kstep = (size_t)(BK * 2);
    const size_t hstep = (size_t)HALF * K * 2;
    const size_t tstep = 2 * hstep;
    const unsigned ldsw = (unsigned)wid * 1024u;
    const int aoff = lds_byte(wr * 64 + fr, fq * 8), boff = lds_byte(wc * 32 + fr, fq * 8);
    Unit cur, nxt; int ui = 0;
    if (!S.next(0, cur)) return;
#ifndef MG_STAGGER_TICKS
#define MG_STAGGER_TICKS 0
#endif
    if (MG_STAGGER_TICKS && (blockIdx.x & 8)) { const unsigned long long t0 = __builtin_amdgcn_s_memrealtime(); while (__builtin_amdgcn_s_memrealtime() - t0 < MG_STAGGER_TICKS) __builtin_amdgcn_s_sleep(16); }
    if (g.rowidx) {
        for (int i = 0; i < MAXU; ++i) { Unit u; if (!S.next(i, u)) break; if (tid < 256) idxl[i * 256 + tid] = g.rowidx[u.pm * BM + tid]; }
        asm volatile("s_waitcnt vmcnt(0) lgkmcnt(0)" ::: "memory"); __builtin_amdgcn_s_barrier(); asm volatile("" ::: "memory");
    }
#define MG_AOFFS(dst, u_, ui_) do { _Pragma("unroll") for (int i_ = 0; i_ < 2; ++i_) { int R_, C_; stage_rc(tid * 16 + i_ * 8192, R_, C_); _Pragma("unroll") for (int h_ = 0; h_ < 2; ++h_) { \
        const int rr_ = g.rowidx ? idxl[(ui_) * 256 + h_ * HALF + R_] : ((u_).pm * BM + h_ * HALF + R_); dst[h_][i_] = (unsigned)(rr_ * K + C_) * 2u; } } } while (0)
#define MG_BPTR(u_) ((const char*)g.Bt + ((size_t)(((u_).pm / g.grp_tiles) % g.ngrp) * g.grp_stride) * 2 + (size_t)(u_).pn * tstep)
#define PG8_SA(b, h) (((b) * 2 + (h)) * HTB)
#define PG8_SB(b, h) ((4 + (b) * 2 + (h)) * HTB)
#define PG8_STAGE(bufoff, gbase, voff) do { _Pragma("unroll") for (int _i = 0; _i < 2; ++_i) \
        __builtin_amdgcn_global_load_lds((const unsigned*)((const char*)(gbase) + (voff)[_i]), (LAS unsigned*)(lds + (bufoff) + ldsw + _i * 8192), 16, 0, 0); } while (0)
#define PG8_LDA(dst, b, h) do { _Pragma("unroll") for (int m = 0; m < 4; ++m) _Pragma("unroll") for (int k = 0; k < 2; ++k) dst[m][k] = *(const LAS bf16x8*)(lds + PG8_SA(b, h) + aoff + m * 2048 + k * 1024); } while (0)
#define PG8_LDB(dst, b, h) do { _Pragma("unroll") for (int n = 0; n < 2; ++n) _Pragma("unroll") for (int k = 0; k < 2; ++k) dst[n][k] = *(const LAS bf16x8*)(lds + PG8_SB(b, h) + boff + n * 2048 + k * 1024); } while (0)
#define PG8_MMA(ai, bj, At, Bt) do { __builtin_amdgcn_s_setprio(1); _Pragma("unroll") for (int m = 0; m < 4; ++m) _Pragma("unroll") for (int n = 0; n < 2; ++n) _Pragma("unroll") for (int k = 0; k < 2; ++k) \
        acc[ai][bj][m][n] = __builtin_amdgcn_mfma_f32_16x16x32_bf16(Bt[n][k], At[m][k], acc[ai][bj][m][n], 0, 0, 0); __builtin_amdgcn_s_setprio(0); } while (0)
#define PG8_WAIT_V(n) asm volatile("s_waitcnt vmcnt(" #n ")" ::: "memory")
#define PG8_WAIT_L(n) asm volatile("s_waitcnt lgkmcnt(" #n ")" ::: "memory")
#define PG8_BAR __builtin_amdgcn_s_barrier()
#define PG8_SCHED __builtin_amdgcn_sched_barrier(0)
    f32x4 acc[2][2][4][2];
#pragma unroll
    for (int a = 0; a < 2; ++a)
#pragma unroll
        for (int b = 0; b < 2; ++b)
#pragma unroll
            for (int m = 0; m < 4; ++m)
#pragma unroll
                for (int n = 0; n < 2; ++n) acc[a][b][m][n] = (f32x4){0.f, 0.f, 0.f, 0.f};
    bf16x8 At[4][2], B0[2][2], B1[2][2];
    unsigned cAo[2][2], o2[2][2];
    MG_AOFFS(cAo, cur, 0);
    const char* const Abase = (const char*)g.A;
    const char* cB = MG_BPTR(cur);
    PG8_STAGE(PG8_SB(0, 0), cB, voffB); PG8_STAGE(PG8_SB(0, 1), cB + hstep, voffB); PG8_STAGE(PG8_SA(0, 0), Abase, cAo[0]); PG8_STAGE(PG8_SA(0, 1), Abase, cAo[1]);
    if (wr == 1) PG8_BAR;
    PG8_WAIT_V(2); PG8_BAR;
    PG8_STAGE(PG8_SB(1, 0), cB + kstep, voffB); PG8_STAGE(PG8_SA(1, 0), Abase + kstep, cAo[0]); PG8_STAGE(PG8_SB(1, 1), cB + hstep + kstep, voffB);
    PG8_WAIT_V(6); PG8_BAR;
    for (;;) {
        const bool has_next = S.next(ui + 1, nxt);
        const char* nB = has_next ? MG_BPTR(nxt) : cB;
        for (int t = 0; t < nt; t += 2) {
            const bool last = (t == nt - 2);
            const char* a1 = Abase + (size_t)(t + 1) * kstep;
            const char* a2 = last ? Abase : Abase + (size_t)(t + 2) * kstep; const char* b2 = last ? nB : cB + (size_t)(t + 2) * kstep;
            const char* a3 = a2 + kstep; const char* b3 = b2 + kstep;
            if (last && has_next) { MG_AOFFS(o2, nxt, ui + 1); } else {
#pragma unroll
                for (int h = 0; h < 2; ++h)
#pragma unroll
                    for (int i = 0; i < 2; ++i) o2[h][i] = cAo[h][i]; }
            PG8_LDB(B0, 0, 0); PG8_LDB(B1, 0, 1); PG8_SCHED; PG8_LDA(At, 0, 0); PG8_STAGE(PG8_SA(1, 1), a1, cAo[1]);
            PG8_WAIT_V(8); PG8_WAIT_L(0); PG8_BAR; PG8_MMA(0, 0, At, B0); PG8_MMA(0, 1, At, B1); PG8_BAR; PG8_SCHED;
            PG8_LDA(At, 0, 1); PG8_STAGE(PG8_SB(0, 0), b2, voffB); PG8_STAGE(PG8_SB(0, 1), b2 + hstep, voffB); PG8_STAGE(PG8_SA(0, 0), a2, o2[0]);
            PG8_WAIT_V(8); PG8_WAIT_L(0); PG8_BAR; PG8_MMA(1, 0, At, B0); PG8_MMA(1, 1, At, B1); PG8_BAR; PG8_SCHED;
            PG8_LDB(B0, 1, 0); PG8_LDB(B1, 1, 1); PG8_SCHED; PG8_LDA(At, 1, 0); PG8_STAGE(PG8_SA(0, 1), a2, o2[1]);
            PG8_WAIT_V(8); PG8_WAIT_L(0); PG8_BAR; PG8_MMA(0, 0, At, B0); PG8_MMA(0, 1, At, B1); PG8_BAR; PG8_SCHED;
            PG8_LDA(At, 1, 1); PG8_STAGE(PG8_SB(1, 0), b3, voffB); PG8_STAGE(PG8_SB(1, 1), b3 + hstep, voffB); PG8_STAGE(PG8_SA(1, 0), a3, o2[0]);
            PG8_WAIT_V(8); PG8_WAIT_L(0); PG8_BAR; PG8_MMA(1, 0, At, B0); PG8_MMA(1, 1, At, B1); PG8_BAR; PG8_SCHED;
        }
        if (wr == 0) PG8_BAR;
        E(acc, cur, wr, wc, fr, fq);
        if (!has_next) break;
#pragma unroll
        for (int a = 0; a < 2; ++a)
#pragma unroll
            for (int b = 0; b < 2; ++b)
#pragma unroll
                for (int m = 0; m < 4; ++m)
#pragma unroll
                    for (int n = 0; n < 2; ++n) acc[a][b][m][n] = (f32x4){0.f, 0.f, 0.f, 0.f};
        cur = nxt; cB = nB; ++ui;
#pragma unroll
        for (int h = 0; h < 2; ++h)
#pragma unroll
            for (int i = 0; i < 2; ++i) cAo[h][i] = o2[h][i];
        if (wr == 1) PG8_BAR;
    }
    PG8_WAIT_V(0);
    PG8_BAR;
#undef MG_AOFFS
#undef MG_BPTR
#undef PG8_SA
#undef PG8_SB
#undef PG8_STAGE
#undef PG8_LDA
#undef PG8_LDB
#undef PG8_MMA
#undef PG8_WAIT_V
#undef PG8_WAIT_L
#undef PG8_BAR
#undef PG8_SCHED
}
template <class EE> struct EpiAdapt {
    EE e; int row_base;
    __device__ __forceinline__ void operator()(const f32x4 (&acc)[2][2][4][2], const Unit& u, int wr, int wc, int fr, int fq) const {
        float rv[2][4];
#pragma unroll
        for (int ai = 0; ai < 2; ++ai)
#pragma unroll
            for (int m = 0; m < 4; ++m) rv[ai][m] = e.rowval(row_base + u.pm * BM + ai * HALF + wr * 64 + m * 16 + fr);
#pragma unroll
        for (int ai = 0; ai < 2; ++ai)
#pragma unroll
            for (int m = 0; m < 4; ++m) { const int row = row_base + u.pm * BM + ai * HALF + wr * 64 + m * 16 + fr;
                e(row, u.pn, wc, fq, acc[ai][0][m][0], acc[ai][0][m][1], acc[ai][1][m][0], acc[ai][1][m][1], rv[ai][m]);
                if (m & 1) asm volatile("" ::: "memory"); }
    }
};
}

struct AttnState { float m, l; float o[32]; };
__device__ __forceinline__ void attn_init(AttnState& st) { st.m = -INFINITY; st.l = 0.f;
#pragma unroll
    for (int d = 0; d < 32; ++d) st.o[d] = 0.f; }
__device__ __forceinline__ void load_row32(const bf16_t* p, float (&r)[32], float scale) {
#pragma unroll
    for (int i = 0; i < 4; ++i) { const u32x4 w = *(const u32x4*)(p + 8 * i);
        r[8 * i + 0] = bf_lo(w.x) * scale; r[8 * i + 1] = bf_hi(w.x) * scale; r[8 * i + 2] = bf_lo(w.y) * scale; r[8 * i + 3] = bf_hi(w.y) * scale;
        r[8 * i + 4] = bf_lo(w.z) * scale; r[8 * i + 5] = bf_hi(w.z) * scale; r[8 * i + 6] = bf_lo(w.w) * scale; r[8 * i + 7] = bf_hi(w.w) * scale; }
}
__device__ __forceinline__ float dot_row32(const bf16_t* p, const float (&q)[32]) {
    float d0 = 0.f, d1 = 0.f;
#pragma unroll
    for (int i = 0; i < 4; ++i) { const u32x4 w = *(const u32x4*)(p + 8 * i);
        d0 += q[8 * i + 0] * bf_lo(w.x); d1 += q[8 * i + 1] * bf_hi(w.x); d0 += q[8 * i + 2] * bf_lo(w.y); d1 += q[8 * i + 3] * bf_hi(w.y);
        d0 += q[8 * i + 4] * bf_lo(w.z); d1 += q[8 * i + 5] * bf_hi(w.z); d0 += q[8 * i + 6] * bf_lo(w.w); d1 += q[8 * i + 7] * bf_hi(w.w); }
    const float d = d0 + d1;
    return d + __shfl_xor(d, 32);
}
__device__ __forceinline__ void axpy_row32(const bf16_t* p, float a, float (&o)[32]) {
#pragma unroll
    for (int i = 0; i < 4; ++i) { const u32x4 w = *(const u32x4*)(p + 8 * i);
        o[8 * i + 0] += a * bf_lo(w.x); o[8 * i + 1] += a * bf_hi(w.x); o[8 * i + 2] += a * bf_lo(w.y); o[8 * i + 3] += a * bf_hi(w.y);
        o[8 * i + 4] += a * bf_lo(w.z); o[8 * i + 5] += a * bf_hi(w.z); o[8 * i + 6] += a * bf_lo(w.w); o[8 * i + 7] += a * bf_hi(w.w); }
}
template <class ScoreFn>
__device__ __forceinline__ void attn_segment(const float (&q)[32], AttnState& st, const bf16_t* Kb, const bf16_t* Vb, int j0, int j1, ScoreFn sf) {
#pragma unroll 1
    for (int j = j0; j < j1; ++j) {
        const float s0 = sf(j, dot_row32(Kb + (size_t)j * INW, q));
        if (s0 > st.m) { const float corr = __expf(st.m - s0); st.l *= corr;
#pragma unroll
            for (int d = 0; d < 32; ++d) st.o[d] *= corr;
            st.m = s0; }
        const float p0 = (s0 == -INFINITY) ? 0.f : __expf(s0 - st.m);
        st.l += p0;
        axpy_row32(Vb + (size_t)j * INW, p0, st.o);
    }
}
__device__ __forceinline__ void attn_sink(AttnState& st, float sk) {
    if (sk > st.m) { const float corr = __expf(st.m - sk); st.l *= corr;
#pragma unroll
        for (int d = 0; d < 32; ++d) st.o[d] *= corr;
        st.m = sk; }
    st.l += __expf(sk - st.m);
}
__device__ __forceinline__ void attn_store(const AttnState& st, bf16_t* o) {
    const float inv = 1.f / st.l;
#pragma unroll
    for (int i = 0; i < 4; ++i) { u32x4 w; w.x = pk2(st.o[8 * i] * inv, st.o[8 * i + 1] * inv); w.y = pk2(st.o[8 * i + 2] * inv, st.o[8 * i + 3] * inv);
        w.z = pk2(st.o[8 * i + 4] * inv, st.o[8 * i + 5] * inv); w.w = pk2(st.o[8 * i + 6] * inv, st.o[8 * i + 7] * inv); *(u32x4*)(o + 8 * i) = w; }
}

__device__ __forceinline__ void phase_mixers(const Params& p, int l, bool with_ctx, int bid, int nb) {
    bid = opaque_s(bid); const int tid = opaque_tid(); const int lane = tid & 63, gw = bid * NWAVES + (tid >> 6), NGW = nb * NWAVES;
    const int ql = lane & 31, hf = lane >> 5;
    const bf16_t* PB = (const bf16_t*)(p.ws + WS_PB); bf16_t* OB = (bf16_t*)(p.ws + WS_OB);
    const float* sink = p.attn_sink + l * 6; const float* rpb = p.na_rpb + (size_t)l * 6 * 15 * 31;
#if !FAST_ATTN
#pragma unroll 1
    for (int it = gw; it < NB * 6 * 256; it += NGW) {
        const int chunk = it & 255, h = (it >> 8) % 6, b = it / (6 * 256), kvh = h / 3;
        const int t = chunk * 32 + ql; const size_t rowb = (size_t)b * SEQ;
        float q[32]; load_row32(PB + (rowb + t) * INW + C_QA + h * 64 + 32 * hf, q, 0.125f);
        AttnState st; attn_init(st);
        const int jlo = max(0, chunk * 32 - 128), jhi = min(SEQ, chunk * 32 + 32 + 128);
        attn_segment(q, st, PB + rowb * INW + C_KA + kvh * 64 + 32 * hf, PB + rowb * INW + C_VA + kvh * 64 + 32 * hf, jlo, jhi,
                     [&](int j, float d) { const int dt = t - j; return (dt <= 128 && dt >= -128) ? d : -INFINITY; });
        const size_t crow = (size_t)NLAT + (size_t)b * CTXL;
        attn_segment(q, st, PB + crow * INW + C_KA + kvh * 64 + 32 * hf, PB + crow * INW + C_VA + kvh * 64 + 32 * hf, 0, CTXL, [&](int, float d) { return d; });
        attn_sink(st, sink[h]);
        attn_store(st, OB + (rowb + t) * DM + h * 64 + 32 * hf);
    }
#pragma unroll 1
    for (int it = gw; it < NB * 6 * 256; it += NGW) {
        const int r = (it & 255) >> 1, ch = it & 1, h = (it >> 8) % 6, b = it / (6 * 256);
        const int cq = ch * 32 + ql; const size_t rowb = (size_t)b * SEQ; const int t = r * 64 + cq;
        float q[32]; load_row32(PB + (rowb + t) * INW + C_QN + h * 64 + 32 * hf, q, 0.125f);
        AttnState st; attn_init(st);
        const int rs = min(max(r - 4, 0), 128 - 8), cs = min(max(cq - 8, 0), 64 - 16);
        const float* bias = rpb + (size_t)h * 15 * 31;
        attn_segment(q, st, PB + (rowb + (size_t)rs * 64) * INW + C_KN + h * 64 + 32 * hf, PB + (rowb + (size_t)rs * 64) * INW + C_VN + h * 64 + 32 * hf, 0, 512,
                     [&](int j, float d) { const int ka = rs + (j >> 6), ck = j & 63; const bool ok = (ck >= cs) && (ck < cs + 16);
                                           const int ro = ka - r + 7, co = min(max(ck - cq, -15), 15) + 15; return ok ? d + bias[ro * 31 + co] : -INFINITY; });
        const size_t crow = (size_t)NLAT + (size_t)b * CTXL;
        attn_segment(q, st, PB + crow * INW + C_KN + h * 64 + 32 * hf, PB + crow * INW + C_VN + h * 64 + 32 * hf, 0, CTXL, [&](int, float d) { return d; });
        attn_store(st, OB + (rowb + t) * DM + 640 + h * 64 + 32 * hf);
    }
#endif
    {
        const float* cw = p.conv_w + (size_t)l * 3 * 256;
        const int nrows = with_ctx ? NROWS : NLAT;
        for (long e = (long)bid * NTHREADS + tid; e < (long)nrows * 32; e += (long)nb * NTHREADS) {
            const int row = (int)(e >> 5), ch = (int)(e & 31) * 8;
            const int tpos = row < NLAT ? (row & (SEQ - 1)) : ((row - NLAT) & (CTXL - 1)); const int tlen = row < NLAT ? SEQ : CTXL;
            const bf16_t* pr = PB + (size_t)row * INW;
            float u[3][8];
#pragma unroll
            for (int dlt = -1; dlt <= 1; ++dlt) {
                const bool ok = (tpos + dlt >= 0) && (tpos + dlt < tlen);
                if (ok) { const u32x4 a = *(const u32x4*)(pr + (long)dlt * INW + C_BX + ch), c = *(const u32x4*)(pr + (long)dlt * INW + C_BC + ch);
                    u[dlt + 1][0] = bf_lo(a.x) * bf_lo(c.x); u[dlt + 1][1] = bf_hi(a.x) * bf_hi(c.x); u[dlt + 1][2] = bf_lo(a.y) * bf_lo(c.y); u[dlt + 1][3] = bf_hi(a.y) * bf_hi(c.y);
                    u[dlt + 1][4] = bf_lo(a.z) * bf_lo(c.z); u[dlt + 1][5] = bf_hi(a.z) * bf_hi(c.z); u[dlt + 1][6] = bf_lo(a.w) * bf_lo(c.w); u[dlt + 1][7] = bf_hi(a.w) * bf_hi(c.w); }
                else {
#pragma unroll
                    for (int i = 0; i < 8; ++i) u[dlt + 1][i] = 0.f; }
            }
            const u32x4 gb = *(const u32x4*)(pr + C_BB + ch);
            const float g[8] = {bf_lo(gb.x), bf_hi(gb.x), bf_lo(gb.y), bf_hi(gb.y), bf_lo(gb.z), bf_hi(gb.z), bf_lo(gb.w), bf_hi(gb.w)};
            float y[8];
#pragma unroll
            for (int i = 0; i < 8; ++i) y[i] = g[i] * (u[0][i] * cw[ch + i] + u[1][i] * cw[256 + ch + i] + u[2][i] * cw[512 + ch + i]);
            u32x4 o; o.x = pk2(y[0], y[1]); o.y = pk2(y[2], y[3]); o.z = pk2(y[4], y[5]); o.w = pk2(y[6], y[7]);
            *(u32x4*)(OB + (size_t)row * DM + 384 + ch) = o;
        }
    }
#if !FAST_ATTN
    if (with_ctx) {
#pragma unroll 1
        for (int it = gw; it < 2 * NB * 6 * 8; it += NGW) {
            const int kind = it / (NB * 6 * 8), r = it % (NB * 6 * 8), chunk = r & 7, h = (r >> 3) % 6, b = r / 48;
            const size_t crow = (size_t)NLAT + (size_t)b * CTXL; const int tq = chunk * 32 + ql;
            const int qc = (kind == 0 ? C_QA + h * 64 : C_QN + h * 64) + 32 * hf, kc = (kind == 0 ? C_KA + (h / 3) * 64 : C_KN + h * 64) + 32 * hf, vc = (kind == 0 ? C_VA + (h / 3) * 64 : C_VN + h * 64) + 32 * hf;
            float q[32]; load_row32(PB + (crow + tq) * INW + qc, q, 0.125f);
            AttnState st; attn_init(st);
            attn_segment(q, st, PB + crow * INW + kc, PB + crow * INW + vc, 0, CTXL, [&](int, float d) { return d; });
            if (kind == 0) attn_sink(st, sink[h]);
            attn_store(st, OB + (crow + tq) * DM + (kind == 0 ? 0 : 640) + h * 64 + 32 * hf);
        }
    }
#endif
}

namespace fa {
typedef short v4i16_t __attribute__((ext_vector_type(4)));
typedef float f32x2_t __attribute__((ext_vector_type(2))); typedef __bf16 bf16x2_t __attribute__((ext_vector_type(2)));
__device__ __forceinline__ unsigned cvtpk(float lo, float hi) { f32x2_t v = {lo, hi}; bf16x2_t b = __builtin_convertvector(v, bf16x2_t); return __builtin_bit_cast(unsigned, b); }
constexpr float LOG2E = 1.4426950408889634f, SC = 0.125f * LOG2E;
constexpr int CHUNK_BYTES = 65536;
constexpr int BIAS_OFF = 2 * CHUNK_BYTES;
constexpr float THR = 8.f;
__device__ __forceinline__ int na_rs(int r) { return min(max(r - 4, 0), 128 - 8); }
__device__ __forceinline__ void glds16(const void* gsrc, unsigned lds_dst) { unsigned keep;
    asm volatile("s_mov_b32 %0, m0\n\ts_mov_b32 m0, %2\n\ts_nop 0\n\tglobal_load_lds_dwordx4 %1, off\n\ts_mov_b32 m0, %0" : "=&s"(keep) : "v"(gsrc), "s"(lds_dst) : "memory"); }
#define FA_WAIT_BAR(N) asm volatile("s_waitcnt vmcnt(" #N ") lgkmcnt(0)\n\ts_barrier" ::: "memory")
__device__ __forceinline__ float max3f(float a, float b, float c) { float r; asm("v_max3_f32 %0, %1, %2, %3" : "=v"(r) : "v"(a), "v"(b), "v"(c)); return r; }
__device__ __forceinline__ float max8f(const f32x4& a, const f32x4& b) { return max3f(max3f(max3f(a[0], a[1], a[2]), a[3], b[0]), max3f(b[1], b[2], b[3]), -INFINITY); }
typedef float f32x16 __attribute__((ext_vector_type(16)));
__device__ __forceinline__ float max16f(const f32x16& a) {
    float x = max3f(a[0], a[1], a[2]); x = max3f(x, a[3], a[4]); x = max3f(x, a[5], a[6]); x = max3f(x, a[7], a[8]); x = max3f(x, a[9], a[10]); x = max3f(x, a[11], a[12]); x = max3f(x, a[13], a[14]);
    return fmaxf(x, a[15]);
}
typedef float f32x2v __attribute__((ext_vector_type(2)));
template <int MODE>
__device__ __forceinline__ void unit32(f32x16 (&o)[2], float& m, float& ls, const bf16x8 (&q)[4], const LAS unsigned char* Kt0, const LAS unsigned char* Kt1, const LAS unsigned char* Vt0, const LAS unsigned char* Vt1,
                                       const int (&kb)[4], const int (&vb)[2], bool rel0, bool rel1, bool mk0, bool mk1, int tb0, int tb1, const f32x16& fmask, const LAS float* bp0, const LAS float* bp1) {
    f32x16 s[2]; float tm = -INFINITY;
#pragma unroll
    for (int t = 0; t < 2; ++t) {
        if (!(t == 0 ? rel0 : rel1)) continue;
        const LAS unsigned char* Kt = t == 0 ? Kt0 : Kt1;
        bf16x8 kf[4];
#pragma unroll
        for (int ks = 0; ks < 4; ++ks) kf[ks] = *(const LAS bf16x8*)(Kt + kb[ks]);
        f32x16 acc = __builtin_amdgcn_mfma_f32_32x32x16_bf16(kf[0], q[0], (f32x16){0.f, 0.f, 0.f, 0.f, 0.f, 0.f, 0.f, 0.f, 0.f, 0.f, 0.f, 0.f, 0.f, 0.f, 0.f, 0.f}, 0, 0, 0);
#pragma unroll
        for (int ks = 1; ks < 4; ++ks) acc = __builtin_amdgcn_mfma_f32_32x32x16_bf16(kf[ks], q[ks], acc, 0, 0, 0);
        if (MODE == 2) {
            const LAS float* bp = t == 0 ? bp0 : bp1;
#pragma unroll
            for (int r = 0; r < 16; ++r) acc[r] = __builtin_fmaf(acc[r], SC, bp[(r & 3) + 8 * (r >> 2)]) + fmask[r];
        } else {
            if (MODE == 1 && (t == 0 ? mk0 : mk1)) { const int tb = t == 0 ? tb0 : tb1;
#pragma unroll
                for (int r = 0; r < 16; ++r) acc[r] = ((unsigned)(tb - ((r & 3) + 8 * (r >> 2))) <= 256u) ? acc[r] : -INFINITY;
            } else asm volatile("s_nop 15\n\ts_nop 7" : "+v"(acc));
        }
        s[t] = acc;
        tm = fmaxf(tm, max16f(acc));
    }
    if (MODE != 2) tm *= SC;
    if (__any(tm > m + THR)) {
        const float mn = fmaxf(m, xor32_max(tm)), al = __builtin_amdgcn_exp2f(m - mn); m = mn; ls *= al;
#pragma unroll
        for (int d = 0; d < 2; ++d) o[d] = o[d] * al;
    }
    const float nm = -m; f32x2v ps2 = {0.f, 0.f};
#pragma unroll
    for (int t = 0; t < 2; ++t) {
        if (!(t == 0 ? rel0 : rel1)) continue;
        const LAS unsigned char* Vt = t == 0 ? Vt0 : Vt1;
        f32x16 pv = MODE == 2 ? s[t] + nm : s[t] * SC + nm;
#pragma unroll
        for (int r = 0; r < 16; ++r) pv[r] = __builtin_amdgcn_exp2f(pv[r]);
#pragma unroll
        for (int r = 0; r < 16; r += 2) ps2 += (f32x2v){pv[r], pv[r + 1]};
#pragma unroll
        for (int st = 0; st < 2; ++st) {
            u32x4 pw; pw.x = cvtpk(pv[8 * st + 0], pv[8 * st + 1]); pw.y = cvtpk(pv[8 * st + 2], pv[8 * st + 3]); pw.z = cvtpk(pv[8 * st + 4], pv[8 * st + 5]); pw.w = cvtpk(pv[8 * st + 6], pv[8 * st + 7]);
            const bf16x8 pb = __builtin_bit_cast(bf16x8, pw);
#pragma unroll
            for (int db = 0; db < 2; ++db) {
                const v4i16_t t0 = __builtin_amdgcn_ds_read_tr16_b64_v4i16((LAS v4i16_t*)(Vt + st * 2048 + vb[db])), t1 = __builtin_amdgcn_ds_read_tr16_b64_v4i16((LAS v4i16_t*)(Vt + st * 2048 + 1024 + vb[db]));
                const bf16x8 vf = (bf16x8){t0[0], t0[1], t0[2], t0[3], t1[0], t1[1], t1[2], t1[3]};
                o[db] = __builtin_amdgcn_mfma_f32_32x32x16_bf16(vf, pb, o[db], 0, 0, 0);
            }
        }
    }
    ls += ps2[0] + ps2[1];
}
template <int KIND>
__device__ __forceinline__ void attn_item(const Params& p, int l, int item, LAS unsigned char* lds, int tid) {
    constexpr bool ISA = (KIND == 0 || KIND == 2);
    constexpr int NG = ISA ? 2 : 1;
    const int lane = tid & 63, w = __builtin_amdgcn_readfirstlane(tid >> 6), ql = lane & 31, hh = lane >> 5;
    const bf16_t* PB = (const bf16_t*)(p.ws + WS_PB); bf16_t* OB = (bf16_t*)(p.ws + WS_OB);
    int b, hx, blk;
    if (KIND == 0) { b = item >> 7; hx = (item >> 6) & 1; blk = item & 63; }
    else if (KIND == 1) { b = item / 192; hx = (item >> 5) % 6; blk = item & 31; }
    else if (KIND == 2) { b = item >> 2; hx = (item >> 1) & 1; blk = item & 1; }
    else { b = item / 6; hx = item % 6; blk = 0; }
    const size_t rowb = (size_t)b * SEQ, ctxb = (size_t)NLAT + (size_t)b * CTXL;
    const bf16_t* KVh = (const bf16_t*)p.out + (size_t)(b * 8 + (ISA ? hx : 2 + hx)) * KV_TOK * 128;
    int nwin = 0; size_t winrow0 = 0; int winpos0 = 0, krs0 = 0;
    if (KIND == 0) { const int first = blk == 0 ? 1 : 0, last = blk == 63 ? 2 : 3; nwin = (last - first + 1) >> 1; winpos0 = 128 * (blk - 1 + first); winrow0 = winpos0; }
    if (KIND == 1) { krs0 = na_rs(4 * blk); nwin = (na_rs(4 * blk + 3) + 8 - krs0 + 3) >> 2; winrow0 = (size_t)krs0 * 64; }
    const int nch = nwin + 1;
    const bool active = true;
    int gh[NG], gp0[NG];
#pragma unroll
    for (int gi = 0; gi < NG; ++gi) {
        const int G = ISA ? (w < 4 ? 2 * w + gi : 8 + (w - 4)) : w;
        if (ISA) { gh[gi] = 3 * hx + (G >> 2); gp0[gi] = 128 * blk + 32 * (G & 3); }
        else if (KIND == 1) { gh[gi] = hx; gp0[gi] = 16 * (G & 3); }
        else { gh[gi] = hx; gp0[gi] = 32 * G; }
    }
    const int nrow0 = 4 * blk + 2 * (w >> 2);
    const int nrq = nrow0 + (ql >> 4), ncq = gp0[0] + (ql & 15);
#define FA_QROW(gi, ql_) (KIND == 0 ? rowb + gp0[gi] + (ql_) : KIND == 2 ? ctxb + gp0[gi] + (ql_) : KIND == 1 ? rowb + (size_t)(nrow0 + ((ql_) >> 4)) * 64 + gp0[gi] + ((ql_) & 15) : ctxb + gp0[gi] + (ql_))
    const int skey = 8 * w + (lane >> 3), spc = lane & 7;
    const int ksrc = skey * 128 + ((spc ^ ((skey >> 1) & 7)) << 3);
    const int vsrc = skey * 128 + 64 + (((((spc >> 1) ^ (skey & 2)) << 1) | (spc & 1)) << 3);
    const unsigned lds0 = (unsigned)(uintptr_t)lds;
    const int noff = KIND == 1 ? ((gp0[0] >> 4) == 0 ? 0 : ((gp0[0] >> 4) == 1 ? 8 : ((gp0[0] >> 4) == 2 ? 24 : 32))) : 0;
    int kb[4], kbw[4], vb[2];
#pragma unroll
    for (int ks = 0; ks < 4; ++ks) { kb[ks] = ql * 128 + (((2 * ks + hh) ^ ((ql >> 1) & 7)) << 4); kbw[ks] = ql * 128 + (((2 * ks + hh) ^ (((noff + ql) >> 1) & 7)) << 4); }
    { const int vk = 4 * hh + ((lane & 15) >> 2);
#pragma unroll
      for (int db = 0; db < 2; ++db) vb[db] = vk * 128 + (((2 * db + ((lane >> 4) & 1)) ^ (vk & 2)) << 5) + ((lane & 3) << 3); }
#define FA_DMA(ci) do { const size_t r0_ = (ci) < nwin ? winrow0 + (size_t)(ci) * 256 : (size_t)SEQ; const bf16_t* s_ = KVh + r0_ * 128; \
        const unsigned d_ = (unsigned)__builtin_amdgcn_readfirstlane((int)(lds0 + ((ci) & 1) * CHUNK_BYTES + w * 1024)); \
        _Pragma("unroll") for (int q_ = 0; q_ < 4; ++q_) { glds16(s_ + q_ * 64 * 128 + ksrc, d_ + q_ * 8192u); glds16(s_ + q_ * 64 * 128 + vsrc, d_ + 32768u + q_ * 8192u); } } while (0)
    FA_DMA(0);
    bf16x8 qf[NG][4];
#pragma unroll
    for (int gi = 0; gi < NG; ++gi)
#pragma unroll
        for (int ks = 0; ks < 4; ++ks) qf[gi][ks] = *(const bf16x8*)(PB + FA_QROW(gi, ql) * INW + (ISA ? C_QA : C_QN) + gh[gi] * 64 + 16 * ks + 8 * hh);
    f32x16 o[NG][2]; float m[NG], ls[NG];
#pragma unroll
    for (int gi = 0; gi < NG; ++gi) {
#pragma unroll
        for (int d = 0; d < 2; ++d)
#pragma unroll
            for (int r = 0; r < 16; ++r) o[gi][d][r] = 0.f;
        if (ISA) { m[gi] = p.attn_sink[l * 6 + gh[gi]] * LOG2E; ls[gi] = hh == 0 ? 1.f : 0.f; } else { m[gi] = -1e30f; ls[gi] = 0.f; }
    }
    f32x16 fmask;
#pragma unroll
    for (int r = 0; r < 16; ++r) fmask[r] = 0.f;
    if (KIND == 1) { const int cs = min(max(ncq - 8, 0), 48);
#pragma unroll
        for (int r = 0; r < 16; ++r) { const int ck = noff + (r & 3) + 8 * (r >> 2) + 4 * hh; fmask[r] = ((ck >= cs) && (ck < cs + 16)) ? 0.f : -INFINITY; } }
    const int nqrs = na_rs(nrq);
    LAS float* biasL = (LAS float*)(lds + BIAS_OFF);
    if (KIND == 1) { const float* rp = p.na_rpb + ((size_t)l * 6 + hx) * 15 * 31;
        for (int i = tid; i < 16 * 128; i += NTHREADS) { const int x = (i & 127) - 64; biasL[i] = (i >> 7) == 15 ? -INFINITY : ((x >= -15 && x <= 15) ? rp[(i >> 7) * 31 + x + 15] * LOG2E : 0.f); } }
    FA_WAIT_BAR(0);
#pragma unroll
    for (int gi = 0; gi < NG; ++gi) { asm volatile("" : "+v"(qf[gi][0]), "+v"(qf[gi][1]), "+v"(qf[gi][2]), "+v"(qf[gi][3])); }
#pragma unroll 1
    for (int ci = 0; ci < nch; ++ci) {
        if (ci + 1 < nch) FA_DMA(ci + 1);
        const LAS unsigned char* Kb = lds + (ci & 1) * CHUNK_BYTES; const LAS unsigned char* Vb = Kb + 32768;
        const bool iswin = ci < nwin;
        if (active) {
            if (KIND == 1 && iswin) {
                const int rsA = na_rs(nrow0), rsB = na_rs(nrow0 + 1), bcol = 64 + noff + 4 * hh - ncq;
#pragma unroll 1
                for (int rr = 0; rr < 2; ++rr) {
                    const int kr0 = krs0 + 4 * ci + 2 * rr;
                    const bool rel0 = (kr0 >= rsA) && (kr0 < rsB + 8), rel1 = (kr0 + 1 >= rsA) && (kr0 + 1 < rsB + 8);
                    if (rel0 || rel1) {
                        const bool rowok0 = (kr0 >= nqrs) && (kr0 < nqrs + 8), rowok1 = (kr0 + 1 >= nqrs) && (kr0 + 1 < nqrs + 8);
                        const LAS float* bp0 = biasL + (rowok0 ? kr0 - nrq + 7 : 15) * 128 + bcol; const LAS float* bp1 = biasL + (rowok1 ? kr0 + 1 - nrq + 7 : 15) * 128 + bcol;
                        const LAS unsigned char* Kt = Kb + (128 * rr + noff) * 128; const LAS unsigned char* Vt = Vb + (128 * rr + noff) * 128;
                        unit32<2>(o[0], m[0], ls[0], qf[0], Kt, Kt + 64 * 128, Vt, Vt + 64 * 128, kbw, vb, rel0, rel1, false, false, 0, 0, fmask, bp0, bp1);
                    }
                }
            } else {
#pragma unroll 1
                for (int u = 0; u < 4; ++u) {
                    const LAS unsigned char* Kt = Kb + (64 * u) * 128; const LAS unsigned char* Vt = Vb + (64 * u) * 128;
#pragma unroll
                    for (int gi = 0; gi < NG; ++gi) {
                        if (ISA && gi == 1 && w >= 4) continue;
                        if (KIND == 0) {
                            bool rel[2] = {true, true}, msk[2] = {false, false};
                            if (iswin) {
#pragma unroll
                                for (int t = 0; t < 2; ++t) { const int j0 = winpos0 + 256 * ci + 64 * u + 32 * t, p0 = gp0[gi];
                                    rel[t] = (j0 + 31 >= p0 - 128) && (j0 <= p0 + 31 + 128); msk[t] = !((j0 >= p0 + 31 - 128) && (j0 + 31 <= p0 + 128)); } }
                            if (!(rel[0] || rel[1])) continue;
                            const int tb0 = gp0[gi] + ql - (winpos0 + 256 * ci + 64 * u) - 4 * hh + 128;
                            unit32<1>(o[gi], m[gi], ls[gi], qf[gi], Kt, Kt + 4096, Vt, Vt + 4096, kb, vb, rel[0], rel[1], msk[0], msk[1], tb0, tb0 - 32, fmask, nullptr, nullptr);
                        } else unit32<0>(o[gi], m[gi], ls[gi], qf[gi], Kt, Kt + 4096, Vt, Vt + 4096, kb, vb, true, true, false, false, 0, 0, fmask, nullptr, nullptr);
                    }
                }
            }
        }
        FA_WAIT_BAR(0);
    }
#undef FA_DMA
    if (active) {
        int ql2 = lane & 31; asm volatile("" : "+v"(ql2));
#pragma unroll
        for (int gi = 0; gi < NG; ++gi) {
            if (ISA && gi == 1 && w >= 4) continue;
            const float lt = xor32_sum(ls[gi]);
            const float inv = 1.f / lt;
            bf16_t* op = OB + FA_QROW(gi, ql2) * DM + (ISA ? 0 : 640) + gh[gi] * 64 + 4 * hh;
#pragma unroll
            for (int db = 0; db < 2; ++db)
#pragma unroll
                for (int i = 0; i < 4; ++i) { u32x2 ov; ov.x = cvtpk(o[gi][db][4 * i] * inv, o[gi][db][4 * i + 1] * inv); ov.y = cvtpk(o[gi][db][4 * i + 2] * inv, o[gi][db][4 * i + 3] * inv); *(u32x2*)(op + 32 * db + 8 * i) = ov; }
        }
    }
#undef FA_QROW
}
__device__ __forceinline__ void phase_attn(const Params& p, int l, bool with_ctx, LAS unsigned char* lds, int bid, int nb) {
    bid = opaque_s(bid);
    const int n0 = NB * 2 * 64, n1 = NB * 6 * 32, n2 = with_ctx ? NB * 2 * 2 : 0, n3 = with_ctx ? NB * 6 : 0;
    const int vb = (nb % 8 == 0) ? (bid % 8) * (nb / 8) + bid / 8 : bid;
#pragma unroll 1
    for (int it = vb; it < n0 + n1 + n2 + n3; it += nb) {
        const int tid = opaque_tid();
#ifndef KMASK
#define KMASK 15
#endif
#ifndef ATT_DUP
#define ATT_DUP 0
#endif
        if (it < n0) { if (KMASK & 1) attn_item<0>(p, l, it, lds, tid); if (ATT_DUP & 1) attn_item<0>(p, l, it, lds, tid); }
        else if (it < n0 + n1) { if (KMASK & 2) attn_item<1>(p, l, it - n0, lds, tid); if (ATT_DUP & 2) attn_item<1>(p, l, it - n0, lds, tid); }
        else if (it < n0 + n1 + n2) { if (KMASK & 4) attn_item<2>(p, l, it - n0 - n1, lds, tid); }
        else { if (KMASK & 8) attn_item<3>(p, l, it - n0 - n1 - n2, lds, tid); }
    }
}
}

__device__ __forceinline__ float reduce16(const float (&t)[16], int lane) {
    float u[8], w4[4], x2[2];
#pragma unroll
    for (int e = 0; e < 8; ++e) { float a = t[e], b = t[e + 8]; asm volatile("s_nop 1\n\tv_permlane32_swap_b32 %0, %1" : "+v"(a), "+v"(b)); u[e] = a + b; }
#pragma unroll
    for (int e = 0; e < 4; ++e) { float a = u[e], b = u[e + 4]; asm volatile("s_nop 1\n\tv_permlane16_swap_b32 %0, %1" : "+v"(a), "+v"(b)); w4[e] = a + b; }
    const bool b3 = (lane & 8) != 0, b2 = (lane & 4) != 0;
#pragma unroll
    for (int e = 0; e < 2; ++e) { const float keep = b3 ? w4[e + 2] : w4[e], send = b3 ? w4[e] : w4[e + 2]; x2[e] = keep + dppf<0x128>(send); }
    const float keep = b2 ? x2[1] : x2[0], send = b2 ? x2[0] : x2[1];
    float y = keep + dppf<0x141>(send);
    y += dppf<0xB1>(y); y += dppf<0x4E>(y);
    return y;
}
__device__ __forceinline__ float wave_max(float v) {
    v = fmaxf(v, dppf<0xB1>(v)); v = fmaxf(v, dppf<0x4E>(v)); v = fmaxf(v, dppf<0x141>(v)); v = fmaxf(v, dppf<0x140>(v));
    return xor32_max(xor16_max(v));
}
__device__ __forceinline__ float row16_sum(float v) { v += dppf<0xB1>(v); v += dppf<0x4E>(v); v += dppf<0x141>(v); v += dppf<0x140>(v); return v; }
__device__ __forceinline__ float row16_max(float v) { v = fmaxf(v, dppf<0xB1>(v)); v = fmaxf(v, dppf<0x4E>(v)); v = fmaxf(v, dppf<0x141>(v)); v = fmaxf(v, dppf<0x140>(v)); return v; }
__device__ __forceinline__ void phase_ln_router(const Params& p, int l, bool with_ctx, LAS unsigned char* lds, int bid, int nb) {
    bid = opaque_s(bid); const int tid = opaque_tid(), lane = tid & 63, w = tid >> 6, gw = bid * NWAVES + w, NGW = nb * NWAVES;
    constexpr int WRS = 2064;
    LAS unsigned char* wrb = lds;
    LAS float* lg = (LAS float*)(lds + 16 * WRS + 32); LAS float* lb = lg + DM; LAS float* lsh = lb + DM; LAS float* lsc = lsh + 5 * DM;
    LAS unsigned char* hst = (LAS unsigned char*)(lsc + 5 * DM) + w * 4096;
    const float* wrg = p.w_router + (size_t)l * DM * NE;
    for (int i = tid; i < DM * NE / 2; i += NTHREADS) { const int c = (i >> 4) * 2, e = i & 15; *(LAS unsigned*)(wrb + e * WRS + c * 2) = pk2(wrg[c * 16 + e], wrg[(c + 1) * 16 + e]); }
    lds_fill(lg, p.ln1_g + l * DM, DM, tid); lds_fill(lb, p.ln1_b + l * DM, DM, tid);
    for (int r = 0; r < 5; ++r) { lds_fill(lsh + r * DM, mod_ptr(p, l, r) + 3 * DM, DM, tid); lds_fill(lsc + r * DM, mod_ptr(p, l, r) + 4 * DM, DM, tid); }
    __syncthreads();
    const bf16_t* XB = (const bf16_t*)(p.ws + WS_XB); bf16_t* HB = (bf16_t*)(p.ws + WS_HB); float* AFF = (float*)(p.ws + WS_AFF);
    const int nrows = with_ctx ? NROWS : NLAT;
    const int fr = lane & 15, fq = lane >> 4;
    const LAS unsigned char* bsrc = wrb + fr * WRS + fq * 16;
    const LAS unsigned char* asrc = hst + (fr & 1) * 2048 + fq * 16;
    auto rowh2 = [&](f32x4 (&v)[4], int row, int slot) {
        row_normalize(v); row_affine_l(v, lg, lb, lane);
        row_normalize(v);
        { const int mr = row_modrow(row); row_modulate_l(v, lsh + mr * DM, lsc + mr * DM, lane); }
#pragma unroll
        for (int j = 0; j < 4; ++j) { u32x2 o; o.x = pk2(v[j][0], v[j][1]); o.y = pk2(v[j][2], v[j][3]); *(u32x2*)(HB + (size_t)row * DM + 256 * j + 4 * lane) = o; *(LAS u32x2*)(hst + slot * 2048 + (256 * j + 4 * lane) * 2) = o; }
    };
    f32x4 va[4], vb[4]; u32x2 na[4], nb2[4];
    auto ldraw = [&](u32x2 (&d)[4], int r) {
#pragma unroll
        for (int j = 0; j < 4; ++j) d[j] = *(const u32x2*)(XB + (size_t)r * DM + 256 * j + 4 * lane); };
    auto unpack = [&](f32x4 (&d)[4], const u32x2 (&sv)[4]) {
#pragma unroll
        for (int j = 0; j < 4; ++j) d[j] = (f32x4){bf_lo(sv[j].x), bf_hi(sv[j].x), bf_lo(sv[j].y), bf_hi(sv[j].y)}; };
    const int step = 2 * NGW;
    ldraw(na, min(gw, nrows - 1)); ldraw(nb2, min(gw + NGW, nrows - 1));
#pragma unroll 1
    for (int row = gw; row < nrows; row += step) {
        const int rowB = min(row + NGW, nrows - 1);
        unpack(va, na); unpack(vb, nb2);
        ldraw(na, min(row + step, nrows - 1)); ldraw(nb2, min(row + step + NGW, nrows - 1));
        rowh2(va, row, 0); asm volatile("" ::: "memory"); rowh2(vb, rowB, 1);
        LDS_WAIT();
        f32x4 acc = {0.f, 0.f, 0.f, 0.f};
#pragma unroll 8
        for (int s = 0; s < 32; ++s) { const bf16x8 af = *(const LAS bf16x8*)(asrc + 64 * s), bf = *(const LAS bf16x8*)(bsrc + 64 * s); acc = __builtin_amdgcn_mfma_f32_16x16x32_bf16(af, bf, acc, 0, 0, 0); }
        const float m0 = row16_max(acc[0]), m1 = row16_max(acc[1]), e0 = expf(acc[0] - m0), e1 = expf(acc[1] - m1);
        float a0 = e0 / row16_sum(e0), a1 = e1 / row16_sum(e1);
        asm volatile("" : "+v"(a0), "+v"(a1));
        if (lane < 16) { AFF[(size_t)lane * NROWS + row] = a0; AFF[(size_t)lane * NROWS + rowB] = a1; }
        LDS_WAIT();
    }
}

__device__ __forceinline__ void topk_item(const float* aff  , int n, int k, int row0  , int e, int slot0,
                                          int* TOK, float* GATE, int* INV, LAS unsigned char* lds) {
    const int tid = opaque_tid(), lane = tid & 63, w = tid >> 6;
    LAS unsigned* keys = (LAS unsigned*)lds;
    LAS unsigned* hist = keys + 8192;
    LAS unsigned* misc = hist + 256;
    for (int i = tid; i < n; i += NTHREADS) keys[i] = __builtin_bit_cast(unsigned, aff[i]);
    if (tid == 0) { misc[0] = 0u; misc[1] = (unsigned)k; }
    __syncthreads();
    unsigned maskv = 0u;
    for (int pass = 0; pass < 4; ++pass) {
        const int shift = 24 - 8 * pass;
        if (tid < 256) hist[tid] = 0u;
        __syncthreads();
        const unsigned prefix = misc[0];
        for (int i = tid; i < n; i += NTHREADS) { const unsigned kv = keys[i]; if ((kv & maskv) == prefix) atomicAdd((unsigned*)&hist[(kv >> shift) & 255u], 1u); }
        __syncthreads();
        if (w == 0) {
            const unsigned rem = misc[1];
            const unsigned h0 = hist[4 * lane], h1 = hist[4 * lane + 1], h2 = hist[4 * lane + 2], h3 = hist[4 * lane + 3], s4 = h0 + h1 + h2 + h3;
            unsigned S = s4;
#pragma unroll
            for (int o = 1; o < 64; o <<= 1) { const unsigned y = __shfl_down(S, o); if (lane + o < 64) S += y; }
            const unsigned above = S - s4;
            if (above < rem && rem <= S) { unsigned cum = above; int bin;
                if (cum + h3 >= rem) bin = 3; else { cum += h3; if (cum + h2 >= rem) bin = 2; else { cum += h2; if (cum + h1 >= rem) bin = 1; else { cum += h1; bin = 0; } } }
                misc[0] = prefix | ((unsigned)(4 * lane + bin) << shift); misc[1] = rem - cum; }
        }
        __syncthreads();
        maskv |= 255u << shift;
    }
    const unsigned T = misc[0], need_eq = misc[1];
    __syncthreads();
    const int per = n >= NTHREADS ? n / NTHREADS : 1; const int t0 = tid * per; const bool act = t0 < n;
    unsigned ce = 0u;
    if (act) for (int i = 0; i < per; ++i) ce += (keys[t0 + i] == T) ? 1u : 0u;
    unsigned inc = ce;
#pragma unroll
    for (int o = 1; o < 64; o <<= 1) { const unsigned y = __shfl_up(inc, o); if (lane >= o) inc += y; }
    if (lane == 63) misc[16 + w] = inc;
    __syncthreads();
    unsigned base = 0u;
    for (int ww = 0; ww < w; ++ww) base += misc[16 + ww];
    unsigned eqrank = base + inc - ce;
    __syncthreads();
    unsigned cs = 0u;
    if (act) { unsigned er = eqrank; for (int i = 0; i < per; ++i) { const unsigned kv = keys[t0 + i]; if (kv > T) cs++; else if (kv == T) { if (er < need_eq) cs++; er++; } } }
    inc = cs;
#pragma unroll
    for (int o = 1; o < 64; o <<= 1) { const unsigned y = __shfl_up(inc, o); if (lane >= o) inc += y; }
    if (lane == 63) misc[16 + w] = inc;
    __syncthreads();
    base = 0u;
    for (int ww = 0; ww < w; ++ww) base += misc[16 + ww];
    unsigned pos = base + inc - cs;
    if (act) { unsigned er = eqrank; for (int i = 0; i < per; ++i) { const unsigned kv = keys[t0 + i]; bool sel = false;
            if (kv > T) sel = true; else if (kv == T) { sel = er < need_eq; er++; }
            const int row = row0 + t0 + i;
            if (sel) { const int slot = slot0 + (int)pos; TOK[slot] = row; GATE[slot] = __builtin_bit_cast(float, kv); INV[(size_t)e * NROWS + row] = slot; pos++; }
            else INV[(size_t)e * NROWS + row] = -1; } }
    __syncthreads();
}
__device__ __forceinline__ void phase_topk(const Params& p, bool with_ctx, LAS unsigned char* lds, int bid, int nb) {
    const float* AFF = (const float*)(p.ws + WS_AFF); int* TOK = (int*)(p.ws + WS_TOK); float* GATE = (float*)(p.ws + WS_GATE); int* INV = (int*)(p.ws + WS_INV);
    const int nitems = with_ctx ? 128 : 64;
    for (int it = bid; it < nitems; it += nb) {
        if (it < 64) { const int b = it >> 4, e = it & 15; topk_item(AFF + (size_t)e * NROWS + (size_t)b * SEQ, SEQ, CAP, b * SEQ, e, (b * NE + e) * CAP, TOK, GATE, INV, lds); }
        else { const int b = (it - 64) >> 4, e = it & 15; topk_item(AFF + (size_t)e * NROWS + NLAT + (size_t)b * CTXL, CTXL, CCAP, NLAT + b * CTXL, e, NSLOT_LAT + (e * NB + b) * CCAP, TOK, GATE, INV, lds); }
    }
}

__device__ __forceinline__ void phase_combine(const Params& p, int l, bool with_ctx, LAS unsigned char* lds, int bid, int nb) {
    bid = opaque_s(bid); const int tid = opaque_tid(); const int lane = tid & 63, gw = bid * NWAVES + (tid >> 6), NGW = nb * NWAVES;
    LAS float* l1g = (LAS float*)lds; LAS float* l1b = l1g + DM; LAS float* l2g = l1b + DM; LAS float* l2b = l2g + DM; LAS float* lg2 = l2b + DM; LAS float* lsh = lg2 + 5 * DM; LAS float* lsc = lsh + 5 * DM;
    lds_fill(l1g, p.ln1_g + l * DM, DM, tid); lds_fill(l1b, p.ln1_b + l * DM, DM, tid); lds_fill(l2g, p.ln2_g + l * DM, DM, tid); lds_fill(l2b, p.ln2_b + l * DM, DM, tid);
    for (int r = 0; r < 5; ++r) { lds_fill(lg2 + r * DM, mod_ptr(p, l, r) + 5 * DM, DM, tid); if (l + 1 < DEPTH) { lds_fill(lsh + r * DM, mod_ptr(p, l + 1, r), DM, tid); lds_fill(lsc + r * DM, mod_ptr(p, l + 1, r) + DM, DM, tid); } }
    __syncthreads();
    bf16_t* XB = (bf16_t*)(p.ws + WS_XB); bf16_t* HB = (bf16_t*)(p.ws + WS_HB);
    const bf16_t* Y = (const bf16_t*)(p.ws + WS_Y); const int* INV = (const int*)(p.ws + WS_INV);
    const float* g = p.ln2_g + l * DM; const float* bb = p.ln2_b + l * DM;
    const int nrows = with_ctx ? NROWS : NLAT;
    f32x4 v[4], vn[4]; int myinv = -1, myinvn = -1;
    if (gw < nrows) { row_load_bf16(XB + (size_t)gw * DM, lane, v); myinv = INV[(size_t)(lane & 15) * NROWS + gw]; }
#pragma unroll 1
    for (int row = gw; row < nrows; row += NGW) {
        bf16_t* xr = XB + (size_t)row * DM;
        const int rn = row + NGW;
        if (rn < nrows) { row_load_bf16(XB + (size_t)rn * DM, lane, vn); myinvn = INV[(size_t)(lane & 15) * NROWS + rn]; }
        f32x4 a[4];
#pragma unroll
        for (int j = 0; j < 4; ++j) a[j] = (f32x4){0.f, 0.f, 0.f, 0.f};
#pragma unroll
        for (int e = 0; e < 16; ++e) {
            const int slot = __builtin_amdgcn_readlane(myinv, e);
            if (slot >= 0) { const bf16_t* yr = Y + (size_t)slot * DM;
#pragma unroll
                for (int j = 0; j < 4; ++j) { const u32x2 wv = *(const u32x2*)(yr + 256 * j + 4 * lane); a[j][0] += bf_lo(wv.x); a[j][1] += bf_hi(wv.x); a[j][2] += bf_lo(wv.y); a[j][3] += bf_hi(wv.y); } }
        }
        row_normalize(v); row_affine_l(v, l1g, l1b, lane);
        const int mr = row_modrow(row);
#pragma unroll
        for (int j = 0; j < 4; ++j) { const f32x4 g2 = *(const LAS f32x4*)(lg2 + mr * DM + 256 * j + 4 * lane); v[j] = v[j] * ALPHA + g2 * a[j]; }
        row_normalize(v); row_affine_l(v, l2g, l2b, lane);
        if (l + 1 < DEPTH) row_store_bf16(xr, lane, v); else row_store(p.out + (size_t)row * DM, lane, v);
        if (l + 1 < DEPTH) { row_normalize(v); row_modulate_l(v, lsh + mr * DM, lsc + mr * DM, lane); row_store_bf16(HB + (size_t)row * DM, lane, v); }
#pragma unroll
        for (int j = 0; j < 4; ++j) v[j] = vn[j];
        myinv = myinvn;
    }
}

constexpr int N_PHASES = 2 + 8 * DEPTH;
#define IN(k) (lo <= (k) && (k) < hi)
#ifndef TS_SEL
#define TS_SEL -1
#endif
#define TS_MULT 8
#define SEAM(k) do { if (IN(k) && IN((k) + 1)) xcd_barrier(bar); if (TS_SEL >= 0 && blockIdx.x == 0 && threadIdx.x == 0) ((unsigned long long*)(p.ws + WS_CTL + 65536))[(k) + 1] = __builtin_amdgcn_s_memrealtime(); } while (0)
#ifndef PHMASK
#define PHMASK 0x3ff
#endif
#define PHON(i) ((PHMASK >> (i)) & 1)
#ifndef DUP_MASK
#define DUP_MASK 0
#endif
#define DUP(i) ((DUP_MASK >> (i)) & 1)
template <int l>
__device__ __forceinline__ void run_layer(const Params& p, LAS unsigned char* lds, LAS int* idxl, const XcdBarrier& bar, int bid, int nb, int lo, int hi) {
    bf16_t* HB = (bf16_t*)(p.ws + WS_HB); bf16_t* PB = (bf16_t*)(p.ws + WS_PB); bf16_t* OB = (bf16_t*)(p.ws + WS_OB);
    bf16_t* HH = (bf16_t*)(p.ws + WS_HH); bf16_t* Y = (bf16_t*)(p.ws + WS_Y);
    const int* TOK = (const int*)(p.ws + WS_TOK); const float* GATE = (const float*)(p.ws + WS_GATE);
        const int pb = 2 + 8 * l; const bool wc = (l == 0);
        if (IN(pb + 0)) { if (PHON(2)) {
            const bf16_t* W = (const bf16_t*)(p.ws + WS_WIN) + (size_t)l * INW * DM; EpiQKV E{PB, (const float*)(p.ws + WS_ROPE), (bf16_t*)p.out};
            { SgDesc g{HB + (size_t)NLAT * DM, DM, nullptr, W, 0, 1 << 30, 1, NCTX, INW, DM, NLAT}; sg_gemm(g, E, lds, bid, nb); }
            { mg::Gemm g{HB, W, NLAT, INW, DM, nullptr, 0, 1 << 20, 1}; mg::StaticOrder S; S.init(NLAT, INW, nb, bid); mg::EpiAdapt<EpiQKV> EA{E, 0}; mg::gemm_phase(lds, idxl, g, S, EA); if (DUP(2)) mg::gemm_phase(lds, idxl, g, S, EA); } } }
        SEAM(pb + 0);
        if (IN(pb + 1)) { if (PHON(3)) {
#if FAST_ATTN
            fa::phase_attn(p, l, wc, lds, bid, nb); if (DUP(3)) fa::phase_attn(p, l, wc, lds, bid, nb);
#endif
            phase_mixers(p, l, wc, bid, nb); if (DUP(11)) phase_mixers(p, l, wc, bid, nb); } }
        SEAM(pb + 1);
        if (IN(pb + 2)) { if (PHON(4)) {
            const bf16_t* W = (const bf16_t*)(p.ws + WS_WOUT) + (size_t)l * DM * DM;
            EpiOut<l == 0> E{p.x, p.ctx, (bf16_t*)(p.ws + WS_XB), mod_ptr(p, l, 0)};
            if (wc) { SgDesc g{OB + (size_t)NLAT * DM, DM, nullptr, W, 0, 1 << 30, 1, NCTX, DM, DM, NLAT}; sg_gemm(g, E, lds, bid, nb); }
            { mg::Gemm g{OB, W, NLAT, DM, DM, nullptr, 0, 1 << 20, 1}; mg::StaticOrder S; S.init(NLAT, DM, nb, bid); mg::EpiAdapt<EpiOut<l == 0>> EA{E, 0}; mg::gemm_phase(lds, idxl, g, S, EA); if (DUP(4) && l == 0) mg::gemm_phase(lds, idxl, g, S, EA); } } }
        SEAM(pb + 2);
        if (IN(pb + 3)) { if (PHON(5)) phase_ln_router(p, l, wc, lds, bid, nb); }
        SEAM(pb + 3);
        if (IN(pb + 4)) { if (PHON(6)) { phase_topk(p, wc, lds, bid, nb); if (DUP(6)) phase_topk(p, wc, lds, bid, nb);
            { const int busy = wc ? 128 : 64;
              if (bid >= busy && nb > busy) phase_weights(p, lds, bid - busy, nb - busy, l == 0 ? TR_P0 : TR_SPLIT, l == 0 ? TR_SPLIT : 2 * TR_PER_L); } } }
        SEAM(pb + 4);
        if (IN(pb + 5)) { if (PHON(7)) {
            const bf16_t* W = (const bf16_t*)(p.ws + WS_WGU) + (size_t)l * NE * 1024 * DM; EpiGU E{HH};
            if (wc) { SgDesc g{HB, DM, TOK + NSLOT_LAT, W, (size_t)1024 * DM, NB * CCAP, NE, NSLOT_CTX, 1024, DM, NSLOT_LAT}; sg_gemm(g, E, lds, bid, nb); }
            { mg::Gemm g{HB, W, NSLOT_LAT, 1024, DM, TOK, (size_t)1024 * DM, CAP / 256, NE}; mg::StaticOrder S; S.init(NSLOT_LAT, 1024, nb, bid); mg::EpiAdapt<EpiGU> EA{E, 0}; mg::gemm_phase(lds, idxl, g, S, EA); if (DUP(7)) mg::gemm_phase(lds, idxl, g, S, EA); } } }
        SEAM(pb + 5);
        if (IN(pb + 6)) { if (PHON(8)) {
            const bf16_t* W = (const bf16_t*)(p.ws + WS_WD) + (size_t)l * NE * DM * FF; EpiDown E{Y, GATE};
            if (wc) { SgDesc g{HH + (size_t)NSLOT_LAT * FF, FF, nullptr, W, (size_t)DM * FF, NB * CCAP, NE, NSLOT_CTX, DM, FF, NSLOT_LAT}; sg_gemm(g, E, lds, bid, nb); }
            { mg::Gemm g{HH, W, NSLOT_LAT, DM, FF, nullptr, (size_t)DM * FF, CAP / 256, NE}; mg::StaticOrder S; S.init(NSLOT_LAT, DM, nb, bid); mg::EpiAdapt<EpiDown> EA{E, 0}; mg::gemm_phase(lds, idxl, g, S, EA); if (DUP(8)) mg::gemm_phase(lds, idxl, g, S, EA); } } }
        SEAM(pb + 6);
        if (IN(pb + 7)) { if (PHON(9)) phase_combine(p, l, wc, lds, bid, nb); }
        SEAM(pb + 7);
}
__global__ void __launch_bounds__(NTHREADS, 2) fwd_kernel(Params p) {
    extern __shared__ __attribute__((aligned(16))) unsigned char lds_raw[];
    LAS unsigned char* lds = (LAS unsigned char*)lds_raw;
    const int bid = blockIdx.x, nb = gridDim.x;
    volatile LAS unsigned* MISC = (volatile LAS unsigned*)(lds + LDS_BYTES - 64);
    LAS int* idxl = (LAS int*)(lds + mg::STAGE_BYTES);
    if (threadIdx.x < 16) MISC[threadIdx.x] = 0u;
    __syncthreads();
    XcdBarrier bar; bar.bar = (unsigned*)(p.ws + WS_CTL) + CW_BAR; bar.x = 0; bar.st = nullptr;
    const bool multi = p.ph_hi - p.ph_lo > 1;
    if (multi) bar = xcd_barrier_post((unsigned*)(p.ws + WS_CTL) + CW_BAR, MISC + 8);
    bf16_t* HB = (bf16_t*)(p.ws + WS_HB); bf16_t* PB = (bf16_t*)(p.ws + WS_PB); bf16_t* OB = (bf16_t*)(p.ws + WS_OB);
    bf16_t* HH = (bf16_t*)(p.ws + WS_HH); bf16_t* Y = (bf16_t*)(p.ws + WS_Y);
    const int* TOK = (const int*)(p.ws + WS_TOK); const float* GATE = (const float*)(p.ws + WS_GATE);
    const int lo = p.ph_lo, hi = p.ph_hi;
    if (TS_SEL >= 0 && blockIdx.x == 0 && threadIdx.x == 0) ((unsigned long long*)(p.ws + WS_CTL + 65536))[0] = __builtin_amdgcn_s_memrealtime();
    if (IN(0)) { if (PHON(0)) { phase_prologue(p, lds, bid, nb); __syncthreads(); phase_weights(p, lds, bid, nb, 0, TR_P0); } } SEAM(0);
    if (IN(1)) { if (PHON(1)) phase_ln1(p, bid, nb); if (DUP(1)) phase_ln1(p, bid, nb); } SEAM(1);
    run_layer<0>(p, lds, idxl, bar, bid, nb, lo, hi);
    run_layer<1>(p, lds, idxl, bar, bid, nb, lo, hi);
    if (TS_SEL >= 0 && blockIdx.x == 0 && threadIdx.x == 0) {
        volatile unsigned long long* ts = (volatile unsigned long long*)(p.ws + WS_CTL + 65536); const unsigned long long dt = (ts[TS_SEL + 1] - ts[TS_SEL]) * TS_MULT, t0 = __builtin_amdgcn_s_memrealtime();
        while (__builtin_amdgcn_s_memrealtime() - t0 < dt) __builtin_amdgcn_s_sleep(8); }
#undef IN
#undef SEAM
}

#ifndef N_LAUNCH_SPLIT
#define N_LAUNCH_SPLIT 0
#endif
extern "C" void kernel_launch(void* const* d_in, const int* in_sizes, int n_in, void* d_out, int out_size, void* d_ws, size_t ws_size, hipStream_t stream) {
    static int grid = 0;
    if (grid == 0) {
        if (n_in != 19 || in_sizes[0] != NLAT * DM || out_size != NLAT * DM || ws_size < WS_END) { fprintf(stderr, "kernel_launch: unexpected shapes (n_in %d, in0 %d, out %d, ws %zu)\n", n_in, n_in > 0 ? in_sizes[0] : -1, out_size, ws_size); grid = -1; return; }
        int dev = 0, cus = 0, per_cu = 0;
        if (hipGetDevice(&dev) != hipSuccess || hipDeviceGetAttribute(&cus, hipDeviceAttributeMultiprocessorCount, dev) != hipSuccess) { grid = -1; return; }
        if (hipFuncSetAttribute((const void*)fwd_kernel, hipFuncAttributeMaxDynamicSharedMemorySize, LDS_BYTES) != hipSuccess) { fprintf(stderr, "kernel_launch: hipFuncSetAttribute failed\n"); grid = -1; return; }
        if (hipOccupancyMaxActiveBlocksPerMultiprocessor(&per_cu, (const void*)fwd_kernel, NTHREADS, LDS_BYTES) != hipSuccess || per_cu < 1) { fprintf(stderr, "kernel_launch: occupancy query says %d\n", per_cu); per_cu = 1; }
        (void)hipGetLastError();
        grid = cus;
    }
    if (grid < 0) return;
    (void)hipMemsetAsync((char*)d_ws + WS_CTL, 0, CTL_ZERO_BYTES, stream);
    Params p{};
    const float** pp = (const float**)&p;
    for (int i = 0; i < 19; ++i) pp[i] = (const float*)d_in[i];
    p.out = (float*)d_out; p.ws = (unsigned char*)d_ws;
#if N_LAUNCH_SPLIT
    for (int ph = 0; ph < N_PHASES; ++ph) { p.ph_lo = ph; p.ph_hi = ph + 1; hipLaunchKernelGGL(fwd_kernel, dim3(grid), dim3(NTHREADS), LDS_BYTES, stream, p); }
#else
    p.ph_lo = 0; p.ph_hi = N_PHASES;
    void* args[] = {&p};
    hipError_t e = hipLaunchCooperativeKernel((const void*)fwd_kernel, dim3(grid), dim3(NTHREADS), args, LDS_BYTES, stream);
    if (e != hipSuccess) fprintf(stderr, "kernel_launch: cooperative launch failed: %s\n", hipGetErrorString(e));
#endif
}
```

```cpp
#include <hip/hip_runtime.h>
#include <hip/hip_cooperative_groups.h>
#include <cstdio>
#include <cstdint>
#include <cmath>

#define LAS __attribute__((address_space(3)))
typedef unsigned short bf16_t;
typedef short bf16x8 __attribute__((ext_vector_type(8)));
typedef float f32x4 __attribute__((ext_vector_type(4)));
typedef unsigned u32x4 __attribute__((ext_vector_type(4)));
typedef unsigned u32x2 __attribute__((ext_vector_type(2)));

constexpr int NB = 4, SEQ = 8192, DM = 1024, CTXL = 256, DEPTH = 2;
constexpr int NLAT = NB * SEQ, NCTX = NB * CTXL, NROWS = NLAT + NCTX;
constexpr int INW = 2560, NE = 16, FF = 512, CAP = 1024, CCAP = 32;
constexpr int NSLOT_LAT = NB * NE * CAP, NSLOT_CTX = NB * NE * CCAP, NSLOT = NSLOT_LAT + NSLOT_CTX;
constexpr int NMOD = 6 * DM;
constexpr float LN_EPS = 1e-6f;
constexpr float ALPHA = 1.41421356237309515f;
constexpr int C_QA = 0, C_KA = 384, C_VA = 512, C_BX = 640, C_BB = 896, C_BC = 1152, C_QN = 1408, C_KN = 1792, C_VN = 2176;

#ifndef FAST_ATTN
#define FAST_ATTN 1
#endif
constexpr int KV_TOK = SEQ + CTXL;
constexpr int NTHREADS = 512, NWAVES = 8;
constexpr int LDS_BYTES = 147456;

constexpr size_t MiB = 1u << 20;
constexpr size_t WS_CTL = 0, CTL_ZERO_BYTES = 128 * 1024;
constexpr size_t WS_ROPE = 1 * MiB;
constexpr size_t WS_MOD = 1 * MiB + 65536;
constexpr size_t WS_AFF = 2 * MiB;
constexpr size_t WS_INV = 5 * MiB;
constexpr size_t WS_TOK = 8 * MiB;
constexpr size_t WS_GATE = 8 * MiB + 512 * 1024;
constexpr size_t WS_CXR = 9 * MiB;
constexpr size_t WS_WIN = 16 * MiB;
constexpr size_t WS_WOUT = 26 * MiB;
constexpr size_t WS_WGU = 30 * MiB;
constexpr size_t WS_WD = 94 * MiB;
constexpr size_t WS_HB = 126 * MiB;
constexpr size_t WS_OB = 192 * MiB;
constexpr size_t WS_HH = 192 * MiB;
constexpr size_t WS_PB = 258 * MiB;
constexpr size_t WS_Y = 258 * MiB;
constexpr size_t WS_XB = 424 * MiB;
constexpr size_t WS_END = 490 * MiB;
static_assert(WS_HB + (size_t)NROWS * DM * 2 <= WS_OB && WS_OB + (size_t)NROWS * DM * 2 <= WS_PB && WS_PB + (size_t)NROWS * INW * 2 <= WS_XB && WS_XB + (size_t)NROWS * DM * 2 <= WS_END, "ws map");
static_assert((size_t)NSLOT * FF * 2 <= (size_t)NROWS * DM * 2 && (size_t)NSLOT * DM * 2 <= (size_t)NROWS * INW * 2, "overlays");
constexpr int CW_BAR = 4096;

struct Params {
    const float *x, *c, *ctx, *c_ctx, *w_mod, *b_mod, *w_in, *conv_w, *attn_sink, *na_rpb, *w_out, *ln1_g, *ln1_b, *w_router, *w_gate, *w_up, *w_down, *ln2_g, *ln2_b;
    float* out; unsigned char* ws;
    int ph_lo, ph_hi;
};

__device__ __forceinline__ unsigned f2bf(float f) { unsigned u = __builtin_bit_cast(unsigned, f); return (u + 0x7fffu + ((u >> 16) & 1u)) >> 16; }
typedef float f32x2_cv __attribute__((ext_vector_type(2))); typedef __bf16 bf16x2_cv __attribute__((ext_vector_type(2)));
__device__ __forceinline__ unsigned pk2(float lo, float hi) { f32x2_cv v = {lo, hi}; bf16x2_cv b = __builtin_convertvector(v, bf16x2_cv); return __builtin_bit_cast(unsigned, b); }
__device__ __forceinline__ float bf_lo(unsigned w) { return __builtin_bit_cast(float, w << 16); }
__device__ __forceinline__ float bf_hi(unsigned w) { return __builtin_bit_cast(float, w & 0xffff0000u); }
template <int CTRL> __device__ __forceinline__ float dppf(float v) { return __builtin_bit_cast(float, __builtin_amdgcn_update_dpp(0, __builtin_bit_cast(int, v), CTRL, 0xf, 0xf, true)); }
__device__ __forceinline__ void swap16(float v, float& a, float& b) { a = v; b = v; asm volatile("s_nop 1\n\tv_permlane16_swap_b32 %0, %1" : "+v"(a), "+v"(b)); }
__device__ __forceinline__ void swap32(float v, float& a, float& b) { a = v; b = v; asm volatile("s_nop 1\n\tv_permlane32_swap_b32 %0, %1" : "+v"(a), "+v"(b)); }
__device__ __forceinline__ float xor16_sum(float v) { float a, b; swap16(v, a, b); return a + b; }
__device__ __forceinline__ float xor32_sum(float v) { float a, b; swap32(v, a, b); return a + b; }
__device__ __forceinline__ float xor16_max(float v) { float a, b; swap16(v, a, b); return fmaxf(a, b); }
__device__ __forceinline__ float xor32_max(float v) { float a, b; swap32(v, a, b); return fmaxf(a, b); }
__device__ __forceinline__ float wave_sum(float v) {
    v += dppf<0xB1>(v); v += dppf<0x4E>(v); v += dppf<0x141>(v); v += dppf<0x140>(v);
    return xor32_sum(xor16_sum(v));
}
#define LDS_WAIT() asm volatile("s_waitcnt lgkmcnt(0)" ::: "memory")
__device__ __forceinline__ int opaque_tid() { int t = threadIdx.x; asm volatile("" : "+v"(t)); return t; }
__device__ __forceinline__ int opaque_s(int v) { asm volatile("" : "+s"(v)); return v; }

__device__ __forceinline__ float* mod_ptr(const Params& p, int l, int r) { return (float*)(p.ws + WS_MOD) + ((size_t)l * 5 + r) * NMOD; }

#define XB_TMO      128
#define XB_XCNT(j)  (256  + 64 * (j))
#define XB_XSUB(j)  (1280 + 64 * (j))
#define XB_XGEN(j)  (2304 + 64 * (j))
#define XB_TOP      3328
#define XB_TOPGEN   3392
#define XCD_BAR_WORDS 3456
#define XB_SPIN_CAP (1u << 20)
__device__ __forceinline__ unsigned xb_ld(unsigned* p)              { return __hip_atomic_load(p, __ATOMIC_RELAXED, __HIP_MEMORY_SCOPE_AGENT); }
__device__ __forceinline__ unsigned xb_add(unsigned* p, unsigned v) { return __hip_atomic_fetch_add(p, v, __ATOMIC_RELAXED, __HIP_MEMORY_SCOPE_AGENT); }
__device__ __forceinline__ unsigned xb_xcc_id() { return (unsigned)__builtin_amdgcn_s_getreg((3 << 11) | 20) & 0xFu; }
#define XB_SPIN(cond, bar) do { unsigned _sp = 0; while (cond) { __builtin_amdgcn_s_sleep(1); \
    if ((++_sp & 255u) == 0u) { if (xb_ld(&(bar)[XB_TMO])) break; if (_sp > XB_SPIN_CAP) { atomicAdd(&(bar)[XB_TMO], 1u); break; } } } } while (0)
struct XcdBarrier { unsigned* bar; unsigned x; volatile LAS unsigned* st; };
__device__ __forceinline__ XcdBarrier xcd_barrier_post(unsigned* bar, volatile LAS unsigned* st) {
    XcdBarrier b; b.bar = bar; b.x = xb_xcc_id(); b.st = st;
    if (threadIdx.x == 0) (void)xb_add(&bar[XB_XCNT(b.x)], 1u);
    return b;
}
__device__ __forceinline__ void xcd_barrier_complete(unsigned* bar, unsigned x, unsigned& nloc, unsigned& nx) {
    const unsigned G = gridDim.x * gridDim.y * gridDim.z;
    unsigned sum, cnt, mine, sp = 0u;
    for (;;) {
        sum = 0u; cnt = 0u; mine = 0u;
#pragma unroll 1
        for (unsigned j = 0; j < 16; ++j) { const unsigned c = xb_ld(&bar[XB_XCNT(j)]); sum += c; cnt += (c > 0u) ? 1u : 0u; mine = (j == x) ? c : mine; }
        if (sum == G) break;
        __builtin_amdgcn_s_sleep(1);
        if ((++sp & 255u) == 0u) { if (xb_ld(&bar[XB_TMO])) break; if (sp > XB_SPIN_CAP) { atomicAdd(&bar[XB_TMO], 1u); break; } }
    }
    nloc = mine > 0u ? mine : 1u; nx = cnt > 0u ? cnt : 1u;
}
__device__ __forceinline__ void xcd_barrier(const XcdBarrier& b) {
    asm volatile("s_waitcnt vmcnt(0)" ::: "memory");
    __syncthreads();
    if (threadIdx.x == 0) {
        unsigned* bar = b.bar; asm volatile("" : "+s"(bar));
        __builtin_amdgcn_s_waitcnt(0);
        unsigned nloc = b.st[0], nx = b.st[1];
        if (nloc == 0u) { xcd_barrier_complete(bar, b.x, nloc, nx); b.st[0] = nloc; b.st[1] = nx; }
        const unsigned old = xb_add(&bar[XB_XSUB(b.x)], 1u);
        const unsigned gen = old / nloc;
        if (old + 1u == (gen + 1u) * nloc) {
            __builtin_amdgcn_fence(__ATOMIC_RELEASE, "agent");
            asm volatile("s_waitcnt vmcnt(0)" ::: "memory");
            const unsigned og = xb_add(&bar[XB_TOP], 1u);
            const unsigned tg = og / nx;
            if (og + 1u == (tg + 1u) * nx) xb_add(&bar[XB_TOPGEN], 1u);
            else XB_SPIN(xb_ld(&bar[XB_TOPGEN]) == tg, bar);
            __builtin_amdgcn_fence(__ATOMIC_ACQUIRE, "agent");
            xb_add(&bar[XB_XGEN(b.x)], 1u);
            asm volatile("s_waitcnt vmcnt(0)" ::: "memory");
        } else {
            XB_SPIN(xb_ld(&bar[XB_XGEN(b.x)]) == gen, bar);
            __builtin_amdgcn_fence(__ATOMIC_ACQUIRE, "agent");
            asm volatile("s_waitcnt vmcnt(0)" ::: "memory");
        }
    }
    __syncthreads();
}

struct TrItem { const float* W; bf16_t* WT; int K, N, mode, item; };
__device__ __forceinline__ void tr_load(const TrItem& t, int lane, float (&r)[32]) {
    const int nblk = t.N / 32, kb = t.item / nblk, nb = t.item % nblk, k0 = 64 * kb, n0 = 32 * nb;
    const float* src = t.W + (size_t)(k0 + (lane >> 5)) * t.N + n0 + (lane & 31);
#pragma unroll
    for (int i = 0; i < 32; ++i) r[i] = src[(size_t)(2 * i) * t.N];
}
__device__ __forceinline__ void tr_finish(const TrItem& t, int lane, const float (&r)[32], LAS float* scr) {
    const int nblk = t.N / 32, kb = t.item / nblk, nb = t.item % nblk, k0 = 64 * kb, n0 = 32 * nb;
#pragma unroll
    for (int i = 0; i < 32; ++i) scr[(2 * i + (lane >> 5)) * 33 + (lane & 31)] = r[i];
    LDS_WAIT();
    const int c = lane & 7;
#pragma unroll
    for (int j = 0; j < 4; ++j) {
        const int n = (lane >> 3) + 8 * j; const LAS float* s = scr + (8 * c) * 33 + n;
        u32x4 o; o.x = pk2(s[0 * 33], s[1 * 33]); o.y = pk2(s[2 * 33], s[3 * 33]); o.z = pk2(s[4 * 33], s[5 * 33]); o.w = pk2(s[6 * 33], s[7 * 33]);
        const int f = n0 + n;
        const int orow = t.mode == 0 ? ((f & ~255) + 128 * ((f >> 4) & 1) + 32 * ((f >> 6) & 3) + 16 * ((f >> 2) & 1) + 4 * (2 * ((f >> 5) & 1) + ((f >> 3) & 1)) + (f & 3))
                                     : (256 * (f >> 7) + (t.mode == 2 ? 128 : 0) + 32 * ((f >> 5) & 3) + 16 * ((f >> 2) & 1) + 4 * ((f >> 3) & 3) + (f & 3));
        *(u32x4*)(t.WT + (size_t)orow * t.K + k0 + 8 * c) = o;
    }
    LDS_WAIT();
}
__device__ __forceinline__ void phase_prologue(const Params& p, LAS unsigned char* lds, int bid, int nb) {
    bid = opaque_s(bid); const int tid = opaque_tid(), lane = tid & 63, w = tid >> 6;
    {
        LAS float* ssil = (LAS float*)lds;
        LAS float* red = ssil + 5 * 1024;
        for (int i = tid; i < 5 * 1024; i += NTHREADS) { const int r = i >> 10, k = i & 1023; const float v = r < 4 ? p.c[r * 1024 + k] : p.c_ctx[k]; ssil[i] = v / (1.f + expf(-v)); }
        __syncthreads();
        for (int item = bid; item < 2 * 96; item += nb) {
            const int l = item / 96, n0 = (item % 96) * 64;
            const float* W = p.w_mod + (size_t)l * DM * NMOD + n0 + lane;
            float a0 = 0.f, a1 = 0.f, a2 = 0.f, a3 = 0.f, a4 = 0.f;
#pragma unroll 8
            for (int k = w * 128; k < w * 128 + 128; ++k) {
                const float wv = W[(size_t)k * NMOD];
                a0 += ssil[k] * wv; a1 += ssil[1024 + k] * wv; a2 += ssil[2048 + k] * wv; a3 += ssil[3072 + k] * wv; a4 += ssil[4096 + k] * wv;
            }
            red[(w * 5 + 0) * 64 + lane] = a0; red[(w * 5 + 1) * 64 + lane] = a1; red[(w * 5 + 2) * 64 + lane] = a2; red[(w * 5 + 3) * 64 + lane] = a3; red[(w * 5 + 4) * 64 + lane] = a4;
            __syncthreads();
            if (tid < 320) { const int r = tid >> 6; float s = 0.f;
#pragma unroll
                for (int ww = 0; ww < 8; ++ww) s += red[(ww * 5 + r) * 64 + lane];
                mod_ptr(p, l, r)[n0 + lane] = s + p.b_mod[l * NMOD + n0 + lane]; }
            __syncthreads();
        }
    }
    if (bid == nb - 1) {
        float* rope = (float*)(p.ws + WS_ROPE);
        for (int e = tid; e < 128 * 16; e += NTHREADS) {
            const int pos = e >> 4, i = e & 15;
            const double a = exp(-((double)i / 16.0) * 9.210340371976184);
            const double a2 = a * a; double c = 1.0, s = a, tc = 1.0, ts = a;
            for (int n = 1; n <= 14; ++n) { tc *= -a2 / (double)((2 * n - 1) * (2 * n)); c += tc; ts *= -a2 / (double)((2 * n) * (2 * n + 1)); s += ts; }
            double rc = 1.0, rs = 0.0, bc = c, bs = s; int q = pos;
            while (q) { if (q & 1) { const double t = rc * bc - rs * bs; rs = rc * bs + rs * bc; rc = t; } const double t = bc * bc - bs * bs; bs = 2.0 * bc * bs; bc = t; q >>= 1; }
            rope[2 * e] = (float)rc; rope[2 * e + 1] = (float)rs;
        }
    }
}

constexpr int TR_I_IN = 16 * 80, TR_I_OUT = 16 * 32, TR_I_G = 16 * 16, TR_I_D = 8 * 32, TR_PER_L = TR_I_IN + TR_I_OUT + 16 * (2 * TR_I_G + TR_I_D);
constexpr int TR_P0 = TR_I_IN + TR_I_OUT, TR_SPLIT = TR_PER_L + TR_I_IN + TR_I_OUT;
__device__ __forceinline__ void phase_weights(const Params& p, LAS unsigned char* lds, int bid, int nb, int lo, int hi) {
    bid = opaque_s(bid); const int tid = opaque_tid(), lane = tid & 63, w = tid >> 6;
    {
        LAS float* scr = (LAS float*)lds + w * (64 * 33);
        const int gw = bid * NWAVES + w, NGW = nb * NWAVES;
        constexpr int I_IN = TR_I_IN, I_OUT = TR_I_OUT, I_G = TR_I_G, I_D = TR_I_D, PER_L = TR_PER_L;
        auto decode = [&](int it) -> TrItem {
            const int l = it / PER_L; int r = it % PER_L;
            if (r < I_IN) return TrItem{p.w_in + (size_t)l * DM * INW, (bf16_t*)(p.ws + WS_WIN) + (size_t)l * INW * DM, DM, INW, 0, r}; r -= I_IN;
            if (r < I_OUT) return TrItem{p.w_out + (size_t)l * DM * DM, (bf16_t*)(p.ws + WS_WOUT) + (size_t)l * DM * DM, DM, DM, 0, r}; r -= I_OUT;
            if (r < 16 * I_G) { const int e = r / I_G; return TrItem{p.w_gate + ((size_t)l * NE + e) * DM * FF, (bf16_t*)(p.ws + WS_WGU) + ((size_t)l * NE + e) * 1024 * DM, DM, FF, 1, r % I_G}; } r -= 16 * I_G;
            if (r < 16 * I_G) { const int e = r / I_G; return TrItem{p.w_up + ((size_t)l * NE + e) * DM * FF, (bf16_t*)(p.ws + WS_WGU) + ((size_t)l * NE + e) * 1024 * DM, DM, FF, 2, r % I_G}; } r -= 16 * I_G;
            const int e = r / I_D; return TrItem{p.w_down + ((size_t)l * NE + e) * FF * DM, (bf16_t*)(p.ws + WS_WD) + ((size_t)l * NE + e) * DM * FF, FF, DM, 0, r % I_D};
        };
        float ra[32], rb[32];
        int it = lo + gw;
        if (it < hi) { TrItem cur = decode(it); tr_load(cur, lane, ra);
#pragma unroll 1
            for (;;) {
                const int itn = it + NGW; const bool hn = itn < hi; TrItem nx = cur;
                if (hn) { nx = decode(itn); tr_load(nx, lane, rb); }
                tr_finish(cur, lane, ra, scr);
                if (!hn) break;
                const int itn2 = itn + NGW; const bool hn2 = itn2 < hi; TrItem nx2 = nx;
                if (hn2) { nx2 = decode(itn2); tr_load(nx2, lane, ra); }
                tr_finish(nx, lane, rb, scr);
                if (!hn2) break;
                cur = nx2; it = itn2;
            }
        }
    }
}

__device__ __forceinline__ void row_load(const float* rowp, int lane, f32x4 (&v)[4]) {
#pragma unroll
    for (int j = 0; j < 4; ++j) v[j] = *(const f32x4*)(rowp + 256 * j + 4 * lane);
}
__device__ __forceinline__ void row_load_bf16(const bf16_t* rowp, int lane, f32x4 (&v)[4]) {
#pragma unroll
    for (int j = 0; j < 4; ++j) { const u32x2 w = *(const u32x2*)(rowp + 256 * j + 4 * lane); v[j] = (f32x4){bf_lo(w.x), bf_hi(w.x), bf_lo(w.y), bf_hi(w.y)}; }
}
__device__ __forceinline__ void row_store(float* rowp, int lane, const f32x4 (&v)[4]) {
#pragma unroll
    for (int j = 0; j < 4; ++j) *(f32x4*)(rowp + 256 * j + 4 * lane) = v[j];
}
__device__ __forceinline__ void row_store_bf16(bf16_t* rowp, int lane, const f32x4 (&v)[4]) {
#pragma unroll
    for (int j = 0; j < 4; ++j) { u32x2 o; o.x = pk2(v[j][0], v[j][1]); o.y = pk2(v[j][2], v[j][3]); *(u32x2*)(rowp + 256 * j + 4 * lane) = o; }
}
__device__ __forceinline__ void row_normalize(f32x4 (&v)[4]) {
    float s = 0.f;
#pragma unroll
    for (int j = 0; j < 4; ++j) s += (v[j][0] + v[j][1]) + (v[j][2] + v[j][3]);
    const float mean = wave_sum(s) * (1.f / DM);
    float q = 0.f;
#pragma unroll
    for (int j = 0; j < 4; ++j) { v[j] = v[j] - mean; q += (v[j][0] * v[j][0] + v[j][1] * v[j][1]) + (v[j][2] * v[j][2] + v[j][3] * v[j][3]); }
    const float rstd = 1.f / sqrtf(wave_sum(q) * (1.f / DM) + LN_EPS);
#pragma unroll
    for (int j = 0; j < 4; ++j) v[j] = v[j] * rstd;
}
__device__ __forceinline__ void row_modulate(f32x4 (&v)[4], const float* sh, const float* sc, int lane) {
#pragma unroll
    for (int j = 0; j < 4; ++j) { const f32x4 a = *(const f32x4*)(sc + 256 * j + 4 * lane), b = *(const f32x4*)(sh + 256 * j + 4 * lane); v[j] = v[j] * (a + 1.f) + b; }
}
__device__ __forceinline__ void row_affine(f32x4 (&v)[4], const float* g, const float* bb, int lane) {
#pragma unroll
    for (int j = 0; j < 4; ++j) { const f32x4 a = *(const f32x4*)(g + 256 * j + 4 * lane), b = *(const f32x4*)(bb + 256 * j + 4 * lane); v[j] = v[j] * a + b; }
}
__device__ __forceinline__ void row_modulate_l(f32x4 (&v)[4], const LAS float* sh, const LAS float* sc, int lane) {
#pragma unroll
    for (int j = 0; j < 4; ++j) { const f32x4 a = *(const LAS f32x4*)(sc + 256 * j + 4 * lane), b = *(const LAS f32x4*)(sh + 256 * j + 4 * lane); v[j] = v[j] * (a + 1.f) + b; }
}
__device__ __forceinline__ void row_affine_l(f32x4 (&v)[4], const LAS float* g, const LAS float* bb, int lane) {
#pragma unroll
    for (int j = 0; j < 4; ++j) { const f32x4 a = *(const LAS f32x4*)(g + 256 * j + 4 * lane), b = *(const LAS f32x4*)(bb + 256 * j + 4 * lane); v[j] = v[j] * a + b; }
}
__device__ __forceinline__ int row_modrow(int row) { return row < NLAT ? (row >> 13) : 4; }
__device__ __forceinline__ void lds_fill(LAS float* dst, const float* src, int n, int tid) { for (int i = tid * 4; i < n; i += NTHREADS * 4) *(LAS f32x4*)(dst + i) = *(const f32x4*)(src + i); }

__device__ __forceinline__ void phase_ln1(const Params& p, int bid, int nb) {
    bid = opaque_s(bid); const int tid = opaque_tid(), lane = tid & 63, gw = bid * NWAVES + (tid >> 6), NGW = nb * NWAVES;
    bf16_t* HB = (bf16_t*)(p.ws + WS_HB);
    f32x4 v[4], vn[4];
    if (gw < NROWS) row_load(gw < NLAT ? p.x + (size_t)gw * DM : p.ctx + (size_t)(gw - NLAT) * DM, lane, v);
#pragma unroll 1
    for (int row = gw; row < NROWS; row += NGW) {
        const int rn = row + NGW;
        if (rn < NROWS) row_load(rn < NLAT ? p.x + (size_t)rn * DM : p.ctx + (size_t)(rn - NLAT) * DM, lane, vn);
        row_normalize(v);
        const float* m = mod_ptr(p, 0, row_modrow(row)); row_modulate(v, m, m + DM, lane);
        row_store_bf16(HB + (size_t)row * DM, lane, v);
#pragma unroll
        for (int j = 0; j < 4; ++j) v[j] = vn[j];
    }
}

struct SgDesc { const bf16_t* A; int lda; const int* rowidx; const bf16_t* Bt; size_t grp_stride; int rows_per_grp, ngrp; int M, N, K; int row_base; };
template <class Epi>
__device__ __forceinline__ void sg_gemm(const SgDesc& g, const Epi& E, LAS unsigned char* lds, int bid, int nb) {
    bid = opaque_s(bid); const int tid = opaque_tid(); const int lane = tid & 63, w = __builtin_amdgcn_readfirstlane(tid >> 6), fr = lane & 15, fq = lane >> 4, wm = w >> 1, wn = w & 1;
    const int tilesN = g.N / 128, tiles = (g.M / 128) * tilesN, nk = g.K / 64;
    const int sr = tid >> 3, sp = tid & 7;
    const int soff = sr * 128 + ((sp ^ ((sr >> 1) & 7)) << 4);
    int aoff[2][2], boff[4][2];
#pragma unroll
    for (int ks = 0; ks < 2; ++ks) {
#pragma unroll
        for (int i = 0; i < 2; ++i) { const int r = 32 * wm + 16 * i + fr; aoff[i][ks] = r * 128 + (((fq + 4 * ks) ^ ((r >> 1) & 7)) << 4); }
#pragma unroll
        for (int n = 0; n < 4; ++n) { const int r = 64 * (n >> 1) + 32 * wn + 16 * (n & 1) + fr; boff[n][ks] = 16384 + r * 128 + (((fq + 4 * ks) ^ ((r >> 1) & 7)) << 4); }
    }
#pragma unroll 1
    for (int t = bid; t < tiles; t += nb) {
        const int tm = t / tilesN, tn = t % tilesN, pn = tn >> 1, wp = tn & 1;
        const int row0 = tm * 128;
        const bf16_t* Bt = g.Bt + (size_t)((row0 / g.rows_per_grp) % g.ngrp) * g.grp_stride;
        const bf16_t* as[2]; const bf16_t* bs[2];
#pragma unroll
        for (int h = 0; h < 2; ++h) { const int r = row0 + sr + 64 * h; const int ar = g.rowidx ? g.rowidx[r] : r; as[h] = g.A + (size_t)ar * g.lda + sp * 8;
            bs[h] = Bt + (size_t)(256 * pn + 128 * h + 64 * wp + sr) * g.K + sp * 8; }
        f32x4 acc[2][4];
#pragma unroll
        for (int i = 0; i < 2; ++i)
#pragma unroll
            for (int n = 0; n < 4; ++n) acc[i][n] = (f32x4){0.f, 0.f, 0.f, 0.f};
        u32x4 ra[2], rb[2];
#pragma unroll
        for (int h = 0; h < 2; ++h) { ra[h] = *(const u32x4*)(as[h]); rb[h] = *(const u32x4*)(bs[h]); }
#pragma unroll
        for (int h = 0; h < 2; ++h) { *(LAS u32x4*)(lds + soff + h * 8192) = ra[h]; *(LAS u32x4*)(lds + 16384 + soff + h * 8192) = rb[h]; }
        __syncthreads();
#pragma unroll 1
        for (int k = 0; k < nk; ++k) {
            const LAS unsigned char* buf = lds + (k & 1) * 32768;
            if (k + 1 < nk) {
#pragma unroll
                for (int h = 0; h < 2; ++h) { ra[h] = *(const u32x4*)(as[h] + (k + 1) * 64); rb[h] = *(const u32x4*)(bs[h] + (k + 1) * 64); } }
#pragma unroll
            for (int ks = 0; ks < 2; ++ks) {
                bf16x8 a[2], b[4];
#pragma unroll
                for (int i = 0; i < 2; ++i) a[i] = *(const LAS bf16x8*)(buf + aoff[i][ks]);
#pragma unroll
                for (int n = 0; n < 4; ++n) b[n] = *(const LAS bf16x8*)(buf + boff[n][ks]);
#pragma unroll
                for (int i = 0; i < 2; ++i)
#pragma unroll
                    for (int n = 0; n < 4; ++n) acc[i][n] = __builtin_amdgcn_mfma_f32_16x16x32_bf16(b[n], a[i], acc[i][n], 0, 0, 0);
            }
            if (k + 1 < nk) { LAS unsigned char* nbuf = lds + ((k + 1) & 1) * 32768;
#pragma unroll
                for (int h = 0; h < 2; ++h) { *(LAS u32x4*)(nbuf + soff + h * 8192) = ra[h]; *(LAS u32x4*)(nbuf + 16384 + soff + h * 8192) = rb[h]; } }
            __syncthreads();
        }
#pragma unroll
        for (int i = 0; i < 2; ++i) {
            const int row = g.row_base + row0 + 32 * wm + 16 * i + fr; const float rv = E.rowval(row);
            E(row, pn, 2 * wp + wn, fq, acc[i][0], acc[i][1], acc[i][2], acc[i][3], rv);
        }
    }
}

__device__ __forceinline__ void store_bf16x8(bf16_t* p, const f32x4 a, const f32x4 b) { u32x4 o; o.x = pk2(a[0], a[1]); o.y = pk2(a[2], a[3]); o.z = pk2(b[0], b[1]); o.w = pk2(b[2], b[3]); *(u32x4*)p = o; }
__device__ __forceinline__ int epi_col(int pn, int wc, int fq) { return 256 * pn + 64 * wc + 32 * (fq >> 1) + 8 * (fq & 1); }

struct EpiQKV {
    bf16_t* PB; const float* rope; bf16_t* KV;
    __device__ __forceinline__ float rowval(int) const { return 0.f; }
    __device__ __forceinline__ void operator()(int row, int pn, int wc, int fq, f32x4 a0, f32x4 a1, f32x4 b0, f32x4 b1, float) const {
        const int c = epi_col(pn, wc, fq);
        if (c < 512 && row < NLAT) {
            const int t = row & (SEQ - 1); const int pos = (fq >> 1) ? (t & 63) : (t >> 6);
            const f32x4* rp = (const f32x4*)(rope + (pos * 16 + 8 * (fq & 1)) * 2);
            const f32x4 r0 = rp[0], r1 = rp[1], r2 = rp[2], r3 = rp[3];
            const f32x4 cs0 = {r0[0], r0[2], r1[0], r1[2]}, sn0 = {r0[1], r0[3], r1[1], r1[3]}, cs1 = {r2[0], r2[2], r3[0], r3[2]}, sn1 = {r2[1], r2[3], r3[1], r3[3]};
            const f32x4 na0 = a0 * cs0 - b0 * sn0, nb0 = b0 * cs0 + a0 * sn0, na1 = a1 * cs1 - b1 * sn1, nb1 = b1 * cs1 + a1 * sn1;
            a0 = na0; b0 = nb0; a1 = na1; b1 = nb1;
        }
        const bool isk = (c >= C_KA && c < C_BX) || c >= C_KN;
        if (isk) {
            const int hd = c < C_BX ? ((c - C_KA) >> 6) & 1 : 2 + ((c - C_KN) >> 6) % 6, isv = c < C_BX ? (c >= C_VA) : (c >= C_VN);
            const int bb = row < NLAT ? row >> 13 : (row - NLAT) >> 8, tok = row < NLAT ? row & (SEQ - 1) : SEQ + ((row - NLAT) & (CTXL - 1));
            bf16_t* o = KV + ((size_t)(bb * 8 + hd) * KV_TOK + tok) * 128 + isv * 64 + (c & 63);
            store_bf16x8(o, a0, a1); store_bf16x8(o + 16, b0, b1);
        } else {
            bf16_t* o = PB + (size_t)row * INW + c;
            store_bf16x8(o, a0, a1); store_bf16x8(o + 16, b0, b1);
        }
    }
};
template <bool FIRST> struct EpiOut {
    const float* xl; const float* xc; bf16_t* XB; const float* mod;
    __device__ __forceinline__ float rowval(int) const { return 0.f; }
    __device__ __forceinline__ void operator()(int row, int pn, int wc, int fq, f32x4 a0, f32x4 a1, f32x4 b0, f32x4 b1, float) const {
        const int c = epi_col(pn, wc, fq); bf16_t* xo = XB + (size_t)row * DM + c;
        const float* g1 = mod + (size_t)row_modrow(row) * NMOD + 2 * DM + c;
        f32x4 xa0, xa1, xb0, xb1;
        if (FIRST) { const float* xin = row < NLAT ? xl + (size_t)row * DM + c : xc + (size_t)(row - NLAT) * DM + c;
            xa0 = *(const f32x4*)xin; xa1 = *(const f32x4*)(xin + 4); xb0 = *(const f32x4*)(xin + 16); xb1 = *(const f32x4*)(xin + 20); }
        else { const u32x4 wa = *(const u32x4*)xo, wb = *(const u32x4*)(xo + 16);
            xa0 = (f32x4){bf_lo(wa.x), bf_hi(wa.x), bf_lo(wa.y), bf_hi(wa.y)}; xa1 = (f32x4){bf_lo(wa.z), bf_hi(wa.z), bf_lo(wa.w), bf_hi(wa.w)};
            xb0 = (f32x4){bf_lo(wb.x), bf_hi(wb.x), bf_lo(wb.y), bf_hi(wb.y)}; xb1 = (f32x4){bf_lo(wb.z), bf_hi(wb.z), bf_lo(wb.w), bf_hi(wb.w)}; }
        const f32x4 ga0 = *(const f32x4*)g1, ga1 = *(const f32x4*)(g1 + 4), gb0 = *(const f32x4*)(g1 + 16), gb1 = *(const f32x4*)(g1 + 20);
        store_bf16x8(xo, xa0 * ALPHA + ga0 * a0, xa1 * ALPHA + ga1 * a1); store_bf16x8(xo + 16, xb0 * ALPHA + gb0 * b0, xb1 * ALPHA + gb1 * b1);
    }
};
struct EpiGU {
    bf16_t* HH;
    __device__ __forceinline__ float rowval(int) const { return 0.f; }
    __device__ __forceinline__ void operator()(int row, int pn, int wc, int fq, f32x4 a0, f32x4 a1, f32x4 b0, f32x4 b1, float) const {
        f32x4 h0, h1;
#pragma unroll
        for (int j = 0; j < 4; ++j) { h0[j] = a0[j] * __builtin_amdgcn_rcpf(1.f + __expf(-a0[j])) * b0[j]; h1[j] = a1[j] * __builtin_amdgcn_rcpf(1.f + __expf(-a1[j])) * b1[j]; }
        store_bf16x8(HH + (size_t)row * FF + 128 * pn + 32 * wc + 8 * fq, h0, h1);
    }
};
struct EpiDown {
    bf16_t* Y; const float* gate;
    __device__ __forceinline__ float rowval(int row) const { return gate[row]; }
    __device__ __forceinline__ void operator()(int row, int pn, int wc, int fq, f32x4 a0, f32x4 a1, f32x4 b0, f32x4 b1, float g) const {
        bf16_t* o = Y + (size_t)row * DM + epi_col(pn, wc, fq);
        store_bf16x8(o, a0 * g, a1 * g); store_bf16x8(o + 16, b0 * g, b1 * g);
    }
};

namespace mg {
constexpr int BM = 256, BK = 64, HALF = 128, HTB = HALF * BK * 2, STAGE_BYTES = 8 * HTB, NXCD = 8, WGM = 8, MAXU = 8;
__device__ __forceinline__ int lds_byte(int r, int c) { const int st = (r >> 4) * 2 + (c >> 5), rr = r & 15, cc = c & 31, ob = rr * 64 + cc * 2; return st * 1024 + (ob ^ (((ob >> 9) & 1) << 5)); }
__device__ __forceinline__ void stage_rc(int b, int& R, int& C) { const int st = b / 1024, sb = b % 1024, swz = sb ^ (((sb >> 9) & 1) << 5); R = (st >> 1) * 16 + swz / 64; C = (st & 1) * 32 + (swz % 64) / 2; }
struct Unit { int pm, pn; };
struct Gemm { const bf16_t* A; const bf16_t* Bt; int M, N, K; const int* rowidx; size_t grp_stride; int grp_tiles, ngrp; };
struct StaticOrder {
    int nM, nN, nwg, G, c;
    __device__ void init(int M, int N, int G_, int c_) { nM = M / BM; nN = N / BM; nwg = nM * nN; G = G_; c = c_; }
    __device__ bool next(int i, Unit& u) const {
        const long L = (long)i * G + c; if (L >= nwg) return false;
        int wgid = (int)L; { const int q = nwg / NXCD, r = nwg % NXCD, xcd = wgid % NXCD, off = wgid / NXCD; wgid = (xcd < r ? xcd * (q + 1) : r * (q + 1) + (xcd - r) * q) + off; }
        const int nig = WGM * nN, gid = wgid / nig, fm = gid * WGM, gsz = (nM - fm) < WGM ? (nM - fm) : WGM;
        u.pm = fm + ((wgid % nig) % gsz); u.pn = (wgid % nig) / gsz; return true;
    }
};
template <class Epi>
__device__ __forceinline__ void gemm_phase(LAS unsigned char* lds, LAS int* idxl, const Gemm g, const StaticOrder& S, const Epi& E) {
    const int tid = opaque_tid(), wid = __builtin_amdgcn_readfirstlane(tid >> 6), lane = tid & 63, wr = wid >> 2, wc = wid & 3, fr = lane & 15, fq = lane >> 4;
    const int K = g.K, nt = K / BK;
    unsigned voffB[2];
#pragma unroll
    for (int i = 0; i < 2; ++i) { int R_, C_; stage_rc(tid * 16 + i * 8192, R_, C_); voffB[i] = (unsigned)(R_ * K + C_) * 2u; }
    const size_t kstep = (size_t)(BK * 2);
    const size_t hstep = (size_t)HALF * K * 2;
    const size_t tstep = 2 * hstep;
    const unsigned ldsw = (unsigned)wid * 1024u;
    const int aoff = lds_byte(wr * 64 + fr, fq * 8), boff = lds_byte(wc * 32 + fr, fq * 8);
    Unit cur, nxt; int ui = 0;
    if (!S.next(0, cur)) return;
#ifndef MG_STAGGER_TICKS
#define MG_STAGGER_TICKS 0
#endif
    if (MG_STAGGER_TICKS && (blockIdx.x & 8)) { const unsigned long long t0 = __builtin_amdgcn_s_memrealtime(); while (__builtin_amdgcn_s_memrealtime() - t0 < MG_STAGGER_TICKS) __builtin_amdgcn_s_sleep(16); }
    if (g.rowidx) {
        for (int i = 0; i < MAXU; ++i) { Unit u; if (!S.next(i, u)) break; if (tid < 256) idxl[i * 256 + tid] = g.rowidx[u.pm * BM + tid]; }
        asm volatile("s_waitcnt vmcnt(0) lgkmcnt(0)" ::: "memory"); __builtin_amdgcn_s_barrier(); asm volatile("" ::: "memory");
    }
#define MG_AOFFS(dst, u_, ui_) do { _Pragma("unroll") for (int i_ = 0; i_ < 2; ++i_) { int R_, C_; stage_rc(tid * 16 + i_ * 8192, R_, C_); _Pragma("unroll") for (int h_ = 0; h_ < 2; ++h_) { \
        const int rr_ = g.rowidx ? idxl[(ui_) * 256 + h_ * HALF + R_] : ((u_).pm * BM + h_ * HALF + R_); dst[h_][i_] = (unsigned)(rr_ * K + C_) * 2u; } } } while (0)
#define MG_BPTR(u_) ((const char*)g.Bt + ((size_t)(((u_).pm / g.grp_tiles) % g.ngrp) * g.grp_stride) * 2 + (size_t)(u_).pn * tstep)
#define PG8_SA(b, h) (((b) * 2 + (h)) * HTB)
#define PG8_SB(b, h) ((4 + (b) * 2 + (h)) * HTB)
#define PG8_STAGE(bufoff, gbase, voff) do { _Pragma("unroll") for (int _i = 0; _i < 2; ++_i) \
        __builtin_amdgcn_global_load_lds((const unsigned*)((const char*)(gbase) + (voff)[_i]), (LAS unsigned*)(lds + (bufoff) + ldsw + _i * 8192), 16, 0, 0); } while (0)
#define PG8_LDA(dst, b, h) do { _Pragma("unroll") for (int m = 0; m < 4; ++m) _Pragma("unroll") for (int k = 0; k < 2; ++k) dst[m][k] = *(const LAS bf16x8*)(lds + PG8_SA(b, h) + aoff + m * 2048 + k * 1024); } while (0)
#define PG8_LDB(dst, b, h) do { _Pragma("unroll") for (int n = 0; n < 2; ++n) _Pragma("unroll") for (int k = 0; k < 2; ++k) dst[n][k] = *(const LAS bf16x8*)(lds + PG8_SB(b, h) + boff + n * 2048 + k * 1024); } while (0)
#define PG8_MMA(ai, bj, At, Bt) do { __builtin_amdgcn_s_setprio(1); _Pragma("unroll") for (int m = 0; m < 4; ++m) _Pragma("unroll") for (int n = 0; n < 2; ++n) _Pragma("unroll") for (int k = 0; k < 2; ++k) \
        acc[ai][bj][m][n] = __builtin_amdgcn_mfma_f32_16x16x32_bf16(Bt[n][k], At[m][k], acc[ai][bj][m][n], 0, 0, 0); __builtin_amdgcn_s_setprio(0); } while (0)
#define PG8_WAIT_V(n) asm volatile("s_waitcnt vmcnt(" #n ")" ::: "memory")
#define PG8_WAIT_L(n) asm volatile("s_waitcnt lgkmcnt(" #n ")" ::: "memory")
#define PG8_BAR __builtin_amdgcn_s_barrier()
#define PG8_SCHED __builtin_amdgcn_sched_barrier(0)
    f32x4 acc[2][2][4][2];
#pragma unroll
    for (int a = 0; a < 2; ++a)
#pragma unroll
        for (int b = 0; b < 2; ++b)
#pragma unroll
            for (int m = 0; m < 4; ++m)
#pragma unroll
                for (int n = 0; n < 2; ++n) acc[a][b][m][n] = (f32x4){0.f, 0.f, 0.f, 0.f};
    bf16x8 At[4][2], B0[2][2], B1[2][2];
    unsigned cAo[2][2], o2[2][2];
    MG_AOFFS(cAo, cur, 0);
    const char* const Abase = (const char*)g.A;
    const char* cB = MG_BPTR(cur);
    PG8_STAGE(PG8_SB(0, 0), cB, voffB); PG8_STAGE(PG8_SB(0, 1), cB + hstep, voffB); PG8_STAGE(PG8_SA(0, 0), Abase, cAo[0]); PG8_STAGE(PG8_SA(0, 1), Abase, cAo[1]);
    if (wr == 1) PG8_BAR;
    PG8_WAIT_V(2); PG8_BAR;
    PG8_STAGE(PG8_SB(1, 0), cB + kstep, voffB); PG8_STAGE(PG8_SA(1, 0), Abase + kstep, cAo[0]); PG8_STAGE(PG8_SB(1, 1), cB + hstep + kstep, voffB);
    PG8_WAIT_V(6); PG8_BAR;
    for (;;) {
        const bool has_next = S.next(ui + 1, nxt);
        const char* nB = has_next ? MG_BPTR(nxt) : cB;
        for (int t = 0; t < nt; t += 2) {
            const bool last = (t == nt - 2);
            const char* a1 = Abase + (size_t)(t + 1) * kstep;
            const char* a2 = last ? Abase : Abase + (size_t)(t + 2) * kstep; const char* b2 = last ? nB : cB + (size_t)(t + 2) * kstep;
            const char* a3 = a2 + kstep; const char* b3 = b2 + kstep;
            if (last && has_next) { MG_AOFFS(o2, nxt, ui + 1); } else {
#pragma unroll
                for (int h = 0; h < 2; ++h)
#pragma unroll
                    for (int i = 0; i < 2; ++i) o2[h][i] = cAo[h][i]; }
            PG8_LDB(B0, 0, 0); PG8_LDB(B1, 0, 1); PG8_SCHED; PG8_LDA(At, 0, 0); PG8_STAGE(PG8_SA(1, 1), a1, cAo[1]);
            PG8_WAIT_V(8); PG8_WAIT_L(0); PG8_BAR; PG8_MMA(0, 0, At, B0); PG8_MMA(0, 1, At, B1); PG8_BAR; PG8_SCHED;
            PG8_LDA(At, 0, 1); PG8_STAGE(PG8_SB(0, 0), b2, voffB); PG8_STAGE(PG8_SB(0, 1), b2 + hstep, voffB); PG8_STAGE(PG8_SA(0, 0), a2, o2[0]);
            PG8_WAIT_V(8); PG8_WAIT_L(0); PG8_BAR; PG8_MMA(1, 0, At, B0); PG8_MMA(1, 1, At, B1); PG8_BAR; PG8_SCHED;
            PG8_LDB(B0, 1, 0); PG8_LDB(B1, 1, 1); PG8_SCHED; PG8_LDA(At, 1, 0); PG8_STAGE(PG8_SA(0, 1), a2, o2[1]);
            PG8_WAIT_V(8); PG8_WAIT_L(0); PG8_BAR; PG8_MMA(0, 0, At, B0); PG8_MMA(0, 1, At, B1); PG8_BAR; PG8_SCHED;
            PG8_LDA(At, 1, 1); PG8_STAGE(PG8_SB(1, 0), b3, voffB); PG8_STAGE(PG8_SB(1, 1), b3 + hstep, voffB); PG8_STAGE(PG8_SA(1, 0), a3, o2[0]);
            PG8_WAIT_V(8); PG8_WAIT_L(0); PG8_BAR; PG8_MMA(1, 0, At, B0); PG8_MMA(1, 1, At, B1); PG8_BAR; PG8_SCHED;
        }
        if (wr == 0) PG8_BAR;
        E(acc, cur, wr, wc, fr, fq);
        if (!has_next) break;
#pragma unroll
        for (int a = 0; a < 2; ++a)
#pragma unroll
            for (int b = 0; b < 2; ++b)
#pragma unroll
                for (int m = 0; m < 4; ++m)
#pragma unroll
                    for (int n = 0; n < 2; ++n) acc[a][b][m][n] = (f32x4){0.f, 0.f, 0.f, 0.f};
        cur = nxt; cB = nB; ++ui;
#pragma unroll
        for (int h = 0; h < 2; ++h)
#pragma unroll
            for (int i = 0; i < 2; ++i) cAo[h][i] = o2[h][i];
        if (wr == 1) PG8_BAR;
    }
    PG8_WAIT_V(0);
    PG8_BAR;
#undef MG_AOFFS
#undef MG_BPTR
#undef PG8_SA
#undef PG8_SB
#undef PG8_STAGE
#undef PG8_LDA
#undef PG8_LDB
#undef PG8_MMA
#undef PG8_WAIT_V
#undef PG8_WAIT_L
#undef PG8_BAR
#undef PG8_SCHED
}
template <class EE> struct EpiAdapt {
    EE e; int row_base;
    __device__ __forceinline__ void operator()(const f32x4 (&acc)[2][2][4][2], const Unit& u, int wr, int wc, int fr, int fq) const {
        float rv[2][4];
#pragma unroll
        for (int ai = 0; ai < 2; ++ai)
#pragma unroll
            for (int m = 0; m < 4; ++m) rv[ai][m] = e.rowval(row_base + u.pm * BM + ai * HALF + wr * 64 + m * 16 + fr);
#pragma unroll
        for (int ai = 0; ai < 2; ++ai)
#pragma unroll
            for (int m = 0; m < 4; ++m) { const int row = row_base + u.pm * BM + ai * HALF + wr * 64 + m * 16 + fr;
                e(row, u.pn, wc, fq, acc[ai][0][m][0], acc[ai][0][m][1], acc[ai][1][m][0], acc[ai][1][m][1], rv[ai][m]);
                if (m & 1) asm volatile("" ::: "memory"); }
    }
};
}

struct AttnState { float m, l; float o[32]; };
__device__ __forceinline__ void attn_init(AttnState& st) { st.m = -INFINITY; st.l = 0.f;
#pragma unroll
    for (int d = 0; d < 32; ++d) st.o[d] = 0.f; }
__device__ __forceinline__ void load_row32(const bf16_t* p, float (&r)[32], float scale) {
#pragma unroll
    for (int i = 0; i < 4; ++i) { const u32x4 w = *(const u32x4*)(p + 8 * i);
        r[8 * i + 0] = bf_lo(w.x) * scale; r[8 * i + 1] = bf_hi(w.x) * scale; r[8 * i + 2] = bf_lo(w.y) * scale; r[8 * i + 3] = bf_hi(w.y) * scale;
        r[8 * i + 4] = bf_lo(w.z) * scale; r[8 * i + 5] = bf_hi(w.z) * scale; r[8 * i + 6] = bf_lo(w.w) * scale; r[8 * i + 7] = bf_hi(w.w) * scale; }
}
__device__ __forceinline__ float dot_row32(const bf16_t* p, const float (&q)[32]) {
    float d0 = 0.f, d1 = 0.f;
#pragma unroll
    for (int i = 0; i < 4; ++i) { const u32x4 w = *(const u32x4*)(p + 8 * i);
        d0 += q[8 * i + 0] * bf_lo(w.x); d1 += q[8 * i + 1] * bf_hi(w.x); d0 += q[8 * i + 2] * bf_lo(w.y); d1 += q[8 * i + 3] * bf_hi(w.y);
        d0 += q[8 * i + 4] * bf_lo(w.z); d1 += q[8 * i + 5] * bf_hi(w.z); d0 += q[8 * i + 6] * bf_lo(w.w); d1 += q[8 * i + 7] * bf_hi(w.w); }
    const float d = d0 + d1;
    return d + __shfl_xor(d, 32);
}
__device__ __forceinline__ void axpy_row32(const bf16_t* p, float a, float (&o)[32]) {
#pragma unroll
    for (int i = 0; i < 4; ++i) { const u32x4 w = *(const u32x4*)(p + 8 * i);
        o[8 * i + 0] += a * bf_lo(w.x); o[8 * i + 1] += a * bf_hi(w.x); o[8 * i + 2] += a * bf_lo(w.y); o[8 * i + 3] += a * bf_hi(w.y);
        o[8 * i + 4] += a * bf_lo(w.z); o[8 * i + 5] += a * bf_hi(w.z); o[8 * i + 6] += a * bf_lo(w.w); o[8 * i + 7] += a * bf_hi(w.w); }
}
template <class ScoreFn>
__device__ __forceinline__ void attn_segment(const float (&q)[32], AttnState& st, const bf16_t* Kb, const bf16_t* Vb, int j0, int j1, ScoreFn sf) {
#pragma unroll 1
    for (int j = j0; j < j1; ++j) {
        const float s0 = sf(j, dot_row32(Kb + (size_t)j * INW, q));
        if (s0 > st.m) { const float corr = __expf(st.m - s0); st.l *= corr;
#pragma unroll
            for (int d = 0; d < 32; ++d) st.o[d] *= corr;
            st.m = s0; }
        const float p0 = (s0 == -INFINITY) ? 0.f : __expf(s0 - st.m);
        st.l += p0;
        axpy_row32(Vb + (size_t)j * INW, p0, st.o);
    }
}
__device__ __forceinline__ void attn_sink(AttnState& st, float sk) {
    if (sk > st.m) { const float corr = __expf(st.m - sk); st.l *= corr;
#pragma unroll
        for (int d = 0; d < 32; ++d) st.o[d] *= corr;
        st.m = sk; }
    st.l += __expf(sk - st.m);
}
__device__ __forceinline__ void attn_store(const AttnState& st, bf16_t* o) {
    const float inv = 1.f / st.l;
#pragma unroll
    for (int i = 0; i < 4; ++i) { u32x4 w; w.x = pk2(st.o[8 * i] * inv, st.o[8 * i + 1] * inv); w.y = pk2(st.o[8 * i + 2] * inv, st.o[8 * i + 3] * inv);
        w.z = pk2(st.o[8 * i + 4] * inv, st.o[8 * i + 5] * inv); w.w = pk2(st.o[8 * i + 6] * inv, st.o[8 * i + 7] * inv); *(u32x4*)(o + 8 * i) = w; }
}

__device__ __forceinline__ void phase_mixers(const Params& p, int l, bool with_ctx, int bid, int nb) {
    bid = opaque_s(bid); const int tid = opaque_tid(); const int lane = tid & 63, gw = bid * NWAVES + (tid >> 6), NGW = nb * NWAVES;
    const int ql = lane & 31, hf = lane >> 5;
    const bf16_t* PB = (const bf16_t*)(p.ws + WS_PB); bf16_t* OB = (bf16_t*)(p.ws + WS_OB);
    const float* sink = p.attn_sink + l * 6; const float* rpb = p.na_rpb + (size_t)l * 6 * 15 * 31;
#if !FAST_ATTN
#pragma unroll 1
    for (int it = gw; it < NB * 6 * 256; it += NGW) {
        const int chunk = it & 255, h = (it >> 8) % 6, b = it / (6 * 256), kvh = h / 3;
        const int t = chunk * 32 + ql; const size_t rowb = (size_t)b * SEQ;
        float q[32]; load_row32(PB + (rowb + t) * INW + C_QA + h * 64 + 32 * hf, q, 0.125f);
        AttnState st; attn_init(st);
        const int jlo = max(0, chunk * 32 - 128), jhi = min(SEQ, chunk * 32 + 32 + 128);
        attn_segment(q, st, PB + rowb * INW + C_KA + kvh * 64 + 32 * hf, PB + rowb * INW + C_VA + kvh * 64 + 32 * hf, jlo, jhi,
                     [&](int j, float d) { const int dt = t - j; return (dt <= 128 && dt >= -128) ? d : -INFINITY; });
        const size_t crow = (size_t)NLAT + (size_t)b * CTXL;
        attn_segment(q, st, PB + crow * INW + C_KA + kvh * 64 + 32 * hf, PB + crow * INW + C_VA + kvh * 64 + 32 * hf, 0, CTXL, [&](int, float d) { return d; });
        attn_sink(st, sink[h]);
        attn_store(st, OB + (rowb + t) * DM + h * 64 + 32 * hf);
    }
#pragma unroll 1
    for (int it = gw; it < NB * 6 * 256; it += NGW) {
        const int r = (it & 255) >> 1, ch = it & 1, h = (it >> 8) % 6, b = it / (6 * 256);
        const int cq = ch * 32 + ql; const size_t rowb = (size_t)b * SEQ; const int t = r * 64 + cq;
        float q[32]; load_row32(PB + (rowb + t) * INW + C_QN + h * 64 + 32 * hf, q, 0.125f);
        AttnState st; attn_init(st);
        const int rs = min(max(r - 4, 0), 128 - 8), cs = min(max(cq - 8, 0), 64 - 16);
        const float* bias = rpb + (size_t)h * 15 * 31;
        attn_segment(q, st, PB + (rowb + (size_t)rs * 64) * INW + C_KN + h * 64 + 32 * hf, PB + (rowb + (size_t)rs * 64) * INW + C_VN + h * 64 + 32 * hf, 0, 512,
                     [&](int j, float d) { const int ka = rs + (j >> 6), ck = j & 63; const bool ok = (ck >= cs) && (ck < cs + 16);
                                           const int ro = ka - r + 7, co = min(max(ck - cq, -15), 15) + 15; return ok ? d + bias[ro * 31 + co] : -INFINITY; });
        const size_t crow = (size_t)NLAT + (size_t)b * CTXL;
        attn_segment(q, st, PB + crow * INW + C_KN + h * 64 + 32 * hf, PB + crow * INW + C_VN + h * 64 + 32 * hf, 0, CTXL, [&](int, float d) { return d; });
        attn_store(st, OB + (rowb + t) * DM + 640 + h * 64 + 32 * hf);
    }
#endif
    {
        const float* cw = p.conv_w + (size_t)l * 3 * 256;
        const int nrows = with_ctx ? NROWS : NLAT;
        for (long e = (long)bid * NTHREADS + tid; e < (long)nrows * 32; e += (long)nb * NTHREADS) {
            const int row = (int)(e >> 5), ch = (int)(e & 31) * 8;
            const int tpos = row < NLAT ? (row & (SEQ - 1)) : ((row - NLAT) & (CTXL - 1)); const int tlen = row < NLAT ? SEQ : CTXL;
            const bf16_t* pr = PB + (size_t)row * INW;
            float u[3][8];
#pragma unroll
            for (int dlt = -1; dlt <= 1; ++dlt) {
                const bool ok = (tpos + dlt >= 0) && (tpos + dlt < tlen);
                if (ok) { const u32x4 a = *(const u32x4*)(pr + (long)dlt * INW + C_BX + ch), c = *(const u32x4*)(pr + (long)dlt * INW + C_BC + ch);
                    u[dlt + 1][0] = bf_lo(a.x) * bf_lo(c.x); u[dlt + 1][1] = bf_hi(a.x) * bf_hi(c.x); u[dlt + 1][2] = bf_lo(a.y) * bf_lo(c.y); u[dlt + 1][3] = bf_hi(a.y) * bf_hi(c.y);
                    u[dlt + 1][4] = bf_lo(a.z) * bf_lo(c.z); u[dlt + 1][5] = bf_hi(a.z) * bf_hi(c.z); u[dlt + 1][6] = bf_lo(a.w) * bf_lo(c.w); u[dlt + 1][7] = bf_hi(a.w) * bf_hi(c.w); }
                else {
#pragma unroll
                    for (int i = 0; i < 8; ++i) u[dlt + 1][i] = 0.f; }
            }
            const u32x4 gb = *(const u32x4*)(pr + C_BB + ch);
            const float g[8] = {bf_lo(gb.x), bf_hi(gb.x), bf_lo(gb.y), bf_hi(gb.y), bf_lo(gb.z), bf_hi(gb.z), bf_lo(gb.w), bf_hi(gb.w)};
            float y[8];
#pragma unroll
            for (int i = 0; i < 8; ++i) y[i] = g[i] * (u[0][i] * cw[ch + i] + u[1][i] * cw[256 + ch + i] + u[2][i] * cw[512 + ch + i]);
            u32x4 o; o.x = pk2(y[0], y[1]); o.y = pk2(y[2], y[3]); o.z = pk2(y[4], y[5]); o.w = pk2(y[6], y[7]);
            *(u32x4*)(OB + (size_t)row * DM + 384 + ch) = o;
        }
    }
#if !FAST_ATTN
    if (with_ctx) {
#pragma unroll 1
        for (int it = gw; it < 2 * NB * 6 * 8; it += NGW) {
            const int kind = it / (NB * 6 * 8), r = it % (NB * 6 * 8), chunk = r & 7, h = (r >> 3) % 6, b = r / 48;
            const size_t crow = (size_t)NLAT + (size_t)b * CTXL; const int tq = chunk * 32 + ql;
            const int qc = (kind == 0 ? C_QA + h * 64 : C_QN + h * 64) + 32 * hf, kc = (kind == 0 ? C_KA + (h / 3) * 64 : C_KN + h * 64) + 32 * hf, vc = (kind == 0 ? C_VA + (h / 3) * 64 : C_VN + h * 64) + 32 * hf;
            float q[32]; load_row32(PB + (crow + tq) * INW + qc, q, 0.125f);
            AttnState st; attn_init(st);
            attn_segment(q, st, PB + crow * INW + kc, PB + crow * INW + vc, 0, CTXL, [&](int, float d) { return d; });
            if (kind == 0) attn_sink(st, sink[h]);
            attn_store(st, OB + (crow + tq) * DM + (kind == 0 ? 0 : 640) + h * 64 + 32 * hf);
        }
    }
#endif
}

namespace fa {
typedef short v4i16_t __attribute__((ext_vector_type(4)));
typedef float f32x2_t __attribute__((ext_vector_type(2))); typedef __bf16 bf16x2_t __attribute__((ext_vector_type(2)));
__device__ __forceinline__ unsigned cvtpk(float lo, float hi) { f32x2_t v = {lo, hi}; bf16x2_t b = __builtin_convertvector(v, bf16x2_t); return __builtin_bit_cast(unsigned, b); }
constexpr float LOG2E = 1.4426950408889634f, SC = 0.125f * LOG2E;
constexpr int CHUNK_BYTES = 65536;
constexpr int BIAS_OFF = 2 * CHUNK_BYTES;
constexpr float THR = 8.f;
__device__ __forceinline__ int na_rs(int r) { return min(max(r - 4, 0), 128 - 8); }
__device__ __forceinline__ void glds16(const void* gsrc, unsigned lds_dst) { unsigned keep;
    asm volatile("s_mov_b32 %0, m0\n\ts_mov_b32 m0, %2\n\ts_nop 0\n\tglobal_load_lds_dwordx4 %1, off\n\ts_mov_b32 m0, %0" : "=&s"(keep) : "v"(gsrc), "s"(lds_dst) : "memory"); }
#define FA_WAIT_BAR(N) asm volatile("s_waitcnt vmcnt(" #N ") lgkmcnt(0)\n\ts_barrier" ::: "memory")
__device__ __forceinline__ float max3f(float a, float b, float c) { float r; asm("v_max3_f32 %0, %1, %2, %3" : "=v"(r) : "v"(a), "v"(b), "v"(c)); return r; }
__device__ __forceinline__ float max8f(const f32x4& a, const f32x4& b) { return max3f(max3f(max3f(a[0], a[1], a[2]), a[3], b[0]), max3f(b[1], b[2], b[3]), -INFINITY); }
typedef float f32x16 __attribute__((ext_vector_type(16)));
__device__ __forceinline__ float max16f(const f32x16& a) {
    float x = max3f(a[0], a[1], a[2]); x = max3f(x, a[3], a[4]); x = max3f(x, a[5], a[6]); x = max3f(x, a[7], a[8]); x = max3f(x, a[9], a[10]); x = max3f(x, a[11], a[12]); x = max3f(x, a[13], a[14]);
    return fmaxf(x, a[15]);
}
typedef float f32x2v __attribute__((ext_vector_type(2)));
template <int MODE>
__device__ __forceinline__ void unit32(f32x16 (&o)[2], float& m, float& ls, const bf16x8 (&q)[4], const LAS unsigned char* Kt0, const LAS unsigned char* Kt1, const LAS unsigned char* Vt0, const LAS unsigned char* Vt1,
                                       const int (&kb)[4], const int (&vb)[2], bool rel0, bool rel1, bool mk0, bool mk1, int tb0, int tb1, const f32x16& fmask, const LAS float* bp0, const LAS float* bp1) {
    f32x16 s[2]; float tm = -INFINITY;
#pragma unroll
    for (int t = 0; t < 2; ++t) {
        if (!(t == 0 ? rel0 : rel1)) continue;
        const LAS unsigned char* Kt = t == 0 ? Kt0 : Kt1;
        bf16x8 kf[4];
#pragma unroll
        for (int ks = 0; ks < 4; ++ks) kf[ks] = *(const LAS bf16x8*)(Kt + kb[ks]);
        f32x16 acc = __builtin_amdgcn_mfma_f32_32x32x16_bf16(kf[0], q[0], (f32x16){0.f, 0.f, 0.f, 0.f, 0.f, 0.f, 0.f, 0.f, 0.f, 0.f, 0.f, 0.f, 0.f, 0.f, 0.f, 0.f}, 0, 0, 0);
#pragma unroll
        for (int ks = 1; ks < 4; ++ks) acc = __builtin_amdgcn_mfma_f32_32x32x16_bf16(kf[ks], q[ks], acc, 0, 0, 0);
        if (MODE == 2) {
            const LAS float* bp = t == 0 ? bp0 : bp1;
#pragma unroll
            for (int r = 0; r < 16; ++r) acc[r] = __builtin_fmaf(acc[r], SC, bp[(r & 3) + 8 * (r >> 2)]) + fmask[r];
        } else {
            if (MODE == 1 && (t == 0 ? mk0 : mk1)) { const int tb = t == 0 ? tb0 : tb1;
#pragma unroll
                for (int r = 0; r < 16; ++r) acc[r] = ((unsigned)(tb - ((r & 3) + 8 * (r >> 2))) <= 256u) ? acc[r] : -INFINITY;
            } else asm volatile("s_nop 15\n\ts_nop 7" : "+v"(acc));
        }
        s[t] = acc;
        tm = fmaxf(tm, max16f(acc));
    }
    if (MODE != 2) tm *= SC;
    if (__any(tm > m + THR)) {
        const float mn = fmaxf(m, xor32_max(tm)), al = __builtin_amdgcn_exp2f(m - mn); m = mn; ls *= al;
#pragma unroll
        for (int d = 0; d < 2; ++d) o[d] = o[d] * al;
    }
    const float nm = -m; f32x2v ps2 = {0.f, 0.f};
#pragma unroll
    for (int t = 0; t < 2; ++t) {
        if (!(t == 0 ? rel0 : rel1)) continue;
        const LAS unsigned char* Vt = t == 0 ? Vt0 : Vt1;
        f32x16 pv = MODE == 2 ? s[t] + nm : s[t] * SC + nm;
#pragma unroll
        for (int r = 0; r < 16; ++r) pv[r] = __builtin_amdgcn_exp2f(pv[r]);
#pragma unroll
        for (int r = 0; r < 16; r += 2) ps2 += (f32x2v){pv[r], pv[r + 1]};
#pragma unroll
        for (int st = 0; st < 2; ++st) {
            u32x4 pw; pw.x = cvtpk(pv[8 * st + 0], pv[8 * st + 1]); pw.y = cvtpk(pv[8 * st + 2], pv[8 * st + 3]); pw.z = cvtpk(pv[8 * st + 4], pv[8 * st + 5]); pw.w = cvtpk(pv[8 * st + 6], pv[8 * st + 7]);
            const bf16x8 pb = __builtin_bit_cast(bf16x8, pw);
#pragma unroll
            for (int db = 0; db < 2; ++db) {
                const v4i16_t t0 = __builtin_amdgcn_ds_read_tr16_b64_v4i16((LAS v4i16_t*)(Vt + st * 2048 + vb[db])), t1 = __builtin_amdgcn_ds_read_tr16_b64_v4i16((LAS v4i16_t*)(Vt + st * 2048 + 1024 + vb[db]));
                const bf16x8 vf = (bf16x8){t0[0], t0[1], t0[2], t0[3], t1[0], t1[1], t1[2], t1[3]};
                o[db] = __builtin_amdgcn_mfma_f32_32x32x16_bf16(vf, pb, o[db], 0, 0, 0);
            }
        }
    }
    ls += ps2[0] + ps2[1];
}
__device__ __forceinline__ void attn_prefetch_first(const Params& p, int it, int n0, int n1, int n2, LAS unsigned char* lds, int tid) {
    int b, hd, tok0;
    if (it < n0) { const int blk = it & 63; b = it >> 7; hd = (it >> 6) & 1; tok0 = 128 * (blk - 1 + (blk == 0 ? 1 : 0)); }
    else if (it < n0 + n1) { const int j = it - n0, blk = j & 31; b = j / 192; hd = 2 + (j >> 5) % 6; tok0 = na_rs(4 * blk) * 64; }
    else if (it < n0 + n1 + n2) { const int j = it - n0 - n1; b = j >> 2; hd = (j >> 1) & 1; tok0 = SEQ; }
    else { const int j = it - n0 - n1 - n2; b = j / 6; hd = 2 + j % 6; tok0 = SEQ; }
    const int lane = tid & 63, w = __builtin_amdgcn_readfirstlane(tid >> 6);
    const int skey = 8 * w + (lane >> 3), spc = lane & 7;
    const int ksrc = skey * 128 + ((spc ^ ((skey >> 1) & 7)) << 3);
    const int vsrc = skey * 128 + 64 + (((((spc >> 1) ^ (skey & 2)) << 1) | (spc & 1)) << 3);
    const bf16_t* s_ = (const bf16_t*)p.out + ((size_t)(b * 8 + hd) * KV_TOK + tok0) * 128;
    const unsigned d_ = (unsigned)__builtin_amdgcn_readfirstlane((int)((unsigned)(uintptr_t)lds + w * 1024));
#pragma unroll
    for (int q_ = 0; q_ < 4; ++q_) { glds16(s_ + q_ * 64 * 128 + ksrc, d_ + q_ * 8192u); glds16(s_ + q_ * 64 * 128 + vsrc, d_ + 32768u + q_ * 8192u); }
}
template <int KIND>
__device__ __forceinline__ void attn_item(const Params& p, int l, int item, LAS unsigned char* lds, int tid, int nxt_it, int n0, int n1, int n2) {
    constexpr bool ISA = (KIND == 0 || KIND == 2);
    constexpr int NG = ISA ? 2 : 1;
    const int lane = tid & 63, w = __builtin_amdgcn_readfirstlane(tid >> 6), ql = lane & 31, hh = lane >> 5;
    const bf16_t* PB = (const bf16_t*)(p.ws + WS_PB); bf16_t* OB = (bf16_t*)(p.ws + WS_OB);
    int b, hx, blk;
    if (KIND == 0) { b = item >> 7; hx = (item >> 6) & 1; blk = item & 63; }
    else if (KIND == 1) { b = item / 192; hx = (item >> 5) % 6; blk = item & 31; }
    else if (KIND == 2) { b = item >> 2; hx = (item >> 1) & 1; blk = item & 1; }
    else { b = item / 6; hx = item % 6; blk = 0; }
    const size_t rowb = (size_t)b * SEQ, ctxb = (size_t)NLAT + (size_t)b * CTXL;
    const bf16_t* KVh = (const bf16_t*)p.out + (size_t)(b * 8 + (ISA ? hx : 2 + hx)) * KV_TOK * 128;
    int nwin = 0; size_t winrow0 = 0; int winpos0 = 0, krs0 = 0;
    if (KIND == 0) { const int first = blk == 0 ? 1 : 0, last = blk == 63 ? 2 : 3; nwin = (last - first + 1) >> 1; winpos0 = 128 * (blk - 1 + first); winrow0 = winpos0; }
    if (KIND == 1) { krs0 = na_rs(4 * blk); nwin = (na_rs(4 * blk + 3) + 8 - krs0 + 3) >> 2; winrow0 = (size_t)krs0 * 64; }
    const int nch = nwin + 1;
    const bool active = true;
    int gh[NG], gp0[NG];
#pragma unroll
    for (int gi = 0; gi < NG; ++gi) {
        const int G = ISA ? (w < 4 ? 2 * w + gi : 8 + (w - 4)) : w;
        if (ISA) { gh[gi] = 3 * hx + (G >> 2); gp0[gi] = 128 * blk + 32 * (G & 3); }
        else if (KIND == 1) { gh[gi] = hx; gp0[gi] = 16 * (G & 3); }
        else { gh[gi] = hx; gp0[gi] = 32 * G; }
    }
    const int nrow0 = 4 * blk + 2 * (w >> 2);
    const int nrq = nrow0 + (ql >> 4), ncq = gp0[0] + (ql & 15);
#define FA_QROW(gi, ql_) (KIND == 0 ? rowb + gp0[gi] + (ql_) : KIND == 2 ? ctxb + gp0[gi] + (ql_) : KIND == 1 ? rowb + (size_t)(nrow0 + ((ql_) >> 4)) * 64 + gp0[gi] + ((ql_) & 15) : ctxb + gp0[gi] + (ql_))
    const int skey = 8 * w + (lane >> 3), spc = lane & 7;
    const int ksrc = skey * 128 + ((spc ^ ((skey >> 1) & 7)) << 3);
    const int vsrc = skey * 128 + 64 + (((((spc >> 1) ^ (skey & 2)) << 1) | (spc & 1)) << 3);
    const unsigned lds0 = (unsigned)(uintptr_t)lds;
    const int noff = KIND == 1 ? ((gp0[0] >> 4) == 0 ? 0 : ((gp0[0] >> 4) == 1 ? 8 : ((gp0[0] >> 4) == 2 ? 24 : 32))) : 0;
    int kb[4], kbw[4], vb[2];
#pragma unroll
    for (int ks = 0; ks < 4; ++ks) { kb[ks] = ql * 128 + (((2 * ks + hh) ^ ((ql >> 1) & 7)) << 4); kbw[ks] = ql * 128 + (((2 * ks + hh) ^ (((noff + ql) >> 1) & 7)) << 4); }
    { const int vk = 4 * hh + ((lane & 15) >> 2);
#pragma unroll
      for (int db = 0; db < 2; ++db) vb[db] = vk * 128 + (((2 * db + ((lane >> 4) & 1)) ^ (vk & 2)) << 5) + ((lane & 3) << 3); }
#define FA_DMA(ci) do { const size_t r0_ = (ci) < nwin ? winrow0 + (size_t)(ci) * 256 : (size_t)SEQ; const bf16_t* s_ = KVh + r0_ * 128; \
        const unsigned d_ = (unsigned)__builtin_amdgcn_readfirstlane((int)(lds0 + ((ci) & 1) * CHUNK_BYTES + w * 1024)); \
        _Pragma("unroll") for (int q_ = 0; q_ < 4; ++q_) { glds16(s_ + q_ * 64 * 128 + ksrc, d_ + q_ * 8192u); glds16(s_ + q_ * 64 * 128 + vsrc, d_ + 32768u + q_ * 8192u); } } while (0)
    bf16x8 qf[NG][4];
#pragma unroll
    for (int gi = 0; gi < NG; ++gi)
#pragma unroll
        for (int ks = 0; ks < 4; ++ks) qf[gi][ks] = *(const bf16x8*)(PB + FA_QROW(gi, ql) * INW + (ISA ? C_QA : C_QN) + gh[gi] * 64 + 16 * ks + 8 * hh);
    f32x16 o[NG][2]; float m[NG], ls[NG];
#pragma unroll
    for (int gi = 0; gi < NG; ++gi) {
#pragma unroll
        for (int d = 0; d < 2; ++d)
#pragma unroll
            for (int r = 0; r < 16; ++r) o[gi][d][r] = 0.f;
        if (ISA) { m[gi] = p.attn_sink[l * 6 + gh[gi]] * LOG2E; ls[gi] = hh == 0 ? 1.f : 0.f; } else { m[gi] = -1e30f; ls[gi] = 0.f; }
    }
    f32x16 fmask;
#pragma unroll
    for (int r = 0; r < 16; ++r) fmask[r] = 0.f;
    if (KIND == 1) { const int cs = min(max(ncq - 8, 0), 48);
#pragma unroll
        for (int r = 0; r < 16; ++r) { const int ck = noff + (r & 3) + 8 * (r >> 2) + 4 * hh; fmask[r] = ((ck >= cs) && (ck < cs + 16)) ? 0.f : -INFINITY; } }
    const int nqrs = na_rs(nrq);
    LAS float* biasL = (LAS float*)(lds + BIAS_OFF);
    if (KIND == 1) { const float* rp = p.na_rpb + ((size_t)l * 6 + hx) * 15 * 31;
        for (int i = tid; i < 16 * 128; i += NTHREADS) { const int x = (i & 127) - 64; biasL[i] = (i >> 7) == 15 ? -INFINITY : ((x >= -15 && x <= 15) ? rp[(i >> 7) * 31 + x + 15] * LOG2E : 0.f); } }
    FA_WAIT_BAR(0);
#pragma unroll
    for (int gi = 0; gi < NG; ++gi) { asm volatile("" : "+v"(qf[gi][0]), "+v"(qf[gi][1]), "+v"(qf[gi][2]), "+v"(qf[gi][3])); }
#pragma unroll 1
    for (int ci = 0; ci < nch; ++ci) {
        if (ci + 1 < nch) FA_DMA(ci + 1);
        const LAS unsigned char* Kb = lds + (ci & 1) * CHUNK_BYTES; const LAS unsigned char* Vb = Kb + 32768;
        const bool iswin = ci < nwin;
        if (active) {
            if (KIND == 1 && iswin) {
                const int rsA = na_rs(nrow0), rsB = na_rs(nrow0 + 1), bcol = 64 + noff + 4 * hh - ncq;
#pragma unroll 1
                for (int rr = 0; rr < 2; ++rr) {
                    const int kr0 = krs0 + 4 * ci + 2 * rr;
                    const bool rel0 = (kr0 >= rsA) && (kr0 < rsB + 8), rel1 = (kr0 + 1 >= rsA) && (kr0 + 1 < rsB + 8);
                    if (rel0 || rel1) {
                        const bool rowok0 = (kr0 >= nqrs) && (kr0 < nqrs + 8), rowok1 = (kr0 + 1 >= nqrs) && (kr0 + 1 < nqrs + 8);
                        const LAS float* bp0 = biasL + (rowok0 ? kr0 - nrq + 7 : 15) * 128 + bcol; const LAS float* bp1 = biasL + (rowok1 ? kr0 + 1 - nrq + 7 : 15) * 128 + bcol;
                        const LAS unsigned char* Kt = Kb + (128 * rr + noff) * 128; const LAS unsigned char* Vt = Vb + (128 * rr + noff) * 128;
                        unit32<2>(o[0], m[0], ls[0], qf[0], Kt, Kt + 64 * 128, Vt, Vt + 64 * 128, kbw, vb, rel0, rel1, false, false, 0, 0, fmask, bp0, bp1);
                    }
                }
            } else {
#pragma unroll 1
                for (int u = 0; u < 4; ++u) {
                    const LAS unsigned char* Kt = Kb + (64 * u) * 128; const LAS unsigned char* Vt = Vb + (64 * u) * 128;
#pragma unroll
                    for (int gi = 0; gi < NG; ++gi) {
                        if (ISA && gi == 1 && w >= 4) continue;
                        if (KIND == 0) {
                            bool rel[2] = {true, true}, msk[2] = {false, false};
                            if (iswin) {
#pragma unroll
                                for (int t = 0; t < 2; ++t) { const int j0 = winpos0 + 256 * ci + 64 * u + 32 * t, p0 = gp0[gi];
                                    rel[t] = (j0 + 31 >= p0 - 128) && (j0 <= p0 + 31 + 128); msk[t] = !((j0 >= p0 + 31 - 128) && (j0 + 31 <= p0 + 128)); } }
                            if (!(rel[0] || rel[1])) continue;
                            const int tb0 = gp0[gi] + ql - (winpos0 + 256 * ci + 64 * u) - 4 * hh + 128;
                            unit32<1>(o[gi], m[gi], ls[gi], qf[gi], Kt, Kt + 4096, Vt, Vt + 4096, kb, vb, rel[0], rel[1], msk[0], msk[1], tb0, tb0 - 32, fmask, nullptr, nullptr);
                        } else unit32<0>(o[gi], m[gi], ls[gi], qf[gi], Kt, Kt + 4096, Vt, Vt + 4096, kb, vb, true, true, false, false, 0, 0, fmask, nullptr, nullptr);
                    }
                }
            }
        }
        FA_WAIT_BAR(0);
    }
#undef FA_DMA
    if (nxt_it >= 0) attn_prefetch_first(p, nxt_it, n0, n1, n2, lds, tid);
    if (active) {
        int ql2 = lane & 31; asm volatile("" : "+v"(ql2));
#pragma unroll
        for (int gi = 0; gi < NG; ++gi) {
            if (ISA && gi == 1 && w >= 4) continue;
            const float lt = xor32_sum(ls[gi]);
            const float inv = 1.f / lt;
            bf16_t* op = OB + FA_QROW(gi, ql2) * DM + (ISA ? 0 : 640) + gh[gi] * 64 + 4 * hh;
#pragma unroll
            for (int db = 0; db < 2; ++db)
#pragma unroll
                for (int i = 0; i < 4; ++i) { u32x2 ov; ov.x = cvtpk(o[gi][db][4 * i] * inv, o[gi][db][4 * i + 1] * inv); ov.y = cvtpk(o[gi][db][4 * i + 2] * inv, o[gi][db][4 * i + 3] * inv); *(u32x2*)(op + 32 * db + 8 * i) = ov; }
        }
    }
#undef FA_QROW
}
__device__ __forceinline__ void phase_attn(const Params& p, int l, bool with_ctx, LAS unsigned char* lds, int bid, int nb) {
    bid = opaque_s(bid);
    const int n0 = NB * 2 * 64, n1 = NB * 6 * 32, n2 = with_ctx ? NB * 2 * 2 : 0, n3 = with_ctx ? NB * 6 : 0;
    const int vb = (nb % 8 == 0) ? (bid % 8) * (nb / 8) + bid / 8 : bid;
    const int ntot = n0 + n1 + n2 + n3;
    if (vb < ntot) attn_prefetch_first(p, vb, n0, n1, n2, lds, opaque_tid());
#pragma unroll 1
    for (int it = vb; it < ntot; it += nb) {
        const int tid = opaque_tid();
        const int nx = it + nb < ntot ? it + nb : -1;
        if (it < n0) attn_item<0>(p, l, it, lds, tid, nx, n0, n1, n2);
        else if (it < n0 + n1) attn_item<1>(p, l, it - n0, lds, tid, nx, n0, n1, n2);
        else if (it < n0 + n1 + n2) attn_item<2>(p, l, it - n0 - n1, lds, tid, nx, n0, n1, n2);
        else attn_item<3>(p, l, it - n0 - n1 - n2, lds, tid, nx, n0, n1, n2);
    }
}
}

__device__ __forceinline__ float reduce16(const float (&t)[16], int lane) {
    float u[8], w4[4], x2[2];
#pragma unroll
    for (int e = 0; e < 8; ++e) { float a = t[e], b = t[e + 8]; asm volatile("s_nop 1\n\tv_permlane32_swap_b32 %0, %1" : "+v"(a), "+v"(b)); u[e] = a + b; }
#pragma unroll
    for (int e = 0; e < 4; ++e) { float a = u[e], b = u[e + 4]; asm volatile("s_nop 1\n\tv_permlane16_swap_b32 %0, %1" : "+v"(a), "+v"(b)); w4[e] = a + b; }
    const bool b3 = (lane & 8) != 0, b2 = (lane & 4) != 0;
#pragma unroll
    for (int e = 0; e < 2; ++e) { const float keep = b3 ? w4[e + 2] : w4[e], send = b3 ? w4[e] : w4[e + 2]; x2[e] = keep + dppf<0x128>(send); }
    const float keep = b2 ? x2[1] : x2[0], send = b2 ? x2[0] : x2[1];
    float y = keep + dppf<0x141>(send);
    y += dppf<0xB1>(y); y += dppf<0x4E>(y);
    return y;
}
__device__ __forceinline__ float wave_max(float v) {
    v = fmaxf(v, dppf<0xB1>(v)); v = fmaxf(v, dppf<0x4E>(v)); v = fmaxf(v, dppf<0x141>(v)); v = fmaxf(v, dppf<0x140>(v));
    return xor32_max(xor16_max(v));
}
__device__ __forceinline__ float row16_sum(float v) { v += dppf<0xB1>(v); v += dppf<0x4E>(v); v += dppf<0x141>(v); v += dppf<0x140>(v); return v; }
__device__ __forceinline__ float row16_max(float v) { v = fmaxf(v, dppf<0xB1>(v)); v = fmaxf(v, dppf<0x4E>(v)); v = fmaxf(v, dppf<0x141>(v)); v = fmaxf(v, dppf<0x140>(v)); return v; }
__device__ __forceinline__ void phase_ln_router(const Params& p, int l, bool with_ctx, LAS unsigned char* lds, int bid, int nb) {
    bid = opaque_s(bid); const int tid = opaque_tid(), lane = tid & 63, w = tid >> 6, gw = bid * NWAVES + w, NGW = nb * NWAVES;
    constexpr int WRS = 2064;
    LAS unsigned char* wrb = lds;
    LAS float* lg = (LAS float*)(lds + 16 * WRS + 32); LAS float* lb = lg + DM; LAS float* lsh = lb + DM; LAS float* lsc = lsh + 5 * DM;
    LAS unsigned char* hst = (LAS unsigned char*)(lsc + 5 * DM) + w * 4096;
    const float* wrg = p.w_router + (size_t)l * DM * NE;
    for (int i = tid; i < DM * NE / 2; i += NTHREADS) { const int c = (i >> 4) * 2, e = i & 15; *(LAS unsigned*)(wrb + e * WRS + c * 2) = pk2(wrg[c * 16 + e], wrg[(c + 1) * 16 + e]); }
    lds_fill(lg, p.ln1_g + l * DM, DM, tid); lds_fill(lb, p.ln1_b + l * DM, DM, tid);
    for (int r = 0; r < 5; ++r) { lds_fill(lsh + r * DM, mod_ptr(p, l, r) + 3 * DM, DM, tid); lds_fill(lsc + r * DM, mod_ptr(p, l, r) + 4 * DM, DM, tid); }
    __syncthreads();
    const bf16_t* XB = (const bf16_t*)(p.ws + WS_XB); bf16_t* HB = (bf16_t*)(p.ws + WS_HB); float* AFF = (float*)(p.ws + WS_AFF);
    const int nrows = with_ctx ? NROWS : NLAT;
    const int fr = lane & 15, fq = lane >> 4;
    const LAS unsigned char* bsrc = wrb + fr * WRS + fq * 16;
    const LAS unsigned char* asrc = hst + (fr & 1) * 2048 + fq * 16;
    auto rowh2 = [&](f32x4 (&v)[4], int row, int slot) {
        row_normalize(v); row_affine_l(v, lg, lb, lane);
        row_normalize(v);
        { const int mr = row_modrow(row); row_modulate_l(v, lsh + mr * DM, lsc + mr * DM, lane); }
#pragma unroll
        for (int j = 0; j < 4; ++j) { u32x2 o; o.x = pk2(v[j][0], v[j][1]); o.y = pk2(v[j][2], v[j][3]); *(u32x2*)(HB + (size_t)row * DM + 256 * j + 4 * lane) = o; *(LAS u32x2*)(hst + slot * 2048 + (256 * j + 4 * lane) * 2) = o; }
    };
    f32x4 va[4], vb[4]; u32x2 na[4], nb2[4];
    auto ldraw = [&](u32x2 (&d)[4], int r) {
#pragma unroll
        for (int j = 0; j < 4; ++j) d[j] = *(const u32x2*)(XB + (size_t)r * DM + 256 * j + 4 * lane); };
    auto unpack = [&](f32x4 (&d)[4], const u32x2 (&sv)[4]) {
#pragma unroll
        for (int j = 0; j < 4; ++j) d[j] = (f32x4){bf_lo(sv[j].x), bf_hi(sv[j].x), bf_lo(sv[j].y), bf_hi(sv[j].y)}; };
    const int step = 2 * NGW;
    ldraw(na, min(gw, nrows - 1)); ldraw(nb2, min(gw + NGW, nrows - 1));
#pragma unroll 1
    for (int row = gw; row < nrows; row += step) {
        const int rowB = min(row + NGW, nrows - 1);
        unpack(va, na); unpack(vb, nb2);
        ldraw(na, min(row + step, nrows - 1)); ldraw(nb2, min(row + step + NGW, nrows - 1));
        rowh2(va, row, 0); asm volatile("" ::: "memory"); rowh2(vb, rowB, 1);
        LDS_WAIT();
        f32x4 acc = {0.f, 0.f, 0.f, 0.f};
#pragma unroll 8
        for (int s = 0; s < 32; ++s) { const bf16x8 af = *(const LAS bf16x8*)(asrc + 64 * s), bf = *(const LAS bf16x8*)(bsrc + 64 * s); acc = __builtin_amdgcn_mfma_f32_16x16x32_bf16(af, bf, acc, 0, 0, 0); }
        const float m0 = row16_max(acc[0]), m1 = row16_max(acc[1]), e0 = expf(acc[0] - m0), e1 = expf(acc[1] - m1);
        float a0 = e0 / row16_sum(e0), a1 = e1 / row16_sum(e1);
        asm volatile("" : "+v"(a0), "+v"(a1));
        if (lane < 16) { AFF[(size_t)lane * NROWS + row] = a0; AFF[(size_t)lane * NROWS + rowB] = a1; }
        LDS_WAIT();
    }
}

__device__ __forceinline__ void topk_item(const float* aff  , int n, int k, int row0  , int e, int slot0,
                                          int* TOK, float* GATE, int* INV, LAS unsigned char* lds) {
    const int tid = opaque_tid(), lane = tid & 63, w = tid >> 6;
    LAS unsigned* keys = (LAS unsigned*)lds;
    LAS unsigned* hist = keys + 8192;
    LAS unsigned* misc = hist + 256;
    for (int i = tid; i < n; i += NTHREADS) keys[i] = __builtin_bit_cast(unsigned, aff[i]);
    if (tid == 0) { misc[0] = 0u; misc[1] = (unsigned)k; }
    __syncthreads();
    unsigned maskv = 0u;
    for (int pass = 0; pass < 4; ++pass) {
        const int shift = 24 - 8 * pass;
        if (tid < 256) hist[tid] = 0u;
        __syncthreads();
        const unsigned prefix = misc[0];
        for (int i = tid; i < n; i += NTHREADS) { const unsigned kv = keys[i]; if ((kv & maskv) == prefix) atomicAdd((unsigned*)&hist[(kv >> shift) & 255u], 1u); }
        __syncthreads();
        if (w == 0) {
            const unsigned rem = misc[1];
            const unsigned h0 = hist[4 * lane], h1 = hist[4 * lane + 1], h2 = hist[4 * lane + 2], h3 = hist[4 * lane + 3], s4 = h0 + h1 + h2 + h3;
            unsigned S = s4;
#pragma unroll
            for (int o = 1; o < 64; o <<= 1) { const unsigned y = __shfl_down(S, o); if (lane + o < 64) S += y; }
            const unsigned above = S - s4;
            if (above < rem && rem <= S) { unsigned cum = above; int bin;
                if (cum + h3 >= rem) bin = 3; else { cum += h3; if (cum + h2 >= rem) bin = 2; else { cum += h2; if (cum + h1 >= rem) bin = 1; else { cum += h1; bin = 0; } } }
                misc[0] = prefix | ((unsigned)(4 * lane + bin) << shift); misc[1] = rem - cum; }
        }
        __syncthreads();
        maskv |= 255u << shift;
    }
    const unsigned T = misc[0], need_eq = misc[1];
    __syncthreads();
    const int per = n >= NTHREADS ? n / NTHREADS : 1; const int t0 = tid * per; const bool act = t0 < n;
    unsigned ce = 0u;
    if (act) for (int i = 0; i < per; ++i) ce += (keys[t0 + i] == T) ? 1u : 0u;
    unsigned inc = ce;
#pragma unroll
    for (int o = 1; o < 64; o <<= 1) { const unsigned y = __shfl_up(inc, o); if (lane >= o) inc += y; }
    if (lane == 63) misc[16 + w] = inc;
    __syncthreads();
    unsigned base = 0u;
    for (int ww = 0; ww < w; ++ww) base += misc[16 + ww];
    unsigned eqrank = base + inc - ce;
    __syncthreads();
    unsigned cs = 0u;
    if (act) { unsigned er = eqrank; for (int i = 0; i < per; ++i) { const unsigned kv = keys[t0 + i]; if (kv > T) cs++; else if (kv == T) { if (er < need_eq) cs++; er++; } } }
    inc = cs;
#pragma unroll
    for (int o = 1; o < 64; o <<= 1) { const unsigned y = __shfl_up(inc, o); if (lane >= o) inc += y; }
    if (lane == 63) misc[16 + w] = inc;
    __syncthreads();
    base = 0u;
    for (int ww = 0; ww < w; ++ww) base += misc[16 + ww];
    unsigned pos = base + inc - cs;
    if (act) { unsigned er = eqrank; for (int i = 0; i < per; ++i) { const unsigned kv = keys[t0 + i]; bool sel = false;
            if (kv > T) sel = true; else if (kv == T) { sel = er < need_eq; er++; }
            const int row = row0 + t0 + i;
            if (sel) { const int slot = slot0 + (int)pos; TOK[slot] = row; GATE[slot] = __builtin_bit_cast(float, kv); INV[(size_t)e * NROWS + row] = slot; pos++; }
            else INV[(size_t)e * NROWS + row] = -1; } }
    __syncthreads();
}
__device__ __forceinline__ void phase_topk(const Params& p, bool with_ctx, LAS unsigned char* lds, int bid, int nb) {
    const float* AFF = (const float*)(p.ws + WS_AFF); int* TOK = (int*)(p.ws + WS_TOK); float* GATE = (float*)(p.ws + WS_GATE); int* INV = (int*)(p.ws + WS_INV);
    const int nitems = with_ctx ? 128 : 64;
    for (int it = bid; it < nitems; it += nb) {
        if (it < 64) { const int b = it >> 4, e = it & 15; topk_item(AFF + (size_t)e * NROWS + (size_t)b * SEQ, SEQ, CAP, b * SEQ, e, (b * NE + e) * CAP, TOK, GATE, INV, lds); }
        else { const int b = (it - 64) >> 4, e = it & 15; topk_item(AFF + (size_t)e * NROWS + NLAT + (size_t)b * CTXL, CTXL, CCAP, NLAT + b * CTXL, e, NSLOT_LAT + (e * NB + b) * CCAP, TOK, GATE, INV, lds); }
    }
}

__device__ __forceinline__ void phase_combine(const Params& p, int l, bool with_ctx, LAS unsigned char* lds, int bid, int nb) {
    bid = opaque_s(bid); const int tid = opaque_tid(); const int lane = tid & 63, gw = bid * NWAVES + (tid >> 6), NGW = nb * NWAVES;
    LAS float* l1g = (LAS float*)lds; LAS float* l1b = l1g + DM; LAS float* l2g = l1b + DM; LAS float* l2b = l2g + DM; LAS float* lg2 = l2b + DM; LAS float* lsh = lg2 + 5 * DM; LAS float* lsc = lsh + 5 * DM;
    lds_fill(l1g, p.ln1_g + l * DM, DM, tid); lds_fill(l1b, p.ln1_b + l * DM, DM, tid); lds_fill(l2g, p.ln2_g + l * DM, DM, tid); lds_fill(l2b, p.ln2_b + l * DM, DM, tid);
    for (int r = 0; r < 5; ++r) { lds_fill(lg2 + r * DM, mod_ptr(p, l, r) + 5 * DM, DM, tid); if (l + 1 < DEPTH) { lds_fill(lsh + r * DM, mod_ptr(p, l + 1, r), DM, tid); lds_fill(lsc + r * DM, mod_ptr(p, l + 1, r) + DM, DM, tid); } }
    __syncthreads();
    bf16_t* XB = (bf16_t*)(p.ws + WS_XB); bf16_t* HB = (bf16_t*)(p.ws + WS_HB);
    const bf16_t* Y = (const bf16_t*)(p.ws + WS_Y); const int* INV = (const int*)(p.ws + WS_INV);
    const float* g = p.ln2_g + l * DM; const float* bb = p.ln2_b + l * DM;
    const int nrows = with_ctx ? NROWS : NLAT;
    f32x4 v[4], vn[4]; int myinv = -1, myinvn = -1;
    if (gw < nrows) { row_load_bf16(XB + (size_t)gw * DM, lane, v); myinv = INV[(size_t)(lane & 15) * NROWS + gw]; }
#pragma unroll 1
    for (int row = gw; row < nrows; row += NGW) {
        bf16_t* xr = XB + (size_t)row * DM;
        const int rn = row + NGW;
        if (rn < nrows) { row_load_bf16(XB + (size_t)rn * DM, lane, vn); myinvn = INV[(size_t)(lane & 15) * NROWS + rn]; }
        f32x4 a[4];
#pragma unroll
        for (int j = 0; j < 4; ++j) a[j] = (f32x4){0.f, 0.f, 0.f, 0.f};
#pragma unroll
        for (int e = 0; e < 16; ++e) {
            const int slot = __builtin_amdgcn_readlane(myinv, e);
            if (slot >= 0) { const bf16_t* yr = Y + (size_t)slot * DM;
#pragma unroll
                for (int j = 0; j < 4; ++j) { const u32x2 wv = *(const u32x2*)(yr + 256 * j + 4 * lane); a[j][0] += bf_lo(wv.x); a[j][1] += bf_hi(wv.x); a[j][2] += bf_lo(wv.y); a[j][3] += bf_hi(wv.y); } }
        }
        row_normalize(v); row_affine_l(v, l1g, l1b, lane);
        const int mr = row_modrow(row);
#pragma unroll
        for (int j = 0; j < 4; ++j) { const f32x4 g2 = *(const LAS f32x4*)(lg2 + mr * DM + 256 * j + 4 * lane); v[j] = v[j] * ALPHA + g2 * a[j]; }
        row_normalize(v); row_affine_l(v, l2g, l2b, lane);
        if (l + 1 < DEPTH) row_store_bf16(xr, lane, v); else row_store(p.out + (size_t)row * DM, lane, v);
        if (l + 1 < DEPTH) { row_normalize(v); row_modulate_l(v, lsh + mr * DM, lsc + mr * DM, lane); row_store_bf16(HB + (size_t)row * DM, lane, v); }
#pragma unroll
        for (int j = 0; j < 4; ++j) v[j] = vn[j];
        myinv = myinvn;
    }
}

constexpr int N_PHASES = 2 + 8 * DEPTH;
#define IN(k) (lo <= (k) && (k) < hi)
#ifndef TS_SEL
#define TS_SEL -1
#endif
#define TS_MULT 8
#define SEAM(k) do { if (IN(k) && IN((k) + 1)) xcd_barrier(bar); if (TS_SEL >= 0 && blockIdx.x == 0 && threadIdx.x == 0) ((unsigned long long*)(p.ws + WS_CTL + 65536))[(k) + 1] = __builtin_amdgcn_s_memrealtime(); } while (0)
#ifndef PHMASK
#define PHMASK 0x3ff
#endif
#define PHON(i) ((PHMASK >> (i)) & 1)
#ifndef DUP_MASK
#define DUP_MASK 0
#endif
#define DUP(i) ((DUP_MASK >> (i)) & 1)
template <int l>
__device__ __forceinline__ void run_layer(const Params& p, LAS unsigned char* lds, LAS int* idxl, const XcdBarrier& bar, int bid, int nb, int lo, int hi) {
    bf16_t* HB = (bf16_t*)(p.ws + WS_HB); bf16_t* PB = (bf16_t*)(p.ws + WS_PB); bf16_t* OB = (bf16_t*)(p.ws + WS_OB);
    bf16_t* HH = (bf16_t*)(p.ws + WS_HH); bf16_t* Y = (bf16_t*)(p.ws + WS_Y);
    const int* TOK = (const int*)(p.ws + WS_TOK); const float* GATE = (const float*)(p.ws + WS_GATE);
        const int pb = 2 + 8 * l; const bool wc = (l == 0);
        if (IN(pb + 0)) { if (PHON(2)) {
            const bf16_t* W = (const bf16_t*)(p.ws + WS_WIN) + (size_t)l * INW * DM; EpiQKV E{PB, (const float*)(p.ws + WS_ROPE), (bf16_t*)p.out};
            { SgDesc g{HB + (size_t)NLAT * DM, DM, nullptr, W, 0, 1 << 30, 1, NCTX, INW, DM, NLAT}; sg_gemm(g, E, lds, bid, nb); }
            { mg::Gemm g{HB, W, NLAT, INW, DM, nullptr, 0, 1 << 20, 1}; mg::StaticOrder S; S.init(NLAT, INW, nb, bid); mg::EpiAdapt<EpiQKV> EA{E, 0}; mg::gemm_phase(lds, idxl, g, S, EA); if (DUP(2)) mg::gemm_phase(lds, idxl, g, S, EA); } } }
        SEAM(pb + 0);
        if (IN(pb + 1)) { if (PHON(3)) {
#if FAST_ATTN
            fa::phase_attn(p, l, wc, lds, bid, nb); if (DUP(3)) fa::phase_attn(p, l, wc, lds, bid, nb);
#endif
            phase_mixers(p, l, wc, bid, nb); if (DUP(11)) phase_mixers(p, l, wc, bid, nb); } }
        SEAM(pb + 1);
        if (IN(pb + 2)) { if (PHON(4)) {
            const bf16_t* W = (const bf16_t*)(p.ws + WS_WOUT) + (size_t)l * DM * DM;
            EpiOut<l == 0> E{p.x, p.ctx, (bf16_t*)(p.ws + WS_XB), mod_ptr(p, l, 0)};
            if (wc) { SgDesc g{OB + (size_t)NLAT * DM, DM, nullptr, W, 0, 1 << 30, 1, NCTX, DM, DM, NLAT}; sg_gemm(g, E, lds, bid, nb); }
            { mg::Gemm g{OB, W, NLAT, DM, DM, nullptr, 0, 1 << 20, 1}; mg::StaticOrder S; S.init(NLAT, DM, nb, bid); mg::EpiAdapt<EpiOut<l == 0>> EA{E, 0}; mg::gemm_phase(lds, idxl, g, S, EA); if (DUP(4) && l == 0) mg::gemm_phase(lds, idxl, g, S, EA); } } }
        SEAM(pb + 2);
        if (IN(pb + 3)) { if (PHON(5)) phase_ln_router(p, l, wc, lds, bid, nb); }
        SEAM(pb + 3);
        if (IN(pb + 4)) { if (PHON(6)) { phase_topk(p, wc, lds, bid, nb); if (DUP(6)) phase_topk(p, wc, lds, bid, nb);
            { const int busy = wc ? 128 : 64;
              if (bid >= busy && nb > busy) phase_weights(p, lds, bid - busy, nb - busy, l == 0 ? TR_P0 : TR_SPLIT, l == 0 ? TR_SPLIT : 2 * TR_PER_L); } } }
        SEAM(pb + 4);
        if (IN(pb + 5)) { if (PHON(7)) {
            const bf16_t* W = (const bf16_t*)(p.ws + WS_WGU) + (size_t)l * NE * 1024 * DM; EpiGU E{HH};
            if (wc) { SgDesc g{HB, DM, TOK + NSLOT_LAT, W, (size_t)1024 * DM, NB * CCAP, NE, NSLOT_CTX, 1024, DM, NSLOT_LAT}; sg_gemm(g, E, lds, bid, nb); }
            { mg::Gemm g{HB, W, NSLOT_LAT, 1024, DM, TOK, (size_t)1024 * DM, CAP / 256, NE}; mg::StaticOrder S; S.init(NSLOT_LAT, 1024, nb, bid); mg::EpiAdapt<EpiGU> EA{E, 0}; mg::gemm_phase(lds, idxl, g, S, EA); if (DUP(7)) mg::gemm_phase(lds, idxl, g, S, EA); } } }
        SEAM(pb + 5);
        if (IN(pb + 6)) { if (PHON(8)) {
            const bf16_t* W = (const bf16_t*)(p.ws + WS_WD) + (size_t)l * NE * DM * FF; EpiDown E{Y, GATE};
            if (wc) { SgDesc g{HH + (size_t)NSLOT_LAT * FF, FF, nullptr, W, (size_t)DM * FF, NB * CCAP, NE, NSLOT_CTX, DM, FF, NSLOT_LAT}; sg_gemm(g, E, lds, bid, nb); }
            { mg::Gemm g{HH, W, NSLOT_LAT, DM, FF, nullptr, (size_t)DM * FF, CAP / 256, NE}; mg::StaticOrder S; S.init(NSLOT_LAT, DM, nb, bid); mg::EpiAdapt<EpiDown> EA{E, 0}; mg::gemm_phase(lds, idxl, g, S, EA); if (DUP(8)) mg::gemm_phase(lds, idxl, g, S, EA); } } }
        SEAM(pb + 6);
        if (IN(pb + 7)) { if (PHON(9)) phase_combine(p, l, wc, lds, bid, nb); }
        SEAM(pb + 7);
}
__global__ void __launch_bounds__(NTHREADS, 2) fwd_kernel(Params p) {
    extern __shared__ __attribute__((aligned(16))) unsigned char lds_raw[];
    LAS unsigned char* lds = (LAS unsigned char*)lds_raw;
    const int bid = blockIdx.x, nb = gridDim.x;
    volatile LAS unsigned* MISC = (volatile LAS unsigned*)(lds + LDS_BYTES - 64);
    LAS int* idxl = (LAS int*)(lds + mg::STAGE_BYTES);
    if (threadIdx.x < 16) MISC[threadIdx.x] = 0u;
    __syncthreads();
    XcdBarrier bar; bar.bar = (unsigned*)(p.ws + WS_CTL) + CW_BAR; bar.x = 0; bar.st = nullptr;
    const bool multi = p.ph_hi - p.ph_lo > 1;
    if (multi) bar = xcd_barrier_post((unsigned*)(p.ws + WS_CTL) + CW_BAR, MISC + 8);
    bf16_t* HB = (bf16_t*)(p.ws + WS_HB); bf16_t* PB = (bf16_t*)(p.ws + WS_PB); bf16_t* OB = (bf16_t*)(p.ws + WS_OB);
    bf16_t* HH = (bf16_t*)(p.ws + WS_HH); bf16_t* Y = (bf16_t*)(p.ws + WS_Y);
    const int* TOK = (const int*)(p.ws + WS_TOK); const float* GATE = (const float*)(p.ws + WS_GATE);
    const int lo = p.ph_lo, hi = p.ph_hi;
    if (TS_SEL >= 0 && blockIdx.x == 0 && threadIdx.x == 0) ((unsigned long long*)(p.ws + WS_CTL + 65536))[0] = __builtin_amdgcn_s_memrealtime();
    if (IN(0)) { if (PHON(0)) { phase_prologue(p, lds, bid, nb); __syncthreads(); phase_weights(p, lds, bid, nb, 0, TR_P0); } } SEAM(0);
    if (IN(1)) { if (PHON(1)) phase_ln1(p, bid, nb); if (DUP(1)) phase_ln1(p, bid, nb); } SEAM(1);
    run_layer<0>(p, lds, idxl, bar, bid, nb, lo, hi);
    run_layer<1>(p, lds, idxl, bar, bid, nb, lo, hi);
    if (TS_SEL >= 0 && blockIdx.x == 0 && threadIdx.x == 0) {
        volatile unsigned long long* ts = (volatile unsigned long long*)(p.ws + WS_CTL + 65536); const unsigned long long dt = (ts[TS_SEL + 1] - ts[TS_SEL]) * TS_MULT, t0 = __builtin_amdgcn_s_memrealtime();
        while (__builtin_amdgcn_s_memrealtime() - t0 < dt) __builtin_amdgcn_s_sleep(8); }
#undef IN
#undef SEAM
}

#ifndef N_LAUNCH_SPLIT
#define N_LAUNCH_SPLIT 0
#endif
extern "C" void kernel_launch(void* const* d_in, const int* in_sizes, int n_in, void* d_out, int out_size, void* d_ws, size_t ws_size, hipStream_t stream) {
    static int grid = 0;
    if (grid == 0) {
        if (n_in != 19 || in_sizes[0] != NLAT * DM || out_size != NLAT * DM || ws_size < WS_END) { fprintf(stderr, "kernel_launch: unexpected shapes (n_in %d, in0 %d, out %d, ws %zu)\n", n_in, n_in > 0 ? in_sizes[0] : -1, out_size, ws_size); grid = -1; return; }
        int dev = 0, cus = 0, per_cu = 0;
        if (hipGetDevice(&dev) != hipSuccess || hipDeviceGetAttribute(&cus, hipDeviceAttributeMultiprocessorCount, dev) != hipSuccess) { grid = -1; return; }
        if (hipFuncSetAttribute((const void*)fwd_kernel, hipFuncAttributeMaxDynamicSharedMemorySize, LDS_BYTES) != hipSuccess) { fprintf(stderr, "kernel_launch: hipFuncSetAttribute failed\n"); grid = -1; return; }
        if (hipOccupancyMaxActiveBlocksPerMultiprocessor(&per_cu, (const void*)fwd_kernel, NTHREADS, LDS_BYTES) != hipSuccess || per_cu < 1) { fprintf(stderr, "kernel_launch: occupancy query says %d\n", per_cu); per_cu = 1; }
        (void)hipGetLastError();
        grid = cus;
    }
    if (grid < 0) return;
    (void)hipMemsetAsync((char*)d_ws + WS_CTL, 0, CTL_ZERO_BYTES, stream);
    Params p{};
    const float** pp = (const float**)&p;
    for (int i = 0; i < 19; ++i) pp[i] = (const float*)d_in[i];
    p.out = (float*)d_out; p.ws = (unsigned char*)d_ws;
#if N_LAUNCH_SPLIT
    for (int ph = 0; ph < N_PHASES; ++ph) { p.ph_lo = ph; p.ph_hi = ph + 1; hipLaunchKernelGGL(fwd_kernel, dim3(grid), dim3(NTHREADS), LDS_BYTES, stream, p); }
#else
    p.ph_lo = 0; p.ph_hi = N_PHASES;
    void* args[] = {&p};
    hipError_t e = hipLaunchCooperativeKernel((const void*)fwd_kernel, dim3(grid), dim3(NTHREADS), args, LDS_BYTES, stream);
    if (e != hipSuccess) fprintf(stderr, "kernel_launch: cooperative launch failed: %s\n", hipGetErrorString(e));
#endif
}
```

```cpp
#include <hip/hip_runtime.h>
#include <hip/hip_cooperative_groups.h>
#include <cstdio>
#include <cstdint>
#include <cmath>

#define LAS __attribute__((address_space(3)))
typedef unsigned short bf16_t;
typedef short bf16x8 __attribute__((ext_vector_type(8)));
typedef float f32x4 __attribute__((ext_vector_type(4)));
typedef unsigned u32x4 __attribute__((ext_vector_type(4)));
typedef unsigned u32x2 __attribute__((ext_vector_type(2)));

constexpr int NB = 4, SEQ = 8192, DM = 1024, CTXL = 256, DEPTH = 2;
constexpr int NLAT = NB * SEQ, NCTX = NB * CTXL, NROWS = NLAT + NCTX;
constexpr int INW = 2560, NE = 16, FF = 512, CAP = 1024, CCAP = 32;
constexpr int NSLOT_LAT = NB * NE * CAP, NSLOT_CTX = NB * NE * CCAP, NSLOT = NSLOT_LAT + NSLOT_CTX;
constexpr int NMOD = 6 * DM;
constexpr float LN_EPS = 1e-6f;
constexpr float ALPHA = 1.41421356237309515f;
constexpr int C_QA = 0, C_KA = 384, C_VA = 512, C_BX = 640, C_BB = 896, C_BC = 1152, C_QN = 1408, C_KN = 1792, C_VN = 2176;

#ifndef FAST_ATTN
#define FAST_ATTN 1
#endif
constexpr int KV_TOK = SEQ + CTXL;
constexpr int NTHREADS = 512, NWAVES = 8;
constexpr int LDS_BYTES = 163840;
constexpr int STG_OFF = 139264, STG_WAVE = 16 * 144;

constexpr size_t MiB = 1u << 20;
constexpr size_t WS_CTL = 0, CTL_ZERO_BYTES = 128 * 1024;
constexpr size_t WS_ROPE = 1 * MiB;
constexpr size_t WS_MOD = 1 * MiB + 65536;
constexpr size_t WS_AFF = 2 * MiB;
constexpr size_t WS_INV = 5 * MiB;
constexpr size_t WS_TOK = 8 * MiB;
constexpr size_t WS_GATE = 8 * MiB + 512 * 1024;
constexpr size_t WS_CXR = 9 * MiB;
constexpr size_t WS_WIN = 16 * MiB;
constexpr size_t WS_WOUT = 26 * MiB;
constexpr size_t WS_WGU = 30 * MiB;
constexpr size_t WS_WD = 94 * MiB;
constexpr size_t WS_HB = 126 * MiB;
constexpr size_t WS_OB = 192 * MiB;
constexpr size_t WS_HH = 192 * MiB;
constexpr size_t WS_PB = 258 * MiB;
constexpr size_t WS_Y = 258 * MiB;
constexpr size_t WS_XB = 424 * MiB;
constexpr size_t WS_END = 490 * MiB;
static_assert(WS_HB + (size_t)NROWS * DM * 2 <= WS_OB && WS_OB + (size_t)NROWS * DM * 2 <= WS_PB && WS_PB + (size_t)NROWS * INW * 2 <= WS_XB && WS_XB + (size_t)NROWS * DM * 2 <= WS_END, "ws map");
static_assert((size_t)NSLOT * FF * 2 <= (size_t)NROWS * DM * 2 && (size_t)NSLOT * DM * 2 <= (size_t)NROWS * INW * 2, "overlays");
constexpr int CW_BAR = 4096;

struct Params {
    const float *x, *c, *ctx, *c_ctx, *w_mod, *b_mod, *w_in, *conv_w, *attn_sink, *na_rpb, *w_out, *ln1_g, *ln1_b, *w_router, *w_gate, *w_up, *w_down, *ln2_g, *ln2_b;
    float* out; unsigned char* ws;
    int ph_lo, ph_hi;
};

__device__ __forceinline__ unsigned f2bf(float f) { unsigned u = __builtin_bit_cast(unsigned, f); return (u + 0x7fffu + ((u >> 16) & 1u)) >> 16; }
typedef float f32x2_cv __attribute__((ext_vector_type(2))); typedef __bf16 bf16x2_cv __attribute__((ext_vector_type(2)));
__device__ __forceinline__ unsigned pk2(float lo, float hi) { f32x2_cv v = {lo, hi}; bf16x2_cv b = __builtin_convertvector(v, bf16x2_cv); return __builtin_bit_cast(unsigned, b); }
__device__ __forceinline__ float bf_lo(unsigned w) { return __builtin_bit_cast(float, w << 16); }
__device__ __forceinline__ float bf_hi(unsigned w) { return __builtin_bit_cast(float, w & 0xffff0000u); }
template <int CTRL> __device__ __forceinline__ float dppf(float v) { return __builtin_bit_cast(float, __builtin_amdgcn_update_dpp(0, __builtin_bit_cast(int, v), CTRL, 0xf, 0xf, true)); }
__device__ __forceinline__ void swap16(float v, float& a, float& b) { a = v; b = v; asm volatile("s_nop 1\n\tv_permlane16_swap_b32 %0, %1" : "+v"(a), "+v"(b)); }
__device__ __forceinline__ void swap32(float v, float& a, float& b) { a = v; b = v; asm volatile("s_nop 1\n\tv_permlane32_swap_b32 %0, %1" : "+v"(a), "+v"(b)); }
__device__ __forceinline__ float xor16_sum(float v) { float a, b; swap16(v, a, b); return a + b; }
__device__ __forceinline__ float xor32_sum(float v) { float a, b; swap32(v, a, b); return a + b; }
__device__ __forceinline__ float xor16_max(float v) { float a, b; swap16(v, a, b); return fmaxf(a, b); }
__device__ __forceinline__ float xor32_max(float v) { float a, b; swap32(v, a, b); return fmaxf(a, b); }
__device__ __forceinline__ float wave_sum(float v) {
    v += dppf<0xB1>(v); v += dppf<0x4E>(v); v += dppf<0x141>(v); v += dppf<0x140>(v);
    return xor32_sum(xor16_sum(v));
}
#define LDS_WAIT() asm volatile("s_waitcnt lgkmcnt(0)" ::: "memory")
__device__ __forceinline__ int opaque_tid() { int t = threadIdx.x; asm volatile("" : "+v"(t)); return t; }
__device__ __forceinline__ int opaque_s(int v) { asm volatile("" : "+s"(v)); return v; }

__device__ __forceinline__ float* mod_ptr(const Params& p, int l, int r) { return (float*)(p.ws + WS_MOD) + ((size_t)l * 5 + r) * NMOD; }

#define XB_TMO      128
#define XB_XCNT(j)  (256  + 64 * (j))
#define XB_XSUB(j)  (1280 + 64 * (j))
#define XB_XGEN(j)  (2304 + 64 * (j))
#define XB_TOP      3328
#define XB_TOPGEN   3392
#define XCD_BAR_WORDS 3456
#define XB_SPIN_CAP (1u << 20)
__device__ __forceinline__ unsigned xb_ld(unsigned* p)              { return __hip_atomic_load(p, __ATOMIC_RELAXED, __HIP_MEMORY_SCOPE_AGENT); }
__device__ __forceinline__ unsigned xb_add(unsigned* p, unsigned v) { return __hip_atomic_fetch_add(p, v, __ATOMIC_RELAXED, __HIP_MEMORY_SCOPE_AGENT); }
__device__ __forceinline__ unsigned xb_xcc_id() { return (unsigned)__builtin_amdgcn_s_getreg((3 << 11) | 20) & 0xFu; }
#define XB_SPIN(cond, bar) do { unsigned _sp = 0; while (cond) { __builtin_amdgcn_s_sleep(1); \
    if ((++_sp & 255u) == 0u) { if (xb_ld(&(bar)[XB_TMO])) break; if (_sp > XB_SPIN_CAP) { atomicAdd(&(bar)[XB_TMO], 1u); break; } } } } while (0)
struct XcdBarrier { unsigned* bar; unsigned x; volatile LAS unsigned* st; };
__device__ __forceinline__ XcdBarrier xcd_barrier_post(unsigned* bar, volatile LAS unsigned* st) {
    XcdBarrier b; b.bar = bar; b.x = xb_xcc_id(); b.st = st;
    if (threadIdx.x == 0) (void)xb_add(&bar[XB_XCNT(b.x)], 1u);
    return b;
}
__device__ __forceinline__ void xcd_barrier_complete(unsigned* bar, unsigned x, unsigned& nloc, unsigned& nx) {
    const unsigned G = gridDim.x * gridDim.y * gridDim.z;
    unsigned sum, cnt, mine, sp = 0u;
    for (;;) {
        sum = 0u; cnt = 0u; mine = 0u;
#pragma unroll 1
        for (unsigned j = 0; j < 16; ++j) { const unsigned c = xb_ld(&bar[XB_XCNT(j)]); sum += c; cnt += (c > 0u) ? 1u : 0u; mine = (j == x) ? c : mine; }
        if (sum == G) break;
        __builtin_amdgcn_s_sleep(1);
        if ((++sp & 255u) == 0u) { if (xb_ld(&bar[XB_TMO])) break; if (sp > XB_SPIN_CAP) { atomicAdd(&bar[XB_TMO], 1u); break; } }
    }
    nloc = mine > 0u ? mine : 1u; nx = cnt > 0u ? cnt : 1u;
}
__device__ __forceinline__ void xcd_barrier(const XcdBarrier& b) {
    asm volatile("s_waitcnt vmcnt(0)" ::: "memory");
    __syncthreads();
    if (threadIdx.x == 0) {
        unsigned* bar = b.bar; asm volatile("" : "+s"(bar));
        __builtin_amdgcn_s_waitcnt(0);
        unsigned nloc = b.st[0], nx = b.st[1];
        if (nloc == 0u) { xcd_barrier_complete(bar, b.x, nloc, nx); b.st[0] = nloc; b.st[1] = nx; }
        const unsigned old = xb_add(&bar[XB_XSUB(b.x)], 1u);
        const unsigned gen = old / nloc;
        if (old + 1u == (gen + 1u) * nloc) {
            __builtin_amdgcn_fence(__ATOMIC_RELEASE, "agent");
            asm volatile("s_waitcnt vmcnt(0)" ::: "memory");
            const unsigned og = xb_add(&bar[XB_TOP], 1u);
            const unsigned tg = og / nx;
            if (og + 1u == (tg + 1u) * nx) xb_add(&bar[XB_TOPGEN], 1u);
            else XB_SPIN(xb_ld(&bar[XB_TOPGEN]) == tg, bar);
            __builtin_amdgcn_fence(__ATOMIC_ACQUIRE, "agent");
            xb_add(&bar[XB_XGEN(b.x)], 1u);
            asm volatile("s_waitcnt vmcnt(0)" ::: "memory");
        } else {
            XB_SPIN(xb_ld(&bar[XB_XGEN(b.x)]) == gen, bar);
            __builtin_amdgcn_fence(__ATOMIC_ACQUIRE, "agent");
            asm volatile("s_waitcnt vmcnt(0)" ::: "memory");
        }
    }
    __syncthreads();
}

struct TrItem { const float* W; bf16_t* WT; int K, N, mode, item; };
__device__ __forceinline__ void tr_load(const TrItem& t, int lane, float (&r)[32]) {
    const int nblk = t.N / 32, kb = t.item / nblk, nb = t.item % nblk, k0 = 64 * kb, n0 = 32 * nb;
    const float* src = t.W + (size_t)(k0 + (lane >> 5)) * t.N + n0 + (lane & 31);
#pragma unroll
    for (int i = 0; i < 32; ++i) r[i] = src[(size_t)(2 * i) * t.N];
}
__device__ __forceinline__ void tr_finish(const TrItem& t, int lane, const float (&r)[32], LAS float* scr) {
    const int nblk = t.N / 32, kb = t.item / nblk, nb = t.item % nblk, k0 = 64 * kb, n0 = 32 * nb;
#pragma unroll
    for (int i = 0; i < 32; ++i) scr[(2 * i + (lane >> 5)) * 33 + (lane & 31)] = r[i];
    LDS_WAIT();
    const int c = lane & 7;
#pragma unroll
    for (int j = 0; j < 4; ++j) {
        const int n = (lane >> 3) + 8 * j; const LAS float* s = scr + (8 * c) * 33 + n;
        u32x4 o; o.x = pk2(s[0 * 33], s[1 * 33]); o.y = pk2(s[2 * 33], s[3 * 33]); o.z = pk2(s[4 * 33], s[5 * 33]); o.w = pk2(s[6 * 33], s[7 * 33]);
        const int f = n0 + n;
        const int orow = t.mode == 0 ? ((f & ~255) + 128 * ((f >> 4) & 1) + 32 * ((f >> 6) & 3) + 16 * ((f >> 2) & 1) + 4 * (2 * ((f >> 5) & 1) + ((f >> 3) & 1)) + (f & 3))
                                     : (256 * (f >> 7) + (t.mode == 2 ? 128 : 0) + 32 * ((f >> 5) & 3) + 16 * ((f >> 2) & 1) + 4 * ((f >> 3) & 3) + (f & 3));
        *(u32x4*)(t.WT + (size_t)orow * t.K + k0 + 8 * c) = o;
    }
    LDS_WAIT();
}
__device__ __forceinline__ void phase_prologue(const Params& p, LAS unsigned char* lds, int bid, int nb) {
    bid = opaque_s(bid); const int tid = opaque_tid(), lane = tid & 63, w = tid >> 6;
    {
        LAS float* ssil = (LAS float*)lds;
        LAS float* red = ssil + 5 * 1024;
        for (int i = tid; i < 5 * 1024; i += NTHREADS) { const int r = i >> 10, k = i & 1023; const float v = r < 4 ? p.c[r * 1024 + k] : p.c_ctx[k]; ssil[i] = v / (1.f + expf(-v)); }
        __syncthreads();
        for (int item = bid; item < 2 * 96; item += nb) {
            const int l = item / 96, n0 = (item % 96) * 64;
            const float* W = p.w_mod + (size_t)l * DM * NMOD + n0 + lane;
            float a0 = 0.f, a1 = 0.f, a2 = 0.f, a3 = 0.f, a4 = 0.f;
#pragma unroll 8
            for (int k = w * 128; k < w * 128 + 128; ++k) {
                const float wv = W[(size_t)k * NMOD];
                a0 += ssil[k] * wv; a1 += ssil[1024 + k] * wv; a2 += ssil[2048 + k] * wv; a3 += ssil[3072 + k] * wv; a4 += ssil[4096 + k] * wv;
            }
            red[(w * 5 + 0) * 64 + lane] = a0; red[(w * 5 + 1) * 64 + lane] = a1; red[(w * 5 + 2) * 64 + lane] = a2; red[(w * 5 + 3) * 64 + lane] = a3; red[(w * 5 + 4) * 64 + lane] = a4;
            __syncthreads();
            if (tid < 320) { const int r = tid >> 6; float s = 0.f;
#pragma unroll
                for (int ww = 0; ww < 8; ++ww) s += red[(ww * 5 + r) * 64 + lane];
                mod_ptr(p, l, r)[n0 + lane] = s + p.b_mod[l * NMOD + n0 + lane]; }
            __syncthreads();
        }
    }
    if (bid == nb - 1) {
        float* rope = (float*)(p.ws + WS_ROPE);
        for (int e = tid; e < 128 * 16; e += NTHREADS) {
            const int pos = e >> 4, i = e & 15;
            const double a = exp(-((double)i / 16.0) * 9.210340371976184);
            const double a2 = a * a; double c = 1.0, s = a, tc = 1.0, ts = a;
            for (int n = 1; n <= 14; ++n) { tc *= -a2 / (double)((2 * n - 1) * (2 * n)); c += tc; ts *= -a2 / (double)((2 * n) * (2 * n + 1)); s += ts; }
            double rc = 1.0, rs = 0.0, bc = c, bs = s; int q = pos;
            while (q) { if (q & 1) { const double t = rc * bc - rs * bs; rs = rc * bs + rs * bc; rc = t; } const double t = bc * bc - bs * bs; bs = 2.0 * bc * bs; bc = t; q >>= 1; }
            rope[2 * e] = (float)rc; rope[2 * e + 1] = (float)rs;
        }
    }
}

constexpr int TR_I_IN = 16 * 80, TR_I_OUT = 16 * 32, TR_I_G = 16 * 16, TR_I_D = 8 * 32, TR_PER_L = TR_I_IN + TR_I_OUT + 16 * (2 * TR_I_G + TR_I_D);
constexpr int TR_P0 = TR_I_IN + TR_I_OUT, TR_SPLIT = TR_PER_L + TR_I_IN + TR_I_OUT;
__device__ __forceinline__ void phase_weights(const Params& p, LAS unsigned char* lds, int bid, int nb, int lo, int hi) {
    bid = opaque_s(bid); const int tid = opaque_tid(), lane = tid & 63, w = tid >> 6;
    {
        LAS float* scr = (LAS float*)lds + w * (64 * 33);
        const int gw = bid * NWAVES + w, NGW = nb * NWAVES;
        constexpr int I_IN = TR_I_IN, I_OUT = TR_I_OUT, I_G = TR_I_G, I_D = TR_I_D, PER_L = TR_PER_L;
        auto decode = [&](int it) -> TrItem {
            const int l = it / PER_L; int r = it % PER_L;
            if (r < I_IN) return TrItem{p.w_in + (size_t)l * DM * INW, (bf16_t*)(p.ws + WS_WIN) + (size_t)l * INW * DM, DM, INW, 0, r}; r -= I_IN;
            if (r < I_OUT) return TrItem{p.w_out + (size_t)l * DM * DM, (bf16_t*)(p.ws + WS_WOUT) + (size_t)l * DM * DM, DM, DM, 0, r}; r -= I_OUT;
            if (r < 16 * I_G) { const int e = r / I_G; return TrItem{p.w_gate + ((size_t)l * NE + e) * DM * FF, (bf16_t*)(p.ws + WS_WGU) + ((size_t)l * NE + e) * 1024 * DM, DM, FF, 1, r % I_G}; } r -= 16 * I_G;
            if (r < 16 * I_G) { const int e = r / I_G; return TrItem{p.w_up + ((size_t)l * NE + e) * DM * FF, (bf16_t*)(p.ws + WS_WGU) + ((size_t)l * NE + e) * 1024 * DM, DM, FF, 2, r % I_G}; } r -= 16 * I_G;
            const int e = r / I_D; return TrItem{p.w_down + ((size_t)l * NE + e) * FF * DM, (bf16_t*)(p.ws + WS_WD) + ((size_t)l * NE + e) * DM * FF, FF, DM, 0, r % I_D};
        };
        float ra[32], rb[32];
        int it = lo + gw;
        if (it < hi) { TrItem cur = decode(it); tr_load(cur, lane, ra);
#pragma unroll 1
            for (;;) {
                const int itn = it + NGW; const bool hn = itn < hi; TrItem nx = cur;
                if (hn) { nx = decode(itn); tr_load(nx, lane, rb); }
                tr_finish(cur, lane, ra, scr);
                if (!hn) break;
                const int itn2 = itn + NGW; const bool hn2 = itn2 < hi; TrItem nx2 = nx;
                if (hn2) { nx2 = decode(itn2); tr_load(nx2, lane, ra); }
                tr_finish(nx, lane, rb, scr);
                if (!hn2) break;
                cur = nx2; it = itn2;
            }
        }
    }
}

__device__ __forceinline__ void row_load(const float* rowp, int lane, f32x4 (&v)[4]) {
#pragma unroll
    for (int j = 0; j < 4; ++j) v[j] = *(const f32x4*)(rowp + 256 * j + 4 * lane);
}
__device__ __forceinline__ void row_load_bf16(const bf16_t* rowp, int lane, f32x4 (&v)[4]) {
#pragma unroll
    for (int j = 0; j < 4; ++j) { const u32x2 w = *(const u32x2*)(rowp + 256 * j + 4 * lane); v[j] = (f32x4){bf_lo(w.x), bf_hi(w.x), bf_lo(w.y), bf_hi(w.y)}; }
}
__device__ __forceinline__ void row_store(float* rowp, int lane, const f32x4 (&v)[4]) {
#pragma unroll
    for (int j = 0; j < 4; ++j) *(f32x4*)(rowp + 256 * j + 4 * lane) = v[j];
}
__device__ __forceinline__ void row_store_bf16(bf16_t* rowp, int lane, const f32x4 (&v)[4]) {
#pragma unroll
    for (int j = 0; j < 4; ++j) { u32x2 o; o.x = pk2(v[j][0], v[j][1]); o.y = pk2(v[j][2], v[j][3]); *(u32x2*)(rowp + 256 * j + 4 * lane) = o; }
}
__device__ __forceinline__ void row_normalize(f32x4 (&v)[4]) {
    float s = 0.f;
#pragma unroll
    for (int j = 0; j < 4; ++j) s += (v[j][0] + v[j][1]) + (v[j][2] + v[j][3]);
    const float mean = wave_sum(s) * (1.f / DM);
    float q = 0.f;
#pragma unroll
    for (int j = 0; j < 4; ++j) { v[j] = v[j] - mean; q += (v[j][0] * v[j][0] + v[j][1] * v[j][1]) + (v[j][2] * v[j][2] + v[j][3] * v[j][3]); }
    const float rstd = 1.f / sqrtf(wave_sum(q) * (1.f / DM) + LN_EPS);
#pragma unroll
    for (int j = 0; j < 4; ++j) v[j] = v[j] * rstd;
}
__device__ __forceinline__ void row_modulate(f32x4 (&v)[4], const float* sh, const float* sc, int lane) {
#pragma unroll
    for (int j = 0; j < 4; ++j) { const f32x4 a = *(const f32x4*)(sc + 256 * j + 4 * lane), b = *(const f32x4*)(sh + 256 * j + 4 * lane); v[j] = v[j] * (a + 1.f) + b; }
}
__device__ __forceinline__ void row_affine(f32x4 (&v)[4], const float* g, const float* bb, int lane) {
#pragma unroll
    for (int j = 0; j < 4; ++j) { const f32x4 a = *(const f32x4*)(g + 256 * j + 4 * lane), b = *(const f32x4*)(bb + 256 * j + 4 * lane); v[j] = v[j] * a + b; }
}
__device__ __forceinline__ void row_modulate_l(f32x4 (&v)[4], const LAS float* sh, const LAS float* sc, int lane) {
#pragma unroll
    for (int j = 0; j < 4; ++j) { const f32x4 a = *(const LAS f32x4*)(sc + 256 * j + 4 * lane), b = *(const LAS f32x4*)(sh + 256 * j + 4 * lane); v[j] = v[j] * (a + 1.f) + b; }
}
__device__ __forceinline__ void row_affine_l(f32x4 (&v)[4], const LAS float* g, const LAS float* bb, int lane) {
#pragma unroll
    for (int j = 0; j < 4; ++j) { const f32x4 a = *(const LAS f32x4*)(g + 256 * j + 4 * lane), b = *(const LAS f32x4*)(bb + 256 * j + 4 * lane); v[j] = v[j] * a + b; }
}
__device__ __forceinline__ int row_modrow(int row) { return row < NLAT ? (row >> 13) : 4; }
__device__ __forceinline__ void lds_fill(LAS float* dst, const float* src, int n, int tid) { for (int i = tid * 4; i < n; i += NTHREADS * 4) *(LAS f32x4*)(dst + i) = *(const f32x4*)(src + i); }

__device__ __forceinline__ void phase_ln1(const Params& p, int bid, int nb) {
    bid = opaque_s(bid); const int tid = opaque_tid(), lane = tid & 63, gw = bid * NWAVES + (tid >> 6), NGW = nb * NWAVES;
    bf16_t* HB = (bf16_t*)(p.ws + WS_HB);
    f32x4 v[4], vn[4];
    if (gw < NROWS) row_load(gw < NLAT ? p.x + (size_t)gw * DM : p.ctx + (size_t)(gw - NLAT) * DM, lane, v);
#pragma unroll 1
    for (int row = gw; row < NROWS; row += NGW) {
        const int rn = row + NGW;
        if (rn < NROWS) row_load(rn < NLAT ? p.x + (size_t)rn * DM : p.ctx + (size_t)(rn - NLAT) * DM, lane, vn);
        row_normalize(v);
        const float* m = mod_ptr(p, 0, row_modrow(row)); row_modulate(v, m, m + DM, lane);
        row_store_bf16(HB + (size_t)row * DM, lane, v);
#pragma unroll
        for (int j = 0; j < 4; ++j) v[j] = vn[j];
    }
}

struct SgDesc { const bf16_t* A; int lda; const int* rowidx; const bf16_t* Bt; size_t grp_stride; int rows_per_grp, ngrp; int M, N, K; int row_base; };
template <class Epi>
__device__ __forceinline__ void sg_gemm(const SgDesc& g, const Epi& E, LAS unsigned char* lds, int bid, int nb) {
    bid = opaque_s(bid); const int tid = opaque_tid(); const int lane = tid & 63, w = __builtin_amdgcn_readfirstlane(tid >> 6), fr = lane & 15, fq = lane >> 4, wm = w >> 1, wn = w & 1;
    const int tilesN = g.N / 128, tiles = (g.M / 128) * tilesN, nk = g.K / 64;
    const int sr = tid >> 3, sp = tid & 7;
    const int soff = sr * 128 + ((sp ^ ((sr >> 1) & 7)) << 4);
    int aoff[2][2], boff[4][2];
#pragma unroll
    for (int ks = 0; ks < 2; ++ks) {
#pragma unroll
        for (int i = 0; i < 2; ++i) { const int r = 32 * wm + 16 * i + fr; aoff[i][ks] = r * 128 + (((fq + 4 * ks) ^ ((r >> 1) & 7)) << 4); }
#pragma unroll
        for (int n = 0; n < 4; ++n) { const int r = 64 * (n >> 1) + 32 * wn + 16 * (n & 1) + fr; boff[n][ks] = 16384 + r * 128 + (((fq + 4 * ks) ^ ((r >> 1) & 7)) << 4); }
    }
#pragma unroll 1
    for (int t = bid; t < tiles; t += nb) {
        const int tm = t / tilesN, tn = t % tilesN, pn = tn >> 1, wp = tn & 1;
        const int row0 = tm * 128;
        const bf16_t* Bt = g.Bt + (size_t)((row0 / g.rows_per_grp) % g.ngrp) * g.grp_stride;
        const bf16_t* as[2]; const bf16_t* bs[2];
#pragma unroll
        for (int h = 0; h < 2; ++h) { const int r = row0 + sr + 64 * h; const int ar = g.rowidx ? g.rowidx[r] : r; as[h] = g.A + (size_t)ar * g.lda + sp * 8;
            bs[h] = Bt + (size_t)(256 * pn + 128 * h + 64 * wp + sr) * g.K + sp * 8; }
        f32x4 acc[2][4];
#pragma unroll
        for (int i = 0; i < 2; ++i)
#pragma unroll
            for (int n = 0; n < 4; ++n) acc[i][n] = (f32x4){0.f, 0.f, 0.f, 0.f};
        u32x4 ra[2], rb[2];
#pragma unroll
        for (int h = 0; h < 2; ++h) { ra[h] = *(const u32x4*)(as[h]); rb[h] = *(const u32x4*)(bs[h]); }
#pragma unroll
        for (int h = 0; h < 2; ++h) { *(LAS u32x4*)(lds + soff + h * 8192) = ra[h]; *(LAS u32x4*)(lds + 16384 + soff + h * 8192) = rb[h]; }
        __syncthreads();
#pragma unroll 1
        for (int k = 0; k < nk; ++k) {
            const LAS unsigned char* buf = lds + (k & 1) * 32768;
            if (k + 1 < nk) {
#pragma unroll
                for (int h = 0; h < 2; ++h) { ra[h] = *(const u32x4*)(as[h] + (k + 1) * 64); rb[h] = *(const u32x4*)(bs[h] + (k + 1) * 64); } }
#pragma unroll
            for (int ks = 0; ks < 2; ++ks) {
                bf16x8 a[2], b[4];
#pragma unroll
                for (int i = 0; i < 2; ++i) a[i] = *(const LAS bf16x8*)(buf + aoff[i][ks]);
#pragma unroll
                for (int n = 0; n < 4; ++n) b[n] = *(const LAS bf16x8*)(buf + boff[n][ks]);
#pragma unroll
                for (int i = 0; i < 2; ++i)
#pragma unroll
                    for (int n = 0; n < 4; ++n) acc[i][n] = __builtin_amdgcn_mfma_f32_16x16x32_bf16(b[n], a[i], acc[i][n], 0, 0, 0);
            }
            if (k + 1 < nk) { LAS unsigned char* nbuf = lds + ((k + 1) & 1) * 32768;
#pragma unroll
                for (int h = 0; h < 2; ++h) { *(LAS u32x4*)(nbuf + soff + h * 8192) = ra[h]; *(LAS u32x4*)(nbuf + 16384 + soff + h * 8192) = rb[h]; } }
            __syncthreads();
        }
#pragma unroll
        for (int i = 0; i < 2; ++i) {
            const int row = g.row_base + row0 + 32 * wm + 16 * i + fr; const float rv = E.rowval(row);
            E(row, pn, 2 * wp + wn, fq, acc[i][0], acc[i][1], acc[i][2], acc[i][3], rv);
        }
    }
}

__device__ __forceinline__ void store_bf16x8(bf16_t* p, const f32x4 a, const f32x4 b) { u32x4 o; o.x = pk2(a[0], a[1]); o.y = pk2(a[2], a[3]); o.z = pk2(b[0], b[1]); o.w = pk2(b[2], b[3]); *(u32x4*)p = o; }
__device__ __forceinline__ int epi_col(int pn, int wc, int fq) { return 256 * pn + 64 * wc + 32 * (fq >> 1) + 8 * (fq & 1); }

__device__ __forceinline__ u32x4 pack_bf16x8(const f32x4 a, const f32x4 b) { u32x4 o; o.x = pk2(a[0], a[1]); o.y = pk2(a[2], a[3]); o.z = pk2(b[0], b[1]); o.w = pk2(b[2], b[3]); return o; }
struct EpiQKV {
    static constexpr bool STAGED = true;
    bf16_t* PB; const float* rope; bf16_t* KV;
    __device__ __forceinline__ float rowval(int) const { return 0.f; }
    __device__ __forceinline__ void vals(int row, int pn, int wc, int fq, f32x4 a0, f32x4 a1, f32x4 b0, f32x4 b1, float, u32x4& ra, u32x4& rb) const {
        const int c = epi_col(pn, wc, fq);
        if (c < 512 && row < NLAT) {
            const int t = row & (SEQ - 1); const int pos = (fq >> 1) ? (t & 63) : (t >> 6);
            const f32x4* rp = (const f32x4*)(rope + (pos * 16 + 8 * (fq & 1)) * 2);
            const f32x4 r0 = rp[0], r1 = rp[1], r2 = rp[2], r3 = rp[3];
            const f32x4 cs0 = {r0[0], r0[2], r1[0], r1[2]}, sn0 = {r0[1], r0[3], r1[1], r1[3]}, cs1 = {r2[0], r2[2], r3[0], r3[2]}, sn1 = {r2[1], r2[3], r3[1], r3[3]};
            const f32x4 na0 = a0 * cs0 - b0 * sn0, nb0 = b0 * cs0 + a0 * sn0, na1 = a1 * cs1 - b1 * sn1, nb1 = b1 * cs1 + a1 * sn1;
            a0 = na0; b0 = nb0; a1 = na1; b1 = nb1;
        }
        ra = pack_bf16x8(a0, a1); rb = pack_bf16x8(b0, b1);
    }
    __device__ __forceinline__ bf16_t* ptr(int row, int c) const {
        const bool isk = (c >= C_KA && c < C_BX) || c >= C_KN;
        if (isk) {
            const int hd = c < C_BX ? ((c - C_KA) >> 6) & 1 : 2 + ((c - C_KN) >> 6) % 6, isv = c < C_BX ? (c >= C_VA) : (c >= C_VN);
            const int bb = row < NLAT ? row >> 13 : (row - NLAT) >> 8, tok = row < NLAT ? row & (SEQ - 1) : SEQ + ((row - NLAT) & (CTXL - 1));
            return KV + ((size_t)(bb * 8 + hd) * KV_TOK + tok) * 128 + isv * 64 + (c & 63);
        }
        return PB + (size_t)row * INW + c;
    }
    __device__ __forceinline__ void operator()(int row, int pn, int wc, int fq, f32x4 a0, f32x4 a1, f32x4 b0, f32x4 b1, float rv) const {
        u32x4 ra, rb; vals(row, pn, wc, fq, a0, a1, b0, b1, rv, ra, rb); const int c = epi_col(pn, wc, fq); *(u32x4*)ptr(row, c) = ra; *(u32x4*)ptr(row, c + 16) = rb; }
};
template <bool FIRST> struct EpiOut {
    static constexpr bool STAGED = true;
    const float* xl; const float* xc; bf16_t* XB; const float* mod;
    __device__ __forceinline__ float rowval(int) const { return 0.f; }
    __device__ __forceinline__ void vals(int row, int pn, int wc, int fq, f32x4 a0, f32x4 a1, f32x4 b0, f32x4 b1, float, u32x4& ra, u32x4& rb) const {
        const int c = epi_col(pn, wc, fq); const bf16_t* xo = XB + (size_t)row * DM + c;
        const float* g1 = mod + (size_t)row_modrow(row) * NMOD + 2 * DM + c;
        f32x4 xa0, xa1, xb0, xb1;
        if (FIRST) { const float* xin = row < NLAT ? xl + (size_t)row * DM + c : xc + (size_t)(row - NLAT) * DM + c;
            xa0 = *(const f32x4*)xin; xa1 = *(const f32x4*)(xin + 4); xb0 = *(const f32x4*)(xin + 16); xb1 = *(const f32x4*)(xin + 20); }
        else { const u32x4 wa = *(const u32x4*)xo, wb = *(const u32x4*)(xo + 16);
            xa0 = (f32x4){bf_lo(wa.x), bf_hi(wa.x), bf_lo(wa.y), bf_hi(wa.y)}; xa1 = (f32x4){bf_lo(wa.z), bf_hi(wa.z), bf_lo(wa.w), bf_hi(wa.w)};
            xb0 = (f32x4){bf_lo(wb.x), bf_hi(wb.x), bf_lo(wb.y), bf_hi(wb.y)}; xb1 = (f32x4){bf_lo(wb.z), bf_hi(wb.z), bf_lo(wb.w), bf_hi(wb.w)}; }
        const f32x4 ga0 = *(const f32x4*)g1, ga1 = *(const f32x4*)(g1 + 4), gb0 = *(const f32x4*)(g1 + 16), gb1 = *(const f32x4*)(g1 + 20);
        ra = pack_bf16x8(xa0 * ALPHA + ga0 * a0, xa1 * ALPHA + ga1 * a1); rb = pack_bf16x8(xb0 * ALPHA + gb0 * b0, xb1 * ALPHA + gb1 * b1);
    }
    __device__ __forceinline__ bf16_t* ptr(int row, int c) const { return XB + (size_t)row * DM + c; }
    __device__ __forceinline__ void operator()(int row, int pn, int wc, int fq, f32x4 a0, f32x4 a1, f32x4 b0, f32x4 b1, float rv) const {
        u32x4 ra, rb; vals(row, pn, wc, fq, a0, a1, b0, b1, rv, ra, rb); const int c = epi_col(pn, wc, fq); *(u32x4*)ptr(row, c) = ra; *(u32x4*)ptr(row, c + 16) = rb; }
};
struct EpiGU {
    static constexpr bool STAGED = false;
    bf16_t* HH;
    __device__ __forceinline__ float rowval(int) const { return 0.f; }
    __device__ __forceinline__ void operator()(int row, int pn, int wc, int fq, f32x4 a0, f32x4 a1, f32x4 b0, f32x4 b1, float) const {
        f32x4 h0, h1;
#pragma unroll
        for (int j = 0; j < 4; ++j) { h0[j] = a0[j] * __builtin_amdgcn_rcpf(1.f + __expf(-a0[j])) * b0[j]; h1[j] = a1[j] * __builtin_amdgcn_rcpf(1.f + __expf(-a1[j])) * b1[j]; }
        store_bf16x8(HH + (size_t)row * FF + 128 * pn + 32 * wc + 8 * fq, h0, h1);
    }
};
struct EpiDown {
    static constexpr bool STAGED = true;
    bf16_t* Y; const float* gate;
    __device__ __forceinline__ float rowval(int row) const { return gate[row]; }
    __device__ __forceinline__ void vals(int, int, int, int, f32x4 a0, f32x4 a1, f32x4 b0, f32x4 b1, float g, u32x4& ra, u32x4& rb) const { ra = pack_bf16x8(a0 * g, a1 * g); rb = pack_bf16x8(b0 * g, b1 * g); }
    __device__ __forceinline__ bf16_t* ptr(int row, int c) const { return Y + (size_t)row * DM + c; }
    __device__ __forceinline__ void operator()(int row, int pn, int wc, int fq, f32x4 a0, f32x4 a1, f32x4 b0, f32x4 b1, float g) const {
        u32x4 ra, rb; vals(row, pn, wc, fq, a0, a1, b0, b1, g, ra, rb); const int c = epi_col(pn, wc, fq); *(u32x4*)ptr(row, c) = ra; *(u32x4*)ptr(row, c + 16) = rb; }
};

namespace mg {
constexpr int BM = 256, BK = 64, HALF = 128, HTB = HALF * BK * 2, STAGE_BYTES = 8 * HTB, NXCD = 8, WGM = 8, MAXU = 8;
__device__ __forceinline__ int lds_byte(int r, int c) { const int st = (r >> 4) * 2 + (c >> 5), rr = r & 15, cc = c & 31, ob = rr * 64 + cc * 2; return st * 1024 + (ob ^ (((ob >> 9) & 1) << 5)); }
__device__ __forceinline__ void stage_rc(int b, int& R, int& C) { const int st = b / 1024, sb = b % 1024, swz = sb ^ (((sb >> 9) & 1) << 5); R = (st >> 1) * 16 + swz / 64; C = (st & 1) * 32 + (swz % 64) / 2; }
struct Unit { int pm, pn; };
struct Gemm { const bf16_t* A; const bf16_t* Bt; int M, N, K; const int* rowidx; size_t grp_stride; int grp_tiles, ngrp; };
struct StaticOrder {
    int nM, nN, nwg, G, c;
    __device__ void init(int M, int N, int G_, int c_) { nM = M / BM; nN = N / BM; nwg = nM * nN; G = G_; c = c_; }
    __device__ bool next(int i, Unit& u) const {
        const long L = (long)i * G + c; if (L >= nwg) return false;
        int wgid = (int)L; { const int q = nwg / NXCD, r = nwg % NXCD, xcd = wgid % NXCD, off = wgid / NXCD; wgid = (xcd < r ? xcd * (q + 1) : r * (q + 1) + (xcd - r) * q) + off; }
        const int nig = WGM * nN, gid = wgid / nig, fm = gid * WGM, gsz = (nM - fm) < WGM ? (nM - fm) : WGM;
        u.pm = fm + ((wgid % nig) % gsz); u.pn = (wgid % nig) / gsz; return true;
    }
};
template <class Epi>
__device__ __forceinline__ void gemm_phase(LAS unsigned char* lds, LAS int* idxl, const Gemm g, const StaticOrder& S, const Epi& E) {
    const int tid = opaque_tid(), wid = __builtin_amdgcn_readfirstlane(tid >> 6), lane = tid & 63, wr = wid >> 2, wc = wid & 3, fr = lane & 15, fq = lane >> 4;
    const int K = g.K, nt = K / BK;
    unsigned voffB[2];
#pragma unroll
    for (int i = 0; i < 2; ++i) { int R_, C_; stage_rc(tid * 16 + i * 8192, R_, C_); voffB[i] = (unsigned)(R_ * K + C_) * 2u; }
    const size_t kstep = (size_t)(BK * 2);
    const size_t hstep = (size_t)HALF * K * 2;
    const size_t tstep = 2 * hstep;
    const unsigned ldsw = (unsigned)wid * 1024u;
    const int aoff = lds_byte(wr * 64 + fr, fq * 8), boff = lds_byte(wc * 32 + fr, fq * 8);
    Unit cur, nxt; int ui = 0;
    if (!S.next(0, cur)) return;
#ifndef MG_STAGGER_TICKS
#define MG_STAGGER_TICKS 0
#endif
    if (MG_STAGGER_TICKS && (blockIdx.x & 8)) { const unsigned long long t0 = __builtin_amdgcn_s_memrealtime(); while (__builtin_amdgcn_s_memrealtime() - t0 < MG_STAGGER_TICKS) __builtin_amdgcn_s_sleep(16); }
    if (g.rowidx) {
        for (int i = 0; i < MAXU; ++i) { Unit u; if (!S.next(i, u)) break; if (tid < 256) idxl[i * 256 + tid] = g.rowidx[u.pm * BM + tid]; }
        asm volatile("s_waitcnt vmcnt(0) lgkmcnt(0)" ::: "memory"); __builtin_amdgcn_s_barrier(); asm volatile("" ::: "memory");
    }
#define MG_AOFFS(dst, u_, ui_) do { _Pragma("unroll") for (int i_ = 0; i_ < 2; ++i_) { int R_, C_; stage_rc(tid * 16 + i_ * 8192, R_, C_); _Pragma("unroll") for (int h_ = 0; h_ < 2; ++h_) { \
        const int rr_ = g.rowidx ? idxl[(ui_) * 256 + h_ * HALF + R_] : ((u_).pm * BM + h_ * HALF + R_); dst[h_][i_] = (unsigned)(rr_ * K + C_) * 2u; } } } while (0)
#define MG_BPTR(u_) ((const char*)g.Bt + ((size_t)(((u_).pm / g.grp_tiles) % g.ngrp) * g.grp_stride) * 2 + (size_t)(u_).pn * tstep)
#define PG8_SA(b, h) (((b) * 2 + (h)) * HTB)
#define PG8_SB(b, h) ((4 + (b) * 2 + (h)) * HTB)
#define PG8_STAGE(bufoff, gbase, voff) do { _Pragma("unroll") for (int _i = 0; _i < 2; ++_i) \
        __builtin_amdgcn_global_load_lds((const unsigned*)((const char*)(gbase) + (voff)[_i]), (LAS unsigned*)(lds + (bufoff) + ldsw + _i * 8192), 16, 0, 0); } while (0)
#define PG8_LDA(dst, b, h) do { _Pragma("unroll") for (int m = 0; m < 4; ++m) _Pragma("unroll") for (int k = 0; k < 2; ++k) dst[m][k] = *(const LAS bf16x8*)(lds + PG8_SA(b, h) + aoff + m * 2048 + k * 1024); } while (0)
#define PG8_LDB(dst, b, h) do { _Pragma("unroll") for (int n = 0; n < 2; ++n) _Pragma("unroll") for (int k = 0; k < 2; ++k) dst[n][k] = *(const LAS bf16x8*)(lds + PG8_SB(b, h) + boff + n * 2048 + k * 1024); } while (0)
#define PG8_MMA(ai, bj, At, Bt) do { __builtin_amdgcn_s_setprio(1); _Pragma("unroll") for (int m = 0; m < 4; ++m) _Pragma("unroll") for (int n = 0; n < 2; ++n) _Pragma("unroll") for (int k = 0; k < 2; ++k) \
        acc[ai][bj][m][n] = __builtin_amdgcn_mfma_f32_16x16x32_bf16(Bt[n][k], At[m][k], acc[ai][bj][m][n], 0, 0, 0); __builtin_amdgcn_s_setprio(0); } while (0)
#define PG8_WAIT_V(n) asm volatile("s_waitcnt vmcnt(" #n ")" ::: "memory")
#define PG8_WAIT_L(n) asm volatile("s_waitcnt lgkmcnt(" #n ")" ::: "memory")
#define PG8_BAR __builtin_amdgcn_s_barrier()
#define PG8_SCHED __builtin_amdgcn_sched_barrier(0)
    f32x4 acc[2][2][4][2];
#pragma unroll
    for (int a = 0; a < 2; ++a)
#pragma unroll
        for (int b = 0; b < 2; ++b)
#pragma unroll
            for (int m = 0; m < 4; ++m)
#pragma unroll
                for (int n = 0; n < 2; ++n) acc[a][b][m][n] = (f32x4){0.f, 0.f, 0.f, 0.f};
    bf16x8 At[4][2], B0[2][2], B1[2][2];
    unsigned cAo[2][2], o2[2][2];
    MG_AOFFS(cAo, cur, 0);
    const char* const Abase = (const char*)g.A;
    const char* cB = MG_BPTR(cur);
    PG8_STAGE(PG8_SB(0, 0), cB, voffB); PG8_STAGE(PG8_SB(0, 1), cB + hstep, voffB); PG8_STAGE(PG8_SA(0, 0), Abase, cAo[0]); PG8_STAGE(PG8_SA(0, 1), Abase, cAo[1]);
    if (wr == 1) PG8_BAR;
    PG8_WAIT_V(2); PG8_BAR;
    PG8_STAGE(PG8_SB(1, 0), cB + kstep, voffB); PG8_STAGE(PG8_SA(1, 0), Abase + kstep, cAo[0]); PG8_STAGE(PG8_SB(1, 1), cB + hstep + kstep, voffB);
    PG8_WAIT_V(6); PG8_BAR;
    for (;;) {
        const bool has_next = S.next(ui + 1, nxt);
        const char* nB = has_next ? MG_BPTR(nxt) : cB;
        for (int t = 0; t < nt; t += 2) {
            const bool last = (t == nt - 2);
            const char* a1 = Abase + (size_t)(t + 1) * kstep;
            const char* a2 = last ? Abase : Abase + (size_t)(t + 2) * kstep; const char* b2 = last ? nB : cB + (size_t)(t + 2) * kstep;
            const char* a3 = a2 + kstep; const char* b3 = b2 + kstep;
            if (last && has_next) { MG_AOFFS(o2, nxt, ui + 1); } else {
#pragma unroll
                for (int h = 0; h < 2; ++h)
#pragma unroll
                    for (int i = 0; i < 2; ++i) o2[h][i] = cAo[h][i]; }
            PG8_LDB(B0, 0, 0); PG8_LDB(B1, 0, 1); PG8_SCHED; PG8_LDA(At, 0, 0); PG8_STAGE(PG8_SA(1, 1), a1, cAo[1]);
            PG8_WAIT_V(8); PG8_WAIT_L(0); PG8_BAR; PG8_MMA(0, 0, At, B0); PG8_MMA(0, 1, At, B1); PG8_BAR; PG8_SCHED;
            PG8_LDA(At, 0, 1); PG8_STAGE(PG8_SB(0, 0), b2, voffB); PG8_STAGE(PG8_SB(0, 1), b2 + hstep, voffB); PG8_STAGE(PG8_SA(0, 0), a2, o2[0]);
            PG8_WAIT_V(8); PG8_WAIT_L(0); PG8_BAR; PG8_MMA(1, 0, At, B0); PG8_MMA(1, 1, At, B1); PG8_BAR; PG8_SCHED;
            PG8_LDB(B0, 1, 0); PG8_LDB(B1, 1, 1); PG8_SCHED; PG8_LDA(At, 1, 0); PG8_STAGE(PG8_SA(0, 1), a2, o2[1]);
            PG8_WAIT_V(8); PG8_WAIT_L(0); PG8_BAR; PG8_MMA(0, 0, At, B0); PG8_MMA(0, 1, At, B1); PG8_BAR; PG8_SCHED;
            PG8_LDA(At, 1, 1); PG8_STAGE(PG8_SB(1, 0), b3, voffB); PG8_STAGE(PG8_SB(1, 1), b3 + hstep, voffB); PG8_STAGE(PG8_SA(1, 0), a3, o2[0]);
            PG8_WAIT_V(8); PG8_WAIT_L(0); PG8_BAR; PG8_MMA(1, 0, At, B0); PG8_MMA(1, 1, At, B1); PG8_BAR; PG8_SCHED;
        }
        if (wr == 0) PG8_BAR;
        E(acc, cur, wr, wc, fr, fq);
        if (!has_next) break;
#pragma unroll
        for (int a = 0; a < 2; ++a)
#pragma unroll
            for (int b = 0; b < 2; ++b)
#pragma unroll
                for (int m = 0; m < 4; ++m)
#pragma unroll
                    for (int n = 0; n < 2; ++n) acc[a][b][m][n] = (f32x4){0.f, 0.f, 0.f, 0.f};
        cur = nxt; cB = nB; ++ui;
#pragma unroll
        for (int h = 0; h < 2; ++h)
#pragma unroll
            for (int i = 0; i < 2; ++i) cAo[h][i] = o2[h][i];
        if (wr == 1) PG8_BAR;
    }
    PG8_WAIT_V(0);
    PG8_BAR;
#undef MG_AOFFS
#undef MG_BPTR
#undef PG8_SA
#undef PG8_SB
#undef PG8_STAGE
#undef PG8_LDA
#undef PG8_LDB
#undef PG8_MMA
#undef PG8_WAIT_V
#undef PG8_WAIT_L
#undef PG8_BAR
#undef PG8_SCHED
}
template <class EE> struct EpiAdapt {
    EE e; int row_base; LAS unsigned char* stg;
    __device__ __forceinline__ void operator()(const f32x4 (&acc)[2][2][4][2], const Unit& u, int wr, int wc, int fr, int fq) const {
        float rv[2][4];
#pragma unroll
        for (int ai = 0; ai < 2; ++ai)
#pragma unroll
            for (int m = 0; m < 4; ++m) rv[ai][m] = e.rowval(row_base + u.pm * BM + ai * HALF + wr * 64 + m * 16 + fr);
        if constexpr (EE::STAGED) {
            LAS unsigned char* T = stg + (4 * wr + wc) * STG_WAVE; const int lane = 16 * fq + fr;
            LAS unsigned char* wp = T + fr * 144 + 64 * (fq >> 1) + 16 * (fq & 1); const LAS unsigned char* rp = T + (lane >> 3) * 144 + (lane & 7) * 16;
            const int cb = u.pn * BM + 64 * wc + 8 * (lane & 7);
#pragma unroll
            for (int ai = 0; ai < 2; ++ai)
#pragma unroll
                for (int m = 0; m < 4; ++m) { const int row0 = row_base + u.pm * BM + ai * HALF + wr * 64 + m * 16;
                    u32x4 ra, rb; e.vals(row0 + fr, u.pn, wc, fq, acc[ai][0][m][0], acc[ai][0][m][1], acc[ai][1][m][0], acc[ai][1][m][1], rv[ai][m], ra, rb);
                    asm volatile("" ::: "memory");
                    *(LAS u32x4*)wp = ra; *(LAS u32x4*)(wp + 32) = rb;
                    asm volatile("s_waitcnt lgkmcnt(0)" ::: "memory");
                    const u32x4 v0 = *(const LAS u32x4*)rp, v1 = *(const LAS u32x4*)(rp + 8 * 144);
                    *(u32x4*)e.ptr(row0 + (lane >> 3), cb) = v0; *(u32x4*)e.ptr(row0 + 8 + (lane >> 3), cb) = v1;
                    asm volatile("" ::: "memory"); }
        } else {
#pragma unroll
            for (int ai = 0; ai < 2; ++ai)
#pragma unroll
                for (int m = 0; m < 4; ++m) { const int row = row_base + u.pm * BM + ai * HALF + wr * 64 + m * 16 + fr;
                    e(row, u.pn, wc, fq, acc[ai][0][m][0], acc[ai][0][m][1], acc[ai][1][m][0], acc[ai][1][m][1], rv[ai][m]);
                    if (m & 1) asm volatile("" ::: "memory"); }
        }
    }
};
}

struct AttnState { float m, l; float o[32]; };
__device__ __forceinline__ void attn_init(AttnState& st) { st.m = -INFINITY; st.l = 0.f;
#pragma unroll
    for (int d = 0; d < 32; ++d) st.o[d] = 0.f; }
__device__ __forceinline__ void load_row32(const bf16_t* p, float (&r)[32], float scale) {
#pragma unroll
    for (int i = 0; i < 4; ++i) { const u32x4 w = *(const u32x4*)(p + 8 * i);
        r[8 * i + 0] = bf_lo(w.x) * scale; r[8 * i + 1] = bf_hi(w.x) * scale; r[8 * i + 2] = bf_lo(w.y) * scale; r[8 * i + 3] = bf_hi(w.y) * scale;
        r[8 * i + 4] = bf_lo(w.z) * scale; r[8 * i + 5] = bf_hi(w.z) * scale; r[8 * i + 6] = bf_lo(w.w) * scale; r[8 * i + 7] = bf_hi(w.w) * scale; }
}
__device__ __forceinline__ float dot_row32(const bf16_t* p, const float (&q)[32]) {
    float d0 = 0.f, d1 = 0.f;
#pragma unroll
    for (int i = 0; i < 4; ++i) { const u32x4 w = *(const u32x4*)(p + 8 * i);
        d0 += q[8 * i + 0] * bf_lo(w.x); d1 += q[8 * i + 1] * bf_hi(w.x); d0 += q[8 * i + 2] * bf_lo(w.y); d1 += q[8 * i + 3] * bf_hi(w.y);
        d0 += q[8 * i + 4] * bf_lo(w.z); d1 += q[8 * i + 5] * bf_hi(w.z); d0 += q[8 * i + 6] * bf_lo(w.w); d1 += q[8 * i + 7] * bf_hi(w.w); }
    const float d = d0 + d1;
    return d + __shfl_xor(d, 32);
}
__device__ __forceinline__ void axpy_row32(const bf16_t* p, float a, float (&o)[32]) {
#pragma unroll
    for (int i = 0; i < 4; ++i) { const u32x4 w = *(const u32x4*)(p + 8 * i);
        o[8 * i + 0] += a * bf_lo(w.x); o[8 * i + 1] += a * bf_hi(w.x); o[8 * i + 2] += a * bf_lo(w.y); o[8 * i + 3] += a * bf_hi(w.y);
        o[8 * i + 4] += a * bf_lo(w.z); o[8 * i + 5] += a * bf_hi(w.z); o[8 * i + 6] += a * bf_lo(w.w); o[8 * i + 7] += a * bf_hi(w.w); }
}
template <class ScoreFn>
__device__ __forceinline__ void attn_segment(const float (&q)[32], AttnState& st, const bf16_t* Kb, const bf16_t* Vb, int j0, int j1, ScoreFn sf) {
#pragma unroll 1
    for (int j = j0; j < j1; ++j) {
        const float s0 = sf(j, dot_row32(Kb + (size_t)j * INW, q));
        if (s0 > st.m) { const float corr = __expf(st.m - s0); st.l *= corr;
#pragma unroll
            for (int d = 0; d < 32; ++d) st.o[d] *= corr;
            st.m = s0; }
        const float p0 = (s0 == -INFINITY) ? 0.f : __expf(s0 - st.m);
        st.l += p0;
        axpy_row32(Vb + (size_t)j * INW, p0, st.o);
    }
}
__device__ __forceinline__ void attn_sink(AttnState& st, float sk) {
    if (sk > st.m) { const float corr = __expf(st.m - sk); st.l *= corr;
#pragma unroll
        for (int d = 0; d < 32; ++d) st.o[d] *= corr;
        st.m = sk; }
    st.l += __expf(sk - st.m);
}
__device__ __forceinline__ void attn_store(const AttnState& st, bf16_t* o) {
    const float inv = 1.f / st.l;
#pragma unroll
    for (int i = 0; i < 4; ++i) { u32x4 w; w.x = pk2(st.o[8 * i] * inv, st.o[8 * i + 1] * inv); w.y = pk2(st.o[8 * i + 2] * inv, st.o[8 * i + 3] * inv);
        w.z = pk2(st.o[8 * i + 4] * inv, st.o[8 * i + 5] * inv); w.w = pk2(st.o[8 * i + 6] * inv, st.o[8 * i + 7] * inv); *(u32x4*)(o + 8 * i) = w; }
}

__device__ __forceinline__ void phase_mixers(const Params& p, int l, bool with_ctx, int bid, int nb) {
    bid = opaque_s(bid); const int tid = opaque_tid(); const int lane = tid & 63, gw = bid * NWAVES + (tid >> 6), NGW = nb * NWAVES;
    const int ql = lane & 31, hf = lane >> 5;
    const bf16_t* PB = (const bf16_t*)(p.ws + WS_PB); bf16_t* OB = (bf16_t*)(p.ws + WS_OB);
    const float* sink = p.attn_sink + l * 6; const float* rpb = p.na_rpb + (size_t)l * 6 * 15 * 31;
#if !FAST_ATTN
#pragma unroll 1
    for (int it = gw; it < NB * 6 * 256; it += NGW) {
        const int chunk = it & 255, h = (it >> 8) % 6, b = it / (6 * 256), kvh = h / 3;
        const int t = chunk * 32 + ql; const size_t rowb = (size_t)b * SEQ;
        float q[32]; load_row32(PB + (rowb + t) * INW + C_QA + h * 64 + 32 * hf, q, 0.125f);
        AttnState st; attn_init(st);
        const int jlo = max(0, chunk * 32 - 128), jhi = min(SEQ, chunk * 32 + 32 + 128);
        attn_segment(q, st, PB + rowb * INW + C_KA + kvh * 64 + 32 * hf, PB + rowb * INW + C_VA + kvh * 64 + 32 * hf, jlo, jhi,
                     [&](int j, float d) { const int dt = t - j; return (dt <= 128 && dt >= -128) ? d : -INFINITY; });
        const size_t crow = (size_t)NLAT + (size_t)b * CTXL;
        attn_segment(q, st, PB + crow * INW + C_KA + kvh * 64 + 32 * hf, PB + crow * INW + C_VA + kvh * 64 + 32 * hf, 0, CTXL, [&](int, float d) { return d; });
        attn_sink(st, sink[h]);
        attn_store(st, OB + (rowb + t) * DM + h * 64 + 32 * hf);
    }
#pragma unroll 1
    for (int it = gw; it < NB * 6 * 256; it += NGW) {
        const int r = (it & 255) >> 1, ch = it & 1, h = (it >> 8) % 6, b = it / (6 * 256);
        const int cq = ch * 32 + ql; const size_t rowb = (size_t)b * SEQ; const int t = r * 64 + cq;
        float q[32]; load_row32(PB + (rowb + t) * INW + C_QN + h * 64 + 32 * hf, q, 0.125f);
        AttnState st; attn_init(st);
        const int rs = min(max(r - 4, 0), 128 - 8), cs = min(max(cq - 8, 0), 64 - 16);
        const float* bias = rpb + (size_t)h * 15 * 31;
        attn_segment(q, st, PB + (rowb + (size_t)rs * 64) * INW + C_KN + h * 64 + 32 * hf, PB + (rowb + (size_t)rs * 64) * INW + C_VN + h * 64 + 32 * hf, 0, 512,
                     [&](int j, float d) { const int ka = rs + (j >> 6), ck = j & 63; const bool ok = (ck >= cs) && (ck < cs + 16);
                                           const int ro = ka - r + 7, co = min(max(ck - cq, -15), 15) + 15; return ok ? d + bias[ro * 31 + co] : -INFINITY; });
        const size_t crow = (size_t)NLAT + (size_t)b * CTXL;
        attn_segment(q, st, PB + crow * INW + C_KN + h * 64 + 32 * hf, PB + crow * INW + C_VN + h * 64 + 32 * hf, 0, CTXL, [&](int, float d) { return d; });
        attn_store(st, OB + (rowb + t) * DM + 640 + h * 64 + 32 * hf);
    }
#endif
    {
        const float* cw = p.conv_w + (size_t)l * 3 * 256;
        const int nrows = with_ctx ? NROWS : NLAT;
        for (long e = (long)bid * NTHREADS + tid; e < (long)nrows * 32; e += (long)nb * NTHREADS) {
            const int row = (int)(e >> 5), ch = (int)(e & 31) * 8;
            const int tpos = row < NLAT ? (row & (SEQ - 1)) : ((row - NLAT) & (CTXL - 1)); const int tlen = row < NLAT ? SEQ : CTXL;
            const bf16_t* pr = PB + (size_t)row * INW;
            float u[3][8];
#pragma unroll
            for (int dlt = -1; dlt <= 1; ++dlt) {
                const bool ok = (tpos + dlt >= 0) && (tpos + dlt < tlen);
                if (ok) { const u32x4 a = *(const u32x4*)(pr + (long)dlt * INW + C_BX + ch), c = *(const u32x4*)(pr + (long)dlt * INW + C_BC + ch);
                    u[dlt + 1][0] = bf_lo(a.x) * bf_lo(c.x); u[dlt + 1][1] = bf_hi(a.x) * bf_hi(c.x); u[dlt + 1][2] = bf_lo(a.y) * bf_lo(c.y); u[dlt + 1][3] = bf_hi(a.y) * bf_hi(c.y);
                    u[dlt + 1][4] = bf_lo(a.z) * bf_lo(c.z); u[dlt + 1][5] = bf_hi(a.z) * bf_hi(c.z); u[dlt + 1][6] = bf_lo(a.w) * bf_lo(c.w); u[dlt + 1][7] = bf_hi(a.w) * bf_hi(c.w); }
                else {
#pragma unroll
                    for (int i = 0; i < 8; ++i) u[dlt + 1][i] = 0.f; }
            }
            const u32x4 gb = *(const u32x4*)(pr + C_BB + ch);
            const float g[8] = {bf_lo(gb.x), bf_hi(gb.x), bf_lo(gb.y), bf_hi(gb.y), bf_lo(gb.z), bf_hi(gb.z), bf_lo(gb.w), bf_hi(gb.w)};
            float y[8];
#pragma unroll
            for (int i = 0; i < 8; ++i) y[i] = g[i] * (u[0][i] * cw[ch + i] + u[1][i] * cw[256 + ch + i] + u[2][i] * cw[512 + ch + i]);
            u32x4 o; o.x = pk2(y[0], y[1]); o.y = pk2(y[2], y[3]); o.z = pk2(y[4], y[5]); o.w = pk2(y[6], y[7]);
            *(u32x4*)(OB + (size_t)row * DM + 384 + ch) = o;
        }
    }
#if !FAST_ATTN
    if (with_ctx) {
#pragma unroll 1
        for (int it = gw; it < 2 * NB * 6 * 8; it += NGW) {
            const int kind = it / (NB * 6 * 8), r = it % (NB * 6 * 8), chunk = r & 7, h = (r >> 3) % 6, b = r / 48;
            const size_t crow = (size_t)NLAT + (size_t)b * CTXL; const int tq = chunk * 32 + ql;
            const int qc = (kind == 0 ? C_QA + h * 64 : C_QN + h * 64) + 32 * hf, kc = (kind == 0 ? C_KA + (h / 3) * 64 : C_KN + h * 64) + 32 * hf, vc = (kind == 0 ? C_VA + (h / 3) * 64 : C_VN + h * 64) + 32 * hf;
            float q[32]; load_row32(PB + (crow + tq) * INW + qc, q, 0.125f);
            AttnState st; attn_init(st);
            attn_segment(q, st, PB + crow * INW + kc, PB + crow * INW + vc, 0, CTXL, [&](int, float d) { return d; });
            if (kind == 0) attn_sink(st, sink[h]);
            attn_store(st, OB + (crow + tq) * DM + (kind == 0 ? 0 : 640) + h * 64 + 32 * hf);
        }
    }
#endif
}

namespace fa {
typedef short v4i16_t __attribute__((ext_vector_type(4)));
typedef float f32x2_t __attribute__((ext_vector_type(2))); typedef __bf16 bf16x2_t __attribute__((ext_vector_type(2)));
__device__ __forceinline__ unsigned cvtpk(float lo, float hi) { f32x2_t v = {lo, hi}; bf16x2_t b = __builtin_convertvector(v, bf16x2_t); return __builtin_bit_cast(unsigned, b); }
constexpr float LOG2E = 1.4426950408889634f, SC = 0.125f * LOG2E;
constexpr int CHUNK_BYTES = 65536;
constexpr int BIAS_OFF = 2 * CHUNK_BYTES;
constexpr float THR = 8.f;
__device__ __forceinline__ int na_rs(int r) { return min(max(r - 4, 0), 128 - 8); }
__device__ __forceinline__ void glds16(const void* gsrc, unsigned lds_dst) { unsigned keep;
    asm volatile("s_mov_b32 %0, m0\n\ts_mov_b32 m0, %2\n\ts_nop 0\n\tglobal_load_lds_dwordx4 %1, off\n\ts_mov_b32 m0, %0" : "=&s"(keep) : "v"(gsrc), "s"(lds_dst) : "memory"); }
#define FA_WAIT_BAR(N) asm volatile("s_waitcnt vmcnt(" #N ") lgkmcnt(0)\n\ts_barrier" ::: "memory")
__device__ __forceinline__ float max3f(float a, float b, float c) { float r; asm("v_max3_f32 %0, %1, %2, %3" : "=v"(r) : "v"(a), "v"(b), "v"(c)); return r; }
__device__ __forceinline__ float max8f(const f32x4& a, const f32x4& b) { return max3f(max3f(max3f(a[0], a[1], a[2]), a[3], b[0]), max3f(b[1], b[2], b[3]), -INFINITY); }
typedef float f32x16 __attribute__((ext_vector_type(16)));
__device__ __forceinline__ float max16f(const f32x16& a) {
    float x = max3f(a[0], a[1], a[2]); x = max3f(x, a[3], a[4]); x = max3f(x, a[5], a[6]); x = max3f(x, a[7], a[8]); x = max3f(x, a[9], a[10]); x = max3f(x, a[11], a[12]); x = max3f(x, a[13], a[14]);
    return fmaxf(x, a[15]);
}
typedef float f32x2v __attribute__((ext_vector_type(2)));
template <int MODE>
__device__ __forceinline__ void unit32(f32x16 (&o)[2], float& m, float& ls, const bf16x8 (&q)[4], const LAS unsigned char* Kt0, const LAS unsigned char* Kt1, const LAS unsigned char* Vt0, const LAS unsigned char* Vt1,
                                       const int (&kb)[4], const int (&vb)[2], bool rel0, bool rel1, bool mk0, bool mk1, int tb0, int tb1, const f32x16& fmask, const LAS float* bp0, const LAS float* bp1) {
    f32x16 s[2]; float tm = -INFINITY;
#pragma unroll
    for (int t = 0; t < 2; ++t) {
        if (!(t == 0 ? rel0 : rel1)) continue;
        const LAS unsigned char* Kt = t == 0 ? Kt0 : Kt1;
        bf16x8 kf[4];
#pragma unroll
        for (int ks = 0; ks < 4; ++ks) kf[ks] = *(const LAS bf16x8*)(Kt + kb[ks]);
        f32x16 acc = __builtin_amdgcn_mfma_f32_32x32x16_bf16(kf[0], q[0], (f32x16){0.f, 0.f, 0.f, 0.f, 0.f, 0.f, 0.f, 0.f, 0.f, 0.f, 0.f, 0.f, 0.f, 0.f, 0.f, 0.f}, 0, 0, 0);
#pragma unroll
        for (int ks = 1; ks < 4; ++ks) acc = __builtin_amdgcn_mfma_f32_32x32x16_bf16(kf[ks], q[ks], acc, 0, 0, 0);
        if (MODE == 2) {
            const LAS float* bp = t == 0 ? bp0 : bp1;
#pragma unroll
            for (int r = 0; r < 16; ++r) acc[r] = __builtin_fmaf(acc[r], SC, bp[(r & 3) + 8 * (r >> 2)]) + fmask[r];
        } else {
            if (MODE == 1 && (t == 0 ? mk0 : mk1)) { const int tb = t == 0 ? tb0 : tb1;
#pragma unroll
                for (int r = 0; r < 16; ++r) acc[r] = ((unsigned)(tb - ((r & 3) + 8 * (r >> 2))) <= 256u) ? acc[r] : -INFINITY;
            } else asm volatile("s_nop 15\n\ts_nop 7" : "+v"(acc));
        }
        s[t] = acc;
        tm = fmaxf(tm, max16f(acc));
    }
    if (MODE != 2) tm *= SC;
    if (__any(tm > m + THR)) {
        const float mn = fmaxf(m, xor32_max(tm)), al = __builtin_amdgcn_exp2f(m - mn); m = mn; ls *= al;
#pragma unroll
        for (int d = 0; d < 2; ++d) o[d] = o[d] * al;
    }
    const float nm = -m; f32x2v ps2 = {0.f, 0.f};
#pragma unroll
    for (int t = 0; t < 2; ++t) {
        if (!(t == 0 ? rel0 : rel1)) continue;
        const LAS unsigned char* Vt = t == 0 ? Vt0 : Vt1;
        f32x16 pv = MODE == 2 ? s[t] + nm : s[t] * SC + nm;
#pragma unroll
        for (int r = 0; r < 16; ++r) pv[r] = __builtin_amdgcn_exp2f(pv[r]);
#pragma unroll
        for (int r = 0; r < 16; r += 2) ps2 += (f32x2v){pv[r], pv[r + 1]};
#pragma unroll
        for (int st = 0; st < 2; ++st) {
            u32x4 pw; pw.x = cvtpk(pv[8 * st + 0], pv[8 * st + 1]); pw.y = cvtpk(pv[8 * st + 2], pv[8 * st + 3]); pw.z = cvtpk(pv[8 * st + 4], pv[8 * st + 5]); pw.w = cvtpk(pv[8 * st + 6], pv[8 * st + 7]);
            const bf16x8 pb = __builtin_bit_cast(bf16x8, pw);
#pragma unroll
            for (int db = 0; db < 2; ++db) {
                const v4i16_t t0 = __builtin_amdgcn_ds_read_tr16_b64_v4i16((LAS v4i16_t*)(Vt + st * 2048 + vb[db])), t1 = __builtin_amdgcn_ds_read_tr16_b64_v4i16((LAS v4i16_t*)(Vt + st * 2048 + 1024 + vb[db]));
                const bf16x8 vf = (bf16x8){t0[0], t0[1], t0[2], t0[3], t1[0], t1[1], t1[2], t1[3]};
                o[db] = __builtin_amdgcn_mfma_f32_32x32x16_bf16(vf, pb, o[db], 0, 0, 0);
            }
        }
    }
    ls += ps2[0] + ps2[1];
}
__device__ __forceinline__ void attn_prefetch_first(const Params& p, int it, int n0, int n1, int n2, LAS unsigned char* lds, int tid) {
    int b, hd, tok0;
    if (it < n0) { const int blk = it & 63; b = it >> 7; hd = (it >> 6) & 1; tok0 = 128 * (blk - 1 + (blk == 0 ? 1 : 0)); }
    else if (it < n0 + n1) { const int j = it - n0, blk = j & 31; b = j / 192; hd = 2 + (j >> 5) % 6; tok0 = na_rs(4 * blk) * 64; }
    else if (it < n0 + n1 + n2) { const int j = it - n0 - n1; b = j >> 2; hd = (j >> 1) & 1; tok0 = SEQ; }
    else { const int j = it - n0 - n1 - n2; b = j / 6; hd = 2 + j % 6; tok0 = SEQ; }
    const int lane = tid & 63, w = __builtin_amdgcn_readfirstlane(tid >> 6);
    const int skey = 8 * w + (lane >> 3), spc = lane & 7;
    const int ksrc = skey * 128 + ((spc ^ ((skey >> 1) & 7)) << 3);
    const int vsrc = skey * 128 + 64 + (((((spc >> 1) ^ (skey & 2)) << 1) | (spc & 1)) << 3);
    const bf16_t* s_ = (const bf16_t*)p.out + ((size_t)(b * 8 + hd) * KV_TOK + tok0) * 128;
    const unsigned d_ = (unsigned)__builtin_amdgcn_readfirstlane((int)((unsigned)(uintptr_t)lds + w * 1024));
#pragma unroll
    for (int q_ = 0; q_ < 4; ++q_) { glds16(s_ + q_ * 64 * 128 + ksrc, d_ + q_ * 8192u); glds16(s_ + q_ * 64 * 128 + vsrc, d_ + 32768u + q_ * 8192u); }
}
template <int KIND>
__device__ __forceinline__ void attn_item(const Params& p, int l, int item, LAS unsigned char* lds, int tid, int nxt_it, int n0, int n1, int n2) {
    constexpr bool ISA = (KIND == 0 || KIND == 2);
    constexpr int NG = ISA ? 2 : 1;
    const int lane = tid & 63, w = __builtin_amdgcn_readfirstlane(tid >> 6), ql = lane & 31, hh = lane >> 5;
    const bf16_t* PB = (const bf16_t*)(p.ws + WS_PB); bf16_t* OB = (bf16_t*)(p.ws + WS_OB);
    int b, hx, blk;
    if (KIND == 0) { b = item >> 7; hx = (item >> 6) & 1; blk = item & 63; }
    else if (KIND == 1) { b = item / 192; hx = (item >> 5) % 6; blk = item & 31; }
    else if (KIND == 2) { b = item >> 2; hx = (item >> 1) & 1; blk = item & 1; }
    else { b = item / 6; hx = item % 6; blk = 0; }
    const size_t rowb = (size_t)b * SEQ, ctxb = (size_t)NLAT + (size_t)b * CTXL;
    const bf16_t* KVh = (const bf16_t*)p.out + (size_t)(b * 8 + (ISA ? hx : 2 + hx)) * KV_TOK * 128;
    int nwin = 0; size_t winrow0 = 0; int winpos0 = 0, krs0 = 0;
    if (KIND == 0) { const int first = blk == 0 ? 1 : 0, last = blk == 63 ? 2 : 3; nwin = (last - first + 1) >> 1; winpos0 = 128 * (blk - 1 + first); winrow0 = winpos0; }
    if (KIND == 1) { krs0 = na_rs(4 * blk); nwin = (na_rs(4 * blk + 3) + 8 - krs0 + 3) >> 2; winrow0 = (size_t)krs0 * 64; }
    const int nch = nwin + 1;
    const bool active = true;
    int gh[NG], gp0[NG];
#pragma unroll
    for (int gi = 0; gi < NG; ++gi) {
        const int G = ISA ? (w < 4 ? 2 * w + gi : 8 + (w - 4)) : w;
        if (ISA) { gh[gi] = 3 * hx + (G >> 2); gp0[gi] = 128 * blk + 32 * (G & 3); }
        else if (KIND == 1) { gh[gi] = hx; gp0[gi] = 16 * (G & 3); }
        else { gh[gi] = hx; gp0[gi] = 32 * G; }
    }
    const int nrow0 = 4 * blk + 2 * (w >> 2);
    const int nrq = nrow0 + (ql >> 4), ncq = gp0[0] + (ql & 15);
#define FA_QROW(gi, ql_) (KIND == 0 ? rowb + gp0[gi] + (ql_) : KIND == 2 ? ctxb + gp0[gi] + (ql_) : KIND == 1 ? rowb + (size_t)(nrow0 + ((ql_) >> 4)) * 64 + gp0[gi] + ((ql_) & 15) : ctxb + gp0[gi] + (ql_))
    const int skey = 8 * w + (lane >> 3), spc = lane & 7;
    const int ksrc = skey * 128 + ((spc ^ ((skey >> 1) & 7)) << 3);
    const int vsrc = skey * 128 + 64 + (((((spc >> 1) ^ (skey & 2)) << 1) | (spc & 1)) << 3);
    const unsigned lds0 = (unsigned)(uintptr_t)lds;
    const int noff = KIND == 1 ? ((gp0[0] >> 4) == 0 ? 0 : ((gp0[0] >> 4) == 1 ? 8 : ((gp0[0] >> 4) == 2 ? 24 : 32))) : 0;
    int kb[4], kbw[4], vb[2];
#pragma unroll
    for (int ks = 0; ks < 4; ++ks) { kb[ks] = ql * 128 + (((2 * ks + hh) ^ ((ql >> 1) & 7)) << 4); kbw[ks] = ql * 128 + (((2 * ks + hh) ^ (((noff + ql) >> 1) & 7)) << 4); }
    { const int vk = 4 * hh + ((lane & 15) >> 2);
#pragma unroll
      for (int db = 0; db < 2; ++db) vb[db] = vk * 128 + (((2 * db + ((lane >> 4) & 1)) ^ (vk & 2)) << 5) + ((lane & 3) << 3); }
#define FA_DMA(ci) do { const size_t r0_ = (ci) < nwin ? winrow0 + (size_t)(ci) * 256 : (size_t)SEQ; const bf16_t* s_ = KVh + r0_ * 128; \
        const unsigned d_ = (unsigned)__builtin_amdgcn_readfirstlane((int)(lds0 + ((ci) & 1) * CHUNK_BYTES + w * 1024)); \
        _Pragma("unroll") for (int q_ = 0; q_ < 4; ++q_) { glds16(s_ + q_ * 64 * 128 + ksrc, d_ + q_ * 8192u); glds16(s_ + q_ * 64 * 128 + vsrc, d_ + 32768u + q_ * 8192u); } } while (0)
    bf16x8 qf[NG][4];
#pragma unroll
    for (int gi = 0; gi < NG; ++gi)
#pragma unroll
        for (int ks = 0; ks < 4; ++ks) qf[gi][ks] = *(const bf16x8*)(PB + FA_QROW(gi, ql) * INW + (ISA ? C_QA : C_QN) + gh[gi] * 64 + 16 * ks + 8 * hh);
    f32x16 o[NG][2]; float m[NG], ls[NG];
#pragma unroll
    for (int gi = 0; gi < NG; ++gi) {
#pragma unroll
        for (int d = 0; d < 2; ++d)
#pragma unroll
            for (int r = 0; r < 16; ++r) o[gi][d][r] = 0.f;
        if (ISA) { m[gi] = p.attn_sink[l * 6 + gh[gi]] * LOG2E; ls[gi] = hh == 0 ? 1.f : 0.f; } else { m[gi] = -1e30f; ls[gi] = 0.f; }
    }
    f32x16 fmask;
#pragma unroll
    for (int r = 0; r < 16; ++r) fmask[r] = 0.f;
    if (KIND == 1) { const int cs = min(max(ncq - 8, 0), 48);
#pragma unroll
        for (int r = 0; r < 16; ++r) { const int ck = noff + (r & 3) + 8 * (r >> 2) + 4 * hh; fmask[r] = ((ck >= cs) && (ck < cs + 16)) ? 0.f : -INFINITY; } }
    const int nqrs = na_rs(nrq);
    LAS float* biasL = (LAS float*)(lds + BIAS_OFF);
    if (KIND == 1) { const float* rp = p.na_rpb + ((size_t)l * 6 + hx) * 15 * 31;
        for (int i = tid; i < 16 * 128; i += NTHREADS) { const int x = (i & 127) - 64; biasL[i] = (i >> 7) == 15 ? -INFINITY : ((x >= -15 && x <= 15) ? rp[(i >> 7) * 31 + x + 15] * LOG2E : 0.f); } }
    FA_WAIT_BAR(0);
#pragma unroll
    for (int gi = 0; gi < NG; ++gi) { asm volatile("" : "+v"(qf[gi][0]), "+v"(qf[gi][1]), "+v"(qf[gi][2]), "+v"(qf[gi][3])); }
#pragma unroll 1
    for (int ci = 0; ci < nch; ++ci) {
        if (ci + 1 < nch) FA_DMA(ci + 1);
        const LAS unsigned char* Kb = lds + (ci & 1) * CHUNK_BYTES; const LAS unsigned char* Vb = Kb + 32768;
        const bool iswin = ci < nwin;
        if (active) {
            if (KIND == 1 && iswin) {
                const int rsA = na_rs(nrow0), rsB = na_rs(nrow0 + 1), bcol = 64 + noff + 4 * hh - ncq;
#pragma unroll 1
                for (int rr = 0; rr < 2; ++rr) {
                    const int kr0 = krs0 + 4 * ci + 2 * rr;
                    const bool rel0 = (kr0 >= rsA) && (kr0 < rsB + 8), rel1 = (kr0 + 1 >= rsA) && (kr0 + 1 < rsB + 8);
                    if (rel0 || rel1) {
                        const bool rowok0 = (kr0 >= nqrs) && (kr0 < nqrs + 8), rowok1 = (kr0 + 1 >= nqrs) && (kr0 + 1 < nqrs + 8);
                        const LAS float* bp0 = biasL + (rowok0 ? kr0 - nrq + 7 : 15) * 128 + bcol; const LAS float* bp1 = biasL + (rowok1 ? kr0 + 1 - nrq + 7 : 15) * 128 + bcol;
                        const LAS unsigned char* Kt = Kb + (128 * rr + noff) * 128; const LAS unsigned char* Vt = Vb + (128 * rr + noff) * 128;
                        unit32<2>(o[0], m[0], ls[0], qf[0], Kt, Kt + 64 * 128, Vt, Vt + 64 * 128, kbw, vb, rel0, rel1, false, false, 0, 0, fmask, bp0, bp1);
                    }
                }
            } else {
#pragma unroll 1
                for (int u = 0; u < 4; ++u) {
                    const LAS unsigned char* Kt = Kb + (64 * u) * 128; const LAS unsigned char* Vt = Vb + (64 * u) * 128;
#pragma unroll
                    for (int gi = 0; gi < NG; ++gi) {
                        if (ISA && gi == 1 && w >= 4) continue;
                        if (KIND == 0) {
                            bool rel[2] = {true, true}, msk[2] = {false, false};
                            if (iswin) {
#pragma unroll
                                for (int t = 0; t < 2; ++t) { const int j0 = winpos0 + 256 * ci + 64 * u + 32 * t, p0 = gp0[gi];
                                    rel[t] = (j0 + 31 >= p0 - 128) && (j0 <= p0 + 31 + 128); msk[t] = !((j0 >= p0 + 31 - 128) && (j0 + 31 <= p0 + 128)); } }
                            if (!(rel[0] || rel[1])) continue;
                            const int tb0 = gp0[gi] + ql - (winpos0 + 256 * ci + 64 * u) - 4 * hh + 128;
                            unit32<1>(o[gi], m[gi], ls[gi], qf[gi], Kt, Kt + 4096, Vt, Vt + 4096, kb, vb, rel[0], rel[1], msk[0], msk[1], tb0, tb0 - 32, fmask, nullptr, nullptr);
                        } else unit32<0>(o[gi], m[gi], ls[gi], qf[gi], Kt, Kt + 4096, Vt, Vt + 4096, kb, vb, true, true, false, false, 0, 0, fmask, nullptr, nullptr);
                    }
                }
            }
        }
        FA_WAIT_BAR(0);
    }
#undef FA_DMA
    if (nxt_it >= 0) attn_prefetch_first(p, nxt_it, n0, n1, n2, lds, tid);
    if (active) {
        int ql2 = lane & 31; asm volatile("" : "+v"(ql2));
#pragma unroll
        for (int gi = 0; gi < NG; ++gi) {
            if (ISA && gi == 1 && w >= 4) continue;
            const float lt = xor32_sum(ls[gi]);
            const float inv = 1.f / lt;
            bf16_t* op = OB + FA_QROW(gi, ql2) * DM + (ISA ? 0 : 640) + gh[gi] * 64 + 4 * hh;
#pragma unroll
            for (int db = 0; db < 2; ++db)
#pragma unroll
                for (int i = 0; i < 4; ++i) { u32x2 ov; ov.x = cvtpk(o[gi][db][4 * i] * inv, o[gi][db][4 * i + 1] * inv); ov.y = cvtpk(o[gi][db][4 * i + 2] * inv, o[gi][db][4 * i + 3] * inv); *(u32x2*)(op + 32 * db + 8 * i) = ov; }
        }
    }
#undef FA_QROW
}
__device__ __forceinline__ void phase_attn(const Params& p, int l, bool with_ctx, LAS unsigned char* lds, int bid, int nb) {
    bid = opaque_s(bid);
    const int n0 = NB * 2 * 64, n1 = NB * 6 * 32, n2 = with_ctx ? NB * 2 * 2 : 0, n3 = with_ctx ? NB * 6 : 0;
    const int vb = (nb % 8 == 0) ? (bid % 8) * (nb / 8) + bid / 8 : bid;
    const int ntot = n0 + n1 + n2 + n3;
    if (vb < ntot) attn_prefetch_first(p, vb, n0, n1, n2, lds, opaque_tid());
#pragma unroll 1
    for (int it = vb; it < ntot; it += nb) {
        const int tid = opaque_tid();
        const int nx = it + nb < ntot ? it + nb : -1;
        if (it < n0) attn_item<0>(p, l, it, lds, tid, nx, n0, n1, n2);
        else if (it < n0 + n1) attn_item<1>(p, l, it - n0, lds, tid, nx, n0, n1, n2);
        else if (it < n0 + n1 + n2) attn_item<2>(p, l, it - n0 - n1, lds, tid, nx, n0, n1, n2);
        else attn_item<3>(p, l, it - n0 - n1 - n2, lds, tid, nx, n0, n1, n2);
    }
}
}

__device__ __forceinline__ float reduce16(const float (&t)[16], int lane) {
    float u[8], w4[4], x2[2];
#pragma unroll
    for (int e = 0; e < 8; ++e) { float a = t[e], b = t[e + 8]; asm volatile("s_nop 1\n\tv_permlane32_swap_b32 %0, %1" : "+v"(a), "+v"(b)); u[e] = a + b; }
#pragma unroll
    for (int e = 0; e < 4; ++e) { float a = u[e], b = u[e + 4]; asm volatile("s_nop 1\n\tv_permlane16_swap_b32 %0, %1" : "+v"(a), "+v"(b)); w4[e] = a + b; }
    const bool b3 = (lane & 8) != 0, b2 = (lane & 4) != 0;
#pragma unroll
    for (int e = 0; e < 2; ++e) { const float keep = b3 ? w4[e + 2] : w4[e], send = b3 ? w4[e] : w4[e + 2]; x2[e] = keep + dppf<0x128>(send); }
    const float keep = b2 ? x2[1] : x2[0], send = b2 ? x2[0] : x2[1];
    float y = keep + dppf<0x141>(send);
    y += dppf<0xB1>(y); y += dppf<0x4E>(y);
    return y;
}
__device__ __forceinline__ float wave_max(float v) {
    v = fmaxf(v, dppf<0xB1>(v)); v = fmaxf(v, dppf<0x4E>(v)); v = fmaxf(v, dppf<0x141>(v)); v = fmaxf(v, dppf<0x140>(v));
    return xor32_max(xor16_max(v));
}
__device__ __forceinline__ float row16_sum(float v) { v += dppf<0xB1>(v); v += dppf<0x4E>(v); v += dppf<0x141>(v); v += dppf<0x140>(v); return v; }
__device__ __forceinline__ float row16_max(float v) { v = fmaxf(v, dppf<0xB1>(v)); v = fmaxf(v, dppf<0x4E>(v)); v = fmaxf(v, dppf<0x141>(v)); v = fmaxf(v, dppf<0x140>(v)); return v; }
__device__ __forceinline__ void phase_ln_router(const Params& p, int l, bool with_ctx, LAS unsigned char* lds, int bid, int nb) {
    bid = opaque_s(bid); const int tid = opaque_tid(), lane = tid & 63, w = tid >> 6, gw = bid * NWAVES + w, NGW = nb * NWAVES;
    constexpr int WRS = 2064;
    LAS unsigned char* wrb = lds;
    LAS float* lg = (LAS float*)(lds + 16 * WRS + 32); LAS float* lb = lg + DM; LAS float* lsh = lb + DM; LAS float* lsc = lsh + 5 * DM;
    LAS unsigned char* hst = (LAS unsigned char*)(lsc + 5 * DM) + w * 4096;
    const float* wrg = p.w_router + (size_t)l * DM * NE;
    for (int i = tid; i < DM * NE / 2; i += NTHREADS) { const int c = (i >> 4) * 2, e = i & 15; *(LAS unsigned*)(wrb + e * WRS + c * 2) = pk2(wrg[c * 16 + e], wrg[(c + 1) * 16 + e]); }
    lds_fill(lg, p.ln1_g + l * DM, DM, tid); lds_fill(lb, p.ln1_b + l * DM, DM, tid);
    for (int r = 0; r < 5; ++r) { lds_fill(lsh + r * DM, mod_ptr(p, l, r) + 3 * DM, DM, tid); lds_fill(lsc + r * DM, mod_ptr(p, l, r) + 4 * DM, DM, tid); }
    __syncthreads();
    const bf16_t* XB = (const bf16_t*)(p.ws + WS_XB); bf16_t* HB = (bf16_t*)(p.ws + WS_HB); float* AFF = (float*)(p.ws + WS_AFF);
    const int nrows = with_ctx ? NROWS : NLAT;
    const int fr = lane & 15, fq = lane >> 4;
    const LAS unsigned char* bsrc = wrb + fr * WRS + fq * 16;
    const LAS unsigned char* asrc = hst + (fr & 1) * 2048 + fq * 16;
    auto rowh2 = [&](f32x4 (&v)[4], int row, int slot) {
        row_normalize(v); row_affine_l(v, lg, lb, lane);
        row_normalize(v);
        { const int mr = row_modrow(row); row_modulate_l(v, lsh + mr * DM, lsc + mr * DM, lane); }
#pragma unroll
        for (int j = 0; j < 4; ++j) { u32x2 o; o.x = pk2(v[j][0], v[j][1]); o.y = pk2(v[j][2], v[j][3]); *(u32x2*)(HB + (size_t)row * DM + 256 * j + 4 * lane) = o; *(LAS u32x2*)(hst + slot * 2048 + (256 * j + 4 * lane) * 2) = o; }
    };
    f32x4 va[4], vb[4]; u32x2 na[4], nb2[4];
    auto ldraw = [&](u32x2 (&d)[4], int r) {
#pragma unroll
        for (int j = 0; j < 4; ++j) d[j] = *(const u32x2*)(XB + (size_t)r * DM + 256 * j + 4 * lane); };
    auto unpack = [&](f32x4 (&d)[4], const u32x2 (&sv)[4]) {
#pragma unroll
        for (int j = 0; j < 4; ++j) d[j] = (f32x4){bf_lo(sv[j].x), bf_hi(sv[j].x), bf_lo(sv[j].y), bf_hi(sv[j].y)}; };
    const int step = 2 * NGW;
    ldraw(na, min(gw, nrows - 1)); ldraw(nb2, min(gw + NGW, nrows - 1));
#pragma unroll 1
    for (int row = gw; row < nrows; row += step) {
        const int rowB = min(row + NGW, nrows - 1);
        unpack(va, na); unpack(vb, nb2);
        ldraw(na, min(row + step, nrows - 1)); ldraw(nb2, min(row + step + NGW, nrows - 1));
        rowh2(va, row, 0); asm volatile("" ::: "memory"); rowh2(vb, rowB, 1);
        LDS_WAIT();
        f32x4 acc = {0.f, 0.f, 0.f, 0.f};
#pragma unroll 8
        for (int s = 0; s < 32; ++s) { const bf16x8 af = *(const LAS bf16x8*)(asrc + 64 * s), bf = *(const LAS bf16x8*)(bsrc + 64 * s); acc = __builtin_amdgcn_mfma_f32_16x16x32_bf16(af, bf, acc, 0, 0, 0); }
        const float m0 = row16_max(acc[0]), m1 = row16_max(acc[1]), e0 = expf(acc[0] - m0), e1 = expf(acc[1] - m1);
        float a0 = e0 / row16_sum(e0), a1 = e1 / row16_sum(e1);
        asm volatile("" : "+v"(a0), "+v"(a1));
        if (lane < 16) { AFF[(size_t)lane * NROWS + row] = a0; AFF[(size_t)lane * NROWS + rowB] = a1; }
        LDS_WAIT();
    }
}

__device__ __forceinline__ void topk_item(const float* aff  , int n, int k, int row0  , int e, int slot0,
                                          int* TOK, float* GATE, int* INV, LAS unsigned char* lds) {
    const int tid = opaque_tid(), lane = tid & 63, w = tid >> 6;
    LAS unsigned* keys = (LAS unsigned*)lds;
    LAS unsigned* hist = keys + 8192;
    LAS unsigned* misc = hist + 256;
    for (int i = tid; i < n; i += NTHREADS) keys[i] = __builtin_bit_cast(unsigned, aff[i]);
    if (tid == 0) { misc[0] = 0u; misc[1] = (unsigned)k; }
    __syncthreads();
    unsigned maskv = 0u;
    for (int pass = 0; pass < 4; ++pass) {
        const int shift = 24 - 8 * pass;
        if (tid < 256) hist[tid] = 0u;
        __syncthreads();
        const unsigned prefix = misc[0];
        for (int i = tid; i < n; i += NTHREADS) { const unsigned kv = keys[i]; if ((kv & maskv) == prefix) atomicAdd((unsigned*)&hist[(kv >> shift) & 255u], 1u); }
        __syncthreads();
        if (w == 0) {
            const unsigned rem = misc[1];
            const unsigned h0 = hist[4 * lane], h1 = hist[4 * lane + 1], h2 = hist[4 * lane + 2], h3 = hist[4 * lane + 3], s4 = h0 + h1 + h2 + h3;
            unsigned S = s4;
#pragma unroll
            for (int o = 1; o < 64; o <<= 1) { const unsigned y = __shfl_down(S, o); if (lane + o < 64) S += y; }
            const unsigned above = S - s4;
            if (above < rem && rem <= S) { unsigned cum = above; int bin;
                if (cum + h3 >= rem) bin = 3; else { cum += h3; if (cum + h2 >= rem) bin = 2; else { cum += h2; if (cum + h1 >= rem) bin = 1; else { cum += h1; bin = 0; } } }
                misc[0] = prefix | ((unsigned)(4 * lane + bin) << shift); misc[1] = rem - cum; }
        }
        __syncthreads();
        maskv |= 255u << shift;
    }
    const unsigned T = misc[0], need_eq = misc[1];
    __syncthreads();
    const int per = n >= NTHREADS ? n / NTHREADS : 1; const int t0 = tid * per; const bool act = t0 < n;
    unsigned ce = 0u;
    if (act) for (int i = 0; i < per; ++i) ce += (keys[t0 + i] == T) ? 1u : 0u;
    unsigned inc = ce;
#pragma unroll
    for (int o = 1; o < 64; o <<= 1) { const unsigned y = __shfl_up(inc, o); if (lane >= o) inc += y; }
    if (lane == 63) misc[16 + w] = inc;
    __syncthreads();
    unsigned base = 0u;
    for (int ww = 0; ww < w; ++ww) base += misc[16 + ww];
    unsigned eqrank = base + inc - ce;
    __syncthreads();
    unsigned cs = 0u;
    if (act) { unsigned er = eqrank; for (int i = 0; i < per; ++i) { const unsigned kv = keys[t0 + i]; if (kv > T) cs++; else if (kv == T) { if (er < need_eq) cs++; er++; } } }
    inc = cs;
#pragma unroll
    for (int o = 1; o < 64; o <<= 1) { const unsigned y = __shfl_up(inc, o); if (lane >= o) inc += y; }
    if (lane == 63) misc[16 + w] = inc;
    __syncthreads();
    base = 0u;
    for (int ww = 0; ww < w; ++ww) base += misc[16 + ww];
    unsigned pos = base + inc - cs;
    if (act) { unsigned er = eqrank; for (int i = 0; i < per; ++i) { const unsigned kv = keys[t0 + i]; bool sel = false;
            if (kv > T) sel = true; else if (kv == T) { sel = er < need_eq; er++; }
            const int row = row0 + t0 + i;
            if (sel) { const int slot = slot0 + (int)pos; TOK[slot] = row; GATE[slot] = __builtin_bit_cast(float, kv); INV[(size_t)e * NROWS + row] = slot; pos++; }
            else INV[(size_t)e * NROWS + row] = -1; } }
    __syncthreads();
}
__device__ __forceinline__ void phase_topk(const Params& p, bool with_ctx, LAS unsigned char* lds, int bid, int nb) {
    const float* AFF = (const float*)(p.ws + WS_AFF); int* TOK = (int*)(p.ws + WS_TOK); float* GATE = (float*)(p.ws + WS_GATE); int* INV = (int*)(p.ws + WS_INV);
    const int nitems = with_ctx ? 128 : 64;
    for (int it = bid; it < nitems; it += nb) {
        if (it < 64) { const int b = it >> 4, e = it & 15; topk_item(AFF + (size_t)e * NROWS + (size_t)b * SEQ, SEQ, CAP, b * SEQ, e, (b * NE + e) * CAP, TOK, GATE, INV, lds); }
        else { const int b = (it - 64) >> 4, e = it & 15; topk_item(AFF + (size_t)e * NROWS + NLAT + (size_t)b * CTXL, CTXL, CCAP, NLAT + b * CTXL, e, NSLOT_LAT + (e * NB + b) * CCAP, TOK, GATE, INV, lds); }
    }
}

__device__ __forceinline__ void phase_combine(const Params& p, int l, bool with_ctx, LAS unsigned char* lds, int bid, int nb) {
    bid = opaque_s(bid); const int tid = opaque_tid(); const int lane = tid & 63, gw = bid * NWAVES + (tid >> 6), NGW = nb * NWAVES;
    LAS float* l1g = (LAS float*)lds; LAS float* l1b = l1g + DM; LAS float* l2g = l1b + DM; LAS float* l2b = l2g + DM; LAS float* lg2 = l2b + DM; LAS float* lsh = lg2 + 5 * DM; LAS float* lsc = lsh + 5 * DM;
    lds_fill(l1g, p.ln1_g + l * DM, DM, tid); lds_fill(l1b, p.ln1_b + l * DM, DM, tid); lds_fill(l2g, p.ln2_g + l * DM, DM, tid); lds_fill(l2b, p.ln2_b + l * DM, DM, tid);
    for (int r = 0; r < 5; ++r) { lds_fill(lg2 + r * DM, mod_ptr(p, l, r) + 5 * DM, DM, tid); if (l + 1 < DEPTH) { lds_fill(lsh + r * DM, mod_ptr(p, l + 1, r), DM, tid); lds_fill(lsc + r * DM, mod_ptr(p, l + 1, r) + DM, DM, tid); } }
    __syncthreads();
    bf16_t* XB = (bf16_t*)(p.ws + WS_XB); bf16_t* HB = (bf16_t*)(p.ws + WS_HB);
    const bf16_t* Y = (const bf16_t*)(p.ws + WS_Y); const int* INV = (const int*)(p.ws + WS_INV);
    const float* g = p.ln2_g + l * DM; const float* bb = p.ln2_b + l * DM;
    const int nrows = with_ctx ? NROWS : NLAT;
    f32x4 v[4], vn[4]; int myinv = -1, myinvn = -1;
    if (gw < nrows) { row_load_bf16(XB + (size_t)gw * DM, lane, v); myinv = INV[(size_t)(lane & 15) * NROWS + gw]; }
#pragma unroll 1
    for (int row = gw; row < nrows; row += NGW) {
        bf16_t* xr = XB + (size_t)row * DM;
        const int rn = row + NGW;
        if (rn < nrows) { row_load_bf16(XB + (size_t)rn * DM, lane, vn); myinvn = INV[(size_t)(lane & 15) * NROWS + rn]; }
        f32x4 a[4];
#pragma unroll
        for (int j = 0; j < 4; ++j) a[j] = (f32x4){0.f, 0.f, 0.f, 0.f};
#pragma unroll
        for (int e = 0; e < 16; ++e) {
            const int slot = __builtin_amdgcn_readlane(myinv, e);
            if (slot >= 0) { const bf16_t* yr = Y + (size_t)slot * DM;
#pragma unroll
                for (int j = 0; j < 4; ++j) { const u32x2 wv = *(const u32x2*)(yr + 256 * j + 4 * lane); a[j][0] += bf_lo(wv.x); a[j][1] += bf_hi(wv.x); a[j][2] += bf_lo(wv.y); a[j][3] += bf_hi(wv.y); } }
        }
        row_normalize(v); row_affine_l(v, l1g, l1b, lane);
        const int mr = row_modrow(row);
#pragma unroll
        for (int j = 0; j < 4; ++j) { const f32x4 g2 = *(const LAS f32x4*)(lg2 + mr * DM + 256 * j + 4 * lane); v[j] = v[j] * ALPHA + g2 * a[j]; }
        row_normalize(v); row_affine_l(v, l2g, l2b, lane);
        if (l + 1 < DEPTH) row_store_bf16(xr, lane, v); else row_store(p.out + (size_t)row * DM, lane, v);
        if (l + 1 < DEPTH) { row_normalize(v); row_modulate_l(v, lsh + mr * DM, lsc + mr * DM, lane); row_store_bf16(HB + (size_t)row * DM, lane, v); }
#pragma unroll
        for (int j = 0; j < 4; ++j) v[j] = vn[j];
        myinv = myinvn;
    }
}

constexpr int N_PHASES = 2 + 8 * DEPTH;
#define IN(k) (lo <= (k) && (k) < hi)
#ifndef TS_SEL
#define TS_SEL -1
#endif
#define TS_MULT 8
#define SEAM(k) do { if (IN(k) && IN((k) + 1)) xcd_barrier(bar); if (TS_SEL >= 0 && blockIdx.x == 0 && threadIdx.x == 0) ((unsigned long long*)(p.ws + WS_CTL + 65536))[(k) + 1] = __builtin_amdgcn_s_memrealtime(); } while (0)
#ifndef PHMASK
#define PHMASK 0x3ff
#endif
#define PHON(i) ((PHMASK >> (i)) & 1)
#ifndef DUP_MASK
#define DUP_MASK 0
#endif
#define DUP(i) ((DUP_MASK >> (i)) & 1)
template <int l>
__device__ __forceinline__ void run_layer(const Params& p, LAS unsigned char* lds, LAS int* idxl, const XcdBarrier& bar, int bid, int nb, int lo, int hi) {
    bf16_t* HB = (bf16_t*)(p.ws + WS_HB); bf16_t* PB = (bf16_t*)(p.ws + WS_PB); bf16_t* OB = (bf16_t*)(p.ws + WS_OB);
    bf16_t* HH = (bf16_t*)(p.ws + WS_HH); bf16_t* Y = (bf16_t*)(p.ws + WS_Y);
    const int* TOK = (const int*)(p.ws + WS_TOK); const float* GATE = (const float*)(p.ws + WS_GATE);
        const int pb = 2 + 8 * l; const bool wc = (l == 0);
        if (IN(pb + 0)) { if (PHON(2)) {
            const bf16_t* W = (const bf16_t*)(p.ws + WS_WIN) + (size_t)l * INW * DM; EpiQKV E{PB, (const float*)(p.ws + WS_ROPE), (bf16_t*)p.out};
            { SgDesc g{HB + (size_t)NLAT * DM, DM, nullptr, W, 0, 1 << 30, 1, NCTX, INW, DM, NLAT}; sg_gemm(g, E, lds, bid, nb); }
            { mg::Gemm g{HB, W, NLAT, INW, DM, nullptr, 0, 1 << 20, 1}; mg::StaticOrder S; S.init(NLAT, INW, nb, bid); mg::EpiAdapt<EpiQKV> EA{E, 0, lds + STG_OFF}; mg::gemm_phase(lds, idxl, g, S, EA); if (DUP(2)) mg::gemm_phase(lds, idxl, g, S, EA); } } }
        SEAM(pb + 0);
        if (IN(pb + 1)) { if (PHON(3)) {
#if FAST_ATTN
            fa::phase_attn(p, l, wc, lds, bid, nb); if (DUP(3)) fa::phase_attn(p, l, wc, lds, bid, nb);
#endif
            phase_mixers(p, l, wc, bid, nb); if (DUP(11)) phase_mixers(p, l, wc, bid, nb); } }
        SEAM(pb + 1);
        if (IN(pb + 2)) { if (PHON(4)) {
            const bf16_t* W = (const bf16_t*)(p.ws + WS_WOUT) + (size_t)l * DM * DM;
            EpiOut<l == 0> E{p.x, p.ctx, (bf16_t*)(p.ws + WS_XB), mod_ptr(p, l, 0)};
            if (wc) { SgDesc g{OB + (size_t)NLAT * DM, DM, nullptr, W, 0, 1 << 30, 1, NCTX, DM, DM, NLAT}; sg_gemm(g, E, lds, bid, nb); }
            { mg::Gemm g{OB, W, NLAT, DM, DM, nullptr, 0, 1 << 20, 1}; mg::StaticOrder S; S.init(NLAT, DM, nb, bid); mg::EpiAdapt<EpiOut<l == 0>> EA{E, 0, lds + STG_OFF}; mg::gemm_phase(lds, idxl, g, S, EA); if (DUP(4) && l == 0) mg::gemm_phase(lds, idxl, g, S, EA); } } }
        SEAM(pb + 2);
        if (IN(pb + 3)) { if (PHON(5)) phase_ln_router(p, l, wc, lds, bid, nb); }
        SEAM(pb + 3);
        if (IN(pb + 4)) { if (PHON(6)) { phase_topk(p, wc, lds, bid, nb); if (DUP(6)) phase_topk(p, wc, lds, bid, nb);
            { const int busy = wc ? 128 : 64;
              if (bid >= busy && nb > busy) phase_weights(p, lds, bid - busy, nb - busy, l == 0 ? TR_P0 : TR_SPLIT, l == 0 ? TR_SPLIT : 2 * TR_PER_L); } } }
        SEAM(pb + 4);
        if (IN(pb + 5)) { if (PHON(7)) {
            const bf16_t* W = (const bf16_t*)(p.ws + WS_WGU) + (size_t)l * NE * 1024 * DM; EpiGU E{HH};
            if (wc) { SgDesc g{HB, DM, TOK + NSLOT_LAT, W, (size_t)1024 * DM, NB * CCAP, NE, NSLOT_CTX, 1024, DM, NSLOT_LAT}; sg_gemm(g, E, lds, bid, nb); }
            { mg::Gemm g{HB, W, NSLOT_LAT, 1024, DM, TOK, (size_t)1024 * DM, CAP / 256, NE}; mg::StaticOrder S; S.init(NSLOT_LAT, 1024, nb, bid); mg::EpiAdapt<EpiGU> EA{E, 0, lds + STG_OFF}; mg::gemm_phase(lds, idxl, g, S, EA); if (DUP(7)) mg::gemm_phase(lds, idxl, g, S, EA); } } }
        SEAM(pb + 5);
        if (IN(pb + 6)) { if (PHON(8)) {
            const bf16_t* W = (const bf16_t*)(p.ws + WS_WD) + (size_t)l * NE * DM * FF; EpiDown E{Y, GATE};
            if (wc) { SgDesc g{HH + (size_t)NSLOT_LAT * FF, FF, nullptr, W, (size_t)DM * FF, NB * CCAP, NE, NSLOT_CTX, DM, FF, NSLOT_LAT}; sg_gemm(g, E, lds, bid, nb); }
            { mg::Gemm g{HH, W, NSLOT_LAT, DM, FF, nullptr, (size_t)DM * FF, CAP / 256, NE}; mg::StaticOrder S; S.init(NSLOT_LAT, DM, nb, bid); mg::EpiAdapt<EpiDown> EA{E, 0, lds + STG_OFF}; mg::gemm_phase(lds, idxl, g, S, EA); if (DUP(8)) mg::gemm_phase(lds, idxl, g, S, EA); } } }
        SEAM(pb + 6);
        if (IN(pb + 7)) { if (PHON(9)) phase_combine(p, l, wc, lds, bid, nb); }
        SEAM(pb + 7);
}
__global__ void __launch_bounds__(NTHREADS, 2) fwd_kernel(Params p) {
    extern __shared__ __attribute__((aligned(16))) unsigned char lds_raw[];
    LAS unsigned char* lds = (LAS unsigned char*)lds_raw;
    const int bid = blockIdx.x, nb = gridDim.x;
    volatile LAS unsigned* MISC = (volatile LAS unsigned*)(lds + LDS_BYTES - 64);
    LAS int* idxl = (LAS int*)(lds + mg::STAGE_BYTES);
    if (threadIdx.x < 16) MISC[threadIdx.x] = 0u;
    __syncthreads();
    XcdBarrier bar; bar.bar = (unsigned*)(p.ws + WS_CTL) + CW_BAR; bar.x = 0; bar.st = nullptr;
    const bool multi = p.ph_hi - p.ph_lo > 1;
    if (multi) bar = xcd_barrier_post((unsigned*)(p.ws + WS_CTL) + CW_BAR, MISC + 8);
    bf16_t* HB = (bf16_t*)(p.ws + WS_HB); bf16_t* PB = (bf16_t*)(p.ws + WS_PB); bf16_t* OB = (bf16_t*)(p.ws + WS_OB);
    bf16_t* HH = (bf16_t*)(p.ws + WS_HH); bf16_t* Y = (bf16_t*)(p.ws + WS_Y);
    const int* TOK = (const int*)(p.ws + WS_TOK); const float* GATE = (const float*)(p.ws + WS_GATE);
    const int lo = p.ph_lo, hi = p.ph_hi;
    if (TS_SEL >= 0 && blockIdx.x == 0 && threadIdx.x == 0) ((unsigned long long*)(p.ws + WS_CTL + 65536))[0] = __builtin_amdgcn_s_memrealtime();
    if (IN(0)) { if (PHON(0)) { phase_prologue(p, lds, bid, nb); __syncthreads(); phase_weights(p, lds, bid, nb, 0, TR_P0); } } SEAM(0);
    if (IN(1)) { if (PHON(1)) phase_ln1(p, bid, nb); if (DUP(1)) phase_ln1(p, bid, nb); } SEAM(1);
    run_layer<0>(p, lds, idxl, bar, bid, nb, lo, hi);
    run_layer<1>(p, lds, idxl, bar, bid, nb, lo, hi);
    if (TS_SEL >= 0 && blockIdx.x == 0 && threadIdx.x == 0) {
        volatile unsigned long long* ts = (volatile unsigned long long*)(p.ws + WS_CTL + 65536); const unsigned long long dt = (ts[TS_SEL + 1] - ts[TS_SEL]) * TS_MULT, t0 = __builtin_amdgcn_s_memrealtime();
        while (__builtin_amdgcn_s_memrealtime() - t0 < dt) __builtin_amdgcn_s_sleep(8); }
#undef IN
#undef SEAM
}

#ifndef N_LAUNCH_SPLIT
#define N_LAUNCH_SPLIT 0
#endif
extern "C" void kernel_launch(void* const* d_in, const int* in_sizes, int n_in, void* d_out, int out_size, void* d_ws, size_t ws_size, hipStream_t stream) {
    static int grid = 0;
    if (grid == 0) {
        if (n_in != 19 || in_sizes[0] != NLAT * DM || out_size != NLAT * DM || ws_size < WS_END) { fprintf(stderr, "kernel_launch: unexpected shapes (n_in %d, in0 %d, out %d, ws %zu)\n", n_in, n_in > 0 ? in_sizes[0] : -1, out_size, ws_size); grid = -1; return; }
        int dev = 0, cus = 0, per_cu = 0;
        if (hipGetDevice(&dev) != hipSuccess || hipDeviceGetAttribute(&cus, hipDeviceAttributeMultiprocessorCount, dev) != hipSuccess) { grid = -1; return; }
        if (hipFuncSetAttribute((const void*)fwd_kernel, hipFuncAttributeMaxDynamicSharedMemorySize, LDS_BYTES) != hipSuccess) { fprintf(stderr, "kernel_launch: hipFuncSetAttribute failed\n"); grid = -1; return; }
        if (hipOccupancyMaxActiveBlocksPerMultiprocessor(&per_cu, (const void*)fwd_kernel, NTHREADS, LDS_BYTES) != hipSuccess || per_cu < 1) { fprintf(stderr, "kernel_launch: occupancy query says %d\n", per_cu); per_cu = 1; }
        (void)hipGetLastError();
        grid = cus;
    }
    if (grid < 0) return;
    (void)hipMemsetAsync((char*)d_ws + WS_CTL, 0, CTL_ZERO_BYTES, stream);
    Params p{};
    const float** pp = (const float**)&p;
    for (int i = 0; i < 19; ++i) pp[i] = (const float*)d_in[i];
    p.out = (float*)d_out; p.ws = (unsigned char*)d_ws;
#if N_LAUNCH_SPLIT
    for (int ph = 0; ph < N_PHASES; ++ph) { p.ph_lo = ph; p.ph_hi = ph + 1; hipLaunchKernelGGL(fwd_kernel, dim3(grid), dim3(NTHREADS), LDS_BYTES, stream, p); }
#else
    p.ph_lo = 0; p.ph_hi = N_PHASES;
    void* args[] = {&p};
    hipError_t e = hipLaunchCooperativeKernel((const void*)fwd_kernel, dim3(grid), dim3(NTHREADS), args, LDS_BYTES, stream);
    if (e != hipSuccess) fprintf(stderr, "kernel_launch: cooperative launch failed: %s\n", hipGetErrorString(e));
#endif
}
```

```cpp
#include <hip/hip_runtime.h>
#include <hip/hip_cooperative_groups.h>
#include <cstdio>
#include <cstdint>
#include <cmath>

#define LAS __attribute__((address_space(3)))
typedef unsigned short bf16_t;
typedef short bf16x8 __attribute__((ext_vector_type(8)));
typedef float f32x4 __attribute__((ext_vector_type(4)));
typedef unsigned u32x4 __attribute__((ext_vector_type(4)));
typedef unsigned u32x2 __attribute__((ext_vector_type(2)));

constexpr int NB = 4, SEQ = 8192, DM = 1024, CTXL = 256, DEPTH = 2;
constexpr int NLAT = NB * SEQ, NCTX = NB * CTXL, NROWS = NLAT + NCTX;
constexpr int INW = 2560, NE = 16, FF = 512, CAP = 1024, CCAP = 32;
constexpr int NSLOT_LAT = NB * NE * CAP, NSLOT_CTX = NB * NE * CCAP, NSLOT = NSLOT_LAT + NSLOT_CTX;
constexpr int NMOD = 6 * DM;
constexpr float LN_EPS = 1e-6f;
constexpr float ALPHA = 1.41421356237309515f;
constexpr int C_QA = 0, C_KA = 384, C_VA = 512, C_BX = 640, C_BB = 896, C_BC = 1152, C_QN = 1408, C_KN = 1792, C_VN = 2176;

#ifndef FAST_ATTN
#define FAST_ATTN 1
#endif
constexpr int KV_TOK = SEQ + CTXL;
constexpr int NTHREADS = 512, NWAVES = 8;
constexpr int LDS_BYTES = 163840;
constexpr int STG_OFF = 139264, STG_WAVE = 16 * 144;

constexpr size_t MiB = 1u << 20;
constexpr size_t WS_CTL = 0, CTL_ZERO_BYTES = 128 * 1024;
constexpr size_t WS_ROPE = 1 * MiB;
constexpr size_t WS_MOD = 1 * MiB + 65536;
constexpr size_t WS_AFF = 2 * MiB;
constexpr size_t WS_INV = 5 * MiB;
constexpr size_t WS_TOK = 8 * MiB;
constexpr size_t WS_GATE = 8 * MiB + 512 * 1024;
constexpr size_t WS_CXR = 9 * MiB;
constexpr size_t WS_WIN = 16 * MiB;
constexpr size_t WS_WOUT = 26 * MiB;
constexpr size_t WS_WGU = 30 * MiB;
constexpr size_t WS_WD = 94 * MiB;
constexpr size_t WS_HB = 126 * MiB;
constexpr size_t WS_OB = 192 * MiB;
constexpr size_t WS_HH = 192 * MiB;
constexpr size_t WS_PB = 258 * MiB;
constexpr size_t WS_Y = 258 * MiB;
constexpr size_t WS_XB = 424 * MiB;
constexpr size_t WS_END = 490 * MiB;
static_assert(WS_HB + (size_t)NROWS * DM * 2 <= WS_OB && WS_OB + (size_t)NROWS * DM * 2 <= WS_PB && WS_PB + (size_t)NROWS * INW * 2 <= WS_XB && WS_XB + (size_t)NROWS * DM * 2 <= WS_END, "ws map");
static_assert((size_t)NSLOT * FF * 2 <= (size_t)NROWS * DM * 2 && (size_t)NSLOT * DM * 2 <= (size_t)NROWS * INW * 2, "overlays");
constexpr int CW_BAR = 4096;

struct Params {
    const float *x, *c, *ctx, *c_ctx, *w_mod, *b_mod, *w_in, *conv_w, *attn_sink, *na_rpb, *w_out, *ln1_g, *ln1_b, *w_router, *w_gate, *w_up, *w_down, *ln2_g, *ln2_b;
    float* out; unsigned char* ws;
    int ph_lo, ph_hi;
};

__device__ __forceinline__ unsigned f2bf(float f) { unsigned u = __builtin_bit_cast(unsigned, f); return (u + 0x7fffu + ((u >> 16) & 1u)) >> 16; }
typedef float f32x2_cv __attribute__((ext_vector_type(2))); typedef __bf16 bf16x2_cv __attribute__((ext_vector_type(2)));
__device__ __forceinline__ unsigned pk2(float lo, float hi) { f32x2_cv v = {lo, hi}; bf16x2_cv b = __builtin_convertvector(v, bf16x2_cv); return __builtin_bit_cast(unsigned, b); }
__device__ __forceinline__ float bf_lo(unsigned w) { return __builtin_bit_cast(float, w << 16); }
__device__ __forceinline__ float bf_hi(unsigned w) { return __builtin_bit_cast(float, w & 0xffff0000u); }
template <int CTRL> __device__ __forceinline__ float dppf(float v) { return __builtin_bit_cast(float, __builtin_amdgcn_update_dpp(0, __builtin_bit_cast(int, v), CTRL, 0xf, 0xf, true)); }
__device__ __forceinline__ void swap16(float v, float& a, float& b) { a = v; b = v; asm volatile("s_nop 1\n\tv_permlane16_swap_b32 %0, %1" : "+v"(a), "+v"(b)); }
__device__ __forceinline__ void swap32(float v, float& a, float& b) { a = v; b = v; asm volatile("s_nop 1\n\tv_permlane32_swap_b32 %0, %1" : "+v"(a), "+v"(b)); }
__device__ __forceinline__ float xor16_sum(float v) { float a, b; swap16(v, a, b); return a + b; }
__device__ __forceinline__ float xor32_sum(float v) { float a, b; swap32(v, a, b); return a + b; }
__device__ __forceinline__ float xor16_max(float v) { float a, b; swap16(v, a, b); return fmaxf(a, b); }
__device__ __forceinline__ float xor32_max(float v) { float a, b; swap32(v, a, b); return fmaxf(a, b); }
__device__ __forceinline__ float wave_sum(float v) {
    v += dppf<0xB1>(v); v += dppf<0x4E>(v); v += dppf<0x141>(v); v += dppf<0x140>(v);
    return xor32_sum(xor16_sum(v));
}
#define LDS_WAIT() asm volatile("s_waitcnt lgkmcnt(0)" ::: "memory")
__device__ __forceinline__ int opaque_tid() { int t = threadIdx.x; asm volatile("" : "+v"(t)); return t; }
__device__ __forceinline__ int opaque_s(int v) { asm volatile("" : "+s"(v)); return v; }

__device__ __forceinline__ float* mod_ptr(const Params& p, int l, int r) { return (float*)(p.ws + WS_MOD) + ((size_t)l * 5 + r) * NMOD; }

#define XB_TMO      128
#define XB_XCNT(j)  (256  + 64 * (j))
#define XB_XSUB(j)  (1280 + 64 * (j))
#define XB_XGEN(j)  (2304 + 64 * (j))
#define XB_TOP      3328
#define XB_TOPGEN   3392
#define XCD_BAR_WORDS 3456
#define XB_SPIN_CAP (1u << 20)
__device__ __forceinline__ unsigned xb_ld(unsigned* p)              { return __hip_atomic_load(p, __ATOMIC_RELAXED, __HIP_MEMORY_SCOPE_AGENT); }
__device__ __forceinline__ unsigned xb_add(unsigned* p, unsigned v) { return __hip_atomic_fetch_add(p, v, __ATOMIC_RELAXED, __HIP_MEMORY_SCOPE_AGENT); }
__device__ __forceinline__ unsigned xb_xcc_id() { return (unsigned)__builtin_amdgcn_s_getreg((3 << 11) | 20) & 0xFu; }
#define XB_SPIN(cond, bar) do { unsigned _sp = 0; while (cond) { __builtin_amdgcn_s_sleep(1); \
    if ((++_sp & 255u) == 0u) { if (xb_ld(&(bar)[XB_TMO])) break; if (_sp > XB_SPIN_CAP) { atomicAdd(&(bar)[XB_TMO], 1u); break; } } } } while (0)
struct XcdBarrier { unsigned* bar; unsigned x; volatile LAS unsigned* st; };
__device__ __forceinline__ XcdBarrier xcd_barrier_post(unsigned* bar, volatile LAS unsigned* st) {
    XcdBarrier b; b.bar = bar; b.x = xb_xcc_id(); b.st = st;
    if (threadIdx.x == 0) (void)xb_add(&bar[XB_XCNT(b.x)], 1u);
    return b;
}
__device__ __forceinline__ void xcd_barrier_complete(unsigned* bar, unsigned x, unsigned& nloc, unsigned& nx) {
    const unsigned G = gridDim.x * gridDim.y * gridDim.z;
    unsigned sum, cnt, mine, sp = 0u;
    for (;;) {
        sum = 0u; cnt = 0u; mine = 0u;
#pragma unroll 1
        for (unsigned j = 0; j < 16; ++j) { const unsigned c = xb_ld(&bar[XB_XCNT(j)]); sum += c; cnt += (c > 0u) ? 1u : 0u; mine = (j == x) ? c : mine; }
        if (sum == G) break;
        __builtin_amdgcn_s_sleep(1);
        if ((++sp & 255u) == 0u) { if (xb_ld(&bar[XB_TMO])) break; if (sp > XB_SPIN_CAP) { atomicAdd(&bar[XB_TMO], 1u); break; } }
    }
    nloc = mine > 0u ? mine : 1u; nx = cnt > 0u ? cnt : 1u;
}
__device__ __forceinline__ void xcd_barrier(const XcdBarrier& b) {
    asm volatile("s_waitcnt vmcnt(0)" ::: "memory");
    __syncthreads();
    if (threadIdx.x == 0) {
        unsigned* bar = b.bar; asm volatile("" : "+s"(bar));
        __builtin_amdgcn_s_waitcnt(0);
        unsigned nloc = b.st[0], nx = b.st[1];
        if (nloc == 0u) { xcd_barrier_complete(bar, b.x, nloc, nx); b.st[0] = nloc; b.st[1] = nx; }
        const unsigned old = xb_add(&bar[XB_XSUB(b.x)], 1u);
        const unsigned gen = old / nloc;
        if (old + 1u == (gen + 1u) * nloc) {
            __builtin_amdgcn_fence(__ATOMIC_RELEASE, "agent");
            asm volatile("s_waitcnt vmcnt(0)" ::: "memory");
            const unsigned og = xb_add(&bar[XB_TOP], 1u);
            const unsigned tg = og / nx;
            if (og + 1u == (tg + 1u) * nx) xb_add(&bar[XB_TOPGEN], 1u);
            else XB_SPIN(xb_ld(&bar[XB_TOPGEN]) == tg, bar);
            __builtin_amdgcn_fence(__ATOMIC_ACQUIRE, "agent");
            xb_add(&bar[XB_XGEN(b.x)], 1u);
            asm volatile("s_waitcnt vmcnt(0)" ::: "memory");
        } else {
            XB_SPIN(xb_ld(&bar[XB_XGEN(b.x)]) == gen, bar);
            __builtin_amdgcn_fence(__ATOMIC_ACQUIRE, "agent");
            asm volatile("s_waitcnt vmcnt(0)" ::: "memory");
        }
    }
    __syncthreads();
}

struct TrItem { const float* W; bf16_t* WT; int K, N, mode, item; };
__device__ __forceinline__ void tr_load(const TrItem& t, int lane, float (&r)[32]) {
    const int nblk = t.N / 32, kb = t.item / nblk, nb = t.item % nblk, k0 = 64 * kb, n0 = 32 * nb;
    const float* src = t.W + (size_t)(k0 + (lane >> 5)) * t.N + n0 + (lane & 31);
#pragma unroll
    for (int i = 0; i < 32; ++i) r[i] = src[(size_t)(2 * i) * t.N];
}
__device__ __forceinline__ void tr_finish(const TrItem& t, int lane, const float (&r)[32], LAS float* scr) {
    const int nblk = t.N / 32, kb = t.item / nblk, nb = t.item % nblk, k0 = 64 * kb, n0 = 32 * nb;
#pragma unroll
    for (int i = 0; i < 32; ++i) scr[(2 * i + (lane >> 5)) * 33 + (lane & 31)] = r[i];
    LDS_WAIT();
    const int c = lane & 7;
#pragma unroll
    for (int j = 0; j < 4; ++j) {
        const int n = (lane >> 3) + 8 * j; const LAS float* s = scr + (8 * c) * 33 + n;
        u32x4 o; o.x = pk2(s[0 * 33], s[1 * 33]); o.y = pk2(s[2 * 33], s[3 * 33]); o.z = pk2(s[4 * 33], s[5 * 33]); o.w = pk2(s[6 * 33], s[7 * 33]);
        const int f = n0 + n;
        const int orow = t.mode == 0 ? ((f & ~255) + 128 * ((f >> 4) & 1) + 32 * ((f >> 6) & 3) + 16 * ((f >> 2) & 1) + 4 * (2 * ((f >> 5) & 1) + ((f >> 3) & 1)) + (f & 3))
                                     : (256 * (f >> 7) + (t.mode == 2 ? 128 : 0) + 32 * ((f >> 5) & 3) + 16 * ((f >> 2) & 1) + 4 * ((f >> 3) & 3) + (f & 3));
        *(u32x4*)(t.WT + (size_t)orow * t.K + k0 + 8 * c) = o;
    }
    LDS_WAIT();
}
__device__ __forceinline__ void phase_prologue(const Params& p, LAS unsigned char* lds, int bid, int nb) {
    bid = opaque_s(bid); const int tid = opaque_tid(), lane = tid & 63, w = tid >> 6;
    {
        LAS float* ssil = (LAS float*)lds;
        LAS float* red = ssil + 5 * 1024;
        for (int i = tid; i < 5 * 1024; i += NTHREADS) { const int r = i >> 10, k = i & 1023; const float v = r < 4 ? p.c[r * 1024 + k] : p.c_ctx[k]; ssil[i] = v / (1.f + expf(-v)); }
        __syncthreads();
        for (int item = bid; item < 2 * 96; item += nb) {
            const int l = item / 96, n0 = (item % 96) * 64;
            const float* W = p.w_mod + (size_t)l * DM * NMOD + n0 + lane;
            float a0 = 0.f, a1 = 0.f, a2 = 0.f, a3 = 0.f, a4 = 0.f;
#pragma unroll 8
            for (int k = w * 128; k < w * 128 + 128; ++k) {
                const float wv = W[(size_t)k * NMOD];
                a0 += ssil[k] * wv; a1 += ssil[1024 + k] * wv; a2 += ssil[2048 + k] * wv; a3 += ssil[3072 + k] * wv; a4 += ssil[4096 + k] * wv;
            }
            red[(w * 5 + 0) * 64 + lane] = a0; red[(w * 5 + 1) * 64 + lane] = a1; red[(w * 5 + 2) * 64 + lane] = a2; red[(w * 5 + 3) * 64 + lane] = a3; red[(w * 5 + 4) * 64 + lane] = a4;
            __syncthreads();
            if (tid < 320) { const int r = tid >> 6; float s = 0.f;
#pragma unroll
                for (int ww = 0; ww < 8; ++ww) s += red[(ww * 5 + r) * 64 + lane];
                mod_ptr(p, l, r)[n0 + lane] = s + p.b_mod[l * NMOD + n0 + lane]; }
            __syncthreads();
        }
    }
    if (bid == nb - 1) {
        float* rope = (float*)(p.ws + WS_ROPE);
        for (int e = tid; e < 128 * 16; e += NTHREADS) {
            const int pos = e >> 4, i = e & 15;
            const double a = exp(-((double)i / 16.0) * 9.210340371976184);
            const double a2 = a * a; double c = 1.0, s = a, tc = 1.0, ts = a;
            for (int n = 1; n <= 14; ++n) { tc *= -a2 / (double)((2 * n - 1) * (2 * n)); c += tc; ts *= -a2 / (double)((2 * n) * (2 * n + 1)); s += ts; }
            double rc = 1.0, rs = 0.0, bc = c, bs = s; int q = pos;
            while (q) { if (q & 1) { const double t = rc * bc - rs * bs; rs = rc * bs + rs * bc; rc = t; } const double t = bc * bc - bs * bs; bs = 2.0 * bc * bs; bc = t; q >>= 1; }
            rope[2 * e] = (float)rc; rope[2 * e + 1] = (float)rs;
        }
    }
}

constexpr int TR_I_IN = 16 * 80, TR_I_OUT = 16 * 32, TR_I_G = 16 * 16, TR_I_D = 8 * 32, TR_PER_L = TR_I_IN + TR_I_OUT + 16 * (2 * TR_I_G + TR_I_D);
constexpr int TR_P0 = TR_I_IN + TR_I_OUT, TR_SPLIT = TR_PER_L + TR_I_IN + TR_I_OUT;
__device__ __forceinline__ void phase_weights(const Params& p, LAS unsigned char* lds, int bid, int nb, int lo, int hi) {
    bid = opaque_s(bid); const int tid = opaque_tid(), lane = tid & 63, w = tid >> 6;
    {
        LAS float* scr = (LAS float*)lds + w * (64 * 33);
        const int gw = bid * NWAVES + w, NGW = nb * NWAVES;
        constexpr int I_IN = TR_I_IN, I_OUT = TR_I_OUT, I_G = TR_I_G, I_D = TR_I_D, PER_L = TR_PER_L;
        auto decode = [&](int it) -> TrItem {
            const int l = it / PER_L; int r = it % PER_L;
            if (r < I_IN) return TrItem{p.w_in + (size_t)l * DM * INW, (bf16_t*)(p.ws + WS_WIN) + (size_t)l * INW * DM, DM, INW, 0, r}; r -= I_IN;
            if (r < I_OUT) return TrItem{p.w_out + (size_t)l * DM * DM, (bf16_t*)(p.ws + WS_WOUT) + (size_t)l * DM * DM, DM, DM, 0, r}; r -= I_OUT;
            if (r < 16 * I_G) { const int e = r / I_G; return TrItem{p.w_gate + ((size_t)l * NE + e) * DM * FF, (bf16_t*)(p.ws + WS_WGU) + ((size_t)l * NE + e) * 1024 * DM, DM, FF, 1, r % I_G}; } r -= 16 * I_G;
            if (r < 16 * I_G) { const int e = r / I_G; return TrItem{p.w_up + ((size_t)l * NE + e) * DM * FF, (bf16_t*)(p.ws + WS_WGU) + ((size_t)l * NE + e) * 1024 * DM, DM, FF, 2, r % I_G}; } r -= 16 * I_G;
            const int e = r / I_D; return TrItem{p.w_down + ((size_t)l * NE + e) * FF * DM, (bf16_t*)(p.ws + WS_WD) + ((size_t)l * NE + e) * DM * FF, FF, DM, 0, r % I_D};
        };
        float ra[32], rb[32];
        int it = lo + gw;
        if (it < hi) { TrItem cur = decode(it); tr_load(cur, lane, ra);
#pragma unroll 1
            for (;;) {
                const int itn = it + NGW; const bool hn = itn < hi; TrItem nx = cur;
                if (hn) { nx = decode(itn); tr_load(nx, lane, rb); }
                tr_finish(cur, lane, ra, scr);
                if (!hn) break;
                const int itn2 = itn + NGW; const bool hn2 = itn2 < hi; TrItem nx2 = nx;
                if (hn2) { nx2 = decode(itn2); tr_load(nx2, lane, ra); }
                tr_finish(nx, lane, rb, scr);
                if (!hn2) break;
                cur = nx2; it = itn2;
            }
        }
    }
}

__device__ __forceinline__ void row_load(const float* rowp, int lane, f32x4 (&v)[4]) {
#pragma unroll
    for (int j = 0; j < 4; ++j) v[j] = *(const f32x4*)(rowp + 256 * j + 4 * lane);
}
__device__ __forceinline__ void row_load_bf16(const bf16_t* rowp, int lane, f32x4 (&v)[4]) {
#pragma unroll
    for (int j = 0; j < 4; ++j) { const u32x2 w = *(const u32x2*)(rowp + 256 * j + 4 * lane); v[j] = (f32x4){bf_lo(w.x), bf_hi(w.x), bf_lo(w.y), bf_hi(w.y)}; }
}
__device__ __forceinline__ void row_store(float* rowp, int lane, const f32x4 (&v)[4]) {
#pragma unroll
    for (int j = 0; j < 4; ++j) *(f32x4*)(rowp + 256 * j + 4 * lane) = v[j];
}
__device__ __forceinline__ void row_store_bf16(bf16_t* rowp, int lane, const f32x4 (&v)[4]) {
#pragma unroll
    for (int j = 0; j < 4; ++j) { u32x2 o; o.x = pk2(v[j][0], v[j][1]); o.y = pk2(v[j][2], v[j][3]); *(u32x2*)(rowp + 256 * j + 4 * lane) = o; }
}
__device__ __forceinline__ void row_normalize(f32x4 (&v)[4]) {
    float s = 0.f;
#pragma unroll
    for (int j = 0; j < 4; ++j) s += (v[j][0] + v[j][1]) + (v[j][2] + v[j][3]);
    const float mean = wave_sum(s) * (1.f / DM);
    float q = 0.f;
#pragma unroll
    for (int j = 0; j < 4; ++j) { v[j] = v[j] - mean; q += (v[j][0] * v[j][0] + v[j][1] * v[j][1]) + (v[j][2] * v[j][2] + v[j][3] * v[j][3]); }
    const float rstd = 1.f / sqrtf(wave_sum(q) * (1.f / DM) + LN_EPS);
#pragma unroll
    for (int j = 0; j < 4; ++j) v[j] = v[j] * rstd;
}
__device__ __forceinline__ void row_modulate(f32x4 (&v)[4], const float* sh, const float* sc, int lane) {
#pragma unroll
    for (int j = 0; j < 4; ++j) { const f32x4 a = *(const f32x4*)(sc + 256 * j + 4 * lane), b = *(const f32x4*)(sh + 256 * j + 4 * lane); v[j] = v[j] * (a + 1.f) + b; }
}
__device__ __forceinline__ void row_affine(f32x4 (&v)[4], const float* g, const float* bb, int lane) {
#pragma unroll
    for (int j = 0; j < 4; ++j) { const f32x4 a = *(const f32x4*)(g + 256 * j + 4 * lane), b = *(const f32x4*)(bb + 256 * j + 4 * lane); v[j] = v[j] * a + b; }
}
__device__ __forceinline__ void row_modulate_l(f32x4 (&v)[4], const LAS float* sh, const LAS float* sc, int lane) {
#pragma unroll
    for (int j = 0; j < 4; ++j) { const f32x4 a = *(const LAS f32x4*)(sc + 256 * j + 4 * lane), b = *(const LAS f32x4*)(sh + 256 * j + 4 * lane); v[j] = v[j] * (a + 1.f) + b; }
}
__device__ __forceinline__ void row_affine_l(f32x4 (&v)[4], const LAS float* g, const LAS float* bb, int lane) {
#pragma unroll
    for (int j = 0; j < 4; ++j) { const f32x4 a = *(const LAS f32x4*)(g + 256 * j + 4 * lane), b = *(const LAS f32x4*)(bb + 256 * j + 4 * lane); v[j] = v[j] * a + b; }
}
__device__ __forceinline__ int row_modrow(int row) { return row < NLAT ? (row >> 13) : 4; }
__device__ __forceinline__ void lds_fill(LAS float* dst, const float* src, int n, int tid) { for (int i = tid * 4; i < n; i += NTHREADS * 4) *(LAS f32x4*)(dst + i) = *(const f32x4*)(src + i); }
template <int N> __device__ __forceinline__ void lds_fill_vecs(LAS float* dst0, const float* const (&src)[N], int tid) {
    constexpr int H = (N + 1) / 2; f32x4 t[H]; const int h = tid >> 8, i4 = (tid & 255) * 4;
#pragma unroll
    for (int k = 0; k < H; ++k) { const float* s = (2 * k + 1 < N && h) ? src[2 * k + 1] : src[2 * k]; t[k] = *(const f32x4*)(s + i4); }
#pragma unroll
    for (int k = 0; k < H; ++k) { const int v = 2 * k + h; if (v < N) *(LAS f32x4*)(dst0 + v * DM + i4) = t[k]; }
}

__device__ __forceinline__ void phase_ln1(const Params& p, LAS unsigned char* lds, int bid, int nb) {
    bid = opaque_s(bid); const int tid = opaque_tid(), lane = tid & 63, gw = bid * NWAVES + (tid >> 6), NGW = nb * NWAVES;
    LAS float* lsh = (LAS float*)lds; LAS float* lsc = lsh + 5 * DM;
    { const float* const srcs[10] = {mod_ptr(p, 0, 0), mod_ptr(p, 0, 1), mod_ptr(p, 0, 2), mod_ptr(p, 0, 3), mod_ptr(p, 0, 4),
                                     mod_ptr(p, 0, 0) + DM, mod_ptr(p, 0, 1) + DM, mod_ptr(p, 0, 2) + DM, mod_ptr(p, 0, 3) + DM, mod_ptr(p, 0, 4) + DM};
      lds_fill_vecs<10>(lsh, srcs, tid); }
    __syncthreads();
    bf16_t* HB = (bf16_t*)(p.ws + WS_HB);
    auto rowp = [&](int r) { r = min(r, NROWS - 1); return r < NLAT ? p.x + (size_t)r * DM : p.ctx + (size_t)(r - NLAT) * DM; };
    f32x4 v[4], vn[4], vnn[4];
    row_load(rowp(gw), lane, v); row_load(rowp(gw + NGW), lane, vn);
#pragma unroll 1
    for (int row = gw; row < NROWS; row += NGW) {
        row_load(rowp(row + 2 * NGW), lane, vnn);
        row_normalize(v);
        { const int mr = row_modrow(row); row_modulate_l(v, lsh + mr * DM, lsc + mr * DM, lane); }
        row_store_bf16(HB + (size_t)row * DM, lane, v);
#pragma unroll
        for (int j = 0; j < 4; ++j) { v[j] = vn[j]; vn[j] = vnn[j]; }
    }
}

struct SgDesc { const bf16_t* A; int lda; const int* rowidx; const bf16_t* Bt; size_t grp_stride; int rows_per_grp, ngrp; int M, N, K; int row_base; };
template <class Epi>
__device__ __forceinline__ void sg_gemm(const SgDesc& g, const Epi& E, LAS unsigned char* lds, int bid, int nb) {
    bid = opaque_s(bid); const int tid = opaque_tid(); const int lane = tid & 63, w = __builtin_amdgcn_readfirstlane(tid >> 6), fr = lane & 15, fq = lane >> 4, wm = w >> 1, wn = w & 1;
    const int tilesN = g.N / 128, tiles = (g.M / 128) * tilesN, nk = g.K / 64;
    const int sr = tid >> 3, sp = tid & 7;
    const int soff = sr * 128 + ((sp ^ ((sr >> 1) & 7)) << 4);
    int aoff[2][2], boff[4][2];
#pragma unroll
    for (int ks = 0; ks < 2; ++ks) {
#pragma unroll
        for (int i = 0; i < 2; ++i) { const int r = 32 * wm + 16 * i + fr; aoff[i][ks] = r * 128 + (((fq + 4 * ks) ^ ((r >> 1) & 7)) << 4); }
#pragma unroll
        for (int n = 0; n < 4; ++n) { const int r = 64 * (n >> 1) + 32 * wn + 16 * (n & 1) + fr; boff[n][ks] = 16384 + r * 128 + (((fq + 4 * ks) ^ ((r >> 1) & 7)) << 4); }
    }
#pragma unroll 1
    for (int t = bid; t < tiles; t += nb) {
        const int tm = t / tilesN, tn = t % tilesN, pn = tn >> 1, wp = tn & 1;
        const int row0 = tm * 128;
        const bf16_t* Bt = g.Bt + (size_t)((row0 / g.rows_per_grp) % g.ngrp) * g.grp_stride;
        const bf16_t* as[2]; const bf16_t* bs[2];
#pragma unroll
        for (int h = 0; h < 2; ++h) { const int r = row0 + sr + 64 * h; const int ar = g.rowidx ? g.rowidx[r] : r; as[h] = g.A + (size_t)ar * g.lda + sp * 8;
            bs[h] = Bt + (size_t)(256 * pn + 128 * h + 64 * wp + sr) * g.K + sp * 8; }
        f32x4 acc[2][4];
#pragma unroll
        for (int i = 0; i < 2; ++i)
#pragma unroll
            for (int n = 0; n < 4; ++n) acc[i][n] = (f32x4){0.f, 0.f, 0.f, 0.f};
        u32x4 ra[2], rb[2];
#pragma unroll
        for (int h = 0; h < 2; ++h) { ra[h] = *(const u32x4*)(as[h]); rb[h] = *(const u32x4*)(bs[h]); }
#pragma unroll
        for (int h = 0; h < 2; ++h) { *(LAS u32x4*)(lds + soff + h * 8192) = ra[h]; *(LAS u32x4*)(lds + 16384 + soff + h * 8192) = rb[h]; }
        __syncthreads();
#pragma unroll 1
        for (int k = 0; k < nk; ++k) {
            const LAS unsigned char* buf = lds + (k & 1) * 32768;
            if (k + 1 < nk) {
#pragma unroll
                for (int h = 0; h < 2; ++h) { ra[h] = *(const u32x4*)(as[h] + (k + 1) * 64); rb[h] = *(const u32x4*)(bs[h] + (k + 1) * 64); } }
#pragma unroll
            for (int ks = 0; ks < 2; ++ks) {
                bf16x8 a[2], b[4];
#pragma unroll
                for (int i = 0; i < 2; ++i) a[i] = *(const LAS bf16x8*)(buf + aoff[i][ks]);
#pragma unroll
                for (int n = 0; n < 4; ++n) b[n] = *(const LAS bf16x8*)(buf + boff[n][ks]);
#pragma unroll
                for (int i = 0; i < 2; ++i)
#pragma unroll
                    for (int n = 0; n < 4; ++n) acc[i][n] = __builtin_amdgcn_mfma_f32_16x16x32_bf16(b[n], a[i], acc[i][n], 0, 0, 0);
            }
            if (k + 1 < nk) { LAS unsigned char* nbuf = lds + ((k + 1) & 1) * 32768;
#pragma unroll
                for (int h = 0; h < 2; ++h) { *(LAS u32x4*)(nbuf + soff + h * 8192) = ra[h]; *(LAS u32x4*)(nbuf + 16384 + soff + h * 8192) = rb[h]; } }
            __syncthreads();
        }
#pragma unroll
        for (int i = 0; i < 2; ++i) {
            const int row = g.row_base + row0 + 32 * wm + 16 * i + fr; const float rv = E.rowval(row);
            E(row, pn, 2 * wp + wn, fq, acc[i][0], acc[i][1], acc[i][2], acc[i][3], rv);
        }
    }
}

__device__ __forceinline__ void store_bf16x8(bf16_t* p, const f32x4 a, const f32x4 b) { u32x4 o; o.x = pk2(a[0], a[1]); o.y = pk2(a[2], a[3]); o.z = pk2(b[0], b[1]); o.w = pk2(b[2], b[3]); *(u32x4*)p = o; }
__device__ __forceinline__ int epi_col(int pn, int wc, int fq) { return 256 * pn + 64 * wc + 32 * (fq >> 1) + 8 * (fq & 1); }

__device__ __forceinline__ u32x4 pack_bf16x8(const f32x4 a, const f32x4 b) { u32x4 o; o.x = pk2(a[0], a[1]); o.y = pk2(a[2], a[3]); o.z = pk2(b[0], b[1]); o.w = pk2(b[2], b[3]); return o; }
struct EpiQKV {
    static constexpr bool STAGED = true;
    bf16_t* PB; const float* rope; bf16_t* KV;
    __device__ __forceinline__ float rowval(int) const { return 0.f; }
    __device__ __forceinline__ void vals(int row, int pn, int wc, int fq, f32x4 a0, f32x4 a1, f32x4 b0, f32x4 b1, float, u32x4& ra, u32x4& rb) const {
        const int c = epi_col(pn, wc, fq);
        if (c < 512 && row < NLAT) {
            const int t = row & (SEQ - 1); const int pos = (fq >> 1) ? (t & 63) : (t >> 6);
            const f32x4* rp = (const f32x4*)(rope + (pos * 16 + 8 * (fq & 1)) * 2);
            const f32x4 r0 = rp[0], r1 = rp[1], r2 = rp[2], r3 = rp[3];
            const f32x4 cs0 = {r0[0], r0[2], r1[0], r1[2]}, sn0 = {r0[1], r0[3], r1[1], r1[3]}, cs1 = {r2[0], r2[2], r3[0], r3[2]}, sn1 = {r2[1], r2[3], r3[1], r3[3]};
            const f32x4 na0 = a0 * cs0 - b0 * sn0, nb0 = b0 * cs0 + a0 * sn0, na1 = a1 * cs1 - b1 * sn1, nb1 = b1 * cs1 + a1 * sn1;
            a0 = na0; b0 = nb0; a1 = na1; b1 = nb1;
        }
        ra = pack_bf16x8(a0, a1); rb = pack_bf16x8(b0, b1);
    }
    __device__ __forceinline__ bf16_t* ptr(int row, int c) const {
        const bool isk = (c >= C_KA && c < C_BX) || c >= C_KN;
        if (isk) {
            const int hd = c < C_BX ? ((c - C_KA) >> 6) & 1 : 2 + ((c - C_KN) >> 6) % 6, isv = c < C_BX ? (c >= C_VA) : (c >= C_VN);
            const int bb = row < NLAT ? row >> 13 : (row - NLAT) >> 8, tok = row < NLAT ? row & (SEQ - 1) : SEQ + ((row - NLAT) & (CTXL - 1));
            return KV + ((size_t)(bb * 8 + hd) * KV_TOK + tok) * 128 + isv * 64 + (c & 63);
        }
        return PB + (size_t)row * INW + c;
    }
    __device__ __forceinline__ void operator()(int row, int pn, int wc, int fq, f32x4 a0, f32x4 a1, f32x4 b0, f32x4 b1, float rv) const {
        u32x4 ra, rb; vals(row, pn, wc, fq, a0, a1, b0, b1, rv, ra, rb); const int c = epi_col(pn, wc, fq); *(u32x4*)ptr(row, c) = ra; *(u32x4*)ptr(row, c + 16) = rb; }
};
template <bool FIRST> struct EpiOut {
    static constexpr bool STAGED = true;
    const float* xl; const float* xc; bf16_t* XB; const float* mod;
    __device__ __forceinline__ float rowval(int) const { return 0.f; }
    __device__ __forceinline__ void vals(int row, int pn, int wc, int fq, f32x4 a0, f32x4 a1, f32x4 b0, f32x4 b1, float, u32x4& ra, u32x4& rb) const {
        const int c = epi_col(pn, wc, fq); const bf16_t* xo = XB + (size_t)row * DM + c;
        const float* g1 = mod + (size_t)row_modrow(row) * NMOD + 2 * DM + c;
        f32x4 xa0, xa1, xb0, xb1;
        if (FIRST) { const float* xin = row < NLAT ? xl + (size_t)row * DM + c : xc + (size_t)(row - NLAT) * DM + c;
            xa0 = *(const f32x4*)xin; xa1 = *(const f32x4*)(xin + 4); xb0 = *(const f32x4*)(xin + 16); xb1 = *(const f32x4*)(xin + 20); }
        else { const u32x4 wa = *(const u32x4*)xo, wb = *(const u32x4*)(xo + 16);
            xa0 = (f32x4){bf_lo(wa.x), bf_hi(wa.x), bf_lo(wa.y), bf_hi(wa.y)}; xa1 = (f32x4){bf_lo(wa.z), bf_hi(wa.z), bf_lo(wa.w), bf_hi(wa.w)};
            xb0 = (f32x4){bf_lo(wb.x), bf_hi(wb.x), bf_lo(wb.y), bf_hi(wb.y)}; xb1 = (f32x4){bf_lo(wb.z), bf_hi(wb.z), bf_lo(wb.w), bf_hi(wb.w)}; }
        const f32x4 ga0 = *(const f32x4*)g1, ga1 = *(const f32x4*)(g1 + 4), gb0 = *(const f32x4*)(g1 + 16), gb1 = *(const f32x4*)(g1 + 20);
        ra = pack_bf16x8(xa0 * ALPHA + ga0 * a0, xa1 * ALPHA + ga1 * a1); rb = pack_bf16x8(xb0 * ALPHA + gb0 * b0, xb1 * ALPHA + gb1 * b1);
    }
    __device__ __forceinline__ bf16_t* ptr(int row, int c) const { return XB + (size_t)row * DM + c; }
    __device__ __forceinline__ void operator()(int row, int pn, int wc, int fq, f32x4 a0, f32x4 a1, f32x4 b0, f32x4 b1, float rv) const {
        u32x4 ra, rb; vals(row, pn, wc, fq, a0, a1, b0, b1, rv, ra, rb); const int c = epi_col(pn, wc, fq); *(u32x4*)ptr(row, c) = ra; *(u32x4*)ptr(row, c + 16) = rb; }
};
struct EpiGU {
    static constexpr bool STAGED = false;
    bf16_t* HH;
    __device__ __forceinline__ float rowval(int) const { return 0.f; }
    __device__ __forceinline__ void operator()(int row, int pn, int wc, int fq, f32x4 a0, f32x4 a1, f32x4 b0, f32x4 b1, float) const {
        f32x4 h0, h1;
#pragma unroll
        for (int j = 0; j < 4; ++j) { h0[j] = a0[j] * __builtin_amdgcn_rcpf(1.f + __expf(-a0[j])) * b0[j]; h1[j] = a1[j] * __builtin_amdgcn_rcpf(1.f + __expf(-a1[j])) * b1[j]; }
        store_bf16x8(HH + (size_t)row * FF + 128 * pn + 32 * wc + 8 * fq, h0, h1);
    }
};
struct EpiDown {
    static constexpr bool STAGED = true;
    bf16_t* Y; const float* gate;
    __device__ __forceinline__ float rowval(int row) const { return gate[row]; }
    __device__ __forceinline__ void vals(int, int, int, int, f32x4 a0, f32x4 a1, f32x4 b0, f32x4 b1, float g, u32x4& ra, u32x4& rb) const { ra = pack_bf16x8(a0 * g, a1 * g); rb = pack_bf16x8(b0 * g, b1 * g); }
    __device__ __forceinline__ bf16_t* ptr(int row, int c) const { return Y + (size_t)row * DM + c; }
    __device__ __forceinline__ void operator()(int row, int pn, int wc, int fq, f32x4 a0, f32x4 a1, f32x4 b0, f32x4 b1, float g) const {
        u32x4 ra, rb; vals(row, pn, wc, fq, a0, a1, b0, b1, g, ra, rb); const int c = epi_col(pn, wc, fq); *(u32x4*)ptr(row, c) = ra; *(u32x4*)ptr(row, c + 16) = rb; }
};

namespace mg {
constexpr int BM = 256, BK = 64, HALF = 128, HTB = HALF * BK * 2, STAGE_BYTES = 8 * HTB, NXCD = 8, WGM = 8, MAXU = 8;
__device__ __forceinline__ int lds_byte(int r, int c) { const int st = (r >> 4) * 2 + (c >> 5), rr = r & 15, cc = c & 31, ob = rr * 64 + cc * 2; return st * 1024 + (ob ^ (((ob >> 9) & 1) << 5)); }
__device__ __forceinline__ void stage_rc(int b, int& R, int& C) { const int st = b / 1024, sb = b % 1024, swz = sb ^ (((sb >> 9) & 1) << 5); R = (st >> 1) * 16 + swz / 64; C = (st & 1) * 32 + (swz % 64) / 2; }
struct Unit { int pm, pn; };
struct Gemm { const bf16_t* A; const bf16_t* Bt; int M, N, K; const int* rowidx; size_t grp_stride; int grp_tiles, ngrp; };
struct StaticOrder {
    int nM, nN, nwg, G, c;
    __device__ void init(int M, int N, int G_, int c_) { nM = M / BM; nN = N / BM; nwg = nM * nN; G = G_; c = c_; }
    __device__ bool next(int i, Unit& u) const {
        const long L = (long)i * G + c; if (L >= nwg) return false;
        int wgid = (int)L; { const int q = nwg / NXCD, r = nwg % NXCD, xcd = wgid % NXCD, off = wgid / NXCD; wgid = (xcd < r ? xcd * (q + 1) : r * (q + 1) + (xcd - r) * q) + off; }
        const int nig = WGM * nN, gid = wgid / nig, fm = gid * WGM, gsz = (nM - fm) < WGM ? (nM - fm) : WGM;
        u.pm = fm + ((wgid % nig) % gsz); u.pn = (wgid % nig) / gsz; return true;
    }
};
template <class Epi>
__device__ __forceinline__ void gemm_phase(LAS unsigned char* lds, LAS int* idxl, const Gemm g, const StaticOrder& S, const Epi& E) {
    const int tid = opaque_tid(), wid = __builtin_amdgcn_readfirstlane(tid >> 6), lane = tid & 63, wr = wid >> 2, wc = wid & 3, fr = lane & 15, fq = lane >> 4;
    const int K = g.K, nt = K / BK;
    unsigned voffB[2];
#pragma unroll
    for (int i = 0; i < 2; ++i) { int R_, C_; stage_rc(tid * 16 + i * 8192, R_, C_); voffB[i] = (unsigned)(R_ * K + C_) * 2u; }
    const size_t kstep = (size_t)(BK * 2);
    const size_t hstep = (size_t)HALF * K * 2;
    const size_t tstep = 2 * hstep;
    const unsigned ldsw = (unsigned)wid * 1024u;
    const int aoff = lds_byte(wr * 64 + fr, fq * 8), boff = lds_byte(wc * 32 + fr, fq * 8);
    Unit cur, nxt; int ui = 0;
    if (!S.next(0, cur)) return;
#ifndef MG_STAGGER_TICKS
#define MG_STAGGER_TICKS 0
#endif
    if (MG_STAGGER_TICKS && (blockIdx.x & 8)) { const unsigned long long t0 = __builtin_amdgcn_s_memrealtime(); while (__builtin_amdgcn_s_memrealtime() - t0 < MG_STAGGER_TICKS) __builtin_amdgcn_s_sleep(16); }
    if (g.rowidx) {
        for (int i = 0; i < MAXU; ++i) { Unit u; if (!S.next(i, u)) break; if (tid < 256) idxl[i * 256 + tid] = g.rowidx[u.pm * BM + tid]; }
        asm volatile("s_waitcnt vmcnt(0) lgkmcnt(0)" ::: "memory"); __builtin_amdgcn_s_barrier(); asm volatile("" ::: "memory");
    }
#define MG_AOFFS(dst, u_, ui_) do { _Pragma("unroll") for (int i_ = 0; i_ < 2; ++i_) { int R_, C_; stage_rc(tid * 16 + i_ * 8192, R_, C_); _Pragma("unroll") for (int h_ = 0; h_ < 2; ++h_) { \
        const int rr_ = g.rowidx ? idxl[(ui_) * 256 + h_ * HALF + R_] : ((u_).pm * BM + h_ * HALF + R_); dst[h_][i_] = (unsigned)(rr_ * K + C_) * 2u; } } } while (0)
#define MG_BPTR(u_) ((const char*)g.Bt + ((size_t)(((u_).pm / g.grp_tiles) % g.ngrp) * g.grp_stride) * 2 + (size_t)(u_).pn * tstep)
#define PG8_SA(b, h) (((b) * 2 + (h)) * HTB)
#define PG8_SB(b, h) ((4 + (b) * 2 + (h)) * HTB)
#define PG8_STAGE(bufoff, gbase, voff) do { _Pragma("unroll") for (int _i = 0; _i < 2; ++_i) \
        __builtin_amdgcn_global_load_lds((const unsigned*)((const char*)(gbase) + (voff)[_i]), (LAS unsigned*)(lds + (bufoff) + ldsw + _i * 8192), 16, 0, 0); } while (0)
#define PG8_LDA(dst, b, h) do { _Pragma("unroll") for (int m = 0; m < 4; ++m) _Pragma("unroll") for (int k = 0; k < 2; ++k) dst[m][k] = *(const LAS bf16x8*)(lds + PG8_SA(b, h) + aoff + m * 2048 + k * 1024); } while (0)
#define PG8_LDB(dst, b, h) do { _Pragma("unroll") for (int n = 0; n < 2; ++n) _Pragma("unroll") for (int k = 0; k < 2; ++k) dst[n][k] = *(const LAS bf16x8*)(lds + PG8_SB(b, h) + boff + n * 2048 + k * 1024); } while (0)
#define PG8_MMA(ai, bj, At, Bt) do { __builtin_amdgcn_s_setprio(1); _Pragma("unroll") for (int m = 0; m < 4; ++m) _Pragma("unroll") for (int n = 0; n < 2; ++n) _Pragma("unroll") for (int k = 0; k < 2; ++k) \
        acc[ai][bj][m][n] = __builtin_amdgcn_mfma_f32_16x16x32_bf16(Bt[n][k], At[m][k], acc[ai][bj][m][n], 0, 0, 0); __builtin_amdgcn_s_setprio(0); } while (0)
#define PG8_WAIT_V(n) asm volatile("s_waitcnt vmcnt(" #n ")" ::: "memory")
#define PG8_WAIT_L(n) asm volatile("s_waitcnt lgkmcnt(" #n ")" ::: "memory")
#define PG8_BAR __builtin_amdgcn_s_barrier()
#define PG8_SCHED __builtin_amdgcn_sched_barrier(0)
    f32x4 acc[2][2][4][2];
#pragma unroll
    for (int a = 0; a < 2; ++a)
#pragma unroll
        for (int b = 0; b < 2; ++b)
#pragma unroll
            for (int m = 0; m < 4; ++m)
#pragma unroll
                for (int n = 0; n < 2; ++n) acc[a][b][m][n] = (f32x4){0.f, 0.f, 0.f, 0.f};
    bf16x8 At[4][2], B0[2][2], B1[2][2];
    unsigned cAo[2][2], o2[2][2];
    MG_AOFFS(cAo, cur, 0);
    const char* const Abase = (const char*)g.A;
    const char* cB = MG_BPTR(cur);
    PG8_STAGE(PG8_SB(0, 0), cB, voffB); PG8_STAGE(PG8_SB(0, 1), cB + hstep, voffB); PG8_STAGE(PG8_SA(0, 0), Abase, cAo[0]); PG8_STAGE(PG8_SA(0, 1), Abase, cAo[1]);
    if (wr == 1) PG8_BAR;
    PG8_WAIT_V(2); PG8_BAR;
    PG8_STAGE(PG8_SB(1, 0), cB + kstep, voffB); PG8_STAGE(PG8_SA(1, 0), Abase + kstep, cAo[0]); PG8_STAGE(PG8_SB(1, 1), cB + hstep + kstep, voffB);
    PG8_WAIT_V(6); PG8_BAR;
    for (;;) {
        const bool has_next = S.next(ui + 1, nxt);
        const char* nB = has_next ? MG_BPTR(nxt) : cB;
        for (int t = 0; t < nt; t += 2) {
            const bool last = (t == nt - 2);
            const char* a1 = Abase + (size_t)(t + 1) * kstep;
            const char* a2 = last ? Abase : Abase + (size_t)(t + 2) * kstep; const char* b2 = last ? nB : cB + (size_t)(t + 2) * kstep;
            const char* a3 = a2 + kstep; const char* b3 = b2 + kstep;
            if (last && has_next) { MG_AOFFS(o2, nxt, ui + 1); } else {
#pragma unroll
                for (int h = 0; h < 2; ++h)
#pragma unroll
                    for (int i = 0; i < 2; ++i) o2[h][i] = cAo[h][i]; }
            PG8_LDB(B0, 0, 0); PG8_LDB(B1, 0, 1); PG8_SCHED; PG8_LDA(At, 0, 0); PG8_STAGE(PG8_SA(1, 1), a1, cAo[1]);
            PG8_WAIT_V(8); PG8_WAIT_L(0); PG8_BAR; PG8_MMA(0, 0, At, B0); PG8_MMA(0, 1, At, B1); PG8_BAR; PG8_SCHED;
            PG8_LDA(At, 0, 1); PG8_STAGE(PG8_SB(0, 0), b2, voffB); PG8_STAGE(PG8_SB(0, 1), b2 + hstep, voffB); PG8_STAGE(PG8_SA(0, 0), a2, o2[0]);
            PG8_WAIT_V(8); PG8_WAIT_L(0); PG8_BAR; PG8_MMA(1, 0, At, B0); PG8_MMA(1, 1, At, B1); PG8_BAR; PG8_SCHED;
            PG8_LDB(B0, 1, 0); PG8_LDB(B1, 1, 1); PG8_SCHED; PG8_LDA(At, 1, 0); PG8_STAGE(PG8_SA(0, 1), a2, o2[1]);
            PG8_WAIT_V(8); PG8_WAIT_L(0); PG8_BAR; PG8_MMA(0, 0, At, B0); PG8_MMA(0, 1, At, B1); PG8_BAR; PG8_SCHED;
            PG8_LDA(At, 1, 1); PG8_STAGE(PG8_SB(1, 0), b3, voffB); PG8_STAGE(PG8_SB(1, 1), b3 + hstep, voffB); PG8_STAGE(PG8_SA(1, 0), a3, o2[0]);
            PG8_WAIT_V(8); PG8_WAIT_L(0); PG8_BAR; PG8_MMA(1, 0, At, B0); PG8_MMA(1, 1, At, B1); PG8_BAR; PG8_SCHED;
        }
        if (wr == 0) PG8_BAR;
        E(acc, cur, wr, wc, fr, fq);
        if (!has_next) break;
#pragma unroll
        for (int a = 0; a < 2; ++a)
#pragma unroll
            for (int b = 0; b < 2; ++b)
#pragma unroll
                for (int m = 0; m < 4; ++m)
#pragma unroll
                    for (int n = 0; n < 2; ++n) acc[a][b][m][n] = (f32x4){0.f, 0.f, 0.f, 0.f};
        cur = nxt; cB = nB; ++ui;
#pragma unroll
        for (int h = 0; h < 2; ++h)
#pragma unroll
            for (int i = 0; i < 2; ++i) cAo[h][i] = o2[h][i];
        if (wr == 1) PG8_BAR;
    }
    PG8_WAIT_V(0);
    PG8_BAR;
#undef MG_AOFFS
#undef MG_BPTR
#undef PG8_SA
#undef PG8_SB
#undef PG8_STAGE
#undef PG8_LDA
#undef PG8_LDB
#undef PG8_MMA
#undef PG8_WAIT_V
#undef PG8_WAIT_L
#undef PG8_BAR
#undef PG8_SCHED
}
template <class EE> struct EpiAdapt {
    EE e; int row_base; LAS unsigned char* stg;
    __device__ __forceinline__ void operator()(const f32x4 (&acc)[2][2][4][2], const Unit& u, int wr, int wc, int fr, int fq) const {
        float rv[2][4];
#pragma unroll
        for (int ai = 0; ai < 2; ++ai)
#pragma unroll
            for (int m = 0; m < 4; ++m) rv[ai][m] = e.rowval(row_base + u.pm * BM + ai * HALF + wr * 64 + m * 16 + fr);
        if constexpr (EE::STAGED) {
            LAS unsigned char* T = stg + (4 * wr + wc) * STG_WAVE; const int lane = 16 * fq + fr;
            LAS unsigned char* wp = T + fr * 144 + 64 * (fq >> 1) + 16 * (fq & 1); const LAS unsigned char* rp = T + (lane >> 3) * 144 + (lane & 7) * 16;
            const int cb = u.pn * BM + 64 * wc + 8 * (lane & 7);
#pragma unroll
            for (int ai = 0; ai < 2; ++ai)
#pragma unroll
                for (int m = 0; m < 4; ++m) { const int row0 = row_base + u.pm * BM + ai * HALF + wr * 64 + m * 16;
                    u32x4 ra, rb; e.vals(row0 + fr, u.pn, wc, fq, acc[ai][0][m][0], acc[ai][0][m][1], acc[ai][1][m][0], acc[ai][1][m][1], rv[ai][m], ra, rb);
                    asm volatile("" ::: "memory");
                    *(LAS u32x4*)wp = ra; *(LAS u32x4*)(wp + 32) = rb;
                    asm volatile("s_waitcnt lgkmcnt(0)" ::: "memory");
                    const u32x4 v0 = *(const LAS u32x4*)rp, v1 = *(const LAS u32x4*)(rp + 8 * 144);
                    *(u32x4*)e.ptr(row0 + (lane >> 3), cb) = v0; *(u32x4*)e.ptr(row0 + 8 + (lane >> 3), cb) = v1;
                    asm volatile("" ::: "memory"); }
        } else {
#pragma unroll
            for (int ai = 0; ai < 2; ++ai)
#pragma unroll
                for (int m = 0; m < 4; ++m) { const int row = row_base + u.pm * BM + ai * HALF + wr * 64 + m * 16 + fr;
                    e(row, u.pn, wc, fq, acc[ai][0][m][0], acc[ai][0][m][1], acc[ai][1][m][0], acc[ai][1][m][1], rv[ai][m]);
                    if (m & 1) asm volatile("" ::: "memory"); }
        }
    }
};
}

struct AttnState { float m, l; float o[32]; };
__device__ __forceinline__ void attn_init(AttnState& st) { st.m = -INFINITY; st.l = 0.f;
#pragma unroll
    for (int d = 0; d < 32; ++d) st.o[d] = 0.f; }
__device__ __forceinline__ void load_row32(const bf16_t* p, float (&r)[32], float scale) {
#pragma unroll
    for (int i = 0; i < 4; ++i) { const u32x4 w = *(const u32x4*)(p + 8 * i);
        r[8 * i + 0] = bf_lo(w.x) * scale; r[8 * i + 1] = bf_hi(w.x) * scale; r[8 * i + 2] = bf_lo(w.y) * scale; r[8 * i + 3] = bf_hi(w.y) * scale;
        r[8 * i + 4] = bf_lo(w.z) * scale; r[8 * i + 5] = bf_hi(w.z) * scale; r[8 * i + 6] = bf_lo(w.w) * scale; r[8 * i + 7] = bf_hi(w.w) * scale; }
}
__device__ __forceinline__ float dot_row32(const bf16_t* p, const float (&q)[32]) {
    float d0 = 0.f, d1 = 0.f;
#pragma unroll
    for (int i = 0; i < 4; ++i) { const u32x4 w = *(const u32x4*)(p + 8 * i);
        d0 += q[8 * i + 0] * bf_lo(w.x); d1 += q[8 * i + 1] * bf_hi(w.x); d0 += q[8 * i + 2] * bf_lo(w.y); d1 += q[8 * i + 3] * bf_hi(w.y);
        d0 += q[8 * i + 4] * bf_lo(w.z); d1 += q[8 * i + 5] * bf_hi(w.z); d0 += q[8 * i + 6] * bf_lo(w.w); d1 += q[8 * i + 7] * bf_hi(w.w); }
    const float d = d0 + d1;
    return d + __shfl_xor(d, 32);
}
__device__ __forceinline__ void axpy_row32(const bf16_t* p, float a, float (&o)[32]) {
#pragma unroll
    for (int i = 0; i < 4; ++i) { const u32x4 w = *(const u32x4*)(p + 8 * i);
        o[8 * i + 0] += a * bf_lo(w.x); o[8 * i + 1] += a * bf_hi(w.x); o[8 * i + 2] += a * bf_lo(w.y); o[8 * i + 3] += a * bf_hi(w.y);
        o[8 * i + 4] += a * bf_lo(w.z); o[8 * i + 5] += a * bf_hi(w.z); o[8 * i + 6] += a * bf_lo(w.w); o[8 * i + 7] += a * bf_hi(w.w); }
}
template <class ScoreFn>
__device__ __forceinline__ void attn_segment(const float (&q)[32], AttnState& st, const bf16_t* Kb, const bf16_t* Vb, int j0, int j1, ScoreFn sf) {
#pragma unroll 1
    for (int j = j0; j < j1; ++j) {
        const float s0 = sf(j, dot_row32(Kb + (size_t)j * INW, q));
        if (s0 > st.m) { const float corr = __expf(st.m - s0); st.l *= corr;
#pragma unroll
            for (int d = 0; d < 32; ++d) st.o[d] *= corr;
            st.m = s0; }
        const float p0 = (s0 == -INFINITY) ? 0.f : __expf(s0 - st.m);
        st.l += p0;
        axpy_row32(Vb + (size_t)j * INW, p0, st.o);
    }
}
__device__ __forceinline__ void attn_sink(AttnState& st, float sk) {
    if (sk > st.m) { const float corr = __expf(st.m - sk); st.l *= corr;
#pragma unroll
        for (int d = 0; d < 32; ++d) st.o[d] *= corr;
        st.m = sk; }
    st.l += __expf(sk - st.m);
}
__device__ __forceinline__ void attn_store(const AttnState& st, bf16_t* o) {
    const float inv = 1.f / st.l;
#pragma unroll
    for (int i = 0; i < 4; ++i) { u32x4 w; w.x = pk2(st.o[8 * i] * inv, st.o[8 * i + 1] * inv); w.y = pk2(st.o[8 * i + 2] * inv, st.o[8 * i + 3] * inv);
        w.z = pk2(st.o[8 * i + 4] * inv, st.o[8 * i + 5] * inv); w.w = pk2(st.o[8 * i + 6] * inv, st.o[8 * i + 7] * inv); *(u32x4*)(o + 8 * i) = w; }
}

__device__ __forceinline__ void phase_mixers(const Params& p, int l, bool with_ctx, int bid, int nb) {
    bid = opaque_s(bid); const int tid = opaque_tid(); const int lane = tid & 63, gw = bid * NWAVES + (tid >> 6), NGW = nb * NWAVES;
    const int ql = lane & 31, hf = lane >> 5;
    const bf16_t* PB = (const bf16_t*)(p.ws + WS_PB); bf16_t* OB = (bf16_t*)(p.ws + WS_OB);
    const float* sink = p.attn_sink + l * 6; const float* rpb = p.na_rpb + (size_t)l * 6 * 15 * 31;
#if !FAST_ATTN
#pragma unroll 1
    for (int it = gw; it < NB * 6 * 256; it += NGW) {
        const int chunk = it & 255, h = (it >> 8) % 6, b = it / (6 * 256), kvh = h / 3;
        const int t = chunk * 32 + ql; const size_t rowb = (size_t)b * SEQ;
        float q[32]; load_row32(PB + (rowb + t) * INW + C_QA + h * 64 + 32 * hf, q, 0.125f);
        AttnState st; attn_init(st);
        const int jlo = max(0, chunk * 32 - 128), jhi = min(SEQ, chunk * 32 + 32 + 128);
        attn_segment(q, st, PB + rowb * INW + C_KA + kvh * 64 + 32 * hf, PB + rowb * INW + C_VA + kvh * 64 + 32 * hf, jlo, jhi,
                     [&](int j, float d) { const int dt = t - j; return (dt <= 128 && dt >= -128) ? d : -INFINITY; });
        const size_t crow = (size_t)NLAT + (size_t)b * CTXL;
        attn_segment(q, st, PB + crow * INW + C_KA + kvh * 64 + 32 * hf, PB + crow * INW + C_VA + kvh * 64 + 32 * hf, 0, CTXL, [&](int, float d) { return d; });
        attn_sink(st, sink[h]);
        attn_store(st, OB + (rowb + t) * DM + h * 64 + 32 * hf);
    }
#pragma unroll 1
    for (int it = gw; it < NB * 6 * 256; it += NGW) {
        const int r = (it & 255) >> 1, ch = it & 1, h = (it >> 8) % 6, b = it / (6 * 256);
        const int cq = ch * 32 + ql; const size_t rowb = (size_t)b * SEQ; const int t = r * 64 + cq;
        float q[32]; load_row32(PB + (rowb + t) * INW + C_QN + h * 64 + 32 * hf, q, 0.125f);
        AttnState st; attn_init(st);
        const int rs = min(max(r - 4, 0), 128 - 8), cs = min(max(cq - 8, 0), 64 - 16);
        const float* bias = rpb + (size_t)h * 15 * 31;
        attn_segment(q, st, PB + (rowb + (size_t)rs * 64) * INW + C_KN + h * 64 + 32 * hf, PB + (rowb + (size_t)rs * 64) * INW + C_VN + h * 64 + 32 * hf, 0, 512,
                     [&](int j, float d) { const int ka = rs + (j >> 6), ck = j & 63; const bool ok = (ck >= cs) && (ck < cs + 16);
                                           const int ro = ka - r + 7, co = min(max(ck - cq, -15), 15) + 15; return ok ? d + bias[ro * 31 + co] : -INFINITY; });
        const size_t crow = (size_t)NLAT + (size_t)b * CTXL;
        attn_segment(q, st, PB + crow * INW + C_KN + h * 64 + 32 * hf, PB + crow * INW + C_VN + h * 64 + 32 * hf, 0, CTXL, [&](int, float d) { return d; });
        attn_store(st, OB + (rowb + t) * DM + 640 + h * 64 + 32 * hf);
    }
#endif
    {
        const float* cw = p.conv_w + (size_t)l * 3 * 256;
        const int nrows = with_ctx ? NROWS : NLAT;
        for (long e = (long)bid * NTHREADS + tid; e < (long)nrows * 32; e += (long)nb * NTHREADS) {
            const int row = (int)(e >> 5), ch = (int)(e & 31) * 8;
            const int tpos = row < NLAT ? (row & (SEQ - 1)) : ((row - NLAT) & (CTXL - 1)); const int tlen = row < NLAT ? SEQ : CTXL;
            const bf16_t* pr = PB + (size_t)row * INW;
            float u[3][8];
#pragma unroll
            for (int dlt = -1; dlt <= 1; ++dlt) {
                const bool ok = (tpos + dlt >= 0) && (tpos + dlt < tlen);
                if (ok) { const u32x4 a = *(const u32x4*)(pr + (long)dlt * INW + C_BX + ch), c = *(const u32x4*)(pr + (long)dlt * INW + C_BC + ch);
                    u[dlt + 1][0] = bf_lo(a.x) * bf_lo(c.x); u[dlt + 1][1] = bf_hi(a.x) * bf_hi(c.x); u[dlt + 1][2] = bf_lo(a.y) * bf_lo(c.y); u[dlt + 1][3] = bf_hi(a.y) * bf_hi(c.y);
                    u[dlt + 1][4] = bf_lo(a.z) * bf_lo(c.z); u[dlt + 1][5] = bf_hi(a.z) * bf_hi(c.z); u[dlt + 1][6] = bf_lo(a.w) * bf_lo(c.w); u[dlt + 1][7] = bf_hi(a.w) * bf_hi(c.w); }
                else {
#pragma unroll
                    for (int i = 0; i < 8; ++i) u[dlt + 1][i] = 0.f; }
            }
            const u32x4 gb = *(const u32x4*)(pr + C_BB + ch);
            const float g[8] = {bf_lo(gb.x), bf_hi(gb.x), bf_lo(gb.y), bf_hi(gb.y), bf_lo(gb.z), bf_hi(gb.z), bf_lo(gb.w), bf_hi(gb.w)};
            float y[8];
#pragma unroll
            for (int i = 0; i < 8; ++i) y[i] = g[i] * (u[0][i] * cw[ch + i] + u[1][i] * cw[256 + ch + i] + u[2][i] * cw[512 + ch + i]);
            u32x4 o; o.x = pk2(y[0], y[1]); o.y = pk2(y[2], y[3]); o.z = pk2(y[4], y[5]); o.w = pk2(y[6], y[7]);
            *(u32x4*)(OB + (size_t)row * DM + 384 + ch) = o;
        }
    }
#if !FAST_ATTN
    if (with_ctx) {
#pragma unroll 1
        for (int it = gw; it < 2 * NB * 6 * 8; it += NGW) {
            const int kind = it / (NB * 6 * 8), r = it % (NB * 6 * 8), chunk = r & 7, h = (r >> 3) % 6, b = r / 48;
            const size_t crow = (size_t)NLAT + (size_t)b * CTXL; const int tq = chunk * 32 + ql;
            const int qc = (kind == 0 ? C_QA + h * 64 : C_QN + h * 64) + 32 * hf, kc = (kind == 0 ? C_KA + (h / 3) * 64 : C_KN + h * 64) + 32 * hf, vc = (kind == 0 ? C_VA + (h / 3) * 64 : C_VN + h * 64) + 32 * hf;
            float q[32]; load_row32(PB + (crow + tq) * INW + qc, q, 0.125f);
            AttnState st; attn_init(st);
            attn_segment(q, st, PB + crow * INW + kc, PB + crow * INW + vc, 0, CTXL, [&](int, float d) { return d; });
            if (kind == 0) attn_sink(st, sink[h]);
            attn_store(st, OB + (crow + tq) * DM + (kind == 0 ? 0 : 640) + h * 64 + 32 * hf);
        }
    }
#endif
}

namespace fa {
typedef short v4i16_t __attribute__((ext_vector_type(4)));
typedef float f32x2_t __attribute__((ext_vector_type(2))); typedef __bf16 bf16x2_t __attribute__((ext_vector_type(2)));
__device__ __forceinline__ unsigned cvtpk(float lo, float hi) { f32x2_t v = {lo, hi}; bf16x2_t b = __builtin_convertvector(v, bf16x2_t); return __builtin_bit_cast(unsigned, b); }
constexpr float LOG2E = 1.4426950408889634f, SC = 0.125f * LOG2E;
constexpr int CHUNK_BYTES = 65536;
constexpr int BIAS_OFF = 2 * CHUNK_BYTES;
constexpr float THR = 8.f;
__device__ __forceinline__ int na_rs(int r) { return min(max(r - 4, 0), 128 - 8); }
__device__ __forceinline__ void glds16(const void* gsrc, unsigned lds_dst) { unsigned keep;
    asm volatile("s_mov_b32 %0, m0\n\ts_mov_b32 m0, %2\n\ts_nop 0\n\tglobal_load_lds_dwordx4 %1, off\n\ts_mov_b32 m0, %0" : "=&s"(keep) : "v"(gsrc), "s"(lds_dst) : "memory"); }
#define FA_WAIT_BAR(N) asm volatile("s_waitcnt vmcnt(" #N ") lgkmcnt(0)\n\ts_barrier" ::: "memory")
__device__ __forceinline__ float max3f(float a, float b, float c) { float r; asm("v_max3_f32 %0, %1, %2, %3" : "=v"(r) : "v"(a), "v"(b), "v"(c)); return r; }
__device__ __forceinline__ float max8f(const f32x4& a, const f32x4& b) { return max3f(max3f(max3f(a[0], a[1], a[2]), a[3], b[0]), max3f(b[1], b[2], b[3]), -INFINITY); }
typedef float f32x16 __attribute__((ext_vector_type(16)));
__device__ __forceinline__ float max16f(const f32x16& a) {
    float x = max3f(a[0], a[1], a[2]); x = max3f(x, a[3], a[4]); x = max3f(x, a[5], a[6]); x = max3f(x, a[7], a[8]); x = max3f(x, a[9], a[10]); x = max3f(x, a[11], a[12]); x = max3f(x, a[13], a[14]);
    return fmaxf(x, a[15]);
}
typedef float f32x2v __attribute__((ext_vector_type(2)));
template <int MODE>
__device__ __forceinline__ void unit32(f32x16 (&o)[2], float& m, float& ls, const bf16x8 (&q)[4], const LAS unsigned char* Kt0, const LAS unsigned char* Kt1, const LAS unsigned char* Vt0, const LAS unsigned char* Vt1,
                                       const int (&kb)[4], const int (&vb)[2], bool rel0, bool rel1, bool mk0, bool mk1, int tb0, int tb1, const f32x16& fmask, const LAS float* bp0, const LAS float* bp1) {
    f32x16 s[2]; float tm = -INFINITY;
#pragma unroll
    for (int t = 0; t < 2; ++t) {
        if (!(t == 0 ? rel0 : rel1)) continue;
        const LAS unsigned char* Kt = t == 0 ? Kt0 : Kt1;
        bf16x8 kf[4];
#pragma unroll
        for (int ks = 0; ks < 4; ++ks) kf[ks] = *(const LAS bf16x8*)(Kt + kb[ks]);
        f32x16 acc = __builtin_amdgcn_mfma_f32_32x32x16_bf16(kf[0], q[0], (f32x16){0.f, 0.f, 0.f, 0.f, 0.f, 0.f, 0.f, 0.f, 0.f, 0.f, 0.f, 0.f, 0.f, 0.f, 0.f, 0.f}, 0, 0, 0);
#pragma unroll
        for (int ks = 1; ks < 4; ++ks) acc = __builtin_amdgcn_mfma_f32_32x32x16_bf16(kf[ks], q[ks], acc, 0, 0, 0);
        if (MODE == 2) {
            const LAS float* bp = t == 0 ? bp0 : bp1;
#pragma unroll
            for (int r = 0; r < 16; ++r) acc[r] = __builtin_fmaf(acc[r], SC, bp[(r & 3) + 8 * (r >> 2)]) + fmask[r];
        } else {
            if (MODE == 1 && (t == 0 ? mk0 : mk1)) { const int tb = t == 0 ? tb0 : tb1;
#pragma unroll
                for (int r = 0; r < 16; ++r) acc[r] = ((unsigned)(tb - ((r & 3) + 8 * (r >> 2))) <= 256u) ? acc[r] : -INFINITY;
            } else asm volatile("s_nop 15\n\ts_nop 7" : "+v"(acc));
        }
        s[t] = acc;
        tm = fmaxf(tm, max16f(acc));
    }
    if (MODE != 2) tm *= SC;
    if (__any(tm > m + THR)) {
        const float mn = fmaxf(m, xor32_max(tm)), al = __builtin_amdgcn_exp2f(m - mn); m = mn; ls *= al;
#pragma unroll
        for (int d = 0; d < 2; ++d) o[d] = o[d] * al;
    }
    const float nm = -m; f32x2v ps2 = {0.f, 0.f};
#pragma unroll
    for (int t = 0; t < 2; ++t) {
        if (!(t == 0 ? rel0 : rel1)) continue;
        const LAS unsigned char* Vt = t == 0 ? Vt0 : Vt1;
        f32x16 pv = MODE == 2 ? s[t] + nm : s[t] * SC + nm;
#pragma unroll
        for (int r = 0; r < 16; ++r) pv[r] = __builtin_amdgcn_exp2f(pv[r]);
#pragma unroll
        for (int r = 0; r < 16; r += 2) ps2 += (f32x2v){pv[r], pv[r + 1]};
#pragma unroll
        for (int st = 0; st < 2; ++st) {
            u32x4 pw; pw.x = cvtpk(pv[8 * st + 0], pv[8 * st + 1]); pw.y = cvtpk(pv[8 * st + 2], pv[8 * st + 3]); pw.z = cvtpk(pv[8 * st + 4], pv[8 * st + 5]); pw.w = cvtpk(pv[8 * st + 6], pv[8 * st + 7]);
            const bf16x8 pb = __builtin_bit_cast(bf16x8, pw);
#pragma unroll
            for (int db = 0; db < 2; ++db) {
                const v4i16_t t0 = __builtin_amdgcn_ds_read_tr16_b64_v4i16((LAS v4i16_t*)(Vt + st * 2048 + vb[db])), t1 = __builtin_amdgcn_ds_read_tr16_b64_v4i16((LAS v4i16_t*)(Vt + st * 2048 + 1024 + vb[db]));
                const bf16x8 vf = (bf16x8){t0[0], t0[1], t0[2], t0[3], t1[0], t1[1], t1[2], t1[3]};
                o[db] = __builtin_amdgcn_mfma_f32_32x32x16_bf16(vf, pb, o[db], 0, 0, 0);
            }
        }
    }
    ls += ps2[0] + ps2[1];
}
__device__ __forceinline__ void attn_prefetch_first(const Params& p, int it, int n0, int n1, int n2, LAS unsigned char* lds, int tid) {
    int b, hd, tok0;
    if (it < n0) { const int blk = it & 63; b = it >> 7; hd = (it >> 6) & 1; tok0 = 128 * (blk - 1 + (blk == 0 ? 1 : 0)); }
    else if (it < n0 + n1) { const int j = it - n0, blk = j & 31; b = j / 192; hd = 2 + (j >> 5) % 6; tok0 = na_rs(4 * blk) * 64; }
    else if (it < n0 + n1 + n2) { const int j = it - n0 - n1; b = j >> 2; hd = (j >> 1) & 1; tok0 = SEQ; }
    else { const int j = it - n0 - n1 - n2; b = j / 6; hd = 2 + j % 6; tok0 = SEQ; }
    const int lane = tid & 63, w = __builtin_amdgcn_readfirstlane(tid >> 6);
    const int skey = 8 * w + (lane >> 3), spc = lane & 7;
    const int ksrc = skey * 128 + ((spc ^ ((skey >> 1) & 7)) << 3);
    const int vsrc = skey * 128 + 64 + (((((spc >> 1) ^ (skey & 2)) << 1) | (spc & 1)) << 3);
    const bf16_t* s_ = (const bf16_t*)p.out + ((size_t)(b * 8 + hd) * KV_TOK + tok0) * 128;
    const unsigned d_ = (unsigned)__builtin_amdgcn_readfirstlane((int)((unsigned)(uintptr_t)lds + w * 1024));
#pragma unroll
    for (int q_ = 0; q_ < 4; ++q_) { glds16(s_ + q_ * 64 * 128 + ksrc, d_ + q_ * 8192u); glds16(s_ + q_ * 64 * 128 + vsrc, d_ + 32768u + q_ * 8192u); }
}
template <int KIND>
__device__ __forceinline__ void attn_item(const Params& p, int l, int item, LAS unsigned char* lds, int tid, int nxt_it, int n0, int n1, int n2) {
    constexpr bool ISA = (KIND == 0 || KIND == 2);
    constexpr int NG = ISA ? 2 : 1;
    const int lane = tid & 63, w = __builtin_amdgcn_readfirstlane(tid >> 6), ql = lane & 31, hh = lane >> 5;
    const bf16_t* PB = (const bf16_t*)(p.ws + WS_PB); bf16_t* OB = (bf16_t*)(p.ws + WS_OB);
    int b, hx, blk;
    if (KIND == 0) { b = item >> 7; hx = (item >> 6) & 1; blk = item & 63; }
    else if (KIND == 1) { b = item / 192; hx = (item >> 5) % 6; blk = item & 31; }
    else if (KIND == 2) { b = item >> 2; hx = (item >> 1) & 1; blk = item & 1; }
    else { b = item / 6; hx = item % 6; blk = 0; }
    const size_t rowb = (size_t)b * SEQ, ctxb = (size_t)NLAT + (size_t)b * CTXL;
    const bf16_t* KVh = (const bf16_t*)p.out + (size_t)(b * 8 + (ISA ? hx : 2 + hx)) * KV_TOK * 128;
    int nwin = 0; size_t winrow0 = 0; int winpos0 = 0, krs0 = 0;
    if (KIND == 0) { const int first = blk == 0 ? 1 : 0, last = blk == 63 ? 2 : 3; nwin = (last - first + 1) >> 1; winpos0 = 128 * (blk - 1 + first); winrow0 = winpos0; }
    if (KIND == 1) { krs0 = na_rs(4 * blk); nwin = (na_rs(4 * blk + 3) + 8 - krs0 + 3) >> 2; winrow0 = (size_t)krs0 * 64; }
    const int nch = nwin + 1;
    const bool active = true;
    int gh[NG], gp0[NG];
#pragma unroll
    for (int gi = 0; gi < NG; ++gi) {
        const int G = ISA ? (w < 4 ? 2 * w + gi : 8 + (w - 4)) : w;
        if (ISA) { gh[gi] = 3 * hx + (G >> 2); gp0[gi] = 128 * blk + 32 * (G & 3); }
        else if (KIND == 1) { gh[gi] = hx; gp0[gi] = 16 * (G & 3); }
        else { gh[gi] = hx; gp0[gi] = 32 * G; }
    }
    const int nrow0 = 4 * blk + 2 * (w >> 2);
    const int nrq = nrow0 + (ql >> 4), ncq = gp0[0] + (ql & 15);
#define FA_QROW(gi, ql_) (KIND == 0 ? rowb + gp0[gi] + (ql_) : KIND == 2 ? ctxb + gp0[gi] + (ql_) : KIND == 1 ? rowb + (size_t)(nrow0 + ((ql_) >> 4)) * 64 + gp0[gi] + ((ql_) & 15) : ctxb + gp0[gi] + (ql_))
    const int skey = 8 * w + (lane >> 3), spc = lane & 7;
    const int ksrc = skey * 128 + ((spc ^ ((skey >> 1) & 7)) << 3);
    const int vsrc = skey * 128 + 64 + (((((spc >> 1) ^ (skey & 2)) << 1) | (spc & 1)) << 3);
    const unsigned lds0 = (unsigned)(uintptr_t)lds;
    const int noff = KIND == 1 ? ((gp0[0] >> 4) == 0 ? 0 : ((gp0[0] >> 4) == 1 ? 8 : ((gp0[0] >> 4) == 2 ? 24 : 32))) : 0;
    int kb[4], kbw[4], vb[2];
#pragma unroll
    for (int ks = 0; ks < 4; ++ks) { kb[ks] = ql * 128 + (((2 * ks + hh) ^ ((ql >> 1) & 7)) << 4); kbw[ks] = ql * 128 + (((2 * ks + hh) ^ (((noff + ql) >> 1) & 7)) << 4); }
    { const int vk = 4 * hh + ((lane & 15) >> 2);
#pragma unroll
      for (int db = 0; db < 2; ++db) vb[db] = vk * 128 + (((2 * db + ((lane >> 4) & 1)) ^ (vk & 2)) << 5) + ((lane & 3) << 3); }
#define FA_DMA(ci) do { const size_t r0_ = (ci) < nwin ? winrow0 + (size_t)(ci) * 256 : (size_t)SEQ; const bf16_t* s_ = KVh + r0_ * 128; \
        const unsigned d_ = (unsigned)__builtin_amdgcn_readfirstlane((int)(lds0 + ((ci) & 1) * CHUNK_BYTES + w * 1024)); \
        _Pragma("unroll") for (int q_ = 0; q_ < 4; ++q_) { glds16(s_ + q_ * 64 * 128 + ksrc, d_ + q_ * 8192u); glds16(s_ + q_ * 64 * 128 + vsrc, d_ + 32768u + q_ * 8192u); } } while (0)
    bf16x8 qf[NG][4];
#pragma unroll
    for (int gi = 0; gi < NG; ++gi)
#pragma unroll
        for (int ks = 0; ks < 4; ++ks) qf[gi][ks] = *(const bf16x8*)(PB + FA_QROW(gi, ql) * INW + (ISA ? C_QA : C_QN) + gh[gi] * 64 + 16 * ks + 8 * hh);
    f32x16 o[NG][2]; float m[NG], ls[NG];
#pragma unroll
    for (int gi = 0; gi < NG; ++gi) {
#pragma unroll
        for (int d = 0; d < 2; ++d)
#pragma unroll
            for (int r = 0; r < 16; ++r) o[gi][d][r] = 0.f;
        if (ISA) { m[gi] = p.attn_sink[l * 6 + gh[gi]] * LOG2E; ls[gi] = hh == 0 ? 1.f : 0.f; } else { m[gi] = -1e30f; ls[gi] = 0.f; }
    }
    f32x16 fmask;
#pragma unroll
    for (int r = 0; r < 16; ++r) fmask[r] = 0.f;
    if (KIND == 1) { const int cs = min(max(ncq - 8, 0), 48);
#pragma unroll
        for (int r = 0; r < 16; ++r) { const int ck = noff + (r & 3) + 8 * (r >> 2) + 4 * hh; fmask[r] = ((ck >= cs) && (ck < cs + 16)) ? 0.f : -INFINITY; } }
    const int nqrs = na_rs(nrq);
    LAS float* biasL = (LAS float*)(lds + BIAS_OFF);
    if (KIND == 1) { const float* rp = p.na_rpb + ((size_t)l * 6 + hx) * 15 * 31;
        for (int i = tid; i < 16 * 128; i += NTHREADS) { const int x = (i & 127) - 64; biasL[i] = (i >> 7) == 15 ? -INFINITY : ((x >= -15 && x <= 15) ? rp[(i >> 7) * 31 + x + 15] * LOG2E : 0.f); } }
    FA_WAIT_BAR(0);
#pragma unroll
    for (int gi = 0; gi < NG; ++gi) { asm volatile("" : "+v"(qf[gi][0]), "+v"(qf[gi][1]), "+v"(qf[gi][2]), "+v"(qf[gi][3])); }
#pragma unroll 1
    for (int ci = 0; ci < nch; ++ci) {
        if (ci + 1 < nch) FA_DMA(ci + 1);
        const LAS unsigned char* Kb = lds + (ci & 1) * CHUNK_BYTES; const LAS unsigned char* Vb = Kb + 32768;
        const bool iswin = ci < nwin;
        if (active) {
            if (KIND == 1 && iswin) {
                const int rsA = na_rs(nrow0), rsB = na_rs(nrow0 + 1), bcol = 64 + noff + 4 * hh - ncq;
#pragma unroll 1
                for (int rr = 0; rr < 2; ++rr) {
                    const int kr0 = krs0 + 4 * ci + 2 * rr;
                    const bool rel0 = (kr0 >= rsA) && (kr0 < rsB + 8), rel1 = (kr0 + 1 >= rsA) && (kr0 + 1 < rsB + 8);
                    if (rel0 || rel1) {
                        const bool rowok0 = (kr0 >= nqrs) && (kr0 < nqrs + 8), rowok1 = (kr0 + 1 >= nqrs) && (kr0 + 1 < nqrs + 8);
                        const LAS float* bp0 = biasL + (rowok0 ? kr0 - nrq + 7 : 15) * 128 + bcol; const LAS float* bp1 = biasL + (rowok1 ? kr0 + 1 - nrq + 7 : 15) * 128 + bcol;
                        const LAS unsigned char* Kt = Kb + (128 * rr + noff) * 128; const LAS unsigned char* Vt = Vb + (128 * rr + noff) * 128;
                        unit32<2>(o[0], m[0], ls[0], qf[0], Kt, Kt + 64 * 128, Vt, Vt + 64 * 128, kbw, vb, rel0, rel1, false, false, 0, 0, fmask, bp0, bp1);
                    }
                }
            } else {
#pragma unroll 1
                for (int u = 0; u < 4; ++u) {
                    const LAS unsigned char* Kt = Kb + (64 * u) * 128; const LAS unsigned char* Vt = Vb + (64 * u) * 128;
#pragma unroll
                    for (int gi = 0; gi < NG; ++gi) {
                        if (ISA && gi == 1 && w >= 4) continue;
                        if (KIND == 0) {
                            bool rel[2] = {true, true}, msk[2] = {false, false};
                            if (iswin) {
#pragma unroll
                                for (int t = 0; t < 2; ++t) { const int j0 = winpos0 + 256 * ci + 64 * u + 32 * t, p0 = gp0[gi];
                                    rel[t] = (j0 + 31 >= p0 - 128) && (j0 <= p0 + 31 + 128); msk[t] = !((j0 >= p0 + 31 - 128) && (j0 + 31 <= p0 + 128)); } }
                            if (!(rel[0] || rel[1])) continue;
                            const int tb0 = gp0[gi] + ql - (winpos0 + 256 * ci + 64 * u) - 4 * hh + 128;
                            unit32<1>(o[gi], m[gi], ls[gi], qf[gi], Kt, Kt + 4096, Vt, Vt + 4096, kb, vb, rel[0], rel[1], msk[0], msk[1], tb0, tb0 - 32, fmask, nullptr, nullptr);
                        } else unit32<0>(o[gi], m[gi], ls[gi], qf[gi], Kt, Kt + 4096, Vt, Vt + 4096, kb, vb, true, true, false, false, 0, 0, fmask, nullptr, nullptr);
                    }
                }
            }
        }
        FA_WAIT_BAR(0);
    }
#undef FA_DMA
    if (nxt_it >= 0) attn_prefetch_first(p, nxt_it, n0, n1, n2, lds, tid);
    if (active) {
        int ql2 = lane & 31; asm volatile("" : "+v"(ql2));
#pragma unroll
        for (int gi = 0; gi < NG; ++gi) {
            if (ISA && gi == 1 && w >= 4) continue;
            const float lt = xor32_sum(ls[gi]);
            const float inv = 1.f / lt;
            bf16_t* op = OB + FA_QROW(gi, ql2) * DM + (ISA ? 0 : 640) + gh[gi] * 64 + 4 * hh;
#pragma unroll
            for (int db = 0; db < 2; ++db)
#pragma unroll
                for (int i = 0; i < 4; ++i) { u32x2 ov; ov.x = cvtpk(o[gi][db][4 * i] * inv, o[gi][db][4 * i + 1] * inv); ov.y = cvtpk(o[gi][db][4 * i + 2] * inv, o[gi][db][4 * i + 3] * inv); *(u32x2*)(op + 32 * db + 8 * i) = ov; }
        }
    }
#undef FA_QROW
}
__device__ __forceinline__ void phase_attn(const Params& p, int l, bool with_ctx, LAS unsigned char* lds, int bid, int nb) {
    bid = opaque_s(bid);
    const int n0 = NB * 2 * 64, n1 = NB * 6 * 32, n2 = with_ctx ? NB * 2 * 2 : 0, n3 = with_ctx ? NB * 6 : 0;
    const int vb = (nb % 8 == 0) ? (bid % 8) * (nb / 8) + bid / 8 : bid;
    const int ntot = n0 + n1 + n2 + n3;
    if (vb < ntot) attn_prefetch_first(p, vb, n0, n1, n2, lds, opaque_tid());
#pragma unroll 1
    for (int it = vb; it < ntot; it += nb) {
        const int tid = opaque_tid();
        const int nx = it + nb < ntot ? it + nb : -1;
        if (it < n0) attn_item<0>(p, l, it, lds, tid, nx, n0, n1, n2);
        else if (it < n0 + n1) attn_item<1>(p, l, it - n0, lds, tid, nx, n0, n1, n2);
        else if (it < n0 + n1 + n2) attn_item<2>(p, l, it - n0 - n1, lds, tid, nx, n0, n1, n2);
        else attn_item<3>(p, l, it - n0 - n1 - n2, lds, tid, nx, n0, n1, n2);
    }
}
}

__device__ __forceinline__ float reduce16(const float (&t)[16], int lane) {
    float u[8], w4[4], x2[2];
#pragma unroll
    for (int e = 0; e < 8; ++e) { float a = t[e], b = t[e + 8]; asm volatile("s_nop 1\n\tv_permlane32_swap_b32 %0, %1" : "+v"(a), "+v"(b)); u[e] = a + b; }
#pragma unroll
    for (int e = 0; e < 4; ++e) { float a = u[e], b = u[e + 4]; asm volatile("s_nop 1\n\tv_permlane16_swap_b32 %0, %1" : "+v"(a), "+v"(b)); w4[e] = a + b; }
    const bool b3 = (lane & 8) != 0, b2 = (lane & 4) != 0;
#pragma unroll
    for (int e = 0; e < 2; ++e) { const float keep = b3 ? w4[e + 2] : w4[e], send = b3 ? w4[e] : w4[e + 2]; x2[e] = keep + dppf<0x128>(send); }
    const float keep = b2 ? x2[1] : x2[0], send = b2 ? x2[0] : x2[1];
    float y = keep + dppf<0x141>(send);
    y += dppf<0xB1>(y); y += dppf<0x4E>(y);
    return y;
}
__device__ __forceinline__ float wave_max(float v) {
    v = fmaxf(v, dppf<0xB1>(v)); v = fmaxf(v, dppf<0x4E>(v)); v = fmaxf(v, dppf<0x141>(v)); v = fmaxf(v, dppf<0x140>(v));
    return xor32_max(xor16_max(v));
}
__device__ __forceinline__ float row16_sum(float v) { v += dppf<0xB1>(v); v += dppf<0x4E>(v); v += dppf<0x141>(v); v += dppf<0x140>(v); return v; }
__device__ __forceinline__ float row16_max(float v) { v = fmaxf(v, dppf<0xB1>(v)); v = fmaxf(v, dppf<0x4E>(v)); v = fmaxf(v, dppf<0x141>(v)); v = fmaxf(v, dppf<0x140>(v)); return v; }
__device__ __forceinline__ void phase_ln_router(const Params& p, int l, bool with_ctx, LAS unsigned char* lds, int bid, int nb) {
    bid = opaque_s(bid); const int tid = opaque_tid(), lane = tid & 63, w = tid >> 6, gw = bid * NWAVES + w, NGW = nb * NWAVES;
    constexpr int WRS = 2064;
    LAS unsigned char* wrb = lds;
    LAS float* lg = (LAS float*)(lds + 16 * WRS + 32); LAS float* lb = lg + DM; LAS float* lsh = lb + DM; LAS float* lsc = lsh + 5 * DM;
    LAS unsigned char* hst = (LAS unsigned char*)(lsc + 5 * DM) + w * 4096;
    const float* wrg = p.w_router + (size_t)l * DM * NE;
    { f32x4 q[8];
#pragma unroll
      for (int k = 0; k < 8; ++k) q[k] = *(const f32x4*)(wrg + (size_t)tid * 32 + 4 * k);
      const float* const srcs[12] = {p.ln1_g + l * DM, p.ln1_b + l * DM, mod_ptr(p, l, 0) + 3 * DM, mod_ptr(p, l, 1) + 3 * DM, mod_ptr(p, l, 2) + 3 * DM, mod_ptr(p, l, 3) + 3 * DM, mod_ptr(p, l, 4) + 3 * DM,
                                     mod_ptr(p, l, 0) + 4 * DM, mod_ptr(p, l, 1) + 4 * DM, mod_ptr(p, l, 2) + 4 * DM, mod_ptr(p, l, 3) + 4 * DM, mod_ptr(p, l, 4) + 4 * DM};
      lds_fill_vecs<12>(lg, srcs, tid);
#pragma unroll
      for (int e = 0; e < 16; ++e) *(LAS unsigned*)(wrb + e * WRS + tid * 4) = pk2(q[e >> 2][e & 3], q[4 + (e >> 2)][e & 3]); }
    __syncthreads();
    const bf16_t* XB = (const bf16_t*)(p.ws + WS_XB); bf16_t* HB = (bf16_t*)(p.ws + WS_HB); float* AFF = (float*)(p.ws + WS_AFF);
    const int nrows = with_ctx ? NROWS : NLAT;
    const int fr = lane & 15, fq = lane >> 4;
    const LAS unsigned char* bsrc = wrb + fr * WRS + fq * 16;
    const LAS unsigned char* asrc = hst + (fr & 1) * 2048 + fq * 16;
    auto rowh2 = [&](f32x4 (&v)[4], int row, int slot) {
        row_normalize(v); row_affine_l(v, lg, lb, lane);
        row_normalize(v);
        { const int mr = row_modrow(row); row_modulate_l(v, lsh + mr * DM, lsc + mr * DM, lane); }
#pragma unroll
        for (int j = 0; j < 4; ++j) { u32x2 o; o.x = pk2(v[j][0], v[j][1]); o.y = pk2(v[j][2], v[j][3]); *(u32x2*)(HB + (size_t)row * DM + 256 * j + 4 * lane) = o; *(LAS u32x2*)(hst + slot * 2048 + (256 * j + 4 * lane) * 2) = o; }
    };
    f32x4 va[4], vb[4]; u32x2 na[4], nb2[4];
    auto ldraw = [&](u32x2 (&d)[4], int r) {
#pragma unroll
        for (int j = 0; j < 4; ++j) d[j] = *(const u32x2*)(XB + (size_t)r * DM + 256 * j + 4 * lane); };
    auto unpack = [&](f32x4 (&d)[4], const u32x2 (&sv)[4]) {
#pragma unroll
        for (int j = 0; j < 4; ++j) d[j] = (f32x4){bf_lo(sv[j].x), bf_hi(sv[j].x), bf_lo(sv[j].y), bf_hi(sv[j].y)}; };
    const int step = 2 * NGW;
    ldraw(na, min(gw, nrows - 1)); ldraw(nb2, min(gw + NGW, nrows - 1));
#pragma unroll 1
    for (int row = gw; row < nrows; row += step) {
        const int rowB = min(row + NGW, nrows - 1);
        unpack(va, na); unpack(vb, nb2);
        ldraw(na, min(row + step, nrows - 1)); ldraw(nb2, min(row + step + NGW, nrows - 1));
        rowh2(va, row, 0); asm volatile("" ::: "memory"); rowh2(vb, rowB, 1);
        LDS_WAIT();
        f32x4 acc = {0.f, 0.f, 0.f, 0.f};
#pragma unroll 8
        for (int s = 0; s < 32; ++s) { const bf16x8 af = *(const LAS bf16x8*)(asrc + 64 * s), bf = *(const LAS bf16x8*)(bsrc + 64 * s); acc = __builtin_amdgcn_mfma_f32_16x16x32_bf16(af, bf, acc, 0, 0, 0); }
        const float m0 = row16_max(acc[0]), m1 = row16_max(acc[1]), e0 = expf(acc[0] - m0), e1 = expf(acc[1] - m1);
        float a0 = e0 / row16_sum(e0), a1 = e1 / row16_sum(e1);
        asm volatile("" : "+v"(a0), "+v"(a1));
        if (lane < 16) { AFF[(size_t)lane * NROWS + row] = a0; AFF[(size_t)lane * NROWS + rowB] = a1; }
        LDS_WAIT();
    }
}

__device__ __forceinline__ void topk_item(const float* aff  , int n, int k, int row0  , int e, int slot0,
                                          int* TOK, float* GATE, int* INV, LAS unsigned char* lds) {
    const int tid = opaque_tid(), lane = tid & 63, w = tid >> 6;
    LAS unsigned* keys = (LAS unsigned*)lds;
    LAS unsigned* hist = keys + 8192;
    LAS unsigned* misc = hist + 256;
    for (int i = tid; i < n; i += NTHREADS) keys[i] = __builtin_bit_cast(unsigned, aff[i]);
    if (tid == 0) { misc[0] = 0u; misc[1] = (unsigned)k; }
    __syncthreads();
    unsigned maskv = 0u;
    for (int pass = 0; pass < 4; ++pass) {
        const int shift = 24 - 8 * pass;
        if (tid < 256) hist[tid] = 0u;
        __syncthreads();
        const unsigned prefix = misc[0];
        for (int i = tid; i < n; i += NTHREADS) { const unsigned kv = keys[i]; if ((kv & maskv) == prefix) atomicAdd((unsigned*)&hist[(kv >> shift) & 255u], 1u); }
        __syncthreads();
        if (w == 0) {
            const unsigned rem = misc[1];
            const unsigned h0 = hist[4 * lane], h1 = hist[4 * lane + 1], h2 = hist[4 * lane + 2], h3 = hist[4 * lane + 3], s4 = h0 + h1 + h2 + h3;
            unsigned S = s4;
#pragma unroll
            for (int o = 1; o < 64; o <<= 1) { const unsigned y = __shfl_down(S, o); if (lane + o < 64) S += y; }
            const unsigned above = S - s4;
            if (above < rem && rem <= S) { unsigned cum = above; int bin;
                if (cum + h3 >= rem) bin = 3; else { cum += h3; if (cum + h2 >= rem) bin = 2; else { cum += h2; if (cum + h1 >= rem) bin = 1; else { cum += h1; bin = 0; } } }
                misc[0] = prefix | ((unsigned)(4 * lane + bin) << shift); misc[1] = rem - cum; }
        }
        __syncthreads();
        maskv |= 255u << shift;
    }
    const unsigned T = misc[0], need_eq = misc[1];
    __syncthreads();
    const int per = n >= NTHREADS ? n / NTHREADS : 1; const int t0 = tid * per; const bool act = t0 < n;
    unsigned ce = 0u;
    if (act) for (int i = 0; i < per; ++i) ce += (keys[t0 + i] == T) ? 1u : 0u;
    unsigned inc = ce;
#pragma unroll
    for (int o = 1; o < 64; o <<= 1) { const unsigned y = __shfl_up(inc, o); if (lane >= o) inc += y; }
    if (lane == 63) misc[16 + w] = inc;
    __syncthreads();
    unsigned base = 0u;
    for (int ww = 0; ww < w; ++ww) base += misc[16 + ww];
    unsigned eqrank = base + inc - ce;
    __syncthreads();
    unsigned cs = 0u;
    if (act) { unsigned er = eqrank; for (int i = 0; i < per; ++i) { const unsigned kv = keys[t0 + i]; if (kv > T) cs++; else if (kv == T) { if (er < need_eq) cs++; er++; } } }
    inc = cs;
#pragma unroll
    for (int o = 1; o < 64; o <<= 1) { const unsigned y = __shfl_up(inc, o); if (lane >= o) inc += y; }
    if (lane == 63) misc[16 + w] = inc;
    __syncthreads();
    base = 0u;
    for (int ww = 0; ww < w; ++ww) base += misc[16 + ww];
    unsigned pos = base + inc - cs;
    if (act) { unsigned er = eqrank; for (int i = 0; i < per; ++i) { const unsigned kv = keys[t0 + i]; bool sel = false;
            if (kv > T) sel = true; else if (kv == T) { sel = er < need_eq; er++; }
            const int row = row0 + t0 + i;
            if (sel) { const int slot = slot0 + (int)pos; TOK[slot] = row; GATE[slot] = __builtin_bit_cast(float, kv); INV[(size_t)e * NROWS + row] = slot; pos++; }
            else INV[(size_t)e * NROWS + row] = -1; } }
    __syncthreads();
}
__device__ __forceinline__ void phase_topk(const Params& p, bool with_ctx, LAS unsigned char* lds, int bid, int nb) {
    const float* AFF = (const float*)(p.ws + WS_AFF); int* TOK = (int*)(p.ws + WS_TOK); float* GATE = (float*)(p.ws + WS_GATE); int* INV = (int*)(p.ws + WS_INV);
    const int nitems = with_ctx ? 128 : 64;
    for (int it = bid; it < nitems; it += nb) {
        if (it < 64) { const int b = it >> 4, e = it & 15; topk_item(AFF + (size_t)e * NROWS + (size_t)b * SEQ, SEQ, CAP, b * SEQ, e, (b * NE + e) * CAP, TOK, GATE, INV, lds); }
        else { const int b = (it - 64) >> 4, e = it & 15; topk_item(AFF + (size_t)e * NROWS + NLAT + (size_t)b * CTXL, CTXL, CCAP, NLAT + b * CTXL, e, NSLOT_LAT + (e * NB + b) * CCAP, TOK, GATE, INV, lds); }
    }
}

__device__ __forceinline__ void phase_combine(const Params& p, int l, bool with_ctx, LAS unsigned char* lds, int bid, int nb) {
    bid = opaque_s(bid); const int tid = opaque_tid(); const int lane = tid & 63, gw = bid * NWAVES + (tid >> 6), NGW = nb * NWAVES;
    LAS float* l1g = (LAS float*)lds; LAS float* l1b = l1g + DM; LAS float* l2g = l1b + DM; LAS float* l2b = l2g + DM; LAS float* lg2 = l2b + DM; LAS float* lsh = lg2 + 5 * DM; LAS float* lsc = lsh + 5 * DM;
    if (l + 1 < DEPTH) { const int n = l + 1 < DEPTH ? l + 1 : l;
        const float* const srcs[19] = {p.ln1_g + l * DM, p.ln1_b + l * DM, p.ln2_g + l * DM, p.ln2_b + l * DM,
            mod_ptr(p, l, 0) + 5 * DM, mod_ptr(p, l, 1) + 5 * DM, mod_ptr(p, l, 2) + 5 * DM, mod_ptr(p, l, 3) + 5 * DM, mod_ptr(p, l, 4) + 5 * DM,
            mod_ptr(p, n, 0), mod_ptr(p, n, 1), mod_ptr(p, n, 2), mod_ptr(p, n, 3), mod_ptr(p, n, 4),
            mod_ptr(p, n, 0) + DM, mod_ptr(p, n, 1) + DM, mod_ptr(p, n, 2) + DM, mod_ptr(p, n, 3) + DM, mod_ptr(p, n, 4) + DM};
        lds_fill_vecs<19>(l1g, srcs, tid); }
    else { const float* const srcs[9] = {p.ln1_g + l * DM, p.ln1_b + l * DM, p.ln2_g + l * DM, p.ln2_b + l * DM,
            mod_ptr(p, l, 0) + 5 * DM, mod_ptr(p, l, 1) + 5 * DM, mod_ptr(p, l, 2) + 5 * DM, mod_ptr(p, l, 3) + 5 * DM, mod_ptr(p, l, 4) + 5 * DM};
        lds_fill_vecs<9>(l1g, srcs, tid); }
    __syncthreads();
    bf16_t* XB = (bf16_t*)(p.ws + WS_XB); bf16_t* HB = (bf16_t*)(p.ws + WS_HB);
    const bf16_t* Y = (const bf16_t*)(p.ws + WS_Y); const int* INV = (const int*)(p.ws + WS_INV);
    const int nrows = with_ctx ? NROWS : NLAT;
    f32x4 v[4]; u32x2 xc[4], xn[4], yc[4][4], yn[4][4]; float wcur[4], wnxt[4]; unsigned restc = 0u, restn = 0u; int invc, invn, invnn;
    auto issue = [&](u32x2 (&x)[4], u32x2 (&y)[4][4], float (&w)[4], unsigned& rest, int row, int inv) {
#pragma unroll
        for (int j = 0; j < 4; ++j) x[j] = *(const u32x2*)(XB + (size_t)row * DM + 256 * j + 4 * lane);
        unsigned m = (unsigned)__ballot(inv >= 0) & 0xffffu; int s0 = 0;
#pragma unroll
        for (int k = 0; k < 4; ++k) { int s = s0; w[k] = 0.f;
            if (m) { s = __builtin_amdgcn_readlane(inv, __builtin_ctz(m)); m &= m - 1u; w[k] = 1.f; if (k == 0) s0 = s; }
            const bf16_t* yr = Y + (size_t)s * DM;
#pragma unroll
            for (int j = 0; j < 4; ++j) y[k][j] = *(const u32x2*)(yr + 256 * j + 4 * lane); }
        rest = m;
    };
    auto invld = [&](int row) { return INV[(size_t)(lane & 15) * NROWS + min(row, nrows - 1)]; };
    invc = invld(gw); invn = invld(gw + NGW);
    issue(xc, yc, wcur, restc, min(gw, nrows - 1), invc);
#pragma unroll 1
    for (int row = gw; row < nrows; row += NGW) {
        bf16_t* xr = XB + (size_t)row * DM;
        const int rn = row + NGW < nrows ? row + NGW : row;
        issue(xn, yn, wnxt, restn, rn, invn); invnn = invld(row + 2 * NGW);
        f32x4 a[4];
#pragma unroll
        for (int j = 0; j < 4; ++j) a[j] = (f32x4){0.f, 0.f, 0.f, 0.f};
#pragma unroll
        for (int k = 0; k < 4; ++k)
#pragma unroll
            for (int j = 0; j < 4; ++j) { const u32x2 wv = yc[k][j]; const float w = wcur[k];
                a[j][0] = fmaf(w, bf_lo(wv.x), a[j][0]); a[j][1] = fmaf(w, bf_hi(wv.x), a[j][1]); a[j][2] = fmaf(w, bf_lo(wv.y), a[j][2]); a[j][3] = fmaf(w, bf_hi(wv.y), a[j][3]); }
        for (unsigned m = restc; m; m &= m - 1u) {
            const int slot = __builtin_amdgcn_readlane(invc, __builtin_ctz(m)); const bf16_t* yr = Y + (size_t)slot * DM;
#pragma unroll
            for (int j = 0; j < 4; ++j) { const u32x2 wv = *(const u32x2*)(yr + 256 * j + 4 * lane); a[j][0] += bf_lo(wv.x); a[j][1] += bf_hi(wv.x); a[j][2] += bf_lo(wv.y); a[j][3] += bf_hi(wv.y); } }
#pragma unroll
        for (int j = 0; j < 4; ++j) v[j] = (f32x4){bf_lo(xc[j].x), bf_hi(xc[j].x), bf_lo(xc[j].y), bf_hi(xc[j].y)};
        row_normalize(v); row_affine_l(v, l1g, l1b, lane);
        const int mr = row_modrow(row);
#pragma unroll
        for (int j = 0; j < 4; ++j) { const f32x4 g2 = *(const LAS f32x4*)(lg2 + mr * DM + 256 * j + 4 * lane); v[j] = v[j] * ALPHA + g2 * a[j]; }
        row_normalize(v); row_affine_l(v, l2g, l2b, lane);
        if (l + 1 < DEPTH) row_store_bf16(xr, lane, v); else row_store(p.out + (size_t)row * DM, lane, v);
        if (l + 1 < DEPTH) { row_normalize(v); row_modulate_l(v, lsh + mr * DM, lsc + mr * DM, lane); row_store_bf16(HB + (size_t)row * DM, lane, v); }
#pragma unroll
        for (int j = 0; j < 4; ++j) { xc[j] = xn[j];
#pragma unroll
            for (int k = 0; k < 4; ++k) yc[k][j] = yn[k][j]; }
#pragma unroll
        for (int k = 0; k < 4; ++k) wcur[k] = wnxt[k];
        restc = restn; invc = invn; invn = invnn;
    }
}

constexpr int N_PHASES = 2 + 8 * DEPTH;
#define IN(k) (lo <= (k) && (k) < hi)
#ifndef TS_SEL
#define TS_SEL -1
#endif
#define TS_MULT 8
#define SEAM(k) do { if (IN(k) && IN((k) + 1)) xcd_barrier(bar); if (TS_SEL >= 0 && blockIdx.x == 0 && threadIdx.x == 0) ((unsigned long long*)(p.ws + WS_CTL + 65536))[(k) + 1] = __builtin_amdgcn_s_memrealtime(); } while (0)
#ifndef PHMASK
#define PHMASK 0x3ff
#endif
#define PHON(i) ((PHMASK >> (i)) & 1)
#ifndef DUP_MASK
#define DUP_MASK 0
#endif
#define DUP(i) ((DUP_MASK >> (i)) & 1)
template <int l>
__device__ __forceinline__ void run_layer(const Params& p, LAS unsigned char* lds, LAS int* idxl, const XcdBarrier& bar, int bid, int nb, int lo, int hi) {
    bf16_t* HB = (bf16_t*)(p.ws + WS_HB); bf16_t* PB = (bf16_t*)(p.ws + WS_PB); bf16_t* OB = (bf16_t*)(p.ws + WS_OB);
    bf16_t* HH = (bf16_t*)(p.ws + WS_HH); bf16_t* Y = (bf16_t*)(p.ws + WS_Y);
    const int* TOK = (const int*)(p.ws + WS_TOK); const float* GATE = (const float*)(p.ws + WS_GATE);
        const int pb = 2 + 8 * l; const bool wc = (l == 0);
        if (IN(pb + 0)) { if (PHON(2)) {
            const bf16_t* W = (const bf16_t*)(p.ws + WS_WIN) + (size_t)l * INW * DM; EpiQKV E{PB, (const float*)(p.ws + WS_ROPE), (bf16_t*)p.out};
            { SgDesc g{HB + (size_t)NLAT * DM, DM, nullptr, W, 0, 1 << 30, 1, NCTX, INW, DM, NLAT}; sg_gemm(g, E, lds, bid, nb); }
            { mg::Gemm g{HB, W, NLAT, INW, DM, nullptr, 0, 1 << 20, 1}; mg::StaticOrder S; S.init(NLAT, INW, nb, bid); mg::EpiAdapt<EpiQKV> EA{E, 0, lds + STG_OFF}; mg::gemm_phase(lds, idxl, g, S, EA); if (DUP(2)) mg::gemm_phase(lds, idxl, g, S, EA); } } }
        SEAM(pb + 0);
        if (IN(pb + 1)) { if (PHON(3)) {
#if FAST_ATTN
            fa::phase_attn(p, l, wc, lds, bid, nb); if (DUP(3)) fa::phase_attn(p, l, wc, lds, bid, nb);
#endif
            phase_mixers(p, l, wc, bid, nb); if (DUP(11)) phase_mixers(p, l, wc, bid, nb); } }
        SEAM(pb + 1);
        if (IN(pb + 2)) { if (PHON(4)) {
            const bf16_t* W = (const bf16_t*)(p.ws + WS_WOUT) + (size_t)l * DM * DM;
            EpiOut<l == 0> E{p.x, p.ctx, (bf16_t*)(p.ws + WS_XB), mod_ptr(p, l, 0)};
            if (wc) { SgDesc g{OB + (size_t)NLAT * DM, DM, nullptr, W, 0, 1 << 30, 1, NCTX, DM, DM, NLAT}; sg_gemm(g, E, lds, bid, nb); }
            { mg::Gemm g{OB, W, NLAT, DM, DM, nullptr, 0, 1 << 20, 1}; mg::StaticOrder S; S.init(NLAT, DM, nb, bid); mg::EpiAdapt<EpiOut<l == 0>> EA{E, 0, lds + STG_OFF}; mg::gemm_phase(lds, idxl, g, S, EA); if (DUP(4) && l == 0) mg::gemm_phase(lds, idxl, g, S, EA); } } }
        SEAM(pb + 2);
        if (IN(pb + 3)) { if (PHON(5)) phase_ln_router(p, l, wc, lds, bid, nb); }
        SEAM(pb + 3);
        if (IN(pb + 4)) { if (PHON(6)) { phase_topk(p, wc, lds, bid, nb); if (DUP(6)) phase_topk(p, wc, lds, bid, nb);
            { const int busy = wc ? 128 : 64;
              if (bid >= busy && nb > busy) phase_weights(p, lds, bid - busy, nb - busy, l == 0 ? TR_P0 : TR_SPLIT, l == 0 ? TR_SPLIT : 2 * TR_PER_L); } } }
        SEAM(pb + 4);
        if (IN(pb + 5)) { if (PHON(7)) {
            const bf16_t* W = (const bf16_t*)(p.ws + WS_WGU) + (size_t)l * NE * 1024 * DM; EpiGU E{HH};
            if (wc) { SgDesc g{HB, DM, TOK + NSLOT_LAT, W, (size_t)1024 * DM, NB * CCAP, NE, NSLOT_CTX, 1024, DM, NSLOT_LAT}; sg_gemm(g, E, lds, bid, nb); }
            { mg::Gemm g{HB, W, NSLOT_LAT, 1024, DM, TOK, (size_t)1024 * DM, CAP / 256, NE}; mg::StaticOrder S; S.init(NSLOT_LAT, 1024, nb, bid); mg::EpiAdapt<EpiGU> EA{E, 0, lds + STG_OFF}; mg::gemm_phase(lds, idxl, g, S, EA); if (DUP(7)) mg::gemm_phase(lds, idxl, g, S, EA); } } }
        SEAM(pb + 5);
        if (IN(pb + 6)) { if (PHON(8)) {
            const bf16_t* W = (const bf16_t*)(p.ws + WS_WD) + (size_t)l * NE * DM * FF; EpiDown E{Y, GATE};
            if (wc) { SgDesc g{HH + (size_t)NSLOT_LAT * FF, FF, nullptr, W, (size_t)DM * FF, NB * CCAP, NE, NSLOT_CTX, DM, FF, NSLOT_LAT}; sg_gemm(g, E, lds, bid, nb); }
            { mg::Gemm g{HH, W, NSLOT_LAT, DM, FF, nullptr, (size_t)DM * FF, CAP / 256, NE}; mg::StaticOrder S; S.init(NSLOT_LAT, DM, nb, bid); mg::EpiAdapt<EpiDown> EA{E, 0, lds + STG_OFF}; mg::gemm_phase(lds, idxl, g, S, EA); if (DUP(8)) mg::gemm_phase(lds, idxl, g, S, EA); } } }
        SEAM(pb + 6);
        if (IN(pb + 7)) { if (PHON(9)) phase_combine(p, l, wc, lds, bid, nb); }
        SEAM(pb + 7);
}
__global__ void __launch_bounds__(NTHREADS, 2) fwd_kernel(Params p) {
    extern __shared__ __attribute__((aligned(16))) unsigned char lds_raw[];
    LAS unsigned char* lds = (LAS unsigned char*)lds_raw;
    const int bid = blockIdx.x, nb = gridDim.x;
    volatile LAS unsigned* MISC = (volatile LAS unsigned*)(lds + LDS_BYTES - 64);
    LAS int* idxl = (LAS int*)(lds + mg::STAGE_BYTES);
    if (threadIdx.x < 16) MISC[threadIdx.x] = 0u;
    __syncthreads();
    XcdBarrier bar; bar.bar = (unsigned*)(p.ws + WS_CTL) + CW_BAR; bar.x = 0; bar.st = nullptr;
    const bool multi = p.ph_hi - p.ph_lo > 1;
    if (multi) bar = xcd_barrier_post((unsigned*)(p.ws + WS_CTL) + CW_BAR, MISC + 8);
    bf16_t* HB = (bf16_t*)(p.ws + WS_HB); bf16_t* PB = (bf16_t*)(p.ws + WS_PB); bf16_t* OB = (bf16_t*)(p.ws + WS_OB);
    bf16_t* HH = (bf16_t*)(p.ws + WS_HH); bf16_t* Y = (bf16_t*)(p.ws + WS_Y);
    const int* TOK = (const int*)(p.ws + WS_TOK); const float* GATE = (const float*)(p.ws + WS_GATE);
    const int lo = p.ph_lo, hi = p.ph_hi;
    if (TS_SEL >= 0 && blockIdx.x == 0 && threadIdx.x == 0) ((unsigned long long*)(p.ws + WS_CTL + 65536))[0] = __builtin_amdgcn_s_memrealtime();
    if (IN(0)) { if (PHON(0)) { phase_prologue(p, lds, bid, nb); __syncthreads(); phase_weights(p, lds, bid, nb, 0, TR_P0); } } SEAM(0);
    if (IN(1)) { if (PHON(1)) phase_ln1(p, lds, bid, nb); if (DUP(1)) { __syncthreads(); phase_ln1(p, lds, bid, nb); } } SEAM(1);
    run_layer<0>(p, lds, idxl, bar, bid, nb, lo, hi);
    run_layer<1>(p, lds, idxl, bar, bid, nb, lo, hi);
    if (TS_SEL >= 0 && blockIdx.x == 0 && threadIdx.x == 0) {
        volatile unsigned long long* ts = (volatile unsigned long long*)(p.ws + WS_CTL + 65536); const unsigned long long dt = (ts[TS_SEL + 1] - ts[TS_SEL]) * TS_MULT, t0 = __builtin_amdgcn_s_memrealtime();
        while (__builtin_amdgcn_s_memrealtime() - t0 < dt) __builtin_amdgcn_s_sleep(8); }
#undef IN
#undef SEAM
}

#ifndef N_LAUNCH_SPLIT
#define N_LAUNCH_SPLIT 0
#endif
extern "C" void kernel_launch(void* const* d_in, const int* in_sizes, int n_in, void* d_out, int out_size, void* d_ws, size_t ws_size, hipStream_t stream) {
    static int grid = 0;
    if (grid == 0) {
        if (n_in != 19 || in_sizes[0] != NLAT * DM || out_size != NLAT * DM || ws_size < WS_END) { fprintf(stderr, "kernel_launch: unexpected shapes (n_in %d, in0 %d, out %d, ws %zu)\n", n_in, n_in > 0 ? in_sizes[0] : -1, out_size, ws_size); grid = -1; return; }
        int dev = 0, cus = 0, per_cu = 0;
        if (hipGetDevice(&dev) != hipSuccess || hipDeviceGetAttribute(&cus, hipDeviceAttributeMultiprocessorCount, dev) != hipSuccess) { grid = -1; return; }
        if (hipFuncSetAttribute((const void*)fwd_kernel, hipFuncAttributeMaxDynamicSharedMemorySize, LDS_BYTES) != hipSuccess) { fprintf(stderr, "kernel_launch: hipFuncSetAttribute failed\n"); grid = -1; return; }
        if (hipOccupancyMaxActiveBlocksPerMultiprocessor(&per_cu, (const void*)fwd_kernel, NTHREADS, LDS_BYTES) != hipSuccess || per_cu < 1) { fprintf(stderr, "kernel_launch: occupancy query says %d\n", per_cu); per_cu = 1; }
        (void)hipGetLastError();
        grid = cus;
    }
    if (grid < 0) return;
    (void)hipMemsetAsync((char*)d_ws + WS_CTL, 0, CTL_ZERO_BYTES, stream);
    Params p{};
    const float** pp = (const float**)&p;
    for (int i = 0; i < 19; ++i) pp[i] = (const float*)d_in[i];
    p.out = (float*)d_out; p.ws = (unsigned char*)d_ws;
#if N_LAUNCH_SPLIT
    for (int ph = 0; ph < N_PHASES; ++ph) { p.ph_lo = ph; p.ph_hi = ph + 1; hipLaunchKernelGGL(fwd_kernel, dim3(grid), dim3(NTHREADS), LDS_BYTES, stream, p); }
#else
    p.ph_lo = 0; p.ph_hi = N_PHASES;
    void* args[] = {&p};
    hipError_t e = hipLaunchCooperativeKernel((const void*)fwd_kernel, dim3(grid), dim3(NTHREADS), args, LDS_BYTES, stream);
    if (e != hipSuccess) fprintf(stderr, "kernel_launch: cooperative launch failed: %s\n", hipGetErrorString(e));
#endif
}
```
